# Optimizing an MI355X kernel written in HIP

```python
import math
import jax, jax.numpy as jnp
from jax import lax
import numpy as np

D_MODEL = 1024
BATCH = 2
SEQ = 8192
DEPTH = 1
DEC_BATCH = 128
DEC_SEQ = 4
PAST_LEN = 2048
PAGE_SIZE = 128

H_M = 4
DH_M = 128
W_M = H_M * DH_M
CHUNK = 64
F_BIAS_LO = 3.0
F_BIAS_HI = 6.0
H_D = 4
DQK_D = 64
DV_D = 2 * DQK_D
W_D = H_D * DV_D
Q_BLOCK = 128
D_FF = 2816
CONV_W = 3
EPS = 1e-6
IN_SIZES = (W_M, W_M, W_M, W_M, 2 * H_M, H_D * 2 * DQK_D, H_D * 2 * DQK_D, W_D, D_MODEL, D_MODEL)
D_IN = 4 * W_M + 2 * H_M + 2 * H_D * 2 * DQK_D + W_D + 2 * D_MODEL

kernel_name = 'hybrid_mlstm_diffattn_convffn_step'


def rms_norm(x, g):
    xf = x.astype(jnp.float32)
    y = xf * lax.rsqrt(jnp.mean(xf * xf, axis=-1, keepdims=True) + EPS)
    return (y * g.astype(jnp.float32)).astype(x.dtype)


def adaln_terms(c, w_ada, b_ada):
    ada = jnp.einsum('bd,de->be', c, w_ada) + b_ada
    return jnp.split(ada[:, None, :], 6, axis=-1)


def split_columns(z):
    offsets = np.cumsum(np.array(IN_SIZES))[:-1].tolist()
    return jnp.split(z, offsets, axis=-1)


def chunk_len(t):
    return CHUNK if t % CHUNK == 0 else t


def mlstm_scan(q, k, v, i_raw, logf, C0, n0, m0):
    B, T, H, Dh = q.shape
    L = chunk_len(T)
    nc = T // L

    def to_chunks(a):
        return jnp.moveaxis(a.reshape((B, nc, L) + a.shape[2:]), 1, 0)

    causal = jnp.tril(jnp.ones((L, L), dtype=bool))[None, :, :, None]

    def step(carry, blk):
        C, n, m = carry
        qb, kb, vb, ib, fb = blk
        F = jnp.cumsum(fb, axis=1)
        a = ib - F
        m_t = F + jnp.maximum(m[:, None, :], lax.cummax(a, axis=1))
        logD = jnp.where(causal, F[:, :, None, :] + a[:, None, :, :] - m_t[:, :, None, :], -jnp.inf)
        s = jnp.einsum('bthd,bshd->btsh', qb, kb) * jnp.exp(logD)
        inter = jnp.exp(F + m[:, None, :] - m_t)
        num = jnp.einsum('btsh,bshv->bthv', s, vb) + inter[..., None] * jnp.einsum('bhvd,bthd->bthv', C, qb)
        den = jnp.sum(s, axis=2) + inter * jnp.einsum('bhd,bthd->bth', n, qb)
        h = num / jnp.maximum(jnp.abs(den), jnp.exp(-m_t))[..., None]
        m_end = m_t[:, -1]
        F_end = F[:, -1]
        w_end = jnp.exp(F_end[:, None, :] + a - m_end[:, None, :])
        decay = jnp.exp(F_end + m - m_end)
        C_new = decay[..., None, None] * C + jnp.einsum('bsh,bshv,bshd->bhvd', w_end, vb, kb)
        n_new = decay[..., None] * n + jnp.einsum('bsh,bshd->bhd', w_end, kb)
        return (C_new, n_new, m_end), h

    blocks = (to_chunks(q), to_chunks(k), to_chunks(v), to_chunks(i_raw), to_chunks(logf))
    (C, n, m), hs = lax.scan(step, (C0, n0, m0), blocks)
    return jnp.moveaxis(hs, 0, 1).reshape(B, T, H, Dh), C, n, m


def mlstm_branch(mq, mk, mv, mo, mif, b_if, g_norm, C0, n0, m0):
    B, T, _ = mq.shape
    f32 = jnp.float32
    q = mq.astype(f32).reshape(B, T, H_M, DH_M)
    k = mk.astype(f32).reshape(B, T, H_M, DH_M) * (DH_M ** -0.5)
    v = mv.astype(f32).reshape(B, T, H_M, DH_M)
    gates = mif.astype(f32) + b_if.astype(f32)
    i_raw = gates[..., :H_M]
    logf = jax.nn.log_sigmoid(gates[..., H_M:])
    h, C, n, m = mlstm_scan(q, k, v, i_raw, logf, C0.astype(f32), n0.astype(f32), m0.astype(f32))
    h = rms_norm(h, g_norm.reshape(H_M, DH_M)).astype(mq.dtype)
    out = jax.nn.sigmoid(mo) * h.reshape(B, T, W_M)
    return out, C, n, m


def diff_attend(q1, q2, k1, k2, v, mask, lam):
    scale = DQK_D ** -0.5
    s1 = jnp.einsum('bqhd,bkhd->bhqk', q1, k1).astype(jnp.float32) * scale
    s2 = jnp.einsum('bqhd,bkhd->bhqk', q2, k2).astype(jnp.float32) * scale
    s1 = jnp.where(mask, s1, -jnp.inf)
    s2 = jnp.where(mask, s2, -jnp.inf)
    a = jax.nn.softmax(s1, axis=-1) - lam * jax.nn.softmax(s2, axis=-1)
    return jnp.einsum('bhqk,bkhv->bqhv', a.astype(v.dtype), v)


def diff_branch(dq, dk, dv, lq1, lk1, lq2, lk2, g_norm, lam_init, past_k, past_v):
    B, T, _ = dq.shape
    f32 = jnp.float32
    q = dq.reshape(B, T, H_D, 2 * DQK_D)
    k_rows = dk.reshape(B, T, H_D, 2 * DQK_D)
    v_rows = dv.reshape(B, T, H_D, DV_D)
    lam = (jnp.exp(jnp.sum(lq1.astype(f32) * lk1.astype(f32)))
           - jnp.exp(jnp.sum(lq2.astype(f32) * lk2.astype(f32))) + lam_init)
    q1, q2 = q[..., :DQK_D], q[..., DQK_D:]
    if past_k is None:
        k1, k2 = k_rows[..., :DQK_D], k_rows[..., DQK_D:]
        nb = T // Q_BLOCK
        key_pos = jnp.arange(T)

        def block(args):
            bi, qb1, qb2 = args
            q_pos = bi * Q_BLOCK + jnp.arange(Q_BLOCK)
            return diff_attend(qb1, qb2, k1, k2, v_rows, key_pos[None, :] <= q_pos[:, None], lam)

        def to_blocks(a):
            return jnp.moveaxis(a.reshape(B, nb, Q_BLOCK, H_D, DQK_D), 1, 0)

        o = lax.map(block, (jnp.arange(nb), to_blocks(q1), to_blocks(q2)))
        o = jnp.moveaxis(o, 0, 1).reshape(B, T, H_D, DV_D)
    else:
        past_len = past_k.shape[1]
        k_all = jnp.concatenate([past_k.astype(k_rows.dtype), k_rows], axis=1)
        v_all = jnp.concatenate([past_v.astype(v_rows.dtype), v_rows], axis=1)
        mask = jnp.arange(past_len + T)[None, :] <= past_len + jnp.arange(T)[:, None]
        o = diff_attend(q1, q2, k_all[..., :DQK_D], k_all[..., DQK_D:], v_all, mask, lam)
    o = rms_norm(o, g_norm.reshape(H_D, DV_D)) * (1.0 - lam_init)
    return o.reshape(B, T, W_D), k_rows, v_rows


def conv_ffn(h, w_up, conv_w, conv_b, w_down, conv_state):
    T = h.shape[1]
    u = jnp.einsum('btd,df->btf', h, w_up)
    a, b = u[..., :D_FF], u[..., D_FF:]
    a_ext = jnp.concatenate([conv_state.astype(a.dtype), a], axis=1)
    conv = conv_b
    for j in range(CONV_W):
        conv = conv + conv_w[j] * a_ext[:, j:j + T]
    out = jnp.einsum('btf,fd->btd', jax.nn.gelu(conv, approximate=True) * b, w_down)
    return out, a_ext[:, -(CONV_W - 1):]


def layer_forward(x, c, p, lam_init, past_k, past_v, C0, n0, m0, conv0):
    shift1, scale1, gate1, shift2, scale2, gate2 = adaln_terms(c, p['w_ada'], p['b_ada'])
    h = rms_norm(x, p['g_pre_mix']) * (1.0 + scale1) + shift1
    z = jnp.einsum('btd,de->bte', h, p['w_in'])
    mq, mk, mv, mo, mif, dq, dk, dv, gm, gd = split_columns(z)
    hm, C, n, m = mlstm_branch(mq, mk, mv, mo, mif, p['b_if'], p['g_mlstm'], C0, n0, m0)
    hd, k_rows, v_rows = diff_branch(dq, dk, dv, p['lq1'], p['lk1'], p['lq2'], p['lk2'],
                                     p['g_diff'], lam_init, past_k, past_v)
    merged = (jax.nn.sigmoid(gm) * jnp.einsum('btw,wd->btd', hm, p['w_proj_m'])
              + jax.nn.sigmoid(gd) * jnp.einsum('btw,wd->btd', hd, p['w_proj_d']))
    y = jnp.einsum('btd,de->bte', merged, p['w_out'])
    x = x + gate1 * rms_norm(y, p['g_post_mix'])
    h2 = rms_norm(x, p['g_pre_ffn']) * (1.0 + scale2) + shift2
    f, conv_new = conv_ffn(h2, p['w_up'], p['conv_w'], p['conv_b'], p['w_down'], conv0)
    x = x + gate2 * rms_norm(f, p['g_post_ffn'])
    return x, k_rows, v_rows, C, n, m, conv_new


def setup_inputs(seed: int = 0) -> dict:
    key = jax.random.key(seed)
    ks = jax.random.split(key, 40)
    n_pages = PAST_LEN // PAGE_SIZE
    n_used = DEC_BATCH * n_pages
    n_pool = (n_used * 5) // 4

    def nrm(k, shape, scale=1.0):
        return scale * jax.random.normal(k, shape, jnp.float32)

    def gain(k, shape):
        return 1.0 + 0.05 * jax.random.normal(k, shape, jnp.float32)

    page_table = jax.random.permutation(ks[6], n_pool)[:n_used].reshape(DEC_BATCH, n_pages).astype(jnp.int32)
    f_bias = jnp.broadcast_to(jnp.linspace(F_BIAS_LO, F_BIAS_HI, H_M, dtype=jnp.float32), (DEPTH, H_M))
    b_if = jnp.concatenate([nrm(ks[16], (DEPTH, H_M), 0.1), f_bias + nrm(ks[17], (DEPTH, H_M), 0.1)], axis=-1)
    return {
        'x_prompt': nrm(ks[0], (BATCH, SEQ, D_MODEL)),
        'x_sample': nrm(ks[1], (DEC_BATCH, DEC_SEQ, D_MODEL)),
        'c_prompt': nrm(ks[2], (BATCH, D_MODEL)),
        'c_sample': nrm(ks[3], (DEC_BATCH, D_MODEL)),
        'cache_k': nrm(ks[4], (DEPTH, n_pool, PAGE_SIZE, H_D, 2 * DQK_D)),
        'cache_v': nrm(ks[5], (DEPTH, n_pool, PAGE_SIZE, H_D, DV_D)),
        'page_table': page_table,
        'state_C': nrm(ks[7], (DEPTH, DEC_BATCH, H_M, DH_M, DH_M), 0.1),
        'state_n': nrm(ks[8], (DEPTH, DEC_BATCH, H_M, DH_M), 0.1),
        'state_m': jax.random.uniform(ks[9], (DEPTH, DEC_BATCH, H_M), jnp.float32, 0.0, 4.0),
        'state_conv': nrm(ks[10], (DEPTH, DEC_BATCH, CONV_W - 1, D_FF)),
        'w_ada': nrm(ks[11], (DEPTH, D_MODEL, 6 * D_MODEL), 0.5 * D_MODEL ** -0.5),
        'b_ada': nrm(ks[12], (DEPTH, 6 * D_MODEL), 0.01),
        'g_pre_mix': gain(ks[13], (DEPTH, D_MODEL)),
        'g_post_mix': gain(ks[14], (DEPTH, D_MODEL)),
        'w_in': nrm(ks[15], (DEPTH, D_MODEL, D_IN), D_MODEL ** -0.5),
        'b_if': b_if,
        'g_mlstm': gain(ks[18], (DEPTH, W_M)),
        'lambda_q1': nrm(ks[19], (DEPTH, DQK_D), 0.1),
        'lambda_k1': nrm(ks[20], (DEPTH, DQK_D), 0.1),
        'lambda_q2': nrm(ks[21], (DEPTH, DQK_D), 0.1),
        'lambda_k2': nrm(ks[22], (DEPTH, DQK_D), 0.1),
        'g_diff': gain(ks[23], (DEPTH, W_D)),
        'w_proj_m': nrm(ks[24], (DEPTH, W_M, D_MODEL), W_M ** -0.5),
        'w_proj_d': nrm(ks[25], (DEPTH, W_D, D_MODEL), W_D ** -0.5),
        'w_out': nrm(ks[26], (DEPTH, D_MODEL, D_MODEL), D_MODEL ** -0.5),
        'g_pre_ffn': gain(ks[27], (DEPTH, D_MODEL)),
        'g_post_ffn': gain(ks[28], (DEPTH, D_MODEL)),
        'w_up': nrm(ks[29], (DEPTH, D_MODEL, 2 * D_FF), D_MODEL ** -0.5),
        'conv_w': nrm(ks[30], (DEPTH, CONV_W, D_FF), CONV_W ** -0.5),
        'conv_b': nrm(ks[31], (DEPTH, D_FF), 0.01),
        'w_down': nrm(ks[32], (DEPTH, D_FF, D_MODEL), D_FF ** -0.5),
    }


def reference(x_prompt, x_sample, c_prompt, c_sample, cache_k, cache_v, page_table,
              state_C, state_n, state_m, state_conv, w_ada, b_ada, g_pre_mix, g_post_mix,
              w_in, b_if, g_mlstm, lambda_q1, lambda_k1, lambda_q2, lambda_k2, g_diff,
              w_proj_m, w_proj_d, w_out, g_pre_ffn, g_post_ffn, w_up, conv_w, conv_b, w_down):
    f32 = jnp.float32
    B = x_prompt.shape[0]
    n_seq, n_pages = page_table.shape
    page = cache_k.shape[2]
    xp, xs = x_prompt, x_sample
    kp_l, vp_l, Cp_l, np_l, mp_l, cvp_l = [], [], [], [], [], []
    ks_l, vs_l, Cs_l, ns_l, ms_l, cvs_l = [], [], [], [], [], []
    for l in range(DEPTH):
        p = {'w_ada': w_ada[l], 'b_ada': b_ada[l], 'g_pre_mix': g_pre_mix[l], 'g_post_mix': g_post_mix[l],
             'w_in': w_in[l], 'b_if': b_if[l], 'g_mlstm': g_mlstm[l],
             'lq1': lambda_q1[l], 'lk1': lambda_k1[l], 'lq2': lambda_q2[l], 'lk2': lambda_k2[l],
             'g_diff': g_diff[l], 'w_proj_m': w_proj_m[l], 'w_proj_d': w_proj_d[l], 'w_out': w_out[l],
             'g_pre_ffn': g_pre_ffn[l], 'g_post_ffn': g_post_ffn[l], 'w_up': w_up[l],
             'conv_w': conv_w[l], 'conv_b': conv_b[l], 'w_down': w_down[l]}
        lam_init = 0.8 - 0.6 * math.exp(-0.3 * l)
        xp, kp, vp, Cp, n_p, mp, cvp = layer_forward(
            xp, c_prompt, p, lam_init, None, None,
            jnp.zeros((B, H_M, DH_M, DH_M), f32), jnp.zeros((B, H_M, DH_M), f32),
            jnp.zeros((B, H_M), f32), jnp.zeros((B, CONV_W - 1, D_FF), xp.dtype))
        past_k = cache_k[l][page_table].reshape(n_seq, n_pages * page, H_D, 2 * DQK_D)
        past_v = cache_v[l][page_table].reshape(n_seq, n_pages * page, H_D, DV_D)
        xs, ksm, vsm, Cs, n_s, ms, cvs = layer_forward(
            xs, c_sample, p, lam_init, past_k, past_v,
            state_C[l], state_n[l], state_m[l], state_conv[l])
        kp_l.append(kp); vp_l.append(vp)
        Cp_l.append(Cp.astype(state_C.dtype)); np_l.append(n_p.astype(state_n.dtype))
        mp_l.append(mp.astype(state_m.dtype)); cvp_l.append(cvp.astype(state_conv.dtype))
        ks_l.append(ksm); vs_l.append(vsm)
        Cs_l.append(Cs.astype(state_C.dtype)); ns_l.append(n_s.astype(state_n.dtype))
        ms_l.append(ms.astype(state_m.dtype)); cvs_l.append(cvs.astype(state_conv.dtype))
    return (xp, xs,
            jnp.stack(kp_l), jnp.stack(vp_l), jnp.stack(Cp_l), jnp.stack(np_l), jnp.stack(mp_l), jnp.stack(cvp_l),
            jnp.stack(ks_l), jnp.stack(vs_l), jnp.stack(Cs_l), jnp.stack(ns_l), jnp.stack(ms_l), jnp.stack(cvs_l))
```

```cpp
#include <hip/hip_runtime.h>
#include <cstdio>
#include <cstdint>

#define LAS __attribute__((address_space(3)))
#define GAS __attribute__((address_space(1)))
typedef unsigned short bf16_t;
typedef short bf16x8 __attribute__((ext_vector_type(8)));
typedef short s16x4 __attribute__((ext_vector_type(4)));
typedef short v4i16_t __attribute__((ext_vector_type(4)));
typedef float f32x2 __attribute__((ext_vector_type(2)));
typedef float f32x4 __attribute__((ext_vector_type(4)));
typedef float f32x16 __attribute__((ext_vector_type(16)));
typedef unsigned u32x2 __attribute__((ext_vector_type(2)));
typedef unsigned u32x4 __attribute__((ext_vector_type(4)));
typedef __bf16 bf16x2_t __attribute__((ext_vector_type(2)));
typedef GAS unsigned gu32;

constexpr int DM = 1024, TP = 8192, MP = 16384, MS = 512, MT = MP + MS;
constexpr int NSEQ = 128, TS = 4, NPAGES = 16, PAGE = 128, PAST = 2048;
constexpr int DIN = 5640, ZP = 5632, DFF = 2816;
constexpr int ZQ = 0, ZK = 512, ZV = 1024, ZO = 1536, ZDQ = 2048, ZDK = 2560, ZDV = 3072, ZGM = 3584, ZGD = 4608;
constexpr float EPS = 1e-6f, LAM_INIT = 0.2f, LOG2E = 1.4426950408889634f;
constexpr float QSCALE = 0.125f * LOG2E;
constexpr float KSCALE = 0.08838834764831845f;
constexpr size_t OFF_Y = 0, OFF_KP = 17301504, OFF_VP = 25690112, OFF_CP = 34078720, OFF_NP = 34209792, OFF_MP = 34210816, OFF_CVP = 34210824,
                 OFF_KS = 34222088, OFF_VS = 34484232, OFF_CS = 34746376, OFF_NS = 43134984, OFF_MS = 43200520, OFF_CVS = 43201032, OUT_TOTAL = 43921928;
constexpr size_t MiB = 1u << 20;
constexpr size_t WS_CTL = 0, CTL_ZERO_BYTES = 1 * MiB;
constexpr size_t WS_WIN = 1 * MiB, WS_WUP = 12 * MiB, WS_WDOWN = 23 * MiB, WS_WOUT = 29 * MiB, WS_WPM = 31 * MiB, WS_WPD = 32 * MiB;
constexpr size_t WS_ADA = 33 * MiB, WS_IG = 37 * MiB, WS_LF = 37 * MiB + 512 * 1024, WS_ST = 38 * MiB, WS_NU = 38 * MiB + 65536, WS_NPREV = 39 * MiB, WS_MPREV = 39 * MiB + 768 * 1024;
constexpr size_t WS_H1 = 40 * MiB, WS_Z = 73 * MiB, WS_U = 255 * MiB, WS_CPREV = 319 * MiB, WS_HM = 351 * MiB, WS_HD = 368 * MiB, WS_O1 = 385 * MiB, WS_O2 = 417 * MiB;
constexpr size_t WS_MG = 449 * MiB, WS_Y = 482 * MiB, WS_UA = 548 * MiB, WS_UB = 639 * MiB, WS_G = 730 * MiB, WS_END = 821 * MiB;
constexpr int CW_BAR = 4096;
constexpr int RING_BYTES = 131072, MISC_OFF = RING_BYTES + 320, LDS_BYTES = 147456;
constexpr int NWAVES = 8, NTHR = 512;

__device__ __forceinline__ unsigned pk2(float lo, float hi) { f32x2 v = {lo, hi}; bf16x2_t b = __builtin_convertvector(v, bf16x2_t); return __builtin_bit_cast(unsigned, b); }
__device__ __forceinline__ bf16_t f2bf(float x) { return (bf16_t)(pk2(x, 0.f) & 0xffffu); }
__device__ __forceinline__ float bflo(unsigned u) { return __uint_as_float(u << 16); }
__device__ __forceinline__ float bfhi(unsigned u) { return __uint_as_float(u & 0xffff0000u); }
__device__ __forceinline__ float bf2f(bf16_t u) { return __uint_as_float(((unsigned)u) << 16); }
__device__ __forceinline__ bf16x8 pack8(f32x4 a, f32x4 b) { u32x4 w; w.x = pk2(a.x, a.y); w.y = pk2(a.z, a.w); w.z = pk2(b.x, b.y); w.w = pk2(b.z, b.w); return __builtin_bit_cast(bf16x8, w); }
__device__ __forceinline__ void unpack8(u32x4 w, f32x4& a, f32x4& b) { a.x = bflo(w.x); a.y = bfhi(w.x); a.z = bflo(w.y); a.w = bfhi(w.y); b.x = bflo(w.z); b.y = bfhi(w.z); b.z = bflo(w.w); b.w = bfhi(w.w); }
__device__ __forceinline__ float wave_sum(float v) {
#pragma unroll
    for (int o = 1; o < 64; o <<= 1) v += __shfl_xor(v, o);
    return v;
}
__device__ __forceinline__ float wave_max(float v) {
#pragma unroll
    for (int o = 1; o < 64; o <<= 1) v = fmaxf(v, __shfl_xor(v, o));
    return v;
}
__device__ __forceinline__ float wave_scan_sum(float v, int lane) {
#pragma unroll
    for (int o = 1; o < 64; o <<= 1) { const float t = __shfl_up(v, o); if (lane >= o) v += t; }
    return v;
}
__device__ __forceinline__ float wave_scan_max(float v, int lane) {
#pragma unroll
    for (int o = 1; o < 64; o <<= 1) { const float t = __shfl_up(v, o); if (lane >= o) v = fmaxf(v, t); }
    return v;
}
__device__ __forceinline__ float sigmoidf_(float x) { return __builtin_amdgcn_rcpf(1.f + __builtin_amdgcn_exp2f(-x * LOG2E)); }
__device__ __forceinline__ float log_sigmoid(float x) { return fminf(x, 0.f) - log1pf(__expf(-fabsf(x))); }
__device__ __forceinline__ int crow(int reg, int h) { return (reg & 3) + 8 * (reg >> 2) + 4 * h; }
#define MFMA32(a, b, c) __builtin_amdgcn_mfma_f32_32x32x16_bf16((a), (b), (c), 0, 0, 0)
#define MFMA16(a, b, c) __builtin_amdgcn_mfma_f32_16x16x32_bf16((a), (b), (c), 0, 0, 0)
__device__ __forceinline__ s16x4 tr_rd(const LAS unsigned char* p) { return __builtin_bit_cast(s16x4, __builtin_amdgcn_ds_read_tr16_b64_v4i16((LAS v4i16_t*)p)); }
__device__ __forceinline__ bf16x8 cat4(s16x4 lo, s16x4 hi) { return (bf16x8){lo[0], lo[1], lo[2], lo[3], hi[0], hi[1], hi[2], hi[3]}; }
#define WG_BAR() __syncthreads()

namespace pg8 {
constexpr int BM = 256, BK = 64, HALF = 128, HTB = HALF * BK * 2, STAGE_BYTES = 8 * HTB, NXCD = 8, WGM = 8;
__host__ __device__ __forceinline__ int lds_byte(int r, int c) { const int st = (r >> 4) * 2 + (c >> 5), rr = r & 15, cc = c & 31, ob = rr * 64 + cc * 2; return st * 1024 + (ob ^ (((ob >> 9) & 1) << 5)); }
__host__ __device__ __forceinline__ void stage_rc(int b, int& R, int& C) { const int st = b / 1024, sb = b % 1024, swz = sb ^ (((sb >> 9) & 1) << 5); R = (st >> 1) * 16 + swz / 64; C = (st & 1) * 32 + (swz % 64) / 2; }
__host__ __device__ __forceinline__ int perm32(int rho) { const int n = rho >> 4, i = rho & 15; return 8 * (i >> 2) + 4 * n + (i & 3); }
struct Unit { int pm, pn; };
struct Gemm { const bf16_t* A; const bf16_t* Bt; int M, N, K; };
struct StaticOrder {
    int nM, nN, nwg, G, c;
    __host__ __device__ void init(int M, int N, int G_, int c_) { nM = M / BM; nN = N / BM; nwg = nM * nN; G = G_; c = c_; }
    __host__ __device__ bool next(int i, Unit& u) const {
        const long L = (long)i * G + c; if (L >= nwg) return false;
        int wgid = (int)L; { const int q = nwg / NXCD, r = nwg % NXCD, xcd = wgid % NXCD, off = wgid / NXCD; wgid = (xcd < r ? xcd * (q + 1) : r * (q + 1) + (xcd - r) * q) + off; }
        const int nig = WGM * nN, gid = wgid / nig, fm = gid * WGM, gsz = (nM - fm) < WGM ? (nM - fm) : WGM;
        u.pm = fm + ((wgid % nig) % gsz); u.pn = (wgid % nig) / gsz; return true;
    }
};
template <class Epi>
__device__ __forceinline__ void gemm_phase(LAS unsigned char* lds, const Gemm g, const StaticOrder& S, const Epi& E) {
    const int tid = threadIdx.x, wid = __builtin_amdgcn_readfirstlane(tid >> 6), lane = tid & 63, wr = wid >> 2, wc = wid & 3, fr = lane & 15, fq = lane >> 4;
    const int K = g.K, nt = K / BK;
    unsigned voffA[2], voffB[2];
#pragma unroll
    for (int i = 0; i < 2; ++i) { int R, C; stage_rc(tid * 16 + i * 8192, R, C); const int Rb = (R & ~31) + perm32(R & 31);
        voffA[i] = (unsigned)(R * K + C) * 2u; voffB[i] = (unsigned)(Rb * K + C) * 2u; }
    const size_t kstep = (size_t)(BK * 2);
    const size_t hstep = (size_t)HALF * K * 2;
    const size_t tstep = 2 * hstep;
    const unsigned ldsw = (unsigned)wid * 1024u;
    const int aoff = lds_byte(wr * 64 + fr, fq * 8), boff = lds_byte(wc * 32 + fr, fq * 8);
#define PG8_SA(b, h) (((b) * 2 + (h)) * HTB)
#define PG8_SB(b, h) ((4 + (b) * 2 + (h)) * HTB)
#define PG8_STAGE(bufoff, gbase, voff) do { _Pragma("unroll") for (int _i = 0; _i < 2; ++_i) \
        __builtin_amdgcn_global_load_lds((const unsigned*)((const char*)(gbase) + (voff)[_i]), (LAS unsigned*)(lds + (bufoff) + ldsw + _i * 8192), 16, 0, 0); } while (0)
#define PG8_LDA(dst, b, h) do { _Pragma("unroll") for (int m = 0; m < 4; ++m) _Pragma("unroll") for (int k = 0; k < 2; ++k) dst[m][k] = *(const LAS bf16x8*)(lds + PG8_SA(b, h) + aoff + m * 2048 + k * 1024); } while (0)
#define PG8_LDB(dst, b, h) do { _Pragma("unroll") for (int n = 0; n < 2; ++n) _Pragma("unroll") for (int k = 0; k < 2; ++k) dst[n][k] = *(const LAS bf16x8*)(lds + PG8_SB(b, h) + boff + n * 2048 + k * 1024); } while (0)
#define PG8_MMA(ai, bj, At, Bt) do { __builtin_amdgcn_s_setprio(1); _Pragma("unroll") for (int m = 0; m < 4; ++m) _Pragma("unroll") for (int n = 0; n < 2; ++n) _Pragma("unroll") for (int k = 0; k < 2; ++k) \
        acc[ai][bj][m][n] = __builtin_amdgcn_mfma_f32_16x16x32_bf16(Bt[n][k], At[m][k], acc[ai][bj][m][n], 0, 0, 0); __builtin_amdgcn_s_setprio(0); } while (0)
#define PG8_WAIT_V(n) asm volatile("s_waitcnt vmcnt(" #n ")" ::: "memory")
#define PG8_WAIT_L(n) asm volatile("s_waitcnt lgkmcnt(" #n ")" ::: "memory")
#define PG8_BAR __builtin_amdgcn_s_barrier()
#define PG8_SCHED __builtin_amdgcn_sched_barrier(0)
    Unit cur, nxt; int ui = 0;
    if (!S.next(0, cur)) return;
    f32x4 acc[2][2][4][2];
#pragma unroll
    for (int a = 0; a < 2; ++a)
#pragma unroll
        for (int b = 0; b < 2; ++b)
#pragma unroll
            for (int m = 0; m < 4; ++m)
#pragma unroll
                for (int n = 0; n < 2; ++n) acc[a][b][m][n] = (f32x4){0.f, 0.f, 0.f, 0.f};
    bf16x8 At[4][2], B0[2][2], B1[2][2];
    const char* cA = (const char*)g.A + (size_t)cur.pm * tstep; const char* cB = (const char*)g.Bt + (size_t)cur.pn * tstep;
    PG8_STAGE(PG8_SB(0, 0), cB, voffB); PG8_STAGE(PG8_SB(0, 1), cB + hstep, voffB); PG8_STAGE(PG8_SA(0, 0), cA, voffA); PG8_STAGE(PG8_SA(0, 1), cA + hstep, voffA);
    if (wr == 1) PG8_BAR;
    PG8_WAIT_V(2); PG8_BAR;
    PG8_STAGE(PG8_SB(1, 0), cB + kstep, voffB); PG8_STAGE(PG8_SA(1, 0), cA + kstep, voffA); PG8_STAGE(PG8_SB(1, 1), cB + hstep + kstep, voffB);
    PG8_WAIT_V(6); PG8_BAR;
    for (;;) {
        const bool has_next = S.next(ui + 1, nxt);
        const char* nA = has_next ? (const char*)g.A + (size_t)nxt.pm * tstep : cA; const char* nB = has_next ? (const char*)g.Bt + (size_t)nxt.pn * tstep : cB;
        for (int t = 0; t < nt; t += 2) {
            const bool last = (t == nt - 2);
            const char* a1 = cA + (size_t)(t + 1) * kstep;
            const char* a2 = last ? nA : cA + (size_t)(t + 2) * kstep; const char* b2 = last ? nB : cB + (size_t)(t + 2) * kstep;
            const char* a3 = a2 + kstep; const char* b3 = b2 + kstep;
            PG8_LDB(B0, 0, 0); PG8_LDB(B1, 0, 1); PG8_SCHED; PG8_LDA(At, 0, 0); PG8_STAGE(PG8_SA(1, 1), a1 + hstep, voffA);
            PG8_WAIT_V(8); PG8_WAIT_L(0); PG8_BAR; PG8_MMA(0, 0, At, B0); PG8_MMA(0, 1, At, B1); PG8_BAR; PG8_SCHED;
            PG8_LDA(At, 0, 1); PG8_STAGE(PG8_SB(0, 0), b2, voffB); PG8_STAGE(PG8_SB(0, 1), b2 + hstep, voffB); PG8_STAGE(PG8_SA(0, 0), a2, voffA);
            PG8_WAIT_V(8); PG8_WAIT_L(0); PG8_BAR; PG8_MMA(1, 0, At, B0); PG8_MMA(1, 1, At, B1); PG8_BAR; PG8_SCHED;
            PG8_LDB(B0, 1, 0); PG8_LDB(B1, 1, 1); PG8_SCHED; PG8_LDA(At, 1, 0); PG8_STAGE(PG8_SA(0, 1), a2 + hstep, voffA);
            PG8_WAIT_V(8); PG8_WAIT_L(0); PG8_BAR; PG8_MMA(0, 0, At, B0); PG8_MMA(0, 1, At, B1); PG8_BAR; PG8_SCHED;
            PG8_LDA(At, 1, 1); PG8_STAGE(PG8_SB(1, 0), b3, voffB); PG8_STAGE(PG8_SB(1, 1), b3 + hstep, voffB); PG8_STAGE(PG8_SA(1, 0), a3, voffA);
            PG8_WAIT_V(8); PG8_WAIT_L(0); PG8_BAR; PG8_MMA(1, 0, At, B0); PG8_MMA(1, 1, At, B1); PG8_BAR; PG8_SCHED;
        }
        if (wr == 0) PG8_BAR;
        {
            const int row0 = cur.pm * BM + wr * 64 + fr, col0 = cur.pn * BM + wc * 32 + 8 * fq;
#pragma unroll
            for (int ai = 0; ai < 2; ++ai)
#pragma unroll
                for (int m = 0; m < 4; ++m)
#pragma unroll
                    for (int bj = 0; bj < 2; ++bj) E.st8(row0 + ai * HALF + m * 16, col0 + bj * HALF, acc[ai][bj][m][0], acc[ai][bj][m][1]);
        }
        if (!has_next) break;
#pragma unroll
        for (int a = 0; a < 2; ++a)
#pragma unroll
            for (int b = 0; b < 2; ++b)
#pragma unroll
                for (int m = 0; m < 4; ++m)
#pragma unroll
                    for (int n = 0; n < 2; ++n) acc[a][b][m][n] = (f32x4){0.f, 0.f, 0.f, 0.f};
        cur = nxt; cA = nA; cB = nB; ++ui;
        if (wr == 1) PG8_BAR;
    }
    PG8_WAIT_V(0);
    PG8_BAR;
#undef PG8_SA
#undef PG8_SB
#undef PG8_STAGE
#undef PG8_LDA
#undef PG8_LDB
#undef PG8_MMA
#undef PG8_WAIT_V
#undef PG8_WAIT_L
#undef PG8_BAR
#undef PG8_SCHED
}
}

#define XB_TMO      128
#define XB_XCNT(j)  (256  + 64 * (j))
#define XB_XSUB(j)  (1280 + 64 * (j))
#define XB_XGEN(j)  (2304 + 64 * (j))
#define XB_TOP      3328
#define XB_TOPGEN   3392
#define XCD_BAR_WORDS 3456
#define XB_SPIN_CAP (1u << 18)
__device__ __forceinline__ unsigned xb_ld(unsigned* p)              { return __hip_atomic_load(p, __ATOMIC_RELAXED, __HIP_MEMORY_SCOPE_AGENT); }
__device__ __forceinline__ unsigned xb_add(unsigned* p, unsigned v) { return __hip_atomic_fetch_add(p, v, __ATOMIC_RELAXED, __HIP_MEMORY_SCOPE_AGENT); }
__device__ __forceinline__ unsigned xb_xcc_id() { return (unsigned)__builtin_amdgcn_s_getreg((3 << 11) | 20) & 0xFu; }
#define XB_SPIN(cond, bar) do { unsigned _sp = 0; while (cond) { __builtin_amdgcn_s_sleep(1); \
    if ((++_sp & 255u) == 0u) { if (xb_ld(&(bar)[XB_TMO])) break; if (_sp > XB_SPIN_CAP) { atomicAdd(&(bar)[XB_TMO], 1u); break; } } } } while (0)
struct XcdBarrier { unsigned* bar; unsigned x; volatile LAS unsigned* st; };
__device__ __forceinline__ XcdBarrier xcd_barrier_post(unsigned* bar, volatile LAS unsigned* st) {
    XcdBarrier b; b.bar = bar; b.x = xb_xcc_id(); b.st = st;
    if (threadIdx.x == 0) (void)xb_add(&bar[XB_XCNT(b.x)], 1u);
    return b;
}
__device__ __forceinline__ void xcd_barrier_complete(unsigned* bar, unsigned x, unsigned& nloc, unsigned& nx) {
    const unsigned G = gridDim.x * gridDim.y * gridDim.z;
    unsigned sum, cnt, mine, sp = 0u;
    for (;;) {
        sum = 0u; cnt = 0u; mine = 0u;
#pragma unroll
        for (unsigned j = 0; j < 16; ++j) { const unsigned c = xb_ld(&bar[XB_XCNT(j)]); sum += c; cnt += (c > 0u) ? 1u : 0u; mine = (j == x) ? c : mine; }
        if (sum == G) break;
        __builtin_amdgcn_s_sleep(1);
        if ((++sp & 255u) == 0u) { if (xb_ld(&bar[XB_TMO])) break; if (sp > XB_SPIN_CAP) { atomicAdd(&bar[XB_TMO], 1u); break; } }
    }
    nloc = mine > 0u ? mine : 1u; nx = cnt > 0u ? cnt : 1u;
}
__device__ __forceinline__ void xcd_barrier(const XcdBarrier& b) {
    asm volatile("s_waitcnt vmcnt(0)" ::: "memory");
    __syncthreads();
    if (threadIdx.x == 0) {
        unsigned* bar = b.bar;
        __builtin_amdgcn_s_waitcnt(0);
        unsigned nloc = b.st[0], nx = b.st[1];
        if (nloc == 0u) { xcd_barrier_complete(bar, b.x, nloc, nx); b.st[0] = nloc; b.st[1] = nx; }
        const unsigned old = xb_add(&bar[XB_XSUB(b.x)], 1u);
        const unsigned gen = old / nloc;
        if (old + 1u == (gen + 1u) * nloc) {
            __builtin_amdgcn_fence(__ATOMIC_RELEASE, "agent");
            asm volatile("s_waitcnt vmcnt(0)" ::: "memory");
            const unsigned og = xb_add(&bar[XB_TOP], 1u);
            const unsigned tg = og / nx;
            if (og + 1u == (tg + 1u) * nx) xb_add(&bar[XB_TOPGEN], 1u);
            else XB_SPIN(xb_ld(&bar[XB_TOPGEN]) == tg, bar);
            __builtin_amdgcn_fence(__ATOMIC_ACQUIRE, "agent");
            xb_add(&bar[XB_XGEN(b.x)], 1u);
            asm volatile("s_waitcnt vmcnt(0)" ::: "memory");
        } else {
            XB_SPIN(xb_ld(&bar[XB_XGEN(b.x)]) == gen, bar);
            __builtin_amdgcn_fence(__ATOMIC_ACQUIRE, "agent");
            asm volatile("s_waitcnt vmcnt(0)" ::: "memory");
        }
    }
    __syncthreads();
}

struct Args { const void* in[32]; float* out; unsigned char* ws; int ph_lo, ph_hi; };
struct Frame { LAS unsigned char* lds; int tid, lane, wave, vcu, G; const Args* a; };
#define FP_x_prompt ((const float*)F.a->in[0])
#define FP_x_sample ((const float*)F.a->in[1])
#define FP_c_prompt ((const float*)F.a->in[2])
#define FP_c_sample ((const float*)F.a->in[3])
#define FP_cache_k ((const float*)F.a->in[4])
#define FP_cache_v ((const float*)F.a->in[5])
#define FP_page_table ((const int*)F.a->in[6])
#define FP_state_C ((const float*)F.a->in[7])
#define FP_state_n ((const float*)F.a->in[8])
#define FP_state_m ((const float*)F.a->in[9])
#define FP_state_conv ((const float*)F.a->in[10])
#define FP_w_ada ((const float*)F.a->in[11])
#define FP_b_ada ((const float*)F.a->in[12])
#define FP_g_pre_mix ((const float*)F.a->in[13])
#define FP_g_post_mix ((const float*)F.a->in[14])
#define FP_w_in ((const float*)F.a->in[15])
#define FP_b_if ((const float*)F.a->in[16])
#define FP_g_mlstm ((const float*)F.a->in[17])
#define FP_lq1 ((const float*)F.a->in[18])
#define FP_lk1 ((const float*)F.a->in[19])
#define FP_lq2 ((const float*)F.a->in[20])
#define FP_lk2 ((const float*)F.a->in[21])
#define FP_g_diff ((const float*)F.a->in[22])
#define FP_w_proj_m ((const float*)F.a->in[23])
#define FP_w_proj_d ((const float*)F.a->in[24])
#define FP_w_out ((const float*)F.a->in[25])
#define FP_g_pre_ffn ((const float*)F.a->in[26])
#define FP_g_post_ffn ((const float*)F.a->in[27])
#define FP_w_up ((const float*)F.a->in[28])
#define FP_conv_w ((const float*)F.a->in[29])
#define FP_conv_b ((const float*)F.a->in[30])
#define FP_w_down ((const float*)F.a->in[31])
#define FP_WinT ((bf16_t*)(F.a->ws + WS_WIN))
#define FP_WupT ((bf16_t*)(F.a->ws + WS_WUP))
#define FP_WdownT ((bf16_t*)(F.a->ws + WS_WDOWN))
#define FP_WoutT ((bf16_t*)(F.a->ws + WS_WOUT))
#define FP_WpmT ((bf16_t*)(F.a->ws + WS_WPM))
#define FP_WpdT ((bf16_t*)(F.a->ws + WS_WPD))
#define FP_H1 ((bf16_t*)(F.a->ws + WS_H1))
#define FP_Z ((bf16_t*)(F.a->ws + WS_Z))
#define FP_CPREV ((bf16_t*)(F.a->ws + WS_CPREV))
#define FP_HM ((bf16_t*)(F.a->ws + WS_HM))
#define FP_HD ((bf16_t*)(F.a->ws + WS_HD))
#define FP_MG ((bf16_t*)(F.a->ws + WS_MG))
#define FP_UA ((bf16_t*)(F.a->ws + WS_UA))
#define FP_UB ((bf16_t*)(F.a->ws + WS_UB))
#define FP_GB ((bf16_t*)(F.a->ws + WS_G))
#define FP_ADA ((float*)(F.a->ws + WS_ADA))
#define FP_IG ((float*)(F.a->ws + WS_IG))
#define FP_LF ((float*)(F.a->ws + WS_LF))
#define FP_ST ((float*)(F.a->ws + WS_ST))
#define FP_NU ((float*)(F.a->ws + WS_NU))
#define FP_NPREV ((float*)(F.a->ws + WS_NPREV))
#define FP_MPREV ((float*)(F.a->ws + WS_MPREV))
#define FP_U ((float*)(F.a->ws + WS_U))
#define FP_O1 ((float*)(F.a->ws + WS_O1))
#define FP_O2 ((float*)(F.a->ws + WS_O2))
#define FP_Y ((float*)(F.a->ws + WS_Y))
#define FP_out (F.a->out)


__device__ __forceinline__ void transpose_item(const float* W, int pitch, int scol0, int K, bf16_t* WT, int drow0, LAS float* scr, int kb, int nb, int lane) {
    const int k0 = 64 * kb, n0 = 32 * nb;
#pragma unroll 8
    for (int i = 0; i < 32; ++i) { const int kk = 2 * i + (lane >> 5); scr[kk * 33 + (lane & 31)] = W[(size_t)(k0 + kk) * pitch + scol0 + n0 + (lane & 31)]; }
    asm volatile("s_waitcnt lgkmcnt(0)" ::: "memory");
    const int c = lane & 7;
#pragma unroll
    for (int j = 0; j < 4; ++j) { const int n = (lane >> 3) + 8 * j; const LAS float* s = scr + (8 * c) * 33 + n;
        u32x4 o; o.x = pk2(s[0 * 33], s[1 * 33]); o.y = pk2(s[2 * 33], s[3 * 33]); o.z = pk2(s[4 * 33], s[5 * 33]); o.w = pk2(s[6 * 33], s[7 * 33]);
        *(u32x4*)(WT + (size_t)(drow0 + n0 + n) * K + k0 + 8 * c) = o; }
    asm volatile("s_waitcnt lgkmcnt(0)" ::: "memory");
}
__device__ __forceinline__ void p0_transposes(const Frame& F) {
    LAS float* scr = (LAS float*)(F.lds + 40960 + F.wave * 8448);
    const int gw = F.vcu * NWAVES + F.wave, NGW = F.G * NWAVES;
    constexpr int I0 = 16 * 64, I1 = 16 * 112, I2 = 8 * 32, I3 = 8 * 32, I4 = 16 * 32, I5 = 16 * 176, I6 = 44 * 32;
    constexpr int NITEMS = I0 + I1 + I2 + I3 + I4 + I5 + I6;
    for (int it = gw; it < NITEMS; it += NGW) {
        int r = it;
        if (r < I0) { transpose_item(FP_w_in, DIN, 0, 1024, FP_WinT, 0, scr, r / 64, r % 64, F.lane); continue; } r -= I0;
        if (r < I1) { transpose_item(FP_w_in, DIN, 2056, 1024, FP_WinT, 2048, scr, r / 112, r % 112, F.lane); continue; } r -= I1;
        if (r < I2) { transpose_item(FP_w_proj_m, 1024, 0, 512, FP_WpmT, 0, scr, r / 32, r % 32, F.lane); continue; } r -= I2;
        if (r < I3) { transpose_item(FP_w_proj_d, 1024, 0, 512, FP_WpdT, 0, scr, r / 32, r % 32, F.lane); continue; } r -= I3;
        if (r < I4) { transpose_item(FP_w_out, 1024, 0, 1024, FP_WoutT, 0, scr, r / 32, r % 32, F.lane); continue; } r -= I4;
        if (r < I5) { transpose_item(FP_w_up, 2 * DFF, 0, 1024, FP_WupT, 0, scr, r / 176, r % 176, F.lane); continue; } r -= I5;
        transpose_item(FP_w_down, 1024, 0, DFF, FP_WdownT, 0, scr, r / 32, r % 32, F.lane);
    }
}
__device__ __forceinline__ void p0_ada(const Frame& F) {
    const int lane = F.lane, r = lane & 31, h = lane >> 5, w = F.wave;
    LAS float* part = (LAS float*)F.lds;
    for (int task = F.vcu; task < 192; task += F.G) {
        const int n0 = 32 * task;
        bf16x8 bw[8];
#pragma unroll
        for (int ks = 0; ks < 8; ++ks) { const float* p = FP_w_ada + (size_t)(128 * w + 16 * ks + 8 * h) * 6144 + n0 + r;
            f32x4 a, b; a.x = p[0]; a.y = p[6144]; a.z = p[2 * 6144]; a.w = p[3 * 6144]; b.x = p[4 * 6144]; b.y = p[5 * 6144]; b.z = p[6 * 6144]; b.w = p[7 * 6144]; bw[ks] = pack8(a, b); }
        for (int rt = 0; rt < 5; ++rt) {
            const int R = 32 * rt + r;
            const float* cr = R < 2 ? FP_c_prompt + (size_t)R * 1024 : FP_c_sample + (size_t)(R < 130 ? R - 2 : 0) * 1024;
            f32x16 acc; for (int i = 0; i < 16; ++i) acc[i] = 0.f;
#pragma unroll
            for (int ks = 0; ks < 8; ++ks) { f32x4 a = *(const f32x4*)(cr + 128 * w + 16 * ks + 8 * h), b = *(const f32x4*)(cr + 128 * w + 16 * ks + 8 * h + 4);
                if (R >= 130) { a = (f32x4){0.f, 0.f, 0.f, 0.f}; b = a; }
                acc = MFMA32(pack8(a, b), bw[ks], acc); }
#pragma unroll
            for (int i = 0; i < 16; ++i) part[(w * 32 + crow(i, h)) * 32 + r] = acc[i];
            WG_BAR();
#pragma unroll
            for (int k = 0; k < 2; ++k) { const int idx = F.tid + 512 * k, row = idx >> 5, col = idx & 31; float s = 0.f;
#pragma unroll
                for (int ww = 0; ww < 8; ++ww) s += part[(ww * 32 + row) * 32 + col];
                const int Rr = 32 * rt + row; if (Rr < 130) FP_ADA[(size_t)Rr * 6144 + n0 + col] = s + FP_b_ada[n0 + col]; }
            WG_BAR();
        }
    }
}
__device__ __forceinline__ int crow_of(int m) { return m < MP ? (m >> 13) : 2 + ((m - MP) >> 2); }
__device__ __forceinline__ const float* xrow_of(const Frame& F, int m) { return m < MP ? FP_x_prompt + (size_t)m * DM : FP_x_sample + (size_t)(m - MP) * DM; }
__device__ __forceinline__ void p1_norm_gates(const Frame& F) {
    LAS float* wg = (LAS float*)F.lds;
    for (int i = F.tid; i < 8192; i += NTHR) { const int k = i >> 3, g = i & 7; wg[g * 1024 + k] = FP_w_in[(size_t)k * DIN + 2048 + g]; }
    WG_BAR();
    const int lane = F.lane, gw = F.vcu * NWAVES + F.wave, NGW = F.G * NWAVES;
    f32x4 gp[4];
#pragma unroll
    for (int j = 0; j < 4; ++j) gp[j] = *(const f32x4*)(FP_g_pre_mix + 4 * lane + 256 * j);
    for (int m = gw; m < MT; m += NGW) {
        const float* xr = xrow_of(F, m); const float* ada = FP_ADA + (size_t)crow_of(m) * 6144;
        f32x4 v[4]; float ss = 0.f;
#pragma unroll
        for (int j = 0; j < 4; ++j) { v[j] = *(const f32x4*)(xr + 4 * lane + 256 * j); ss += (v[j].x * v[j].x + v[j].y * v[j].y) + (v[j].z * v[j].z + v[j].w * v[j].w); }
        const float rs = rsqrtf(wave_sum(ss) * (1.f / DM) + EPS);
        float gd[8];
#pragma unroll
        for (int g = 0; g < 8; ++g) gd[g] = 0.f;
#pragma unroll
        for (int j = 0; j < 4; ++j) { const f32x4 sh = *(const f32x4*)(ada + 4 * lane + 256 * j), sc = *(const f32x4*)(ada + 1024 + 4 * lane + 256 * j);
            f32x4 hv = (v[j] * rs * gp[j]) * (sc + 1.f) + sh; v[j] = hv;
#pragma unroll
            for (int g = 0; g < 8; ++g) { const f32x4 wv = *(const LAS f32x4*)(wg + g * 1024 + 4 * lane + 256 * j); gd[g] += (hv.x * wv.x + hv.y * wv.y) + (hv.z * wv.z + hv.w * wv.w); }
            u32x2 o; o.x = pk2(hv.x, hv.y); o.y = pk2(hv.z, hv.w); *(u32x2*)(FP_H1 + (size_t)m * DM + 4 * lane + 256 * j) = o; }
#pragma unroll
        for (int g = 0; g < 8; ++g) gd[g] = wave_sum(gd[g]);
        if (lane == 0) { const f32x4 bi = *(const f32x4*)FP_b_if, bf = *(const f32x4*)(FP_b_if + 4);
            *(f32x4*)(FP_IG + (size_t)m * 4) = (f32x4){gd[0] + bi.x, gd[1] + bi.y, gd[2] + bi.z, gd[3] + bi.w};
            *(f32x4*)(FP_LF + (size_t)m * 4) = (f32x4){log_sigmoid(gd[4] + bf.x), log_sigmoid(gd[5] + bf.y), log_sigmoid(gd[6] + bf.z), log_sigmoid(gd[7] + bf.w)}; }
    }
}
struct EpiZ {
    bf16_t* Z; float* out;
    __device__ __forceinline__ void st8(int row, int col, f32x4 v0, f32x4 v1) const {
        const int pn = col >> 8; const float sc = (pn == 2 || pn == 3) ? KSCALE : ((pn == 8 || pn == 9) ? QSCALE : 1.f);
        if (pn >= 10 && pn < 14) { const int kv = pn >= 12; const int c = col - (kv ? ZDV : ZDK);
            float* o = row < MP ? out + (kv ? OFF_VP : OFF_KP) + (size_t)row * 512 + c : out + (kv ? OFF_VS : OFF_KS) + (size_t)(row - MP) * 512 + c;
            *(f32x4*)o = v0; *(f32x4*)(o + 4) = v1; }
        *(bf16x8*)(Z + (size_t)row * ZP + col) = pack8(v0 * sc, v1 * sc);
    }
};
struct EpiPM {
    const bf16_t* Z; bf16_t* MG;
    __device__ __forceinline__ void st4(int row, int col, f32x4 v) const {
        const u32x2 g = *(const u32x2*)(Z + (size_t)row * ZP + ZGM + col);
        u32x2 o; o.x = pk2(sigmoidf_(bflo(g.x)) * v.x, sigmoidf_(bfhi(g.x)) * v.y); o.y = pk2(sigmoidf_(bflo(g.y)) * v.z, sigmoidf_(bfhi(g.y)) * v.w);
        *(u32x2*)(MG + (size_t)row * DM + col) = o; }
    __device__ __forceinline__ void st8(int row, int col, f32x4 v0, f32x4 v1) const { st4(row, col, v0); st4(row, col + 4, v1); }
};
struct EpiPD {
    const bf16_t* Z; bf16_t* MG;
    __device__ __forceinline__ void st4(int row, int col, f32x4 v) const {
        const u32x2 g = *(const u32x2*)(Z + (size_t)row * ZP + ZGD + col); const u32x2 p = *(const u32x2*)(MG + (size_t)row * DM + col);
        u32x2 o; o.x = pk2(bflo(p.x) + sigmoidf_(bflo(g.x)) * v.x, bfhi(p.x) + sigmoidf_(bfhi(g.x)) * v.y); o.y = pk2(bflo(p.y) + sigmoidf_(bflo(g.y)) * v.z, bfhi(p.y) + sigmoidf_(bfhi(g.y)) * v.w);
        *(u32x2*)(MG + (size_t)row * DM + col) = o; }
    __device__ __forceinline__ void st8(int row, int col, f32x4 v0, f32x4 v1) const { st4(row, col, v0); st4(row, col + 4, v1); }
};
struct EpiF32 {
    float* Y;
    __device__ __forceinline__ void st4(int row, int col, f32x4 v) const { *(f32x4*)(Y + (size_t)row * DM + col) = v; }
    __device__ __forceinline__ void st8(int row, int col, f32x4 v0, f32x4 v1) const { st4(row, col, v0); st4(row, col + 4, v1); }
};
struct EpiUp {
    bf16_t* UA; bf16_t* UB; float* out;
    __device__ __forceinline__ void st8(int row, int col, f32x4 v0, f32x4 v1) const {
        if (col < DFF) {
            *(bf16x8*)(UA + (size_t)row * DFF + col) = pack8(v0, v1);
            if (row < MP) { const int t = row & (TP - 1); if (t >= TP - 2) { float* o = out + OFF_CVP + ((size_t)(row >> 13) * 2 + (t - (TP - 2))) * DFF + col; *(f32x4*)o = v0; *(f32x4*)(o + 4) = v1; } }
            else { const int t = (row - MP) & 3; if (t >= 2) { float* o = out + OFF_CVS + ((size_t)((row - MP) >> 2) * 2 + (t - 2)) * DFF + col; *(f32x4*)o = v0; *(f32x4*)(o + 4) = v1; } }
        } else *(bf16x8*)(UB + (size_t)row * DFF + (col - DFF)) = pack8(v0, v1);
    }
};
template <class Epi>
__device__ __forceinline__ void skinny_gemm(const Frame& F, const bf16_t* A, const bf16_t* Bt, int K, const Epi& E) {
    const int lane = F.lane, r = lane & 31, h = lane >> 5, ct = F.wave & 1, kq = F.wave >> 1, Kq = K >> 2;
    LAS float* part = (LAS float*)F.lds;
    for (int task = F.vcu; task < 256; task += F.G) {
        const int rt = task >> 4, cg = task & 15;
        const bf16_t* ap = A + (size_t)(32 * rt + r) * K + kq * Kq + 8 * h;
        const bf16_t* bp = Bt + (size_t)(64 * cg + 32 * ct + r) * K + kq * Kq + 8 * h;
        f32x16 acc; for (int i = 0; i < 16; ++i) acc[i] = 0.f;
#pragma unroll 4
        for (int s = 0; s < Kq / 16; ++s) { const bf16x8 a = *(const bf16x8*)(ap + 16 * s), b = *(const bf16x8*)(bp + 16 * s); acc = MFMA32(b, a, acc); }
#pragma unroll
        for (int g4 = 0; g4 < 4; ++g4) *(LAS f32x4*)(part + (kq * 32 + r) * 68 + 32 * ct + 8 * g4 + 4 * h) = (f32x4){acc[4 * g4], acc[4 * g4 + 1], acc[4 * g4 + 2], acc[4 * g4 + 3]};
        WG_BAR();
        { const int row = F.tid >> 4, c4 = (F.tid & 15) * 4;
          f32x4 s = *(const LAS f32x4*)(part + row * 68 + c4) + *(const LAS f32x4*)(part + (32 + row) * 68 + c4) + *(const LAS f32x4*)(part + (64 + row) * 68 + c4) + *(const LAS f32x4*)(part + (96 + row) * 68 + c4);
          E.st4(MP + 32 * rt + row, 64 * cg + c4, s); }
        WG_BAR();
    }
}

constexpr int VROW = 320;
__device__ __forceinline__ void mlstm_A_unit(const Frame& F, int u) {
    const int bh = u >> 7, c = u & 127, b = bh >> 2, h = bh & 3, m0 = b * TP + c * 64;
    const int tid = F.tid, lane = F.lane, wid = F.wave;
    LAS unsigned char* Vt = F.lds; LAS unsigned char* Kt = F.lds + 20480; LAS float* wl = (LAS float*)(F.lds + 40960);
    if (wid == 0) {
        const float lf = FP_LF[(size_t)(m0 + lane) * 4 + h], ig = FP_IG[(size_t)(m0 + lane) * 4 + h];
        const float Fc = wave_scan_sum(lf, lane), a = ig - Fc, Ac = wave_scan_max(a, lane);
        const float Mloc = __shfl(Ac, 63), Fsum = __shfl(Fc, 63);
        wl[lane] = __expf(a - Mloc);
        if (lane == 0) { FP_ST[2 * u] = Fsum; FP_ST[2 * u + 1] = Mloc; }
    }
    WG_BAR();
#pragma unroll
    for (int i = 0; i < 2; ++i) { const int idx = tid + 512 * i, row = idx >> 4, ch = idx & 15;
        const bf16_t* src = FP_Z + (size_t)(m0 + row) * ZP + h * 128 + ch * 8;
        const u32x4 vv = *(const u32x4*)(src + ZV); const u32x4 kk = *(const u32x4*)(src + ZK);
        f32x4 k0, k1; unpack8(kk, k0, k1); const float w = wl[row];
        *(LAS u32x4*)(Vt + row * VROW + ch * 16) = vv;
        *(LAS bf16x8*)(Kt + row * VROW + ch * 16) = pack8(k0 * w, k1 * w); }
    WG_BAR();
    if (tid < 128) { float s = 0.f;
#pragma unroll 8
        for (int row = 0; row < 64; ++row) s += bf2f(*(const LAS bf16_t*)(Kt + row * VROW + tid * 2));
        FP_NU[(size_t)u * 128 + tid] = s; }
    {
        const int r32 = lane & 31, hi = lane >> 5, vh = (lane >> 4) & 1, q4 = (lane & 15) >> 2, p = lane & 3;
        const int vt = wid >> 1, dt0 = 2 * (wid & 1);
        const int lbase = (8 * hi + q4) * VROW + (16 * vh + 4 * p) * 2;
        f32x16 acc0, acc1; for (int i = 0; i < 16; ++i) { acc0[i] = 0.f; acc1[i] = 0.f; }
#pragma unroll
        for (int st = 0; st < 4; ++st) {
            const LAS unsigned char* va = Vt + lbase + st * 16 * VROW + vt * 64;
            const bf16x8 af = cat4(tr_rd(va), tr_rd(va + 4 * VROW));
            const LAS unsigned char* ka = Kt + lbase + st * 16 * VROW + dt0 * 64;
            const bf16x8 b0 = cat4(tr_rd(ka), tr_rd(ka + 4 * VROW)), b1 = cat4(tr_rd(ka + 64), tr_rd(ka + 64 + 4 * VROW));
            acc0 = MFMA32(af, b0, acc0); acc1 = MFMA32(af, b1, acc1);
        }
        float* Uo = FP_U + (size_t)u * 16384;
#pragma unroll
        for (int i = 0; i < 16; ++i) { const int v = 32 * vt + crow(i, hi); Uo[v * 128 + 32 * dt0 + r32] = acc0[i]; Uo[v * 128 + 32 * dt0 + 32 + r32] = acc1[i]; }
    }
    WG_BAR();
}
__device__ __forceinline__ void smlstm_unit(const Frame& F, int u) {
    const int n = u >> 2, h = u & 3, tid = F.tid, lane = F.lane, wid = F.wave;
    const int mrow = MP + 4 * n;
    LAS float* qs = (LAS float*)F.lds; LAS float* ks = qs + 512; LAS float* vs = ks + 512; LAS float* numI = vs + 512; LAS float* Sm = numI + 512; LAS float* nq = Sm + 16; LAS float* red = nq + 4;
    { const int t = tid >> 7, d = tid & 127; const bf16_t* z = FP_Z + (size_t)(mrow + t) * ZP + h * 128 + d;
      qs[tid] = bf2f(z[ZQ]); ks[tid] = bf2f(z[ZK]); vs[tid] = bf2f(z[ZV]); }
    LAS float* gl = red + 8;
    const float m0 = FP_state_m[n * 4 + h];
    if (tid < 4) { float cum = 0.f, am = -INFINITY, at = 0.f;
      for (int t = 0; t <= tid; ++t) { cum += FP_LF[(size_t)(mrow + t) * 4 + h]; at = FP_IG[(size_t)(mrow + t) * 4 + h] - cum; am = fmaxf(am, at); }
      const float mxv = fmaxf(m0, am);
      gl[tid] = cum; gl[4 + tid] = at; gl[8 + tid] = mxv; gl[12 + tid] = __expf(m0 - mxv); gl[16 + tid] = cum + mxv; }
    WG_BAR();
    const float m_end = gl[19], Fend = gl[3], decay = __expf(Fend + m0 - m_end);
    const float wend0 = __expf(Fend + gl[4] - m_end), wend1 = __expf(Fend + gl[5] - m_end), wend2 = __expf(Fend + gl[6] - m_end), wend3 = __expf(Fend + gl[7] - m_end);
#pragma unroll
    for (int k = 0; k < 2; ++k) { const int pid = 2 * wid + k, t = pid >> 2, s = pid & 3;
        float d = qs[t * 128 + lane] * ks[s * 128 + lane] + qs[t * 128 + 64 + lane] * ks[s * 128 + 64 + lane]; d = wave_sum(d);
        if (lane == 0) Sm[pid] = (s <= t) ? d * __expf(gl[4 + s] - gl[8 + t]) : 0.f; }
    if (wid < 4) { const float* n0 = FP_state_n + (size_t)u * 128; float d = n0[lane] * qs[wid * 128 + lane] + n0[64 + lane] * qs[wid * 128 + 64 + lane]; d = wave_sum(d); if (lane == 0) nq[wid] = d; }
    { const int vrow = tid >> 2, dq = tid & 3;
      const float* c0 = FP_state_C + ((size_t)u * 128 + vrow) * 128 + 32 * dq; float* co = FP_out + OFF_CS + ((size_t)u * 128 + vrow) * 128 + 32 * dq;
      f32x4 cv[8];
#pragma unroll
      for (int i = 0; i < 8; ++i) cv[i] = *(const f32x4*)(c0 + 4 * i);
      float ps[4]; float coef[4];
      ps[0] = 0.f; ps[1] = 0.f; ps[2] = 0.f; ps[3] = 0.f;
      coef[0] = wend0 * vs[vrow]; coef[1] = wend1 * vs[128 + vrow]; coef[2] = wend2 * vs[256 + vrow]; coef[3] = wend3 * vs[384 + vrow];
#pragma unroll
      for (int i = 0; i < 8; ++i) { f32x4 cn = cv[i] * decay;
#pragma unroll
          for (int t = 0; t < 4; ++t) { const f32x4 qv = *(const LAS f32x4*)(qs + t * 128 + 32 * dq + 4 * i), kv = *(const LAS f32x4*)(ks + t * 128 + 32 * dq + 4 * i);
              ps[t] += (cv[i].x * qv.x + cv[i].y * qv.y) + (cv[i].z * qv.z + cv[i].w * qv.w); cn += kv * coef[t]; }
          *(f32x4*)(co + 4 * i) = cn; }
#pragma unroll
      for (int t = 0; t < 4; ++t) { ps[t] += __shfl_xor(ps[t], 1); ps[t] += __shfl_xor(ps[t], 2); if (dq == 0) numI[t * 128 + vrow] = ps[t]; } }
    WG_BAR();
    { const int t = tid >> 7, v = tid & 127;
      const float it = gl[12 + t], mtt = gl[16 + t];
      float num = it * numI[tid], den = it * nq[t];
#pragma unroll
      for (int s = 0; s < 4; ++s) { const float sv = Sm[t * 4 + s]; num += sv * vs[s * 128 + v]; den += sv; }
      const float hval = num / fmaxf(fabsf(den), __expf(-mtt));
      const float ssw = wave_sum(hval * hval); if (lane == 0) red[wid] = ssw;
      WG_BAR();
      const float rms = rsqrtf((red[2 * t] + red[2 * t + 1]) * (1.f / 128.f) + EPS);
      const float mo = bf2f(FP_Z[(size_t)(mrow + t) * ZP + ZO + h * 128 + v]);
      FP_HM[(size_t)(mrow + t) * 512 + h * 128 + v] = f2bf(hval * rms * FP_g_mlstm[h * 128 + v] * sigmoidf_(mo));
      if (tid < 128) { const float n0v = FP_state_n[(size_t)u * 128 + tid]; float nn = decay * n0v;
          nn += wend0 * ks[tid] + wend1 * ks[128 + tid] + wend2 * ks[256 + tid] + wend3 * ks[384 + tid];
          FP_out[OFF_NS + (size_t)u * 128 + tid] = nn; }
      if (tid == 0) FP_out[OFF_MS + u] = m_end; }
    WG_BAR();
}
__device__ __forceinline__ void mlstm_scan_item(const Frame& F, int item) {
    const int bh = item >> 5, j = item & 31, e = 512 * j + F.tid; const bool nthr = (j == 0 && F.tid < 128);
    float C = 0.f, m = 0.f, nacc = 0.f;
    const float* Ub = FP_U + (size_t)bh * 128 * 16384 + e; bf16_t* Cp = FP_CPREV + (size_t)bh * 128 * 16384 + e;
    for (int c0 = 0; c0 < 128; c0 += 8) {
        float uu[8], un[8];
#pragma unroll
        for (int i = 0; i < 8; ++i) { uu[i] = Ub[(size_t)(c0 + i) * 16384]; un[i] = nthr ? FP_NU[(size_t)(bh * 128 + c0 + i) * 128 + F.tid] : 0.f; }
#pragma unroll
        for (int i = 0; i < 8; ++i) { const int c = c0 + i; const float fs = FP_ST[2 * (bh * 128 + c)], ml = FP_ST[2 * (bh * 128 + c) + 1];
            Cp[(size_t)c * 16384] = f2bf(C);
            if (nthr) FP_NPREV[(size_t)(bh * 128 + c) * 128 + F.tid] = nacc;
            if (j == 0 && F.tid == 0) FP_MPREV[bh * 128 + c] = m;
            const float mn = fs + fmaxf(m, ml), dec = __expf(fs + m - mn), sc = __expf(fs + ml - mn);
            C = dec * C + sc * uu[i]; nacc = dec * nacc + sc * un[i]; m = mn; }
    }
    FP_out[OFF_CP + (size_t)bh * 16384 + e] = C;
    if (nthr) FP_out[OFF_NP + bh * 128 + F.tid] = nacc;
    if (j == 0 && F.tid == 0) FP_out[OFF_MP + bh] = m;
}
__device__ __forceinline__ void mlstm_C_unit(const Frame& F, int u) {
    const int bh = u >> 7, c = u & 127, b = bh >> 2, h = bh & 3, m0 = b * TP + c * 64;
    const int tid = F.tid, lane = F.lane, wid = F.wave, r32 = lane & 31, hi = lane >> 5;
    LAS unsigned char* Vt = F.lds; LAS float* Fa = (LAS float*)(F.lds + 20480); LAS float* aa = Fa + 64; LAS float* Aa = aa + 64; LAS float* dqp = Aa + 64;   LAS float* ssq = dqp + 512;
    if (wid == 0) {
        const float lf = FP_LF[(size_t)(m0 + lane) * 4 + h], ig = FP_IG[(size_t)(m0 + lane) * 4 + h];
        const float Fc = wave_scan_sum(lf, lane), a = ig - Fc, Ac = wave_scan_max(a, lane);
        Fa[lane] = Fc; aa[lane] = a; Aa[lane] = Ac;
    }
#pragma unroll
    for (int i = 0; i < 2; ++i) { const int idx = tid + 512 * i, row = idx >> 4, ch = idx & 15;
        *(LAS u32x4*)(Vt + row * VROW + ch * 16) = *(const u32x4*)(FP_Z + (size_t)(m0 + row) * ZP + ZV + h * 128 + ch * 8); }
    { const int t = tid & 63, part = tid >> 6; const bf16_t* qp = FP_Z + (size_t)(m0 + t) * ZP + ZQ + h * 128 + 16 * part; const float* np = FP_NPREV + (size_t)u * 128 + 16 * part;
      f32x4 q0, q1, q2, q3; unpack8(*(const u32x4*)qp, q0, q1); unpack8(*(const u32x4*)(qp + 8), q2, q3);
      const f32x4 n0 = *(const f32x4*)np, n1 = *(const f32x4*)(np + 4), n2 = *(const f32x4*)(np + 8), n3 = *(const f32x4*)(np + 12);
      const f32x4 s = q0 * n0 + q1 * n1 + q2 * n2 + q3 * n3; dqp[part * 64 + t] = (s.x + s.y) + (s.z + s.w); }
    WG_BAR();
    const int vt = wid & 3, tt = wid >> 2, t = 32 * tt + r32;
    const float mprev = FP_MPREV[u];
    const float Ft = Fa[t], At = Aa[t], mxt = fmaxf(mprev, At), mt = Ft + mxt, inter = __expf(mprev - mxt);
    bf16x8 qf[8];
    { const bf16_t* qp = FP_Z + (size_t)(m0 + t) * ZP + ZQ + h * 128 + 8 * hi;
#pragma unroll
      for (int st = 0; st < 8; ++st) qf[st] = *(const bf16x8*)(qp + 16 * st); }
    f32x16 acc; for (int i = 0; i < 16; ++i) acc[i] = 0.f;
    { const bf16_t* cp = FP_CPREV + (size_t)u * 16384 + (size_t)(32 * vt + r32) * 128 + 8 * hi;
#pragma unroll
      for (int st = 0; st < 8; ++st) acc = MFMA32(*(const bf16x8*)(cp + 16 * st), qf[st], acc); }
#pragma unroll
    for (int i = 0; i < 16; ++i) acc[i] *= inter;
    float den = 0.f;
    const int vh = (lane >> 4) & 1, q4 = (lane & 15) >> 2, p = lane & 3;
    const int lbase = (4 * hi + q4) * VROW + (32 * vt + 16 * vh + 4 * p) * 2;
    for (int sub = 0; sub <= tt; ++sub) {
        f32x16 sacc; for (int i = 0; i < 16; ++i) sacc[i] = 0.f;
        { const bf16_t* kp = FP_Z + (size_t)(m0 + 32 * sub + r32) * ZP + ZK + h * 128 + 8 * hi;
#pragma unroll
          for (int st = 0; st < 8; ++st) sacc = MFMA32(*(const bf16x8*)(kp + 16 * st), qf[st], sacc); }
#pragma unroll
        for (int g = 0; g < 4; ++g) { const f32x4 av = *(const LAS f32x4*)(aa + 32 * sub + 8 * g + 4 * hi);
#pragma unroll
            for (int k = 0; k < 4; ++k) { const int s = 32 * sub + 8 * g + 4 * hi + k; const float wgt = (s <= t) ? __expf(av[k] - mxt) : 0.f; const float val = (s <= t) ? sacc[4 * g + k] * wgt : 0.f; sacc[4 * g + k] = val; den += val; } }
#pragma unroll
        for (int s2 = 0; s2 < 2; ++s2) {
            const bf16x8 pb = pack8((f32x4){sacc[8 * s2], sacc[8 * s2 + 1], sacc[8 * s2 + 2], sacc[8 * s2 + 3]}, (f32x4){sacc[8 * s2 + 4], sacc[8 * s2 + 5], sacc[8 * s2 + 6], sacc[8 * s2 + 7]});
            const LAS unsigned char* va = Vt + lbase + (32 * sub + 16 * s2) * VROW;
            acc = MFMA32(cat4(tr_rd(va), tr_rd(va + 8 * VROW)), pb, acc);
        }
    }
    den += __shfl_xor(den, 32);
    float dq = 0.f;
#pragma unroll
    for (int k = 0; k < 8; ++k) dq += dqp[k * 64 + t];
    den += inter * dq;
    const float rden = 1.f / fmaxf(fabsf(den), __expf(-mt));
    float ss = 0.f;
#pragma unroll
    for (int i = 0; i < 16; ++i) { acc[i] *= rden; ss += acc[i] * acc[i]; }
    ss += __shfl_xor(ss, 32);
    if (hi == 0) ssq[vt * 64 + t] = ss;
    WG_BAR();
    const float rms = rsqrtf((ssq[t] + ssq[64 + t] + ssq[128 + t] + ssq[192 + t]) * (1.f / 128.f) + EPS);
#pragma unroll
    for (int g = 0; g < 4; ++g) { const int v = 32 * vt + 8 * g + 4 * hi;
        const f32x4 gv = *(const f32x4*)(FP_g_mlstm + h * 128 + v); const u32x2 mo = *(const u32x2*)(FP_Z + (size_t)(m0 + t) * ZP + ZO + h * 128 + v);
        u32x2 o; o.x = pk2(acc[4 * g] * rms * gv.x * sigmoidf_(bflo(mo.x)), acc[4 * g + 1] * rms * gv.y * sigmoidf_(bfhi(mo.x)));
        o.y = pk2(acc[4 * g + 2] * rms * gv.z * sigmoidf_(bflo(mo.y)), acc[4 * g + 3] * rms * gv.w * sigmoidf_(bfhi(mo.y)));
        *(u32x2*)(FP_HM + (size_t)(m0 + t) * 512 + h * 128 + v) = o; }
    WG_BAR();
}
constexpr int AT_KB = 8320, AT_TILE = 8320 + 20480;
__device__ __forceinline__ void attn_half_unit(const Frame& F, int bh, int qb, int map, float* Odst) {
    const int b = bh >> 2, h = bh & 3, tid = F.tid, lane = F.lane, wid = F.wave, r32 = lane & 31, hi = lane >> 5;
    const int rowbase = b * TP, q0 = qb * 256, qrow = q0 + 32 * wid + r32;
    const bf16_t* Zb = FP_Z + (size_t)rowbase * ZP;
    bf16x8 qf[4];
    { const bf16_t* qp = Zb + (size_t)qrow * ZP + ZDQ + h * 128 + map * 64 + 8 * hi;
#pragma unroll
      for (int st = 0; st < 4; ++st) qf[st] = *(const bf16x8*)(qp + 16 * st); }
    const int NT = 4 * qb + 4;
    const int krow = tid >> 3, kch = tid & 7;
    const bf16_t* ksrc = Zb + (size_t)krow * ZP + ZDK + h * 128 + map * 64 + kch * 8;
    const int kdst = kch * 1040 + krow * 16;
    const int vrow0 = tid >> 4, vch = tid & 15;
    const bf16_t* vsrc = Zb + (size_t)vrow0 * ZP + ZDV + h * 128 + vch * 8;
    const int vdst = AT_KB + vrow0 * VROW + vch * 16;
    u32x4 sk, sv0, sv1;
    sk = *(const u32x4*)ksrc; sv0 = *(const u32x4*)vsrc; sv1 = *(const u32x4*)(vsrc + (size_t)32 * ZP);
    *(LAS u32x4*)(F.lds + kdst) = sk; *(LAS u32x4*)(F.lds + vdst) = sv0; *(LAS u32x4*)(F.lds + vdst + 32 * VROW) = sv1;
    WG_BAR();
    f32x16 o[4];
#pragma unroll
    for (int vt = 0; vt < 4; ++vt) for (int i = 0; i < 16; ++i) o[vt][i] = 0.f;
    float mrun = -1e30f, lrun = 0.f;
    const int vh = (lane >> 4) & 1, q4 = (lane & 15) >> 2, p = lane & 3;
    const int vlane = AT_KB + (4 * hi + q4) * VROW + (16 * vh + 4 * p) * 2;
    const int klane = hi * 1040 + r32 * 16;
    const int wlast = q0 + 32 * wid + 31, wfirst = q0 + 32 * wid;
    for (int j = 0; j < NT; ++j) {
        const int cur = (j & 1) * AT_TILE;
        const bool more = (j + 1 < NT);
        if (more) { const size_t adv = (size_t)(j + 1) * 64 * ZP; sk = *(const u32x4*)(ksrc + adv); sv0 = *(const u32x4*)(vsrc + adv); sv1 = *(const u32x4*)(vsrc + adv + (size_t)32 * ZP); }
        if (64 * j <= wlast) {
            f32x16 p0, p1; for (int i = 0; i < 16; ++i) { p0[i] = 0.f; p1[i] = 0.f; }
            const LAS unsigned char* kb = F.lds + cur + klane;
#pragma unroll
            for (int st = 0; st < 4; ++st) { const bf16x8 k0 = *(const LAS bf16x8*)(kb + st * 2080), k1 = *(const LAS bf16x8*)(kb + st * 2080 + 512);
                p0 = MFMA32(k0, qf[st], p0); p1 = MFMA32(k1, qf[st], p1); }
            if (64 * j + 63 > wfirst) {
#pragma unroll
                for (int i = 0; i < 16; ++i) { const int key = 64 * j + crow(i, hi); if (key > qrow) p0[i] = -INFINITY; if (key + 32 > qrow) p1[i] = -INFINITY; }
            }
            float mx = fmaxf(p0[0], p1[0]);
#pragma unroll
            for (int i = 1; i < 16; ++i) mx = fmaxf(mx, fmaxf(p0[i], p1[i]));
            mx = fmaxf(mx, __shfl_xor(mx, 32));
            const float mnew = fmaxf(mrun, mx);
            if (__any(mnew > mrun)) { const float alpha = __builtin_amdgcn_exp2f(mrun - mnew); lrun *= alpha;
#pragma unroll
                for (int vt = 0; vt < 4; ++vt) for (int i = 0; i < 16; ++i) o[vt][i] *= alpha;
                mrun = mnew; }
            float rsum = 0.f;
#pragma unroll
            for (int i = 0; i < 16; ++i) { p0[i] = __builtin_amdgcn_exp2f(p0[i] - mrun); p1[i] = __builtin_amdgcn_exp2f(p1[i] - mrun); rsum += p0[i] + p1[i]; }
            lrun += rsum;
            const LAS unsigned char* vb = F.lds + cur + vlane;
#pragma unroll
            for (int sub = 0; sub < 2; ++sub) {
#pragma unroll
                for (int s2 = 0; s2 < 2; ++s2) {
                    bf16x8 pb;
                    if (sub == 0) pb = pack8((f32x4){p0[8 * s2], p0[8 * s2 + 1], p0[8 * s2 + 2], p0[8 * s2 + 3]}, (f32x4){p0[8 * s2 + 4], p0[8 * s2 + 5], p0[8 * s2 + 6], p0[8 * s2 + 7]});
                    else          pb = pack8((f32x4){p1[8 * s2], p1[8 * s2 + 1], p1[8 * s2 + 2], p1[8 * s2 + 3]}, (f32x4){p1[8 * s2 + 4], p1[8 * s2 + 5], p1[8 * s2 + 6], p1[8 * s2 + 7]});
                    const LAS unsigned char* va = vb + (32 * sub + 16 * s2) * VROW;
#pragma unroll
                    for (int vt = 0; vt < 4; ++vt) o[vt] = MFMA32(cat4(tr_rd(va + vt * 64), tr_rd(va + vt * 64 + 8 * VROW)), pb, o[vt]);
                }
            }
        }
        if (more) { const int nx = ((j + 1) & 1) * AT_TILE; *(LAS u32x4*)(F.lds + nx + kdst) = sk; *(LAS u32x4*)(F.lds + nx + vdst) = sv0; *(LAS u32x4*)(F.lds + nx + vdst + 32 * VROW) = sv1; }
        WG_BAR();
    }
    lrun += __shfl_xor(lrun, 32);
    const float rl = 1.f / lrun;
    float* op = Odst + (size_t)(rowbase + qrow) * 512 + h * 128 + 4 * hi;
#pragma unroll
    for (int vt = 0; vt < 4; ++vt)
#pragma unroll
        for (int g = 0; g < 4; ++g) *(f32x4*)(op + 32 * vt + 8 * g) = (f32x4){o[vt][4 * g] * rl, o[vt][4 * g + 1] * rl, o[vt][4 * g + 2] * rl, o[vt][4 * g + 3] * rl};
}
__device__ __forceinline__ float lambda_full(const Frame& F, int lane) {
    const float a = wave_sum(FP_lq1[lane] * FP_lk1[lane]), b = wave_sum(FP_lq2[lane] * FP_lk2[lane]);
    return __expf(a) - __expf(b) + LAM_INIT;
}
__device__ __forceinline__ void attn_combine_rows(const Frame& F) {
    const int lane = F.lane, gw = F.vcu * NWAVES + F.wave, NGW = F.G * NWAVES;
    const float lam = lambda_full(F, lane);
    const f32x4 g0 = *(const f32x4*)(FP_g_diff + 8 * lane), g1 = *(const f32x4*)(FP_g_diff + 8 * lane + 4);
    for (int m = gw; m < MP; m += NGW) {
        const float* a = FP_O1 + (size_t)m * 512 + 8 * lane; const float* bb = FP_O2 + (size_t)m * 512 + 8 * lane;
        const f32x4 x0 = *(const f32x4*)a - *(const f32x4*)bb * lam, x1 = *(const f32x4*)(a + 4) - *(const f32x4*)(bb + 4) * lam;
        float ss = (x0.x * x0.x + x0.y * x0.y) + (x0.z * x0.z + x0.w * x0.w) + (x1.x * x1.x + x1.y * x1.y) + (x1.z * x1.z + x1.w * x1.w);
        ss += __shfl_xor(ss, 1); ss += __shfl_xor(ss, 2); ss += __shfl_xor(ss, 4); ss += __shfl_xor(ss, 8);
        const float rms = rsqrtf(ss * (1.f / 128.f) + EPS) * (1.f - LAM_INIT);
        *(bf16x8*)(FP_HD + (size_t)m * 512 + 8 * lane) = pack8(x0 * rms * g0, x1 * rms * g1);
    }
}
constexpr int SB_P = 2064;
__device__ __forceinline__ void decode_unit(const Frame& F, int u, float lam) {
    const int n = u >> 2, h = u & 3, tid = F.tid, lane = F.lane, wid = F.wave;
    const int mrow = MP + 4 * n;
    LAS float* Sbuf = (LAS float*)F.lds;
    LAS float* part = Sbuf + 8 * SB_P;
    LAS float* rlv = part + 8192;
    LAS float* red = rlv + 8;
    const int* pt = FP_page_table + n * NPAGES;
    const int c16 = lane & 15, g = lane >> 4;
    bf16x8 bq[4];
#pragma unroll
    for (int st = 0; st < 4; ++st) { const bool ok = (c16 < 4 && st < 2) || (c16 >= 4 && c16 < 8 && st >= 2);
        const bf16x8 v = *(const bf16x8*)(FP_Z + (size_t)(mrow + (c16 & 3)) * ZP + ZDQ + h * 128 + 32 * st + 8 * g);
        const bf16x8 zz = {0, 0, 0, 0, 0, 0, 0, 0}; bq[st] = ok ? v : zz; }
    {
        const int pg0 = pt[2 * wid], pg1 = pt[2 * wid + 1];
        f32x4 kr[8];
        { const float* kp = FP_cache_k + (((size_t)pg0 * PAGE + c16) * 4 + h) * 128 + 8 * g;
#pragma unroll
          for (int st = 0; st < 4; ++st) { kr[2 * st] = *(const f32x4*)(kp + 32 * st); kr[2 * st + 1] = *(const f32x4*)(kp + 32 * st + 4); } }
        for (int i = 0; i < 16; ++i) {
            bf16x8 af[4];
#pragma unroll
            for (int st = 0; st < 4; ++st) af[st] = pack8(kr[2 * st], kr[2 * st + 1]);
            if (i + 1 < 16) { const int i1 = i + 1; const int pg = (i1 < 8) ? pg0 : pg1; const int tok = 16 * (i1 & 7) + c16;
                const float* kp = FP_cache_k + (((size_t)pg * PAGE + tok) * 4 + h) * 128 + 8 * g;
#pragma unroll
                for (int st = 0; st < 4; ++st) { kr[2 * st] = *(const f32x4*)(kp + 32 * st); kr[2 * st + 1] = *(const f32x4*)(kp + 32 * st + 4); } }
            f32x4 acc = {0.f, 0.f, 0.f, 0.f};
#pragma unroll
            for (int st = 0; st < 4; ++st) acc = MFMA16(af[st], bq[st], acc);
            if (c16 < 8) *(LAS f32x4*)(Sbuf + c16 * SB_P + 256 * wid + 16 * i + 4 * g) = acc;
        }
        if (wid == 0) {
            f32x4 acc = {0.f, 0.f, 0.f, 0.f};
#pragma unroll
            for (int st = 0; st < 4; ++st) { const bf16x8 v = *(const bf16x8*)(FP_Z + (size_t)(mrow + (c16 & 3)) * ZP + ZDK + h * 128 + 32 * st + 8 * g);
                const bf16x8 zz = {0, 0, 0, 0, 0, 0, 0, 0}; const bf16x8 av = (c16 < 4) ? v : zz; acc = MFMA16(av, bq[st], acc); }
            if (g == 0 && c16 < 8) { const int t = c16 & 3; f32x4 m;
                m.x = acc.x; m.y = (1 <= t) ? acc.y : -INFINITY; m.z = (2 <= t) ? acc.z : -INFINITY; m.w = (3 <= t) ? acc.w : -INFINITY;
                *(LAS f32x4*)(Sbuf + c16 * SB_P + PAST) = m; }
        }
    }
    WG_BAR();
    {
        LAS float* col = Sbuf + wid * SB_P; float mx = -INFINITY;
        for (int k = lane; k < PAST + 4; k += 64) mx = fmaxf(mx, col[k]);
        mx = wave_max(mx); float sm = 0.f;
        for (int k = lane; k < PAST + 4; k += 64) { const float pv = __builtin_amdgcn_exp2f(col[k] - mx); col[k] = pv; sm += pv; }
        sm = wave_sum(sm); if (lane == 0) rlv[wid] = 1.f / sm;
    }
    WG_BAR();
    {
        const int hh = lane >> 5, l5 = lane & 31; const int pg = pt[2 * wid + hh];
        const float* vp = FP_cache_v + (((size_t)pg * PAGE) * 4 + h) * 128 + 4 * l5;
        const LAS float* pbase = Sbuf + 256 * wid + 128 * hh;
        f32x4 acc[8];
#pragma unroll
        for (int c = 0; c < 8; ++c) acc[c] = (f32x4){0.f, 0.f, 0.f, 0.f};
        f32x4 vr[4];
#pragma unroll
        for (int kk = 0; kk < 4; ++kk) vr[kk] = *(const f32x4*)(vp + (size_t)kk * 512);
        for (int t4 = 0; t4 < 32; ++t4) {
            f32x4 vc[4];
#pragma unroll
            for (int kk = 0; kk < 4; ++kk) vc[kk] = vr[kk];
            if (t4 + 1 < 32) {
#pragma unroll
                for (int kk = 0; kk < 4; ++kk) vr[kk] = *(const f32x4*)(vp + (size_t)(4 * (t4 + 1) + kk) * 512); }
#pragma unroll
            for (int c = 0; c < 8; ++c) { const f32x4 pp = *(const LAS f32x4*)(pbase + c * SB_P + 4 * t4);
                acc[c] += vc[0] * pp.x + vc[1] * pp.y + vc[2] * pp.z + vc[3] * pp.w; }
        }
        if (wid == 0) {
#pragma unroll
            for (int s = 0; s < 4; ++s) { const u32x2 vv = *(const u32x2*)(FP_Z + (size_t)(mrow + s) * ZP + ZDV + h * 128 + 4 * l5);
                const f32x4 vf = {bflo(vv.x), bfhi(vv.x), bflo(vv.y), bfhi(vv.y)};
#pragma unroll
                for (int c = 0; c < 8; ++c) { const float pp = (hh == 0) ? Sbuf[c * SB_P + PAST + s] : 0.f; acc[c] += vf * pp; } }
        }
#pragma unroll
        for (int c = 0; c < 8; ++c) { acc[c].x += __shfl_xor(acc[c].x, 32); acc[c].y += __shfl_xor(acc[c].y, 32); acc[c].z += __shfl_xor(acc[c].z, 32); acc[c].w += __shfl_xor(acc[c].w, 32);
            if (hh == 0) *(LAS f32x4*)(part + (wid * 8 + c) * 128 + 4 * l5) = acc[c]; }
    }
    WG_BAR();
    { const int t = tid >> 7, v = tid & 127; float o1 = 0.f, o2 = 0.f;
#pragma unroll
      for (int w = 0; w < 8; ++w) { o1 += part[(w * 8 + t) * 128 + v]; o2 += part[(w * 8 + 4 + t) * 128 + v]; }
      const float ov = o1 * rlv[t] - lam * o2 * rlv[4 + t];
      const float ssw = wave_sum(ov * ov); if (lane == 0) red[wid] = ssw;
      WG_BAR();
      const float rms = rsqrtf((red[2 * t] + red[2 * t + 1]) * (1.f / 128.f) + EPS) * (1.f - LAM_INIT);
      FP_HD[(size_t)(mrow + t) * 512 + h * 128 + v] = f2bf(ov * rms * FP_g_diff[h * 128 + v]); }
    WG_BAR();
}
__device__ __forceinline__ void rows_post_mix(const Frame& F) {
    const int lane = F.lane, gw = F.vcu * NWAVES + F.wave, NGW = F.G * NWAVES;
    for (int m = gw; m < MT; m += NGW) {
        const float* xr = xrow_of(F, m); const float* ada = FP_ADA + (size_t)crow_of(m) * 6144; const float* yr = FP_Y + (size_t)m * DM;
        f32x4 y[4], x1[4]; float ss = 0.f;
#pragma unroll
        for (int j = 0; j < 4; ++j) { y[j] = *(const f32x4*)(yr + 4 * lane + 256 * j); ss += (y[j].x * y[j].x + y[j].y * y[j].y) + (y[j].z * y[j].z + y[j].w * y[j].w); }
        const float rs = rsqrtf(wave_sum(ss) * (1.f / DM) + EPS); float s1 = 0.f;
#pragma unroll
        for (int j = 0; j < 4; ++j) { const int c = 4 * lane + 256 * j; const f32x4 xv = *(const f32x4*)(xr + c), gp = *(const f32x4*)(FP_g_post_mix + c), g1 = *(const f32x4*)(ada + 2048 + c);
            x1[j] = xv + g1 * (y[j] * rs * gp); *(f32x4*)(FP_out + OFF_Y + (size_t)m * DM + c) = x1[j];
            s1 += (x1[j].x * x1[j].x + x1[j].y * x1[j].y) + (x1[j].z * x1[j].z + x1[j].w * x1[j].w); }
        const float r1 = rsqrtf(wave_sum(s1) * (1.f / DM) + EPS);
#pragma unroll
        for (int j = 0; j < 4; ++j) { const int c = 4 * lane + 256 * j; const f32x4 gf = *(const f32x4*)(FP_g_pre_ffn + c), sh = *(const f32x4*)(ada + 3072 + c), sc = *(const f32x4*)(ada + 4096 + c);
            const f32x4 hv = (x1[j] * r1 * gf) * (sc + 1.f) + sh; u32x2 o; o.x = pk2(hv.x, hv.y); o.y = pk2(hv.z, hv.w); *(u32x2*)(FP_H1 + (size_t)m * DM + c) = o; }
    }
}
__device__ __forceinline__ void rows_final(const Frame& F) {
    const int lane = F.lane, gw = F.vcu * NWAVES + F.wave, NGW = F.G * NWAVES;
    for (int m = gw; m < MT; m += NGW) {
        const float* ada = FP_ADA + (size_t)crow_of(m) * 6144; const float* yr = FP_Y + (size_t)m * DM; float* orow = FP_out + OFF_Y + (size_t)m * DM;
        f32x4 y[4]; float ss = 0.f;
#pragma unroll
        for (int j = 0; j < 4; ++j) { y[j] = *(const f32x4*)(yr + 4 * lane + 256 * j); ss += (y[j].x * y[j].x + y[j].y * y[j].y) + (y[j].z * y[j].z + y[j].w * y[j].w); }
        const float rs = rsqrtf(wave_sum(ss) * (1.f / DM) + EPS);
#pragma unroll
        for (int j = 0; j < 4; ++j) { const int c = 4 * lane + 256 * j; const f32x4 xv = *(const f32x4*)(orow + c), gp = *(const f32x4*)(FP_g_post_ffn + c), g2 = *(const f32x4*)(ada + 5120 + c);
            *(f32x4*)(orow + c) = xv + g2 * (y[j] * rs * gp); }
    }
}
__device__ __forceinline__ float gelu_tanh(float x) { const float u = 1.5957691216057308f * (x + 0.044715f * x * x * x); return x * __builtin_amdgcn_rcpf(1.f + __builtin_amdgcn_exp2f(-u * LOG2E)); }
__device__ __forceinline__ void geglu_phase(const Frame& F) {
    const size_t NIT = (size_t)MT * 352; const size_t stride = (size_t)F.G * NTHR;
    for (size_t it = (size_t)F.vcu * NTHR + F.tid; it < NIT; it += stride) {
        const int m = (int)(it / 352), ch = (int)(it % 352), f0 = 8 * ch;
        f32x4 a0, a1, p10, p11, p20, p21, b0, b1;
        unpack8(*(const u32x4*)(FP_UA + (size_t)m * DFF + f0), a0, a1); unpack8(*(const u32x4*)(FP_UB + (size_t)m * DFF + f0), b0, b1);
        const f32x4 z4 = {0.f, 0.f, 0.f, 0.f};
        if (m < MP) { const int t = m & (TP - 1);
            if (t >= 1) unpack8(*(const u32x4*)(FP_UA + (size_t)(m - 1) * DFF + f0), p10, p11); else { p10 = z4; p11 = z4; }
            if (t >= 2) unpack8(*(const u32x4*)(FP_UA + (size_t)(m - 2) * DFF + f0), p20, p21); else { p20 = z4; p21 = z4; }
        } else { const int t = (m - MP) & 3, n = (m - MP) >> 2; const float* st = FP_state_conv + (size_t)n * 2 * DFF + f0;
            if (t >= 1) unpack8(*(const u32x4*)(FP_UA + (size_t)(m - 1) * DFF + f0), p10, p11); else { p10 = *(const f32x4*)(st + DFF); p11 = *(const f32x4*)(st + DFF + 4); }
            if (t >= 2) unpack8(*(const u32x4*)(FP_UA + (size_t)(m - 2) * DFF + f0), p20, p21);
            else if (t == 1) { p20 = *(const f32x4*)(st + DFF); p21 = *(const f32x4*)(st + DFF + 4); } else { p20 = *(const f32x4*)st; p21 = *(const f32x4*)(st + 4); } }
        const f32x4 w00 = *(const f32x4*)(FP_conv_w + f0), w01 = *(const f32x4*)(FP_conv_w + f0 + 4), w10 = *(const f32x4*)(FP_conv_w + DFF + f0), w11 = *(const f32x4*)(FP_conv_w + DFF + f0 + 4),
                    w20 = *(const f32x4*)(FP_conv_w + 2 * DFF + f0), w21 = *(const f32x4*)(FP_conv_w + 2 * DFF + f0 + 4), cb0 = *(const f32x4*)(FP_conv_b + f0), cb1 = *(const f32x4*)(FP_conv_b + f0 + 4);
        f32x4 c0 = cb0 + w00 * p20 + w10 * p10 + w20 * a0, c1 = cb1 + w01 * p21 + w11 * p11 + w21 * a1;
        c0.x = gelu_tanh(c0.x) * b0.x; c0.y = gelu_tanh(c0.y) * b0.y; c0.z = gelu_tanh(c0.z) * b0.z; c0.w = gelu_tanh(c0.w) * b0.w;
        c1.x = gelu_tanh(c1.x) * b1.x; c1.y = gelu_tanh(c1.y) * b1.y; c1.z = gelu_tanh(c1.z) * b1.z; c1.w = gelu_tanh(c1.w) * b1.w;
        *(bf16x8*)(FP_GB + (size_t)m * DFF + f0) = pack8(c0, c1);
    }
}

constexpr int NPHASE = 15;
__global__ void __launch_bounds__(NTHR, 2) fwd_kernel(Args args) {
    extern __shared__ __attribute__((aligned(16))) unsigned char lds_raw[];
    Frame F;
    F.lds = (LAS unsigned char*)lds_raw;
    F.tid = threadIdx.x; F.lane = F.tid & 63; F.wave = __builtin_amdgcn_readfirstlane(F.tid >> 6);
    F.G = gridDim.x; { const int bx = blockIdx.x; F.vcu = (F.G % 8 == 0) ? (bx % 8) * (F.G / 8) + bx / 8 : bx; }
    F.a = &args; unsigned char* ws = args.ws;
    volatile LAS unsigned* MISC = (volatile LAS unsigned*)(F.lds + MISC_OFF);
    for (int u = F.tid; u < (LDS_BYTES - RING_BYTES) / 4; u += NTHR) ((LAS unsigned*)(F.lds + RING_BYTES))[u] = 0u;
    __syncthreads();
    const int lo = args.ph_lo, hi = args.ph_hi;
    const bool multi = (hi - lo) > 1;
    XcdBarrier bar; bar.bar = (unsigned*)(ws + WS_CTL) + CW_BAR; bar.x = 0; bar.st = nullptr;
    if (multi) bar = xcd_barrier_post((unsigned*)(ws + WS_CTL) + CW_BAR, MISC + 8);
#define IN(k) (lo <= (k) && (k) < hi)
#define SEAM(k) do { if (IN(k) && IN((k) + 1)) xcd_barrier(bar); } while (0)

    if (IN(0)) { p0_ada(F); p0_transposes(F); } SEAM(0);
    if (IN(1)) { p1_norm_gates(F); } SEAM(1);
    if (IN(2)) { pg8::Gemm g{FP_H1, FP_WinT, MT, ZP, DM}; pg8::StaticOrder S; S.init(MT, ZP, F.G, (int)blockIdx.x); EpiZ E{FP_Z, FP_out}; pg8::gemm_phase(F.lds, g, S, E); } SEAM(2);
    if (IN(3)) { for (int i = 0; i < 4; ++i) { const int u = F.vcu * 4 + i; if (u < 1024) mlstm_A_unit(F, u); }
                 if (F.G != 256) for (int u = 4 * F.G + F.vcu; u < 1024; u += F.G) mlstm_A_unit(F, u);
                 for (int u = F.vcu; u < 512; u += F.G) smlstm_unit(F, u); } SEAM(3);
    if (IN(4)) { for (int it = F.vcu; it < 256; it += F.G) mlstm_scan_item(F, it); } SEAM(4);
    if (IN(5)) { for (int i = F.vcu; i < 256; i += F.G) { const int bh = i >> 5, s = i & 31; attn_half_unit(F, bh, s, 0, FP_O1); attn_half_unit(F, bh, 31 - s, 1, FP_O2); }
                 const float lam = lambda_full(F, F.lane);
                 for (int u = F.vcu; u < 512; u += F.G) decode_unit(F, u, lam); } SEAM(5);
    if (IN(6)) { for (int i = 0; i < 4; ++i) { const int u = F.vcu * 4 + i; if (u < 1024) mlstm_C_unit(F, u); }
                 if (F.G != 256) for (int u = 4 * F.G + F.vcu; u < 1024; u += F.G) mlstm_C_unit(F, u);
                 attn_combine_rows(F); } SEAM(6);
    if (IN(7)) { pg8::Gemm g{FP_HM, FP_WpmT, MP, DM, 512}; pg8::StaticOrder S; S.init(MP, DM, F.G, (int)blockIdx.x); EpiPM E{FP_Z, FP_MG}; pg8::gemm_phase(F.lds, g, S, E);
                 skinny_gemm(F, FP_HM + (size_t)MP * 512, FP_WpmT, 512, E); } SEAM(7);
    if (IN(8)) { pg8::Gemm g{FP_HD, FP_WpdT, MP, DM, 512}; pg8::StaticOrder S; S.init(MP, DM, F.G, (int)blockIdx.x); EpiPD E{FP_Z, FP_MG}; pg8::gemm_phase(F.lds, g, S, E);
                 skinny_gemm(F, FP_HD + (size_t)MP * 512, FP_WpdT, 512, E); } SEAM(8);
    if (IN(9)) { pg8::Gemm g{FP_MG, FP_WoutT, MP, DM, DM}; pg8::StaticOrder S; S.init(MP, DM, F.G, (int)blockIdx.x); EpiF32 E{FP_Y}; pg8::gemm_phase(F.lds, g, S, E);
                 skinny_gemm(F, FP_MG + (size_t)MP * DM, FP_WoutT, DM, E); } SEAM(9);
    if (IN(10)) { rows_post_mix(F); } SEAM(10);
    if (IN(11)) { pg8::Gemm g{FP_H1, FP_WupT, MT, 2 * DFF, DM}; pg8::StaticOrder S; S.init(MT, 2 * DFF, F.G, (int)blockIdx.x); EpiUp E{FP_UA, FP_UB, FP_out}; pg8::gemm_phase(F.lds, g, S, E); } SEAM(11);
    if (IN(12)) { geglu_phase(F); } SEAM(12);
    if (IN(13)) { pg8::Gemm g{FP_GB, FP_WdownT, MP, DM, DFF}; pg8::StaticOrder S; S.init(MP, DM, F.G, (int)blockIdx.x); EpiF32 E{FP_Y}; pg8::gemm_phase(F.lds, g, S, E);
                  skinny_gemm(F, FP_GB + (size_t)MP * DFF, FP_WdownT, DFF, E); } SEAM(13);
    if (IN(14)) { rows_final(F); }
#undef IN
#undef SEAM
}

#ifndef MK_ONE_LAUNCH
#define MK_ONE_LAUNCH 0
#endif
extern "C" void kernel_launch(void* const* d_in, const int* in_sizes, int n_in, void* d_out, int out_size, void* d_ws, size_t ws_size, hipStream_t stream) {
    static int grid = 0;
    if (grid == 0) {
        if (n_in != 32 || out_size != (int)OUT_TOTAL || ws_size < WS_END) { fprintf(stderr, "kernel_launch: unexpected sizes n_in %d out %d ws %zu\n", n_in, out_size, ws_size); grid = -1; return; }
        int dev = 0, cus = 0, per_cu = 0;
        if (hipGetDevice(&dev) != hipSuccess || hipDeviceGetAttribute(&cus, hipDeviceAttributeMultiprocessorCount, dev) != hipSuccess) { grid = -1; return; }
        if (hipFuncSetAttribute((const void*)fwd_kernel, hipFuncAttributeMaxDynamicSharedMemorySize, LDS_BYTES) != hipSuccess) { fprintf(stderr, "kernel_launch: hipFuncSetAttribute failed\n"); grid = -1; return; }
        if (hipOccupancyMaxActiveBlocksPerMultiprocessor(&per_cu, (const void*)fwd_kernel, NTHR, LDS_BYTES) != hipSuccess || per_cu < 1) fprintf(stderr, "kernel_launch: occupancy query reports %d\n", per_cu);
        (void)hipGetLastError();
        grid = cus;
    }
    if (grid < 0) return;
    if (hipMemsetAsync((char*)d_ws + WS_CTL, 0, CTL_ZERO_BYTES, stream) != hipSuccess) return;
    Args a{};
    for (int i = 0; i < 32; ++i) a.in[i] = d_in[i];
    a.out = (float*)d_out; a.ws = (unsigned char*)d_ws;
#if MK_ONE_LAUNCH
    a.ph_lo = 0; a.ph_hi = NPHASE;
    hipLaunchKernelGGL(fwd_kernel, dim3(grid), dim3(NTHR), LDS_BYTES, stream, a);
#else
    for (int p = 0; p < NPHASE; ++p) { a.ph_lo = p; a.ph_hi = p + 1; hipLaunchKernelGGL(fwd_kernel, dim3(grid), dim3(NTHR), LDS_BYTES, stream, a); }
#endif
}
```

```cpp
#include <hip/hip_runtime.h>
#include <cstdio>
#include <cstdint>

#define LAS __attribute__((address_space(3)))
#define GAS __attribute__((address_space(1)))
typedef unsigned short bf16_t;
typedef short bf16x8 __attribute__((ext_vector_type(8)));
typedef short s16x4 __attribute__((ext_vector_type(4)));
typedef short v4i16_t __attribute__((ext_vector_type(4)));
typedef float f32x2 __attribute__((ext_vector_type(2)));
typedef float f32x4 __attribute__((ext_vector_type(4)));
typedef float f32x16 __attribute__((ext_vector_type(16)));
typedef unsigned u32x2 __attribute__((ext_vector_type(2)));
typedef unsigned u32x4 __attribute__((ext_vector_type(4)));
typedef __bf16 bf16x2_t __attribute__((ext_vector_type(2)));
typedef GAS unsigned gu32;

constexpr int DM = 1024, TP = 8192, MP = 16384, MS = 512, MT = MP + MS;
constexpr int NSEQ = 128, TS = 4, NPAGES = 16, PAGE = 128, PAST = 2048;
constexpr int DIN = 5640, ZP = 5632, DFF = 2816;
constexpr int ZQ = 0, ZK = 512, ZV = 1024, ZO = 1536, ZDQ = 2048, ZDK = 2560, ZDV = 3072, ZGM = 3584, ZGD = 4608;
constexpr float EPS = 1e-6f, LAM_INIT = 0.2f, LOG2E = 1.4426950408889634f;
constexpr float QSCALE = 0.125f * LOG2E;
constexpr float KSCALE = 0.08838834764831845f;
constexpr size_t OFF_Y = 0, OFF_KP = 17301504, OFF_VP = 25690112, OFF_CP = 34078720, OFF_NP = 34209792, OFF_MP = 34210816, OFF_CVP = 34210824,
                 OFF_KS = 34222088, OFF_VS = 34484232, OFF_CS = 34746376, OFF_NS = 43134984, OFF_MS = 43200520, OFF_CVS = 43201032, OUT_TOTAL = 43921928;
constexpr size_t MiB = 1u << 20;
constexpr size_t WS_CTL = 0, CTL_ZERO_BYTES = 1 * MiB;
constexpr size_t WS_WIN = 1 * MiB, WS_WUP = 12 * MiB, WS_WDOWN = 23 * MiB, WS_WOUT = 29 * MiB, WS_WPM = 31 * MiB, WS_WPD = 32 * MiB;
constexpr size_t WS_ADA = 33 * MiB, WS_IG = 37 * MiB, WS_LF = 37 * MiB + 512 * 1024, WS_ST = 38 * MiB, WS_NU = 38 * MiB + 65536, WS_NPREV = 39 * MiB, WS_MPREV = 39 * MiB + 768 * 1024;
constexpr size_t WS_H1 = 40 * MiB, WS_Z = 73 * MiB, WS_U = 255 * MiB, WS_CPREV = 319 * MiB, WS_HM = 351 * MiB, WS_HD = 368 * MiB, WS_O1 = 385 * MiB, WS_O2 = 417 * MiB;
constexpr size_t WS_MG = 449 * MiB, WS_Y = 482 * MiB, WS_UA = 548 * MiB, WS_UB = 639 * MiB, WS_G = 730 * MiB, WS_END = 821 * MiB;
constexpr int CW_BAR = 4096;
constexpr int RING_BYTES = 131072, MISC_OFF = RING_BYTES + 320, LDS_BYTES = 147456;
constexpr int NWAVES = 8, NTHR = 512;

__device__ __forceinline__ unsigned pk2(float lo, float hi) { f32x2 v = {lo, hi}; bf16x2_t b = __builtin_convertvector(v, bf16x2_t); return __builtin_bit_cast(unsigned, b); }
__device__ __forceinline__ bf16_t f2bf(float x) { return (bf16_t)(pk2(x, 0.f) & 0xffffu); }
__device__ __forceinline__ float bflo(unsigned u) { return __uint_as_float(u << 16); }
__device__ __forceinline__ float bfhi(unsigned u) { return __uint_as_float(u & 0xffff0000u); }
__device__ __forceinline__ float bf2f(bf16_t u) { return __uint_as_float(((unsigned)u) << 16); }
__device__ __forceinline__ bf16x8 pack8(f32x4 a, f32x4 b) { u32x4 w; w.x = pk2(a.x, a.y); w.y = pk2(a.z, a.w); w.z = pk2(b.x, b.y); w.w = pk2(b.z, b.w); return __builtin_bit_cast(bf16x8, w); }
__device__ __forceinline__ void unpack8(u32x4 w, f32x4& a, f32x4& b) { a.x = bflo(w.x); a.y = bfhi(w.x); a.z = bflo(w.y); a.w = bfhi(w.y); b.x = bflo(w.z); b.y = bfhi(w.z); b.z = bflo(w.w); b.w = bfhi(w.w); }
__device__ __forceinline__ float wave_sum(float v) {
#pragma unroll
    for (int o = 1; o < 64; o <<= 1) v += __shfl_xor(v, o);
    return v;
}
__device__ __forceinline__ float wave_max(float v) {
#pragma unroll
    for (int o = 1; o < 64; o <<= 1) v = fmaxf(v, __shfl_xor(v, o));
    return v;
}
__device__ __forceinline__ float wave_scan_sum(float v, int lane) {
#pragma unroll
    for (int o = 1; o < 64; o <<= 1) { const float t = __shfl_up(v, o); if (lane >= o) v += t; }
    return v;
}
__device__ __forceinline__ float wave_scan_max(float v, int lane) {
#pragma unroll
    for (int o = 1; o < 64; o <<= 1) { const float t = __shfl_up(v, o); if (lane >= o) v = fmaxf(v, t); }
    return v;
}
__device__ __forceinline__ float sigmoidf_(float x) { return __builtin_amdgcn_rcpf(1.f + __builtin_amdgcn_exp2f(-x * LOG2E)); }
__device__ __forceinline__ float log_sigmoid(float x) { return fminf(x, 0.f) - log1pf(__expf(-fabsf(x))); }
__device__ __forceinline__ int crow(int reg, int h) { return (reg & 3) + 8 * (reg >> 2) + 4 * h; }
#define MFMA32(a, b, c) __builtin_amdgcn_mfma_f32_32x32x16_bf16((a), (b), (c), 0, 0, 0)
#define MFMA16(a, b, c) __builtin_amdgcn_mfma_f32_16x16x32_bf16((a), (b), (c), 0, 0, 0)
__device__ __forceinline__ s16x4 tr_rd(const LAS unsigned char* p) { return __builtin_bit_cast(s16x4, __builtin_amdgcn_ds_read_tr16_b64_v4i16((LAS v4i16_t*)p)); }
__device__ __forceinline__ bf16x8 cat4(s16x4 lo, s16x4 hi) { return (bf16x8){lo[0], lo[1], lo[2], lo[3], hi[0], hi[1], hi[2], hi[3]}; }
#define WG_BAR() __syncthreads()

namespace pg8 {
constexpr int BM = 256, BK = 64, HALF = 128, HTB = HALF * BK * 2, STAGE_BYTES = 8 * HTB, NXCD = 8, WGM = 8;
__host__ __device__ __forceinline__ int lds_byte(int r, int c) { const int st = (r >> 4) * 2 + (c >> 5), rr = r & 15, cc = c & 31, ob = rr * 64 + cc * 2; return st * 1024 + (ob ^ (((ob >> 9) & 1) << 5)); }
__host__ __device__ __forceinline__ void stage_rc(int b, int& R, int& C) { const int st = b / 1024, sb = b % 1024, swz = sb ^ (((sb >> 9) & 1) << 5); R = (st >> 1) * 16 + swz / 64; C = (st & 1) * 32 + (swz % 64) / 2; }
__host__ __device__ __forceinline__ int perm32(int rho) { const int n = rho >> 4, i = rho & 15; return 8 * (i >> 2) + 4 * n + (i & 3); }
struct Unit { int pm, pn; };
struct Gemm { const bf16_t* A; const bf16_t* Bt; int M, N, K; };
struct StaticOrder {
    int nM, nN, nwg, G, c;
    __host__ __device__ void init(int M, int N, int G_, int c_) { nM = M / BM; nN = N / BM; nwg = nM * nN; G = G_; c = c_; }
    __host__ __device__ bool next(int i, Unit& u) const {
        const long L = (long)i * G + c; if (L >= nwg) return false;
        int wgid = (int)L; { const int q = nwg / NXCD, r = nwg % NXCD, xcd = wgid % NXCD, off = wgid / NXCD; wgid = (xcd < r ? xcd * (q + 1) : r * (q + 1) + (xcd - r) * q) + off; }
        const int nig = WGM * nN, gid = wgid / nig, fm = gid * WGM, gsz = (nM - fm) < WGM ? (nM - fm) : WGM;
        u.pm = fm + ((wgid % nig) % gsz); u.pn = (wgid % nig) / gsz; return true;
    }
};
template <class Epi>
__device__ __forceinline__ void gemm_phase(LAS unsigned char* lds, const Gemm g, const StaticOrder& S, const Epi& E) {
    const int tid = threadIdx.x, wid = __builtin_amdgcn_readfirstlane(tid >> 6), lane = tid & 63, wr = wid >> 2, wc = wid & 3, fr = lane & 15, fq = lane >> 4;
    const int K = g.K, nt = K / BK;
    unsigned voffA[2], voffB[2];
#pragma unroll
    for (int i = 0; i < 2; ++i) { int R, C; stage_rc(tid * 16 + i * 8192, R, C); const int Rb = (R & ~31) + perm32(R & 31);
        voffA[i] = (unsigned)(R * K + C) * 2u; voffB[i] = (unsigned)(Rb * K + C) * 2u; }
    const size_t kstep = (size_t)(BK * 2);
    const size_t hstep = (size_t)HALF * K * 2;
    const size_t tstep = 2 * hstep;
    const unsigned ldsw = (unsigned)wid * 1024u;
    const int aoff = lds_byte(wr * 64 + fr, fq * 8), boff = lds_byte(wc * 32 + fr, fq * 8);
#define PG8_SA(b, h) (((b) * 2 + (h)) * HTB)
#define PG8_SB(b, h) ((4 + (b) * 2 + (h)) * HTB)
#define PG8_STAGE(bufoff, gbase, voff) do { _Pragma("unroll") for (int _i = 0; _i < 2; ++_i) \
        __builtin_amdgcn_global_load_lds((const unsigned*)((const char*)(gbase) + (voff)[_i]), (LAS unsigned*)(lds + (bufoff) + ldsw + _i * 8192), 16, 0, 0); } while (0)
#define PG8_LDA(dst, b, h) do { _Pragma("unroll") for (int m = 0; m < 4; ++m) _Pragma("unroll") for (int k = 0; k < 2; ++k) dst[m][k] = *(const LAS bf16x8*)(lds + PG8_SA(b, h) + aoff + m * 2048 + k * 1024); } while (0)
#define PG8_LDB(dst, b, h) do { _Pragma("unroll") for (int n = 0; n < 2; ++n) _Pragma("unroll") for (int k = 0; k < 2; ++k) dst[n][k] = *(const LAS bf16x8*)(lds + PG8_SB(b, h) + boff + n * 2048 + k * 1024); } while (0)
#define PG8_MMA(ai, bj, At, Bt) do { __builtin_amdgcn_s_setprio(1); _Pragma("unroll") for (int m = 0; m < 4; ++m) _Pragma("unroll") for (int n = 0; n < 2; ++n) _Pragma("unroll") for (int k = 0; k < 2; ++k) \
        acc[ai][bj][m][n] = __builtin_amdgcn_mfma_f32_16x16x32_bf16(Bt[n][k], At[m][k], acc[ai][bj][m][n], 0, 0, 0); __builtin_amdgcn_s_setprio(0); } while (0)
#define PG8_WAIT_V(n) asm volatile("s_waitcnt vmcnt(" #n ")" ::: "memory")
#define PG8_WAIT_L(n) asm volatile("s_waitcnt lgkmcnt(" #n ")" ::: "memory")
#define PG8_BAR __builtin_amdgcn_s_barrier()
#define PG8_SCHED __builtin_amdgcn_sched_barrier(0)
    Unit cur, nxt; int ui = 0;
    if (!S.next(0, cur)) return;
    f32x4 acc[2][2][4][2];
#pragma unroll
    for (int a = 0; a < 2; ++a)
#pragma unroll
        for (int b = 0; b < 2; ++b)
#pragma unroll
            for (int m = 0; m < 4; ++m)
#pragma unroll
                for (int n = 0; n < 2; ++n) acc[a][b][m][n] = (f32x4){0.f, 0.f, 0.f, 0.f};
    bf16x8 At[4][2], B0[2][2], B1[2][2];
    const char* cA = (const char*)g.A + (size_t)cur.pm * tstep; const char* cB = (const char*)g.Bt + (size_t)cur.pn * tstep;
    PG8_STAGE(PG8_SB(0, 0), cB, voffB); PG8_STAGE(PG8_SB(0, 1), cB + hstep, voffB); PG8_STAGE(PG8_SA(0, 0), cA, voffA); PG8_STAGE(PG8_SA(0, 1), cA + hstep, voffA);
    if (wr == 1) PG8_BAR;
    PG8_WAIT_V(2); PG8_BAR;
    PG8_STAGE(PG8_SB(1, 0), cB + kstep, voffB); PG8_STAGE(PG8_SA(1, 0), cA + kstep, voffA); PG8_STAGE(PG8_SB(1, 1), cB + hstep + kstep, voffB);
    PG8_WAIT_V(6); PG8_BAR;
    for (;;) {
        const bool has_next = S.next(ui + 1, nxt);
        const char* nA = has_next ? (const char*)g.A + (size_t)nxt.pm * tstep : cA; const char* nB = has_next ? (const char*)g.Bt + (size_t)nxt.pn * tstep : cB;
        for (int t = 0; t < nt; t += 2) {
            const bool last = (t == nt - 2);
            const char* a1 = cA + (size_t)(t + 1) * kstep;
            const char* a2 = last ? nA : cA + (size_t)(t + 2) * kstep; const char* b2 = last ? nB : cB + (size_t)(t + 2) * kstep;
            const char* a3 = a2 + kstep; const char* b3 = b2 + kstep;
            PG8_LDB(B0, 0, 0); PG8_LDB(B1, 0, 1); PG8_SCHED; PG8_LDA(At, 0, 0); PG8_STAGE(PG8_SA(1, 1), a1 + hstep, voffA);
            PG8_WAIT_V(8); PG8_WAIT_L(0); PG8_BAR; PG8_MMA(0, 0, At, B0); PG8_MMA(0, 1, At, B1); PG8_BAR; PG8_SCHED;
            PG8_LDA(At, 0, 1); PG8_STAGE(PG8_SB(0, 0), b2, voffB); PG8_STAGE(PG8_SB(0, 1), b2 + hstep, voffB); PG8_STAGE(PG8_SA(0, 0), a2, voffA);
            PG8_WAIT_V(8); PG8_WAIT_L(0); PG8_BAR; PG8_MMA(1, 0, At, B0); PG8_MMA(1, 1, At, B1); PG8_BAR; PG8_SCHED;
            PG8_LDB(B0, 1, 0); PG8_LDB(B1, 1, 1); PG8_SCHED; PG8_LDA(At, 1, 0); PG8_STAGE(PG8_SA(0, 1), a2 + hstep, voffA);
            PG8_WAIT_V(8); PG8_WAIT_L(0); PG8_BAR; PG8_MMA(0, 0, At, B0); PG8_MMA(0, 1, At, B1); PG8_BAR; PG8_SCHED;
            PG8_LDA(At, 1, 1); PG8_STAGE(PG8_SB(1, 0), b3, voffB); PG8_STAGE(PG8_SB(1, 1), b3 + hstep, voffB); PG8_STAGE(PG8_SA(1, 0), a3, voffA);
            PG8_WAIT_V(8); PG8_WAIT_L(0); PG8_BAR; PG8_MMA(1, 0, At, B0); PG8_MMA(1, 1, At, B1); PG8_BAR; PG8_SCHED;
        }
        if (wr == 0) PG8_BAR;
        {
            const int row0 = cur.pm * BM + wr * 64 + fr, col0 = cur.pn * BM + wc * 32 + 8 * fq;
#pragma unroll
            for (int ai = 0; ai < 2; ++ai)
#pragma unroll
                for (int m = 0; m < 4; ++m)
#pragma unroll
                    for (int bj = 0; bj < 2; ++bj) E.st8(row0 + ai * HALF + m * 16, col0 + bj * HALF, acc[ai][bj][m][0], acc[ai][bj][m][1]);
        }
        if (!has_next) break;
#pragma unroll
        for (int a = 0; a < 2; ++a)
#pragma unroll
            for (int b = 0; b < 2; ++b)
#pragma unroll
                for (int m = 0; m < 4; ++m)
#pragma unroll
                    for (int n = 0; n < 2; ++n) acc[a][b][m][n] = (f32x4){0.f, 0.f, 0.f, 0.f};
        cur = nxt; cA = nA; cB = nB; ++ui;
        if (wr == 1) PG8_BAR;
    }
    PG8_WAIT_V(0);
    PG8_BAR;
#undef PG8_SA
#undef PG8_SB
#undef PG8_STAGE
#undef PG8_LDA
#undef PG8_LDB
#undef PG8_MMA
#undef PG8_WAIT_V
#undef PG8_WAIT_L
#undef PG8_BAR
#undef PG8_SCHED
}
}

#define XB_TMO      128
#define XB_XCNT(j)  (256  + 64 * (j))
#define XB_XSUB(j)  (1280 + 64 * (j))
#define XB_XGEN(j)  (2304 + 64 * (j))
#define XB_TOP      3328
#define XB_TOPGEN   3392
#define XCD_BAR_WORDS 3456
#define XB_SPIN_CAP (1u << 18)
__device__ __forceinline__ unsigned xb_ld(unsigned* p)              { return __hip_atomic_load(p, __ATOMIC_RELAXED, __HIP_MEMORY_SCOPE_AGENT); }
__device__ __forceinline__ unsigned xb_add(unsigned* p, unsigned v) { return __hip_atomic_fetch_add(p, v, __ATOMIC_RELAXED, __HIP_MEMORY_SCOPE_AGENT); }
__device__ __forceinline__ unsigned xb_xcc_id() { return (unsigned)__builtin_amdgcn_s_getreg((3 << 11) | 20) & 0xFu; }
#define XB_SPIN(cond, bar) do { unsigned _sp = 0; while (cond) { __builtin_amdgcn_s_sleep(1); \
    if ((++_sp & 255u) == 0u) { if (xb_ld(&(bar)[XB_TMO])) break; if (_sp > XB_SPIN_CAP) { atomicAdd(&(bar)[XB_TMO], 1u); break; } } } } while (0)
struct XcdBarrier { unsigned* bar; unsigned x; volatile LAS unsigned* st; };
__device__ __forceinline__ XcdBarrier xcd_barrier_post(unsigned* bar, volatile LAS unsigned* st) {
    XcdBarrier b; b.bar = bar; b.x = xb_xcc_id(); b.st = st;
    if (threadIdx.x == 0) (void)xb_add(&bar[XB_XCNT(b.x)], 1u);
    return b;
}
__device__ __forceinline__ void xcd_barrier_complete(unsigned* bar, unsigned x, unsigned& nloc, unsigned& nx) {
    const unsigned G = gridDim.x * gridDim.y * gridDim.z;
    unsigned sum, cnt, mine, sp = 0u;
    for (;;) {
        sum = 0u; cnt = 0u; mine = 0u;
#pragma unroll
        for (unsigned j = 0; j < 16; ++j) { const unsigned c = xb_ld(&bar[XB_XCNT(j)]); sum += c; cnt += (c > 0u) ? 1u : 0u; mine = (j == x) ? c : mine; }
        if (sum == G) break;
        __builtin_amdgcn_s_sleep(1);
        if ((++sp & 255u) == 0u) { if (xb_ld(&bar[XB_TMO])) break; if (sp > XB_SPIN_CAP) { atomicAdd(&bar[XB_TMO], 1u); break; } }
    }
    nloc = mine > 0u ? mine : 1u; nx = cnt > 0u ? cnt : 1u;
}
__device__ __forceinline__ void xcd_barrier(const XcdBarrier& b) {
    asm volatile("s_waitcnt vmcnt(0)" ::: "memory");
    __syncthreads();
    if (threadIdx.x == 0) {
        unsigned* bar = b.bar;
        __builtin_amdgcn_s_waitcnt(0);
        unsigned nloc = b.st[0], nx = b.st[1];
        if (nloc == 0u) { xcd_barrier_complete(bar, b.x, nloc, nx); b.st[0] = nloc; b.st[1] = nx; }
        const unsigned old = xb_add(&bar[XB_XSUB(b.x)], 1u);
        const unsigned gen = old / nloc;
        if (old + 1u == (gen + 1u) * nloc) {
            __builtin_amdgcn_fence(__ATOMIC_RELEASE, "agent");
            asm volatile("s_waitcnt vmcnt(0)" ::: "memory");
            const unsigned og = xb_add(&bar[XB_TOP], 1u);
            const unsigned tg = og / nx;
            if (og + 1u == (tg + 1u) * nx) xb_add(&bar[XB_TOPGEN], 1u);
            else XB_SPIN(xb_ld(&bar[XB_TOPGEN]) == tg, bar);
            __builtin_amdgcn_fence(__ATOMIC_ACQUIRE, "agent");
            xb_add(&bar[XB_XGEN(b.x)], 1u);
            asm volatile("s_waitcnt vmcnt(0)" ::: "memory");
        } else {
            XB_SPIN(xb_ld(&bar[XB_XGEN(b.x)]) == gen, bar);
            __builtin_amdgcn_fence(__ATOMIC_ACQUIRE, "agent");
            asm volatile("s_waitcnt vmcnt(0)" ::: "memory");
        }
    }
    __syncthreads();
}

struct Args { const void* in[32]; float* out; unsigned char* ws; int ph_lo, ph_hi; };
struct Frame { LAS unsigned char* lds; int tid, lane, wave, vcu, G; const Args* a; };
#define FP_x_prompt ((const float*)F.a->in[0])
#define FP_x_sample ((const float*)F.a->in[1])
#define FP_c_prompt ((const float*)F.a->in[2])
#define FP_c_sample ((const float*)F.a->in[3])
#define FP_cache_k ((const float*)F.a->in[4])
#define FP_cache_v ((const float*)F.a->in[5])
#define FP_page_table ((const int*)F.a->in[6])
#define FP_state_C ((const float*)F.a->in[7])
#define FP_state_n ((const float*)F.a->in[8])
#define FP_state_m ((const float*)F.a->in[9])
#define FP_state_conv ((const float*)F.a->in[10])
#define FP_w_ada ((const float*)F.a->in[11])
#define FP_b_ada ((const float*)F.a->in[12])
#define FP_g_pre_mix ((const float*)F.a->in[13])
#define FP_g_post_mix ((const float*)F.a->in[14])
#define FP_w_in ((const float*)F.a->in[15])
#define FP_b_if ((const float*)F.a->in[16])
#define FP_g_mlstm ((const float*)F.a->in[17])
#define FP_lq1 ((const float*)F.a->in[18])
#define FP_lk1 ((const float*)F.a->in[19])
#define FP_lq2 ((const float*)F.a->in[20])
#define FP_lk2 ((const float*)F.a->in[21])
#define FP_g_diff ((const float*)F.a->in[22])
#define FP_w_proj_m ((const float*)F.a->in[23])
#define FP_w_proj_d ((const float*)F.a->in[24])
#define FP_w_out ((const float*)F.a->in[25])
#define FP_g_pre_ffn ((const float*)F.a->in[26])
#define FP_g_post_ffn ((const float*)F.a->in[27])
#define FP_w_up ((const float*)F.a->in[28])
#define FP_conv_w ((const float*)F.a->in[29])
#define FP_conv_b ((const float*)F.a->in[30])
#define FP_w_down ((const float*)F.a->in[31])
#define FP_WinT ((bf16_t*)(F.a->ws + WS_WIN))
#define FP_WupT ((bf16_t*)(F.a->ws + WS_WUP))
#define FP_WdownT ((bf16_t*)(F.a->ws + WS_WDOWN))
#define FP_WoutT ((bf16_t*)(F.a->ws + WS_WOUT))
#define FP_WpmT ((bf16_t*)(F.a->ws + WS_WPM))
#define FP_WpdT ((bf16_t*)(F.a->ws + WS_WPD))
#define FP_H1 ((bf16_t*)(F.a->ws + WS_H1))
#define FP_Z ((bf16_t*)(F.a->ws + WS_Z))
#define FP_CPREV ((bf16_t*)(F.a->ws + WS_CPREV))
#define FP_HM ((bf16_t*)(F.a->ws + WS_HM))
#define FP_HD ((bf16_t*)(F.a->ws + WS_HD))
#define FP_MG ((bf16_t*)(F.a->ws + WS_MG))
#define FP_UA ((bf16_t*)(F.a->ws + WS_UA))
#define FP_UB ((bf16_t*)(F.a->ws + WS_UB))
#define FP_GB ((bf16_t*)(F.a->ws + WS_G))
#define FP_ADA ((float*)(F.a->ws + WS_ADA))
#define FP_IG ((float*)(F.a->ws + WS_IG))
#define FP_LF ((float*)(F.a->ws + WS_LF))
#define FP_ST ((float*)(F.a->ws + WS_ST))
#define FP_NU ((float*)(F.a->ws + WS_NU))
#define FP_NPREV ((float*)(F.a->ws + WS_NPREV))
#define FP_MPREV ((float*)(F.a->ws + WS_MPREV))
#define FP_U ((float*)(F.a->ws + WS_U))
#define FP_O1 ((float*)(F.a->ws + WS_O1))
#define FP_O2 ((float*)(F.a->ws + WS_O2))
#define FP_Y ((float*)(F.a->ws + WS_Y))
#define FP_out (F.a->out)


__device__ __forceinline__ void transpose_item(const float* W, int pitch, int scol0, int K, bf16_t* WT, int drow0, LAS float* scr, int kb, int nb, int lane) {
    const int k0 = 64 * kb, n0 = 32 * nb;
#pragma unroll 8
    for (int i = 0; i < 32; ++i) { const int kk = 2 * i + (lane >> 5); scr[kk * 33 + (lane & 31)] = W[(size_t)(k0 + kk) * pitch + scol0 + n0 + (lane & 31)]; }
    asm volatile("s_waitcnt lgkmcnt(0)" ::: "memory");
    const int c = lane & 7;
#pragma unroll
    for (int j = 0; j < 4; ++j) { const int n = (lane >> 3) + 8 * j; const LAS float* s = scr + (8 * c) * 33 + n;
        u32x4 o; o.x = pk2(s[0 * 33], s[1 * 33]); o.y = pk2(s[2 * 33], s[3 * 33]); o.z = pk2(s[4 * 33], s[5 * 33]); o.w = pk2(s[6 * 33], s[7 * 33]);
        *(u32x4*)(WT + (size_t)(drow0 + n0 + n) * K + k0 + 8 * c) = o; }
    asm volatile("s_waitcnt lgkmcnt(0)" ::: "memory");
}
__device__ __forceinline__ void p0_transposes(const Frame& F) {
    LAS float* scr = (LAS float*)(F.lds + 40960 + F.wave * 8448);
    const int gw = F.vcu * NWAVES + F.wave, NGW = F.G * NWAVES;
    constexpr int I0 = 16 * 64, I1 = 16 * 112, I2 = 8 * 32, I3 = 8 * 32, I4 = 16 * 32, I5 = 16 * 176, I6 = 44 * 32;
    constexpr int NITEMS = I0 + I1 + I2 + I3 + I4 + I5 + I6;
    for (int it = gw; it < NITEMS; it += NGW) {
        int r = it;
        if (r < I0) { transpose_item(FP_w_in, DIN, 0, 1024, FP_WinT, 0, scr, r / 64, r % 64, F.lane); continue; } r -= I0;
        if (r < I1) { transpose_item(FP_w_in, DIN, 2056, 1024, FP_WinT, 2048, scr, r / 112, r % 112, F.lane); continue; } r -= I1;
        if (r < I2) { transpose_item(FP_w_proj_m, 1024, 0, 512, FP_WpmT, 0, scr, r / 32, r % 32, F.lane); continue; } r -= I2;
        if (r < I3) { transpose_item(FP_w_proj_d, 1024, 0, 512, FP_WpdT, 0, scr, r / 32, r % 32, F.lane); continue; } r -= I3;
        if (r < I4) { transpose_item(FP_w_out, 1024, 0, 1024, FP_WoutT, 0, scr, r / 32, r % 32, F.lane); continue; } r -= I4;
        if (r < I5) { transpose_item(FP_w_up, 2 * DFF, 0, 1024, FP_WupT, 0, scr, r / 176, r % 176, F.lane); continue; } r -= I5;
        transpose_item(FP_w_down, 1024, 0, DFF, FP_WdownT, 0, scr, r / 32, r % 32, F.lane);
    }
}
__device__ __forceinline__ void p0_ada(const Frame& F) {
    const int lane = F.lane, r = lane & 31, h = lane >> 5, w = F.wave;
    LAS float* part = (LAS float*)F.lds;
    for (int task = F.vcu; task < 192; task += F.G) {
        const int n0 = 32 * task;
        bf16x8 bw[8];
#pragma unroll
        for (int ks = 0; ks < 8; ++ks) { const float* p = FP_w_ada + (size_t)(128 * w + 16 * ks + 8 * h) * 6144 + n0 + r;
            f32x4 a, b; a.x = p[0]; a.y = p[6144]; a.z = p[2 * 6144]; a.w = p[3 * 6144]; b.x = p[4 * 6144]; b.y = p[5 * 6144]; b.z = p[6 * 6144]; b.w = p[7 * 6144]; bw[ks] = pack8(a, b); }
        for (int rt = 0; rt < 5; ++rt) {
            const int R = 32 * rt + r;
            const float* cr = R < 2 ? FP_c_prompt + (size_t)R * 1024 : FP_c_sample + (size_t)(R < 130 ? R - 2 : 0) * 1024;
            f32x16 acc; for (int i = 0; i < 16; ++i) acc[i] = 0.f;
#pragma unroll
            for (int ks = 0; ks < 8; ++ks) { f32x4 a = *(const f32x4*)(cr + 128 * w + 16 * ks + 8 * h), b = *(const f32x4*)(cr + 128 * w + 16 * ks + 8 * h + 4);
                if (R >= 130) { a = (f32x4){0.f, 0.f, 0.f, 0.f}; b = a; }
                acc = MFMA32(pack8(a, b), bw[ks], acc); }
#pragma unroll
            for (int i = 0; i < 16; ++i) part[(w * 32 + crow(i, h)) * 32 + r] = acc[i];
            WG_BAR();
#pragma unroll
            for (int k = 0; k < 2; ++k) { const int idx = F.tid + 512 * k, row = idx >> 5, col = idx & 31; float s = 0.f;
#pragma unroll
                for (int ww = 0; ww < 8; ++ww) s += part[(ww * 32 + row) * 32 + col];
                const int Rr = 32 * rt + row; if (Rr < 130) FP_ADA[(size_t)Rr * 6144 + n0 + col] = s + FP_b_ada[n0 + col]; }
            WG_BAR();
        }
    }
}
__device__ __forceinline__ int crow_of(int m) { return m < MP ? (m >> 13) : 2 + ((m - MP) >> 2); }
__device__ __forceinline__ const float* xrow_of(const Frame& F, int m) { return m < MP ? FP_x_prompt + (size_t)m * DM : FP_x_sample + (size_t)(m - MP) * DM; }
__device__ __forceinline__ void p1_norm_gates(const Frame& F) {
    LAS float* wg = (LAS float*)F.lds;
    for (int i = F.tid; i < 8192; i += NTHR) { const int k = i >> 3, g = i & 7; wg[g * 1024 + k] = FP_w_in[(size_t)k * DIN + 2048 + g]; }
    WG_BAR();
    const int lane = F.lane, gw = F.vcu * NWAVES + F.wave, NGW = F.G * NWAVES;
    f32x4 gp[4];
#pragma unroll
    for (int j = 0; j < 4; ++j) gp[j] = *(const f32x4*)(FP_g_pre_mix + 4 * lane + 256 * j);
    for (int m = gw; m < MT; m += NGW) {
        const float* xr = xrow_of(F, m); const float* ada = FP_ADA + (size_t)crow_of(m) * 6144;
        f32x4 v[4]; float ss = 0.f;
#pragma unroll
        for (int j = 0; j < 4; ++j) { v[j] = *(const f32x4*)(xr + 4 * lane + 256 * j); ss += (v[j].x * v[j].x + v[j].y * v[j].y) + (v[j].z * v[j].z + v[j].w * v[j].w); }
        const float rs = rsqrtf(wave_sum(ss) * (1.f / DM) + EPS);
        float gd[8];
#pragma unroll
        for (int g = 0; g < 8; ++g) gd[g] = 0.f;
#pragma unroll
        for (int j = 0; j < 4; ++j) { const f32x4 sh = *(const f32x4*)(ada + 4 * lane + 256 * j), sc = *(const f32x4*)(ada + 1024 + 4 * lane + 256 * j);
            f32x4 hv = (v[j] * rs * gp[j]) * (sc + 1.f) + sh; v[j] = hv;
#pragma unroll
            for (int g = 0; g < 8; ++g) { const f32x4 wv = *(const LAS f32x4*)(wg + g * 1024 + 4 * lane + 256 * j); gd[g] += (hv.x * wv.x + hv.y * wv.y) + (hv.z * wv.z + hv.w * wv.w); }
            u32x2 o; o.x = pk2(hv.x, hv.y); o.y = pk2(hv.z, hv.w); *(u32x2*)(FP_H1 + (size_t)m * DM + 4 * lane + 256 * j) = o; }
#pragma unroll
        for (int g = 0; g < 8; ++g) gd[g] = wave_sum(gd[g]);
        if (lane == 0) { const f32x4 bi = *(const f32x4*)FP_b_if, bf = *(const f32x4*)(FP_b_if + 4);
            *(f32x4*)(FP_IG + (size_t)m * 4) = (f32x4){gd[0] + bi.x, gd[1] + bi.y, gd[2] + bi.z, gd[3] + bi.w};
            *(f32x4*)(FP_LF + (size_t)m * 4) = (f32x4){log_sigmoid(gd[4] + bf.x), log_sigmoid(gd[5] + bf.y), log_sigmoid(gd[6] + bf.z), log_sigmoid(gd[7] + bf.w)}; }
    }
}
struct EpiZ {
    bf16_t* Z; float* out;
    __device__ __forceinline__ void st8(int row, int col, f32x4 v0, f32x4 v1) const {
        const int pn = col >> 8; const float sc = (pn == 2 || pn == 3) ? KSCALE : ((pn == 8 || pn == 9) ? QSCALE : 1.f);
        if (pn >= 10 && pn < 14) { const int kv = pn >= 12; const int c = col - (kv ? ZDV : ZDK);
            float* o = row < MP ? out + (kv ? OFF_VP : OFF_KP) + (size_t)row * 512 + c : out + (kv ? OFF_VS : OFF_KS) + (size_t)(row - MP) * 512 + c;
            *(f32x4*)o = v0; *(f32x4*)(o + 4) = v1; }
        *(bf16x8*)(Z + (size_t)row * ZP + col) = pack8(v0 * sc, v1 * sc);
    }
};
struct EpiPM {
    const bf16_t* Z; bf16_t* MG;
    __device__ __forceinline__ void st4(int row, int col, f32x4 v) const {
        const u32x2 g = *(const u32x2*)(Z + (size_t)row * ZP + ZGM + col);
        u32x2 o; o.x = pk2(sigmoidf_(bflo(g.x)) * v.x, sigmoidf_(bfhi(g.x)) * v.y); o.y = pk2(sigmoidf_(bflo(g.y)) * v.z, sigmoidf_(bfhi(g.y)) * v.w);
        *(u32x2*)(MG + (size_t)row * DM + col) = o; }
    __device__ __forceinline__ void st8(int row, int col, f32x4 v0, f32x4 v1) const { st4(row, col, v0); st4(row, col + 4, v1); }
};
struct EpiPD {
    const bf16_t* Z; bf16_t* MG;
    __device__ __forceinline__ void st4(int row, int col, f32x4 v) const {
        const u32x2 g = *(const u32x2*)(Z + (size_t)row * ZP + ZGD + col); const u32x2 p = *(const u32x2*)(MG + (size_t)row * DM + col);
        u32x2 o; o.x = pk2(bflo(p.x) + sigmoidf_(bflo(g.x)) * v.x, bfhi(p.x) + sigmoidf_(bfhi(g.x)) * v.y); o.y = pk2(bflo(p.y) + sigmoidf_(bflo(g.y)) * v.z, bfhi(p.y) + sigmoidf_(bfhi(g.y)) * v.w);
        *(u32x2*)(MG + (size_t)row * DM + col) = o; }
    __device__ __forceinline__ void st8(int row, int col, f32x4 v0, f32x4 v1) const { st4(row, col, v0); st4(row, col + 4, v1); }
};
struct EpiF32 {
    float* Y;
    __device__ __forceinline__ void st4(int row, int col, f32x4 v) const { *(f32x4*)(Y + (size_t)row * DM + col) = v; }
    __device__ __forceinline__ void st8(int row, int col, f32x4 v0, f32x4 v1) const { st4(row, col, v0); st4(row, col + 4, v1); }
};
struct EpiUp {
    bf16_t* UA; bf16_t* UB; float* out;
    __device__ __forceinline__ void st8(int row, int col, f32x4 v0, f32x4 v1) const {
        if (col < DFF) {
            *(bf16x8*)(UA + (size_t)row * DFF + col) = pack8(v0, v1);
            if (row < MP) { const int t = row & (TP - 1); if (t >= TP - 2) { float* o = out + OFF_CVP + ((size_t)(row >> 13) * 2 + (t - (TP - 2))) * DFF + col; *(f32x4*)o = v0; *(f32x4*)(o + 4) = v1; } }
            else { const int t = (row - MP) & 3; if (t >= 2) { float* o = out + OFF_CVS + ((size_t)((row - MP) >> 2) * 2 + (t - 2)) * DFF + col; *(f32x4*)o = v0; *(f32x4*)(o + 4) = v1; } }
        } else *(bf16x8*)(UB + (size_t)row * DFF + (col - DFF)) = pack8(v0, v1);
    }
};
template <class Epi>
__device__ __forceinline__ void skinny_gemm(const Frame& F, const bf16_t* A, const bf16_t* Bt, int K, const Epi& E) {
    const int lane = F.lane, r = lane & 31, h = lane >> 5, ct = F.wave & 1, kq = F.wave >> 1, Kq = K >> 2;
    LAS float* part = (LAS float*)F.lds;
    for (int task = F.vcu; task < 256; task += F.G) {
        const int rt = task >> 4, cg = task & 15;
        const bf16_t* ap = A + (size_t)(32 * rt + r) * K + kq * Kq + 8 * h;
        const bf16_t* bp = Bt + (size_t)(64 * cg + 32 * ct + r) * K + kq * Kq + 8 * h;
        f32x16 acc; for (int i = 0; i < 16; ++i) acc[i] = 0.f;
#pragma unroll 4
        for (int s = 0; s < Kq / 16; ++s) { const bf16x8 a = *(const bf16x8*)(ap + 16 * s), b = *(const bf16x8*)(bp + 16 * s); acc = MFMA32(b, a, acc); }
#pragma unroll
        for (int g4 = 0; g4 < 4; ++g4) *(LAS f32x4*)(part + (kq * 32 + r) * 68 + 32 * ct + 8 * g4 + 4 * h) = (f32x4){acc[4 * g4], acc[4 * g4 + 1], acc[4 * g4 + 2], acc[4 * g4 + 3]};
        WG_BAR();
        { const int row = F.tid >> 4, c4 = (F.tid & 15) * 4;
          f32x4 s = *(const LAS f32x4*)(part + row * 68 + c4) + *(const LAS f32x4*)(part + (32 + row) * 68 + c4) + *(const LAS f32x4*)(part + (64 + row) * 68 + c4) + *(const LAS f32x4*)(part + (96 + row) * 68 + c4);
          E.st4(MP + 32 * rt + row, 64 * cg + c4, s); }
        WG_BAR();
    }
}

constexpr int VROW = 320;
__device__ __forceinline__ void mlstm_A_unit(const Frame& F, int u) {
    const int bh = u >> 7, c = u & 127, b = bh >> 2, h = bh & 3, m0 = b * TP + c * 64;
    const int tid = F.tid, lane = F.lane, wid = F.wave;
    LAS unsigned char* Vt = F.lds; LAS unsigned char* Kt = F.lds + 20480; LAS float* wl = (LAS float*)(F.lds + 40960);
    if (wid == 0) {
        const float lf = FP_LF[(size_t)(m0 + lane) * 4 + h], ig = FP_IG[(size_t)(m0 + lane) * 4 + h];
        const float Fc = wave_scan_sum(lf, lane), a = ig - Fc, Ac = wave_scan_max(a, lane);
        const float Mloc = __shfl(Ac, 63), Fsum = __shfl(Fc, 63);
        wl[lane] = __expf(a - Mloc);
        if (lane == 0) { FP_ST[2 * u] = Fsum; FP_ST[2 * u + 1] = Mloc; }
    }
    WG_BAR();
#pragma unroll
    for (int i = 0; i < 2; ++i) { const int idx = tid + 512 * i, row = idx >> 4, ch = idx & 15;
        const bf16_t* src = FP_Z + (size_t)(m0 + row) * ZP + h * 128 + ch * 8;
        const u32x4 vv = *(const u32x4*)(src + ZV); const u32x4 kk = *(const u32x4*)(src + ZK);
        f32x4 k0, k1; unpack8(kk, k0, k1); const float w = wl[row];
        *(LAS u32x4*)(Vt + row * VROW + ch * 16) = vv;
        *(LAS bf16x8*)(Kt + row * VROW + ch * 16) = pack8(k0 * w, k1 * w); }
    WG_BAR();
    if (tid < 128) { float s = 0.f;
#pragma unroll 8
        for (int row = 0; row < 64; ++row) s += bf2f(*(const LAS bf16_t*)(Kt + row * VROW + tid * 2));
        FP_NU[(size_t)u * 128 + tid] = s; }
    {
        const int r32 = lane & 31, hi = lane >> 5, vh = (lane >> 4) & 1, q4 = (lane & 15) >> 2, p = lane & 3;
        const int vt = wid >> 1, dt0 = 2 * (wid & 1);
        const int lbase = (8 * hi + q4) * VROW + (16 * vh + 4 * p) * 2;
        f32x16 acc0, acc1; for (int i = 0; i < 16; ++i) { acc0[i] = 0.f; acc1[i] = 0.f; }
#pragma unroll
        for (int st = 0; st < 4; ++st) {
            const LAS unsigned char* va = Vt + lbase + st * 16 * VROW + vt * 64;
            const bf16x8 af = cat4(tr_rd(va), tr_rd(va + 4 * VROW));
            const LAS unsigned char* ka = Kt + lbase + st * 16 * VROW + dt0 * 64;
            const bf16x8 b0 = cat4(tr_rd(ka), tr_rd(ka + 4 * VROW)), b1 = cat4(tr_rd(ka + 64), tr_rd(ka + 64 + 4 * VROW));
            acc0 = MFMA32(af, b0, acc0); acc1 = MFMA32(af, b1, acc1);
        }
        float* Uo = FP_U + (size_t)u * 16384;
#pragma unroll
        for (int i = 0; i < 16; ++i) { const int v = 32 * vt + crow(i, hi); Uo[v * 128 + 32 * dt0 + r32] = acc0[i]; Uo[v * 128 + 32 * dt0 + 32 + r32] = acc1[i]; }
    }
    WG_BAR();
}
__device__ __forceinline__ void smlstm_unit(const Frame& F, int u) {
    const int n = u >> 2, h = u & 3, tid = F.tid, lane = F.lane, wid = F.wave;
    const int mrow = MP + 4 * n;
    LAS float* qs = (LAS float*)F.lds; LAS float* ks = qs + 512; LAS float* vs = ks + 512; LAS float* numI = vs + 512; LAS float* Sm = numI + 512; LAS float* nq = Sm + 16; LAS float* red = nq + 4;
    { const int t = tid >> 7, d = tid & 127; const bf16_t* z = FP_Z + (size_t)(mrow + t) * ZP + h * 128 + d;
      qs[tid] = bf2f(z[ZQ]); ks[tid] = bf2f(z[ZK]); vs[tid] = bf2f(z[ZV]); }
    LAS float* gl = red + 8;
    const float m0 = FP_state_m[n * 4 + h];
    if (tid < 4) { float cum = 0.f, am = -INFINITY, at = 0.f;
      for (int t = 0; t <= tid; ++t) { cum += FP_LF[(size_t)(mrow + t) * 4 + h]; at = FP_IG[(size_t)(mrow + t) * 4 + h] - cum; am = fmaxf(am, at); }
      const float mxv = fmaxf(m0, am);
      gl[tid] = cum; gl[4 + tid] = at; gl[8 + tid] = mxv; gl[12 + tid] = __expf(m0 - mxv); gl[16 + tid] = cum + mxv; }
    WG_BAR();
    const float m_end = gl[19], Fend = gl[3], decay = __expf(Fend + m0 - m_end);
    const float wend0 = __expf(Fend + gl[4] - m_end), wend1 = __expf(Fend + gl[5] - m_end), wend2 = __expf(Fend + gl[6] - m_end), wend3 = __expf(Fend + gl[7] - m_end);
#pragma unroll
    for (int k = 0; k < 2; ++k) { const int pid = 2 * wid + k, t = pid >> 2, s = pid & 3;
        float d = qs[t * 128 + lane] * ks[s * 128 + lane] + qs[t * 128 + 64 + lane] * ks[s * 128 + 64 + lane]; d = wave_sum(d);
        if (lane == 0) Sm[pid] = (s <= t) ? d * __expf(gl[4 + s] - gl[8 + t]) : 0.f; }
    if (wid < 4) { const float* n0 = FP_state_n + (size_t)u * 128; float d = n0[lane] * qs[wid * 128 + lane] + n0[64 + lane] * qs[wid * 128 + 64 + lane]; d = wave_sum(d); if (lane == 0) nq[wid] = d; }
    { const int vrow = tid >> 2, dq = tid & 3;
      const float* c0 = FP_state_C + ((size_t)u * 128 + vrow) * 128 + 32 * dq; float* co = FP_out + OFF_CS + ((size_t)u * 128 + vrow) * 128 + 32 * dq;
      f32x4 cv[8];
#pragma unroll
      for (int i = 0; i < 8; ++i) cv[i] = *(const f32x4*)(c0 + 4 * i);
      float ps[4]; float coef[4];
      ps[0] = 0.f; ps[1] = 0.f; ps[2] = 0.f; ps[3] = 0.f;
      coef[0] = wend0 * vs[vrow]; coef[1] = wend1 * vs[128 + vrow]; coef[2] = wend2 * vs[256 + vrow]; coef[3] = wend3 * vs[384 + vrow];
#pragma unroll
      for (int i = 0; i < 8; ++i) { f32x4 cn = cv[i] * decay;
#pragma unroll
          for (int t = 0; t < 4; ++t) { const f32x4 qv = *(const LAS f32x4*)(qs + t * 128 + 32 * dq + 4 * i), kv = *(const LAS f32x4*)(ks + t * 128 + 32 * dq + 4 * i);
              ps[t] += (cv[i].x * qv.x + cv[i].y * qv.y) + (cv[i].z * qv.z + cv[i].w * qv.w); cn += kv * coef[t]; }
          *(f32x4*)(co + 4 * i) = cn; }
#pragma unroll
      for (int t = 0; t < 4; ++t) { ps[t] += __shfl_xor(ps[t], 1); ps[t] += __shfl_xor(ps[t], 2); if (dq == 0) numI[t * 128 + vrow] = ps[t]; } }
    WG_BAR();
    { const int t = tid >> 7, v = tid & 127;
      const float it = gl[12 + t], mtt = gl[16 + t];
      float num = it * numI[tid], den = it * nq[t];
#pragma unroll
      for (int s = 0; s < 4; ++s) { const float sv = Sm[t * 4 + s]; num += sv * vs[s * 128 + v]; den += sv; }
      const float hval = num / fmaxf(fabsf(den), __expf(-mtt));
      const float ssw = wave_sum(hval * hval); if (lane == 0) red[wid] = ssw;
      WG_BAR();
      const float rms = rsqrtf((red[2 * t] + red[2 * t + 1]) * (1.f / 128.f) + EPS);
      const float mo = bf2f(FP_Z[(size_t)(mrow + t) * ZP + ZO + h * 128 + v]);
      FP_HM[(size_t)(mrow + t) * 512 + h * 128 + v] = f2bf(hval * rms * FP_g_mlstm[h * 128 + v] * sigmoidf_(mo));
      if (tid < 128) { const float n0v = FP_state_n[(size_t)u * 128 + tid]; float nn = decay * n0v;
          nn += wend0 * ks[tid] + wend1 * ks[128 + tid] + wend2 * ks[256 + tid] + wend3 * ks[384 + tid];
          FP_out[OFF_NS + (size_t)u * 128 + tid] = nn; }
      if (tid == 0) FP_out[OFF_MS + u] = m_end; }
    WG_BAR();
}
__device__ __forceinline__ void mlstm_scan_item(const Frame& F, int item) {
    const int bh = item >> 5, j = item & 31, e = 512 * j + F.tid; const bool nthr = (j == 0 && F.tid < 128);
    float C = 0.f, m = 0.f, nacc = 0.f;
    const float* Ub = FP_U + (size_t)bh * 128 * 16384 + e; bf16_t* Cp = FP_CPREV + (size_t)bh * 128 * 16384 + e;
    for (int c0 = 0; c0 < 128; c0 += 8) {
        float uu[8], un[8];
#pragma unroll
        for (int i = 0; i < 8; ++i) { uu[i] = Ub[(size_t)(c0 + i) * 16384]; un[i] = nthr ? FP_NU[(size_t)(bh * 128 + c0 + i) * 128 + F.tid] : 0.f; }
#pragma unroll
        for (int i = 0; i < 8; ++i) { const int c = c0 + i; const float fs = FP_ST[2 * (bh * 128 + c)], ml = FP_ST[2 * (bh * 128 + c) + 1];
            Cp[(size_t)c * 16384] = f2bf(C);
            if (nthr) FP_NPREV[(size_t)(bh * 128 + c) * 128 + F.tid] = nacc;
            if (j == 0 && F.tid == 0) FP_MPREV[bh * 128 + c] = m;
            const float mn = fs + fmaxf(m, ml), dec = __expf(fs + m - mn), sc = __expf(fs + ml - mn);
            C = dec * C + sc * uu[i]; nacc = dec * nacc + sc * un[i]; m = mn; }
    }
    FP_out[OFF_CP + (size_t)bh * 16384 + e] = C;
    if (nthr) FP_out[OFF_NP + bh * 128 + F.tid] = nacc;
    if (j == 0 && F.tid == 0) FP_out[OFF_MP + bh] = m;
}
__device__ __forceinline__ void mlstm_C_unit(const Frame& F, int u) {
    const int bh = u >> 7, c = u & 127, b = bh >> 2, h = bh & 3, m0 = b * TP + c * 64;
    const int tid = F.tid, lane = F.lane, wid = F.wave, r32 = lane & 31, hi = lane >> 5;
    LAS unsigned char* Vt = F.lds; LAS float* Fa = (LAS float*)(F.lds + 20480); LAS float* aa = Fa + 64; LAS float* Aa = aa + 64; LAS float* dqp = Aa + 64;   LAS float* ssq = dqp + 512;
    if (wid == 0) {
        const float lf = FP_LF[(size_t)(m0 + lane) * 4 + h], ig = FP_IG[(size_t)(m0 + lane) * 4 + h];
        const float Fc = wave_scan_sum(lf, lane), a = ig - Fc, Ac = wave_scan_max(a, lane);
        Fa[lane] = Fc; aa[lane] = a; Aa[lane] = Ac;
    }
#pragma unroll
    for (int i = 0; i < 2; ++i) { const int idx = tid + 512 * i, row = idx >> 4, ch = idx & 15;
        *(LAS u32x4*)(Vt + row * VROW + ch * 16) = *(const u32x4*)(FP_Z + (size_t)(m0 + row) * ZP + ZV + h * 128 + ch * 8); }
    { const int t = tid & 63, part = tid >> 6; const bf16_t* qp = FP_Z + (size_t)(m0 + t) * ZP + ZQ + h * 128 + 16 * part; const float* np = FP_NPREV + (size_t)u * 128 + 16 * part;
      f32x4 q0, q1, q2, q3; unpack8(*(const u32x4*)qp, q0, q1); unpack8(*(const u32x4*)(qp + 8), q2, q3);
      const f32x4 n0 = *(const f32x4*)np, n1 = *(const f32x4*)(np + 4), n2 = *(const f32x4*)(np + 8), n3 = *(const f32x4*)(np + 12);
      const f32x4 s = q0 * n0 + q1 * n1 + q2 * n2 + q3 * n3; dqp[part * 64 + t] = (s.x + s.y) + (s.z + s.w); }
    WG_BAR();
    const int vt = wid & 3, tt = wid >> 2, t = 32 * tt + r32;
    const float mprev = FP_MPREV[u];
    const float Ft = Fa[t], At = Aa[t], mxt = fmaxf(mprev, At), mt = Ft + mxt, inter = __expf(mprev - mxt);
    bf16x8 qf[8];
    { const bf16_t* qp = FP_Z + (size_t)(m0 + t) * ZP + ZQ + h * 128 + 8 * hi;
#pragma unroll
      for (int st = 0; st < 8; ++st) qf[st] = *(const bf16x8*)(qp + 16 * st); }
    f32x16 acc; for (int i = 0; i < 16; ++i) acc[i] = 0.f;
    { const bf16_t* cp = FP_CPREV + (size_t)u * 16384 + (size_t)(32 * vt + r32) * 128 + 8 * hi;
#pragma unroll
      for (int st = 0; st < 8; ++st) acc = MFMA32(*(const bf16x8*)(cp + 16 * st), qf[st], acc); }
#pragma unroll
    for (int i = 0; i < 16; ++i) acc[i] *= inter;
    float den = 0.f;
    const int vh = (lane >> 4) & 1, q4 = (lane & 15) >> 2, p = lane & 3;
    const int lbase = (4 * hi + q4) * VROW + (32 * vt + 16 * vh + 4 * p) * 2;
    for (int sub = 0; sub <= tt; ++sub) {
        f32x16 sacc; for (int i = 0; i < 16; ++i) sacc[i] = 0.f;
        { const bf16_t* kp = FP_Z + (size_t)(m0 + 32 * sub + r32) * ZP + ZK + h * 128 + 8 * hi;
#pragma unroll
          for (int st = 0; st < 8; ++st) sacc = MFMA32(*(const bf16x8*)(kp + 16 * st), qf[st], sacc); }
#pragma unroll
        for (int g = 0; g < 4; ++g) { const f32x4 av = *(const LAS f32x4*)(aa + 32 * sub + 8 * g + 4 * hi);
#pragma unroll
            for (int k = 0; k < 4; ++k) { const int s = 32 * sub + 8 * g + 4 * hi + k; const float wgt = (s <= t) ? __expf(av[k] - mxt) : 0.f; const float val = (s <= t) ? sacc[4 * g + k] * wgt : 0.f; sacc[4 * g + k] = val; den += val; } }
#pragma unroll
        for (int s2 = 0; s2 < 2; ++s2) {
            const bf16x8 pb = pack8((f32x4){sacc[8 * s2], sacc[8 * s2 + 1], sacc[8 * s2 + 2], sacc[8 * s2 + 3]}, (f32x4){sacc[8 * s2 + 4], sacc[8 * s2 + 5], sacc[8 * s2 + 6], sacc[8 * s2 + 7]});
            const LAS unsigned char* va = Vt + lbase + (32 * sub + 16 * s2) * VROW;
            acc = MFMA32(cat4(tr_rd(va), tr_rd(va + 8 * VROW)), pb, acc);
        }
    }
    den += __shfl_xor(den, 32);
    float dq = 0.f;
#pragma unroll
    for (int k = 0; k < 8; ++k) dq += dqp[k * 64 + t];
    den += inter * dq;
    const float rden = 1.f / fmaxf(fabsf(den), __expf(-mt));
    float ss = 0.f;
#pragma unroll
    for (int i = 0; i < 16; ++i) { acc[i] *= rden; ss += acc[i] * acc[i]; }
    ss += __shfl_xor(ss, 32);
    if (hi == 0) ssq[vt * 64 + t] = ss;
    WG_BAR();
    const float rms = rsqrtf((ssq[t] + ssq[64 + t] + ssq[128 + t] + ssq[192 + t]) * (1.f / 128.f) + EPS);
#pragma unroll
    for (int g = 0; g < 4; ++g) { const int v = 32 * vt + 8 * g + 4 * hi;
        const f32x4 gv = *(const f32x4*)(FP_g_mlstm + h * 128 + v); const u32x2 mo = *(const u32x2*)(FP_Z + (size_t)(m0 + t) * ZP + ZO + h * 128 + v);
        u32x2 o; o.x = pk2(acc[4 * g] * rms * gv.x * sigmoidf_(bflo(mo.x)), acc[4 * g + 1] * rms * gv.y * sigmoidf_(bfhi(mo.x)));
        o.y = pk2(acc[4 * g + 2] * rms * gv.z * sigmoidf_(bflo(mo.y)), acc[4 * g + 3] * rms * gv.w * sigmoidf_(bfhi(mo.y)));
        *(u32x2*)(FP_HM + (size_t)(m0 + t) * 512 + h * 128 + v) = o; }
    WG_BAR();
}
constexpr int AT_KB = 8320, AT_TILE = 8320 + 20480;
__device__ __forceinline__ void attn_half_unit(const Frame& F, int bh, int qb, int map, float* Odst) {
    const int b = bh >> 2, h = bh & 3, tid = F.tid, lane = F.lane, wid = F.wave, r32 = lane & 31, hi = lane >> 5;
    const int rowbase = b * TP, q0 = qb * 256, qrow = q0 + 32 * wid + r32;
    const bf16_t* Zb = FP_Z + (size_t)rowbase * ZP;
    bf16x8 qf[4];
    { const bf16_t* qp = Zb + (size_t)qrow * ZP + ZDQ + h * 128 + map * 64 + 8 * hi;
#pragma unroll
      for (int st = 0; st < 4; ++st) qf[st] = *(const bf16x8*)(qp + 16 * st); }
    const int NT = 4 * qb + 4;
    const int krow = tid >> 3, kch = tid & 7;
    const bf16_t* ksrc = Zb + (size_t)krow * ZP + ZDK + h * 128 + map * 64 + kch * 8;
    const int kdst = kch * 1040 + krow * 16;
    const int vrow0 = tid >> 4, vch = tid & 15;
    const bf16_t* vsrc = Zb + (size_t)vrow0 * ZP + ZDV + h * 128 + vch * 8;
    const int vdst = AT_KB + vrow0 * VROW + vch * 16;
    u32x4 sk, sv0, sv1;
    sk = *(const u32x4*)ksrc; sv0 = *(const u32x4*)vsrc; sv1 = *(const u32x4*)(vsrc + (size_t)32 * ZP);
    *(LAS u32x4*)(F.lds + kdst) = sk; *(LAS u32x4*)(F.lds + vdst) = sv0; *(LAS u32x4*)(F.lds + vdst + 32 * VROW) = sv1;
    WG_BAR();
    f32x16 o[4];
#pragma unroll
    for (int vt = 0; vt < 4; ++vt) for (int i = 0; i < 16; ++i) o[vt][i] = 0.f;
    float mrun = -1e30f, lrun = 0.f;
    const int vh = (lane >> 4) & 1, q4 = (lane & 15) >> 2, p = lane & 3;
    const int vlane = AT_KB + (4 * hi + q4) * VROW + (16 * vh + 4 * p) * 2;
    const int klane = hi * 1040 + r32 * 16;
    const int wlast = q0 + 32 * wid + 31, wfirst = q0 + 32 * wid;
    for (int j = 0; j < NT; ++j) {
        const int cur = (j & 1) * AT_TILE;
        const bool more = (j + 1 < NT);
        if (more) { const size_t adv = (size_t)(j + 1) * 64 * ZP; sk = *(const u32x4*)(ksrc + adv); sv0 = *(const u32x4*)(vsrc + adv); sv1 = *(const u32x4*)(vsrc + adv + (size_t)32 * ZP); }
        if (64 * j <= wlast) {
            f32x16 p0, p1; for (int i = 0; i < 16; ++i) { p0[i] = 0.f; p1[i] = 0.f; }
            const LAS unsigned char* kb = F.lds + cur + klane;
#pragma unroll
            for (int st = 0; st < 4; ++st) { const bf16x8 k0 = *(const LAS bf16x8*)(kb + st * 2080), k1 = *(const LAS bf16x8*)(kb + st * 2080 + 512);
                p0 = MFMA32(k0, qf[st], p0); p1 = MFMA32(k1, qf[st], p1); }
            if (64 * j + 63 > wfirst) {
#pragma unroll
                for (int i = 0; i < 16; ++i) { const int key = 64 * j + crow(i, hi); if (key > qrow) p0[i] = -INFINITY; if (key + 32 > qrow) p1[i] = -INFINITY; }
            }
            float mx = fmaxf(p0[0], p1[0]);
#pragma unroll
            for (int i = 1; i < 16; ++i) mx = fmaxf(mx, fmaxf(p0[i], p1[i]));
            mx = fmaxf(mx, __shfl_xor(mx, 32));
            const float mnew = fmaxf(mrun, mx);
            if (__any(mnew > mrun)) { const float alpha = __builtin_amdgcn_exp2f(mrun - mnew); lrun *= alpha;
#pragma unroll
                for (int vt = 0; vt < 4; ++vt) for (int i = 0; i < 16; ++i) o[vt][i] *= alpha;
                mrun = mnew; }
            float rsum = 0.f;
#pragma unroll
            for (int i = 0; i < 16; ++i) { p0[i] = __builtin_amdgcn_exp2f(p0[i] - mrun); p1[i] = __builtin_amdgcn_exp2f(p1[i] - mrun); rsum += p0[i] + p1[i]; }
            lrun += rsum;
            const LAS unsigned char* vb = F.lds + cur + vlane;
#pragma unroll
            for (int sub = 0; sub < 2; ++sub) {
#pragma unroll
                for (int s2 = 0; s2 < 2; ++s2) {
                    bf16x8 pb;
                    if (sub == 0) pb = pack8((f32x4){p0[8 * s2], p0[8 * s2 + 1], p0[8 * s2 + 2], p0[8 * s2 + 3]}, (f32x4){p0[8 * s2 + 4], p0[8 * s2 + 5], p0[8 * s2 + 6], p0[8 * s2 + 7]});
                    else          pb = pack8((f32x4){p1[8 * s2], p1[8 * s2 + 1], p1[8 * s2 + 2], p1[8 * s2 + 3]}, (f32x4){p1[8 * s2 + 4], p1[8 * s2 + 5], p1[8 * s2 + 6], p1[8 * s2 + 7]});
                    const LAS unsigned char* va = vb + (32 * sub + 16 * s2) * VROW;
#pragma unroll
                    for (int vt = 0; vt < 4; ++vt) o[vt] = MFMA32(cat4(tr_rd(va + vt * 64), tr_rd(va + vt * 64 + 8 * VROW)), pb, o[vt]);
                }
            }
        }
        if (more) { const int nx = ((j + 1) & 1) * AT_TILE; *(LAS u32x4*)(F.lds + nx + kdst) = sk; *(LAS u32x4*)(F.lds + nx + vdst) = sv0; *(LAS u32x4*)(F.lds + nx + vdst + 32 * VROW) = sv1; }
        WG_BAR();
    }
    lrun += __shfl_xor(lrun, 32);
    const float rl = 1.f / lrun;
    float* op = Odst + (size_t)(rowbase + qrow) * 512 + h * 128 + 4 * hi;
#pragma unroll
    for (int vt = 0; vt < 4; ++vt)
#pragma unroll
        for (int g = 0; g < 4; ++g) *(f32x4*)(op + 32 * vt + 8 * g) = (f32x4){o[vt][4 * g] * rl, o[vt][4 * g + 1] * rl, o[vt][4 * g + 2] * rl, o[vt][4 * g + 3] * rl};
}
__device__ __forceinline__ float lambda_full(const Frame& F, int lane) {
    const float a = wave_sum(FP_lq1[lane] * FP_lk1[lane]), b = wave_sum(FP_lq2[lane] * FP_lk2[lane]);
    return __expf(a) - __expf(b) + LAM_INIT;
}
__device__ __forceinline__ void attn_combine_rows(const Frame& F) {
    const int lane = F.lane, gw = F.vcu * NWAVES + F.wave, NGW = F.G * NWAVES;
    const float lam = lambda_full(F, lane);
    const f32x4 g0 = *(const f32x4*)(FP_g_diff + 8 * lane), g1 = *(const f32x4*)(FP_g_diff + 8 * lane + 4);
    for (int m = gw; m < MP; m += NGW) {
        const float* a = FP_O1 + (size_t)m * 512 + 8 * lane; const float* bb = FP_O2 + (size_t)m * 512 + 8 * lane;
        const f32x4 x0 = *(const f32x4*)a - *(const f32x4*)bb * lam, x1 = *(const f32x4*)(a + 4) - *(const f32x4*)(bb + 4) * lam;
        float ss = (x0.x * x0.x + x0.y * x0.y) + (x0.z * x0.z + x0.w * x0.w) + (x1.x * x1.x + x1.y * x1.y) + (x1.z * x1.z + x1.w * x1.w);
        ss += __shfl_xor(ss, 1); ss += __shfl_xor(ss, 2); ss += __shfl_xor(ss, 4); ss += __shfl_xor(ss, 8);
        const float rms = rsqrtf(ss * (1.f / 128.f) + EPS) * (1.f - LAM_INIT);
        *(bf16x8*)(FP_HD + (size_t)m * 512 + 8 * lane) = pack8(x0 * rms * g0, x1 * rms * g1);
    }
}
constexpr int SB_P = 2064;
__device__ __forceinline__ void decode_unit(const Frame& F, int u, float lam) {
    const int n = u >> 2, h = u & 3, tid = F.tid, lane = F.lane, wid = F.wave;
    const int mrow = MP + 4 * n;
    LAS float* Sbuf = (LAS float*)F.lds;
    LAS float* part = Sbuf + 8 * SB_P;
    LAS float* rlv = part + 8192;
    LAS float* red = rlv + 8;
    const int* pt = FP_page_table + n * NPAGES;
    const int c16 = lane & 15, g = lane >> 4;
    bf16x8 bq[4];
#pragma unroll
    for (int st = 0; st < 4; ++st) { const bool ok = (c16 < 4 && st < 2) || (c16 >= 4 && c16 < 8 && st >= 2);
        const bf16x8 v = *(const bf16x8*)(FP_Z + (size_t)(mrow + (c16 & 3)) * ZP + ZDQ + h * 128 + 32 * st + 8 * g);
        const bf16x8 zz = {0, 0, 0, 0, 0, 0, 0, 0}; bq[st] = ok ? v : zz; }
    {
        const int pg0 = pt[2 * wid], pg1 = pt[2 * wid + 1];
        f32x4 kr[8];
        { const float* kp = FP_cache_k + (((size_t)pg0 * PAGE + c16) * 4 + h) * 128 + 8 * g;
#pragma unroll
          for (int st = 0; st < 4; ++st) { kr[2 * st] = *(const f32x4*)(kp + 32 * st); kr[2 * st + 1] = *(const f32x4*)(kp + 32 * st + 4); } }
        for (int i = 0; i < 16; ++i) {
            bf16x8 af[4];
#pragma unroll
            for (int st = 0; st < 4; ++st) af[st] = pack8(kr[2 * st], kr[2 * st + 1]);
            if (i + 1 < 16) { const int i1 = i + 1; const int pg = (i1 < 8) ? pg0 : pg1; const int tok = 16 * (i1 & 7) + c16;
                const float* kp = FP_cache_k + (((size_t)pg * PAGE + tok) * 4 + h) * 128 + 8 * g;
#pragma unroll
                for (int st = 0; st < 4; ++st) { kr[2 * st] = *(const f32x4*)(kp + 32 * st); kr[2 * st + 1] = *(const f32x4*)(kp + 32 * st + 4); } }
            f32x4 acc = {0.f, 0.f, 0.f, 0.f};
#pragma unroll
            for (int st = 0; st < 4; ++st) acc = MFMA16(af[st], bq[st], acc);
            if (c16 < 8) *(LAS f32x4*)(Sbuf + c16 * SB_P + 256 * wid + 16 * i + 4 * g) = acc;
        }
        if (wid == 0) {
            f32x4 acc = {0.f, 0.f, 0.f, 0.f};
#pragma unroll
            for (int st = 0; st < 4; ++st) { const bf16x8 v = *(const bf16x8*)(FP_Z + (size_t)(mrow + (c16 & 3)) * ZP + ZDK + h * 128 + 32 * st + 8 * g);
                const bf16x8 zz = {0, 0, 0, 0, 0, 0, 0, 0}; const bf16x8 av = (c16 < 4) ? v : zz; acc = MFMA16(av, bq[st], acc); }
            if (g == 0 && c16 < 8) { const int t = c16 & 3; f32x4 m;
                m.x = acc.x; m.y = (1 <= t) ? acc.y : -INFINITY; m.z = (2 <= t) ? acc.z : -INFINITY; m.w = (3 <= t) ? acc.w : -INFINITY;
                *(LAS f32x4*)(Sbuf + c16 * SB_P + PAST) = m; }
        }
    }
    WG_BAR();
    {
        LAS float* col = Sbuf + wid * SB_P; float mx = -INFINITY;
        for (int k = lane; k < PAST + 4; k += 64) mx = fmaxf(mx, col[k]);
        mx = wave_max(mx); float sm = 0.f;
        for (int k = lane; k < PAST + 4; k += 64) { const float pv = __builtin_amdgcn_exp2f(col[k] - mx); col[k] = pv; sm += pv; }
        sm = wave_sum(sm); if (lane == 0) rlv[wid] = 1.f / sm;
    }
    WG_BAR();
    {
        const int hh = lane >> 5, l5 = lane & 31; const int pg = pt[2 * wid + hh];
        const float* vp = FP_cache_v + (((size_t)pg * PAGE) * 4 + h) * 128 + 4 * l5;
        const LAS float* pbase = Sbuf + 256 * wid + 128 * hh;
        f32x4 acc[8];
#pragma unroll
        for (int c = 0; c < 8; ++c) acc[c] = (f32x4){0.f, 0.f, 0.f, 0.f};
        f32x4 vr[4];
#pragma unroll
        for (int kk = 0; kk < 4; ++kk) vr[kk] = *(const f32x4*)(vp + (size_t)kk * 512);
        for (int t4 = 0; t4 < 32; ++t4) {
            f32x4 vc[4];
#pragma unroll
            for (int kk = 0; kk < 4; ++kk) vc[kk] = vr[kk];
            if (t4 + 1 < 32) {
#pragma unroll
                for (int kk = 0; kk < 4; ++kk) vr[kk] = *(const f32x4*)(vp + (size_t)(4 * (t4 + 1) + kk) * 512); }
#pragma unroll
            for (int c = 0; c < 8; ++c) { const f32x4 pp = *(const LAS f32x4*)(pbase + c * SB_P + 4 * t4);
                acc[c] += vc[0] * pp.x + vc[1] * pp.y + vc[2] * pp.z + vc[3] * pp.w; }
        }
        if (wid == 0) {
#pragma unroll
            for (int s = 0; s < 4; ++s) { const u32x2 vv = *(const u32x2*)(FP_Z + (size_t)(mrow + s) * ZP + ZDV + h * 128 + 4 * l5);
                const f32x4 vf = {bflo(vv.x), bfhi(vv.x), bflo(vv.y), bfhi(vv.y)};
#pragma unroll
                for (int c = 0; c < 8; ++c) { const float pp = (hh == 0) ? Sbuf[c * SB_P + PAST + s] : 0.f; acc[c] += vf * pp; } }
        }
#pragma unroll
        for (int c = 0; c < 8; ++c) { acc[c].x += __shfl_xor(acc[c].x, 32); acc[c].y += __shfl_xor(acc[c].y, 32); acc[c].z += __shfl_xor(acc[c].z, 32); acc[c].w += __shfl_xor(acc[c].w, 32);
            if (hh == 0) *(LAS f32x4*)(part + (wid * 8 + c) * 128 + 4 * l5) = acc[c]; }
    }
    WG_BAR();
    { const int t = tid >> 7, v = tid & 127; float o1 = 0.f, o2 = 0.f;
#pragma unroll
      for (int w = 0; w < 8; ++w) { o1 += part[(w * 8 + t) * 128 + v]; o2 += part[(w * 8 + 4 + t) * 128 + v]; }
      const float ov = o1 * rlv[t] - lam * o2 * rlv[4 + t];
      const float ssw = wave_sum(ov * ov); if (lane == 0) red[wid] = ssw;
      WG_BAR();
      const float rms = rsqrtf((red[2 * t] + red[2 * t + 1]) * (1.f / 128.f) + EPS) * (1.f - LAM_INIT);
      FP_HD[(size_t)(mrow + t) * 512 + h * 128 + v] = f2bf(ov * rms * FP_g_diff[h * 128 + v]); }
    WG_BAR();
}
__device__ __forceinline__ void rows_post_mix(const Frame& F) {
    const int lane = F.lane, gw = F.vcu * NWAVES + F.wave, NGW = F.G * NWAVES;
    for (int m = gw; m < MT; m += NGW) {
        const float* xr = xrow_of(F, m); const float* ada = FP_ADA + (size_t)crow_of(m) * 6144; const float* yr = FP_Y + (size_t)m * DM;
        f32x4 y[4], x1[4]; float ss = 0.f;
#pragma unroll
        for (int j = 0; j < 4; ++j) { y[j] = *(const f32x4*)(yr + 4 * lane + 256 * j); ss += (y[j].x * y[j].x + y[j].y * y[j].y) + (y[j].z * y[j].z + y[j].w * y[j].w); }
        const float rs = rsqrtf(wave_sum(ss) * (1.f / DM) + EPS); float s1 = 0.f;
#pragma unroll
        for (int j = 0; j < 4; ++j) { const int c = 4 * lane + 256 * j; const f32x4 xv = *(const f32x4*)(xr + c), gp = *(const f32x4*)(FP_g_post_mix + c), g1 = *(const f32x4*)(ada + 2048 + c);
            x1[j] = xv + g1 * (y[j] * rs * gp); *(f32x4*)(FP_out + OFF_Y + (size_t)m * DM + c) = x1[j];
            s1 += (x1[j].x * x1[j].x + x1[j].y * x1[j].y) + (x1[j].z * x1[j].z + x1[j].w * x1[j].w); }
        const float r1 = rsqrtf(wave_sum(s1) * (1.f / DM) + EPS);
#pragma unroll
        for (int j = 0; j < 4; ++j) { const int c = 4 * lane + 256 * j; const f32x4 gf = *(const f32x4*)(FP_g_pre_ffn + c), sh = *(const f32x4*)(ada + 3072 + c), sc = *(const f32x4*)(ada + 4096 + c);
            const f32x4 hv = (x1[j] * r1 * gf) * (sc + 1.f) + sh; u32x2 o; o.x = pk2(hv.x, hv.y); o.y = pk2(hv.z, hv.w); *(u32x2*)(FP_H1 + (size_t)m * DM + c) = o; }
    }
}
__device__ __forceinline__ void rows_final(const Frame& F) {
    const int lane = F.lane, gw = F.vcu * NWAVES + F.wave, NGW = F.G * NWAVES;
    for (int m = gw; m < MT; m += NGW) {
        const float* ada = FP_ADA + (size_t)crow_of(m) * 6144; const float* yr = FP_Y + (size_t)m * DM; float* orow = FP_out + OFF_Y + (size_t)m * DM;
        f32x4 y[4]; float ss = 0.f;
#pragma unroll
        for (int j = 0; j < 4; ++j) { y[j] = *(const f32x4*)(yr + 4 * lane + 256 * j); ss += (y[j].x * y[j].x + y[j].y * y[j].y) + (y[j].z * y[j].z + y[j].w * y[j].w); }
        const float rs = rsqrtf(wave_sum(ss) * (1.f / DM) + EPS);
#pragma unroll
        for (int j = 0; j < 4; ++j) { const int c = 4 * lane + 256 * j; const f32x4 xv = *(const f32x4*)(orow + c), gp = *(const f32x4*)(FP_g_post_ffn + c), g2 = *(const f32x4*)(ada + 5120 + c);
            *(f32x4*)(orow + c) = xv + g2 * (y[j] * rs * gp); }
    }
}
__device__ __forceinline__ float gelu_tanh(float x) { const float u = 1.5957691216057308f * (x + 0.044715f * x * x * x); return x * __builtin_amdgcn_rcpf(1.f + __builtin_amdgcn_exp2f(-u * LOG2E)); }
__device__ __forceinline__ void geglu_phase(const Frame& F) {
    const size_t NIT = (size_t)MT * 352; const size_t stride = (size_t)F.G * NTHR;
    for (size_t it = (size_t)F.vcu * NTHR + F.tid; it < NIT; it += stride) {
        const int m = (int)(it / 352), ch = (int)(it % 352), f0 = 8 * ch;
        f32x4 a0, a1, p10, p11, p20, p21, b0, b1;
        unpack8(*(const u32x4*)(FP_UA + (size_t)m * DFF + f0), a0, a1); unpack8(*(const u32x4*)(FP_UB + (size_t)m * DFF + f0), b0, b1);
        const f32x4 z4 = {0.f, 0.f, 0.f, 0.f};
        if (m < MP) { const int t = m & (TP - 1);
            if (t >= 1) unpack8(*(const u32x4*)(FP_UA + (size_t)(m - 1) * DFF + f0), p10, p11); else { p10 = z4; p11 = z4; }
            if (t >= 2) unpack8(*(const u32x4*)(FP_UA + (size_t)(m - 2) * DFF + f0), p20, p21); else { p20 = z4; p21 = z4; }
        } else { const int t = (m - MP) & 3, n = (m - MP) >> 2; const float* st = FP_state_conv + (size_t)n * 2 * DFF + f0;
            if (t >= 1) unpack8(*(const u32x4*)(FP_UA + (size_t)(m - 1) * DFF + f0), p10, p11); else { p10 = *(const f32x4*)(st + DFF); p11 = *(const f32x4*)(st + DFF + 4); }
            if (t >= 2) unpack8(*(const u32x4*)(FP_UA + (size_t)(m - 2) * DFF + f0), p20, p21);
            else if (t == 1) { p20 = *(const f32x4*)(st + DFF); p21 = *(const f32x4*)(st + DFF + 4); } else { p20 = *(const f32x4*)st; p21 = *(const f32x4*)(st + 4); } }
        const f32x4 w00 = *(const f32x4*)(FP_conv_w + f0), w01 = *(const f32x4*)(FP_conv_w + f0 + 4), w10 = *(const f32x4*)(FP_conv_w + DFF + f0), w11 = *(const f32x4*)(FP_conv_w + DFF + f0 + 4),
                    w20 = *(const f32x4*)(FP_conv_w + 2 * DFF + f0), w21 = *(const f32x4*)(FP_conv_w + 2 * DFF + f0 + 4), cb0 = *(const f32x4*)(FP_conv_b + f0), cb1 = *(const f32x4*)(FP_conv_b + f0 + 4);
        f32x4 c0 = cb0 + w00 * p20 + w10 * p10 + w20 * a0, c1 = cb1 + w01 * p21 + w11 * p11 + w21 * a1;
        c0.x = gelu_tanh(c0.x) * b0.x; c0.y = gelu_tanh(c0.y) * b0.y; c0.z = gelu_tanh(c0.z) * b0.z; c0.w = gelu_tanh(c0.w) * b0.w;
        c1.x = gelu_tanh(c1.x) * b1.x; c1.y = gelu_tanh(c1.y) * b1.y; c1.z = gelu_tanh(c1.z) * b1.z; c1.w = gelu_tanh(c1.w) * b1.w;
        *(bf16x8*)(FP_GB + (size_t)m * DFF + f0) = pack8(c0, c1);
    }
}

constexpr int NPHASE = 15;
__global__ void __launch_bounds__(NTHR, 2) fwd_kernel(Args args) {
    extern __shared__ __attribute__((aligned(16))) unsigned char lds_raw[];
    Frame F;
    F.lds = (LAS unsigned char*)lds_raw;
    F.tid = threadIdx.x; F.lane = F.tid & 63; F.wave = __builtin_amdgcn_readfirstlane(F.tid >> 6);
    F.G = gridDim.x; { const int bx = blockIdx.x; F.vcu = (F.G % 8 == 0) ? (bx % 8) * (F.G / 8) + bx / 8 : bx; }
    F.a = &args; unsigned char* ws = args.ws;
    volatile LAS unsigned* MISC = (volatile LAS unsigned*)(F.lds + MISC_OFF);
    for (int u = F.tid; u < (LDS_BYTES - RING_BYTES) / 4; u += NTHR) ((LAS unsigned*)(F.lds + RING_BYTES))[u] = 0u;
    __syncthreads();
    const int lo = args.ph_lo, hi = args.ph_hi;
    const bool multi = (hi - lo) > 1;
    XcdBarrier bar; bar.bar = (unsigned*)(ws + WS_CTL) + CW_BAR; bar.x = 0; bar.st = nullptr;
    if (multi) bar = xcd_barrier_post((unsigned*)(ws + WS_CTL) + CW_BAR, MISC + 8);
#define IN(k) (lo <= (k) && (k) < hi)
#define SEAM(k) do { if (IN(k) && IN((k) + 1)) xcd_barrier(bar); } while (0)

    if (IN(0)) { p0_ada(F); p0_transposes(F); } SEAM(0);
    if (IN(1)) { p1_norm_gates(F); } SEAM(1);
    if (IN(2)) { pg8::Gemm g{FP_H1, FP_WinT, MT, ZP, DM}; pg8::StaticOrder S; S.init(MT, ZP, F.G, (int)blockIdx.x); EpiZ E{FP_Z, FP_out}; pg8::gemm_phase(F.lds, g, S, E); } SEAM(2);
    if (IN(3)) { for (int i = 0; i < 4; ++i) { const int u = F.vcu * 4 + i; if (u < 1024) mlstm_A_unit(F, u); }
                 if (F.G != 256) for (int u = 4 * F.G + F.vcu; u < 1024; u += F.G) mlstm_A_unit(F, u);
                 for (int u = F.vcu; u < 512; u += F.G) smlstm_unit(F, u); } SEAM(3);
    if (IN(4)) { for (int it = F.vcu; it < 256; it += F.G) mlstm_scan_item(F, it); } SEAM(4);
    if (IN(5)) { for (int i = F.vcu; i < 256; i += F.G) { const int bh = i >> 5, s = i & 31; attn_half_unit(F, bh, s, 0, FP_O1); attn_half_unit(F, bh, 31 - s, 1, FP_O2); }
                 const float lam = lambda_full(F, F.lane);
                 for (int u = F.vcu; u < 512; u += F.G) decode_unit(F, u, lam); } SEAM(5);
    if (IN(6)) { for (int i = 0; i < 4; ++i) { const int u = F.vcu * 4 + i; if (u < 1024) mlstm_C_unit(F, u); }
                 if (F.G != 256) for (int u = 4 * F.G + F.vcu; u < 1024; u += F.G) mlstm_C_unit(F, u);
                 attn_combine_rows(F); } SEAM(6);
    if (IN(7)) { pg8::Gemm g{FP_HM, FP_WpmT, MP, DM, 512}; pg8::StaticOrder S; S.init(MP, DM, F.G, (int)blockIdx.x); EpiPM E{FP_Z, FP_MG}; pg8::gemm_phase(F.lds, g, S, E);
                 skinny_gemm(F, FP_HM + (size_t)MP * 512, FP_WpmT, 512, E); } SEAM(7);
    if (IN(8)) { pg8::Gemm g{FP_HD, FP_WpdT, MP, DM, 512}; pg8::StaticOrder S; S.init(MP, DM, F.G, (int)blockIdx.x); EpiPD E{FP_Z, FP_MG}; pg8::gemm_phase(F.lds, g, S, E);
                 skinny_gemm(F, FP_HD + (size_t)MP * 512, FP_WpdT, 512, E); } SEAM(8);
    if (IN(9)) { pg8::Gemm g{FP_MG, FP_WoutT, MP, DM, DM}; pg8::StaticOrder S; S.init(MP, DM, F.G, (int)blockIdx.x); EpiF32 E{FP_Y}; pg8::gemm_phase(F.lds, g, S, E);
                 skinny_gemm(F, FP_MG + (size_t)MP * DM, FP_WoutT, DM, E); } SEAM(9);
    if (IN(10)) { rows_post_mix(F); } SEAM(10);
    if (IN(11)) { pg8::Gemm g{FP_H1, FP_WupT, MT, 2 * DFF, DM}; pg8::StaticOrder S; S.init(MT, 2 * DFF, F.G, (int)blockIdx.x); EpiUp E{FP_UA, FP_UB, FP_out}; pg8::gemm_phase(F.lds, g, S, E); } SEAM(11);
    if (IN(12)) { geglu_phase(F); } SEAM(12);
    if (IN(13)) { pg8::Gemm g{FP_GB, FP_WdownT, MP, DM, DFF}; pg8::StaticOrder S; S.init(MP, DM, F.G, (int)blockIdx.x); EpiF32 E{FP_Y}; pg8::gemm_phase(F.lds, g, S, E);
                  skinny_gemm(F, FP_GB + (size_t)MP * DFF, FP_WdownT, DFF, E); } SEAM(13);
    if (IN(14)) { rows_final(F); }
#undef IN
#undef SEAM
}

#ifndef MK_ONE_LAUNCH
#define MK_ONE_LAUNCH 1
#endif
extern "C" void kernel_launch(void* const* d_in, const int* in_sizes, int n_in, void* d_out, int out_size, void* d_ws, size_t ws_size, hipStream_t stream) {
    static int grid = 0;
    if (grid == 0) {
        if (n_in != 32 || out_size != (int)OUT_TOTAL || ws_size < WS_END) { fprintf(stderr, "kernel_launch: unexpected sizes n_in %d out %d ws %zu\n", n_in, out_size, ws_size); grid = -1; return; }
        int dev = 0, cus = 0, per_cu = 0;
        if (hipGetDevice(&dev) != hipSuccess || hipDeviceGetAttribute(&cus, hipDeviceAttributeMultiprocessorCount, dev) != hipSuccess) { grid = -1; return; }
        if (hipFuncSetAttribute((const void*)fwd_kernel, hipFuncAttributeMaxDynamicSharedMemorySize, LDS_BYTES) != hipSuccess) { fprintf(stderr, "kernel_launch: hipFuncSetAttribute failed\n"); grid = -1; return; }
        if (hipOccupancyMaxActiveBlocksPerMultiprocessor(&per_cu, (const void*)fwd_kernel, NTHR, LDS_BYTES) != hipSuccess || per_cu < 1) fprintf(stderr, "kernel_launch: occupancy query reports %d\n", per_cu);
        (void)hipGetLastError();
        grid = cus;
    }
    if (grid < 0) return;
    if (hipMemsetAsync((char*)d_ws + WS_CTL, 0, CTL_ZERO_BYTES, stream) != hipSuccess) return;
    Args a{};
    for (int i = 0; i < 32; ++i) a.in[i] = d_in[i];
    a.out = (float*)d_out; a.ws = (unsigned char*)d_ws;
#if MK_ONE_LAUNCH
    a.ph_lo = 0; a.ph_hi = NPHASE;
    hipLaunchKernelGGL(fwd_kernel, dim3(grid), dim3(NTHR), LDS_BYTES, stream, a);
#else
    for (int p = 0; p < NPHASE; ++p) { a.ph_lo = p; a.ph_hi = p + 1; hipLaunchKernelGGL(fwd_kernel, dim3(grid), dim3(NTHR), LDS_BYTES, stream, a); }
#endif
}
```

```cpp
#include <hip/hip_runtime.h>
#include <cstdio>
#include <cstdint>

#define LAS __attribute__((address_space(3)))
#define GAS __attribute__((address_space(1)))
typedef unsigned short bf16_t;
typedef short bf16x8 __attribute__((ext_vector_type(8)));
typedef short s16x4 __attribute__((ext_vector_type(4)));
typedef short v4i16_t __attribute__((ext_vector_type(4)));
typedef float f32x2 __attribute__((ext_vector_type(2)));
typedef float f32x4 __attribute__((ext_vector_type(4)));
typedef float f32x16 __attribute__((ext_vector_type(16)));
typedef unsigned u32x2 __attribute__((ext_vector_type(2)));
typedef unsigned u32x4 __attribute__((ext_vector_type(4)));
typedef __bf16 bf16x2_t __attribute__((ext_vector_type(2)));
typedef GAS unsigned gu32;

constexpr int DM = 1024, TP = 8192, MP = 16384, MS = 512, MT = MP + MS;
constexpr int NSEQ = 128, TS = 4, NPAGES = 16, PAGE = 128, PAST = 2048;
constexpr int DIN = 5640, ZP = 5632, DFF = 2816;
constexpr int ZQ = 0, ZK = 512, ZV = 1024, ZO = 1536, ZDQ = 2048, ZDK = 2560, ZDV = 3072, ZGM = 3584, ZGD = 4608;
constexpr float EPS = 1e-6f, LAM_INIT = 0.2f, LOG2E = 1.4426950408889634f;
constexpr float QSCALE = 0.125f * LOG2E;
constexpr float KSCALE = 0.08838834764831845f;
constexpr size_t OFF_Y = 0, OFF_KP = 17301504, OFF_VP = 25690112, OFF_CP = 34078720, OFF_NP = 34209792, OFF_MP = 34210816, OFF_CVP = 34210824,
                 OFF_KS = 34222088, OFF_VS = 34484232, OFF_CS = 34746376, OFF_NS = 43134984, OFF_MS = 43200520, OFF_CVS = 43201032, OUT_TOTAL = 43921928;
constexpr size_t MiB = 1u << 20;
constexpr size_t WS_CTL = 0, CTL_ZERO_BYTES = 1 * MiB;
constexpr size_t WS_WIN = 1 * MiB, WS_WUP = 12 * MiB, WS_WDOWN = 23 * MiB, WS_WOUT = 29 * MiB, WS_WPM = 31 * MiB, WS_WPD = 32 * MiB;
constexpr size_t WS_ADA = 33 * MiB, WS_IG = 37 * MiB, WS_LF = 37 * MiB + 512 * 1024, WS_ST = 38 * MiB, WS_NU = 38 * MiB + 65536, WS_NPREV = 39 * MiB, WS_MPREV = 39 * MiB + 768 * 1024;
constexpr size_t WS_H1 = 40 * MiB, WS_Z = 73 * MiB, WS_U = 255 * MiB, WS_CPREV = 319 * MiB, WS_HM = 351 * MiB, WS_HD = 368 * MiB, WS_O1 = 385 * MiB, WS_O2 = 417 * MiB;
constexpr size_t WS_MG = 449 * MiB, WS_Y = 482 * MiB, WS_UA = 548 * MiB, WS_UB = 639 * MiB, WS_G = 730 * MiB, WS_END = 821 * MiB;
constexpr int CW_BAR = 4096;
constexpr int RING_BYTES = 131072, MISC_OFF = RING_BYTES + 320, LDS_BYTES = 147456;
constexpr int NWAVES = 8, NTHR = 512;

__device__ __forceinline__ unsigned pk2(float lo, float hi) { f32x2 v = {lo, hi}; bf16x2_t b = __builtin_convertvector(v, bf16x2_t); return __builtin_bit_cast(unsigned, b); }
__device__ __forceinline__ bf16_t f2bf(float x) { return (bf16_t)(pk2(x, 0.f) & 0xffffu); }
__device__ __forceinline__ float bflo(unsigned u) { return __uint_as_float(u << 16); }
__device__ __forceinline__ float bfhi(unsigned u) { return __uint_as_float(u & 0xffff0000u); }
__device__ __forceinline__ float bf2f(bf16_t u) { return __uint_as_float(((unsigned)u) << 16); }
__device__ __forceinline__ bf16x8 pack8(f32x4 a, f32x4 b) { u32x4 w; w.x = pk2(a.x, a.y); w.y = pk2(a.z, a.w); w.z = pk2(b.x, b.y); w.w = pk2(b.z, b.w); return __builtin_bit_cast(bf16x8, w); }
__device__ __forceinline__ void unpack8(u32x4 w, f32x4& a, f32x4& b) { a.x = bflo(w.x); a.y = bfhi(w.x); a.z = bflo(w.y); a.w = bfhi(w.y); b.x = bflo(w.z); b.y = bfhi(w.z); b.z = bflo(w.w); b.w = bfhi(w.w); }
__device__ __forceinline__ float wave_sum(float v) {
#pragma unroll
    for (int o = 1; o < 64; o <<= 1) v += __shfl_xor(v, o);
    return v;
}
__device__ __forceinline__ float wave_max(float v) {
#pragma unroll
    for (int o = 1; o < 64; o <<= 1) v = fmaxf(v, __shfl_xor(v, o));
    return v;
}
__device__ __forceinline__ float wave_scan_sum(float v, int lane) {
#pragma unroll
    for (int o = 1; o < 64; o <<= 1) { const float t = __shfl_up(v, o); if (lane >= o) v += t; }
    return v;
}
__device__ __forceinline__ float wave_scan_max(float v, int lane) {
#pragma unroll
    for (int o = 1; o < 64; o <<= 1) { const float t = __shfl_up(v, o); if (lane >= o) v = fmaxf(v, t); }
    return v;
}
__device__ __forceinline__ float sigmoidf_(float x) { return __builtin_amdgcn_rcpf(1.f + __builtin_amdgcn_exp2f(-x * LOG2E)); }
__device__ __forceinline__ float log_sigmoid(float x) { return fminf(x, 0.f) - log1pf(__expf(-fabsf(x))); }
__device__ __forceinline__ int crow(int reg, int h) { return (reg & 3) + 8 * (reg >> 2) + 4 * h; }
#define MFMA32(a, b, c) __builtin_amdgcn_mfma_f32_32x32x16_bf16((a), (b), (c), 0, 0, 0)
#define MFMA16(a, b, c) __builtin_amdgcn_mfma_f32_16x16x32_bf16((a), (b), (c), 0, 0, 0)
__device__ __forceinline__ s16x4 tr_rd(const LAS unsigned char* p) { return __builtin_bit_cast(s16x4, __builtin_amdgcn_ds_read_tr16_b64_v4i16((LAS v4i16_t*)p)); }
__device__ __forceinline__ bf16x8 cat4(s16x4 lo, s16x4 hi) { return (bf16x8){lo[0], lo[1], lo[2], lo[3], hi[0], hi[1], hi[2], hi[3]}; }
#define WG_BAR() __syncthreads()

namespace pg8 {
constexpr int BM = 256, BK = 64, HALF = 128, HTB = HALF * BK * 2, STAGE_BYTES = 8 * HTB, NXCD = 8, WGM = 8;
__host__ __device__ __forceinline__ int lds_byte(int r, int c) { const int st = (r >> 4) * 2 + (c >> 5), rr = r & 15, cc = c & 31, ob = rr * 64 + cc * 2; return st * 1024 + (ob ^ (((ob >> 9) & 1) << 5)); }
__host__ __device__ __forceinline__ void stage_rc(int b, int& R, int& C) { const int st = b / 1024, sb = b % 1024, swz = sb ^ (((sb >> 9) & 1) << 5); R = (st >> 1) * 16 + swz / 64; C = (st & 1) * 32 + (swz % 64) / 2; }
__host__ __device__ __forceinline__ int perm32(int rho) { const int n = rho >> 4, i = rho & 15; return 8 * (i >> 2) + 4 * n + (i & 3); }
struct Unit { int pm, pn; };
struct Gemm { const bf16_t* A; const bf16_t* Bt; int M, N, K; };
struct StaticOrder {
    int nM, nN, nwg, G, c;
    __host__ __device__ void init(int M, int N, int G_, int c_) { nM = M / BM; nN = N / BM; nwg = nM * nN; G = G_; c = c_; }
    __host__ __device__ bool next(int i, Unit& u) const {
        const long L = (long)i * G + c; if (L >= nwg) return false;
        int wgid = (int)L; { const int q = nwg / NXCD, r = nwg % NXCD, xcd = wgid % NXCD, off = wgid / NXCD; wgid = (xcd < r ? xcd * (q + 1) : r * (q + 1) + (xcd - r) * q) + off; }
        const int nig = WGM * nN, gid = wgid / nig, fm = gid * WGM, gsz = (nM - fm) < WGM ? (nM - fm) : WGM;
        u.pm = fm + ((wgid % nig) % gsz); u.pn = (wgid % nig) / gsz; return true;
    }
};
template <class Epi>
__device__ __forceinline__ void gemm_phase(LAS unsigned char* lds, const Gemm g, const StaticOrder& S, const Epi& E) {
    const int tid = threadIdx.x, wid = __builtin_amdgcn_readfirstlane(tid >> 6), lane = tid & 63, wr = wid >> 2, wc = wid & 3, fr = lane & 15, fq = lane >> 4;
    const int K = g.K, nt = K / BK;
    unsigned voffA[2], voffB[2];
#pragma unroll
    for (int i = 0; i < 2; ++i) { int R, C; stage_rc(tid * 16 + i * 8192, R, C); const int Rb = (R & ~31) + perm32(R & 31);
        voffA[i] = (unsigned)(R * K + C) * 2u; voffB[i] = (unsigned)(Rb * K + C) * 2u; }
    const size_t kstep = (size_t)(BK * 2);
    const size_t hstep = (size_t)HALF * K * 2;
    const size_t tstep = 2 * hstep;
    const unsigned ldsw = (unsigned)wid * 1024u;
    const int aoff = lds_byte(wr * 64 + fr, fq * 8), boff = lds_byte(wc * 32 + fr, fq * 8);
#define PG8_SA(b, h) (((b) * 2 + (h)) * HTB)
#define PG8_SB(b, h) ((4 + (b) * 2 + (h)) * HTB)
#define PG8_STAGE(bufoff, gbase, voff) do { _Pragma("unroll") for (int _i = 0; _i < 2; ++_i) \
        __builtin_amdgcn_global_load_lds((const unsigned*)((const char*)(gbase) + (voff)[_i]), (LAS unsigned*)(lds + (bufoff) + ldsw + _i * 8192), 16, 0, 0); } while (0)
#define PG8_LDA(dst, b, h) do { _Pragma("unroll") for (int m = 0; m < 4; ++m) _Pragma("unroll") for (int k = 0; k < 2; ++k) dst[m][k] = *(const LAS bf16x8*)(lds + PG8_SA(b, h) + aoff + m * 2048 + k * 1024); } while (0)
#define PG8_LDB(dst, b, h) do { _Pragma("unroll") for (int n = 0; n < 2; ++n) _Pragma("unroll") for (int k = 0; k < 2; ++k) dst[n][k] = *(const LAS bf16x8*)(lds + PG8_SB(b, h) + boff + n * 2048 + k * 1024); } while (0)
#define PG8_MMA(ai, bj, At, Bt) do { __builtin_amdgcn_s_setprio(1); _Pragma("unroll") for (int m = 0; m < 4; ++m) _Pragma("unroll") for (int n = 0; n < 2; ++n) _Pragma("unroll") for (int k = 0; k < 2; ++k) \
        acc[ai][bj][m][n] = __builtin_amdgcn_mfma_f32_16x16x32_bf16(Bt[n][k], At[m][k], acc[ai][bj][m][n], 0, 0, 0); __builtin_amdgcn_s_setprio(0); } while (0)
#define PG8_WAIT_V(n) asm volatile("s_waitcnt vmcnt(" #n ")" ::: "memory")
#define PG8_WAIT_L(n) asm volatile("s_waitcnt lgkmcnt(" #n ")" ::: "memory")
#define PG8_BAR __builtin_amdgcn_s_barrier()
#define PG8_SCHED __builtin_amdgcn_sched_barrier(0)
    Unit cur, nxt; int ui = 0;
    if (!S.next(0, cur)) return;
    f32x4 acc[2][2][4][2];
#pragma unroll
    for (int a = 0; a < 2; ++a)
#pragma unroll
        for (int b = 0; b < 2; ++b)
#pragma unroll
            for (int m = 0; m < 4; ++m)
#pragma unroll
                for (int n = 0; n < 2; ++n) acc[a][b][m][n] = (f32x4){0.f, 0.f, 0.f, 0.f};
    bf16x8 At[4][2], B0[2][2], B1[2][2];
    const char* cA = (const char*)g.A + (size_t)cur.pm * tstep; const char* cB = (const char*)g.Bt + (size_t)cur.pn * tstep;
    PG8_STAGE(PG8_SB(0, 0), cB, voffB); PG8_STAGE(PG8_SB(0, 1), cB + hstep, voffB); PG8_STAGE(PG8_SA(0, 0), cA, voffA); PG8_STAGE(PG8_SA(0, 1), cA + hstep, voffA);
    if (wr == 1) PG8_BAR;
    PG8_WAIT_V(2); PG8_BAR;
    PG8_STAGE(PG8_SB(1, 0), cB + kstep, voffB); PG8_STAGE(PG8_SA(1, 0), cA + kstep, voffA); PG8_STAGE(PG8_SB(1, 1), cB + hstep + kstep, voffB);
    PG8_WAIT_V(6); PG8_BAR;
    for (;;) {
        const bool has_next = S.next(ui + 1, nxt);
        const char* nA = has_next ? (const char*)g.A + (size_t)nxt.pm * tstep : cA; const char* nB = has_next ? (const char*)g.Bt + (size_t)nxt.pn * tstep : cB;
        for (int t = 0; t < nt; t += 2) {
            const bool last = (t == nt - 2);
            const char* a1 = cA + (size_t)(t + 1) * kstep;
            const char* a2 = last ? nA : cA + (size_t)(t + 2) * kstep; const char* b2 = last ? nB : cB + (size_t)(t + 2) * kstep;
            const char* a3 = a2 + kstep; const char* b3 = b2 + kstep;
            PG8_LDB(B0, 0, 0); PG8_LDB(B1, 0, 1); PG8_SCHED; PG8_LDA(At, 0, 0); PG8_STAGE(PG8_SA(1, 1), a1 + hstep, voffA);
            PG8_WAIT_V(8); PG8_WAIT_L(0); PG8_BAR; PG8_MMA(0, 0, At, B0); PG8_MMA(0, 1, At, B1); PG8_BAR; PG8_SCHED;
            PG8_LDA(At, 0, 1); PG8_STAGE(PG8_SB(0, 0), b2, voffB); PG8_STAGE(PG8_SB(0, 1), b2 + hstep, voffB); PG8_STAGE(PG8_SA(0, 0), a2, voffA);
            PG8_WAIT_V(8); PG8_WAIT_L(0); PG8_BAR; PG8_MMA(1, 0, At, B0); PG8_MMA(1, 1, At, B1); PG8_BAR; PG8_SCHED;
            PG8_LDB(B0, 1, 0); PG8_LDB(B1, 1, 1); PG8_SCHED; PG8_LDA(At, 1, 0); PG8_STAGE(PG8_SA(0, 1), a2 + hstep, voffA);
            PG8_WAIT_V(8); PG8_WAIT_L(0); PG8_BAR; PG8_MMA(0, 0, At, B0); PG8_MMA(0, 1, At, B1); PG8_BAR; PG8_SCHED;
            PG8_LDA(At, 1, 1); PG8_STAGE(PG8_SB(1, 0), b3, voffB); PG8_STAGE(PG8_SB(1, 1), b3 + hstep, voffB); PG8_STAGE(PG8_SA(1, 0), a3, voffA);
            PG8_WAIT_V(8); PG8_WAIT_L(0); PG8_BAR; PG8_MMA(1, 0, At, B0); PG8_MMA(1, 1, At, B1); PG8_BAR; PG8_SCHED;
        }
        if (wr == 0) PG8_BAR;
        {
            const int row0 = cur.pm * BM + wr * 64 + fr, col0 = cur.pn * BM + wc * 32 + 8 * fq;
#pragma unroll
            for (int ai = 0; ai < 2; ++ai)
#pragma unroll
                for (int m = 0; m < 4; ++m)
#pragma unroll
                    for (int bj = 0; bj < 2; ++bj) E.st8(row0 + ai * HALF + m * 16, col0 + bj * HALF, acc[ai][bj][m][0], acc[ai][bj][m][1]);
        }
        if (!has_next) break;
#pragma unroll
        for (int a = 0; a < 2; ++a)
#pragma unroll
            for (int b = 0; b < 2; ++b)
#pragma unroll
                for (int m = 0; m < 4; ++m)
#pragma unroll
                    for (int n = 0; n < 2; ++n) acc[a][b][m][n] = (f32x4){0.f, 0.f, 0.f, 0.f};
        cur = nxt; cA = nA; cB = nB; ++ui;
        if (wr == 1) PG8_BAR;
    }
    PG8_WAIT_V(0);
    PG8_BAR;
#undef PG8_SA
#undef PG8_SB
#undef PG8_STAGE
#undef PG8_LDA
#undef PG8_LDB
#undef PG8_MMA
#undef PG8_WAIT_V
#undef PG8_WAIT_L
#undef PG8_BAR
#undef PG8_SCHED
}
}

#define XB_TMO      128
#define XB_XCNT(j)  (256  + 64 * (j))
#define XB_XSUB(j)  (1280 + 64 * (j))
#define XB_XGEN(j)  (2304 + 64 * (j))
#define XB_TOP      3328
#define XB_TOPGEN   3392
#define XCD_BAR_WORDS 3456
#define XB_SPIN_CAP (1u << 18)
__device__ __forceinline__ unsigned xb_ld(unsigned* p)              { return __hip_atomic_load(p, __ATOMIC_RELAXED, __HIP_MEMORY_SCOPE_AGENT); }
__device__ __forceinline__ unsigned xb_add(unsigned* p, unsigned v) { return __hip_atomic_fetch_add(p, v, __ATOMIC_RELAXED, __HIP_MEMORY_SCOPE_AGENT); }
__device__ __forceinline__ unsigned xb_xcc_id() { return (unsigned)__builtin_amdgcn_s_getreg((3 << 11) | 20) & 0xFu; }
#define XB_SPIN(cond, bar) do { unsigned _sp = 0; while (cond) { __builtin_amdgcn_s_sleep(1); \
    if ((++_sp & 255u) == 0u) { if (xb_ld(&(bar)[XB_TMO])) break; if (_sp > XB_SPIN_CAP) { atomicAdd(&(bar)[XB_TMO], 1u); break; } } } } while (0)
struct XcdBarrier { unsigned* bar; unsigned x; volatile LAS unsigned* st; };
__device__ __forceinline__ XcdBarrier xcd_barrier_post(unsigned* bar, volatile LAS unsigned* st) {
    XcdBarrier b; b.bar = bar; b.x = xb_xcc_id(); b.st = st;
    if (threadIdx.x == 0) (void)xb_add(&bar[XB_XCNT(b.x)], 1u);
    return b;
}
__device__ __forceinline__ void xcd_barrier_complete(unsigned* bar, unsigned x, unsigned& nloc, unsigned& nx) {
    const unsigned G = gridDim.x * gridDim.y * gridDim.z;
    unsigned sum, cnt, mine, sp = 0u;
    for (;;) {
        sum = 0u; cnt = 0u; mine = 0u;
#pragma unroll
        for (unsigned j = 0; j < 16; ++j) { const unsigned c = xb_ld(&bar[XB_XCNT(j)]); sum += c; cnt += (c > 0u) ? 1u : 0u; mine = (j == x) ? c : mine; }
        if (sum == G) break;
        __builtin_amdgcn_s_sleep(1);
        if ((++sp & 255u) == 0u) { if (xb_ld(&bar[XB_TMO])) break; if (sp > XB_SPIN_CAP) { atomicAdd(&bar[XB_TMO], 1u); break; } }
    }
    nloc = mine > 0u ? mine : 1u; nx = cnt > 0u ? cnt : 1u;
}
__device__ __forceinline__ void xcd_barrier(const XcdBarrier& b) {
    asm volatile("s_waitcnt vmcnt(0)" ::: "memory");
    __syncthreads();
    if (threadIdx.x == 0) {
        unsigned* bar = b.bar;
        __builtin_amdgcn_s_waitcnt(0);
        unsigned nloc = b.st[0], nx = b.st[1];
        if (nloc == 0u) { xcd_barrier_complete(bar, b.x, nloc, nx); b.st[0] = nloc; b.st[1] = nx; }
        const unsigned old = xb_add(&bar[XB_XSUB(b.x)], 1u);
        const unsigned gen = old / nloc;
        if (old + 1u == (gen + 1u) * nloc) {
            __builtin_amdgcn_fence(__ATOMIC_RELEASE, "agent");
            asm volatile("s_waitcnt vmcnt(0)" ::: "memory");
            const unsigned og = xb_add(&bar[XB_TOP], 1u);
            const unsigned tg = og / nx;
            if (og + 1u == (tg + 1u) * nx) xb_add(&bar[XB_TOPGEN], 1u);
            else XB_SPIN(xb_ld(&bar[XB_TOPGEN]) == tg, bar);
            __builtin_amdgcn_fence(__ATOMIC_ACQUIRE, "agent");
            xb_add(&bar[XB_XGEN(b.x)], 1u);
            asm volatile("s_waitcnt vmcnt(0)" ::: "memory");
        } else {
            XB_SPIN(xb_ld(&bar[XB_XGEN(b.x)]) == gen, bar);
            __builtin_amdgcn_fence(__ATOMIC_ACQUIRE, "agent");
            asm volatile("s_waitcnt vmcnt(0)" ::: "memory");
        }
    }
    __syncthreads();
}

struct Args { const void* in[32]; float* out; unsigned char* ws; int ph_lo, ph_hi; };
struct Frame { LAS unsigned char* lds; int tid, lane, wave, vcu, G; const Args* a; };
#define FP_x_prompt ((const float*)F.a->in[0])
#define FP_x_sample ((const float*)F.a->in[1])
#define FP_c_prompt ((const float*)F.a->in[2])
#define FP_c_sample ((const float*)F.a->in[3])
#define FP_cache_k ((const float*)F.a->in[4])
#define FP_cache_v ((const float*)F.a->in[5])
#define FP_page_table ((const int*)F.a->in[6])
#define FP_state_C ((const float*)F.a->in[7])
#define FP_state_n ((const float*)F.a->in[8])
#define FP_state_m ((const float*)F.a->in[9])
#define FP_state_conv ((const float*)F.a->in[10])
#define FP_w_ada ((const float*)F.a->in[11])
#define FP_b_ada ((const float*)F.a->in[12])
#define FP_g_pre_mix ((const float*)F.a->in[13])
#define FP_g_post_mix ((const float*)F.a->in[14])
#define FP_w_in ((const float*)F.a->in[15])
#define FP_b_if ((const float*)F.a->in[16])
#define FP_g_mlstm ((const float*)F.a->in[17])
#define FP_lq1 ((const float*)F.a->in[18])
#define FP_lk1 ((const float*)F.a->in[19])
#define FP_lq2 ((const float*)F.a->in[20])
#define FP_lk2 ((const float*)F.a->in[21])
#define FP_g_diff ((const float*)F.a->in[22])
#define FP_w_proj_m ((const float*)F.a->in[23])
#define FP_w_proj_d ((const float*)F.a->in[24])
#define FP_w_out ((const float*)F.a->in[25])
#define FP_g_pre_ffn ((const float*)F.a->in[26])
#define FP_g_post_ffn ((const float*)F.a->in[27])
#define FP_w_up ((const float*)F.a->in[28])
#define FP_conv_w ((const float*)F.a->in[29])
#define FP_conv_b ((const float*)F.a->in[30])
#define FP_w_down ((const float*)F.a->in[31])
#define FP_WinT ((bf16_t*)(F.a->ws + WS_WIN))
#define FP_WupT ((bf16_t*)(F.a->ws + WS_WUP))
#define FP_WdownT ((bf16_t*)(F.a->ws + WS_WDOWN))
#define FP_WoutT ((bf16_t*)(F.a->ws + WS_WOUT))
#define FP_WpmT ((bf16_t*)(F.a->ws + WS_WPM))
#define FP_WpdT ((bf16_t*)(F.a->ws + WS_WPD))
#define FP_H1 ((bf16_t*)(F.a->ws + WS_H1))
#define FP_Z ((bf16_t*)(F.a->ws + WS_Z))
#define FP_CPREV ((bf16_t*)(F.a->ws + WS_CPREV))
#define FP_HM ((bf16_t*)(F.a->ws + WS_HM))
#define FP_HD ((bf16_t*)(F.a->ws + WS_HD))
#define FP_MG ((bf16_t*)(F.a->ws + WS_MG))
#define FP_UA ((bf16_t*)(F.a->ws + WS_UA))
#define FP_UB ((bf16_t*)(F.a->ws + WS_UB))
#define FP_GB ((bf16_t*)(F.a->ws + WS_G))
#define FP_ADA ((float*)(F.a->ws + WS_ADA))
#define FP_IG ((float*)(F.a->ws + WS_IG))
#define FP_LF ((float*)(F.a->ws + WS_LF))
#define FP_ST ((float*)(F.a->ws + WS_ST))
#define FP_NU ((float*)(F.a->ws + WS_NU))
#define FP_NPREV ((float*)(F.a->ws + WS_NPREV))
#define FP_MPREV ((float*)(F.a->ws + WS_MPREV))
#define FP_U ((float*)(F.a->ws + WS_U))
#define FP_O1 ((float*)(F.a->ws + WS_O1))
#define FP_O2 ((float*)(F.a->ws + WS_O2))
#define FP_Y ((float*)(F.a->ws + WS_Y))
#define FP_out (F.a->out)


__device__ __forceinline__ void transpose_item(const float* W, int pitch, int scol0, int K, bf16_t* WT, int drow0, LAS float* scr, int kb, int nb, int lane) {
    const int k0 = 64 * kb, n0 = 32 * nb;
#pragma unroll 8
    for (int i = 0; i < 32; ++i) { const int kk = 2 * i + (lane >> 5); scr[kk * 33 + (lane & 31)] = W[(size_t)(k0 + kk) * pitch + scol0 + n0 + (lane & 31)]; }
    asm volatile("s_waitcnt lgkmcnt(0)" ::: "memory");
    const int c = lane & 7;
#pragma unroll
    for (int j = 0; j < 4; ++j) { const int n = (lane >> 3) + 8 * j; const LAS float* s = scr + (8 * c) * 33 + n;
        u32x4 o; o.x = pk2(s[0 * 33], s[1 * 33]); o.y = pk2(s[2 * 33], s[3 * 33]); o.z = pk2(s[4 * 33], s[5 * 33]); o.w = pk2(s[6 * 33], s[7 * 33]);
        *(u32x4*)(WT + (size_t)(drow0 + n0 + n) * K + k0 + 8 * c) = o; }
    asm volatile("s_waitcnt lgkmcnt(0)" ::: "memory");
}
__device__ __forceinline__ void p0_transposes(const Frame& F) {
    LAS float* scr = (LAS float*)(F.lds + 40960 + F.wave * 8448);
    const int gw = F.vcu * NWAVES + F.wave, NGW = F.G * NWAVES;
    constexpr int I0 = 16 * 64, I1 = 16 * 112, I2 = 8 * 32, I3 = 8 * 32, I4 = 16 * 32, I5 = 16 * 176, I6 = 44 * 32;
    constexpr int NITEMS = I0 + I1 + I2 + I3 + I4 + I5 + I6;
    for (int it = gw; it < NITEMS; it += NGW) {
        int r = it;
        if (r < I0) { transpose_item(FP_w_in, DIN, 0, 1024, FP_WinT, 0, scr, r / 64, r % 64, F.lane); continue; } r -= I0;
        if (r < I1) { transpose_item(FP_w_in, DIN, 2056, 1024, FP_WinT, 2048, scr, r / 112, r % 112, F.lane); continue; } r -= I1;
        if (r < I2) { transpose_item(FP_w_proj_m, 1024, 0, 512, FP_WpmT, 0, scr, r / 32, r % 32, F.lane); continue; } r -= I2;
        if (r < I3) { transpose_item(FP_w_proj_d, 1024, 0, 512, FP_WpdT, 0, scr, r / 32, r % 32, F.lane); continue; } r -= I3;
        if (r < I4) { transpose_item(FP_w_out, 1024, 0, 1024, FP_WoutT, 0, scr, r / 32, r % 32, F.lane); continue; } r -= I4;
        if (r < I5) { transpose_item(FP_w_up, 2 * DFF, 0, 1024, FP_WupT, 0, scr, r / 176, r % 176, F.lane); continue; } r -= I5;
        transpose_item(FP_w_down, 1024, 0, DFF, FP_WdownT, 0, scr, r / 32, r % 32, F.lane);
    }
}
__device__ __forceinline__ void p0_ada(const Frame& F) {
    const int lane = F.lane, r = lane & 31, h = lane >> 5, w = F.wave;
    LAS float* part = (LAS float*)F.lds;
    for (int task = F.vcu; task < 192; task += F.G) {
        const int n0 = 32 * task;
        bf16x8 bw[8];
#pragma unroll
        for (int ks = 0; ks < 8; ++ks) { const float* p = FP_w_ada + (size_t)(128 * w + 16 * ks + 8 * h) * 6144 + n0 + r;
            f32x4 a, b; a.x = p[0]; a.y = p[6144]; a.z = p[2 * 6144]; a.w = p[3 * 6144]; b.x = p[4 * 6144]; b.y = p[5 * 6144]; b.z = p[6 * 6144]; b.w = p[7 * 6144]; bw[ks] = pack8(a, b); }
        for (int rt = 0; rt < 5; ++rt) {
            const int R = 32 * rt + r;
            const float* cr = R < 2 ? FP_c_prompt + (size_t)R * 1024 : FP_c_sample + (size_t)(R < 130 ? R - 2 : 0) * 1024;
            f32x16 acc; for (int i = 0; i < 16; ++i) acc[i] = 0.f;
#pragma unroll
            for (int ks = 0; ks < 8; ++ks) { f32x4 a = *(const f32x4*)(cr + 128 * w + 16 * ks + 8 * h), b = *(const f32x4*)(cr + 128 * w + 16 * ks + 8 * h + 4);
                if (R >= 130) { a = (f32x4){0.f, 0.f, 0.f, 0.f}; b = a; }
                acc = MFMA32(pack8(a, b), bw[ks], acc); }
#pragma unroll
            for (int i = 0; i < 16; ++i) part[(w * 32 + crow(i, h)) * 32 + r] = acc[i];
            WG_BAR();
#pragma unroll
            for (int k = 0; k < 2; ++k) { const int idx = F.tid + 512 * k, row = idx >> 5, col = idx & 31; float s = 0.f;
#pragma unroll
                for (int ww = 0; ww < 8; ++ww) s += part[(ww * 32 + row) * 32 + col];
                const int Rr = 32 * rt + row; if (Rr < 130) FP_ADA[(size_t)Rr * 6144 + n0 + col] = s + FP_b_ada[n0 + col]; }
            WG_BAR();
        }
    }
}
__device__ __forceinline__ int crow_of(int m) { return m < MP ? (m >> 13) : 2 + ((m - MP) >> 2); }
__device__ __forceinline__ const float* xrow_of(const Frame& F, int m) { return m < MP ? FP_x_prompt + (size_t)m * DM : FP_x_sample + (size_t)(m - MP) * DM; }
__device__ __forceinline__ void p1_norm_gates(const Frame& F) {
    LAS float* wg = (LAS float*)F.lds;
    for (int i = F.tid; i < 8192; i += NTHR) { const int k = i >> 3, g = i & 7; wg[g * 1024 + k] = FP_w_in[(size_t)k * DIN + 2048 + g]; }
    WG_BAR();
    const int lane = F.lane, gw = F.vcu * NWAVES + F.wave, NGW = F.G * NWAVES;
    const int r_lo = (int)(((long)gw * MT) / NGW), r_hi = (int)(((long)(gw + 1) * MT) / NGW);
    f32x4 gp[4], gs[4], sh[4], vn[4];
#pragma unroll
    for (int j = 0; j < 4; ++j) { gp[j] = *(const f32x4*)(FP_g_pre_mix + 4 * lane + 256 * j); gs[j] = gp[j]; sh[j] = gp[j]; vn[j] = gp[j]; }
    int ccur = -1;
    if (r_lo < r_hi) { const float* xr = xrow_of(F, r_lo);
#pragma unroll
        for (int j = 0; j < 4; ++j) vn[j] = *(const f32x4*)(xr + 4 * lane + 256 * j); }
    for (int m = r_lo; m < r_hi; ++m) {
        f32x4 v[4]; float ss = 0.f;
#pragma unroll
        for (int j = 0; j < 4; ++j) v[j] = vn[j];
        if (m + 1 < r_hi) { const float* xr = xrow_of(F, m + 1);
#pragma unroll
            for (int j = 0; j < 4; ++j) vn[j] = *(const f32x4*)(xr + 4 * lane + 256 * j); }
        const int cr = crow_of(m);
        if (cr != ccur) { ccur = cr; const float* ada = FP_ADA + (size_t)cr * 6144;
#pragma unroll
            for (int j = 0; j < 4; ++j) { sh[j] = *(const f32x4*)(ada + 4 * lane + 256 * j); gs[j] = gp[j] * (*(const f32x4*)(ada + 1024 + 4 * lane + 256 * j) + 1.f); } }
#pragma unroll
        for (int j = 0; j < 4; ++j) ss += (v[j].x * v[j].x + v[j].y * v[j].y) + (v[j].z * v[j].z + v[j].w * v[j].w);
        const float rs = rsqrtf(wave_sum(ss) * (1.f / DM) + EPS);
        float gd[8];
#pragma unroll
        for (int g = 0; g < 8; ++g) gd[g] = 0.f;
#pragma unroll
        for (int j = 0; j < 4; ++j) { const f32x4 hv = (v[j] * rs) * gs[j] + sh[j];
#pragma unroll
            for (int g = 0; g < 8; ++g) { const f32x4 wv = *(const LAS f32x4*)(wg + g * 1024 + 4 * lane + 256 * j); gd[g] += (hv.x * wv.x + hv.y * wv.y) + (hv.z * wv.z + hv.w * wv.w); }
            u32x2 o; o.x = pk2(hv.x, hv.y); o.y = pk2(hv.z, hv.w); *(u32x2*)(FP_H1 + (size_t)m * DM + 4 * lane + 256 * j) = o; }
#pragma unroll
        for (int g = 0; g < 8; ++g) gd[g] = wave_sum(gd[g]);
        if (lane == 0) { const f32x4 bi = *(const f32x4*)FP_b_if, bf = *(const f32x4*)(FP_b_if + 4);
            *(f32x4*)(FP_IG + (size_t)m * 4) = (f32x4){gd[0] + bi.x, gd[1] + bi.y, gd[2] + bi.z, gd[3] + bi.w};
            *(f32x4*)(FP_LF + (size_t)m * 4) = (f32x4){log_sigmoid(gd[4] + bf.x), log_sigmoid(gd[5] + bf.y), log_sigmoid(gd[6] + bf.z), log_sigmoid(gd[7] + bf.w)}; }
    }
}
struct EpiZ {
    bf16_t* Z; float* out;
    __device__ __forceinline__ void st8(int row, int col, f32x4 v0, f32x4 v1) const {
        const int pn = col >> 8; const float sc = (pn == 2 || pn == 3) ? KSCALE : ((pn == 8 || pn == 9) ? QSCALE : 1.f);
        if (pn >= 10 && pn < 14) { const int kv = pn >= 12; const int c = col - (kv ? ZDV : ZDK);
            float* o = row < MP ? out + (kv ? OFF_VP : OFF_KP) + (size_t)row * 512 + c : out + (kv ? OFF_VS : OFF_KS) + (size_t)(row - MP) * 512 + c;
            *(f32x4*)o = v0; *(f32x4*)(o + 4) = v1; }
        *(bf16x8*)(Z + (size_t)row * ZP + col) = pack8(v0 * sc, v1 * sc);
    }
};
struct EpiPM {
    const bf16_t* Z; bf16_t* MG;
    __device__ __forceinline__ void st4(int row, int col, f32x4 v) const {
        const u32x2 g = *(const u32x2*)(Z + (size_t)row * ZP + ZGM + col);
        u32x2 o; o.x = pk2(sigmoidf_(bflo(g.x)) * v.x, sigmoidf_(bfhi(g.x)) * v.y); o.y = pk2(sigmoidf_(bflo(g.y)) * v.z, sigmoidf_(bfhi(g.y)) * v.w);
        *(u32x2*)(MG + (size_t)row * DM + col) = o; }
    __device__ __forceinline__ void st8(int row, int col, f32x4 v0, f32x4 v1) const { st4(row, col, v0); st4(row, col + 4, v1); }
};
struct EpiPD {
    const bf16_t* Z; bf16_t* MG;
    __device__ __forceinline__ void st4(int row, int col, f32x4 v) const {
        const u32x2 g = *(const u32x2*)(Z + (size_t)row * ZP + ZGD + col); const u32x2 p = *(const u32x2*)(MG + (size_t)row * DM + col);
        u32x2 o; o.x = pk2(bflo(p.x) + sigmoidf_(bflo(g.x)) * v.x, bfhi(p.x) + sigmoidf_(bfhi(g.x)) * v.y); o.y = pk2(bflo(p.y) + sigmoidf_(bflo(g.y)) * v.z, bfhi(p.y) + sigmoidf_(bfhi(g.y)) * v.w);
        *(u32x2*)(MG + (size_t)row * DM + col) = o; }
    __device__ __forceinline__ void st8(int row, int col, f32x4 v0, f32x4 v1) const { st4(row, col, v0); st4(row, col + 4, v1); }
};
struct EpiF32 {
    float* Y;
    __device__ __forceinline__ void st4(int row, int col, f32x4 v) const { *(f32x4*)(Y + (size_t)row * DM + col) = v; }
    __device__ __forceinline__ void st8(int row, int col, f32x4 v0, f32x4 v1) const { st4(row, col, v0); st4(row, col + 4, v1); }
};
struct EpiUp {
    bf16_t* UA; bf16_t* UB; float* out;
    __device__ __forceinline__ void st8(int row, int col, f32x4 v0, f32x4 v1) const {
        if (col < DFF) {
            *(bf16x8*)(UA + (size_t)row * DFF + col) = pack8(v0, v1);
            if (row < MP) { const int t = row & (TP - 1); if (t >= TP - 2) { float* o = out + OFF_CVP + ((size_t)(row >> 13) * 2 + (t - (TP - 2))) * DFF + col; *(f32x4*)o = v0; *(f32x4*)(o + 4) = v1; } }
            else { const int t = (row - MP) & 3; if (t >= 2) { float* o = out + OFF_CVS + ((size_t)((row - MP) >> 2) * 2 + (t - 2)) * DFF + col; *(f32x4*)o = v0; *(f32x4*)(o + 4) = v1; } }
        } else *(bf16x8*)(UB + (size_t)row * DFF + (col - DFF)) = pack8(v0, v1);
    }
};
template <class Epi>
__device__ __forceinline__ void skinny_gemm(const Frame& F, const bf16_t* A, const bf16_t* Bt, int K, const Epi& E) {
    const int lane = F.lane, r = lane & 31, h = lane >> 5, ct = F.wave & 1, kq = F.wave >> 1, Kq = K >> 2;
    LAS float* part = (LAS float*)F.lds;
    for (int task = F.vcu; task < 256; task += F.G) {
        const int rt = task >> 4, cg = task & 15;
        const bf16_t* ap = A + (size_t)(32 * rt + r) * K + kq * Kq + 8 * h;
        const bf16_t* bp = Bt + (size_t)(64 * cg + 32 * ct + r) * K + kq * Kq + 8 * h;
        f32x16 acc; for (int i = 0; i < 16; ++i) acc[i] = 0.f;
#pragma unroll 4
        for (int s = 0; s < Kq / 16; ++s) { const bf16x8 a = *(const bf16x8*)(ap + 16 * s), b = *(const bf16x8*)(bp + 16 * s); acc = MFMA32(b, a, acc); }
#pragma unroll
        for (int g4 = 0; g4 < 4; ++g4) *(LAS f32x4*)(part + (kq * 32 + r) * 68 + 32 * ct + 8 * g4 + 4 * h) = (f32x4){acc[4 * g4], acc[4 * g4 + 1], acc[4 * g4 + 2], acc[4 * g4 + 3]};
        WG_BAR();
        { const int row = F.tid >> 4, c4 = (F.tid & 15) * 4;
          f32x4 s = *(const LAS f32x4*)(part + row * 68 + c4) + *(const LAS f32x4*)(part + (32 + row) * 68 + c4) + *(const LAS f32x4*)(part + (64 + row) * 68 + c4) + *(const LAS f32x4*)(part + (96 + row) * 68 + c4);
          E.st4(MP + 32 * rt + row, 64 * cg + c4, s); }
        WG_BAR();
    }
}

constexpr int VROW = 320;
__device__ __forceinline__ void mlstm_A_unit(const Frame& F, int u) {
    const int bh = u >> 7, c = u & 127, b = bh >> 2, h = bh & 3, m0 = b * TP + c * 64;
    const int tid = F.tid, lane = F.lane, wid = F.wave;
    LAS unsigned char* Vt = F.lds; LAS unsigned char* Kt = F.lds + 20480; LAS float* wl = (LAS float*)(F.lds + 40960);
    if (wid == 0) {
        const float lf = FP_LF[(size_t)(m0 + lane) * 4 + h], ig = FP_IG[(size_t)(m0 + lane) * 4 + h];
        const float Fc = wave_scan_sum(lf, lane), a = ig - Fc, Ac = wave_scan_max(a, lane);
        const float Mloc = __shfl(Ac, 63), Fsum = __shfl(Fc, 63);
        wl[lane] = __expf(a - Mloc);
        if (lane == 0) { FP_ST[2 * u] = Fsum; FP_ST[2 * u + 1] = Mloc; }
    }
    WG_BAR();
#pragma unroll
    for (int i = 0; i < 2; ++i) { const int idx = tid + 512 * i, row = idx >> 4, ch = idx & 15;
        const bf16_t* src = FP_Z + (size_t)(m0 + row) * ZP + h * 128 + ch * 8;
        const u32x4 vv = *(const u32x4*)(src + ZV); const u32x4 kk = *(const u32x4*)(src + ZK);
        f32x4 k0, k1; unpack8(kk, k0, k1); const float w = wl[row];
        *(LAS u32x4*)(Vt + row * VROW + ch * 16) = vv;
        *(LAS bf16x8*)(Kt + row * VROW + ch * 16) = pack8(k0 * w, k1 * w); }
    WG_BAR();
    if (tid < 128) { float s = 0.f;
#pragma unroll 8
        for (int row = 0; row < 64; ++row) s += bf2f(*(const LAS bf16_t*)(Kt + row * VROW + tid * 2));
        FP_NU[(size_t)u * 128 + tid] = s; }
    {
        const int r32 = lane & 31, hi = lane >> 5, vh = (lane >> 4) & 1, q4 = (lane & 15) >> 2, p = lane & 3;
        const int vt = wid >> 1, dt0 = 2 * (wid & 1);
        const int lbase = (8 * hi + q4) * VROW + (16 * vh + 4 * p) * 2;
        f32x16 acc0, acc1; for (int i = 0; i < 16; ++i) { acc0[i] = 0.f; acc1[i] = 0.f; }
#pragma unroll
        for (int st = 0; st < 4; ++st) {
            const LAS unsigned char* va = Vt + lbase + st * 16 * VROW + vt * 64;
            const bf16x8 af = cat4(tr_rd(va), tr_rd(va + 4 * VROW));
            const LAS unsigned char* ka = Kt + lbase + st * 16 * VROW + dt0 * 64;
            const bf16x8 b0 = cat4(tr_rd(ka), tr_rd(ka + 4 * VROW)), b1 = cat4(tr_rd(ka + 64), tr_rd(ka + 64 + 4 * VROW));
            acc0 = MFMA32(af, b0, acc0); acc1 = MFMA32(af, b1, acc1);
        }
        float* Uo = FP_U + (size_t)u * 16384;
#pragma unroll
        for (int i = 0; i < 16; ++i) { const int v = 32 * vt + crow(i, hi); Uo[v * 128 + 32 * dt0 + r32] = acc0[i]; Uo[v * 128 + 32 * dt0 + 32 + r32] = acc1[i]; }
    }
    WG_BAR();
}
__device__ __forceinline__ void smlstm_unit(const Frame& F, int u) {
    const int n = u >> 2, h = u & 3, tid = F.tid, lane = F.lane, wid = F.wave;
    const int mrow = MP + 4 * n;
    LAS float* qs = (LAS float*)F.lds; LAS float* ks = qs + 512; LAS float* vs = ks + 512; LAS float* numI = vs + 512; LAS float* Sm = numI + 512; LAS float* nq = Sm + 16; LAS float* red = nq + 4;
    { const int t = tid >> 7, d = tid & 127; const bf16_t* z = FP_Z + (size_t)(mrow + t) * ZP + h * 128 + d;
      qs[tid] = bf2f(z[ZQ]); ks[tid] = bf2f(z[ZK]); vs[tid] = bf2f(z[ZV]); }
    LAS float* gl = red + 8;
    const float m0 = FP_state_m[n * 4 + h];
    if (tid < 4) { float cum = 0.f, am = -INFINITY, at = 0.f;
      for (int t = 0; t <= tid; ++t) { cum += FP_LF[(size_t)(mrow + t) * 4 + h]; at = FP_IG[(size_t)(mrow + t) * 4 + h] - cum; am = fmaxf(am, at); }
      const float mxv = fmaxf(m0, am);
      gl[tid] = cum; gl[4 + tid] = at; gl[8 + tid] = mxv; gl[12 + tid] = __expf(m0 - mxv); gl[16 + tid] = cum + mxv; }
    WG_BAR();
    const float m_end = gl[19], Fend = gl[3], decay = __expf(Fend + m0 - m_end);
    const float wend0 = __expf(Fend + gl[4] - m_end), wend1 = __expf(Fend + gl[5] - m_end), wend2 = __expf(Fend + gl[6] - m_end), wend3 = __expf(Fend + gl[7] - m_end);
#pragma unroll
    for (int k = 0; k < 2; ++k) { const int pid = 2 * wid + k, t = pid >> 2, s = pid & 3;
        float d = qs[t * 128 + lane] * ks[s * 128 + lane] + qs[t * 128 + 64 + lane] * ks[s * 128 + 64 + lane]; d = wave_sum(d);
        if (lane == 0) Sm[pid] = (s <= t) ? d * __expf(gl[4 + s] - gl[8 + t]) : 0.f; }
    if (wid < 4) { const float* n0 = FP_state_n + (size_t)u * 128; float d = n0[lane] * qs[wid * 128 + lane] + n0[64 + lane] * qs[wid * 128 + 64 + lane]; d = wave_sum(d); if (lane == 0) nq[wid] = d; }
    { const int vrow = tid >> 2, dq = tid & 3;
      const float* c0 = FP_state_C + ((size_t)u * 128 + vrow) * 128 + 32 * dq; float* co = FP_out + OFF_CS + ((size_t)u * 128 + vrow) * 128 + 32 * dq;
      f32x4 cv[8];
#pragma unroll
      for (int i = 0; i < 8; ++i) cv[i] = *(const f32x4*)(c0 + 4 * i);
      float ps[4]; float coef[4];
      ps[0] = 0.f; ps[1] = 0.f; ps[2] = 0.f; ps[3] = 0.f;
      coef[0] = wend0 * vs[vrow]; coef[1] = wend1 * vs[128 + vrow]; coef[2] = wend2 * vs[256 + vrow]; coef[3] = wend3 * vs[384 + vrow];
#pragma unroll
      for (int i = 0; i < 8; ++i) { f32x4 cn = cv[i] * decay;
#pragma unroll
          for (int t = 0; t < 4; ++t) { const f32x4 qv = *(const LAS f32x4*)(qs + t * 128 + 32 * dq + 4 * i), kv = *(const LAS f32x4*)(ks + t * 128 + 32 * dq + 4 * i);
              ps[t] += (cv[i].x * qv.x + cv[i].y * qv.y) + (cv[i].z * qv.z + cv[i].w * qv.w); cn += kv * coef[t]; }
          *(f32x4*)(co + 4 * i) = cn; }
#pragma unroll
      for (int t = 0; t < 4; ++t) { ps[t] += __shfl_xor(ps[t], 1); ps[t] += __shfl_xor(ps[t], 2); if (dq == 0) numI[t * 128 + vrow] = ps[t]; } }
    WG_BAR();
    { const int t = tid >> 7, v = tid & 127;
      const float it = gl[12 + t], mtt = gl[16 + t];
      float num = it * numI[tid], den = it * nq[t];
#pragma unroll
      for (int s = 0; s < 4; ++s) { const float sv = Sm[t * 4 + s]; num += sv * vs[s * 128 + v]; den += sv; }
      const float hval = num / fmaxf(fabsf(den), __expf(-mtt));
      const float ssw = wave_sum(hval * hval); if (lane == 0) red[wid] = ssw;
      WG_BAR();
      const float rms = rsqrtf((red[2 * t] + red[2 * t + 1]) * (1.f / 128.f) + EPS);
      const float mo = bf2f(FP_Z[(size_t)(mrow + t) * ZP + ZO + h * 128 + v]);
      FP_HM[(size_t)(mrow + t) * 512 + h * 128 + v] = f2bf(hval * rms * FP_g_mlstm[h * 128 + v] * sigmoidf_(mo));
      if (tid < 128) { const float n0v = FP_state_n[(size_t)u * 128 + tid]; float nn = decay * n0v;
          nn += wend0 * ks[tid] + wend1 * ks[128 + tid] + wend2 * ks[256 + tid] + wend3 * ks[384 + tid];
          FP_out[OFF_NS + (size_t)u * 128 + tid] = nn; }
      if (tid == 0) FP_out[OFF_MS + u] = m_end; }
    WG_BAR();
}
__device__ __forceinline__ void mlstm_scan_item(const Frame& F, int item) {
    const int bh = item >> 5, j = item & 31, e = 512 * j + F.tid; const bool nthr = (j == 0 && F.tid < 128);
    float C = 0.f, m = 0.f, nacc = 0.f;
    const float* Ub = FP_U + (size_t)bh * 128 * 16384 + e; bf16_t* Cp = FP_CPREV + (size_t)bh * 128 * 16384 + e;
    for (int c0 = 0; c0 < 128; c0 += 32) {
        float uu[32], un[32];
#pragma unroll
        for (int i = 0; i < 32; ++i) { uu[i] = Ub[(size_t)(c0 + i) * 16384]; un[i] = nthr ? FP_NU[(size_t)(bh * 128 + c0 + i) * 128 + F.tid] : 0.f; }
#pragma unroll
        for (int i = 0; i < 32; ++i) { const int c = c0 + i; const float fs = FP_ST[2 * (bh * 128 + c)], ml = FP_ST[2 * (bh * 128 + c) + 1];
            Cp[(size_t)c * 16384] = f2bf(C);
            if (nthr) FP_NPREV[(size_t)(bh * 128 + c) * 128 + F.tid] = nacc;
            if (j == 0 && F.tid == 0) FP_MPREV[bh * 128 + c] = m;
            const float mn = fs + fmaxf(m, ml), dec = __expf(fs + m - mn), sc = __expf(fs + ml - mn);
            C = dec * C + sc * uu[i]; nacc = dec * nacc + sc * un[i]; m = mn; }
    }
    FP_out[OFF_CP + (size_t)bh * 16384 + e] = C;
    if (nthr) FP_out[OFF_NP + bh * 128 + F.tid] = nacc;
    if (j == 0 && F.tid == 0) FP_out[OFF_MP + bh] = m;
}
__device__ __forceinline__ void mlstm_C_unit(const Frame& F, int u) {
    const int bh = u >> 7, c = u & 127, b = bh >> 2, h = bh & 3, m0 = b * TP + c * 64;
    const int tid = F.tid, lane = F.lane, wid = F.wave, r32 = lane & 31, hi = lane >> 5;
    LAS unsigned char* Vt = F.lds; LAS float* Fa = (LAS float*)(F.lds + 20480); LAS float* aa = Fa + 64; LAS float* Aa = aa + 64; LAS float* dqp = Aa + 64;   LAS float* ssq = dqp + 512;
    if (wid == 0) {
        const float lf = FP_LF[(size_t)(m0 + lane) * 4 + h], ig = FP_IG[(size_t)(m0 + lane) * 4 + h];
        const float Fc = wave_scan_sum(lf, lane), a = ig - Fc, Ac = wave_scan_max(a, lane);
        Fa[lane] = Fc; aa[lane] = a; Aa[lane] = Ac;
    }
#pragma unroll
    for (int i = 0; i < 2; ++i) { const int idx = tid + 512 * i, row = idx >> 4, ch = idx & 15;
        *(LAS u32x4*)(Vt + row * VROW + ch * 16) = *(const u32x4*)(FP_Z + (size_t)(m0 + row) * ZP + ZV + h * 128 + ch * 8); }
    { const int t = tid & 63, part = tid >> 6; const bf16_t* qp = FP_Z + (size_t)(m0 + t) * ZP + ZQ + h * 128 + 16 * part; const float* np = FP_NPREV + (size_t)u * 128 + 16 * part;
      f32x4 q0, q1, q2, q3; unpack8(*(const u32x4*)qp, q0, q1); unpack8(*(const u32x4*)(qp + 8), q2, q3);
      const f32x4 n0 = *(const f32x4*)np, n1 = *(const f32x4*)(np + 4), n2 = *(const f32x4*)(np + 8), n3 = *(const f32x4*)(np + 12);
      const f32x4 s = q0 * n0 + q1 * n1 + q2 * n2 + q3 * n3; dqp[part * 64 + t] = (s.x + s.y) + (s.z + s.w); }
    WG_BAR();
    const int vt = wid & 3, tt = wid >> 2, t = 32 * tt + r32;
    const float mprev = FP_MPREV[u];
    const float Ft = Fa[t], At = Aa[t], mxt = fmaxf(mprev, At), mt = Ft + mxt, inter = __expf(mprev - mxt);
    bf16x8 qf[8];
    { const bf16_t* qp = FP_Z + (size_t)(m0 + t) * ZP + ZQ + h * 128 + 8 * hi;
#pragma unroll
      for (int st = 0; st < 8; ++st) qf[st] = *(const bf16x8*)(qp + 16 * st); }
    f32x16 acc; for (int i = 0; i < 16; ++i) acc[i] = 0.f;
    { const bf16_t* cp = FP_CPREV + (size_t)u * 16384 + (size_t)(32 * vt + r32) * 128 + 8 * hi;
#pragma unroll
      for (int st = 0; st < 8; ++st) acc = MFMA32(*(const bf16x8*)(cp + 16 * st), qf[st], acc); }
#pragma unroll
    for (int i = 0; i < 16; ++i) acc[i] *= inter;
    float den = 0.f;
    const int vh = (lane >> 4) & 1, q4 = (lane & 15) >> 2, p = lane & 3;
    const int lbase = (4 * hi + q4) * VROW + (32 * vt + 16 * vh + 4 * p) * 2;
    for (int sub = 0; sub <= tt; ++sub) {
        f32x16 sacc; for (int i = 0; i < 16; ++i) sacc[i] = 0.f;
        { const bf16_t* kp = FP_Z + (size_t)(m0 + 32 * sub + r32) * ZP + ZK + h * 128 + 8 * hi;
#pragma unroll
          for (int st = 0; st < 8; ++st) sacc = MFMA32(*(const bf16x8*)(kp + 16 * st), qf[st], sacc); }
#pragma unroll
        for (int g = 0; g < 4; ++g) { const f32x4 av = *(const LAS f32x4*)(aa + 32 * sub + 8 * g + 4 * hi);
#pragma unroll
            for (int k = 0; k < 4; ++k) { const int s = 32 * sub + 8 * g + 4 * hi + k; const float wgt = (s <= t) ? __expf(av[k] - mxt) : 0.f; const float val = (s <= t) ? sacc[4 * g + k] * wgt : 0.f; sacc[4 * g + k] = val; den += val; } }
#pragma unroll
        for (int s2 = 0; s2 < 2; ++s2) {
            const bf16x8 pb = pack8((f32x4){sacc[8 * s2], sacc[8 * s2 + 1], sacc[8 * s2 + 2], sacc[8 * s2 + 3]}, (f32x4){sacc[8 * s2 + 4], sacc[8 * s2 + 5], sacc[8 * s2 + 6], sacc[8 * s2 + 7]});
            const LAS unsigned char* va = Vt + lbase + (32 * sub + 16 * s2) * VROW;
            acc = MFMA32(cat4(tr_rd(va), tr_rd(va + 8 * VROW)), pb, acc);
        }
    }
    den += __shfl_xor(den, 32);
    float dq = 0.f;
#pragma unroll
    for (int k = 0; k < 8; ++k) dq += dqp[k * 64 + t];
    den += inter * dq;
    const float rden = 1.f / fmaxf(fabsf(den), __expf(-mt));
    float ss = 0.f;
#pragma unroll
    for (int i = 0; i < 16; ++i) { acc[i] *= rden; ss += acc[i] * acc[i]; }
    ss += __shfl_xor(ss, 32);
    if (hi == 0) ssq[vt * 64 + t] = ss;
    WG_BAR();
    const float rms = rsqrtf((ssq[t] + ssq[64 + t] + ssq[128 + t] + ssq[192 + t]) * (1.f / 128.f) + EPS);
#pragma unroll
    for (int g = 0; g < 4; ++g) { const int v = 32 * vt + 8 * g + 4 * hi;
        const f32x4 gv = *(const f32x4*)(FP_g_mlstm + h * 128 + v); const u32x2 mo = *(const u32x2*)(FP_Z + (size_t)(m0 + t) * ZP + ZO + h * 128 + v);
        u32x2 o; o.x = pk2(acc[4 * g] * rms * gv.x * sigmoidf_(bflo(mo.x)), acc[4 * g + 1] * rms * gv.y * sigmoidf_(bfhi(mo.x)));
        o.y = pk2(acc[4 * g + 2] * rms * gv.z * sigmoidf_(bflo(mo.y)), acc[4 * g + 3] * rms * gv.w * sigmoidf_(bfhi(mo.y)));
        *(u32x2*)(FP_HM + (size_t)(m0 + t) * 512 + h * 128 + v) = o; }
    WG_BAR();
}
constexpr int AT_KB = 8320, AT_TILE = 8320 + 20480;
__device__ __forceinline__ void attn_half_unit(const Frame& F, int bh, int qb, int map, float* Odst) {
    const int b = bh >> 2, h = bh & 3, tid = F.tid, lane = F.lane, wid = F.wave, r32 = lane & 31, hi = lane >> 5;
    const int rowbase = b * TP, q0 = qb * 256, qrow = q0 + 32 * wid + r32;
    const bf16_t* Zb = FP_Z + (size_t)rowbase * ZP;
    bf16x8 qf[4];
    { const bf16_t* qp = Zb + (size_t)qrow * ZP + ZDQ + h * 128 + map * 64 + 8 * hi;
#pragma unroll
      for (int st = 0; st < 4; ++st) qf[st] = *(const bf16x8*)(qp + 16 * st); }
    const int NT = 4 * qb + 4;
    const int krow = tid >> 3, kch = tid & 7;
    const bf16_t* ksrc = Zb + (size_t)krow * ZP + ZDK + h * 128 + map * 64 + kch * 8;
    const int kdst = kch * 1040 + krow * 16;
    const int vrow0 = tid >> 4, vch = tid & 15;
    const bf16_t* vsrc = Zb + (size_t)vrow0 * ZP + ZDV + h * 128 + vch * 8;
    const int vdst = AT_KB + vrow0 * VROW + vch * 16;
    u32x4 sk, sv0, sv1;
    sk = *(const u32x4*)ksrc; sv0 = *(const u32x4*)vsrc; sv1 = *(const u32x4*)(vsrc + (size_t)32 * ZP);
    *(LAS u32x4*)(F.lds + kdst) = sk; *(LAS u32x4*)(F.lds + vdst) = sv0; *(LAS u32x4*)(F.lds + vdst + 32 * VROW) = sv1;
    WG_BAR();
    f32x16 o[4];
#pragma unroll
    for (int vt = 0; vt < 4; ++vt) for (int i = 0; i < 16; ++i) o[vt][i] = 0.f;
    float mrun = -1e30f, lrun = 0.f;
    const int vh = (lane >> 4) & 1, q4 = (lane & 15) >> 2, p = lane & 3;
    const int vlane = AT_KB + (4 * hi + q4) * VROW + (16 * vh + 4 * p) * 2;
    const int klane = hi * 1040 + r32 * 16;
    const int wlast = q0 + 32 * wid + 31, wfirst = q0 + 32 * wid;
    for (int j = 0; j < NT; ++j) {
        const int cur = (j & 1) * AT_TILE;
        const bool more = (j + 1 < NT);
        if (more) { const size_t adv = (size_t)(j + 1) * 64 * ZP; sk = *(const u32x4*)(ksrc + adv); sv0 = *(const u32x4*)(vsrc + adv); sv1 = *(const u32x4*)(vsrc + adv + (size_t)32 * ZP); }
        if (64 * j <= wlast) {
            f32x16 p0, p1; for (int i = 0; i < 16; ++i) { p0[i] = 0.f; p1[i] = 0.f; }
            const LAS unsigned char* kb = F.lds + cur + klane;
#pragma unroll
            for (int st = 0; st < 4; ++st) { const bf16x8 k0 = *(const LAS bf16x8*)(kb + st * 2080), k1 = *(const LAS bf16x8*)(kb + st * 2080 + 512);
                p0 = MFMA32(k0, qf[st], p0); p1 = MFMA32(k1, qf[st], p1); }
            if (64 * j + 63 > wfirst) {
#pragma unroll
                for (int i = 0; i < 16; ++i) { const int key = 64 * j + crow(i, hi); if (key > qrow) p0[i] = -INFINITY; if (key + 32 > qrow) p1[i] = -INFINITY; }
            }
            float mx = fmaxf(p0[0], p1[0]);
#pragma unroll
            for (int i = 1; i < 16; ++i) mx = fmaxf(mx, fmaxf(p0[i], p1[i]));
            mx = fmaxf(mx, __shfl_xor(mx, 32));
            const float mnew = fmaxf(mrun, mx);
            if (__any(mnew > mrun)) { const float alpha = __builtin_amdgcn_exp2f(mrun - mnew); lrun *= alpha;
#pragma unroll
                for (int vt = 0; vt < 4; ++vt) for (int i = 0; i < 16; ++i) o[vt][i] *= alpha;
                mrun = mnew; }
            float rsum = 0.f;
#pragma unroll
            for (int i = 0; i < 16; ++i) { p0[i] = __builtin_amdgcn_exp2f(p0[i] - mrun); p1[i] = __builtin_amdgcn_exp2f(p1[i] - mrun); rsum += p0[i] + p1[i]; }
            lrun += rsum;
            const LAS unsigned char* vb = F.lds + cur + vlane;
#pragma unroll
            for (int sub = 0; sub < 2; ++sub) {
#pragma unroll
                for (int s2 = 0; s2 < 2; ++s2) {
                    bf16x8 pb;
                    if (sub == 0) pb = pack8((f32x4){p0[8 * s2], p0[8 * s2 + 1], p0[8 * s2 + 2], p0[8 * s2 + 3]}, (f32x4){p0[8 * s2 + 4], p0[8 * s2 + 5], p0[8 * s2 + 6], p0[8 * s2 + 7]});
                    else          pb = pack8((f32x4){p1[8 * s2], p1[8 * s2 + 1], p1[8 * s2 + 2], p1[8 * s2 + 3]}, (f32x4){p1[8 * s2 + 4], p1[8 * s2 + 5], p1[8 * s2 + 6], p1[8 * s2 + 7]});
                    const LAS unsigned char* va = vb + (32 * sub + 16 * s2) * VROW;
#pragma unroll
                    for (int vt = 0; vt < 4; ++vt) o[vt] = MFMA32(cat4(tr_rd(va + vt * 64), tr_rd(va + vt * 64 + 8 * VROW)), pb, o[vt]);
                }
            }
        }
        if (more) { const int nx = ((j + 1) & 1) * AT_TILE; *(LAS u32x4*)(F.lds + nx + kdst) = sk; *(LAS u32x4*)(F.lds + nx + vdst) = sv0; *(LAS u32x4*)(F.lds + nx + vdst + 32 * VROW) = sv1; }
        WG_BAR();
    }
    lrun += __shfl_xor(lrun, 32);
    const float rl = 1.f / lrun;
    float* op = Odst + (size_t)(rowbase + qrow) * 512 + h * 128 + 4 * hi;
#pragma unroll
    for (int vt = 0; vt < 4; ++vt)
#pragma unroll
        for (int g = 0; g < 4; ++g) *(f32x4*)(op + 32 * vt + 8 * g) = (f32x4){o[vt][4 * g] * rl, o[vt][4 * g + 1] * rl, o[vt][4 * g + 2] * rl, o[vt][4 * g + 3] * rl};
}
__device__ __forceinline__ float lambda_full(const Frame& F, int lane) {
    const float a = wave_sum(FP_lq1[lane] * FP_lk1[lane]), b = wave_sum(FP_lq2[lane] * FP_lk2[lane]);
    return __expf(a) - __expf(b) + LAM_INIT;
}
__device__ __forceinline__ void attn_combine_rows(const Frame& F) {
    const int lane = F.lane, gw = F.vcu * NWAVES + F.wave, NGW = F.G * NWAVES;
    const float lam = lambda_full(F, lane);
    const f32x4 g0 = *(const f32x4*)(FP_g_diff + 8 * lane), g1 = *(const f32x4*)(FP_g_diff + 8 * lane + 4);
    for (int m = gw; m < MP; m += NGW) {
        const float* a = FP_O1 + (size_t)m * 512 + 8 * lane; const float* bb = FP_O2 + (size_t)m * 512 + 8 * lane;
        const f32x4 x0 = *(const f32x4*)a - *(const f32x4*)bb * lam, x1 = *(const f32x4*)(a + 4) - *(const f32x4*)(bb + 4) * lam;
        float ss = (x0.x * x0.x + x0.y * x0.y) + (x0.z * x0.z + x0.w * x0.w) + (x1.x * x1.x + x1.y * x1.y) + (x1.z * x1.z + x1.w * x1.w);
        ss += __shfl_xor(ss, 1); ss += __shfl_xor(ss, 2); ss += __shfl_xor(ss, 4); ss += __shfl_xor(ss, 8);
        const float rms = rsqrtf(ss * (1.f / 128.f) + EPS) * (1.f - LAM_INIT);
        *(bf16x8*)(FP_HD + (size_t)m * 512 + 8 * lane) = pack8(x0 * rms * g0, x1 * rms * g1);
    }
}
constexpr int SB_P = 2064;
__device__ __forceinline__ void decode_unit(const Frame& F, int u, float lam) {
    const int n = u >> 2, h = u & 3, tid = F.tid, lane = F.lane, wid = F.wave;
    const int mrow = MP + 4 * n;
    LAS float* Sbuf = (LAS float*)F.lds;
    LAS float* part = Sbuf + 8 * SB_P;
    LAS float* rlv = part + 8192;
    LAS float* red = rlv + 8;
    const int* pt = FP_page_table + n * NPAGES;
    const int c16 = lane & 15, g = lane >> 4;
    bf16x8 bq[4];
#pragma unroll
    for (int st = 0; st < 4; ++st) { const bool ok = (c16 < 4 && st < 2) || (c16 >= 4 && c16 < 8 && st >= 2);
        const bf16x8 v = *(const bf16x8*)(FP_Z + (size_t)(mrow + (c16 & 3)) * ZP + ZDQ + h * 128 + 32 * st + 8 * g);
        const bf16x8 zz = {0, 0, 0, 0, 0, 0, 0, 0}; bq[st] = ok ? v : zz; }
    {
        const int pg0 = pt[2 * wid], pg1 = pt[2 * wid + 1];
        f32x4 kr[8];
        { const float* kp = FP_cache_k + (((size_t)pg0 * PAGE + c16) * 4 + h) * 128 + 8 * g;
#pragma unroll
          for (int st = 0; st < 4; ++st) { kr[2 * st] = *(const f32x4*)(kp + 32 * st); kr[2 * st + 1] = *(const f32x4*)(kp + 32 * st + 4); } }
        for (int i = 0; i < 16; ++i) {
            bf16x8 af[4];
#pragma unroll
            for (int st = 0; st < 4; ++st) af[st] = pack8(kr[2 * st], kr[2 * st + 1]);
            if (i + 1 < 16) { const int i1 = i + 1; const int pg = (i1 < 8) ? pg0 : pg1; const int tok = 16 * (i1 & 7) + c16;
                const float* kp = FP_cache_k + (((size_t)pg * PAGE + tok) * 4 + h) * 128 + 8 * g;
#pragma unroll
                for (int st = 0; st < 4; ++st) { kr[2 * st] = *(const f32x4*)(kp + 32 * st); kr[2 * st + 1] = *(const f32x4*)(kp + 32 * st + 4); } }
            f32x4 acc = {0.f, 0.f, 0.f, 0.f};
#pragma unroll
            for (int st = 0; st < 4; ++st) acc = MFMA16(af[st], bq[st], acc);
            if (c16 < 8) *(LAS f32x4*)(Sbuf + c16 * SB_P + 256 * wid + 16 * i + 4 * g) = acc;
        }
        if (wid == 0) {
            f32x4 acc = {0.f, 0.f, 0.f, 0.f};
#pragma unroll
            for (int st = 0; st < 4; ++st) { const bf16x8 v = *(const bf16x8*)(FP_Z + (size_t)(mrow + (c16 & 3)) * ZP + ZDK + h * 128 + 32 * st + 8 * g);
                const bf16x8 zz = {0, 0, 0, 0, 0, 0, 0, 0}; const bf16x8 av = (c16 < 4) ? v : zz; acc = MFMA16(av, bq[st], acc); }
            if (g == 0 && c16 < 8) { const int t = c16 & 3; f32x4 m;
                m.x = acc.x; m.y = (1 <= t) ? acc.y : -INFINITY; m.z = (2 <= t) ? acc.z : -INFINITY; m.w = (3 <= t) ? acc.w : -INFINITY;
                *(LAS f32x4*)(Sbuf + c16 * SB_P + PAST) = m; }
        }
    }
    WG_BAR();
    {
        LAS float* col = Sbuf + wid * SB_P; float mx = -INFINITY;
        for (int k = lane; k < PAST + 4; k += 64) mx = fmaxf(mx, col[k]);
        mx = wave_max(mx); float sm = 0.f;
        for (int k = lane; k < PAST + 4; k += 64) { const float pv = __builtin_amdgcn_exp2f(col[k] - mx); col[k] = pv; sm += pv; }
        sm = wave_sum(sm); if (lane == 0) rlv[wid] = 1.f / sm;
    }
    WG_BAR();
    {
        const int hh = lane >> 5, l5 = lane & 31; const int pg = pt[2 * wid + hh];
        const float* vp = FP_cache_v + (((size_t)pg * PAGE) * 4 + h) * 128 + 4 * l5;
        const LAS float* pbase = Sbuf + 256 * wid + 128 * hh;
        f32x4 acc[8];
#pragma unroll
        for (int c = 0; c < 8; ++c) acc[c] = (f32x4){0.f, 0.f, 0.f, 0.f};
        f32x4 vr[4];
#pragma unroll
        for (int kk = 0; kk < 4; ++kk) vr[kk] = *(const f32x4*)(vp + (size_t)kk * 512);
        for (int t4 = 0; t4 < 32; ++t4) {
            f32x4 vc[4];
#pragma unroll
            for (int kk = 0; kk < 4; ++kk) vc[kk] = vr[kk];
            if (t4 + 1 < 32) {
#pragma unroll
                for (int kk = 0; kk < 4; ++kk) vr[kk] = *(const f32x4*)(vp + (size_t)(4 * (t4 + 1) + kk) * 512); }
#pragma unroll
            for (int c = 0; c < 8; ++c) { const f32x4 pp = *(const LAS f32x4*)(pbase + c * SB_P + 4 * t4);
                acc[c] += vc[0] * pp.x + vc[1] * pp.y + vc[2] * pp.z + vc[3] * pp.w; }
        }
        if (wid == 0) {
#pragma unroll
            for (int s = 0; s < 4; ++s) { const u32x2 vv = *(const u32x2*)(FP_Z + (size_t)(mrow + s) * ZP + ZDV + h * 128 + 4 * l5);
                const f32x4 vf = {bflo(vv.x), bfhi(vv.x), bflo(vv.y), bfhi(vv.y)};
#pragma unroll
                for (int c = 0; c < 8; ++c) { const float pp = (hh == 0) ? Sbuf[c * SB_P + PAST + s] : 0.f; acc[c] += vf * pp; } }
        }
#pragma unroll
        for (int c = 0; c < 8; ++c) { acc[c].x += __shfl_xor(acc[c].x, 32); acc[c].y += __shfl_xor(acc[c].y, 32); acc[c].z += __shfl_xor(acc[c].z, 32); acc[c].w += __shfl_xor(acc[c].w, 32);
            if (hh == 0) *(LAS f32x4*)(part + (wid * 8 + c) * 128 + 4 * l5) = acc[c]; }
    }
    WG_BAR();
    { const int t = tid >> 7, v = tid & 127; float o1 = 0.f, o2 = 0.f;
#pragma unroll
      for (int w = 0; w < 8; ++w) { o1 += part[(w * 8 + t) * 128 + v]; o2 += part[(w * 8 + 4 + t) * 128 + v]; }
      const float ov = o1 * rlv[t] - lam * o2 * rlv[4 + t];
      const float ssw = wave_sum(ov * ov); if (lane == 0) red[wid] = ssw;
      WG_BAR();
      const float rms = rsqrtf((red[2 * t] + red[2 * t + 1]) * (1.f / 128.f) + EPS) * (1.f - LAM_INIT);
      FP_HD[(size_t)(mrow + t) * 512 + h * 128 + v] = f2bf(ov * rms * FP_g_diff[h * 128 + v]); }
    WG_BAR();
}
__device__ __forceinline__ void rows_post_mix(const Frame& F) {
    const int lane = F.lane, gw = F.vcu * NWAVES + F.wave, NGW = F.G * NWAVES;
    const int r_lo = (int)(((long)gw * MT) / NGW), r_hi = (int)(((long)(gw + 1) * MT) / NGW);
    f32x4 gpm[4], gpf[4], g1[4], sh2[4], sc2[4], yn[4], xn[4];
#pragma unroll
    for (int j = 0; j < 4; ++j) { gpm[j] = *(const f32x4*)(FP_g_post_mix + 4 * lane + 256 * j); gpf[j] = *(const f32x4*)(FP_g_pre_ffn + 4 * lane + 256 * j); g1[j] = gpm[j]; sh2[j] = gpm[j]; sc2[j] = gpm[j]; yn[j] = gpm[j]; xn[j] = gpm[j]; }
    int ccur = -1;
    if (r_lo < r_hi) { const float* xr = xrow_of(F, r_lo); const float* yr = FP_Y + (size_t)r_lo * DM;
#pragma unroll
        for (int j = 0; j < 4; ++j) { yn[j] = *(const f32x4*)(yr + 4 * lane + 256 * j); xn[j] = *(const f32x4*)(xr + 4 * lane + 256 * j); } }
    for (int m = r_lo; m < r_hi; ++m) {
        f32x4 y[4], x1[4]; float ss = 0.f;
#pragma unroll
        for (int j = 0; j < 4; ++j) { y[j] = yn[j]; x1[j] = xn[j]; }
        if (m + 1 < r_hi) { const float* xr = xrow_of(F, m + 1); const float* yr = FP_Y + (size_t)(m + 1) * DM;
#pragma unroll
            for (int j = 0; j < 4; ++j) { yn[j] = *(const f32x4*)(yr + 4 * lane + 256 * j); xn[j] = *(const f32x4*)(xr + 4 * lane + 256 * j); } }
        const int cr = crow_of(m);
        if (cr != ccur) { ccur = cr; const float* ada = FP_ADA + (size_t)cr * 6144;
#pragma unroll
            for (int j = 0; j < 4; ++j) { const int c = 4 * lane + 256 * j; g1[j] = *(const f32x4*)(ada + 2048 + c) * gpm[j]; sh2[j] = *(const f32x4*)(ada + 3072 + c); sc2[j] = (*(const f32x4*)(ada + 4096 + c) + 1.f) * gpf[j]; } }
#pragma unroll
        for (int j = 0; j < 4; ++j) ss += (y[j].x * y[j].x + y[j].y * y[j].y) + (y[j].z * y[j].z + y[j].w * y[j].w);
        const float rs = rsqrtf(wave_sum(ss) * (1.f / DM) + EPS); float s1 = 0.f;
#pragma unroll
        for (int j = 0; j < 4; ++j) { const int c = 4 * lane + 256 * j;
            x1[j] = x1[j] + g1[j] * (y[j] * rs); *(f32x4*)(FP_out + OFF_Y + (size_t)m * DM + c) = x1[j];
            s1 += (x1[j].x * x1[j].x + x1[j].y * x1[j].y) + (x1[j].z * x1[j].z + x1[j].w * x1[j].w); }
        const float r1 = rsqrtf(wave_sum(s1) * (1.f / DM) + EPS);
#pragma unroll
        for (int j = 0; j < 4; ++j) { const int c = 4 * lane + 256 * j;
            const f32x4 hv = (x1[j] * r1) * sc2[j] + sh2[j]; u32x2 o; o.x = pk2(hv.x, hv.y); o.y = pk2(hv.z, hv.w); *(u32x2*)(FP_H1 + (size_t)m * DM + c) = o; }
    }
}
__device__ __forceinline__ void rows_final(const Frame& F) {
    const int lane = F.lane, gw = F.vcu * NWAVES + F.wave, NGW = F.G * NWAVES;
    const int r_lo = (int)(((long)gw * MT) / NGW), r_hi = (int)(((long)(gw + 1) * MT) / NGW);
    f32x4 gpf[4], g2[4], yn[4], xn[4];
#pragma unroll
    for (int j = 0; j < 4; ++j) { gpf[j] = *(const f32x4*)(FP_g_post_ffn + 4 * lane + 256 * j); g2[j] = gpf[j]; yn[j] = gpf[j]; xn[j] = gpf[j]; }
    int ccur = -1;
    if (r_lo < r_hi) { const float* xr = FP_out + OFF_Y + (size_t)r_lo * DM; const float* yr = FP_Y + (size_t)r_lo * DM;
#pragma unroll
        for (int j = 0; j < 4; ++j) { yn[j] = *(const f32x4*)(yr + 4 * lane + 256 * j); xn[j] = *(const f32x4*)(xr + 4 * lane + 256 * j); } }
    for (int m = r_lo; m < r_hi; ++m) {
        f32x4 y[4], x1[4]; float ss = 0.f;
#pragma unroll
        for (int j = 0; j < 4; ++j) { y[j] = yn[j]; x1[j] = xn[j]; }
        if (m + 1 < r_hi) { const float* xr = FP_out + OFF_Y + (size_t)(m + 1) * DM; const float* yr = FP_Y + (size_t)(m + 1) * DM;
#pragma unroll
            for (int j = 0; j < 4; ++j) { yn[j] = *(const f32x4*)(yr + 4 * lane + 256 * j); xn[j] = *(const f32x4*)(xr + 4 * lane + 256 * j); } }
        const int cr = crow_of(m);
        if (cr != ccur) { ccur = cr; const float* ada = FP_ADA + (size_t)cr * 6144;
#pragma unroll
            for (int j = 0; j < 4; ++j) g2[j] = *(const f32x4*)(ada + 5120 + 4 * lane + 256 * j) * gpf[j]; }
#pragma unroll
        for (int j = 0; j < 4; ++j) ss += (y[j].x * y[j].x + y[j].y * y[j].y) + (y[j].z * y[j].z + y[j].w * y[j].w);
        const float rs = rsqrtf(wave_sum(ss) * (1.f / DM) + EPS);
#pragma unroll
        for (int j = 0; j < 4; ++j) *(f32x4*)(FP_out + OFF_Y + (size_t)m * DM + 4 * lane + 256 * j) = x1[j] + g2[j] * (y[j] * rs);
    }
}
__device__ __forceinline__ float gelu_tanh(float x) { const float u = 1.5957691216057308f * (x + 0.044715f * x * x * x); return x * __builtin_amdgcn_rcpf(1.f + __builtin_amdgcn_exp2f(-u * LOG2E)); }
__device__ __forceinline__ void geglu_hist(const Frame& F, int m, int f0, f32x4& p10, f32x4& p11, f32x4& p20, f32x4& p21) {
    const f32x4 z4 = {0.f, 0.f, 0.f, 0.f};
    if (m < MP) { const int t = m & (TP - 1);
        if (t >= 1) unpack8(*(const u32x4*)(FP_UA + (size_t)(m - 1) * DFF + f0), p10, p11); else { p10 = z4; p11 = z4; }
        if (t >= 2) unpack8(*(const u32x4*)(FP_UA + (size_t)(m - 2) * DFF + f0), p20, p21); else { p20 = z4; p21 = z4; }
    } else { const int t = (m - MP) & 3, n = (m - MP) >> 2; const float* st = FP_state_conv + (size_t)n * 2 * DFF + f0;
        if (t >= 1) unpack8(*(const u32x4*)(FP_UA + (size_t)(m - 1) * DFF + f0), p10, p11); else { p10 = *(const f32x4*)(st + DFF); p11 = *(const f32x4*)(st + DFF + 4); }
        if (t >= 2) unpack8(*(const u32x4*)(FP_UA + (size_t)(m - 2) * DFF + f0), p20, p21);
        else if (t == 1) { p20 = *(const f32x4*)(st + DFF); p21 = *(const f32x4*)(st + DFF + 4); } else { p20 = *(const f32x4*)st; p21 = *(const f32x4*)(st + 4); } }
}
__device__ __forceinline__ void geglu_phase(const Frame& F) {
    constexpr int RB = 66, NBLK = MT / RB;
    if (F.tid >= 352) return;
    const int f0 = 8 * F.tid;
    const f32x4 w00 = *(const f32x4*)(FP_conv_w + f0), w01 = *(const f32x4*)(FP_conv_w + f0 + 4), w10 = *(const f32x4*)(FP_conv_w + DFF + f0), w11 = *(const f32x4*)(FP_conv_w + DFF + f0 + 4),
                w20 = *(const f32x4*)(FP_conv_w + 2 * DFF + f0), w21 = *(const f32x4*)(FP_conv_w + 2 * DFF + f0 + 4), cb0 = *(const f32x4*)(FP_conv_b + f0), cb1 = *(const f32x4*)(FP_conv_b + f0 + 4);
    for (int blk = F.vcu; blk < NBLK; blk += F.G) {
        const int m0 = blk * RB;
        f32x4 p10, p11, p20, p21;
        geglu_hist(F, m0, f0, p10, p11, p20, p21);
        u32x4 qa[4], qb[4];
#pragma unroll
        for (int i = 0; i < 4; ++i) { qa[i] = *(const u32x4*)(FP_UA + (size_t)(m0 + i) * DFF + f0); qb[i] = *(const u32x4*)(FP_UB + (size_t)(m0 + i) * DFF + f0); }
        for (int r0 = 0; r0 < RB; r0 += 4) {
#pragma unroll
            for (int i = 0; i < 4; ++i) {
                const int r = r0 + i;
                if (r < RB) {
                    const int m = m0 + r;
                    f32x4 a0, a1, b0, b1; unpack8(qa[i], a0, a1); unpack8(qb[i], b0, b1);
                    if (r + 4 < RB) { qa[i] = *(const u32x4*)(FP_UA + (size_t)(m + 4) * DFF + f0); qb[i] = *(const u32x4*)(FP_UB + (size_t)(m + 4) * DFF + f0); }
                    const bool seq_start = (m < MP) ? ((m & (TP - 1)) == 0) : (((m - MP) & 3) == 0);
                    if (seq_start && r != 0) geglu_hist(F, m, f0, p10, p11, p20, p21);
                    f32x4 c0 = cb0 + w00 * p20 + w10 * p10 + w20 * a0, c1 = cb1 + w01 * p21 + w11 * p11 + w21 * a1;
                    c0.x = gelu_tanh(c0.x) * b0.x; c0.y = gelu_tanh(c0.y) * b0.y; c0.z = gelu_tanh(c0.z) * b0.z; c0.w = gelu_tanh(c0.w) * b0.w;
                    c1.x = gelu_tanh(c1.x) * b1.x; c1.y = gelu_tanh(c1.y) * b1.y; c1.z = gelu_tanh(c1.z) * b1.z; c1.w = gelu_tanh(c1.w) * b1.w;
                    *(bf16x8*)(FP_GB + (size_t)m * DFF + f0) = pack8(c0, c1);
                    p20 = p10; p21 = p11; p10 = a0; p11 = a1;
                }
            }
        }
    }
}

constexpr int NPHASE = 15;
#ifndef DUPMASK
#define DUPMASK 0
#endif
__global__ void __launch_bounds__(NTHR, 2) fwd_kernel(Args args) {
    extern __shared__ __attribute__((aligned(16))) unsigned char lds_raw[];
    Frame F;
    F.lds = (LAS unsigned char*)lds_raw;
    F.tid = threadIdx.x; F.lane = F.tid & 63; F.wave = __builtin_amdgcn_readfirstlane(F.tid >> 6);
    F.G = gridDim.x; { const int bx = blockIdx.x; F.vcu = (F.G % 8 == 0) ? (bx % 8) * (F.G / 8) + bx / 8 : bx; }
    F.a = &args; unsigned char* ws = args.ws;
    volatile LAS unsigned* MISC = (volatile LAS unsigned*)(F.lds + MISC_OFF);
    for (int u = F.tid; u < (LDS_BYTES - RING_BYTES) / 4; u += NTHR) ((LAS unsigned*)(F.lds + RING_BYTES))[u] = 0u;
    __syncthreads();
    const int lo = args.ph_lo, hi = args.ph_hi;
    const bool multi = (hi - lo) > 1;
    XcdBarrier bar; bar.bar = (unsigned*)(ws + WS_CTL) + CW_BAR; bar.x = 0; bar.st = nullptr;
    if (multi) bar = xcd_barrier_post((unsigned*)(ws + WS_CTL) + CW_BAR, MISC + 8);
#define IN(k) (lo <= (k) && (k) < hi)
#define SEAM(k) do { if (IN(k) && IN((k) + 1)) xcd_barrier(bar); } while (0)

#define DUP(k, ...) do { { __VA_ARGS__ } if ((DUPMASK >> (k)) & 1) { __VA_ARGS__ } } while (0)
    if (IN(0)) { DUP(0,  p0_ada(F); p0_transposes(F); ); } SEAM(0);
    if (IN(1)) { DUP(1,  p1_norm_gates(F); WG_BAR(); ); } SEAM(1);
    if (IN(2)) { DUP(2,  pg8::Gemm g{FP_H1, FP_WinT, MT, ZP, DM}; pg8::StaticOrder S; S.init(MT, ZP, F.G, (int)blockIdx.x); EpiZ E{FP_Z, FP_out}; pg8::gemm_phase(F.lds, g, S, E); ); } SEAM(2);
    if (IN(3)) { DUP(3,  for (int i = 0; i < 4; ++i) { const int u = F.vcu * 4 + i; if (u < 1024) mlstm_A_unit(F, u); }
                 if (F.G != 256) for (int u = 4 * F.G + F.vcu; u < 1024; u += F.G) mlstm_A_unit(F, u);
                 for (int u = F.vcu; u < 512; u += F.G) smlstm_unit(F, u); ); } SEAM(3);
    if (IN(4)) { DUP(4,  for (int it = F.vcu; it < 256; it += F.G) mlstm_scan_item(F, it); ); } SEAM(4);
    if (IN(5)) { DUP(5,  for (int i = F.vcu; i < 256; i += F.G) { const int bh = i >> 5, s = i & 31; attn_half_unit(F, bh, s, 0, FP_O1); attn_half_unit(F, bh, 31 - s, 1, FP_O2); } );
                 const float lam = lambda_full(F, F.lane);
                 DUP(15,  for (int u = F.vcu; u < 512; u += F.G) decode_unit(F, u, lam); ); } SEAM(5);
    if (IN(6)) { DUP(6,  for (int i = 0; i < 4; ++i) { const int u = F.vcu * 4 + i; if (u < 1024) mlstm_C_unit(F, u); }
                 if (F.G != 256) for (int u = 4 * F.G + F.vcu; u < 1024; u += F.G) mlstm_C_unit(F, u);
                 attn_combine_rows(F); ); } SEAM(6);
    if (IN(7)) { DUP(7,  pg8::Gemm g{FP_HM, FP_WpmT, MP, DM, 512}; pg8::StaticOrder S; S.init(MP, DM, F.G, (int)blockIdx.x); EpiPM E{FP_Z, FP_MG}; pg8::gemm_phase(F.lds, g, S, E);
                 skinny_gemm(F, FP_HM + (size_t)MP * 512, FP_WpmT, 512, E); ); } SEAM(7);
    if (IN(8)) { pg8::Gemm g{FP_HD, FP_WpdT, MP, DM, 512}; pg8::StaticOrder S; S.init(MP, DM, F.G, (int)blockIdx.x); EpiPD E{FP_Z, FP_MG}; pg8::gemm_phase(F.lds, g, S, E);
                 skinny_gemm(F, FP_HD + (size_t)MP * 512, FP_WpdT, 512, E); } SEAM(8);
    if (IN(9)) { DUP(9,  pg8::Gemm g{FP_MG, FP_WoutT, MP, DM, DM}; pg8::StaticOrder S; S.init(MP, DM, F.G, (int)blockIdx.x); EpiF32 E{FP_Y}; pg8::gemm_phase(F.lds, g, S, E);
                 skinny_gemm(F, FP_MG + (size_t)MP * DM, FP_WoutT, DM, E); ); } SEAM(9);
    if (IN(10)) { DUP(10,  rows_post_mix(F); ); } SEAM(10);
    if (IN(11)) { DUP(11,  pg8::Gemm g{FP_H1, FP_WupT, MT, 2 * DFF, DM}; pg8::StaticOrder S; S.init(MT, 2 * DFF, F.G, (int)blockIdx.x); EpiUp E{FP_UA, FP_UB, FP_out}; pg8::gemm_phase(F.lds, g, S, E); ); } SEAM(11);
    if (IN(12)) { DUP(12,  geglu_phase(F); ); } SEAM(12);
    if (IN(13)) { DUP(13,  pg8::Gemm g{FP_GB, FP_WdownT, MP, DM, DFF}; pg8::StaticOrder S; S.init(MP, DM, F.G, (int)blockIdx.x); EpiF32 E{FP_Y}; pg8::gemm_phase(F.lds, g, S, E);
                  skinny_gemm(F, FP_GB + (size_t)MP * DFF, FP_WdownT, DFF, E); ); } SEAM(13);
    if (IN(14)) { rows_final(F); }
#undef DUP
#undef IN
#undef SEAM
}

#ifndef MK_ONE_LAUNCH
#define MK_ONE_LAUNCH 1
#endif
extern "C" void kernel_launch(void* const* d_in, const int* in_sizes, int n_in, void* d_out, int out_size, void* d_ws, size_t ws_size, hipStream_t stream) {
    static int grid = 0;
    if (grid == 0) {
        if (n_in != 32 || out_size != (int)OUT_TOTAL || ws_size < WS_END) { fprintf(stderr, "kernel_launch: unexpected sizes n_in %d out %d ws %zu\n", n_in, out_size, ws_size); grid = -1; return; }
        int dev = 0, cus = 0, per_cu = 0;
        if (hipGetDevice(&dev) != hipSuccess || hipDeviceGetAttribute(&cus, hipDeviceAttributeMultiprocessorCount, dev) != hipSuccess) { grid = -1; return; }
        if (hipFuncSetAttribute((const void*)fwd_kernel, hipFuncAttributeMaxDynamicSharedMemorySize, LDS_BYTES) != hipSuccess) { fprintf(stderr, "kernel_launch: hipFuncSetAttribute failed\n"); grid = -1; return; }
        if (hipOccupancyMaxActiveBlocksPerMultiprocessor(&per_cu, (const void*)fwd_kernel, NTHR, LDS_BYTES) != hipSuccess || per_cu < 1) fprintf(stderr, "kernel_launch: occupancy query reports %d\n", per_cu);
        (void)hipGetLastError();
        grid = cus;
    }
    if (grid < 0) return;
    if (hipMemsetAsync((char*)d_ws + WS_CTL, 0, CTL_ZERO_BYTES, stream) != hipSuccess) return;
    Args a{};
    for (int i = 0; i < 32; ++i) a.in[i] = d_in[i];
    a.out = (float*)d_out; a.ws = (unsigned char*)d_ws;
#if MK_ONE_LAUNCH
    a.ph_lo = 0; a.ph_hi = NPHASE;
    hipLaunchKernelGGL(fwd_kernel, dim3(grid), dim3(NTHR), LDS_BYTES, stream, a);
#else
    for (int p = 0; p < NPHASE; ++p) { a.ph_lo = p; a.ph_hi = p + 1; hipLaunchKernelGGL(fwd_kernel, dim3(grid), dim3(NTHR), LDS_BYTES, stream, a); }
#endif
}
```

```cpp
#include <hip/hip_runtime.h>
#include <cstdio>
#include <cstdint>

#define LAS __attribute__((address_space(3)))
#define GAS __attribute__((address_space(1)))
typedef unsigned short bf16_t;
typedef short bf16x8 __attribute__((ext_vector_type(8)));
typedef short s16x4 __attribute__((ext_vector_type(4)));
typedef short v4i16_t __attribute__((ext_vector_type(4)));
typedef float f32x2 __attribute__((ext_vector_type(2)));
typedef float f32x4 __attribute__((ext_vector_type(4)));
typedef float f32x16 __attribute__((ext_vector_type(16)));
typedef unsigned u32x2 __attribute__((ext_vector_type(2)));
typedef unsigned u32x4 __attribute__((ext_vector_type(4)));
typedef __bf16 bf16x2_t __attribute__((ext_vector_type(2)));
typedef GAS unsigned gu32;

constexpr int DM = 1024, TP = 8192, MP = 16384, MS = 512, MT = MP + MS;
constexpr int NSEQ = 128, TS = 4, NPAGES = 16, PAGE = 128, PAST = 2048;
constexpr int DIN = 5640, ZP = 5632, DFF = 2816;
constexpr int ZQ = 0, ZK = 512, ZV = 1024, ZO = 1536, ZDQ = 2048, ZDK = 2560, ZDV = 3072, ZGM = 3584, ZGD = 4608;
constexpr float EPS = 1e-6f, LAM_INIT = 0.2f, LOG2E = 1.4426950408889634f;
constexpr float QSCALE = 0.125f * LOG2E;
constexpr float KSCALE = 0.08838834764831845f;
constexpr size_t OFF_Y = 0, OFF_KP = 17301504, OFF_VP = 25690112, OFF_CP = 34078720, OFF_NP = 34209792, OFF_MP = 34210816, OFF_CVP = 34210824,
                 OFF_KS = 34222088, OFF_VS = 34484232, OFF_CS = 34746376, OFF_NS = 43134984, OFF_MS = 43200520, OFF_CVS = 43201032, OUT_TOTAL = 43921928;
constexpr size_t MiB = 1u << 20;
constexpr size_t WS_CTL = 0, CTL_ZERO_BYTES = 1 * MiB;
constexpr size_t WS_WIN = 1 * MiB, WS_WUP = 12 * MiB, WS_WDOWN = 23 * MiB, WS_WOUT = 29 * MiB, WS_WPM = 31 * MiB, WS_WPD = 32 * MiB;
constexpr size_t WS_ADA = 33 * MiB, WS_IG = 37 * MiB, WS_LF = 37 * MiB + 512 * 1024, WS_ST = 38 * MiB, WS_NU = 38 * MiB + 65536, WS_NPREV = 39 * MiB, WS_MPREV = 39 * MiB + 768 * 1024;
constexpr size_t WS_H1 = 40 * MiB, WS_Z = 73 * MiB, WS_U = 255 * MiB, WS_CPREV = 319 * MiB, WS_HM = 351 * MiB, WS_HD = 368 * MiB, WS_O1 = 385 * MiB, WS_O2 = 417 * MiB;
constexpr size_t WS_MG = 449 * MiB, WS_Y = 482 * MiB, WS_UA = 548 * MiB, WS_UB = 639 * MiB, WS_G = 730 * MiB, WS_END = 821 * MiB;
constexpr int CW_BAR = 4096, CW_SCHED = 8192;
#ifndef DEC_LIM8
#define DEC_LIM8 12
#endif
constexpr int RING_BYTES = 131072, MISC_OFF = RING_BYTES + 320, LDS_BYTES = 147456;
constexpr int NWAVES = 8, NTHR = 512;

__device__ __forceinline__ unsigned pk2(float lo, float hi) { f32x2 v = {lo, hi}; bf16x2_t b = __builtin_convertvector(v, bf16x2_t); return __builtin_bit_cast(unsigned, b); }
__device__ __forceinline__ bf16_t f2bf(float x) { return (bf16_t)(pk2(x, 0.f) & 0xffffu); }
__device__ __forceinline__ float bflo(unsigned u) { return __uint_as_float(u << 16); }
__device__ __forceinline__ float bfhi(unsigned u) { return __uint_as_float(u & 0xffff0000u); }
__device__ __forceinline__ float bf2f(bf16_t u) { return __uint_as_float(((unsigned)u) << 16); }
__device__ __forceinline__ bf16x8 pack8(f32x4 a, f32x4 b) { u32x4 w; w.x = pk2(a.x, a.y); w.y = pk2(a.z, a.w); w.z = pk2(b.x, b.y); w.w = pk2(b.z, b.w); return __builtin_bit_cast(bf16x8, w); }
__device__ __forceinline__ void unpack8(u32x4 w, f32x4& a, f32x4& b) { a.x = bflo(w.x); a.y = bfhi(w.x); a.z = bflo(w.y); a.w = bfhi(w.y); b.x = bflo(w.z); b.y = bfhi(w.z); b.z = bflo(w.w); b.w = bfhi(w.w); }
__device__ __forceinline__ float wave_sum(float v) {
#pragma unroll
    for (int o = 1; o < 64; o <<= 1) v += __shfl_xor(v, o);
    return v;
}
__device__ __forceinline__ float wave_max(float v) {
#pragma unroll
    for (int o = 1; o < 64; o <<= 1) v = fmaxf(v, __shfl_xor(v, o));
    return v;
}
__device__ __forceinline__ float wave_scan_sum(float v, int lane) {
#pragma unroll
    for (int o = 1; o < 64; o <<= 1) { const float t = __shfl_up(v, o); if (lane >= o) v += t; }
    return v;
}
__device__ __forceinline__ float wave_scan_max(float v, int lane) {
#pragma unroll
    for (int o = 1; o < 64; o <<= 1) { const float t = __shfl_up(v, o); if (lane >= o) v = fmaxf(v, t); }
    return v;
}
__device__ __forceinline__ float sigmoidf_(float x) { return __builtin_amdgcn_rcpf(1.f + __builtin_amdgcn_exp2f(-x * LOG2E)); }
__device__ __forceinline__ float log_sigmoid(float x) { return fminf(x, 0.f) - log1pf(__expf(-fabsf(x))); }
__device__ __forceinline__ int crow(int reg, int h) { return (reg & 3) + 8 * (reg >> 2) + 4 * h; }
#define MFMA32(a, b, c) __builtin_amdgcn_mfma_f32_32x32x16_bf16((a), (b), (c), 0, 0, 0)
#define MFMA16(a, b, c) __builtin_amdgcn_mfma_f32_16x16x32_bf16((a), (b), (c), 0, 0, 0)
__device__ __forceinline__ s16x4 tr_rd(const LAS unsigned char* p) { return __builtin_bit_cast(s16x4, __builtin_amdgcn_ds_read_tr16_b64_v4i16((LAS v4i16_t*)p)); }
__device__ __forceinline__ bf16x8 cat4(s16x4 lo, s16x4 hi) { return (bf16x8){lo[0], lo[1], lo[2], lo[3], hi[0], hi[1], hi[2], hi[3]}; }
#define WG_BAR() __syncthreads()

namespace pg8 {
constexpr int BM = 256, BK = 64, HALF = 128, HTB = HALF * BK * 2, STAGE_BYTES = 8 * HTB, NXCD = 8, WGM = 8;
__host__ __device__ __forceinline__ int lds_byte(int r, int c) { const int st = (r >> 4) * 2 + (c >> 5), rr = r & 15, cc = c & 31, ob = rr * 64 + cc * 2; return st * 1024 + (ob ^ (((ob >> 9) & 1) << 5)); }
__host__ __device__ __forceinline__ void stage_rc(int b, int& R, int& C) { const int st = b / 1024, sb = b % 1024, swz = sb ^ (((sb >> 9) & 1) << 5); R = (st >> 1) * 16 + swz / 64; C = (st & 1) * 32 + (swz % 64) / 2; }
__host__ __device__ __forceinline__ int perm32(int rho) { const int n = rho >> 4, i = rho & 15; return 8 * (i >> 2) + 4 * n + (i & 3); }
struct Unit { int pm, pn; };
struct Gemm { const bf16_t* A; const bf16_t* Bt; int M, N, K; };
struct StaticOrder {
    int nM, nN, nwg, G, c;
    __host__ __device__ void init(int M, int N, int G_, int c_) { nM = M / BM; nN = N / BM; nwg = nM * nN; G = G_; c = c_; }
    __host__ __device__ bool next(int i, Unit& u) const {
        const long L = (long)i * G + c; if (L >= nwg) return false;
        int wgid = (int)L; { const int q = nwg / NXCD, r = nwg % NXCD, xcd = wgid % NXCD, off = wgid / NXCD; wgid = (xcd < r ? xcd * (q + 1) : r * (q + 1) + (xcd - r) * q) + off; }
        const int nig = WGM * nN, gid = wgid / nig, fm = gid * WGM, gsz = (nM - fm) < WGM ? (nM - fm) : WGM;
        u.pm = fm + ((wgid % nig) % gsz); u.pn = (wgid % nig) / gsz; return true;
    }
};
template <class Epi>
__device__ __forceinline__ void gemm_phase(LAS unsigned char* lds, const Gemm g, const StaticOrder& S, const Epi& E) {
    const int tid = threadIdx.x, wid = __builtin_amdgcn_readfirstlane(tid >> 6), lane = tid & 63, wr = wid >> 2, wc = wid & 3, fr = lane & 15, fq = lane >> 4;
    const int K = g.K, nt = K / BK;
    unsigned voffA[2], voffB[2];
#pragma unroll
    for (int i = 0; i < 2; ++i) { int R, C; stage_rc(tid * 16 + i * 8192, R, C); const int Rb = (R & ~31) + perm32(R & 31);
        voffA[i] = (unsigned)(R * K + C) * 2u; voffB[i] = (unsigned)(Rb * K + C) * 2u; }
    const size_t kstep = (size_t)(BK * 2);
    const size_t hstep = (size_t)HALF * K * 2;
    const size_t tstep = 2 * hstep;
    const unsigned ldsw = (unsigned)wid * 1024u;
    const int aoff = lds_byte(wr * 64 + fr, fq * 8), boff = lds_byte(wc * 32 + fr, fq * 8);
#define PG8_SA(b, h) (((b) * 2 + (h)) * HTB)
#define PG8_SB(b, h) ((4 + (b) * 2 + (h)) * HTB)
#define PG8_STAGE(bufoff, gbase, voff) do { _Pragma("unroll") for (int _i = 0; _i < 2; ++_i) \
        __builtin_amdgcn_global_load_lds((const unsigned*)((const char*)(gbase) + (voff)[_i]), (LAS unsigned*)(lds + (bufoff) + ldsw + _i * 8192), 16, 0, 0); } while (0)
#define PG8_LDA(dst, b, h) do { _Pragma("unroll") for (int m = 0; m < 4; ++m) _Pragma("unroll") for (int k = 0; k < 2; ++k) dst[m][k] = *(const LAS bf16x8*)(lds + PG8_SA(b, h) + aoff + m * 2048 + k * 1024); } while (0)
#define PG8_LDB(dst, b, h) do { _Pragma("unroll") for (int n = 0; n < 2; ++n) _Pragma("unroll") for (int k = 0; k < 2; ++k) dst[n][k] = *(const LAS bf16x8*)(lds + PG8_SB(b, h) + boff + n * 2048 + k * 1024); } while (0)
#define PG8_MMA(ai, bj, At, Bt) do { __builtin_amdgcn_s_setprio(1); _Pragma("unroll") for (int m = 0; m < 4; ++m) _Pragma("unroll") for (int n = 0; n < 2; ++n) _Pragma("unroll") for (int k = 0; k < 2; ++k) \
        acc[ai][bj][m][n] = __builtin_amdgcn_mfma_f32_16x16x32_bf16(Bt[n][k], At[m][k], acc[ai][bj][m][n], 0, 0, 0); __builtin_amdgcn_s_setprio(0); } while (0)
#define PG8_WAIT_V(n) asm volatile("s_waitcnt vmcnt(" #n ")" ::: "memory")
#define PG8_WAIT_L(n) asm volatile("s_waitcnt lgkmcnt(" #n ")" ::: "memory")
#define PG8_BAR __builtin_amdgcn_s_barrier()
#define PG8_SCHED __builtin_amdgcn_sched_barrier(0)
    Unit cur, nxt; int ui = 0;
    if (!S.next(0, cur)) return;
    f32x4 acc[2][2][4][2];
#pragma unroll
    for (int a = 0; a < 2; ++a)
#pragma unroll
        for (int b = 0; b < 2; ++b)
#pragma unroll
            for (int m = 0; m < 4; ++m)
#pragma unroll
                for (int n = 0; n < 2; ++n) acc[a][b][m][n] = (f32x4){0.f, 0.f, 0.f, 0.f};
    bf16x8 At[4][2], B0[2][2], B1[2][2];
    const char* cA = (const char*)g.A + (size_t)cur.pm * tstep; const char* cB = (const char*)g.Bt + (size_t)cur.pn * tstep;
    PG8_STAGE(PG8_SB(0, 0), cB, voffB); PG8_STAGE(PG8_SB(0, 1), cB + hstep, voffB); PG8_STAGE(PG8_SA(0, 0), cA, voffA); PG8_STAGE(PG8_SA(0, 1), cA + hstep, voffA);
    if (wr == 1) PG8_BAR;
    PG8_WAIT_V(2); PG8_BAR;
    PG8_STAGE(PG8_SB(1, 0), cB + kstep, voffB); PG8_STAGE(PG8_SA(1, 0), cA + kstep, voffA); PG8_STAGE(PG8_SB(1, 1), cB + hstep + kstep, voffB);
    PG8_WAIT_V(6); PG8_BAR;
    for (;;) {
        const bool has_next = S.next(ui + 1, nxt);
        const char* nA = has_next ? (const char*)g.A + (size_t)nxt.pm * tstep : cA; const char* nB = has_next ? (const char*)g.Bt + (size_t)nxt.pn * tstep : cB;
        for (int t = 0; t < nt; t += 2) {
            const bool last = (t == nt - 2);
            const char* a1 = cA + (size_t)(t + 1) * kstep;
            const char* a2 = last ? nA : cA + (size_t)(t + 2) * kstep; const char* b2 = last ? nB : cB + (size_t)(t + 2) * kstep;
            const char* a3 = a2 + kstep; const char* b3 = b2 + kstep;
            PG8_LDB(B0, 0, 0); PG8_LDB(B1, 0, 1); PG8_SCHED; PG8_LDA(At, 0, 0); PG8_STAGE(PG8_SA(1, 1), a1 + hstep, voffA);
            PG8_WAIT_V(8); PG8_WAIT_L(0); PG8_BAR; PG8_MMA(0, 0, At, B0); PG8_MMA(0, 1, At, B1); PG8_BAR; PG8_SCHED;
            PG8_LDA(At, 0, 1); PG8_STAGE(PG8_SB(0, 0), b2, voffB); PG8_STAGE(PG8_SB(0, 1), b2 + hstep, voffB); PG8_STAGE(PG8_SA(0, 0), a2, voffA);
            PG8_WAIT_V(8); PG8_WAIT_L(0); PG8_BAR; PG8_MMA(1, 0, At, B0); PG8_MMA(1, 1, At, B1); PG8_BAR; PG8_SCHED;
            PG8_LDB(B0, 1, 0); PG8_LDB(B1, 1, 1); PG8_SCHED; PG8_LDA(At, 1, 0); PG8_STAGE(PG8_SA(0, 1), a2 + hstep, voffA);
            PG8_WAIT_V(8); PG8_WAIT_L(0); PG8_BAR; PG8_MMA(0, 0, At, B0); PG8_MMA(0, 1, At, B1); PG8_BAR; PG8_SCHED;
            PG8_LDA(At, 1, 1); PG8_STAGE(PG8_SB(1, 0), b3, voffB); PG8_STAGE(PG8_SB(1, 1), b3 + hstep, voffB); PG8_STAGE(PG8_SA(1, 0), a3, voffA);
            PG8_WAIT_V(8); PG8_WAIT_L(0); PG8_BAR; PG8_MMA(1, 0, At, B0); PG8_MMA(1, 1, At, B1); PG8_BAR; PG8_SCHED;
        }
        if (wr == 0) PG8_BAR;
        {
            const int row0 = cur.pm * BM + wr * 64 + fr, col0 = cur.pn * BM + wc * 32 + 8 * fq;
#pragma unroll
            for (int ai = 0; ai < 2; ++ai)
#pragma unroll
                for (int m = 0; m < 4; ++m)
#pragma unroll
                    for (int bj = 0; bj < 2; ++bj) E.st8(row0 + ai * HALF + m * 16, col0 + bj * HALF, acc[ai][bj][m][0], acc[ai][bj][m][1]);
        }
        if (!has_next) break;
#pragma unroll
        for (int a = 0; a < 2; ++a)
#pragma unroll
            for (int b = 0; b < 2; ++b)
#pragma unroll
                for (int m = 0; m < 4; ++m)
#pragma unroll
                    for (int n = 0; n < 2; ++n) acc[a][b][m][n] = (f32x4){0.f, 0.f, 0.f, 0.f};
        cur = nxt; cA = nA; cB = nB; ++ui;
        if (wr == 1) PG8_BAR;
    }
    PG8_WAIT_V(0);
    PG8_BAR;
#undef PG8_SA
#undef PG8_SB
#undef PG8_STAGE
#undef PG8_LDA
#undef PG8_LDB
#undef PG8_MMA
#undef PG8_WAIT_V
#undef PG8_WAIT_L
#undef PG8_BAR
#undef PG8_SCHED
}
}

#define XB_TMO      128
#define XB_XCNT(j)  (256  + 64 * (j))
#define XB_XSUB(j)  (1280 + 64 * (j))
#define XB_XGEN(j)  (2304 + 64 * (j))
#define XB_TOP      3328
#define XB_TOPGEN   3392
#define XCD_BAR_WORDS 3456
#define XB_SPIN_CAP (1u << 18)
__device__ __forceinline__ unsigned xb_ld(unsigned* p)              { return __hip_atomic_load(p, __ATOMIC_RELAXED, __HIP_MEMORY_SCOPE_AGENT); }
__device__ __forceinline__ unsigned xb_add(unsigned* p, unsigned v) { return __hip_atomic_fetch_add(p, v, __ATOMIC_RELAXED, __HIP_MEMORY_SCOPE_AGENT); }
__device__ __forceinline__ unsigned xb_xcc_id() { return (unsigned)__builtin_amdgcn_s_getreg((3 << 11) | 20) & 0xFu; }
#define XB_SPIN(cond, bar) do { unsigned _sp = 0; while (cond) { __builtin_amdgcn_s_sleep(1); \
    if ((++_sp & 255u) == 0u) { if (xb_ld(&(bar)[XB_TMO])) break; if (_sp > XB_SPIN_CAP) { atomicAdd(&(bar)[XB_TMO], 1u); break; } } } } while (0)
struct XcdBarrier { unsigned* bar; unsigned x; volatile LAS unsigned* st; };
__device__ __forceinline__ XcdBarrier xcd_barrier_post(unsigned* bar, volatile LAS unsigned* st) {
    XcdBarrier b; b.bar = bar; b.x = xb_xcc_id(); b.st = st;
    if (threadIdx.x == 0) (void)xb_add(&bar[XB_XCNT(b.x)], 1u);
    return b;
}
__device__ __forceinline__ void xcd_barrier_complete(unsigned* bar, unsigned x, unsigned& nloc, unsigned& nx) {
    const unsigned G = gridDim.x * gridDim.y * gridDim.z;
    unsigned sum, cnt, mine, sp = 0u;
    for (;;) {
        sum = 0u; cnt = 0u; mine = 0u;
#pragma unroll
        for (unsigned j = 0; j < 16; ++j) { const unsigned c = xb_ld(&bar[XB_XCNT(j)]); sum += c; cnt += (c > 0u) ? 1u : 0u; mine = (j == x) ? c : mine; }
        if (sum == G) break;
        __builtin_amdgcn_s_sleep(1);
        if ((++sp & 255u) == 0u) { if (xb_ld(&bar[XB_TMO])) break; if (sp > XB_SPIN_CAP) { atomicAdd(&bar[XB_TMO], 1u); break; } }
    }
    nloc = mine > 0u ? mine : 1u; nx = cnt > 0u ? cnt : 1u;
}
__device__ __forceinline__ void xcd_barrier(const XcdBarrier& b) {
    asm volatile("s_waitcnt vmcnt(0)" ::: "memory");
    __syncthreads();
    if (threadIdx.x == 0) {
        unsigned* bar = b.bar;
        __builtin_amdgcn_s_waitcnt(0);
        unsigned nloc = b.st[0], nx = b.st[1];
        if (nloc == 0u) { xcd_barrier_complete(bar, b.x, nloc, nx); b.st[0] = nloc; b.st[1] = nx; }
        const unsigned old = xb_add(&bar[XB_XSUB(b.x)], 1u);
        const unsigned gen = old / nloc;
        if (old + 1u == (gen + 1u) * nloc) {
            __builtin_amdgcn_fence(__ATOMIC_RELEASE, "agent");
            asm volatile("s_waitcnt vmcnt(0)" ::: "memory");
            const unsigned og = xb_add(&bar[XB_TOP], 1u);
            const unsigned tg = og / nx;
            if (og + 1u == (tg + 1u) * nx) xb_add(&bar[XB_TOPGEN], 1u);
            else XB_SPIN(xb_ld(&bar[XB_TOPGEN]) == tg, bar);
            __builtin_amdgcn_fence(__ATOMIC_ACQUIRE, "agent");
            xb_add(&bar[XB_XGEN(b.x)], 1u);
            asm volatile("s_waitcnt vmcnt(0)" ::: "memory");
        } else {
            XB_SPIN(xb_ld(&bar[XB_XGEN(b.x)]) == gen, bar);
            __builtin_amdgcn_fence(__ATOMIC_ACQUIRE, "agent");
            asm volatile("s_waitcnt vmcnt(0)" ::: "memory");
        }
    }
    __syncthreads();
}

struct Args { const void* in[32]; float* out; unsigned char* ws; int ph_lo, ph_hi; };
struct Frame { LAS unsigned char* lds; int tid, lane, wave, vcu, G; const Args* a; };
#define FP_x_prompt ((const float*)F.a->in[0])
#define FP_x_sample ((const float*)F.a->in[1])
#define FP_c_prompt ((const float*)F.a->in[2])
#define FP_c_sample ((const float*)F.a->in[3])
#define FP_cache_k ((const float*)F.a->in[4])
#define FP_cache_v ((const float*)F.a->in[5])
#define FP_page_table ((const int*)F.a->in[6])
#define FP_state_C ((const float*)F.a->in[7])
#define FP_state_n ((const float*)F.a->in[8])
#define FP_state_m ((const float*)F.a->in[9])
#define FP_state_conv ((const float*)F.a->in[10])
#define FP_w_ada ((const float*)F.a->in[11])
#define FP_b_ada ((const float*)F.a->in[12])
#define FP_g_pre_mix ((const float*)F.a->in[13])
#define FP_g_post_mix ((const float*)F.a->in[14])
#define FP_w_in ((const float*)F.a->in[15])
#define FP_b_if ((const float*)F.a->in[16])
#define FP_g_mlstm ((const float*)F.a->in[17])
#define FP_lq1 ((const float*)F.a->in[18])
#define FP_lk1 ((const float*)F.a->in[19])
#define FP_lq2 ((const float*)F.a->in[20])
#define FP_lk2 ((const float*)F.a->in[21])
#define FP_g_diff ((const float*)F.a->in[22])
#define FP_w_proj_m ((const float*)F.a->in[23])
#define FP_w_proj_d ((const float*)F.a->in[24])
#define FP_w_out ((const float*)F.a->in[25])
#define FP_g_pre_ffn ((const float*)F.a->in[26])
#define FP_g_post_ffn ((const float*)F.a->in[27])
#define FP_w_up ((const float*)F.a->in[28])
#define FP_conv_w ((const float*)F.a->in[29])
#define FP_conv_b ((const float*)F.a->in[30])
#define FP_w_down ((const float*)F.a->in[31])
#define FP_WinT ((bf16_t*)(F.a->ws + WS_WIN))
#define FP_WupT ((bf16_t*)(F.a->ws + WS_WUP))
#define FP_WdownT ((bf16_t*)(F.a->ws + WS_WDOWN))
#define FP_WoutT ((bf16_t*)(F.a->ws + WS_WOUT))
#define FP_WpmT ((bf16_t*)(F.a->ws + WS_WPM))
#define FP_WpdT ((bf16_t*)(F.a->ws + WS_WPD))
#define FP_H1 ((bf16_t*)(F.a->ws + WS_H1))
#define FP_Z ((bf16_t*)(F.a->ws + WS_Z))
#define FP_CPREV ((bf16_t*)(F.a->ws + WS_CPREV))
#define FP_HM ((bf16_t*)(F.a->ws + WS_HM))
#define FP_HD ((bf16_t*)(F.a->ws + WS_HD))
#define FP_MG ((bf16_t*)(F.a->ws + WS_MG))
#define FP_UA ((bf16_t*)(F.a->ws + WS_UA))
#define FP_UB ((bf16_t*)(F.a->ws + WS_UB))
#define FP_GB ((bf16_t*)(F.a->ws + WS_G))
#define FP_ADA ((float*)(F.a->ws + WS_ADA))
#define FP_IG ((float*)(F.a->ws + WS_IG))
#define FP_LF ((float*)(F.a->ws + WS_LF))
#define FP_ST ((float*)(F.a->ws + WS_ST))
#define FP_NU ((float*)(F.a->ws + WS_NU))
#define FP_NPREV ((float*)(F.a->ws + WS_NPREV))
#define FP_MPREV ((float*)(F.a->ws + WS_MPREV))
#define FP_U ((float*)(F.a->ws + WS_U))
#define FP_O1 ((float*)(F.a->ws + WS_O1))
#define FP_O2 ((float*)(F.a->ws + WS_O2))
#define FP_Y ((float*)(F.a->ws + WS_Y))
#define FP_out (F.a->out)


__device__ __forceinline__ void transpose_item(const float* W, int pitch, int scol0, int K, bf16_t* WT, int drow0, LAS float* scr, int kb, int nb, int lane) {
    const int k0 = 64 * kb, n0 = 32 * nb;
#pragma unroll 8
    for (int i = 0; i < 32; ++i) { const int kk = 2 * i + (lane >> 5); scr[kk * 33 + (lane & 31)] = W[(size_t)(k0 + kk) * pitch + scol0 + n0 + (lane & 31)]; }
    asm volatile("s_waitcnt lgkmcnt(0)" ::: "memory");
    const int c = lane & 7;
#pragma unroll
    for (int j = 0; j < 4; ++j) { const int n = (lane >> 3) + 8 * j; const LAS float* s = scr + (8 * c) * 33 + n;
        u32x4 o; o.x = pk2(s[0 * 33], s[1 * 33]); o.y = pk2(s[2 * 33], s[3 * 33]); o.z = pk2(s[4 * 33], s[5 * 33]); o.w = pk2(s[6 * 33], s[7 * 33]);
        *(u32x4*)(WT + (size_t)(drow0 + n0 + n) * K + k0 + 8 * c) = o; }
    asm volatile("s_waitcnt lgkmcnt(0)" ::: "memory");
}
__device__ __forceinline__ void p0_transposes(const Frame& F) {
    LAS float* scr = (LAS float*)(F.lds + 40960 + F.wave * 8448);
    const int gw = F.vcu * NWAVES + F.wave, NGW = F.G * NWAVES;
    constexpr int I0 = 16 * 64, I1 = 16 * 112, I2 = 8 * 32, I3 = 8 * 32, I4 = 16 * 32, I5 = 16 * 176, I6 = 44 * 32;
    constexpr int NITEMS = I0 + I1 + I2 + I3 + I4 + I5 + I6;
    for (int it = gw; it < NITEMS; it += NGW) {
        int r = it;
        if (r < I0) { transpose_item(FP_w_in, DIN, 0, 1024, FP_WinT, 0, scr, r / 64, r % 64, F.lane); continue; } r -= I0;
        if (r < I1) { transpose_item(FP_w_in, DIN, 2056, 1024, FP_WinT, 2048, scr, r / 112, r % 112, F.lane); continue; } r -= I1;
        if (r < I2) { transpose_item(FP_w_proj_m, 1024, 0, 512, FP_WpmT, 0, scr, r / 32, r % 32, F.lane); continue; } r -= I2;
        if (r < I3) { transpose_item(FP_w_proj_d, 1024, 0, 512, FP_WpdT, 0, scr, r / 32, r % 32, F.lane); continue; } r -= I3;
        if (r < I4) { transpose_item(FP_w_out, 1024, 0, 1024, FP_WoutT, 0, scr, r / 32, r % 32, F.lane); continue; } r -= I4;
        if (r < I5) { transpose_item(FP_w_up, 2 * DFF, 0, 1024, FP_WupT, 0, scr, r / 176, r % 176, F.lane); continue; } r -= I5;
        transpose_item(FP_w_down, 1024, 0, DFF, FP_WdownT, 0, scr, r / 32, r % 32, F.lane);
    }
}
__device__ __forceinline__ void p0_ada(const Frame& F) {
    const int lane = F.lane, r = lane & 31, h = lane >> 5, w = F.wave;
    LAS float* part = (LAS float*)F.lds;
    for (int task = F.vcu; task < 192; task += F.G) {
        const int n0 = 32 * task;
        bf16x8 bw[8];
#pragma unroll
        for (int ks = 0; ks < 8; ++ks) { const float* p = FP_w_ada + (size_t)(128 * w + 16 * ks + 8 * h) * 6144 + n0 + r;
            f32x4 a, b; a.x = p[0]; a.y = p[6144]; a.z = p[2 * 6144]; a.w = p[3 * 6144]; b.x = p[4 * 6144]; b.y = p[5 * 6144]; b.z = p[6 * 6144]; b.w = p[7 * 6144]; bw[ks] = pack8(a, b); }
        for (int rt = 0; rt < 5; ++rt) {
            const int R = 32 * rt + r;
            const float* cr = R < 2 ? FP_c_prompt + (size_t)R * 1024 : FP_c_sample + (size_t)(R < 130 ? R - 2 : 0) * 1024;
            f32x16 acc; for (int i = 0; i < 16; ++i) acc[i] = 0.f;
#pragma unroll
            for (int ks = 0; ks < 8; ++ks) { f32x4 a = *(const f32x4*)(cr + 128 * w + 16 * ks + 8 * h), b = *(const f32x4*)(cr + 128 * w + 16 * ks + 8 * h + 4);
                if (R >= 130) { a = (f32x4){0.f, 0.f, 0.f, 0.f}; b = a; }
                acc = MFMA32(pack8(a, b), bw[ks], acc); }
#pragma unroll
            for (int i = 0; i < 16; ++i) part[(w * 32 + crow(i, h)) * 32 + r] = acc[i];
            WG_BAR();
#pragma unroll
            for (int k = 0; k < 2; ++k) { const int idx = F.tid + 512 * k, row = idx >> 5, col = idx & 31; float s = 0.f;
#pragma unroll
                for (int ww = 0; ww < 8; ++ww) s += part[(ww * 32 + row) * 32 + col];
                const int Rr = 32 * rt + row; if (Rr < 130) FP_ADA[(size_t)Rr * 6144 + n0 + col] = s + FP_b_ada[n0 + col]; }
            WG_BAR();
        }
    }
}
__device__ __forceinline__ int crow_of(int m) { return m < MP ? (m >> 13) : 2 + ((m - MP) >> 2); }
__device__ __forceinline__ const float* xrow_of(const Frame& F, int m) { return m < MP ? FP_x_prompt + (size_t)m * DM : FP_x_sample + (size_t)(m - MP) * DM; }
__device__ __forceinline__ void p1_norm_gates(const Frame& F) {
    LAS float* wg = (LAS float*)F.lds;
    for (int i = F.tid; i < 8192; i += NTHR) { const int k = i >> 3, g = i & 7; wg[g * 1024 + k] = FP_w_in[(size_t)k * DIN + 2048 + g]; }
    WG_BAR();
    const int lane = F.lane, gw = F.vcu * NWAVES + F.wave, NGW = F.G * NWAVES;
    const int r_lo = (int)(((long)gw * MT) / NGW), r_hi = (int)(((long)(gw + 1) * MT) / NGW);
    f32x4 gp[4], gs[4], sh[4], vn[4];
#pragma unroll
    for (int j = 0; j < 4; ++j) { gp[j] = *(const f32x4*)(FP_g_pre_mix + 4 * lane + 256 * j); gs[j] = gp[j]; sh[j] = gp[j]; vn[j] = gp[j]; }
    int ccur = -1;
    if (r_lo < r_hi) { const float* xr = xrow_of(F, r_lo);
#pragma unroll
        for (int j = 0; j < 4; ++j) vn[j] = *(const f32x4*)(xr + 4 * lane + 256 * j); }
    for (int m = r_lo; m < r_hi; ++m) {
        f32x4 v[4]; float ss = 0.f;
#pragma unroll
        for (int j = 0; j < 4; ++j) v[j] = vn[j];
        if (m + 1 < r_hi) { const float* xr = xrow_of(F, m + 1);
#pragma unroll
            for (int j = 0; j < 4; ++j) vn[j] = *(const f32x4*)(xr + 4 * lane + 256 * j); }
        const int cr = crow_of(m);
        if (cr != ccur) { ccur = cr; const float* ada = FP_ADA + (size_t)cr * 6144;
#pragma unroll
            for (int j = 0; j < 4; ++j) { sh[j] = *(const f32x4*)(ada + 4 * lane + 256 * j); gs[j] = gp[j] * (*(const f32x4*)(ada + 1024 + 4 * lane + 256 * j) + 1.f); } }
#pragma unroll
        for (int j = 0; j < 4; ++j) ss += (v[j].x * v[j].x + v[j].y * v[j].y) + (v[j].z * v[j].z + v[j].w * v[j].w);
        const float rs = rsqrtf(wave_sum(ss) * (1.f / DM) + EPS);
        float gd[8];
#pragma unroll
        for (int g = 0; g < 8; ++g) gd[g] = 0.f;
#pragma unroll
        for (int j = 0; j < 4; ++j) { const f32x4 hv = (v[j] * rs) * gs[j] + sh[j];
#pragma unroll
            for (int g = 0; g < 8; ++g) { const f32x4 wv = *(const LAS f32x4*)(wg + g * 1024 + 4 * lane + 256 * j); gd[g] += (hv.x * wv.x + hv.y * wv.y) + (hv.z * wv.z + hv.w * wv.w); }
            u32x2 o; o.x = pk2(hv.x, hv.y); o.y = pk2(hv.z, hv.w); *(u32x2*)(FP_H1 + (size_t)m * DM + 4 * lane + 256 * j) = o; }
#pragma unroll
        for (int g = 0; g < 8; ++g) gd[g] = wave_sum(gd[g]);
        if (lane == 0) { const f32x4 bi = *(const f32x4*)FP_b_if, bf = *(const f32x4*)(FP_b_if + 4);
            *(f32x4*)(FP_IG + (size_t)m * 4) = (f32x4){gd[0] + bi.x, gd[1] + bi.y, gd[2] + bi.z, gd[3] + bi.w};
            *(f32x4*)(FP_LF + (size_t)m * 4) = (f32x4){log_sigmoid(gd[4] + bf.x), log_sigmoid(gd[5] + bf.y), log_sigmoid(gd[6] + bf.z), log_sigmoid(gd[7] + bf.w)}; }
    }
}
struct EpiZ {
    bf16_t* Z; float* out;
    __device__ __forceinline__ void st8(int row, int col, f32x4 v0, f32x4 v1) const {
        const int pn = col >> 8; const float sc = (pn == 2 || pn == 3) ? KSCALE : ((pn == 8 || pn == 9) ? QSCALE : 1.f);
        if (pn >= 10 && pn < 14) { const int kv = pn >= 12; const int c = col - (kv ? ZDV : ZDK);
            float* o = row < MP ? out + (kv ? OFF_VP : OFF_KP) + (size_t)row * 512 + c : out + (kv ? OFF_VS : OFF_KS) + (size_t)(row - MP) * 512 + c;
            *(f32x4*)o = v0; *(f32x4*)(o + 4) = v1; }
        *(bf16x8*)(Z + (size_t)row * ZP + col) = pack8(v0 * sc, v1 * sc);
    }
};
struct EpiPM {
    const bf16_t* Z; bf16_t* MG;
    __device__ __forceinline__ void st4(int row, int col, f32x4 v) const {
        const u32x2 g = *(const u32x2*)(Z + (size_t)row * ZP + ZGM + col);
        u32x2 o; o.x = pk2(sigmoidf_(bflo(g.x)) * v.x, sigmoidf_(bfhi(g.x)) * v.y); o.y = pk2(sigmoidf_(bflo(g.y)) * v.z, sigmoidf_(bfhi(g.y)) * v.w);
        *(u32x2*)(MG + (size_t)row * DM + col) = o; }
    __device__ __forceinline__ void st8(int row, int col, f32x4 v0, f32x4 v1) const { st4(row, col, v0); st4(row, col + 4, v1); }
};
struct EpiPD {
    const bf16_t* Z; bf16_t* MG;
    __device__ __forceinline__ void st4(int row, int col, f32x4 v) const {
        const u32x2 g = *(const u32x2*)(Z + (size_t)row * ZP + ZGD + col); const u32x2 p = *(const u32x2*)(MG + (size_t)row * DM + col);
        u32x2 o; o.x = pk2(bflo(p.x) + sigmoidf_(bflo(g.x)) * v.x, bfhi(p.x) + sigmoidf_(bfhi(g.x)) * v.y); o.y = pk2(bflo(p.y) + sigmoidf_(bflo(g.y)) * v.z, bfhi(p.y) + sigmoidf_(bfhi(g.y)) * v.w);
        *(u32x2*)(MG + (size_t)row * DM + col) = o; }
    __device__ __forceinline__ void st8(int row, int col, f32x4 v0, f32x4 v1) const { st4(row, col, v0); st4(row, col + 4, v1); }
};
struct EpiF32 {
    float* Y;
    __device__ __forceinline__ void st4(int row, int col, f32x4 v) const { *(f32x4*)(Y + (size_t)row * DM + col) = v; }
    __device__ __forceinline__ void st8(int row, int col, f32x4 v0, f32x4 v1) const { st4(row, col, v0); st4(row, col + 4, v1); }
};
struct EpiUp {
    bf16_t* UA; bf16_t* UB; float* out;
    __device__ __forceinline__ void st8(int row, int col, f32x4 v0, f32x4 v1) const {
        if (col < DFF) {
            *(bf16x8*)(UA + (size_t)row * DFF + col) = pack8(v0, v1);
            if (row < MP) { const int t = row & (TP - 1); if (t >= TP - 2) { float* o = out + OFF_CVP + ((size_t)(row >> 13) * 2 + (t - (TP - 2))) * DFF + col; *(f32x4*)o = v0; *(f32x4*)(o + 4) = v1; } }
            else { const int t = (row - MP) & 3; if (t >= 2) { float* o = out + OFF_CVS + ((size_t)((row - MP) >> 2) * 2 + (t - 2)) * DFF + col; *(f32x4*)o = v0; *(f32x4*)(o + 4) = v1; } }
        } else *(bf16x8*)(UB + (size_t)row * DFF + (col - DFF)) = pack8(v0, v1);
    }
};
template <class Epi>
__device__ __forceinline__ void skinny_gemm(const Frame& F, const bf16_t* A, const bf16_t* Bt, int K, const Epi& E) {
    const int lane = F.lane, r = lane & 31, h = lane >> 5, ct = F.wave & 1, kq = F.wave >> 1, Kq = K >> 2;
    LAS float* part = (LAS float*)F.lds;
    for (int task = F.vcu; task < 256; task += F.G) {
        const int rt = task >> 4, cg = task & 15;
        const bf16_t* ap = A + (size_t)(32 * rt + r) * K + kq * Kq + 8 * h;
        const bf16_t* bp = Bt + (size_t)(64 * cg + 32 * ct + r) * K + kq * Kq + 8 * h;
        f32x16 acc; for (int i = 0; i < 16; ++i) acc[i] = 0.f;
#pragma unroll 4
        for (int s = 0; s < Kq / 16; ++s) { const bf16x8 a = *(const bf16x8*)(ap + 16 * s), b = *(const bf16x8*)(bp + 16 * s); acc = MFMA32(b, a, acc); }
#pragma unroll
        for (int g4 = 0; g4 < 4; ++g4) *(LAS f32x4*)(part + (kq * 32 + r) * 68 + 32 * ct + 8 * g4 + 4 * h) = (f32x4){acc[4 * g4], acc[4 * g4 + 1], acc[4 * g4 + 2], acc[4 * g4 + 3]};
        WG_BAR();
        { const int row = F.tid >> 4, c4 = (F.tid & 15) * 4;
          f32x4 s = *(const LAS f32x4*)(part + row * 68 + c4) + *(const LAS f32x4*)(part + (32 + row) * 68 + c4) + *(const LAS f32x4*)(part + (64 + row) * 68 + c4) + *(const LAS f32x4*)(part + (96 + row) * 68 + c4);
          E.st4(MP + 32 * rt + row, 64 * cg + c4, s); }
        WG_BAR();
    }
}

constexpr int VROW = 320;
__device__ __forceinline__ void mlstm_A_unit(const Frame& F, int u) {
    const int bh = u >> 7, c = u & 127, b = bh >> 2, h = bh & 3, m0 = b * TP + c * 64;
    const int tid = F.tid, lane = F.lane, wid = F.wave;
    LAS unsigned char* Vt = F.lds; LAS unsigned char* Kt = F.lds + 20480; LAS float* wl = (LAS float*)(F.lds + 40960);
    if (wid == 0) {
        const float lf = FP_LF[(size_t)(m0 + lane) * 4 + h], ig = FP_IG[(size_t)(m0 + lane) * 4 + h];
        const float Fc = wave_scan_sum(lf, lane), a = ig - Fc, Ac = wave_scan_max(a, lane);
        const float Mloc = __shfl(Ac, 63), Fsum = __shfl(Fc, 63);
        wl[lane] = __expf(a - Mloc);
        if (lane == 0) { FP_ST[2 * u] = Fsum; FP_ST[2 * u + 1] = Mloc; }
    }
    WG_BAR();
#pragma unroll
    for (int i = 0; i < 2; ++i) { const int idx = tid + 512 * i, row = idx >> 4, ch = idx & 15;
        const bf16_t* src = FP_Z + (size_t)(m0 + row) * ZP + h * 128 + ch * 8;
        const u32x4 vv = *(const u32x4*)(src + ZV); const u32x4 kk = *(const u32x4*)(src + ZK);
        f32x4 k0, k1; unpack8(kk, k0, k1); const float w = wl[row];
        *(LAS u32x4*)(Vt + row * VROW + ch * 16) = vv;
        *(LAS bf16x8*)(Kt + row * VROW + ch * 16) = pack8(k0 * w, k1 * w); }
    WG_BAR();
    if (tid < 128) { float s = 0.f;
#pragma unroll 8
        for (int row = 0; row < 64; ++row) s += bf2f(*(const LAS bf16_t*)(Kt + row * VROW + tid * 2));
        FP_NU[(size_t)u * 128 + tid] = s; }
    {
        const int r32 = lane & 31, hi = lane >> 5, vh = (lane >> 4) & 1, q4 = (lane & 15) >> 2, p = lane & 3;
        const int vt = wid >> 1, dt0 = 2 * (wid & 1);
        const int lbase = (8 * hi + q4) * VROW + (16 * vh + 4 * p) * 2;
        f32x16 acc0, acc1; for (int i = 0; i < 16; ++i) { acc0[i] = 0.f; acc1[i] = 0.f; }
#pragma unroll
        for (int st = 0; st < 4; ++st) {
            const LAS unsigned char* va = Vt + lbase + st * 16 * VROW + vt * 64;
            const bf16x8 af = cat4(tr_rd(va), tr_rd(va + 4 * VROW));
            const LAS unsigned char* ka = Kt + lbase + st * 16 * VROW + dt0 * 64;
            const bf16x8 b0 = cat4(tr_rd(ka), tr_rd(ka + 4 * VROW)), b1 = cat4(tr_rd(ka + 64), tr_rd(ka + 64 + 4 * VROW));
            acc0 = MFMA32(af, b0, acc0); acc1 = MFMA32(af, b1, acc1);
        }
        float* Uo = FP_U + (size_t)u * 16384;
#pragma unroll
        for (int i = 0; i < 16; ++i) { const int v = 32 * vt + crow(i, hi); Uo[v * 128 + 32 * dt0 + r32] = acc0[i]; Uo[v * 128 + 32 * dt0 + 32 + r32] = acc1[i]; }
    }
    WG_BAR();
}
__device__ __forceinline__ void smlstm_unit(const Frame& F, int u) {
    const int n = u >> 2, h = u & 3, tid = F.tid, lane = F.lane, wid = F.wave;
    const int mrow = MP + 4 * n;
    LAS float* qs = (LAS float*)F.lds; LAS float* ks = qs + 512; LAS float* vs = ks + 512; LAS float* numI = vs + 512; LAS float* Sm = numI + 512; LAS float* nq = Sm + 16; LAS float* red = nq + 4;
    { const int t = tid >> 7, d = tid & 127; const bf16_t* z = FP_Z + (size_t)(mrow + t) * ZP + h * 128 + d;
      qs[tid] = bf2f(z[ZQ]); ks[tid] = bf2f(z[ZK]); vs[tid] = bf2f(z[ZV]); }
    LAS float* gl = red + 8;
    const float m0 = FP_state_m[n * 4 + h];
    if (tid < 4) { float cum = 0.f, am = -INFINITY, at = 0.f;
      for (int t = 0; t <= tid; ++t) { cum += FP_LF[(size_t)(mrow + t) * 4 + h]; at = FP_IG[(size_t)(mrow + t) * 4 + h] - cum; am = fmaxf(am, at); }
      const float mxv = fmaxf(m0, am);
      gl[tid] = cum; gl[4 + tid] = at; gl[8 + tid] = mxv; gl[12 + tid] = __expf(m0 - mxv); gl[16 + tid] = cum + mxv; }
    WG_BAR();
    const float m_end = gl[19], Fend = gl[3], decay = __expf(Fend + m0 - m_end);
    const float wend0 = __expf(Fend + gl[4] - m_end), wend1 = __expf(Fend + gl[5] - m_end), wend2 = __expf(Fend + gl[6] - m_end), wend3 = __expf(Fend + gl[7] - m_end);
#pragma unroll
    for (int k = 0; k < 2; ++k) { const int pid = 2 * wid + k, t = pid >> 2, s = pid & 3;
        float d = qs[t * 128 + lane] * ks[s * 128 + lane] + qs[t * 128 + 64 + lane] * ks[s * 128 + 64 + lane]; d = wave_sum(d);
        if (lane == 0) Sm[pid] = (s <= t) ? d * __expf(gl[4 + s] - gl[8 + t]) : 0.f; }
    if (wid < 4) { const float* n0 = FP_state_n + (size_t)u * 128; float d = n0[lane] * qs[wid * 128 + lane] + n0[64 + lane] * qs[wid * 128 + 64 + lane]; d = wave_sum(d); if (lane == 0) nq[wid] = d; }
    { const int vrow = tid >> 2, dq = tid & 3;
      const float* c0 = FP_state_C + ((size_t)u * 128 + vrow) * 128 + 32 * dq; float* co = FP_out + OFF_CS + ((size_t)u * 128 + vrow) * 128 + 32 * dq;
      f32x4 cv[8];
#pragma unroll
      for (int i = 0; i < 8; ++i) cv[i] = *(const f32x4*)(c0 + 4 * i);
      float ps[4]; float coef[4];
      ps[0] = 0.f; ps[1] = 0.f; ps[2] = 0.f; ps[3] = 0.f;
      coef[0] = wend0 * vs[vrow]; coef[1] = wend1 * vs[128 + vrow]; coef[2] = wend2 * vs[256 + vrow]; coef[3] = wend3 * vs[384 + vrow];
#pragma unroll
      for (int i = 0; i < 8; ++i) { f32x4 cn = cv[i] * decay;
#pragma unroll
          for (int t = 0; t < 4; ++t) { const f32x4 qv = *(const LAS f32x4*)(qs + t * 128 + 32 * dq + 4 * i), kv = *(const LAS f32x4*)(ks + t * 128 + 32 * dq + 4 * i);
              ps[t] += (cv[i].x * qv.x + cv[i].y * qv.y) + (cv[i].z * qv.z + cv[i].w * qv.w); cn += kv * coef[t]; }
          *(f32x4*)(co + 4 * i) = cn; }
#pragma unroll
      for (int t = 0; t < 4; ++t) { ps[t] += __shfl_xor(ps[t], 1); ps[t] += __shfl_xor(ps[t], 2); if (dq == 0) numI[t * 128 + vrow] = ps[t]; } }
    WG_BAR();
    { const int t = tid >> 7, v = tid & 127;
      const float it = gl[12 + t], mtt = gl[16 + t];
      float num = it * numI[tid], den = it * nq[t];
#pragma unroll
      for (int s = 0; s < 4; ++s) { const float sv = Sm[t * 4 + s]; num += sv * vs[s * 128 + v]; den += sv; }
      const float hval = num / fmaxf(fabsf(den), __expf(-mtt));
      const float ssw = wave_sum(hval * hval); if (lane == 0) red[wid] = ssw;
      WG_BAR();
      const float rms = rsqrtf((red[2 * t] + red[2 * t + 1]) * (1.f / 128.f) + EPS);
      const float mo = bf2f(FP_Z[(size_t)(mrow + t) * ZP + ZO + h * 128 + v]);
      FP_HM[(size_t)(mrow + t) * 512 + h * 128 + v] = f2bf(hval * rms * FP_g_mlstm[h * 128 + v] * sigmoidf_(mo));
      if (tid < 128) { const float n0v = FP_state_n[(size_t)u * 128 + tid]; float nn = decay * n0v;
          nn += wend0 * ks[tid] + wend1 * ks[128 + tid] + wend2 * ks[256 + tid] + wend3 * ks[384 + tid];
          FP_out[OFF_NS + (size_t)u * 128 + tid] = nn; }
      if (tid == 0) FP_out[OFF_MS + u] = m_end; }
    WG_BAR();
}
__device__ __forceinline__ void mlstm_scan_item(const Frame& F, int item) {
    const int bh = item >> 5, j = item & 31, e = 512 * j + F.tid; const bool nthr = (j == 0 && F.tid < 128);
    float C = 0.f, m = 0.f, nacc = 0.f;
    const float* Ub = FP_U + (size_t)bh * 128 * 16384 + e; bf16_t* Cp = FP_CPREV + (size_t)bh * 128 * 16384 + e;
    for (int c0 = 0; c0 < 128; c0 += 32) {
        float uu[32], un[32];
#pragma unroll
        for (int i = 0; i < 32; ++i) { uu[i] = Ub[(size_t)(c0 + i) * 16384]; un[i] = nthr ? FP_NU[(size_t)(bh * 128 + c0 + i) * 128 + F.tid] : 0.f; }
#pragma unroll
        for (int i = 0; i < 32; ++i) { const int c = c0 + i; const float fs = FP_ST[2 * (bh * 128 + c)], ml = FP_ST[2 * (bh * 128 + c) + 1];
            Cp[(size_t)c * 16384] = f2bf(C);
            if (nthr) FP_NPREV[(size_t)(bh * 128 + c) * 128 + F.tid] = nacc;
            if (j == 0 && F.tid == 0) FP_MPREV[bh * 128 + c] = m;
            const float mn = fs + fmaxf(m, ml), dec = __expf(fs + m - mn), sc = __expf(fs + ml - mn);
            C = dec * C + sc * uu[i]; nacc = dec * nacc + sc * un[i]; m = mn; }
    }
    FP_out[OFF_CP + (size_t)bh * 16384 + e] = C;
    if (nthr) FP_out[OFF_NP + bh * 128 + F.tid] = nacc;
    if (j == 0 && F.tid == 0) FP_out[OFF_MP + bh] = m;
}
__device__ __forceinline__ void mlstm_C_unit(const Frame& F, int u) {
    const int bh = u >> 7, c = u & 127, b = bh >> 2, h = bh & 3, m0 = b * TP + c * 64;
    const int tid = F.tid, lane = F.lane, wid = F.wave, r32 = lane & 31, hi = lane >> 5;
    LAS unsigned char* Vt = F.lds; LAS float* Fa = (LAS float*)(F.lds + 20480); LAS float* aa = Fa + 64; LAS float* Aa = aa + 64; LAS float* dqp = Aa + 64;   LAS float* ssq = dqp + 512;
    if (wid == 0) {
        const float lf = FP_LF[(size_t)(m0 + lane) * 4 + h], ig = FP_IG[(size_t)(m0 + lane) * 4 + h];
        const float Fc = wave_scan_sum(lf, lane), a = ig - Fc, Ac = wave_scan_max(a, lane);
        Fa[lane] = Fc; aa[lane] = a; Aa[lane] = Ac;
    }
#pragma unroll
    for (int i = 0; i < 2; ++i) { const int idx = tid + 512 * i, row = idx >> 4, ch = idx & 15;
        *(LAS u32x4*)(Vt + row * VROW + ch * 16) = *(const u32x4*)(FP_Z + (size_t)(m0 + row) * ZP + ZV + h * 128 + ch * 8); }
    { const int t = tid & 63, part = tid >> 6; const bf16_t* qp = FP_Z + (size_t)(m0 + t) * ZP + ZQ + h * 128 + 16 * part; const float* np = FP_NPREV + (size_t)u * 128 + 16 * part;
      f32x4 q0, q1, q2, q3; unpack8(*(const u32x4*)qp, q0, q1); unpack8(*(const u32x4*)(qp + 8), q2, q3);
      const f32x4 n0 = *(const f32x4*)np, n1 = *(const f32x4*)(np + 4), n2 = *(const f32x4*)(np + 8), n3 = *(const f32x4*)(np + 12);
      const f32x4 s = q0 * n0 + q1 * n1 + q2 * n2 + q3 * n3; dqp[part * 64 + t] = (s.x + s.y) + (s.z + s.w); }
    WG_BAR();
    const int vt = wid & 3, tt = wid >> 2, t = 32 * tt + r32;
    const float mprev = FP_MPREV[u];
    const float Ft = Fa[t], At = Aa[t], mxt = fmaxf(mprev, At), mt = Ft + mxt, inter = __expf(mprev - mxt);
    bf16x8 qf[8];
    { const bf16_t* qp = FP_Z + (size_t)(m0 + t) * ZP + ZQ + h * 128 + 8 * hi;
#pragma unroll
      for (int st = 0; st < 8; ++st) qf[st] = *(const bf16x8*)(qp + 16 * st); }
    f32x16 acc; for (int i = 0; i < 16; ++i) acc[i] = 0.f;
    { const bf16_t* cp = FP_CPREV + (size_t)u * 16384 + (size_t)(32 * vt + r32) * 128 + 8 * hi;
#pragma unroll
      for (int st = 0; st < 8; ++st) acc = MFMA32(*(const bf16x8*)(cp + 16 * st), qf[st], acc); }
#pragma unroll
    for (int i = 0; i < 16; ++i) acc[i] *= inter;
    float den = 0.f;
    const int vh = (lane >> 4) & 1, q4 = (lane & 15) >> 2, p = lane & 3;
    const int lbase = (4 * hi + q4) * VROW + (32 * vt + 16 * vh + 4 * p) * 2;
    for (int sub = 0; sub <= tt; ++sub) {
        f32x16 sacc; for (int i = 0; i < 16; ++i) sacc[i] = 0.f;
        { const bf16_t* kp = FP_Z + (size_t)(m0 + 32 * sub + r32) * ZP + ZK + h * 128 + 8 * hi;
#pragma unroll
          for (int st = 0; st < 8; ++st) sacc = MFMA32(*(const bf16x8*)(kp + 16 * st), qf[st], sacc); }
#pragma unroll
        for (int g = 0; g < 4; ++g) { const f32x4 av = *(const LAS f32x4*)(aa + 32 * sub + 8 * g + 4 * hi);
#pragma unroll
            for (int k = 0; k < 4; ++k) { const int s = 32 * sub + 8 * g + 4 * hi + k; const float wgt = (s <= t) ? __expf(av[k] - mxt) : 0.f; const float val = (s <= t) ? sacc[4 * g + k] * wgt : 0.f; sacc[4 * g + k] = val; den += val; } }
#pragma unroll
        for (int s2 = 0; s2 < 2; ++s2) {
            const bf16x8 pb = pack8((f32x4){sacc[8 * s2], sacc[8 * s2 + 1], sacc[8 * s2 + 2], sacc[8 * s2 + 3]}, (f32x4){sacc[8 * s2 + 4], sacc[8 * s2 + 5], sacc[8 * s2 + 6], sacc[8 * s2 + 7]});
            const LAS unsigned char* va = Vt + lbase + (32 * sub + 16 * s2) * VROW;
            acc = MFMA32(cat4(tr_rd(va), tr_rd(va + 8 * VROW)), pb, acc);
        }
    }
    den += __shfl_xor(den, 32);
    float dq = 0.f;
#pragma unroll
    for (int k = 0; k < 8; ++k) dq += dqp[k * 64 + t];
    den += inter * dq;
    const float rden = 1.f / fmaxf(fabsf(den), __expf(-mt));
    float ss = 0.f;
#pragma unroll
    for (int i = 0; i < 16; ++i) { acc[i] *= rden; ss += acc[i] * acc[i]; }
    ss += __shfl_xor(ss, 32);
    if (hi == 0) ssq[vt * 64 + t] = ss;
    WG_BAR();
    const float rms = rsqrtf((ssq[t] + ssq[64 + t] + ssq[128 + t] + ssq[192 + t]) * (1.f / 128.f) + EPS);
#pragma unroll
    for (int g = 0; g < 4; ++g) { const int v = 32 * vt + 8 * g + 4 * hi;
        const f32x4 gv = *(const f32x4*)(FP_g_mlstm + h * 128 + v); const u32x2 mo = *(const u32x2*)(FP_Z + (size_t)(m0 + t) * ZP + ZO + h * 128 + v);
        u32x2 o; o.x = pk2(acc[4 * g] * rms * gv.x * sigmoidf_(bflo(mo.x)), acc[4 * g + 1] * rms * gv.y * sigmoidf_(bfhi(mo.x)));
        o.y = pk2(acc[4 * g + 2] * rms * gv.z * sigmoidf_(bflo(mo.y)), acc[4 * g + 3] * rms * gv.w * sigmoidf_(bfhi(mo.y)));
        *(u32x2*)(FP_HM + (size_t)(m0 + t) * 512 + h * 128 + v) = o; }
    WG_BAR();
}
constexpr int AT_SLOT = 24576, AT_VOFF = 8192, AT_NSLOT = 3;
constexpr float AT_THR = 8.f;
__device__ __forceinline__ void glds16(const void* gsrc, unsigned lds_dst) { unsigned keep;
    asm volatile("s_mov_b32 %0, m0\n\ts_mov_b32 m0, %2\n\ts_nop 0\n\tglobal_load_lds_dwordx4 %1, off\n\ts_mov_b32 m0, %0" : "=&s"(keep) : "v"(gsrc), "s"(lds_dst) : "memory"); }
#define AT_WAIT_BAR(N) asm volatile("s_waitcnt vmcnt(" #N ") lgkmcnt(0)\n\ts_barrier" ::: "memory")
__device__ __forceinline__ void attn_half_unit(const Frame& F, int bh, int qb, int map, float* Odst) {
    int tid_ = F.tid; asm volatile("" : "+v"(tid_));
    const int b = bh >> 2, h = bh & 3, lane = tid_ & 63, wid = F.wave, r32 = lane & 31, hi = lane >> 5;
    const int rowbase = b * TP, q0 = qb * 256, qrow = q0 + 32 * wid + r32;
    const bf16_t* Zb = FP_Z + (size_t)rowbase * ZP;
    const unsigned lds0 = (unsigned)(uintptr_t)F.lds;
    const bf16_t* ksrc = Zb + (size_t)lane * ZP + ZDK + h * 128 + map * 64 + wid * 8;
    const bf16_t* vsrc0 = Zb + (size_t)(((2 * wid) & 3) * 16 + (lane >> 2)) * ZP + ZDV + h * 128 + ((2 * wid) >> 2) * 32 + (lane & 3) * 8;
    const bf16_t* vsrc1 = vsrc0 + (size_t)16 * ZP;
    const unsigned kdst = lds0 + wid * 1024, vdst = lds0 + AT_VOFF + 2 * wid * 1024;
#define AT_DMA(t, slot) do { const size_t adv_ = (size_t)(t) * 64 * ZP; const unsigned so_ = (unsigned)(slot) * AT_SLOT; \
        glds16(ksrc + adv_, (unsigned)__builtin_amdgcn_readfirstlane(kdst + so_)); glds16(vsrc0 + adv_, (unsigned)__builtin_amdgcn_readfirstlane(vdst + so_)); \
        glds16(vsrc1 + adv_, (unsigned)__builtin_amdgcn_readfirstlane(vdst + so_ + 1024u)); } while (0)
    bf16x8 qf[4];
    { const bf16_t* qp = Zb + (size_t)qrow * ZP + ZDQ + h * 128 + map * 64 + 8 * hi;
#pragma unroll
      for (int st = 0; st < 4; ++st) qf[st] = *(const bf16x8*)(qp + 16 * st); }
    const int NT = 4 * qb + 4;
    AT_DMA(0, 0); AT_DMA(1, 1);
    f32x16 o[4];
#pragma unroll
    for (int vt = 0; vt < 4; ++vt) for (int i = 0; i < 16; ++i) o[vt][i] = 0.f;
    f32x16 negm; for (int i = 0; i < 16; ++i) negm[i] = 0.f;
    float mhat = 0.f, lrun = 0.f;
    const int vh = (lane >> 4) & 1, q4 = (lane & 15) >> 2, p = lane & 3;
    const int vlane = AT_VOFF + (4 * hi + q4) * 64 + (16 * vh + 4 * p) * 2;
    const int klane = hi * 1024 + r32 * 16;
    const int wlast = q0 + 32 * wid + 31, wfirst = q0 + 32 * wid;
    int slot = 0, slot2 = 2;
    for (int j = 0; j < NT; ++j) {
        if (j + 1 < NT) AT_WAIT_BAR(3); else AT_WAIT_BAR(0);
        if (j + 2 < NT) AT_DMA(j + 2, slot2);
        if (64 * j <= wlast) {
            const LAS unsigned char* kb = F.lds + slot * AT_SLOT + klane;
            f32x16 p0 = negm, p1 = negm;
#pragma unroll
            for (int st = 0; st < 4; ++st) { const bf16x8 k0 = *(const LAS bf16x8*)(kb + st * 2048), k1 = *(const LAS bf16x8*)(kb + st * 2048 + 512);
                p0 = MFMA32(k0, qf[st], p0); p1 = MFMA32(k1, qf[st], p1); }
            if (64 * j + 63 > wfirst) {
#pragma unroll
                for (int i = 0; i < 16; ++i) { const int key = 64 * j + crow(i, hi); if (key > qrow) p0[i] = -INFINITY; if (key + 32 > qrow) p1[i] = -INFINITY; }
            }
            float mx = fmaxf(p0[0], p1[0]);
#pragma unroll
            for (int i = 1; i < 16; ++i) mx = fmaxf(mx, fmaxf(p0[i], p1[i]));
            mx = fmaxf(mx, __shfl_xor(mx, 32));
            if (j == 0 || __any(mx > AT_THR)) {
                const float dl = (j == 0) ? mx : fmaxf(mx, 0.f), f = __builtin_amdgcn_exp2f(-dl);
                mhat += dl; lrun *= f;
#pragma unroll
                for (int i = 0; i < 16; ++i) { p0[i] -= dl; p1[i] -= dl; negm[i] = -mhat; }
#pragma unroll
                for (int vt = 0; vt < 4; ++vt) for (int i = 0; i < 16; ++i) o[vt][i] *= f;
            }
            float rsum = 0.f;
#pragma unroll
            for (int i = 0; i < 16; ++i) { p0[i] = __builtin_amdgcn_exp2f(p0[i]); p1[i] = __builtin_amdgcn_exp2f(p1[i]); rsum += p0[i] + p1[i]; }
            lrun += rsum;
            const LAS unsigned char* vb = F.lds + slot * AT_SLOT + vlane;
#pragma unroll
            for (int sub = 0; sub < 2; ++sub) {
#pragma unroll
                for (int s2 = 0; s2 < 2; ++s2) {
                    bf16x8 pb;
                    if (sub == 0) pb = pack8((f32x4){p0[8 * s2], p0[8 * s2 + 1], p0[8 * s2 + 2], p0[8 * s2 + 3]}, (f32x4){p0[8 * s2 + 4], p0[8 * s2 + 5], p0[8 * s2 + 6], p0[8 * s2 + 7]});
                    else          pb = pack8((f32x4){p1[8 * s2], p1[8 * s2 + 1], p1[8 * s2 + 2], p1[8 * s2 + 3]}, (f32x4){p1[8 * s2 + 4], p1[8 * s2 + 5], p1[8 * s2 + 6], p1[8 * s2 + 7]});
                    const LAS unsigned char* va = vb + (2 * sub + s2) * 1024;
#pragma unroll
                    for (int vt = 0; vt < 4; ++vt) o[vt] = MFMA32(cat4(tr_rd(va + vt * 4096), tr_rd(va + vt * 4096 + 512)), pb, o[vt]);
                }
            }
        }
        slot = (slot == AT_NSLOT - 1) ? 0 : slot + 1; slot2 = (slot2 == AT_NSLOT - 1) ? 0 : slot2 + 1;
    }
    lrun += __shfl_xor(lrun, 32);
    const float rl = 1.f / lrun;
    float* op = Odst + (size_t)(rowbase + qrow) * 512 + h * 128 + 4 * hi;
#pragma unroll
    for (int vt = 0; vt < 4; ++vt)
#pragma unroll
        for (int g = 0; g < 4; ++g) *(f32x4*)(op + 32 * vt + 8 * g) = (f32x4){o[vt][4 * g] * rl, o[vt][4 * g + 1] * rl, o[vt][4 * g + 2] * rl, o[vt][4 * g + 3] * rl};
    AT_WAIT_BAR(0);
#undef AT_DMA
}
__device__ __forceinline__ float lambda_full(const Frame& F, int lane) {
    const float a = wave_sum(FP_lq1[lane] * FP_lk1[lane]), b = wave_sum(FP_lq2[lane] * FP_lk2[lane]);
    return __expf(a) - __expf(b) + LAM_INIT;
}
__device__ __forceinline__ void attn_combine_rows(const Frame& F) {
    const int lane = F.lane, gw = F.vcu * NWAVES + F.wave, NGW = F.G * NWAVES;
    const float lam = lambda_full(F, lane);
    const f32x4 g0 = *(const f32x4*)(FP_g_diff + 8 * lane), g1 = *(const f32x4*)(FP_g_diff + 8 * lane + 4);
    for (int m = gw; m < MP; m += NGW) {
        const float* a = FP_O1 + (size_t)m * 512 + 8 * lane; const float* bb = FP_O2 + (size_t)m * 512 + 8 * lane;
        const f32x4 x0 = *(const f32x4*)a - *(const f32x4*)bb * lam, x1 = *(const f32x4*)(a + 4) - *(const f32x4*)(bb + 4) * lam;
        float ss = (x0.x * x0.x + x0.y * x0.y) + (x0.z * x0.z + x0.w * x0.w) + (x1.x * x1.x + x1.y * x1.y) + (x1.z * x1.z + x1.w * x1.w);
        ss += __shfl_xor(ss, 1); ss += __shfl_xor(ss, 2); ss += __shfl_xor(ss, 4); ss += __shfl_xor(ss, 8);
        const float rms = rsqrtf(ss * (1.f / 128.f) + EPS) * (1.f - LAM_INIT);
        *(bf16x8*)(FP_HD + (size_t)m * 512 + 8 * lane) = pack8(x0 * rms * g0, x1 * rms * g1);
    }
}
constexpr int SB_P = 2064;
__device__ __forceinline__ void decode_unit(const Frame& F, int u, float lam) {
    int tid_ = F.tid; asm volatile("" : "+v"(tid_));
    const int n = u >> 2, h = u & 3, tid = tid_, lane = tid_ & 63, wid = F.wave;
    const int mrow = MP + 4 * n;
    LAS float* Sbuf = (LAS float*)F.lds;
    LAS float* part = Sbuf + 8 * SB_P;
    LAS float* rlv = part + 8192;
    LAS float* red = rlv + 8;
    const int* pt = FP_page_table + n * NPAGES;
    const int c16 = lane & 15, g = lane >> 4;
    bf16x8 bq[4];
#pragma unroll
    for (int st = 0; st < 4; ++st) { const bool ok = (c16 < 4 && st < 2) || (c16 >= 4 && c16 < 8 && st >= 2);
        const bf16x8 v = *(const bf16x8*)(FP_Z + (size_t)(mrow + (c16 & 3)) * ZP + ZDQ + h * 128 + 32 * st + 8 * g);
        const bf16x8 zz = {0, 0, 0, 0, 0, 0, 0, 0}; bq[st] = ok ? v : zz; }
    const int hh = lane >> 5, l5 = lane & 31;
    const char* vpool = (const char*)FP_cache_v; const char* kpool = (const char*)FP_cache_k;
    const unsigned voff = (((unsigned)pt[2 * wid + hh] * PAGE) * 4u + (unsigned)h) * 512u + 16u * (unsigned)l5;
#define NTL(p) __builtin_nontemporal_load((const f32x4*)(p))
#define VLD(row) NTL(vpool + (voff + 2048u * (unsigned)(row)))
    f32x4 va[8], vb[8];
    {
        const unsigned ko0 = (((unsigned)pt[2 * wid] * PAGE + (unsigned)c16) * 4u + (unsigned)h) * 512u + 32u * (unsigned)g;
        const unsigned ko1 = (((unsigned)pt[2 * wid + 1] * PAGE + (unsigned)c16) * 4u + (unsigned)h) * 512u + 32u * (unsigned)g;
        f32x4 ka[16], kb[8];
#define KLOAD(dst, ti) do { const unsigned ko_ = (((ti) < 8) ? ko0 : ko1) + 32768u * (unsigned)((ti) & 7); \
            _Pragma("unroll") for (int st = 0; st < 4; ++st) { dst[2 * st] = NTL(kpool + (ko_ + 128u * st)); dst[2 * st + 1] = NTL(kpool + (ko_ + 128u * st + 16u)); } } while (0)
#define KTILE(src, ti) do { f32x4 acc_ = {0.f, 0.f, 0.f, 0.f}; \
            _Pragma("unroll") for (int st = 0; st < 4; ++st) acc_ = MFMA16(pack8(src[2 * st], src[2 * st + 1]), bq[st], acc_); \
            if (c16 < 8) *(LAS f32x4*)(Sbuf + c16 * SB_P + 256 * wid + 16 * (ti) + 4 * g) = acc_; } while (0)
        KLOAD(ka, 0); KLOAD((ka + 8), 1); KLOAD(kb, 2);
        for (int ip = 0; ip < 12; ip += 3) {
            KTILE(ka, ip); KTILE((ka + 8), ip + 1); KLOAD(ka, ip + 3); KLOAD((ka + 8), ip + 4);
            KTILE(kb, ip + 2); KLOAD(kb, ip + 5);
        }
        KTILE(ka, 12); KTILE((ka + 8), 13); KLOAD(ka, 15);
#pragma unroll
        for (int kk = 0; kk < 8; ++kk) va[kk] = VLD(kk);
        KTILE(kb, 14);
#pragma unroll
        for (int kk = 0; kk < 8; ++kk) vb[kk] = VLD(8 + kk);
        KTILE(ka, 15);
#undef KLOAD
#undef KTILE
        if (wid == 0) {
            f32x4 acc = {0.f, 0.f, 0.f, 0.f};
#pragma unroll
            for (int st = 0; st < 4; ++st) { const bf16x8 v = *(const bf16x8*)(FP_Z + (size_t)(mrow + (c16 & 3)) * ZP + ZDK + h * 128 + 32 * st + 8 * g);
                const bf16x8 zz = {0, 0, 0, 0, 0, 0, 0, 0}; const bf16x8 av = (c16 < 4) ? v : zz; acc = MFMA16(av, bq[st], acc); }
            if (g == 0 && c16 < 8) { const int t = c16 & 3; f32x4 m;
                m.x = acc.x; m.y = (1 <= t) ? acc.y : -INFINITY; m.z = (2 <= t) ? acc.z : -INFINITY; m.w = (3 <= t) ? acc.w : -INFINITY;
                *(LAS f32x4*)(Sbuf + c16 * SB_P + PAST) = m; }
        }
    }
    WG_BAR();
    {
        LAS float* col = Sbuf + wid * SB_P; float mx = -INFINITY;
        for (int k = lane; k < PAST + 4; k += 64) mx = fmaxf(mx, col[k]);
        mx = wave_max(mx); float sm = 0.f;
        for (int k = lane; k < PAST + 4; k += 64) { const float pv = __builtin_amdgcn_exp2f(col[k] - mx); col[k] = pv; sm += pv; }
        sm = wave_sum(sm); if (lane == 0) rlv[wid] = 1.f / sm;
    }
    WG_BAR();
    {
        const LAS float* pbase = Sbuf + 256 * wid + 128 * hh;
        f32x4 acc[8];
#pragma unroll
        for (int c = 0; c < 8; ++c) acc[c] = (f32x4){0.f, 0.f, 0.f, 0.f};
#define VSTEP(buf, t8) do { f32x4 vc_[8]; _Pragma("unroll") for (int kk = 0; kk < 8; ++kk) vc_[kk] = buf[kk]; \
            if ((t8) + 2 < 16) { _Pragma("unroll") for (int kk = 0; kk < 8; ++kk) buf[kk] = VLD(8 * ((t8) + 2) + kk); } \
            _Pragma("unroll") for (int c = 0; c < 8; ++c) { const f32x4 p0_ = *(const LAS f32x4*)(pbase + c * SB_P + 8 * (t8)), p1_ = *(const LAS f32x4*)(pbase + c * SB_P + 8 * (t8) + 4); \
                acc[c] += vc_[0] * p0_.x + vc_[1] * p0_.y + vc_[2] * p0_.z + vc_[3] * p0_.w + vc_[4] * p1_.x + vc_[5] * p1_.y + vc_[6] * p1_.z + vc_[7] * p1_.w; } } while (0)
        for (int t8 = 0; t8 < 16; t8 += 2) { VSTEP(va, t8); VSTEP(vb, t8 + 1); }
#undef VSTEP
        if (wid == 0) {
#pragma unroll
            for (int s = 0; s < 4; ++s) { const u32x2 vv = *(const u32x2*)(FP_Z + (size_t)(mrow + s) * ZP + ZDV + h * 128 + 4 * l5);
                const f32x4 vf = {bflo(vv.x), bfhi(vv.x), bflo(vv.y), bfhi(vv.y)};
#pragma unroll
                for (int c = 0; c < 8; ++c) { const float pp = (hh == 0) ? Sbuf[c * SB_P + PAST + s] : 0.f; acc[c] += vf * pp; } }
        }
#pragma unroll
        for (int c = 0; c < 8; ++c) { acc[c].x += __shfl_xor(acc[c].x, 32); acc[c].y += __shfl_xor(acc[c].y, 32); acc[c].z += __shfl_xor(acc[c].z, 32); acc[c].w += __shfl_xor(acc[c].w, 32);
            if (hh == 0) *(LAS f32x4*)(part + (wid * 8 + c) * 128 + 4 * l5) = acc[c]; }
    }
    WG_BAR();
    { const int t = tid >> 7, v = tid & 127; float o1 = 0.f, o2 = 0.f;
#pragma unroll
      for (int w = 0; w < 8; ++w) { o1 += part[(w * 8 + t) * 128 + v]; o2 += part[(w * 8 + 4 + t) * 128 + v]; }
      const float ov = o1 * rlv[t] - lam * o2 * rlv[4 + t];
      const float ssw = wave_sum(ov * ov); if (lane == 0) red[wid] = ssw;
      WG_BAR();
      const float rms = rsqrtf((red[2 * t] + red[2 * t + 1]) * (1.f / 128.f) + EPS) * (1.f - LAM_INIT);
      FP_HD[(size_t)(mrow + t) * 512 + h * 128 + v] = f2bf(ov * rms * FP_g_diff[h * 128 + v]); }
    WG_BAR();
}
__device__ __forceinline__ void rows_post_mix(const Frame& F) {
    const int lane = F.lane, gw = F.vcu * NWAVES + F.wave, NGW = F.G * NWAVES;
    const int r_lo = (int)(((long)gw * MT) / NGW), r_hi = (int)(((long)(gw + 1) * MT) / NGW);
    f32x4 gpm[4], gpf[4], g1[4], sh2[4], sc2[4], yn[4], xn[4];
#pragma unroll
    for (int j = 0; j < 4; ++j) { gpm[j] = *(const f32x4*)(FP_g_post_mix + 4 * lane + 256 * j); gpf[j] = *(const f32x4*)(FP_g_pre_ffn + 4 * lane + 256 * j); g1[j] = gpm[j]; sh2[j] = gpm[j]; sc2[j] = gpm[j]; yn[j] = gpm[j]; xn[j] = gpm[j]; }
    int ccur = -1;
    if (r_lo < r_hi) { const float* xr = xrow_of(F, r_lo); const float* yr = FP_Y + (size_t)r_lo * DM;
#pragma unroll
        for (int j = 0; j < 4; ++j) { yn[j] = *(const f32x4*)(yr + 4 * lane + 256 * j); xn[j] = *(const f32x4*)(xr + 4 * lane + 256 * j); } }
    for (int m = r_lo; m < r_hi; ++m) {
        f32x4 y[4], x1[4]; float ss = 0.f;
#pragma unroll
        for (int j = 0; j < 4; ++j) { y[j] = yn[j]; x1[j] = xn[j]; }
        if (m + 1 < r_hi) { const float* xr = xrow_of(F, m + 1); const float* yr = FP_Y + (size_t)(m + 1) * DM;
#pragma unroll
            for (int j = 0; j < 4; ++j) { yn[j] = *(const f32x4*)(yr + 4 * lane + 256 * j); xn[j] = *(const f32x4*)(xr + 4 * lane + 256 * j); } }
        const int cr = crow_of(m);
        if (cr != ccur) { ccur = cr; const float* ada = FP_ADA + (size_t)cr * 6144;
#pragma unroll
            for (int j = 0; j < 4; ++j) { const int c = 4 * lane + 256 * j; g1[j] = *(const f32x4*)(ada + 2048 + c) * gpm[j]; sh2[j] = *(const f32x4*)(ada + 3072 + c); sc2[j] = (*(const f32x4*)(ada + 4096 + c) + 1.f) * gpf[j]; } }
#pragma unroll
        for (int j = 0; j < 4; ++j) ss += (y[j].x * y[j].x + y[j].y * y[j].y) + (y[j].z * y[j].z + y[j].w * y[j].w);
        const float rs = rsqrtf(wave_sum(ss) * (1.f / DM) + EPS); float s1 = 0.f;
#pragma unroll
        for (int j = 0; j < 4; ++j) { const int c = 4 * lane + 256 * j;
            x1[j] = x1[j] + g1[j] * (y[j] * rs); *(f32x4*)(FP_out + OFF_Y + (size_t)m * DM + c) = x1[j];
            s1 += (x1[j].x * x1[j].x + x1[j].y * x1[j].y) + (x1[j].z * x1[j].z + x1[j].w * x1[j].w); }
        const float r1 = rsqrtf(wave_sum(s1) * (1.f / DM) + EPS);
#pragma unroll
        for (int j = 0; j < 4; ++j) { const int c = 4 * lane + 256 * j;
            const f32x4 hv = (x1[j] * r1) * sc2[j] + sh2[j]; u32x2 o; o.x = pk2(hv.x, hv.y); o.y = pk2(hv.z, hv.w); *(u32x2*)(FP_H1 + (size_t)m * DM + c) = o; }
    }
}
__device__ __forceinline__ void rows_final(const Frame& F) {
    const int lane = F.lane, gw = F.vcu * NWAVES + F.wave, NGW = F.G * NWAVES;
    const int r_lo = (int)(((long)gw * MT) / NGW), r_hi = (int)(((long)(gw + 1) * MT) / NGW);
    f32x4 gpf[4], g2[4], yn[4], xn[4];
#pragma unroll
    for (int j = 0; j < 4; ++j) { gpf[j] = *(const f32x4*)(FP_g_post_ffn + 4 * lane + 256 * j); g2[j] = gpf[j]; yn[j] = gpf[j]; xn[j] = gpf[j]; }
    int ccur = -1;
    if (r_lo < r_hi) { const float* xr = FP_out + OFF_Y + (size_t)r_lo * DM; const float* yr = FP_Y + (size_t)r_lo * DM;
#pragma unroll
        for (int j = 0; j < 4; ++j) { yn[j] = *(const f32x4*)(yr + 4 * lane + 256 * j); xn[j] = *(const f32x4*)(xr + 4 * lane + 256 * j); } }
    for (int m = r_lo; m < r_hi; ++m) {
        f32x4 y[4], x1[4]; float ss = 0.f;
#pragma unroll
        for (int j = 0; j < 4; ++j) { y[j] = yn[j]; x1[j] = xn[j]; }
        if (m + 1 < r_hi) { const float* xr = FP_out + OFF_Y + (size_t)(m + 1) * DM; const float* yr = FP_Y + (size_t)(m + 1) * DM;
#pragma unroll
            for (int j = 0; j < 4; ++j) { yn[j] = *(const f32x4*)(yr + 4 * lane + 256 * j); xn[j] = *(const f32x4*)(xr + 4 * lane + 256 * j); } }
        const int cr = crow_of(m);
        if (cr != ccur) { ccur = cr; const float* ada = FP_ADA + (size_t)cr * 6144;
#pragma unroll
            for (int j = 0; j < 4; ++j) g2[j] = *(const f32x4*)(ada + 5120 + 4 * lane + 256 * j) * gpf[j]; }
#pragma unroll
        for (int j = 0; j < 4; ++j) ss += (y[j].x * y[j].x + y[j].y * y[j].y) + (y[j].z * y[j].z + y[j].w * y[j].w);
        const float rs = rsqrtf(wave_sum(ss) * (1.f / DM) + EPS);
#pragma unroll
        for (int j = 0; j < 4; ++j) *(f32x4*)(FP_out + OFF_Y + (size_t)m * DM + 4 * lane + 256 * j) = x1[j] + g2[j] * (y[j] * rs);
    }
}
__device__ __forceinline__ float gelu_tanh(float x) { const float u = 1.5957691216057308f * (x + 0.044715f * x * x * x); return x * __builtin_amdgcn_rcpf(1.f + __builtin_amdgcn_exp2f(-u * LOG2E)); }
__device__ __forceinline__ void geglu_hist(const Frame& F, int m, int f0, f32x4& p10, f32x4& p11, f32x4& p20, f32x4& p21) {
    const f32x4 z4 = {0.f, 0.f, 0.f, 0.f};
    if (m < MP) { const int t = m & (TP - 1);
        if (t >= 1) unpack8(*(const u32x4*)(FP_UA + (size_t)(m - 1) * DFF + f0), p10, p11); else { p10 = z4; p11 = z4; }
        if (t >= 2) unpack8(*(const u32x4*)(FP_UA + (size_t)(m - 2) * DFF + f0), p20, p21); else { p20 = z4; p21 = z4; }
    } else { const int t = (m - MP) & 3, n = (m - MP) >> 2; const float* st = FP_state_conv + (size_t)n * 2 * DFF + f0;
        if (t >= 1) unpack8(*(const u32x4*)(FP_UA + (size_t)(m - 1) * DFF + f0), p10, p11); else { p10 = *(const f32x4*)(st + DFF); p11 = *(const f32x4*)(st + DFF + 4); }
        if (t >= 2) unpack8(*(const u32x4*)(FP_UA + (size_t)(m - 2) * DFF + f0), p20, p21);
        else if (t == 1) { p20 = *(const f32x4*)(st + DFF); p21 = *(const f32x4*)(st + DFF + 4); } else { p20 = *(const f32x4*)st; p21 = *(const f32x4*)(st + 4); } }
}
__device__ __forceinline__ void geglu_phase(const Frame& F) {
    constexpr int RB = 66, NBLK = MT / RB;
    if (F.tid >= 352) return;
    const int f0 = 8 * F.tid;
    const f32x4 w00 = *(const f32x4*)(FP_conv_w + f0), w01 = *(const f32x4*)(FP_conv_w + f0 + 4), w10 = *(const f32x4*)(FP_conv_w + DFF + f0), w11 = *(const f32x4*)(FP_conv_w + DFF + f0 + 4),
                w20 = *(const f32x4*)(FP_conv_w + 2 * DFF + f0), w21 = *(const f32x4*)(FP_conv_w + 2 * DFF + f0 + 4), cb0 = *(const f32x4*)(FP_conv_b + f0), cb1 = *(const f32x4*)(FP_conv_b + f0 + 4);
    for (int blk = F.vcu; blk < NBLK; blk += F.G) {
        const int m0 = blk * RB;
        f32x4 p10, p11, p20, p21;
        geglu_hist(F, m0, f0, p10, p11, p20, p21);
        u32x4 qa[4], qb[4];
#pragma unroll
        for (int i = 0; i < 4; ++i) { qa[i] = *(const u32x4*)(FP_UA + (size_t)(m0 + i) * DFF + f0); qb[i] = *(const u32x4*)(FP_UB + (size_t)(m0 + i) * DFF + f0); }
        for (int r0 = 0; r0 < RB; r0 += 4) {
#pragma unroll
            for (int i = 0; i < 4; ++i) {
                const int r = r0 + i;
                if (r < RB) {
                    const int m = m0 + r;
                    f32x4 a0, a1, b0, b1; unpack8(qa[i], a0, a1); unpack8(qb[i], b0, b1);
                    if (r + 4 < RB) { qa[i] = *(const u32x4*)(FP_UA + (size_t)(m + 4) * DFF + f0); qb[i] = *(const u32x4*)(FP_UB + (size_t)(m + 4) * DFF + f0); }
                    const bool seq_start = (m < MP) ? ((m & (TP - 1)) == 0) : (((m - MP) & 3) == 0);
                    if (seq_start && r != 0) geglu_hist(F, m, f0, p10, p11, p20, p21);
                    f32x4 c0 = cb0 + w00 * p20 + w10 * p10 + w20 * a0, c1 = cb1 + w01 * p21 + w11 * p11 + w21 * a1;
                    c0.x = gelu_tanh(c0.x) * b0.x; c0.y = gelu_tanh(c0.y) * b0.y; c0.z = gelu_tanh(c0.z) * b0.z; c0.w = gelu_tanh(c0.w) * b0.w;
                    c1.x = gelu_tanh(c1.x) * b1.x; c1.y = gelu_tanh(c1.y) * b1.y; c1.z = gelu_tanh(c1.z) * b1.z; c1.w = gelu_tanh(c1.w) * b1.w;
                    *(bf16x8*)(FP_GB + (size_t)m * DFF + f0) = pack8(c0, c1);
                    p20 = p10; p21 = p11; p10 = a0; p11 = a1;
                }
            }
        }
    }
}

__device__ __forceinline__ void attention_phase(const Frame& F, volatile LAS unsigned* MISC) {
    unsigned* ctl = (unsigned*)(F.a->ws + WS_CTL) + CW_SCHED;
    const int xq = (F.vcu * 8) / F.G;
    const float lam = lambda_full(F, F.lane);
    for (;;) {
        if (F.tid == 0) {
            int kind = -1; unsigned idx = 0u;
            unsigned* QD = ctl + 64 * 8; unsigned* NS = ctl + 64 * (9 + xq);
            if (xb_ld(QD) < 512u) { const unsigned sn = xb_add(NS, 1u);
                if (sn < (unsigned)DEC_LIM8) { const unsigned d = xb_add(QD, 1u); if (d < 512u) { kind = 1; idx = d; } }
                if (kind < 0) (void)__hip_atomic_fetch_sub(NS, 1u, __ATOMIC_RELAXED, __HIP_MEMORY_SCOPE_AGENT); }
            for (int k = 0; k < 8 && kind < 0; ++k) { const int x = (xq + k) & 7; unsigned* QP = ctl + 64 * x;
                if (xb_ld(QP) < 64u) { const unsigned p = xb_add(QP, 1u); if (p < 64u) { kind = 0; idx = (unsigned)x * 64u + p; } } }
            if (kind < 0) { const unsigned d = xb_add(QD, 1u); if (d < 512u) { kind = 2; idx = d; } }
            MISC[0] = (unsigned)kind; MISC[1] = idx;
        }
        WG_BAR();
        const int kind = (int)MISC[0]; const int idx = (int)MISC[1];
        WG_BAR();
        if (kind < 0) break;
        if (kind == 0) { const int bh = idx >> 6, j = idx & 63, qb = 31 - (j >> 1), map = j & 1; attn_half_unit(F, bh, qb, map, map ? FP_O2 : FP_O1); }
        else { decode_unit(F, idx, lam);
               if (kind == 1 && F.tid == 0) (void)__hip_atomic_fetch_sub(ctl + 64 * (9 + xq), 1u, __ATOMIC_RELAXED, __HIP_MEMORY_SCOPE_AGENT); }
    }
}

constexpr int NPHASE = 15;
#ifndef DUPMASK
#define DUPMASK 0
#endif
__global__ void __launch_bounds__(NTHR, 2) fwd_kernel(Args args) {
    extern __shared__ __attribute__((aligned(16))) unsigned char lds_raw[];
    Frame F;
    F.lds = (LAS unsigned char*)lds_raw;
    F.tid = threadIdx.x; F.lane = F.tid & 63; F.wave = __builtin_amdgcn_readfirstlane(F.tid >> 6);
    F.G = gridDim.x; { const int bx = blockIdx.x; F.vcu = (F.G % 8 == 0) ? (bx % 8) * (F.G / 8) + bx / 8 : bx; }
    F.a = &args; unsigned char* ws = args.ws;
    volatile LAS unsigned* MISC = (volatile LAS unsigned*)(F.lds + MISC_OFF);
    for (int u = F.tid; u < (LDS_BYTES - RING_BYTES) / 4; u += NTHR) ((LAS unsigned*)(F.lds + RING_BYTES))[u] = 0u;
    __syncthreads();
    const int lo = args.ph_lo, hi = args.ph_hi;
    const bool multi = (hi - lo) > 1;
    XcdBarrier bar; bar.bar = (unsigned*)(ws + WS_CTL) + CW_BAR; bar.x = 0; bar.st = nullptr;
    if (multi) bar = xcd_barrier_post((unsigned*)(ws + WS_CTL) + CW_BAR, MISC + 8);
#define IN(k) (lo <= (k) && (k) < hi)
#define SEAM(k) do { if (IN(k) && IN((k) + 1)) xcd_barrier(bar); } while (0)

#define DUP(k, ...) do { { __VA_ARGS__ } if ((DUPMASK >> (k)) & 1) { __VA_ARGS__ } } while (0)
    if (IN(0)) { DUP(0,  p0_ada(F); p0_transposes(F); ); } SEAM(0);
    if (IN(1)) { DUP(1,  p1_norm_gates(F); WG_BAR(); ); } SEAM(1);
    if (IN(2)) { DUP(2,  pg8::Gemm g{FP_H1, FP_WinT, MT, ZP, DM}; pg8::StaticOrder S; S.init(MT, ZP, F.G, (int)blockIdx.x); EpiZ E{FP_Z, FP_out}; pg8::gemm_phase(F.lds, g, S, E); ); } SEAM(2);
    if (IN(3)) { DUP(3,  for (int i = 0; i < 4; ++i) { const int u = F.vcu * 4 + i; if (u < 1024) mlstm_A_unit(F, u); }
                 if (F.G != 256) for (int u = 4 * F.G + F.vcu; u < 1024; u += F.G) mlstm_A_unit(F, u);
                 for (int u = F.vcu; u < 512; u += F.G) smlstm_unit(F, u); ); } SEAM(3);
    if (IN(4)) { DUP(4,  for (int it = F.vcu; it < 256; it += F.G) mlstm_scan_item(F, it); ); } SEAM(4);
    if (IN(5)) { attention_phase(F, MISC); } SEAM(5);
    if (IN(6)) { DUP(6,  for (int i = 0; i < 4; ++i) { const int u = F.vcu * 4 + i; if (u < 1024) mlstm_C_unit(F, u); }
                 if (F.G != 256) for (int u = 4 * F.G + F.vcu; u < 1024; u += F.G) mlstm_C_unit(F, u);
                 attn_combine_rows(F); ); } SEAM(6);
    if (IN(7)) { DUP(7,  pg8::Gemm g{FP_HM, FP_WpmT, MP, DM, 512}; pg8::StaticOrder S; S.init(MP, DM, F.G, (int)blockIdx.x); EpiPM E{FP_Z, FP_MG}; pg8::gemm_phase(F.lds, g, S, E);
                 skinny_gemm(F, FP_HM + (size_t)MP * 512, FP_WpmT, 512, E); ); } SEAM(7);
    if (IN(8)) { pg8::Gemm g{FP_HD, FP_WpdT, MP, DM, 512}; pg8::StaticOrder S; S.init(MP, DM, F.G, (int)blockIdx.x); EpiPD E{FP_Z, FP_MG}; pg8::gemm_phase(F.lds, g, S, E);
                 skinny_gemm(F, FP_HD + (size_t)MP * 512, FP_WpdT, 512, E); } SEAM(8);
    if (IN(9)) { DUP(9,  pg8::Gemm g{FP_MG, FP_WoutT, MP, DM, DM}; pg8::StaticOrder S; S.init(MP, DM, F.G, (int)blockIdx.x); EpiF32 E{FP_Y}; pg8::gemm_phase(F.lds, g, S, E);
                 skinny_gemm(F, FP_MG + (size_t)MP * DM, FP_WoutT, DM, E); ); } SEAM(9);
    if (IN(10)) { DUP(10,  rows_post_mix(F); ); } SEAM(10);
    if (IN(11)) { DUP(11,  pg8::Gemm g{FP_H1, FP_WupT, MT, 2 * DFF, DM}; pg8::StaticOrder S; S.init(MT, 2 * DFF, F.G, (int)blockIdx.x); EpiUp E{FP_UA, FP_UB, FP_out}; pg8::gemm_phase(F.lds, g, S, E); ); } SEAM(11);
    if (IN(12)) { DUP(12,  geglu_phase(F); ); } SEAM(12);
    if (IN(13)) { DUP(13,  pg8::Gemm g{FP_GB, FP_WdownT, MP, DM, DFF}; pg8::StaticOrder S; S.init(MP, DM, F.G, (int)blockIdx.x); EpiF32 E{FP_Y}; pg8::gemm_phase(F.lds, g, S, E);
                  skinny_gemm(F, FP_GB + (size_t)MP * DFF, FP_WdownT, DFF, E); ); } SEAM(13);
    if (IN(14)) { rows_final(F); }
#undef DUP
#undef IN
#undef SEAM
}

#ifndef MK_ONE_LAUNCH
#define MK_ONE_LAUNCH 1
#endif
extern "C" void kernel_launch(void* const* d_in, const int* in_sizes, int n_in, void* d_out, int out_size, void* d_ws, size_t ws_size, hipStream_t stream) {
    static int grid = 0;
    if (grid == 0) {
        if (n_in != 32 || out_size != (int)OUT_TOTAL || ws_size < WS_END) { fprintf(stderr, "kernel_launch: unexpected sizes n_in %d out %d ws %zu\n", n_in, out_size, ws_size); grid = -1; return; }
        int dev = 0, cus = 0, per_cu = 0;
        if (hipGetDevice(&dev) != hipSuccess || hipDeviceGetAttribute(&cus, hipDeviceAttributeMultiprocessorCount, dev) != hipSuccess) { grid = -1; return; }
        if (hipFuncSetAttribute((const void*)fwd_kernel, hipFuncAttributeMaxDynamicSharedMemorySize, LDS_BYTES) != hipSuccess) { fprintf(stderr, "kernel_launch: hipFuncSetAttribute failed\n"); grid = -1; return; }
        if (hipOccupancyMaxActiveBlocksPerMultiprocessor(&per_cu, (const void*)fwd_kernel, NTHR, LDS_BYTES) != hipSuccess || per_cu < 1) fprintf(stderr, "kernel_launch: occupancy query reports %d\n", per_cu);
        (void)hipGetLastError();
        grid = cus;
    }
    if (grid < 0) return;
    if (hipMemsetAsync((char*)d_ws + WS_CTL, 0, CTL_ZERO_BYTES, stream) != hipSuccess) return;
    Args a{};
    for (int i = 0; i < 32; ++i) a.in[i] = d_in[i];
    a.out = (float*)d_out; a.ws = (unsigned char*)d_ws;
#if MK_ONE_LAUNCH
    a.ph_lo = 0; a.ph_hi = NPHASE;
    hipLaunchKernelGGL(fwd_kernel, dim3(grid), dim3(NTHR), LDS_BYTES, stream, a);
#else
    for (int p = 0; p < NPHASE; ++p) { a.ph_lo = p; a.ph_hi = p + 1; hipLaunchKernelGGL(fwd_kernel, dim3(grid), dim3(NTHR), LDS_BYTES, stream, a); }
#endif
}
```

```cpp
#include <hip/hip_runtime.h>
#include <cstdio>
#include <cstdint>

#define LAS __attribute__((address_space(3)))
#define GAS __attribute__((address_space(1)))
typedef unsigned short bf16_t;
typedef short bf16x8 __attribute__((ext_vector_type(8)));
typedef short s16x4 __attribute__((ext_vector_type(4)));
typedef short v4i16_t __attribute__((ext_vector_type(4)));
typedef float f32x2 __attribute__((ext_vector_type(2)));
typedef float f32x4 __attribute__((ext_vector_type(4)));
typedef float f32x16 __attribute__((ext_vector_type(16)));
typedef unsigned u32x2 __attribute__((ext_vector_type(2)));
typedef unsigned u32x4 __attribute__((ext_vector_type(4)));
typedef __bf16 bf16x2_t __attribute__((ext_vector_type(2)));
typedef GAS unsigned gu32;

constexpr int DM = 1024, TP = 8192, MP = 16384, MS = 512, MT = MP + MS;
constexpr int NSEQ = 128, TS = 4, NPAGES = 16, PAGE = 128, PAST = 2048;
constexpr int DIN = 5640, ZP = 5632, DFF = 2816;
constexpr int ZQ = 0, ZK = 512, ZV = 1024, ZO = 1536, ZDQ = 2048, ZDK = 2560, ZDV = 3072, ZGM = 3584, ZGD = 4608;
constexpr float EPS = 1e-6f, LAM_INIT = 0.2f, LOG2E = 1.4426950408889634f;
constexpr float QSCALE = 0.125f * LOG2E;
constexpr float KSCALE = 0.08838834764831845f;
constexpr size_t OFF_Y = 0, OFF_KP = 17301504, OFF_VP = 25690112, OFF_CP = 34078720, OFF_NP = 34209792, OFF_MP = 34210816, OFF_CVP = 34210824,
                 OFF_KS = 34222088, OFF_VS = 34484232, OFF_CS = 34746376, OFF_NS = 43134984, OFF_MS = 43200520, OFF_CVS = 43201032, OUT_TOTAL = 43921928;
constexpr size_t MiB = 1u << 20;
constexpr size_t WS_CTL = 0, CTL_ZERO_BYTES = 1 * MiB;
constexpr size_t WS_WIN = 1 * MiB, WS_WUP = 12 * MiB, WS_WDOWN = 23 * MiB, WS_WOUT = 29 * MiB, WS_WPM = 31 * MiB, WS_WPD = 32 * MiB;
constexpr size_t WS_ADA = 33 * MiB, WS_IG = 37 * MiB, WS_LF = 37 * MiB + 512 * 1024, WS_ST = 38 * MiB, WS_NU = 38 * MiB + 65536, WS_NPREV = 39 * MiB, WS_MPREV = 39 * MiB + 768 * 1024;
constexpr size_t WS_H1 = 40 * MiB, WS_Z = 73 * MiB, WS_U = 255 * MiB, WS_CPREV = 319 * MiB, WS_HM = 351 * MiB, WS_HD = 368 * MiB, WS_O1 = 385 * MiB, WS_O2 = 417 * MiB;
constexpr size_t WS_MG = 449 * MiB, WS_Y = 482 * MiB, WS_UA = 548 * MiB, WS_UB = 639 * MiB, WS_G = 730 * MiB, WS_END = 821 * MiB;
constexpr int CW_BAR = 4096, CW_SCHED = 8192;
#ifndef DEC_LIM8
#define DEC_LIM8 12
#endif
constexpr int RING_BYTES = 131072, MISC_OFF = RING_BYTES + 320, LDS_BYTES = 147456;
constexpr int NWAVES = 8, NTHR = 512;

__device__ __forceinline__ unsigned pk2(float lo, float hi) { f32x2 v = {lo, hi}; bf16x2_t b = __builtin_convertvector(v, bf16x2_t); return __builtin_bit_cast(unsigned, b); }
__device__ __forceinline__ bf16_t f2bf(float x) { return (bf16_t)(pk2(x, 0.f) & 0xffffu); }
__device__ __forceinline__ float bflo(unsigned u) { return __uint_as_float(u << 16); }
__device__ __forceinline__ float bfhi(unsigned u) { return __uint_as_float(u & 0xffff0000u); }
__device__ __forceinline__ float bf2f(bf16_t u) { return __uint_as_float(((unsigned)u) << 16); }
__device__ __forceinline__ bf16x8 pack8(f32x4 a, f32x4 b) { u32x4 w; w.x = pk2(a.x, a.y); w.y = pk2(a.z, a.w); w.z = pk2(b.x, b.y); w.w = pk2(b.z, b.w); return __builtin_bit_cast(bf16x8, w); }
__device__ __forceinline__ void unpack8(u32x4 w, f32x4& a, f32x4& b) { a.x = bflo(w.x); a.y = bfhi(w.x); a.z = bflo(w.y); a.w = bfhi(w.y); b.x = bflo(w.z); b.y = bfhi(w.z); b.z = bflo(w.w); b.w = bfhi(w.w); }
__device__ __forceinline__ float wave_sum(float v) {
#pragma unroll
    for (int o = 1; o < 64; o <<= 1) v += __shfl_xor(v, o);
    return v;
}
__device__ __forceinline__ float wave_max(float v) {
#pragma unroll
    for (int o = 1; o < 64; o <<= 1) v = fmaxf(v, __shfl_xor(v, o));
    return v;
}
__device__ __forceinline__ float wave_scan_sum(float v, int lane) {
#pragma unroll
    for (int o = 1; o < 64; o <<= 1) { const float t = __shfl_up(v, o); if (lane >= o) v += t; }
    return v;
}
__device__ __forceinline__ float wave_scan_max(float v, int lane) {
#pragma unroll
    for (int o = 1; o < 64; o <<= 1) { const float t = __shfl_up(v, o); if (lane >= o) v = fmaxf(v, t); }
    return v;
}
__device__ __forceinline__ float sigmoidf_(float x) { return __builtin_amdgcn_rcpf(1.f + __builtin_amdgcn_exp2f(-x * LOG2E)); }
__device__ __forceinline__ float log_sigmoid(float x) { return fminf(x, 0.f) - log1pf(__expf(-fabsf(x))); }
__device__ __forceinline__ int crow(int reg, int h) { return (reg & 3) + 8 * (reg >> 2) + 4 * h; }
#define MFMA32(a, b, c) __builtin_amdgcn_mfma_f32_32x32x16_bf16((a), (b), (c), 0, 0, 0)
#define MFMA16(a, b, c) __builtin_amdgcn_mfma_f32_16x16x32_bf16((a), (b), (c), 0, 0, 0)
__device__ __forceinline__ s16x4 tr_rd(const LAS unsigned char* p) { return __builtin_bit_cast(s16x4, __builtin_amdgcn_ds_read_tr16_b64_v4i16((LAS v4i16_t*)p)); }
__device__ __forceinline__ bf16x8 cat4(s16x4 lo, s16x4 hi) { return (bf16x8){lo[0], lo[1], lo[2], lo[3], hi[0], hi[1], hi[2], hi[3]}; }
#define WG_BAR() __syncthreads()

namespace pg8 {
constexpr int BM = 256, BK = 64, HALF = 128, HTB = HALF * BK * 2, STAGE_BYTES = 8 * HTB, NXCD = 8, WGM = 8;
__host__ __device__ __forceinline__ int lds_byte(int r, int c) { const int st = (r >> 4) * 2 + (c >> 5), rr = r & 15, cc = c & 31, ob = rr * 64 + cc * 2; return st * 1024 + (ob ^ (((ob >> 9) & 1) << 5)); }
__host__ __device__ __forceinline__ void stage_rc(int b, int& R, int& C) { const int st = b / 1024, sb = b % 1024, swz = sb ^ (((sb >> 9) & 1) << 5); R = (st >> 1) * 16 + swz / 64; C = (st & 1) * 32 + (swz % 64) / 2; }
__host__ __device__ __forceinline__ int perm32(int rho) { const int n = rho >> 4, i = rho & 15; return 8 * (i >> 2) + 4 * n + (i & 3); }
struct Unit { int pm, pn; };
struct Gemm { const bf16_t* A; const bf16_t* Bt; int M, N, K; };
struct StaticOrder {
    int nM, nN, nwg, G, c;
    __host__ __device__ void init(int M, int N, int G_, int c_) { nM = M / BM; nN = N / BM; nwg = nM * nN; G = G_; c = c_; }
    __host__ __device__ bool next(int i, Unit& u) const {
        const long L = (long)i * G + c; if (L >= nwg) return false;
        int wgid = (int)L; { const int q = nwg / NXCD, r = nwg % NXCD, xcd = wgid % NXCD, off = wgid / NXCD; wgid = (xcd < r ? xcd * (q + 1) : r * (q + 1) + (xcd - r) * q) + off; }
        const int nig = WGM * nN, gid = wgid / nig, fm = gid * WGM, gsz = (nM - fm) < WGM ? (nM - fm) : WGM;
        u.pm = fm + ((wgid % nig) % gsz); u.pn = (wgid % nig) / gsz; return true;
    }
};
template <class Epi>
__device__ __forceinline__ void gemm_phase(LAS unsigned char* lds, const Gemm g, const StaticOrder& S, const Epi& E) {
    const int tid = threadIdx.x, wid = __builtin_amdgcn_readfirstlane(tid >> 6), lane = tid & 63, wr = wid >> 2, wc = wid & 3, fr = lane & 15, fq = lane >> 4;
    const int K = g.K, nt = K / BK;
    unsigned voffA[2], voffB[2];
#pragma unroll
    for (int i = 0; i < 2; ++i) { int R, C; stage_rc(tid * 16 + i * 8192, R, C); const int Rb = (R & ~31) + perm32(R & 31);
        voffA[i] = (unsigned)(R * K + C) * 2u; voffB[i] = (unsigned)(Rb * K + C) * 2u; }
    const size_t kstep = (size_t)(BK * 2);
    const size_t hstep = (size_t)HALF * K * 2;
    const size_t tstep = 2 * hstep;
    const unsigned ldsw = (unsigned)wid * 1024u;
    const int aoff = lds_byte(wr * 64 + fr, fq * 8), boff = lds_byte(wc * 32 + fr, fq * 8);
#define PG8_SA(b, h) (((b) * 2 + (h)) * HTB)
#define PG8_SB(b, h) ((4 + (b) * 2 + (h)) * HTB)
#define PG8_STAGE(bufoff, gbase, voff) do { _Pragma("unroll") for (int _i = 0; _i < 2; ++_i) \
        __builtin_amdgcn_global_load_lds((const unsigned*)((const char*)(gbase) + (voff)[_i]), (LAS unsigned*)(lds + (bufoff) + ldsw + _i * 8192), 16, 0, 0); } while (0)
#define PG8_LDA(dst, b, h) do { _Pragma("unroll") for (int m = 0; m < 4; ++m) _Pragma("unroll") for (int k = 0; k < 2; ++k) dst[m][k] = *(const LAS bf16x8*)(lds + PG8_SA(b, h) + aoff + m * 2048 + k * 1024); } while (0)
#define PG8_LDB(dst, b, h) do { _Pragma("unroll") for (int n = 0; n < 2; ++n) _Pragma("unroll") for (int k = 0; k < 2; ++k) dst[n][k] = *(const LAS bf16x8*)(lds + PG8_SB(b, h) + boff + n * 2048 + k * 1024); } while (0)
#define PG8_MMA(ai, bj, At, Bt) do { __builtin_amdgcn_s_setprio(1); _Pragma("unroll") for (int m = 0; m < 4; ++m) _Pragma("unroll") for (int n = 0; n < 2; ++n) _Pragma("unroll") for (int k = 0; k < 2; ++k) \
        acc[ai][bj][m][n] = __builtin_amdgcn_mfma_f32_16x16x32_bf16(Bt[n][k], At[m][k], acc[ai][bj][m][n], 0, 0, 0); __builtin_amdgcn_s_setprio(0); } while (0)
#define PG8_WAIT_V(n) asm volatile("s_waitcnt vmcnt(" #n ")" ::: "memory")
#define PG8_WAIT_L(n) asm volatile("s_waitcnt lgkmcnt(" #n ")" ::: "memory")
#define PG8_BAR __builtin_amdgcn_s_barrier()
#define PG8_SCHED __builtin_amdgcn_sched_barrier(0)
    Unit cur, nxt; int ui = 0;
    if (!S.next(0, cur)) return;
    f32x4 acc[2][2][4][2];
#pragma unroll
    for (int a = 0; a < 2; ++a)
#pragma unroll
        for (int b = 0; b < 2; ++b)
#pragma unroll
            for (int m = 0; m < 4; ++m)
#pragma unroll
                for (int n = 0; n < 2; ++n) acc[a][b][m][n] = (f32x4){0.f, 0.f, 0.f, 0.f};
    bf16x8 At[4][2], B0[2][2], B1[2][2];
    const char* cA = (const char*)g.A + (size_t)cur.pm * tstep; const char* cB = (const char*)g.Bt + (size_t)cur.pn * tstep;
    PG8_STAGE(PG8_SB(0, 0), cB, voffB); PG8_STAGE(PG8_SB(0, 1), cB + hstep, voffB); PG8_STAGE(PG8_SA(0, 0), cA, voffA); PG8_STAGE(PG8_SA(0, 1), cA + hstep, voffA);
    if (wr == 1) PG8_BAR;
    PG8_WAIT_V(2); PG8_BAR;
    PG8_STAGE(PG8_SB(1, 0), cB + kstep, voffB); PG8_STAGE(PG8_SA(1, 0), cA + kstep, voffA); PG8_STAGE(PG8_SB(1, 1), cB + hstep + kstep, voffB);
    PG8_WAIT_V(6); PG8_BAR;
    for (;;) {
        const bool has_next = S.next(ui + 1, nxt);
        const char* nA = has_next ? (const char*)g.A + (size_t)nxt.pm * tstep : cA; const char* nB = has_next ? (const char*)g.Bt + (size_t)nxt.pn * tstep : cB;
        for (int t = 0; t < nt; t += 2) {
            const bool last = (t == nt - 2);
            const char* a1 = cA + (size_t)(t + 1) * kstep;
            const char* a2 = last ? nA : cA + (size_t)(t + 2) * kstep; const char* b2 = last ? nB : cB + (size_t)(t + 2) * kstep;
            const char* a3 = a2 + kstep; const char* b3 = b2 + kstep;
            PG8_LDB(B0, 0, 0); PG8_LDB(B1, 0, 1); PG8_SCHED; PG8_LDA(At, 0, 0); PG8_STAGE(PG8_SA(1, 1), a1 + hstep, voffA);
            PG8_WAIT_V(8); PG8_WAIT_L(0); PG8_BAR; PG8_MMA(0, 0, At, B0); PG8_MMA(0, 1, At, B1); PG8_BAR; PG8_SCHED;
            PG8_LDA(At, 0, 1); PG8_STAGE(PG8_SB(0, 0), b2, voffB); PG8_STAGE(PG8_SB(0, 1), b2 + hstep, voffB); PG8_STAGE(PG8_SA(0, 0), a2, voffA);
            PG8_WAIT_V(8); PG8_WAIT_L(0); PG8_BAR; PG8_MMA(1, 0, At, B0); PG8_MMA(1, 1, At, B1); PG8_BAR; PG8_SCHED;
            PG8_LDB(B0, 1, 0); PG8_LDB(B1, 1, 1); PG8_SCHED; PG8_LDA(At, 1, 0); PG8_STAGE(PG8_SA(0, 1), a2 + hstep, voffA);
            PG8_WAIT_V(8); PG8_WAIT_L(0); PG8_BAR; PG8_MMA(0, 0, At, B0); PG8_MMA(0, 1, At, B1); PG8_BAR; PG8_SCHED;
            PG8_LDA(At, 1, 1); PG8_STAGE(PG8_SB(1, 0), b3, voffB); PG8_STAGE(PG8_SB(1, 1), b3 + hstep, voffB); PG8_STAGE(PG8_SA(1, 0), a3, voffA);
            PG8_WAIT_V(8); PG8_WAIT_L(0); PG8_BAR; PG8_MMA(1, 0, At, B0); PG8_MMA(1, 1, At, B1); PG8_BAR; PG8_SCHED;
        }
        if (wr == 0) PG8_BAR;
        {
            const int row0 = cur.pm * BM + wr * 64 + fr, col0 = cur.pn * BM + wc * 32 + 8 * fq;
#pragma unroll
            for (int ai = 0; ai < 2; ++ai)
#pragma unroll
                for (int m = 0; m < 4; ++m)
#pragma unroll
                    for (int bj = 0; bj < 2; ++bj) E.st8(row0 + ai * HALF + m * 16, col0 + bj * HALF, acc[ai][bj][m][0], acc[ai][bj][m][1]);
        }
        if (!has_next) break;
#pragma unroll
        for (int a = 0; a < 2; ++a)
#pragma unroll
            for (int b = 0; b < 2; ++b)
#pragma unroll
                for (int m = 0; m < 4; ++m)
#pragma unroll
                    for (int n = 0; n < 2; ++n) acc[a][b][m][n] = (f32x4){0.f, 0.f, 0.f, 0.f};
        cur = nxt; cA = nA; cB = nB; ++ui;
        if (wr == 1) PG8_BAR;
    }
    PG8_WAIT_V(0);
    PG8_BAR;
#undef PG8_SA
#undef PG8_SB
#undef PG8_STAGE
#undef PG8_LDA
#undef PG8_LDB
#undef PG8_MMA
#undef PG8_WAIT_V
#undef PG8_WAIT_L
#undef PG8_BAR
#undef PG8_SCHED
}
}

#define XB_TMO      128
#define XB_XCNT(j)  (256  + 64 * (j))
#define XB_XSUB(j)  (1280 + 64 * (j))
#define XB_XGEN(j)  (2304 + 64 * (j))
#define XB_TOP      3328
#define XB_TOPGEN   3392
#define XCD_BAR_WORDS 3456
#define XB_SPIN_CAP (1u << 18)
__device__ __forceinline__ unsigned xb_ld(unsigned* p)              { return __hip_atomic_load(p, __ATOMIC_RELAXED, __HIP_MEMORY_SCOPE_AGENT); }
__device__ __forceinline__ unsigned xb_add(unsigned* p, unsigned v) { return __hip_atomic_fetch_add(p, v, __ATOMIC_RELAXED, __HIP_MEMORY_SCOPE_AGENT); }
__device__ __forceinline__ unsigned xb_xcc_id() { return (unsigned)__builtin_amdgcn_s_getreg((3 << 11) | 20) & 0xFu; }
#define XB_SPIN(cond, bar) do { unsigned _sp = 0; while (cond) { __builtin_amdgcn_s_sleep(1); \
    if ((++_sp & 255u) == 0u) { if (xb_ld(&(bar)[XB_TMO])) break; if (_sp > XB_SPIN_CAP) { atomicAdd(&(bar)[XB_TMO], 1u); break; } } } } while (0)
struct XcdBarrier { unsigned* bar; unsigned x; volatile LAS unsigned* st; };
__device__ __forceinline__ XcdBarrier xcd_barrier_post(unsigned* bar, volatile LAS unsigned* st) {
    XcdBarrier b; b.bar = bar; b.x = xb_xcc_id(); b.st = st;
    if (threadIdx.x == 0) (void)xb_add(&bar[XB_XCNT(b.x)], 1u);
    return b;
}
__device__ __forceinline__ void xcd_barrier_complete(unsigned* bar, unsigned x, unsigned& nloc, unsigned& nx) {
    const unsigned G = gridDim.x * gridDim.y * gridDim.z;
    unsigned sum, cnt, mine, sp = 0u;
    for (;;) {
        sum = 0u; cnt = 0u; mine = 0u;
#pragma unroll
        for (unsigned j = 0; j < 16; ++j) { const unsigned c = xb_ld(&bar[XB_XCNT(j)]); sum += c; cnt += (c > 0u) ? 1u : 0u; mine = (j == x) ? c : mine; }
        if (sum == G) break;
        __builtin_amdgcn_s_sleep(1);
        if ((++sp & 255u) == 0u) { if (xb_ld(&bar[XB_TMO])) break; if (sp > XB_SPIN_CAP) { atomicAdd(&bar[XB_TMO], 1u); break; } }
    }
    nloc = mine > 0u ? mine : 1u; nx = cnt > 0u ? cnt : 1u;
}
__device__ __forceinline__ void xcd_barrier(const XcdBarrier& b) {
    asm volatile("s_waitcnt vmcnt(0)" ::: "memory");
    __syncthreads();
    if (threadIdx.x == 0) {
        unsigned* bar = b.bar;
        __builtin_amdgcn_s_waitcnt(0);
        unsigned nloc = b.st[0], nx = b.st[1];
        if (nloc == 0u) { xcd_barrier_complete(bar, b.x, nloc, nx); b.st[0] = nloc; b.st[1] = nx; }
        const unsigned old = xb_add(&bar[XB_XSUB(b.x)], 1u);
        const unsigned gen = old / nloc;
        if (old + 1u == (gen + 1u) * nloc) {
            __builtin_amdgcn_fence(__ATOMIC_RELEASE, "agent");
            asm volatile("s_waitcnt vmcnt(0)" ::: "memory");
            const unsigned og = xb_add(&bar[XB_TOP], 1u);
            const unsigned tg = og / nx;
            if (og + 1u == (tg + 1u) * nx) xb_add(&bar[XB_TOPGEN], 1u);
            else XB_SPIN(xb_ld(&bar[XB_TOPGEN]) == tg, bar);
            __builtin_amdgcn_fence(__ATOMIC_ACQUIRE, "agent");
            xb_add(&bar[XB_XGEN(b.x)], 1u);
            asm volatile("s_waitcnt vmcnt(0)" ::: "memory");
        } else {
            XB_SPIN(xb_ld(&bar[XB_XGEN(b.x)]) == gen, bar);
            __builtin_amdgcn_fence(__ATOMIC_ACQUIRE, "agent");
            asm volatile("s_waitcnt vmcnt(0)" ::: "memory");
        }
    }
    __syncthreads();
}

struct Args { const void* in[32]; float* out; unsigned char* ws; int ph_lo, ph_hi; };
struct Frame { LAS unsigned char* lds; int tid, lane, wave, vcu, G; const Args* a; };
#define FP_x_prompt ((const float*)F.a->in[0])
#define FP_x_sample ((const float*)F.a->in[1])
#define FP_c_prompt ((const float*)F.a->in[2])
#define FP_c_sample ((const float*)F.a->in[3])
#define FP_cache_k ((const float*)F.a->in[4])
#define FP_cache_v ((const float*)F.a->in[5])
#define FP_page_table ((const int*)F.a->in[6])
#define FP_state_C ((const float*)F.a->in[7])
#define FP_state_n ((const float*)F.a->in[8])
#define FP_state_m ((const float*)F.a->in[9])
#define FP_state_conv ((const float*)F.a->in[10])
#define FP_w_ada ((const float*)F.a->in[11])
#define FP_b_ada ((const float*)F.a->in[12])
#define FP_g_pre_mix ((const float*)F.a->in[13])
#define FP_g_post_mix ((const float*)F.a->in[14])
#define FP_w_in ((const float*)F.a->in[15])
#define FP_b_if ((const float*)F.a->in[16])
#define FP_g_mlstm ((const float*)F.a->in[17])
#define FP_lq1 ((const float*)F.a->in[18])
#define FP_lk1 ((const float*)F.a->in[19])
#define FP_lq2 ((const float*)F.a->in[20])
#define FP_lk2 ((const float*)F.a->in[21])
#define FP_g_diff ((const float*)F.a->in[22])
#define FP_w_proj_m ((const float*)F.a->in[23])
#define FP_w_proj_d ((const float*)F.a->in[24])
#define FP_w_out ((const float*)F.a->in[25])
#define FP_g_pre_ffn ((const float*)F.a->in[26])
#define FP_g_post_ffn ((const float*)F.a->in[27])
#define FP_w_up ((const float*)F.a->in[28])
#define FP_conv_w ((const float*)F.a->in[29])
#define FP_conv_b ((const float*)F.a->in[30])
#define FP_w_down ((const float*)F.a->in[31])
#define FP_WinT ((bf16_t*)(F.a->ws + WS_WIN))
#define FP_WupT ((bf16_t*)(F.a->ws + WS_WUP))
#define FP_WdownT ((bf16_t*)(F.a->ws + WS_WDOWN))
#define FP_WoutT ((bf16_t*)(F.a->ws + WS_WOUT))
#define FP_WpmT ((bf16_t*)(F.a->ws + WS_WPM))
#define FP_WpdT ((bf16_t*)(F.a->ws + WS_WPD))
#define FP_H1 ((bf16_t*)(F.a->ws + WS_H1))
#define FP_Z ((bf16_t*)(F.a->ws + WS_Z))
#define FP_CPREV ((bf16_t*)(F.a->ws + WS_CPREV))
#define FP_HM ((bf16_t*)(F.a->ws + WS_HM))
#define FP_HD ((bf16_t*)(F.a->ws + WS_HD))
#define FP_MG ((bf16_t*)(F.a->ws + WS_MG))
#define FP_UA ((bf16_t*)(F.a->ws + WS_UA))
#define FP_UB ((bf16_t*)(F.a->ws + WS_UB))
#define FP_GB ((bf16_t*)(F.a->ws + WS_G))
#define FP_ADA ((float*)(F.a->ws + WS_ADA))
#define FP_IG ((float*)(F.a->ws + WS_IG))
#define FP_LF ((float*)(F.a->ws + WS_LF))
#define FP_ST ((float*)(F.a->ws + WS_ST))
#define FP_NU ((float*)(F.a->ws + WS_NU))
#define FP_NPREV ((float*)(F.a->ws + WS_NPREV))
#define FP_MPREV ((float*)(F.a->ws + WS_MPREV))
#define FP_U ((float*)(F.a->ws + WS_U))
#define FP_O1 ((float*)(F.a->ws + WS_O1))
#define FP_O2 ((float*)(F.a->ws + WS_O2))
#define FP_Y ((bf16_t*)(F.a->ws + WS_Y))
#define FP_out (F.a->out)


__device__ __forceinline__ void transpose_item(const float* W, int pitch, int scol0, int K, bf16_t* WT, int drow0, LAS float* scr, int kb, int nb, int lane) {
    const int k0 = 64 * kb, n0 = 32 * nb;
#pragma unroll 8
    for (int i = 0; i < 32; ++i) { const int kk = 2 * i + (lane >> 5); scr[kk * 33 + (lane & 31)] = W[(size_t)(k0 + kk) * pitch + scol0 + n0 + (lane & 31)]; }
    asm volatile("s_waitcnt lgkmcnt(0)" ::: "memory");
    const int c = lane & 7;
#pragma unroll
    for (int j = 0; j < 4; ++j) { const int n = (lane >> 3) + 8 * j; const LAS float* s = scr + (8 * c) * 33 + n;
        u32x4 o; o.x = pk2(s[0 * 33], s[1 * 33]); o.y = pk2(s[2 * 33], s[3 * 33]); o.z = pk2(s[4 * 33], s[5 * 33]); o.w = pk2(s[6 * 33], s[7 * 33]);
        *(u32x4*)(WT + (size_t)(drow0 + n0 + n) * K + k0 + 8 * c) = o; }
    asm volatile("s_waitcnt lgkmcnt(0)" ::: "memory");
}
__device__ __forceinline__ void p0_transposes(const Frame& F) {
    LAS float* scr = (LAS float*)(F.lds + 40960 + F.wave * 8448);
    const int gw = F.vcu * NWAVES + F.wave, NGW = F.G * NWAVES;
    constexpr int I0 = 16 * 64, I1 = 16 * 112, I2 = 8 * 32, I3 = 8 * 32, I4 = 16 * 32, I5 = 16 * 176, I6 = 44 * 32;
    constexpr int NITEMS = I0 + I1 + I2 + I3 + I4 + I5 + I6;
    for (int it = gw; it < NITEMS; it += NGW) {
        int r = it;
        if (r < I0) { transpose_item(FP_w_in, DIN, 0, 1024, FP_WinT, 0, scr, r / 64, r % 64, F.lane); continue; } r -= I0;
        if (r < I1) { transpose_item(FP_w_in, DIN, 2056, 1024, FP_WinT, 2048, scr, r / 112, r % 112, F.lane); continue; } r -= I1;
        if (r < I2) { transpose_item(FP_w_proj_m, 1024, 0, 512, FP_WpmT, 0, scr, r / 32, r % 32, F.lane); continue; } r -= I2;
        if (r < I3) { transpose_item(FP_w_proj_d, 1024, 0, 512, FP_WpdT, 0, scr, r / 32, r % 32, F.lane); continue; } r -= I3;
        if (r < I4) { transpose_item(FP_w_out, 1024, 0, 1024, FP_WoutT, 0, scr, r / 32, r % 32, F.lane); continue; } r -= I4;
        if (r < I5) { transpose_item(FP_w_up, 2 * DFF, 0, 1024, FP_WupT, 0, scr, r / 176, r % 176, F.lane); continue; } r -= I5;
        transpose_item(FP_w_down, 1024, 0, DFF, FP_WdownT, 0, scr, r / 32, r % 32, F.lane);
    }
}
__device__ __forceinline__ void p0_ada(const Frame& F) {
    const int lane = F.lane, r = lane & 31, h = lane >> 5, w = F.wave;
    LAS float* part = (LAS float*)F.lds;
    for (int task = F.vcu; task < 192; task += F.G) {
        const int n0 = 32 * task;
        bf16x8 bw[8];
#pragma unroll
        for (int ks = 0; ks < 8; ++ks) { const float* p = FP_w_ada + (size_t)(128 * w + 16 * ks + 8 * h) * 6144 + n0 + r;
            f32x4 a, b; a.x = p[0]; a.y = p[6144]; a.z = p[2 * 6144]; a.w = p[3 * 6144]; b.x = p[4 * 6144]; b.y = p[5 * 6144]; b.z = p[6 * 6144]; b.w = p[7 * 6144]; bw[ks] = pack8(a, b); }
        for (int rt = 0; rt < 5; ++rt) {
            const int R = 32 * rt + r;
            const float* cr = R < 2 ? FP_c_prompt + (size_t)R * 1024 : FP_c_sample + (size_t)(R < 130 ? R - 2 : 0) * 1024;
            f32x16 acc; for (int i = 0; i < 16; ++i) acc[i] = 0.f;
#pragma unroll
            for (int ks = 0; ks < 8; ++ks) { f32x4 a = *(const f32x4*)(cr + 128 * w + 16 * ks + 8 * h), b = *(const f32x4*)(cr + 128 * w + 16 * ks + 8 * h + 4);
                if (R >= 130) { a = (f32x4){0.f, 0.f, 0.f, 0.f}; b = a; }
                acc = MFMA32(pack8(a, b), bw[ks], acc); }
#pragma unroll
            for (int i = 0; i < 16; ++i) part[(w * 32 + crow(i, h)) * 32 + r] = acc[i];
            WG_BAR();
#pragma unroll
            for (int k = 0; k < 2; ++k) { const int idx = F.tid + 512 * k, row = idx >> 5, col = idx & 31; float s = 0.f;
#pragma unroll
                for (int ww = 0; ww < 8; ++ww) s += part[(ww * 32 + row) * 32 + col];
                const int Rr = 32 * rt + row; if (Rr < 130) FP_ADA[(size_t)Rr * 6144 + n0 + col] = s + FP_b_ada[n0 + col]; }
            WG_BAR();
        }
    }
}
__device__ __forceinline__ int crow_of(int m) { return m < MP ? (m >> 13) : 2 + ((m - MP) >> 2); }
__device__ __forceinline__ const float* xrow_of(const Frame& F, int m) { return m < MP ? FP_x_prompt + (size_t)m * DM : FP_x_sample + (size_t)(m - MP) * DM; }
__device__ __forceinline__ void p1_norm_gates(const Frame& F) {
    LAS float* wg = (LAS float*)F.lds;
    for (int i = F.tid; i < 8192; i += NTHR) { const int k = i >> 3, g = i & 7; wg[g * 1024 + k] = FP_w_in[(size_t)k * DIN + 2048 + g]; }
    WG_BAR();
    const int lane = F.lane, gw = F.vcu * NWAVES + F.wave, NGW = F.G * NWAVES;
    const int r_lo = (int)(((long)gw * MT) / NGW), r_hi = (int)(((long)(gw + 1) * MT) / NGW);
    f32x4 gp[4], gs[4], sh[4], vn[4];
#pragma unroll
    for (int j = 0; j < 4; ++j) { gp[j] = *(const f32x4*)(FP_g_pre_mix + 4 * lane + 256 * j); gs[j] = gp[j]; sh[j] = gp[j]; vn[j] = gp[j]; }
    int ccur = -1;
    if (r_lo < r_hi) { const float* xr = xrow_of(F, r_lo);
#pragma unroll
        for (int j = 0; j < 4; ++j) vn[j] = *(const f32x4*)(xr + 4 * lane + 256 * j); }
    for (int m = r_lo; m < r_hi; ++m) {
        f32x4 v[4]; float ss = 0.f;
#pragma unroll
        for (int j = 0; j < 4; ++j) v[j] = vn[j];
        if (m + 1 < r_hi) { const float* xr = xrow_of(F, m + 1);
#pragma unroll
            for (int j = 0; j < 4; ++j) vn[j] = *(const f32x4*)(xr + 4 * lane + 256 * j); }
        const int cr = crow_of(m);
        if (cr != ccur) { ccur = cr; const float* ada = FP_ADA + (size_t)cr * 6144;
#pragma unroll
            for (int j = 0; j < 4; ++j) { sh[j] = *(const f32x4*)(ada + 4 * lane + 256 * j); gs[j] = gp[j] * (*(const f32x4*)(ada + 1024 + 4 * lane + 256 * j) + 1.f); } }
#pragma unroll
        for (int j = 0; j < 4; ++j) ss += (v[j].x * v[j].x + v[j].y * v[j].y) + (v[j].z * v[j].z + v[j].w * v[j].w);
        const float rs = rsqrtf(wave_sum(ss) * (1.f / DM) + EPS);
        float gd[8];
#pragma unroll
        for (int g = 0; g < 8; ++g) gd[g] = 0.f;
#pragma unroll
        for (int j = 0; j < 4; ++j) { const f32x4 hv = (v[j] * rs) * gs[j] + sh[j];
#pragma unroll
            for (int g = 0; g < 8; ++g) { const f32x4 wv = *(const LAS f32x4*)(wg + g * 1024 + 4 * lane + 256 * j); gd[g] += (hv.x * wv.x + hv.y * wv.y) + (hv.z * wv.z + hv.w * wv.w); }
            u32x2 o; o.x = pk2(hv.x, hv.y); o.y = pk2(hv.z, hv.w); *(u32x2*)(FP_H1 + (size_t)m * DM + 4 * lane + 256 * j) = o; }
#pragma unroll
        for (int g = 0; g < 8; ++g) gd[g] = wave_sum(gd[g]);
        if (lane == 0) { const f32x4 bi = *(const f32x4*)FP_b_if, bf = *(const f32x4*)(FP_b_if + 4);
            *(f32x4*)(FP_IG + (size_t)m * 4) = (f32x4){gd[0] + bi.x, gd[1] + bi.y, gd[2] + bi.z, gd[3] + bi.w};
            *(f32x4*)(FP_LF + (size_t)m * 4) = (f32x4){log_sigmoid(gd[4] + bf.x), log_sigmoid(gd[5] + bf.y), log_sigmoid(gd[6] + bf.z), log_sigmoid(gd[7] + bf.w)}; }
    }
}
struct EpiZ {
    bf16_t* Z; float* out;
    __device__ __forceinline__ void st8(int row, int col, f32x4 v0, f32x4 v1) const {
        const int pn = col >> 8; const float sc = (pn == 2 || pn == 3) ? KSCALE : ((pn == 8 || pn == 9) ? QSCALE : 1.f);
        if (pn >= 10 && pn < 14) { const int kv = pn >= 12; const int c = col - (kv ? ZDV : ZDK);
            float* o = row < MP ? out + (kv ? OFF_VP : OFF_KP) + (size_t)row * 512 + c : out + (kv ? OFF_VS : OFF_KS) + (size_t)(row - MP) * 512 + c;
            *(f32x4*)o = v0; *(f32x4*)(o + 4) = v1; }
        *(bf16x8*)(Z + (size_t)row * ZP + col) = pack8(v0 * sc, v1 * sc);
    }
};
struct EpiPM {
    const bf16_t* Z; bf16_t* MG;
    __device__ __forceinline__ void st4(int row, int col, f32x4 v) const {
        const u32x2 g = *(const u32x2*)(Z + (size_t)row * ZP + ZGM + col);
        u32x2 o; o.x = pk2(sigmoidf_(bflo(g.x)) * v.x, sigmoidf_(bfhi(g.x)) * v.y); o.y = pk2(sigmoidf_(bflo(g.y)) * v.z, sigmoidf_(bfhi(g.y)) * v.w);
        *(u32x2*)(MG + (size_t)row * DM + col) = o; }
    __device__ __forceinline__ void st8(int row, int col, f32x4 v0, f32x4 v1) const { st4(row, col, v0); st4(row, col + 4, v1); }
};
struct EpiPD {
    const bf16_t* Z; bf16_t* MG;
    __device__ __forceinline__ void st4(int row, int col, f32x4 v) const {
        const u32x2 g = *(const u32x2*)(Z + (size_t)row * ZP + ZGD + col); const u32x2 p = *(const u32x2*)(MG + (size_t)row * DM + col);
        u32x2 o; o.x = pk2(bflo(p.x) + sigmoidf_(bflo(g.x)) * v.x, bfhi(p.x) + sigmoidf_(bfhi(g.x)) * v.y); o.y = pk2(bflo(p.y) + sigmoidf_(bflo(g.y)) * v.z, bfhi(p.y) + sigmoidf_(bfhi(g.y)) * v.w);
        *(u32x2*)(MG + (size_t)row * DM + col) = o; }
    __device__ __forceinline__ void st8(int row, int col, f32x4 v0, f32x4 v1) const { st4(row, col, v0); st4(row, col + 4, v1); }
};
struct EpiF32 {
    bf16_t* Y;
    __device__ __forceinline__ void st4(int row, int col, f32x4 v) const { u32x2 o; o.x = pk2(v.x, v.y); o.y = pk2(v.z, v.w); *(u32x2*)(Y + (size_t)row * DM + col) = o; }
    __device__ __forceinline__ void st8(int row, int col, f32x4 v0, f32x4 v1) const { *(bf16x8*)(Y + (size_t)row * DM + col) = pack8(v0, v1); }
};
struct EpiUp {
    bf16_t* UA; bf16_t* UB; float* out;
    __device__ __forceinline__ void st8(int row, int col, f32x4 v0, f32x4 v1) const {
        if (col < DFF) {
            *(bf16x8*)(UA + (size_t)row * DFF + col) = pack8(v0, v1);
            if (row < MP) { const int t = row & (TP - 1); if (t >= TP - 2) { float* o = out + OFF_CVP + ((size_t)(row >> 13) * 2 + (t - (TP - 2))) * DFF + col; *(f32x4*)o = v0; *(f32x4*)(o + 4) = v1; } }
            else { const int t = (row - MP) & 3; if (t >= 2) { float* o = out + OFF_CVS + ((size_t)((row - MP) >> 2) * 2 + (t - 2)) * DFF + col; *(f32x4*)o = v0; *(f32x4*)(o + 4) = v1; } }
        } else *(bf16x8*)(UB + (size_t)row * DFF + (col - DFF)) = pack8(v0, v1);
    }
};
template <class Epi>
__device__ __forceinline__ void skinny_gemm(const Frame& F, const bf16_t* A, const bf16_t* Bt, int K, const Epi& E) {
    const int lane = F.lane, r = lane & 31, h = lane >> 5, ct = F.wave & 1, kq = F.wave >> 1, Kq = K >> 2;
    LAS float* part = (LAS float*)F.lds;
    for (int task = F.vcu; task < 256; task += F.G) {
        const int rt = task >> 4, cg = task & 15;
        const bf16_t* ap = A + (size_t)(32 * rt + r) * K + kq * Kq + 8 * h;
        const bf16_t* bp = Bt + (size_t)(64 * cg + 32 * ct + r) * K + kq * Kq + 8 * h;
        f32x16 acc; for (int i = 0; i < 16; ++i) acc[i] = 0.f;
#pragma unroll 4
        for (int s = 0; s < Kq / 16; ++s) { const bf16x8 a = *(const bf16x8*)(ap + 16 * s), b = *(const bf16x8*)(bp + 16 * s); acc = MFMA32(b, a, acc); }
#pragma unroll
        for (int g4 = 0; g4 < 4; ++g4) *(LAS f32x4*)(part + (kq * 32 + r) * 68 + 32 * ct + 8 * g4 + 4 * h) = (f32x4){acc[4 * g4], acc[4 * g4 + 1], acc[4 * g4 + 2], acc[4 * g4 + 3]};
        WG_BAR();
        { const int row = F.tid >> 4, c4 = (F.tid & 15) * 4;
          f32x4 s = *(const LAS f32x4*)(part + row * 68 + c4) + *(const LAS f32x4*)(part + (32 + row) * 68 + c4) + *(const LAS f32x4*)(part + (64 + row) * 68 + c4) + *(const LAS f32x4*)(part + (96 + row) * 68 + c4);
          E.st4(MP + 32 * rt + row, 64 * cg + c4, s); }
        WG_BAR();
    }
}

constexpr int VROW = 320;
__device__ __forceinline__ void mlstm_A_unit(const Frame& F, int u) {
    const int bh = u >> 7, c = u & 127, b = bh >> 2, h = bh & 3, m0 = b * TP + c * 64;
    const int tid = F.tid, lane = F.lane, wid = F.wave;
    LAS unsigned char* Vt = F.lds; LAS unsigned char* Kt = F.lds + 20480; LAS float* wl = (LAS float*)(F.lds + 40960);
    if (wid == 0) {
        const float lf = FP_LF[(size_t)(m0 + lane) * 4 + h], ig = FP_IG[(size_t)(m0 + lane) * 4 + h];
        const float Fc = wave_scan_sum(lf, lane), a = ig - Fc, Ac = wave_scan_max(a, lane);
        const float Mloc = __shfl(Ac, 63), Fsum = __shfl(Fc, 63);
        wl[lane] = __expf(a - Mloc);
        if (lane == 0) { FP_ST[2 * u] = Fsum; FP_ST[2 * u + 1] = Mloc; }
    }
    WG_BAR();
#pragma unroll
    for (int i = 0; i < 2; ++i) { const int idx = tid + 512 * i, row = idx >> 4, ch = idx & 15;
        const bf16_t* src = FP_Z + (size_t)(m0 + row) * ZP + h * 128 + ch * 8;
        const u32x4 vv = *(const u32x4*)(src + ZV); const u32x4 kk = *(const u32x4*)(src + ZK);
        f32x4 k0, k1; unpack8(kk, k0, k1); const float w = wl[row];
        *(LAS u32x4*)(Vt + row * VROW + ch * 16) = vv;
        *(LAS bf16x8*)(Kt + row * VROW + ch * 16) = pack8(k0 * w, k1 * w); }
    WG_BAR();
    if (tid < 128) { float s = 0.f;
#pragma unroll 8
        for (int row = 0; row < 64; ++row) s += bf2f(*(const LAS bf16_t*)(Kt + row * VROW + tid * 2));
        FP_NU[(size_t)u * 128 + tid] = s; }
    {
        const int r32 = lane & 31, hi = lane >> 5, vh = (lane >> 4) & 1, q4 = (lane & 15) >> 2, p = lane & 3;
        const int vt = wid >> 1, dt0 = 2 * (wid & 1);
        const int lbase = (8 * hi + q4) * VROW + (16 * vh + 4 * p) * 2;
        f32x16 acc0, acc1; for (int i = 0; i < 16; ++i) { acc0[i] = 0.f; acc1[i] = 0.f; }
#pragma unroll
        for (int st = 0; st < 4; ++st) {
            const LAS unsigned char* va = Vt + lbase + st * 16 * VROW + vt * 64;
            const bf16x8 af = cat4(tr_rd(va), tr_rd(va + 4 * VROW));
            const LAS unsigned char* ka = Kt + lbase + st * 16 * VROW + dt0 * 64;
            const bf16x8 b0 = cat4(tr_rd(ka), tr_rd(ka + 4 * VROW)), b1 = cat4(tr_rd(ka + 64), tr_rd(ka + 64 + 4 * VROW));
            acc0 = MFMA32(af, b0, acc0); acc1 = MFMA32(af, b1, acc1);
        }
        float* Uo = FP_U + (size_t)u * 16384;
#pragma unroll
        for (int i = 0; i < 16; ++i) { const int v = 32 * vt + crow(i, hi); Uo[v * 128 + 32 * dt0 + r32] = acc0[i]; Uo[v * 128 + 32 * dt0 + 32 + r32] = acc1[i]; }
    }
    WG_BAR();
}
__device__ __forceinline__ void smlstm_unit(const Frame& F, int u) {
    const int n = u >> 2, h = u & 3, tid = F.tid, lane = F.lane, wid = F.wave;
    const int mrow = MP + 4 * n;
    LAS float* qs = (LAS float*)F.lds; LAS float* ks = qs + 512; LAS float* vs = ks + 512; LAS float* numI = vs + 512; LAS float* Sm = numI + 512; LAS float* nq = Sm + 16; LAS float* red = nq + 4;
    { const int t = tid >> 7, d = tid & 127; const bf16_t* z = FP_Z + (size_t)(mrow + t) * ZP + h * 128 + d;
      qs[tid] = bf2f(z[ZQ]); ks[tid] = bf2f(z[ZK]); vs[tid] = bf2f(z[ZV]); }
    LAS float* gl = red + 8;
    const float m0 = FP_state_m[n * 4 + h];
    if (tid < 4) { float cum = 0.f, am = -INFINITY, at = 0.f;
      for (int t = 0; t <= tid; ++t) { cum += FP_LF[(size_t)(mrow + t) * 4 + h]; at = FP_IG[(size_t)(mrow + t) * 4 + h] - cum; am = fmaxf(am, at); }
      const float mxv = fmaxf(m0, am);
      gl[tid] = cum; gl[4 + tid] = at; gl[8 + tid] = mxv; gl[12 + tid] = __expf(m0 - mxv); gl[16 + tid] = cum + mxv; }
    WG_BAR();
    const float m_end = gl[19], Fend = gl[3], decay = __expf(Fend + m0 - m_end);
    const float wend0 = __expf(Fend + gl[4] - m_end), wend1 = __expf(Fend + gl[5] - m_end), wend2 = __expf(Fend + gl[6] - m_end), wend3 = __expf(Fend + gl[7] - m_end);
#pragma unroll
    for (int k = 0; k < 2; ++k) { const int pid = 2 * wid + k, t = pid >> 2, s = pid & 3;
        float d = qs[t * 128 + lane] * ks[s * 128 + lane] + qs[t * 128 + 64 + lane] * ks[s * 128 + 64 + lane]; d = wave_sum(d);
        if (lane == 0) Sm[pid] = (s <= t) ? d * __expf(gl[4 + s] - gl[8 + t]) : 0.f; }
    if (wid < 4) { const float* n0 = FP_state_n + (size_t)u * 128; float d = n0[lane] * qs[wid * 128 + lane] + n0[64 + lane] * qs[wid * 128 + 64 + lane]; d = wave_sum(d); if (lane == 0) nq[wid] = d; }
    { const int vrow = tid >> 2, dq = tid & 3;
      const float* c0 = FP_state_C + ((size_t)u * 128 + vrow) * 128 + 32 * dq; float* co = FP_out + OFF_CS + ((size_t)u * 128 + vrow) * 128 + 32 * dq;
      f32x4 cv[8];
#pragma unroll
      for (int i = 0; i < 8; ++i) cv[i] = *(const f32x4*)(c0 + 4 * i);
      float ps[4]; float coef[4];
      ps[0] = 0.f; ps[1] = 0.f; ps[2] = 0.f; ps[3] = 0.f;
      coef[0] = wend0 * vs[vrow]; coef[1] = wend1 * vs[128 + vrow]; coef[2] = wend2 * vs[256 + vrow]; coef[3] = wend3 * vs[384 + vrow];
#pragma unroll
      for (int i = 0; i < 8; ++i) { f32x4 cn = cv[i] * decay;
#pragma unroll
          for (int t = 0; t < 4; ++t) { const f32x4 qv = *(const LAS f32x4*)(qs + t * 128 + 32 * dq + 4 * i), kv = *(const LAS f32x4*)(ks + t * 128 + 32 * dq + 4 * i);
              ps[t] += (cv[i].x * qv.x + cv[i].y * qv.y) + (cv[i].z * qv.z + cv[i].w * qv.w); cn += kv * coef[t]; }
          *(f32x4*)(co + 4 * i) = cn; }
#pragma unroll
      for (int t = 0; t < 4; ++t) { ps[t] += __shfl_xor(ps[t], 1); ps[t] += __shfl_xor(ps[t], 2); if (dq == 0) numI[t * 128 + vrow] = ps[t]; } }
    WG_BAR();
    { const int t = tid >> 7, v = tid & 127;
      const float it = gl[12 + t], mtt = gl[16 + t];
      float num = it * numI[tid], den = it * nq[t];
#pragma unroll
      for (int s = 0; s < 4; ++s) { const float sv = Sm[t * 4 + s]; num += sv * vs[s * 128 + v]; den += sv; }
      const float hval = num / fmaxf(fabsf(den), __expf(-mtt));
      const float ssw = wave_sum(hval * hval); if (lane == 0) red[wid] = ssw;
      WG_BAR();
      const float rms = rsqrtf((red[2 * t] + red[2 * t + 1]) * (1.f / 128.f) + EPS);
      const float mo = bf2f(FP_Z[(size_t)(mrow + t) * ZP + ZO + h * 128 + v]);
      FP_HM[(size_t)(mrow + t) * 512 + h * 128 + v] = f2bf(hval * rms * FP_g_mlstm[h * 128 + v] * sigmoidf_(mo));
      if (tid < 128) { const float n0v = FP_state_n[(size_t)u * 128 + tid]; float nn = decay * n0v;
          nn += wend0 * ks[tid] + wend1 * ks[128 + tid] + wend2 * ks[256 + tid] + wend3 * ks[384 + tid];
          FP_out[OFF_NS + (size_t)u * 128 + tid] = nn; }
      if (tid == 0) FP_out[OFF_MS + u] = m_end; }
    WG_BAR();
}
__device__ __forceinline__ void mlstm_scan_item(const Frame& F, int item) {
    const int bh = item >> 5, j = item & 31, e = 512 * j + F.tid; const bool nthr = (j == 0 && F.tid < 128);
    float C = 0.f, m = 0.f, nacc = 0.f;
    const float* Ub = FP_U + (size_t)bh * 128 * 16384 + e; bf16_t* Cp = FP_CPREV + (size_t)bh * 128 * 16384 + e;
    for (int c0 = 0; c0 < 128; c0 += 32) {
        float uu[32], un[32];
#pragma unroll
        for (int i = 0; i < 32; ++i) { uu[i] = Ub[(size_t)(c0 + i) * 16384]; un[i] = nthr ? FP_NU[(size_t)(bh * 128 + c0 + i) * 128 + F.tid] : 0.f; }
#pragma unroll
        for (int i = 0; i < 32; ++i) { const int c = c0 + i; const float fs = FP_ST[2 * (bh * 128 + c)], ml = FP_ST[2 * (bh * 128 + c) + 1];
            Cp[(size_t)c * 16384] = f2bf(C);
            if (nthr) FP_NPREV[(size_t)(bh * 128 + c) * 128 + F.tid] = nacc;
            if (j == 0 && F.tid == 0) FP_MPREV[bh * 128 + c] = m;
            const float mn = fs + fmaxf(m, ml), dec = __expf(fs + m - mn), sc = __expf(fs + ml - mn);
            C = dec * C + sc * uu[i]; nacc = dec * nacc + sc * un[i]; m = mn; }
    }
    FP_out[OFF_CP + (size_t)bh * 16384 + e] = C;
    if (nthr) FP_out[OFF_NP + bh * 128 + F.tid] = nacc;
    if (j == 0 && F.tid == 0) FP_out[OFF_MP + bh] = m;
}
__device__ __forceinline__ void glds16(const void* gsrc, unsigned lds_dst);
__device__ __forceinline__ void mlstm_C_group(const Frame& F, int grp) {
    int tid_ = F.tid; asm volatile("" : "+v"(tid_));
    const int lane = tid_ & 63, wid = F.wave, r32 = lane & 31, hi = lane >> 5, ci = wid >> 1, tt = wid & 1;
    const int u = 4 * grp + ci, bh = u >> 7, c = u & 127, b = bh >> 2, h = bh & 3, m0 = b * TP + c * 64;
    LAS unsigned char* Vt = F.lds + ci * 16384;
    LAS float* Fa = (LAS float*)(F.lds + 65536 + wid * 1024); LAS float* aa = Fa + 64; LAS float* Aa = aa + 64;
    {
        const unsigned lds0 = (unsigned)(uintptr_t)Vt;
#pragma unroll
        for (int k = 0; k < 8; ++k) { const int bb = 8 * tt + k, c4 = bb >> 2, kg = bb & 3;
            glds16(FP_Z + (size_t)(m0 + kg * 16 + (lane >> 2)) * ZP + ZV + h * 128 + c4 * 32 + (lane & 3) * 8, (unsigned)__builtin_amdgcn_readfirstlane(lds0 + bb * 1024)); }
    }
    {
        const float lf = FP_LF[(size_t)(m0 + lane) * 4 + h], ig = FP_IG[(size_t)(m0 + lane) * 4 + h];
        const float Fc = wave_scan_sum(lf, lane), a = ig - Fc, Ac = wave_scan_max(a, lane);
        Fa[lane] = Fc; aa[lane] = a; Aa[lane] = Ac;
    }
    const int t = 32 * tt + r32;
    const float mprev = FP_MPREV[u];
    bf16x8 qf[8];
    { const bf16_t* qp = FP_Z + (size_t)(m0 + t) * ZP + ZQ + h * 128 + 8 * hi;
#pragma unroll
      for (int st = 0; st < 8; ++st) qf[st] = *(const bf16x8*)(qp + 16 * st); }
    const float Ft = Fa[t], At = Aa[t], mxt = fmaxf(mprev, At), mt = Ft + mxt, inter = __expf(mprev - mxt);
    float dq = 0.f;
    { const float* np = FP_NPREV + (size_t)u * 128 + 8 * hi;
#pragma unroll
      for (int st = 0; st < 8; ++st) { const f32x4 n0 = *(const f32x4*)(np + 16 * st), n1 = *(const f32x4*)(np + 16 * st + 4); f32x4 q0, q1; unpack8(__builtin_bit_cast(u32x4, qf[st]), q0, q1);
          dq += (q0.x * n0.x + q0.y * n0.y) + (q0.z * n0.z + q0.w * n0.w) + (q1.x * n1.x + q1.y * n1.y) + (q1.z * n1.z + q1.w * n1.w); } }
    dq += __shfl_xor(dq, 32);
    f32x16 acc[4];
#pragma unroll
    for (int vt = 0; vt < 4; ++vt) { for (int i = 0; i < 16; ++i) acc[vt][i] = 0.f;
        const bf16_t* cp = FP_CPREV + (size_t)u * 16384 + (size_t)(32 * vt + r32) * 128 + 8 * hi;
#pragma unroll
        for (int st = 0; st < 8; ++st) acc[vt] = MFMA32(*(const bf16x8*)(cp + 16 * st), qf[st], acc[vt]);
#pragma unroll
        for (int i = 0; i < 16; ++i) acc[vt][i] *= inter; }
    asm volatile("s_waitcnt vmcnt(0) lgkmcnt(0)\n\ts_barrier" ::: "memory");
    float den = 0.f;
    const int vh = (lane >> 4) & 1, q4 = (lane & 15) >> 2, p = lane & 3;
    const int vlane = (4 * hi + q4) * 64 + (16 * vh + 4 * p) * 2;
    for (int sub = 0; sub <= tt; ++sub) {
        f32x16 sacc; for (int i = 0; i < 16; ++i) sacc[i] = 0.f;
        { const bf16_t* kp = FP_Z + (size_t)(m0 + 32 * sub + r32) * ZP + ZK + h * 128 + 8 * hi;
#pragma unroll
          for (int st = 0; st < 8; ++st) sacc = MFMA32(*(const bf16x8*)(kp + 16 * st), qf[st], sacc); }
#pragma unroll
        for (int g = 0; g < 4; ++g) { const f32x4 av = *(const LAS f32x4*)(aa + 32 * sub + 8 * g + 4 * hi);
#pragma unroll
            for (int k = 0; k < 4; ++k) { const int sidx = 32 * sub + 8 * g + 4 * hi + k; const float wgt = (sidx <= t) ? __expf(av[k] - mxt) : 0.f; const float val = (sidx <= t) ? sacc[4 * g + k] * wgt : 0.f; sacc[4 * g + k] = val; den += val; } }
#pragma unroll
        for (int s2 = 0; s2 < 2; ++s2) {
            const bf16x8 pb = pack8((f32x4){sacc[8 * s2], sacc[8 * s2 + 1], sacc[8 * s2 + 2], sacc[8 * s2 + 3]}, (f32x4){sacc[8 * s2 + 4], sacc[8 * s2 + 5], sacc[8 * s2 + 6], sacc[8 * s2 + 7]});
            const LAS unsigned char* va = Vt + vlane + (2 * sub + s2) * 1024;
#pragma unroll
            for (int vt = 0; vt < 4; ++vt) acc[vt] = MFMA32(cat4(tr_rd(va + vt * 4096), tr_rd(va + vt * 4096 + 512)), pb, acc[vt]);
        }
    }
    den += __shfl_xor(den, 32);
    den += inter * dq;
    const float rden = 1.f / fmaxf(fabsf(den), __expf(-mt));
    float ss = 0.f;
#pragma unroll
    for (int vt = 0; vt < 4; ++vt) for (int i = 0; i < 16; ++i) { acc[vt][i] *= rden; ss += acc[vt][i] * acc[vt][i]; }
    ss += __shfl_xor(ss, 32);
    const float rms = rsqrtf(ss * (1.f / 128.f) + EPS);
#pragma unroll
    for (int vt = 0; vt < 4; ++vt)
#pragma unroll
        for (int g = 0; g < 4; ++g) { const int v = 32 * vt + 8 * g + 4 * hi;
            const f32x4 gv = *(const f32x4*)(FP_g_mlstm + h * 128 + v); const u32x2 mo = *(const u32x2*)(FP_Z + (size_t)(m0 + t) * ZP + ZO + h * 128 + v);
            u32x2 o; o.x = pk2(acc[vt][4 * g] * rms * gv.x * sigmoidf_(bflo(mo.x)), acc[vt][4 * g + 1] * rms * gv.y * sigmoidf_(bfhi(mo.x)));
            o.y = pk2(acc[vt][4 * g + 2] * rms * gv.z * sigmoidf_(bflo(mo.y)), acc[vt][4 * g + 3] * rms * gv.w * sigmoidf_(bfhi(mo.y)));
            *(u32x2*)(FP_HM + (size_t)(m0 + t) * 512 + h * 128 + v) = o; }
    asm volatile("s_waitcnt lgkmcnt(0)\n\ts_barrier" ::: "memory");
}
constexpr int AT_SLOT = 24576, AT_VOFF = 8192, AT_NSLOT = 3;
constexpr float AT_THR = 8.f;
__device__ __forceinline__ void glds16(const void* gsrc, unsigned lds_dst) { unsigned keep;
    asm volatile("s_mov_b32 %0, m0\n\ts_mov_b32 m0, %2\n\ts_nop 0\n\tglobal_load_lds_dwordx4 %1, off\n\ts_mov_b32 m0, %0" : "=&s"(keep) : "v"(gsrc), "s"(lds_dst) : "memory"); }
#define AT_WAIT_BAR(N) asm volatile("s_waitcnt vmcnt(" #N ") lgkmcnt(0)\n\ts_barrier" ::: "memory")
__device__ __forceinline__ void attn_half_unit(const Frame& F, int bh, int qb, int map, float* Odst) {
    int tid_ = F.tid; asm volatile("" : "+v"(tid_));
    const int b = bh >> 2, h = bh & 3, lane = tid_ & 63, wid = F.wave, r32 = lane & 31, hi = lane >> 5;
    const int rowbase = b * TP, q0 = qb * 256, qrow = q0 + 32 * wid + r32;
    const bf16_t* Zb = FP_Z + (size_t)rowbase * ZP;
    const unsigned lds0 = (unsigned)(uintptr_t)F.lds;
    const bf16_t* ksrc = Zb + (size_t)lane * ZP + ZDK + h * 128 + map * 64 + wid * 8;
    const bf16_t* vsrc0 = Zb + (size_t)(((2 * wid) & 3) * 16 + (lane >> 2)) * ZP + ZDV + h * 128 + ((2 * wid) >> 2) * 32 + (lane & 3) * 8;
    const bf16_t* vsrc1 = vsrc0 + (size_t)16 * ZP;
    const unsigned kdst = lds0 + wid * 1024, vdst = lds0 + AT_VOFF + 2 * wid * 1024;
#define AT_DMA(t, slot) do { const size_t adv_ = (size_t)(t) * 64 * ZP; const unsigned so_ = (unsigned)(slot) * AT_SLOT; \
        glds16(ksrc + adv_, (unsigned)__builtin_amdgcn_readfirstlane(kdst + so_)); glds16(vsrc0 + adv_, (unsigned)__builtin_amdgcn_readfirstlane(vdst + so_)); \
        glds16(vsrc1 + adv_, (unsigned)__builtin_amdgcn_readfirstlane(vdst + so_ + 1024u)); } while (0)
    bf16x8 qf[4];
    { const bf16_t* qp = Zb + (size_t)qrow * ZP + ZDQ + h * 128 + map * 64 + 8 * hi;
#pragma unroll
      for (int st = 0; st < 4; ++st) qf[st] = *(const bf16x8*)(qp + 16 * st); }
    const int NT = 4 * qb + 4;
    AT_DMA(0, 0); AT_DMA(1, 1);
    f32x16 o[4];
#pragma unroll
    for (int vt = 0; vt < 4; ++vt) for (int i = 0; i < 16; ++i) o[vt][i] = 0.f;
    f32x16 negm; for (int i = 0; i < 16; ++i) negm[i] = 0.f;
    float mhat = 0.f, lrun = 0.f;
    const int vh = (lane >> 4) & 1, q4 = (lane & 15) >> 2, p = lane & 3;
    const int vlane = AT_VOFF + (4 * hi + q4) * 64 + (16 * vh + 4 * p) * 2;
    const int klane = hi * 1024 + r32 * 16;
    const int wlast = q0 + 32 * wid + 31, wfirst = q0 + 32 * wid;
    int slot = 0, slot2 = 2;
    for (int j = 0; j < NT; ++j) {
        if (j + 1 < NT) AT_WAIT_BAR(3); else AT_WAIT_BAR(0);
        if (j + 2 < NT) AT_DMA(j + 2, slot2);
        if (64 * j <= wlast) {
            const LAS unsigned char* kb = F.lds + slot * AT_SLOT + klane;
            f32x16 p0 = negm, p1 = negm;
#pragma unroll
            for (int st = 0; st < 4; ++st) { const bf16x8 k0 = *(const LAS bf16x8*)(kb + st * 2048), k1 = *(const LAS bf16x8*)(kb + st * 2048 + 512);
                p0 = MFMA32(k0, qf[st], p0); p1 = MFMA32(k1, qf[st], p1); }
            if (64 * j + 63 > wfirst) {
#pragma unroll
                for (int i = 0; i < 16; ++i) { const int key = 64 * j + crow(i, hi); if (key > qrow) p0[i] = -INFINITY; if (key + 32 > qrow) p1[i] = -INFINITY; }
            }
            float mx = fmaxf(p0[0], p1[0]);
#pragma unroll
            for (int i = 1; i < 16; ++i) mx = fmaxf(mx, fmaxf(p0[i], p1[i]));
            mx = fmaxf(mx, __shfl_xor(mx, 32));
            if (j == 0 || __any(mx > AT_THR)) {
                const float dl = (j == 0) ? mx : fmaxf(mx, 0.f), f = __builtin_amdgcn_exp2f(-dl);
                mhat += dl; lrun *= f;
#pragma unroll
                for (int i = 0; i < 16; ++i) { p0[i] -= dl; p1[i] -= dl; negm[i] = -mhat; }
#pragma unroll
                for (int vt = 0; vt < 4; ++vt) for (int i = 0; i < 16; ++i) o[vt][i] *= f;
            }
            float rsum = 0.f;
#pragma unroll
            for (int i = 0; i < 16; ++i) { p0[i] = __builtin_amdgcn_exp2f(p0[i]); p1[i] = __builtin_amdgcn_exp2f(p1[i]); rsum += p0[i] + p1[i]; }
            lrun += rsum;
            const LAS unsigned char* vb = F.lds + slot * AT_SLOT + vlane;
#pragma unroll
            for (int sub = 0; sub < 2; ++sub) {
#pragma unroll
                for (int s2 = 0; s2 < 2; ++s2) {
                    bf16x8 pb;
                    if (sub == 0) pb = pack8((f32x4){p0[8 * s2], p0[8 * s2 + 1], p0[8 * s2 + 2], p0[8 * s2 + 3]}, (f32x4){p0[8 * s2 + 4], p0[8 * s2 + 5], p0[8 * s2 + 6], p0[8 * s2 + 7]});
                    else          pb = pack8((f32x4){p1[8 * s2], p1[8 * s2 + 1], p1[8 * s2 + 2], p1[8 * s2 + 3]}, (f32x4){p1[8 * s2 + 4], p1[8 * s2 + 5], p1[8 * s2 + 6], p1[8 * s2 + 7]});
                    const LAS unsigned char* va = vb + (2 * sub + s2) * 1024;
#pragma unroll
                    for (int vt = 0; vt < 4; ++vt) o[vt] = MFMA32(cat4(tr_rd(va + vt * 4096), tr_rd(va + vt * 4096 + 512)), pb, o[vt]);
                }
            }
        }
        slot = (slot == AT_NSLOT - 1) ? 0 : slot + 1; slot2 = (slot2 == AT_NSLOT - 1) ? 0 : slot2 + 1;
    }
    lrun += __shfl_xor(lrun, 32);
    const float rl = 1.f / lrun;
    float* op = Odst + (size_t)(rowbase + qrow) * 512 + h * 128 + 4 * hi;
#pragma unroll
    for (int vt = 0; vt < 4; ++vt)
#pragma unroll
        for (int g = 0; g < 4; ++g) *(f32x4*)(op + 32 * vt + 8 * g) = (f32x4){o[vt][4 * g] * rl, o[vt][4 * g + 1] * rl, o[vt][4 * g + 2] * rl, o[vt][4 * g + 3] * rl};
    AT_WAIT_BAR(0);
#undef AT_DMA
}
__device__ __forceinline__ float lambda_full(const Frame& F, int lane) {
    const float a = wave_sum(FP_lq1[lane] * FP_lk1[lane]), b = wave_sum(FP_lq2[lane] * FP_lk2[lane]);
    return __expf(a) - __expf(b) + LAM_INIT;
}
__device__ __forceinline__ void attn_combine_rows(const Frame& F) {
    const int lane = F.lane, gw = F.vcu * NWAVES + F.wave, NGW = F.G * NWAVES;
    const float lam = lambda_full(F, lane);
    const f32x4 g0 = *(const f32x4*)(FP_g_diff + 8 * lane), g1 = *(const f32x4*)(FP_g_diff + 8 * lane + 4);
    for (int m = gw; m < MP; m += NGW) {
        const float* a = FP_O1 + (size_t)m * 512 + 8 * lane; const float* bb = FP_O2 + (size_t)m * 512 + 8 * lane;
        const f32x4 x0 = *(const f32x4*)a - *(const f32x4*)bb * lam, x1 = *(const f32x4*)(a + 4) - *(const f32x4*)(bb + 4) * lam;
        float ss = (x0.x * x0.x + x0.y * x0.y) + (x0.z * x0.z + x0.w * x0.w) + (x1.x * x1.x + x1.y * x1.y) + (x1.z * x1.z + x1.w * x1.w);
        ss += __shfl_xor(ss, 1); ss += __shfl_xor(ss, 2); ss += __shfl_xor(ss, 4); ss += __shfl_xor(ss, 8);
        const float rms = rsqrtf(ss * (1.f / 128.f) + EPS) * (1.f - LAM_INIT);
        *(bf16x8*)(FP_HD + (size_t)m * 512 + 8 * lane) = pack8(x0 * rms * g0, x1 * rms * g1);
    }
}
constexpr int SB_P = 2064;
__device__ __forceinline__ void decode_unit(const Frame& F, int u, float lam) {
    int tid_ = F.tid; asm volatile("" : "+v"(tid_));
    const int n = u >> 2, h = u & 3, tid = tid_, lane = tid_ & 63, wid = F.wave;
    const int mrow = MP + 4 * n;
    LAS float* Sbuf = (LAS float*)F.lds;
    LAS float* part = Sbuf + 8 * SB_P;
    LAS float* rlv = part + 8192;
    LAS float* red = rlv + 8;
    const int* pt = FP_page_table + n * NPAGES;
    const int c16 = lane & 15, g = lane >> 4;
    bf16x8 bq[4];
#pragma unroll
    for (int st = 0; st < 4; ++st) { const bool ok = (c16 < 4 && st < 2) || (c16 >= 4 && c16 < 8 && st >= 2);
        const bf16x8 v = *(const bf16x8*)(FP_Z + (size_t)(mrow + (c16 & 3)) * ZP + ZDQ + h * 128 + 32 * st + 8 * g);
        const bf16x8 zz = {0, 0, 0, 0, 0, 0, 0, 0}; bq[st] = ok ? v : zz; }
    const int hh = lane >> 5, l5 = lane & 31;
    const char* vpool = (const char*)FP_cache_v; const char* kpool = (const char*)FP_cache_k;
    const unsigned voff = (((unsigned)pt[2 * wid + hh] * PAGE) * 4u + (unsigned)h) * 512u + 16u * (unsigned)l5;
#define NTL(p) __builtin_nontemporal_load((const f32x4*)(p))
#define VLD(row) NTL(vpool + (voff + 2048u * (unsigned)(row)))
    f32x4 va[8], vb[8];
    {
        const unsigned ko0 = (((unsigned)pt[2 * wid] * PAGE + (unsigned)c16) * 4u + (unsigned)h) * 512u + 32u * (unsigned)g;
        const unsigned ko1 = (((unsigned)pt[2 * wid + 1] * PAGE + (unsigned)c16) * 4u + (unsigned)h) * 512u + 32u * (unsigned)g;
        f32x4 ka[16], kb[8];
#define KLOAD(dst, ti) do { const unsigned ko_ = (((ti) < 8) ? ko0 : ko1) + 32768u * (unsigned)((ti) & 7); \
            _Pragma("unroll") for (int st = 0; st < 4; ++st) { dst[2 * st] = NTL(kpool + (ko_ + 128u * st)); dst[2 * st + 1] = NTL(kpool + (ko_ + 128u * st + 16u)); } } while (0)
#define KTILE(src, ti) do { f32x4 acc_ = {0.f, 0.f, 0.f, 0.f}; \
            _Pragma("unroll") for (int st = 0; st < 4; ++st) acc_ = MFMA16(pack8(src[2 * st], src[2 * st + 1]), bq[st], acc_); \
            if (c16 < 8) *(LAS f32x4*)(Sbuf + c16 * SB_P + 256 * wid + 16 * (ti) + 4 * g) = acc_; } while (0)
        KLOAD(ka, 0); KLOAD((ka + 8), 1); KLOAD(kb, 2);
        for (int ip = 0; ip < 12; ip += 3) {
            KTILE(ka, ip); KTILE((ka + 8), ip + 1); KLOAD(ka, ip + 3); KLOAD((ka + 8), ip + 4);
            KTILE(kb, ip + 2); KLOAD(kb, ip + 5);
        }
        KTILE(ka, 12); KTILE((ka + 8), 13); KLOAD(ka, 15);
#pragma unroll
        for (int kk = 0; kk < 8; ++kk) va[kk] = VLD(kk);
        KTILE(kb, 14);
#pragma unroll
        for (int kk = 0; kk < 8; ++kk) vb[kk] = VLD(8 + kk);
        KTILE(ka, 15);
#undef KLOAD
#undef KTILE
        if (wid == 0) {
            f32x4 acc = {0.f, 0.f, 0.f, 0.f};
#pragma unroll
            for (int st = 0; st < 4; ++st) { const bf16x8 v = *(const bf16x8*)(FP_Z + (size_t)(mrow + (c16 & 3)) * ZP + ZDK + h * 128 + 32 * st + 8 * g);
                const bf16x8 zz = {0, 0, 0, 0, 0, 0, 0, 0}; const bf16x8 av = (c16 < 4) ? v : zz; acc = MFMA16(av, bq[st], acc); }
            if (g == 0 && c16 < 8) { const int t = c16 & 3; f32x4 m;
                m.x = acc.x; m.y = (1 <= t) ? acc.y : -INFINITY; m.z = (2 <= t) ? acc.z : -INFINITY; m.w = (3 <= t) ? acc.w : -INFINITY;
                *(LAS f32x4*)(Sbuf + c16 * SB_P + PAST) = m; }
        }
    }
    WG_BAR();
    {
        LAS float* col = Sbuf + wid * SB_P; float mx = -INFINITY;
        for (int k = lane; k < PAST + 4; k += 64) mx = fmaxf(mx, col[k]);
        mx = wave_max(mx); float sm = 0.f;
        for (int k = lane; k < PAST + 4; k += 64) { const float pv = __builtin_amdgcn_exp2f(col[k] - mx); col[k] = pv; sm += pv; }
        sm = wave_sum(sm); if (lane == 0) rlv[wid] = 1.f / sm;
    }
    WG_BAR();
    {
        const LAS float* pbase = Sbuf + 256 * wid + 128 * hh;
        f32x4 acc[8];
#pragma unroll
        for (int c = 0; c < 8; ++c) acc[c] = (f32x4){0.f, 0.f, 0.f, 0.f};
#define VSTEP(buf, t8) do { f32x4 vc_[8]; _Pragma("unroll") for (int kk = 0; kk < 8; ++kk) vc_[kk] = buf[kk]; \
            if ((t8) + 2 < 16) { _Pragma("unroll") for (int kk = 0; kk < 8; ++kk) buf[kk] = VLD(8 * ((t8) + 2) + kk); } \
            _Pragma("unroll") for (int c = 0; c < 8; ++c) { const f32x4 p0_ = *(const LAS f32x4*)(pbase + c * SB_P + 8 * (t8)), p1_ = *(const LAS f32x4*)(pbase + c * SB_P + 8 * (t8) + 4); \
                acc[c] += vc_[0] * p0_.x + vc_[1] * p0_.y + vc_[2] * p0_.z + vc_[3] * p0_.w + vc_[4] * p1_.x + vc_[5] * p1_.y + vc_[6] * p1_.z + vc_[7] * p1_.w; } } while (0)
        for (int t8 = 0; t8 < 16; t8 += 2) { VSTEP(va, t8); VSTEP(vb, t8 + 1); }
#undef VSTEP
        if (wid == 0) {
#pragma unroll
            for (int s = 0; s < 4; ++s) { const u32x2 vv = *(const u32x2*)(FP_Z + (size_t)(mrow + s) * ZP + ZDV + h * 128 + 4 * l5);
                const f32x4 vf = {bflo(vv.x), bfhi(vv.x), bflo(vv.y), bfhi(vv.y)};
#pragma unroll
                for (int c = 0; c < 8; ++c) { const float pp = (hh == 0) ? Sbuf[c * SB_P + PAST + s] : 0.f; acc[c] += vf * pp; } }
        }
#pragma unroll
        for (int c = 0; c < 8; ++c) { acc[c].x += __shfl_xor(acc[c].x, 32); acc[c].y += __shfl_xor(acc[c].y, 32); acc[c].z += __shfl_xor(acc[c].z, 32); acc[c].w += __shfl_xor(acc[c].w, 32);
            if (hh == 0) *(LAS f32x4*)(part + (wid * 8 + c) * 128 + 4 * l5) = acc[c]; }
    }
    WG_BAR();
    { const int t = tid >> 7, v = tid & 127; float o1 = 0.f, o2 = 0.f;
#pragma unroll
      for (int w = 0; w < 8; ++w) { o1 += part[(w * 8 + t) * 128 + v]; o2 += part[(w * 8 + 4 + t) * 128 + v]; }
      const float ov = o1 * rlv[t] - lam * o2 * rlv[4 + t];
      const float ssw = wave_sum(ov * ov); if (lane == 0) red[wid] = ssw;
      WG_BAR();
      const float rms = rsqrtf((red[2 * t] + red[2 * t + 1]) * (1.f / 128.f) + EPS) * (1.f - LAM_INIT);
      FP_HD[(size_t)(mrow + t) * 512 + h * 128 + v] = f2bf(ov * rms * FP_g_diff[h * 128 + v]); }
    WG_BAR();
}
__device__ __forceinline__ void rows_post_mix(const Frame& F) {
    const int lane = F.lane, gw = F.vcu * NWAVES + F.wave, NGW = F.G * NWAVES;
    const int r_lo = (int)(((long)gw * MT) / NGW), r_hi = (int)(((long)(gw + 1) * MT) / NGW);
    f32x4 gpm[4], gpf[4], g1[4], sh2[4], sc2[4], yn[4], xn[4];
#pragma unroll
    for (int j = 0; j < 4; ++j) { gpm[j] = *(const f32x4*)(FP_g_post_mix + 4 * lane + 256 * j); gpf[j] = *(const f32x4*)(FP_g_pre_ffn + 4 * lane + 256 * j); g1[j] = gpm[j]; sh2[j] = gpm[j]; sc2[j] = gpm[j]; yn[j] = gpm[j]; xn[j] = gpm[j]; }
    int ccur = -1;
    if (r_lo < r_hi) { const float* xr = xrow_of(F, r_lo); const bf16_t* yr = FP_Y + (size_t)r_lo * DM;
#pragma unroll
        for (int j = 0; j < 4; ++j) { { const u32x2 yy = *(const u32x2*)(yr + 4 * lane + 256 * j); yn[j] = (f32x4){bflo(yy.x), bfhi(yy.x), bflo(yy.y), bfhi(yy.y)}; } xn[j] = *(const f32x4*)(xr + 4 * lane + 256 * j); } }
    for (int m = r_lo; m < r_hi; ++m) {
        f32x4 y[4], x1[4]; float ss = 0.f;
#pragma unroll
        for (int j = 0; j < 4; ++j) { y[j] = yn[j]; x1[j] = xn[j]; }
        if (m + 1 < r_hi) { const float* xr = xrow_of(F, m + 1); const bf16_t* yr = FP_Y + (size_t)(m + 1) * DM;
#pragma unroll
            for (int j = 0; j < 4; ++j) { { const u32x2 yy = *(const u32x2*)(yr + 4 * lane + 256 * j); yn[j] = (f32x4){bflo(yy.x), bfhi(yy.x), bflo(yy.y), bfhi(yy.y)}; } xn[j] = *(const f32x4*)(xr + 4 * lane + 256 * j); } }
        const int cr = crow_of(m);
        if (cr != ccur) { ccur = cr; const float* ada = FP_ADA + (size_t)cr * 6144;
#pragma unroll
            for (int j = 0; j < 4; ++j) { const int c = 4 * lane + 256 * j; g1[j] = *(const f32x4*)(ada + 2048 + c) * gpm[j]; sh2[j] = *(const f32x4*)(ada + 3072 + c); sc2[j] = (*(const f32x4*)(ada + 4096 + c) + 1.f) * gpf[j]; } }
#pragma unroll
        for (int j = 0; j < 4; ++j) ss += (y[j].x * y[j].x + y[j].y * y[j].y) + (y[j].z * y[j].z + y[j].w * y[j].w);
        const float rs = rsqrtf(wave_sum(ss) * (1.f / DM) + EPS); float s1 = 0.f;
#pragma unroll
        for (int j = 0; j < 4; ++j) { const int c = 4 * lane + 256 * j;
            x1[j] = x1[j] + g1[j] * (y[j] * rs); *(f32x4*)(FP_out + OFF_Y + (size_t)m * DM + c) = x1[j];
            s1 += (x1[j].x * x1[j].x + x1[j].y * x1[j].y) + (x1[j].z * x1[j].z + x1[j].w * x1[j].w); }
        const float r1 = rsqrtf(wave_sum(s1) * (1.f / DM) + EPS);
#pragma unroll
        for (int j = 0; j < 4; ++j) { const int c = 4 * lane + 256 * j;
            const f32x4 hv = (x1[j] * r1) * sc2[j] + sh2[j]; u32x2 o; o.x = pk2(hv.x, hv.y); o.y = pk2(hv.z, hv.w); *(u32x2*)(FP_H1 + (size_t)m * DM + c) = o; }
    }
}
__device__ __forceinline__ void rows_final(const Frame& F) {
    const int lane = F.lane, gw = F.vcu * NWAVES + F.wave, NGW = F.G * NWAVES;
    const int r_lo = (int)(((long)gw * MT) / NGW), r_hi = (int)(((long)(gw + 1) * MT) / NGW);
    f32x4 gpf[4], g2[4], yn[4], xn[4];
#pragma unroll
    for (int j = 0; j < 4; ++j) { gpf[j] = *(const f32x4*)(FP_g_post_ffn + 4 * lane + 256 * j); g2[j] = gpf[j]; yn[j] = gpf[j]; xn[j] = gpf[j]; }
    int ccur = -1;
    if (r_lo < r_hi) { const float* xr = FP_out + OFF_Y + (size_t)r_lo * DM; const bf16_t* yr = FP_Y + (size_t)r_lo * DM;
#pragma unroll
        for (int j = 0; j < 4; ++j) { { const u32x2 yy = *(const u32x2*)(yr + 4 * lane + 256 * j); yn[j] = (f32x4){bflo(yy.x), bfhi(yy.x), bflo(yy.y), bfhi(yy.y)}; } xn[j] = *(const f32x4*)(xr + 4 * lane + 256 * j); } }
    for (int m = r_lo; m < r_hi; ++m) {
        f32x4 y[4], x1[4]; float ss = 0.f;
#pragma unroll
        for (int j = 0; j < 4; ++j) { y[j] = yn[j]; x1[j] = xn[j]; }
        if (m + 1 < r_hi) { const float* xr = FP_out + OFF_Y + (size_t)(m + 1) * DM; const bf16_t* yr = FP_Y + (size_t)(m + 1) * DM;
#pragma unroll
            for (int j = 0; j < 4; ++j) { { const u32x2 yy = *(const u32x2*)(yr + 4 * lane + 256 * j); yn[j] = (f32x4){bflo(yy.x), bfhi(yy.x), bflo(yy.y), bfhi(yy.y)}; } xn[j] = *(const f32x4*)(xr + 4 * lane + 256 * j); } }
        const int cr = crow_of(m);
        if (cr != ccur) { ccur = cr; const float* ada = FP_ADA + (size_t)cr * 6144;
#pragma unroll
            for (int j = 0; j < 4; ++j) g2[j] = *(const f32x4*)(ada + 5120 + 4 * lane + 256 * j) * gpf[j]; }
#pragma unroll
        for (int j = 0; j < 4; ++j) ss += (y[j].x * y[j].x + y[j].y * y[j].y) + (y[j].z * y[j].z + y[j].w * y[j].w);
        const float rs = rsqrtf(wave_sum(ss) * (1.f / DM) + EPS);
#pragma unroll
        for (int j = 0; j < 4; ++j) *(f32x4*)(FP_out + OFF_Y + (size_t)m * DM + 4 * lane + 256 * j) = x1[j] + g2[j] * (y[j] * rs);
    }
}
__device__ __forceinline__ float gelu_tanh(float x) { const float u = 1.5957691216057308f * (x + 0.044715f * x * x * x); return x * __builtin_amdgcn_rcpf(1.f + __builtin_amdgcn_exp2f(-u * LOG2E)); }
__device__ __forceinline__ void geglu_hist(const Frame& F, int m, int f0, f32x4& p10, f32x4& p11, f32x4& p20, f32x4& p21) {
    const f32x4 z4 = {0.f, 0.f, 0.f, 0.f};
    if (m < MP) { const int t = m & (TP - 1);
        if (t >= 1) unpack8(*(const u32x4*)(FP_UA + (size_t)(m - 1) * DFF + f0), p10, p11); else { p10 = z4; p11 = z4; }
        if (t >= 2) unpack8(*(const u32x4*)(FP_UA + (size_t)(m - 2) * DFF + f0), p20, p21); else { p20 = z4; p21 = z4; }
    } else { const int t = (m - MP) & 3, n = (m - MP) >> 2; const float* st = FP_state_conv + (size_t)n * 2 * DFF + f0;
        if (t >= 1) unpack8(*(const u32x4*)(FP_UA + (size_t)(m - 1) * DFF + f0), p10, p11); else { p10 = *(const f32x4*)(st + DFF); p11 = *(const f32x4*)(st + DFF + 4); }
        if (t >= 2) unpack8(*(const u32x4*)(FP_UA + (size_t)(m - 2) * DFF + f0), p20, p21);
        else if (t == 1) { p20 = *(const f32x4*)(st + DFF); p21 = *(const f32x4*)(st + DFF + 4); } else { p20 = *(const f32x4*)st; p21 = *(const f32x4*)(st + 4); } }
}
__device__ __forceinline__ void geglu_phase(const Frame& F) {
    constexpr int RB = 66, NBLK = MT / RB;
    if (F.tid >= 352) return;
    const int f0 = 8 * F.tid;
    const f32x4 w00 = *(const f32x4*)(FP_conv_w + f0), w01 = *(const f32x4*)(FP_conv_w + f0 + 4), w10 = *(const f32x4*)(FP_conv_w + DFF + f0), w11 = *(const f32x4*)(FP_conv_w + DFF + f0 + 4),
                w20 = *(const f32x4*)(FP_conv_w + 2 * DFF + f0), w21 = *(const f32x4*)(FP_conv_w + 2 * DFF + f0 + 4), cb0 = *(const f32x4*)(FP_conv_b + f0), cb1 = *(const f32x4*)(FP_conv_b + f0 + 4);
    for (int blk = F.vcu; blk < NBLK; blk += F.G) {
        const int m0 = blk * RB;
        f32x4 p10, p11, p20, p21;
        geglu_hist(F, m0, f0, p10, p11, p20, p21);
        u32x4 qa[4], qb[4];
#pragma unroll
        for (int i = 0; i < 4; ++i) { qa[i] = *(const u32x4*)(FP_UA + (size_t)(m0 + i) * DFF + f0); qb[i] = *(const u32x4*)(FP_UB + (size_t)(m0 + i) * DFF + f0); }
        for (int r0 = 0; r0 < RB; r0 += 4) {
#pragma unroll
            for (int i = 0; i < 4; ++i) {
                const int r = r0 + i;
                if (r < RB) {
                    const int m = m0 + r;
                    f32x4 a0, a1, b0, b1; unpack8(qa[i], a0, a1); unpack8(qb[i], b0, b1);
                    if (r + 4 < RB) { qa[i] = *(const u32x4*)(FP_UA + (size_t)(m + 4) * DFF + f0); qb[i] = *(const u32x4*)(FP_UB + (size_t)(m + 4) * DFF + f0); }
                    const bool seq_start = (m < MP) ? ((m & (TP - 1)) == 0) : (((m - MP) & 3) == 0);
                    if (seq_start && r != 0) geglu_hist(F, m, f0, p10, p11, p20, p21);
                    f32x4 c0 = cb0 + w00 * p20 + w10 * p10 + w20 * a0, c1 = cb1 + w01 * p21 + w11 * p11 + w21 * a1;
                    c0.x = gelu_tanh(c0.x) * b0.x; c0.y = gelu_tanh(c0.y) * b0.y; c0.z = gelu_tanh(c0.z) * b0.z; c0.w = gelu_tanh(c0.w) * b0.w;
                    c1.x = gelu_tanh(c1.x) * b1.x; c1.y = gelu_tanh(c1.y) * b1.y; c1.z = gelu_tanh(c1.z) * b1.z; c1.w = gelu_tanh(c1.w) * b1.w;
                    *(bf16x8*)(FP_GB + (size_t)m * DFF + f0) = pack8(c0, c1);
                    p20 = p10; p21 = p11; p10 = a0; p11 = a1;
                }
            }
        }
    }
}

__device__ __forceinline__ void attention_phase(const Frame& F, volatile LAS unsigned* MISC) {
    unsigned* ctl = (unsigned*)(F.a->ws + WS_CTL) + CW_SCHED;
    const int xq = (F.vcu * 8) / F.G;
    const float lam = lambda_full(F, F.lane);
    for (;;) {
        if (F.tid == 0) {
            int kind = -1; unsigned idx = 0u;
            unsigned* QD = ctl + 64 * 8; unsigned* NS = ctl + 64 * (9 + xq);
            if (xb_ld(QD) < 512u) { const unsigned sn = xb_add(NS, 1u);
                if (sn < (unsigned)DEC_LIM8) { const unsigned d = xb_add(QD, 1u); if (d < 512u) { kind = 1; idx = d; } }
                if (kind < 0) (void)__hip_atomic_fetch_sub(NS, 1u, __ATOMIC_RELAXED, __HIP_MEMORY_SCOPE_AGENT); }
            for (int k = 0; k < 8 && kind < 0; ++k) { const int x = (xq + k) & 7; unsigned* QP = ctl + 64 * x;
                if (xb_ld(QP) < 64u) { const unsigned p = xb_add(QP, 1u); if (p < 64u) { kind = 0; idx = (unsigned)x * 64u + p; } } }
            if (kind < 0) { const unsigned d = xb_add(QD, 1u); if (d < 512u) { kind = 2; idx = d; } }
            MISC[0] = (unsigned)kind; MISC[1] = idx;
        }
        WG_BAR();
        const int kind = (int)MISC[0]; const int idx = (int)MISC[1];
        WG_BAR();
        if (kind < 0) break;
        if (kind == 0) { const int bh = idx >> 6, j = idx & 63, qb = 31 - (j >> 1), map = j & 1; attn_half_unit(F, bh, qb, map, map ? FP_O2 : FP_O1); }
        else { decode_unit(F, idx, lam);
               if (kind == 1 && F.tid == 0) (void)__hip_atomic_fetch_sub(ctl + 64 * (9 + xq), 1u, __ATOMIC_RELAXED, __HIP_MEMORY_SCOPE_AGENT); }
    }
}

constexpr int NPHASE = 15;
#ifndef DUPMASK
#define DUPMASK 0
#endif
__global__ void __launch_bounds__(NTHR, 2) fwd_kernel(Args args) {
    extern __shared__ __attribute__((aligned(16))) unsigned char lds_raw[];
    Frame F;
    F.lds = (LAS unsigned char*)lds_raw;
    F.tid = threadIdx.x; F.lane = F.tid & 63; F.wave = __builtin_amdgcn_readfirstlane(F.tid >> 6);
    F.G = gridDim.x; { const int bx = blockIdx.x; F.vcu = (F.G % 8 == 0) ? (bx % 8) * (F.G / 8) + bx / 8 : bx; }
    F.a = &args; unsigned char* ws = args.ws;
    volatile LAS unsigned* MISC = (volatile LAS unsigned*)(F.lds + MISC_OFF);
    for (int u = F.tid; u < (LDS_BYTES - RING_BYTES) / 4; u += NTHR) ((LAS unsigned*)(F.lds + RING_BYTES))[u] = 0u;
    __syncthreads();
    const int lo = args.ph_lo, hi = args.ph_hi;
    const bool multi = (hi - lo) > 1;
    XcdBarrier bar; bar.bar = (unsigned*)(ws + WS_CTL) + CW_BAR; bar.x = 0; bar.st = nullptr;
    if (multi) bar = xcd_barrier_post((unsigned*)(ws + WS_CTL) + CW_BAR, MISC + 8);
#define IN(k) (lo <= (k) && (k) < hi)
#define SEAM(k) do { if (IN(k) && IN((k) + 1)) xcd_barrier(bar); } while (0)

#define DUP(k, ...) do { { __VA_ARGS__ } if ((DUPMASK >> (k)) & 1) { __VA_ARGS__ } } while (0)
    if (IN(0)) { DUP(0,  p0_ada(F); p0_transposes(F); ); } SEAM(0);
    if (IN(1)) { DUP(1,  p1_norm_gates(F); WG_BAR(); ); } SEAM(1);
    if (IN(2)) { DUP(2,  pg8::Gemm g{FP_H1, FP_WinT, MT, ZP, DM}; pg8::StaticOrder S; S.init(MT, ZP, F.G, (int)blockIdx.x); EpiZ E{FP_Z, FP_out}; pg8::gemm_phase(F.lds, g, S, E); ); } SEAM(2);
    if (IN(3)) { DUP(3,  for (int i = 0; i < 4; ++i) { const int u = F.vcu * 4 + i; if (u < 1024) mlstm_A_unit(F, u); }
                 if (F.G != 256) for (int u = 4 * F.G + F.vcu; u < 1024; u += F.G) mlstm_A_unit(F, u);
                 for (int u = F.vcu; u < 512; u += F.G) smlstm_unit(F, u); ); } SEAM(3);
    if (IN(4)) { DUP(4,  for (int it = F.vcu; it < 256; it += F.G) mlstm_scan_item(F, it); ); } SEAM(4);
    if (IN(5)) { attention_phase(F, MISC); } SEAM(5);
    if (IN(6)) { DUP(6,  for (int grp = F.vcu; grp < 256; grp += F.G) mlstm_C_group(F, grp);
                 attn_combine_rows(F); ); } SEAM(6);
    if (IN(7)) { DUP(7,  pg8::Gemm g{FP_HM, FP_WpmT, MP, DM, 512}; pg8::StaticOrder S; S.init(MP, DM, F.G, (int)blockIdx.x); EpiPM E{FP_Z, FP_MG}; pg8::gemm_phase(F.lds, g, S, E);
                 skinny_gemm(F, FP_HM + (size_t)MP * 512, FP_WpmT, 512, E); ); } SEAM(7);
    if (IN(8)) { pg8::Gemm g{FP_HD, FP_WpdT, MP, DM, 512}; pg8::StaticOrder S; S.init(MP, DM, F.G, (int)blockIdx.x); EpiPD E{FP_Z, FP_MG}; pg8::gemm_phase(F.lds, g, S, E);
                 skinny_gemm(F, FP_HD + (size_t)MP * 512, FP_WpdT, 512, E); } SEAM(8);
    if (IN(9)) { DUP(9,  pg8::Gemm g{FP_MG, FP_WoutT, MP, DM, DM}; pg8::StaticOrder S; S.init(MP, DM, F.G, (int)blockIdx.x); EpiF32 E{FP_Y}; pg8::gemm_phase(F.lds, g, S, E);
                 skinny_gemm(F, FP_MG + (size_t)MP * DM, FP_WoutT, DM, E); ); } SEAM(9);
    if (IN(10)) { DUP(10,  rows_post_mix(F); ); } SEAM(10);
    if (IN(11)) { DUP(11,  pg8::Gemm g{FP_H1, FP_WupT, MT, 2 * DFF, DM}; pg8::StaticOrder S; S.init(MT, 2 * DFF, F.G, (int)blockIdx.x); EpiUp E{FP_UA, FP_UB, FP_out}; pg8::gemm_phase(F.lds, g, S, E); ); } SEAM(11);
    if (IN(12)) { DUP(12,  geglu_phase(F); ); } SEAM(12);
    if (IN(13)) { DUP(13,  pg8::Gemm g{FP_GB, FP_WdownT, MP, DM, DFF}; pg8::StaticOrder S; S.init(MP, DM, F.G, (int)blockIdx.x); EpiF32 E{FP_Y}; pg8::gemm_phase(F.lds, g, S, E);
                  skinny_gemm(F, FP_GB + (size_t)MP * DFF, FP_WdownT, DFF, E); ); } SEAM(13);
    if (IN(14)) { rows_final(F); }
#undef DUP
#undef IN
#undef SEAM
}

#ifndef MK_ONE_LAUNCH
#define MK_ONE_LAUNCH 1
#endif
extern "C" void kernel_launch(void* const* d_in, const int* in_sizes, int n_in, void* d_out, int out_size, void* d_ws, size_t ws_size, hipStream_t stream) {
    static int grid = 0;
    if (grid == 0) {
        if (n_in != 32 || out_size != (int)OUT_TOTAL || ws_size < WS_END) { fprintf(stderr, "kernel_launch: unexpected sizes n_in %d out %d ws %zu\n", n_in, out_size, ws_size); grid = -1; return; }
        int dev = 0, cus = 0, per_cu = 0;
        if (hipGetDevice(&dev) != hipSuccess || hipDeviceGetAttribute(&cus, hipDeviceAttributeMultiprocessorCount, dev) != hipSuccess) { grid = -1; return; }
        if (hipFuncSetAttribute((const void*)fwd_kernel, hipFuncAttributeMaxDynamicSharedMemorySize, LDS_BYTES) != hipSuccess) { fprintf(stderr, "kernel_launch: hipFuncSetAttribute failed\n"); grid = -1; return; }
        if (hipOccupancyMaxActiveBlocksPerMultiprocessor(&per_cu, (const void*)fwd_kernel, NTHR, LDS_BYTES) != hipSuccess || per_cu < 1) fprintf(stderr, "kernel_launch: occupancy query reports %d\n", per_cu);
        (void)hipGetLastError();
        grid = cus;
    }
    if (grid < 0) return;
    if (hipMemsetAsync((char*)d_ws + WS_CTL, 0, CTL_ZERO_BYTES, stream) != hipSuccess) return;
    Args a{};
    for (int i = 0; i < 32; ++i) a.in[i] = d_in[i];
    a.out = (float*)d_out; a.ws = (unsigned char*)d_ws;
#if MK_ONE_LAUNCH
    a.ph_lo = 0; a.ph_hi = NPHASE;
    hipLaunchKernelGGL(fwd_kernel, dim3(grid), dim3(NTHR), LDS_BYTES, stream, a);
#else
    for (int p = 0; p < NPHASE; ++p) { a.ph_lo = p; a.ph_hi = p + 1; hipLaunchKernelGGL(fwd_kernel, dim3(grid), dim3(NTHR), LDS_BYTES, stream, a); }
#endif
}
```

```cpp
#include <hip/hip_runtime.h>
#include <cstdio>
#include <cstdint>

#define LAS __attribute__((address_space(3)))
#define GAS __attribute__((address_space(1)))
typedef unsigned short bf16_t;
typedef short bf16x8 __attribute__((ext_vector_type(8)));
typedef short s16x4 __attribute__((ext_vector_type(4)));
typedef short v4i16_t __attribute__((ext_vector_type(4)));
typedef float f32x2 __attribute__((ext_vector_type(2)));
typedef float f32x4 __attribute__((ext_vector_type(4)));
typedef float f32x16 __attribute__((ext_vector_type(16)));
typedef unsigned u32x2 __attribute__((ext_vector_type(2)));
typedef unsigned u32x4 __attribute__((ext_vector_type(4)));
typedef __bf16 bf16x2_t __attribute__((ext_vector_type(2)));
typedef GAS unsigned gu32;

constexpr int DM = 1024, TP = 8192, MP = 16384, MS = 512, MT = MP + MS;
constexpr int NSEQ = 128, TS = 4, NPAGES = 16, PAGE = 128, PAST = 2048;
constexpr int DIN = 5640, ZP = 5632, DFF = 2816;
constexpr int ZQ = 0, ZK = 512, ZV = 1024, ZO = 1536, ZDQ = 2048, ZDK = 2560, ZDV = 3072, ZGM = 3584, ZGD = 4608;
constexpr float EPS = 1e-6f, LAM_INIT = 0.2f, LOG2E = 1.4426950408889634f;
constexpr float QSCALE = 0.125f * LOG2E;
constexpr float KSCALE = 0.08838834764831845f;
constexpr size_t OFF_Y = 0, OFF_KP = 17301504, OFF_VP = 25690112, OFF_CP = 34078720, OFF_NP = 34209792, OFF_MP = 34210816, OFF_CVP = 34210824,
                 OFF_KS = 34222088, OFF_VS = 34484232, OFF_CS = 34746376, OFF_NS = 43134984, OFF_MS = 43200520, OFF_CVS = 43201032, OUT_TOTAL = 43921928;
constexpr size_t MiB = 1u << 20;
constexpr size_t WS_CTL = 0, CTL_ZERO_BYTES = 1 * MiB;
constexpr size_t WS_WIN = 1 * MiB, WS_WUP = 12 * MiB, WS_WDOWN = 23 * MiB, WS_WOUT = 29 * MiB, WS_WPM = 31 * MiB, WS_WPD = 32 * MiB;
constexpr size_t WS_ADA = 33 * MiB, WS_IG = 37 * MiB, WS_LF = 37 * MiB + 512 * 1024, WS_ST = 38 * MiB, WS_NU = 38 * MiB + 65536, WS_NPREV = 39 * MiB, WS_MPREV = 39 * MiB + 768 * 1024;
constexpr size_t WS_H1 = 40 * MiB, WS_Z = 73 * MiB, WS_U = 255 * MiB, WS_CPREV = 319 * MiB, WS_HM = 351 * MiB, WS_HD = 368 * MiB, WS_O1 = 385 * MiB, WS_O2 = 417 * MiB;
constexpr size_t WS_MG = 449 * MiB, WS_Y = 482 * MiB, WS_UA = 548 * MiB, WS_UB = 639 * MiB, WS_G = 730 * MiB, WS_END = 821 * MiB;
constexpr int CW_BAR = 4096, CW_SCHED = 8192;
#ifndef DEC_LIM8
#define DEC_LIM8 12
#endif
constexpr int RING_BYTES = 131072, MISC_OFF = RING_BYTES + 320, LDS_BYTES = 147456;
constexpr int NWAVES = 8, NTHR = 512;

__device__ __forceinline__ unsigned pk2(float lo, float hi) { f32x2 v = {lo, hi}; bf16x2_t b = __builtin_convertvector(v, bf16x2_t); return __builtin_bit_cast(unsigned, b); }
__device__ __forceinline__ bf16_t f2bf(float x) { return (bf16_t)(pk2(x, 0.f) & 0xffffu); }
__device__ __forceinline__ float bflo(unsigned u) { return __uint_as_float(u << 16); }
__device__ __forceinline__ float bfhi(unsigned u) { return __uint_as_float(u & 0xffff0000u); }
__device__ __forceinline__ float bf2f(bf16_t u) { return __uint_as_float(((unsigned)u) << 16); }
__device__ __forceinline__ bf16x8 pack8(f32x4 a, f32x4 b) { u32x4 w; w.x = pk2(a.x, a.y); w.y = pk2(a.z, a.w); w.z = pk2(b.x, b.y); w.w = pk2(b.z, b.w); return __builtin_bit_cast(bf16x8, w); }
__device__ __forceinline__ void unpack8(u32x4 w, f32x4& a, f32x4& b) { a.x = bflo(w.x); a.y = bfhi(w.x); a.z = bflo(w.y); a.w = bfhi(w.y); b.x = bflo(w.z); b.y = bfhi(w.z); b.z = bflo(w.w); b.w = bfhi(w.w); }
__device__ __forceinline__ float wave_sum(float v) {
#pragma unroll
    for (int o = 1; o < 64; o <<= 1) v += __shfl_xor(v, o);
    return v;
}
__device__ __forceinline__ float wave_max(float v) {
#pragma unroll
    for (int o = 1; o < 64; o <<= 1) v = fmaxf(v, __shfl_xor(v, o));
    return v;
}
__device__ __forceinline__ float wave_scan_sum(float v, int lane) {
#pragma unroll
    for (int o = 1; o < 64; o <<= 1) { const float t = __shfl_up(v, o); if (lane >= o) v += t; }
    return v;
}
__device__ __forceinline__ float wave_scan_max(float v, int lane) {
#pragma unroll
    for (int o = 1; o < 64; o <<= 1) { const float t = __shfl_up(v, o); if (lane >= o) v = fmaxf(v, t); }
    return v;
}
__device__ __forceinline__ float sigmoidf_(float x) { return __builtin_amdgcn_rcpf(1.f + __builtin_amdgcn_exp2f(-x * LOG2E)); }
__device__ __forceinline__ float log_sigmoid(float x) { return fminf(x, 0.f) - log1pf(__expf(-fabsf(x))); }
__device__ __forceinline__ int crow(int reg, int h) { return (reg & 3) + 8 * (reg >> 2) + 4 * h; }
#define MFMA32(a, b, c) __builtin_amdgcn_mfma_f32_32x32x16_bf16((a), (b), (c), 0, 0, 0)
#define MFMA16(a, b, c) __builtin_amdgcn_mfma_f32_16x16x32_bf16((a), (b), (c), 0, 0, 0)
__device__ __forceinline__ s16x4 tr_rd(const LAS unsigned char* p) { return __builtin_bit_cast(s16x4, __builtin_amdgcn_ds_read_tr16_b64_v4i16((LAS v4i16_t*)p)); }
__device__ __forceinline__ bf16x8 cat4(s16x4 lo, s16x4 hi) { return (bf16x8){lo[0], lo[1], lo[2], lo[3], hi[0], hi[1], hi[2], hi[3]}; }
#define WG_BAR() __syncthreads()

namespace pg8 {
constexpr int BM = 256, BK = 64, HALF = 128, HTB = HALF * BK * 2, STAGE_BYTES = 8 * HTB, NXCD = 8, WGM = 8;
__host__ __device__ __forceinline__ int lds_byte(int r, int c) { const int st = (r >> 4) * 2 + (c >> 5), rr = r & 15, cc = c & 31, ob = rr * 64 + cc * 2; return st * 1024 + (ob ^ (((ob >> 9) & 1) << 5)); }
__host__ __device__ __forceinline__ void stage_rc(int b, int& R, int& C) { const int st = b / 1024, sb = b % 1024, swz = sb ^ (((sb >> 9) & 1) << 5); R = (st >> 1) * 16 + swz / 64; C = (st & 1) * 32 + (swz % 64) / 2; }
__host__ __device__ __forceinline__ int perm32(int rho) { const int n = rho >> 4, i = rho & 15; return 8 * (i >> 2) + 4 * n + (i & 3); }
struct Unit { int pm, pn; };
struct Gemm { const bf16_t* A; const bf16_t* Bt; int M, N, K; };
struct StaticOrder {
    int nM, nN, nwg, G, c;
    __host__ __device__ void init(int M, int N, int G_, int c_) { nM = M / BM; nN = N / BM; nwg = nM * nN; G = G_; c = c_; }
    __host__ __device__ bool next(int i, Unit& u) const {
        const long L = (long)i * G + c; if (L >= nwg) return false;
        int wgid = (int)L; { const int q = nwg / NXCD, r = nwg % NXCD, xcd = wgid % NXCD, off = wgid / NXCD; wgid = (xcd < r ? xcd * (q + 1) : r * (q + 1) + (xcd - r) * q) + off; }
        const int nig = WGM * nN, gid = wgid / nig, fm = gid * WGM, gsz = (nM - fm) < WGM ? (nM - fm) : WGM;
        u.pm = fm + ((wgid % nig) % gsz); u.pn = (wgid % nig) / gsz; return true;
    }
};
template <class Epi>
__device__ __forceinline__ void gemm_phase(LAS unsigned char* lds, const Gemm g, const StaticOrder& S, const Epi& E) {
    const int tid = threadIdx.x, wid = __builtin_amdgcn_readfirstlane(tid >> 6), lane = tid & 63, wr = wid >> 2, wc = wid & 3, fr = lane & 15, fq = lane >> 4;
    const int K = g.K, nt = K / BK;
    unsigned voffA[2], voffB[2];
#pragma unroll
    for (int i = 0; i < 2; ++i) { int R, C; stage_rc(tid * 16 + i * 8192, R, C); const int Rb = (R & ~31) + perm32(R & 31);
        voffA[i] = (unsigned)(R * K + C) * 2u; voffB[i] = (unsigned)(Rb * K + C) * 2u; }
    const size_t kstep = (size_t)(BK * 2);
    const size_t hstep = (size_t)HALF * K * 2;
    const size_t tstep = 2 * hstep;
    const unsigned ldsw = (unsigned)wid * 1024u;
    const int aoff = lds_byte(wr * 64 + fr, fq * 8), boff = lds_byte(wc * 32 + fr, fq * 8);
#define PG8_SA(b, h) (((b) * 2 + (h)) * HTB)
#define PG8_SB(b, h) ((4 + (b) * 2 + (h)) * HTB)
#define PG8_STAGE(bufoff, gbase, voff) do { _Pragma("unroll") for (int _i = 0; _i < 2; ++_i) \
        __builtin_amdgcn_global_load_lds((const unsigned*)((const char*)(gbase) + (voff)[_i]), (LAS unsigned*)(lds + (bufoff) + ldsw + _i * 8192), 16, 0, 0); } while (0)
#define PG8_LDA(dst, b, h) do { _Pragma("unroll") for (int m = 0; m < 4; ++m) _Pragma("unroll") for (int k = 0; k < 2; ++k) dst[m][k] = *(const LAS bf16x8*)(lds + PG8_SA(b, h) + aoff + m * 2048 + k * 1024); } while (0)
#define PG8_LDB(dst, b, h) do { _Pragma("unroll") for (int n = 0; n < 2; ++n) _Pragma("unroll") for (int k = 0; k < 2; ++k) dst[n][k] = *(const LAS bf16x8*)(lds + PG8_SB(b, h) + boff + n * 2048 + k * 1024); } while (0)
#define PG8_MMA(ai, bj, At, Bt) do { __builtin_amdgcn_s_setprio(1); _Pragma("unroll") for (int m = 0; m < 4; ++m) _Pragma("unroll") for (int n = 0; n < 2; ++n) _Pragma("unroll") for (int k = 0; k < 2; ++k) \
        acc[ai][bj][m][n] = __builtin_amdgcn_mfma_f32_16x16x32_bf16(Bt[n][k], At[m][k], acc[ai][bj][m][n], 0, 0, 0); __builtin_amdgcn_s_setprio(0); } while (0)
#define PG8_WAIT_V(n) asm volatile("s_waitcnt vmcnt(" #n ")" ::: "memory")
#define PG8_WAIT_L(n) asm volatile("s_waitcnt lgkmcnt(" #n ")" ::: "memory")
#define PG8_BAR __builtin_amdgcn_s_barrier()
#define PG8_SCHED __builtin_amdgcn_sched_barrier(0)
    Unit cur, nxt; int ui = 0;
    if (!S.next(0, cur)) return;
    f32x4 acc[2][2][4][2];
#pragma unroll
    for (int a = 0; a < 2; ++a)
#pragma unroll
        for (int b = 0; b < 2; ++b)
#pragma unroll
            for (int m = 0; m < 4; ++m)
#pragma unroll
                for (int n = 0; n < 2; ++n) acc[a][b][m][n] = (f32x4){0.f, 0.f, 0.f, 0.f};
    bf16x8 At[4][2], B0[2][2], B1[2][2];
    const char* cA = (const char*)g.A + (size_t)cur.pm * tstep; const char* cB = (const char*)g.Bt + (size_t)cur.pn * tstep;
    PG8_STAGE(PG8_SB(0, 0), cB, voffB); PG8_STAGE(PG8_SB(0, 1), cB + hstep, voffB); PG8_STAGE(PG8_SA(0, 0), cA, voffA); PG8_STAGE(PG8_SA(0, 1), cA + hstep, voffA);
    if (wr == 1) PG8_BAR;
    PG8_WAIT_V(2); PG8_BAR;
    PG8_STAGE(PG8_SB(1, 0), cB + kstep, voffB); PG8_STAGE(PG8_SA(1, 0), cA + kstep, voffA); PG8_STAGE(PG8_SB(1, 1), cB + hstep + kstep, voffB);
    PG8_WAIT_V(6); PG8_BAR;
    for (;;) {
        const bool has_next = S.next(ui + 1, nxt);
        const char* nA = has_next ? (const char*)g.A + (size_t)nxt.pm * tstep : cA; const char* nB = has_next ? (const char*)g.Bt + (size_t)nxt.pn * tstep : cB;
        for (int t = 0; t < nt; t += 2) {
            const bool last = (t == nt - 2);
            const char* a1 = cA + (size_t)(t + 1) * kstep;
            const char* a2 = last ? nA : cA + (size_t)(t + 2) * kstep; const char* b2 = last ? nB : cB + (size_t)(t + 2) * kstep;
            const char* a3 = a2 + kstep; const char* b3 = b2 + kstep;
            PG8_LDB(B0, 0, 0); PG8_LDB(B1, 0, 1); PG8_SCHED; PG8_LDA(At, 0, 0); PG8_STAGE(PG8_SA(1, 1), a1 + hstep, voffA);
            PG8_WAIT_V(8); PG8_WAIT_L(0); PG8_BAR; PG8_MMA(0, 0, At, B0); PG8_MMA(0, 1, At, B1); PG8_BAR; PG8_SCHED;
            PG8_LDA(At, 0, 1); PG8_STAGE(PG8_SB(0, 0), b2, voffB); PG8_STAGE(PG8_SB(0, 1), b2 + hstep, voffB); PG8_STAGE(PG8_SA(0, 0), a2, voffA);
            PG8_WAIT_V(8); PG8_WAIT_L(0); PG8_BAR; PG8_MMA(1, 0, At, B0); PG8_MMA(1, 1, At, B1); PG8_BAR; PG8_SCHED;
            PG8_LDB(B0, 1, 0); PG8_LDB(B1, 1, 1); PG8_SCHED; PG8_LDA(At, 1, 0); PG8_STAGE(PG8_SA(0, 1), a2 + hstep, voffA);
            PG8_WAIT_V(8); PG8_WAIT_L(0); PG8_BAR; PG8_MMA(0, 0, At, B0); PG8_MMA(0, 1, At, B1); PG8_BAR; PG8_SCHED;
            PG8_LDA(At, 1, 1); PG8_STAGE(PG8_SB(1, 0), b3, voffB); PG8_STAGE(PG8_SB(1, 1), b3 + hstep, voffB); PG8_STAGE(PG8_SA(1, 0), a3, voffA);
            PG8_WAIT_V(8); PG8_WAIT_L(0); PG8_BAR; PG8_MMA(1, 0, At, B0); PG8_MMA(1, 1, At, B1); PG8_BAR; PG8_SCHED;
        }
        if (wr == 0) PG8_BAR;
        {
            const int row0 = cur.pm * BM + wr * 64 + fr, col0 = cur.pn * BM + wc * 32 + 8 * fq;
#pragma unroll
            for (int ai = 0; ai < 2; ++ai)
#pragma unroll
                for (int m = 0; m < 4; ++m)
#pragma unroll
                    for (int bj = 0; bj < 2; ++bj) E.st8(row0 + ai * HALF + m * 16, col0 + bj * HALF, acc[ai][bj][m][0], acc[ai][bj][m][1]);
        }
        if (!has_next) break;
#pragma unroll
        for (int a = 0; a < 2; ++a)
#pragma unroll
            for (int b = 0; b < 2; ++b)
#pragma unroll
                for (int m = 0; m < 4; ++m)
#pragma unroll
                    for (int n = 0; n < 2; ++n) acc[a][b][m][n] = (f32x4){0.f, 0.f, 0.f, 0.f};
        cur = nxt; cA = nA; cB = nB; ++ui;
        if (wr == 1) PG8_BAR;
    }
    PG8_WAIT_V(0);
    PG8_BAR;
#undef PG8_SA
#undef PG8_SB
#undef PG8_STAGE
#undef PG8_LDA
#undef PG8_LDB
#undef PG8_MMA
#undef PG8_WAIT_V
#undef PG8_WAIT_L
#undef PG8_BAR
#undef PG8_SCHED
}
}

#define XB_TMO      128
#define XB_XCNT(j)  (256  + 64 * (j))
#define XB_XSUB(j)  (1280 + 64 * (j))
#define XB_XGEN(j)  (2304 + 64 * (j))
#define XB_TOP      3328
#define XB_TOPGEN   3392
#define XCD_BAR_WORDS 3456
#define XB_SPIN_CAP (1u << 18)
__device__ __forceinline__ unsigned xb_ld(unsigned* p)              { return __hip_atomic_load(p, __ATOMIC_RELAXED, __HIP_MEMORY_SCOPE_AGENT); }
__device__ __forceinline__ unsigned xb_add(unsigned* p, unsigned v) { return __hip_atomic_fetch_add(p, v, __ATOMIC_RELAXED, __HIP_MEMORY_SCOPE_AGENT); }
__device__ __forceinline__ unsigned xb_xcc_id() { return (unsigned)__builtin_amdgcn_s_getreg((3 << 11) | 20) & 0xFu; }
#define XB_SPIN(cond, bar) do { unsigned _sp = 0; while (cond) { __builtin_amdgcn_s_sleep(1); \
    if ((++_sp & 255u) == 0u) { if (xb_ld(&(bar)[XB_TMO])) break; if (_sp > XB_SPIN_CAP) { atomicAdd(&(bar)[XB_TMO], 1u); break; } } } } while (0)
struct XcdBarrier { unsigned* bar; unsigned x; volatile LAS unsigned* st; };
__device__ __forceinline__ XcdBarrier xcd_barrier_post(unsigned* bar, volatile LAS unsigned* st) {
    XcdBarrier b; b.bar = bar; b.x = xb_xcc_id(); b.st = st;
    if (threadIdx.x == 0) (void)xb_add(&bar[XB_XCNT(b.x)], 1u);
    return b;
}
__device__ __forceinline__ void xcd_barrier_complete(unsigned* bar, unsigned x, unsigned& nloc, unsigned& nx) {
    const unsigned G = gridDim.x * gridDim.y * gridDim.z;
    unsigned sum, cnt, mine, sp = 0u;
    for (;;) {
        sum = 0u; cnt = 0u; mine = 0u;
#pragma unroll
        for (unsigned j = 0; j < 16; ++j) { const unsigned c = xb_ld(&bar[XB_XCNT(j)]); sum += c; cnt += (c > 0u) ? 1u : 0u; mine = (j == x) ? c : mine; }
        if (sum == G) break;
        __builtin_amdgcn_s_sleep(1);
        if ((++sp & 255u) == 0u) { if (xb_ld(&bar[XB_TMO])) break; if (sp > XB_SPIN_CAP) { atomicAdd(&bar[XB_TMO], 1u); break; } }
    }
    nloc = mine > 0u ? mine : 1u; nx = cnt > 0u ? cnt : 1u;
}
__device__ __forceinline__ void xcd_barrier(const XcdBarrier& b) {
    asm volatile("s_waitcnt vmcnt(0)" ::: "memory");
    __syncthreads();
    if (threadIdx.x == 0) {
        unsigned* bar = b.bar;
        __builtin_amdgcn_s_waitcnt(0);
        unsigned nloc = b.st[0], nx = b.st[1];
        if (nloc == 0u) { xcd_barrier_complete(bar, b.x, nloc, nx); b.st[0] = nloc; b.st[1] = nx; }
        const unsigned old = xb_add(&bar[XB_XSUB(b.x)], 1u);
        const unsigned gen = old / nloc;
        if (old + 1u == (gen + 1u) * nloc) {
            __builtin_amdgcn_fence(__ATOMIC_RELEASE, "agent");
            asm volatile("s_waitcnt vmcnt(0)" ::: "memory");
            const unsigned og = xb_add(&bar[XB_TOP], 1u);
            const unsigned tg = og / nx;
            if (og + 1u == (tg + 1u) * nx) xb_add(&bar[XB_TOPGEN], 1u);
            else XB_SPIN(xb_ld(&bar[XB_TOPGEN]) == tg, bar);
            __builtin_amdgcn_fence(__ATOMIC_ACQUIRE, "agent");
            xb_add(&bar[XB_XGEN(b.x)], 1u);
            asm volatile("s_waitcnt vmcnt(0)" ::: "memory");
        } else {
            XB_SPIN(xb_ld(&bar[XB_XGEN(b.x)]) == gen, bar);
            __builtin_amdgcn_fence(__ATOMIC_ACQUIRE, "agent");
            asm volatile("s_waitcnt vmcnt(0)" ::: "memory");
        }
    }
    __syncthreads();
}

struct Args { const void* in[32]; float* out; unsigned char* ws; int ph_lo, ph_hi; };
struct Frame { LAS unsigned char* lds; int tid, lane, wave, vcu, G; const Args* a; };
#define FP_x_prompt ((const float*)F.a->in[0])
#define FP_x_sample ((const float*)F.a->in[1])
#define FP_c_prompt ((const float*)F.a->in[2])
#define FP_c_sample ((const float*)F.a->in[3])
#define FP_cache_k ((const float*)F.a->in[4])
#define FP_cache_v ((const float*)F.a->in[5])
#define FP_page_table ((const int*)F.a->in[6])
#define FP_state_C ((const float*)F.a->in[7])
#define FP_state_n ((const float*)F.a->in[8])
#define FP_state_m ((const float*)F.a->in[9])
#define FP_state_conv ((const float*)F.a->in[10])
#define FP_w_ada ((const float*)F.a->in[11])
#define FP_b_ada ((const float*)F.a->in[12])
#define FP_g_pre_mix ((const float*)F.a->in[13])
#define FP_g_post_mix ((const float*)F.a->in[14])
#define FP_w_in ((const float*)F.a->in[15])
#define FP_b_if ((const float*)F.a->in[16])
#define FP_g_mlstm ((const float*)F.a->in[17])
#define FP_lq1 ((const float*)F.a->in[18])
#define FP_lk1 ((const float*)F.a->in[19])
#define FP_lq2 ((const float*)F.a->in[20])
#define FP_lk2 ((const float*)F.a->in[21])
#define FP_g_diff ((const float*)F.a->in[22])
#define FP_w_proj_m ((const float*)F.a->in[23])
#define FP_w_proj_d ((const float*)F.a->in[24])
#define FP_w_out ((const float*)F.a->in[25])
#define FP_g_pre_ffn ((const float*)F.a->in[26])
#define FP_g_post_ffn ((const float*)F.a->in[27])
#define FP_w_up ((const float*)F.a->in[28])
#define FP_conv_w ((const float*)F.a->in[29])
#define FP_conv_b ((const float*)F.a->in[30])
#define FP_w_down ((const float*)F.a->in[31])
#define FP_WinT ((bf16_t*)(F.a->ws + WS_WIN))
#define FP_WupT ((bf16_t*)(F.a->ws + WS_WUP))
#define FP_WdownT ((bf16_t*)(F.a->ws + WS_WDOWN))
#define FP_WoutT ((bf16_t*)(F.a->ws + WS_WOUT))
#define FP_WpmT ((bf16_t*)(F.a->ws + WS_WPM))
#define FP_WpdT ((bf16_t*)(F.a->ws + WS_WPD))
#define FP_H1 ((bf16_t*)(F.a->ws + WS_H1))
#define FP_Z ((bf16_t*)(F.a->ws + WS_Z))
#define FP_CPREV ((bf16_t*)(F.a->ws + WS_CPREV))
#define FP_HM ((bf16_t*)(F.a->ws + WS_HM))
#define FP_HD ((bf16_t*)(F.a->ws + WS_HD))
#define FP_MG ((bf16_t*)(F.a->ws + WS_MG))
#define FP_UA ((bf16_t*)(F.a->ws + WS_UA))
#define FP_UB ((bf16_t*)(F.a->ws + WS_UB))
#define FP_GB ((bf16_t*)(F.a->ws + WS_G))
#define FP_ADA ((float*)(F.a->ws + WS_ADA))
#define FP_IG ((float*)(F.a->ws + WS_IG))
#define FP_LF ((float*)(F.a->ws + WS_LF))
#define FP_ST ((float*)(F.a->ws + WS_ST))
#define FP_NU ((float*)(F.a->ws + WS_NU))
#define FP_NPREV ((float*)(F.a->ws + WS_NPREV))
#define FP_MPREV ((float*)(F.a->ws + WS_MPREV))
#define FP_U ((float*)(F.a->ws + WS_U))
#define FP_O1 ((float*)(F.a->ws + WS_O1))
#define FP_O2 ((float*)(F.a->ws + WS_O2))
#define FP_Y ((bf16_t*)(F.a->ws + WS_Y))
#define FP_out (F.a->out)


__device__ __forceinline__ void transpose_item(const float* W, int pitch, int scol0, int K, bf16_t* WT, int drow0, LAS float* scr, int kb, int nb, int lane) {
    const int k0 = 64 * kb, n0 = 32 * nb;
#pragma unroll 8
    for (int i = 0; i < 32; ++i) { const int kk = 2 * i + (lane >> 5); scr[kk * 33 + (lane & 31)] = W[(size_t)(k0 + kk) * pitch + scol0 + n0 + (lane & 31)]; }
    asm volatile("s_waitcnt lgkmcnt(0)" ::: "memory");
    const int c = lane & 7;
#pragma unroll
    for (int j = 0; j < 4; ++j) { const int n = (lane >> 3) + 8 * j; const LAS float* s = scr + (8 * c) * 33 + n;
        u32x4 o; o.x = pk2(s[0 * 33], s[1 * 33]); o.y = pk2(s[2 * 33], s[3 * 33]); o.z = pk2(s[4 * 33], s[5 * 33]); o.w = pk2(s[6 * 33], s[7 * 33]);
        *(u32x4*)(WT + (size_t)(drow0 + n0 + n) * K + k0 + 8 * c) = o; }
    asm volatile("s_waitcnt lgkmcnt(0)" ::: "memory");
}
__device__ __forceinline__ void p0_transposes(const Frame& F) {
    LAS float* scr = (LAS float*)(F.lds + 40960 + F.wave * 8448);
    const int gw = F.vcu * NWAVES + F.wave, NGW = F.G * NWAVES;
    constexpr int I0 = 16 * 64, I1 = 16 * 112, I2 = 8 * 32, I3 = 8 * 32, I4 = 16 * 32, I5 = 16 * 176, I6 = 44 * 32;
    constexpr int NITEMS = I0 + I1 + I2 + I3 + I4 + I5 + I6;
    for (int it = gw; it < NITEMS; it += NGW) {
        int r = it;
        if (r < I0) { transpose_item(FP_w_in, DIN, 0, 1024, FP_WinT, 0, scr, r / 64, r % 64, F.lane); continue; } r -= I0;
        if (r < I1) { transpose_item(FP_w_in, DIN, 2056, 1024, FP_WinT, 2048, scr, r / 112, r % 112, F.lane); continue; } r -= I1;
        if (r < I2) { transpose_item(FP_w_proj_m, 1024, 0, 512, FP_WpmT, 0, scr, r / 32, r % 32, F.lane); continue; } r -= I2;
        if (r < I3) { transpose_item(FP_w_proj_d, 1024, 0, 512, FP_WpdT, 0, scr, r / 32, r % 32, F.lane); continue; } r -= I3;
        if (r < I4) { transpose_item(FP_w_out, 1024, 0, 1024, FP_WoutT, 0, scr, r / 32, r % 32, F.lane); continue; } r -= I4;
        if (r < I5) { transpose_item(FP_w_up, 2 * DFF, 0, 1024, FP_WupT, 0, scr, r / 176, r % 176, F.lane); continue; } r -= I5;
        transpose_item(FP_w_down, 1024, 0, DFF, FP_WdownT, 0, scr, r / 32, r % 32, F.lane);
    }
}
__device__ __forceinline__ void p0_ada(const Frame& F) {
    const int lane = F.lane, r = lane & 31, h = lane >> 5, w = F.wave;
    LAS float* part = (LAS float*)F.lds;
    for (int task = F.vcu; task < 192; task += F.G) {
        const int n0 = 32 * task;
        bf16x8 bw[8];
#pragma unroll
        for (int ks = 0; ks < 8; ++ks) { const float* p = FP_w_ada + (size_t)(128 * w + 16 * ks + 8 * h) * 6144 + n0 + r;
            f32x4 a, b; a.x = p[0]; a.y = p[6144]; a.z = p[2 * 6144]; a.w = p[3 * 6144]; b.x = p[4 * 6144]; b.y = p[5 * 6144]; b.z = p[6 * 6144]; b.w = p[7 * 6144]; bw[ks] = pack8(a, b); }
        for (int rt = 0; rt < 5; ++rt) {
            const int R = 32 * rt + r;
            const float* cr = R < 2 ? FP_c_prompt + (size_t)R * 1024 : FP_c_sample + (size_t)(R < 130 ? R - 2 : 0) * 1024;
            f32x16 acc; for (int i = 0; i < 16; ++i) acc[i] = 0.f;
#pragma unroll
            for (int ks = 0; ks < 8; ++ks) { f32x4 a = *(const f32x4*)(cr + 128 * w + 16 * ks + 8 * h), b = *(const f32x4*)(cr + 128 * w + 16 * ks + 8 * h + 4);
                if (R >= 130) { a = (f32x4){0.f, 0.f, 0.f, 0.f}; b = a; }
                acc = MFMA32(pack8(a, b), bw[ks], acc); }
#pragma unroll
            for (int i = 0; i < 16; ++i) part[(w * 32 + crow(i, h)) * 32 + r] = acc[i];
            WG_BAR();
#pragma unroll
            for (int k = 0; k < 2; ++k) { const int idx = F.tid + 512 * k, row = idx >> 5, col = idx & 31; float s = 0.f;
#pragma unroll
                for (int ww = 0; ww < 8; ++ww) s += part[(ww * 32 + row) * 32 + col];
                const int Rr = 32 * rt + row; if (Rr < 130) FP_ADA[(size_t)Rr * 6144 + n0 + col] = s + FP_b_ada[n0 + col]; }
            WG_BAR();
        }
    }
}
__device__ __forceinline__ int crow_of(int m) { return m < MP ? (m >> 13) : 2 + ((m - MP) >> 2); }
__device__ __forceinline__ const float* xrow_of(const Frame& F, int m) { return m < MP ? FP_x_prompt + (size_t)m * DM : FP_x_sample + (size_t)(m - MP) * DM; }
__device__ __forceinline__ void p1_norm_gates(const Frame& F) {
    LAS float* wg = (LAS float*)F.lds;
    for (int i = F.tid; i < 8192; i += NTHR) { const int k = i >> 3, g = i & 7; wg[g * 1024 + k] = FP_w_in[(size_t)k * DIN + 2048 + g]; }
    WG_BAR();
    const int lane = F.lane, gw = F.vcu * NWAVES + F.wave, NGW = F.G * NWAVES;
    const int r_lo = (int)(((long)gw * MT) / NGW), r_hi = (int)(((long)(gw + 1) * MT) / NGW);
    f32x4 gp[4], gs[4], sh[4], vn[4];
#pragma unroll
    for (int j = 0; j < 4; ++j) { gp[j] = *(const f32x4*)(FP_g_pre_mix + 4 * lane + 256 * j); gs[j] = gp[j]; sh[j] = gp[j]; vn[j] = gp[j]; }
    int ccur = -1;
    if (r_lo < r_hi) { const float* xr = xrow_of(F, r_lo);
#pragma unroll
        for (int j = 0; j < 4; ++j) vn[j] = *(const f32x4*)(xr + 4 * lane + 256 * j); }
    for (int m = r_lo; m < r_hi; ++m) {
        f32x4 v[4]; float ss = 0.f;
#pragma unroll
        for (int j = 0; j < 4; ++j) v[j] = vn[j];
        if (m + 1 < r_hi) { const float* xr = xrow_of(F, m + 1);
#pragma unroll
            for (int j = 0; j < 4; ++j) vn[j] = *(const f32x4*)(xr + 4 * lane + 256 * j); }
        const int cr = crow_of(m);
        if (cr != ccur) { ccur = cr; const float* ada = FP_ADA + (size_t)cr * 6144;
#pragma unroll
            for (int j = 0; j < 4; ++j) { sh[j] = *(const f32x4*)(ada + 4 * lane + 256 * j); gs[j] = gp[j] * (*(const f32x4*)(ada + 1024 + 4 * lane + 256 * j) + 1.f); } }
#pragma unroll
        for (int j = 0; j < 4; ++j) ss += (v[j].x * v[j].x + v[j].y * v[j].y) + (v[j].z * v[j].z + v[j].w * v[j].w);
        const float rs = rsqrtf(wave_sum(ss) * (1.f / DM) + EPS);
        float gd[8];
#pragma unroll
        for (int g = 0; g < 8; ++g) gd[g] = 0.f;
#pragma unroll
        for (int j = 0; j < 4; ++j) { const f32x4 hv = (v[j] * rs) * gs[j] + sh[j];
#pragma unroll
            for (int g = 0; g < 8; ++g) { const f32x4 wv = *(const LAS f32x4*)(wg + g * 1024 + 4 * lane + 256 * j); gd[g] += (hv.x * wv.x + hv.y * wv.y) + (hv.z * wv.z + hv.w * wv.w); }
            u32x2 o; o.x = pk2(hv.x, hv.y); o.y = pk2(hv.z, hv.w); *(u32x2*)(FP_H1 + (size_t)m * DM + 4 * lane + 256 * j) = o; }
#pragma unroll
        for (int g = 0; g < 8; ++g) gd[g] = wave_sum(gd[g]);
        if (lane == 0) { const f32x4 bi = *(const f32x4*)FP_b_if, bf = *(const f32x4*)(FP_b_if + 4);
            *(f32x4*)(FP_IG + (size_t)m * 4) = (f32x4){gd[0] + bi.x, gd[1] + bi.y, gd[2] + bi.z, gd[3] + bi.w};
            *(f32x4*)(FP_LF + (size_t)m * 4) = (f32x4){log_sigmoid(gd[4] + bf.x), log_sigmoid(gd[5] + bf.y), log_sigmoid(gd[6] + bf.z), log_sigmoid(gd[7] + bf.w)}; }
    }
}
struct EpiZ {
    bf16_t* Z; float* out;
    __device__ __forceinline__ void st8(int row, int col, f32x4 v0, f32x4 v1) const {
        const int pn = col >> 8; const float sc = (pn == 2 || pn == 3) ? KSCALE : ((pn == 8 || pn == 9) ? QSCALE : 1.f);
        if (pn >= 10 && pn < 14) { const int kv = pn >= 12; const int c = col - (kv ? ZDV : ZDK);
            float* o = row < MP ? out + (kv ? OFF_VP : OFF_KP) + (size_t)row * 512 + c : out + (kv ? OFF_VS : OFF_KS) + (size_t)(row - MP) * 512 + c;
            *(f32x4*)o = v0; *(f32x4*)(o + 4) = v1; }
        *(bf16x8*)(Z + (size_t)row * ZP + col) = pack8(v0 * sc, v1 * sc);
    }
};
struct EpiPM {
    const bf16_t* Z; bf16_t* MG;
    __device__ __forceinline__ void st4(int row, int col, f32x4 v) const {
        const u32x2 g = *(const u32x2*)(Z + (size_t)row * ZP + ZGM + col);
        u32x2 o; o.x = pk2(sigmoidf_(bflo(g.x)) * v.x, sigmoidf_(bfhi(g.x)) * v.y); o.y = pk2(sigmoidf_(bflo(g.y)) * v.z, sigmoidf_(bfhi(g.y)) * v.w);
        *(u32x2*)(MG + (size_t)row * DM + col) = o; }
    __device__ __forceinline__ void st8(int row, int col, f32x4 v0, f32x4 v1) const { st4(row, col, v0); st4(row, col + 4, v1); }
};
struct EpiPD {
    const bf16_t* Z; bf16_t* MG;
    __device__ __forceinline__ void st4(int row, int col, f32x4 v) const {
        const u32x2 g = *(const u32x2*)(Z + (size_t)row * ZP + ZGD + col); const u32x2 p = *(const u32x2*)(MG + (size_t)row * DM + col);
        u32x2 o; o.x = pk2(bflo(p.x) + sigmoidf_(bflo(g.x)) * v.x, bfhi(p.x) + sigmoidf_(bfhi(g.x)) * v.y); o.y = pk2(bflo(p.y) + sigmoidf_(bflo(g.y)) * v.z, bfhi(p.y) + sigmoidf_(bfhi(g.y)) * v.w);
        *(u32x2*)(MG + (size_t)row * DM + col) = o; }
    __device__ __forceinline__ void st8(int row, int col, f32x4 v0, f32x4 v1) const { st4(row, col, v0); st4(row, col + 4, v1); }
};
struct EpiF32 {
    bf16_t* Y;
    __device__ __forceinline__ void st4(int row, int col, f32x4 v) const { u32x2 o; o.x = pk2(v.x, v.y); o.y = pk2(v.z, v.w); *(u32x2*)(Y + (size_t)row * DM + col) = o; }
    __device__ __forceinline__ void st8(int row, int col, f32x4 v0, f32x4 v1) const { *(bf16x8*)(Y + (size_t)row * DM + col) = pack8(v0, v1); }
};
struct EpiUp {
    bf16_t* UA; bf16_t* UB; float* out;
    __device__ __forceinline__ void st8(int row, int col, f32x4 v0, f32x4 v1) const {
        if (col < DFF) {
            *(bf16x8*)(UA + (size_t)row * DFF + col) = pack8(v0, v1);
            if (row < MP) { const int t = row & (TP - 1); if (t >= TP - 2) { float* o = out + OFF_CVP + ((size_t)(row >> 13) * 2 + (t - (TP - 2))) * DFF + col; *(f32x4*)o = v0; *(f32x4*)(o + 4) = v1; } }
            else { const int t = (row - MP) & 3; if (t >= 2) { float* o = out + OFF_CVS + ((size_t)((row - MP) >> 2) * 2 + (t - 2)) * DFF + col; *(f32x4*)o = v0; *(f32x4*)(o + 4) = v1; } }
        } else *(bf16x8*)(UB + (size_t)row * DFF + (col - DFF)) = pack8(v0, v1);
    }
};
template <class Epi>
__device__ __forceinline__ void skinny_gemm(const Frame& F, const bf16_t* A, const bf16_t* Bt, int K, const Epi& E) {
    const int lane = F.lane, r = lane & 31, h = lane >> 5, ct = F.wave & 1, kq = F.wave >> 1, Kq = K >> 2;
    LAS float* part = (LAS float*)F.lds;
    for (int task = F.vcu; task < 256; task += F.G) {
        const int rt = task >> 4, cg = task & 15;
        const bf16_t* ap = A + (size_t)(32 * rt + r) * K + kq * Kq + 8 * h;
        const bf16_t* bp = Bt + (size_t)(64 * cg + 32 * ct + r) * K + kq * Kq + 8 * h;
        f32x16 acc; for (int i = 0; i < 16; ++i) acc[i] = 0.f;
#pragma unroll 4
        for (int s = 0; s < Kq / 16; ++s) { const bf16x8 a = *(const bf16x8*)(ap + 16 * s), b = *(const bf16x8*)(bp + 16 * s); acc = MFMA32(b, a, acc); }
#pragma unroll
        for (int g4 = 0; g4 < 4; ++g4) *(LAS f32x4*)(part + (kq * 32 + r) * 68 + 32 * ct + 8 * g4 + 4 * h) = (f32x4){acc[4 * g4], acc[4 * g4 + 1], acc[4 * g4 + 2], acc[4 * g4 + 3]};
        WG_BAR();
        { const int row = F.tid >> 4, c4 = (F.tid & 15) * 4;
          f32x4 s = *(const LAS f32x4*)(part + row * 68 + c4) + *(const LAS f32x4*)(part + (32 + row) * 68 + c4) + *(const LAS f32x4*)(part + (64 + row) * 68 + c4) + *(const LAS f32x4*)(part + (96 + row) * 68 + c4);
          E.st4(MP + 32 * rt + row, 64 * cg + c4, s); }
        WG_BAR();
    }
}

constexpr int VROW = 320;
__device__ __forceinline__ void mlstm_A_unit(const Frame& F, int u) {
    const int bh = u >> 7, c = u & 127, b = bh >> 2, h = bh & 3, m0 = b * TP + c * 64;
    const int tid = F.tid, lane = F.lane, wid = F.wave;
    LAS unsigned char* Vt = F.lds; LAS unsigned char* Kt = F.lds + 20480; LAS float* wl = (LAS float*)(F.lds + 40960);
    if (wid == 0) {
        const float lf = FP_LF[(size_t)(m0 + lane) * 4 + h], ig = FP_IG[(size_t)(m0 + lane) * 4 + h];
        const float Fc = wave_scan_sum(lf, lane), a = ig - Fc, Ac = wave_scan_max(a, lane);
        const float Mloc = __shfl(Ac, 63), Fsum = __shfl(Fc, 63);
        wl[lane] = __expf(a - Mloc);
        if (lane == 0) { FP_ST[2 * u] = Fsum; FP_ST[2 * u + 1] = Mloc; }
    }
    WG_BAR();
#pragma unroll
    for (int i = 0; i < 2; ++i) { const int idx = tid + 512 * i, row = idx >> 4, ch = idx & 15;
        const bf16_t* src = FP_Z + (size_t)(m0 + row) * ZP + h * 128 + ch * 8;
        const u32x4 vv = *(const u32x4*)(src + ZV); const u32x4 kk = *(const u32x4*)(src + ZK);
        f32x4 k0, k1; unpack8(kk, k0, k1); const float w = wl[row];
        *(LAS u32x4*)(Vt + row * VROW + ch * 16) = vv;
        *(LAS bf16x8*)(Kt + row * VROW + ch * 16) = pack8(k0 * w, k1 * w); }
    WG_BAR();
    if (tid < 128) { float s = 0.f;
#pragma unroll 8
        for (int row = 0; row < 64; ++row) s += bf2f(*(const LAS bf16_t*)(Kt + row * VROW + tid * 2));
        FP_NU[(size_t)u * 128 + tid] = s; }
    {
        const int r32 = lane & 31, hi = lane >> 5, vh = (lane >> 4) & 1, q4 = (lane & 15) >> 2, p = lane & 3;
        const int vt = wid >> 1, dt0 = 2 * (wid & 1);
        const int lbase = (8 * hi + q4) * VROW + (16 * vh + 4 * p) * 2;
        f32x16 acc0, acc1; for (int i = 0; i < 16; ++i) { acc0[i] = 0.f; acc1[i] = 0.f; }
#pragma unroll
        for (int st = 0; st < 4; ++st) {
            const LAS unsigned char* va = Vt + lbase + st * 16 * VROW + vt * 64;
            const bf16x8 af = cat4(tr_rd(va), tr_rd(va + 4 * VROW));
            const LAS unsigned char* ka = Kt + lbase + st * 16 * VROW + dt0 * 64;
            const bf16x8 b0 = cat4(tr_rd(ka), tr_rd(ka + 4 * VROW)), b1 = cat4(tr_rd(ka + 64), tr_rd(ka + 64 + 4 * VROW));
            acc0 = MFMA32(af, b0, acc0); acc1 = MFMA32(af, b1, acc1);
        }
        float* Uo = FP_U + (size_t)u * 16384;
#pragma unroll
        for (int i = 0; i < 16; ++i) { const int v = 32 * vt + crow(i, hi); Uo[v * 128 + 32 * dt0 + r32] = acc0[i]; Uo[v * 128 + 32 * dt0 + 32 + r32] = acc1[i]; }
    }
    WG_BAR();
}
__device__ __forceinline__ void smlstm_unit(const Frame& F, int u) {
    const int n = u >> 2, h = u & 3, tid = F.tid, lane = F.lane, wid = F.wave;
    const int mrow = MP + 4 * n;
    LAS float* qs = (LAS float*)F.lds; LAS float* ks = qs + 512; LAS float* vs = ks + 512; LAS float* numI = vs + 512; LAS float* Sm = numI + 512; LAS float* nq = Sm + 16; LAS float* red = nq + 4;
    { const int t = tid >> 7, d = tid & 127; const bf16_t* z = FP_Z + (size_t)(mrow + t) * ZP + h * 128 + d;
      qs[tid] = bf2f(z[ZQ]); ks[tid] = bf2f(z[ZK]); vs[tid] = bf2f(z[ZV]); }
    LAS float* gl = red + 8;
    const float m0 = FP_state_m[n * 4 + h];
    if (tid < 4) { float cum = 0.f, am = -INFINITY, at = 0.f;
      for (int t = 0; t <= tid; ++t) { cum += FP_LF[(size_t)(mrow + t) * 4 + h]; at = FP_IG[(size_t)(mrow + t) * 4 + h] - cum; am = fmaxf(am, at); }
      const float mxv = fmaxf(m0, am);
      gl[tid] = cum; gl[4 + tid] = at; gl[8 + tid] = mxv; gl[12 + tid] = __expf(m0 - mxv); gl[16 + tid] = cum + mxv; }
    WG_BAR();
    const float m_end = gl[19], Fend = gl[3], decay = __expf(Fend + m0 - m_end);
    const float wend0 = __expf(Fend + gl[4] - m_end), wend1 = __expf(Fend + gl[5] - m_end), wend2 = __expf(Fend + gl[6] - m_end), wend3 = __expf(Fend + gl[7] - m_end);
#pragma unroll
    for (int k = 0; k < 2; ++k) { const int pid = 2 * wid + k, t = pid >> 2, s = pid & 3;
        float d = qs[t * 128 + lane] * ks[s * 128 + lane] + qs[t * 128 + 64 + lane] * ks[s * 128 + 64 + lane]; d = wave_sum(d);
        if (lane == 0) Sm[pid] = (s <= t) ? d * __expf(gl[4 + s] - gl[8 + t]) : 0.f; }
    if (wid < 4) { const float* n0 = FP_state_n + (size_t)u * 128; float d = n0[lane] * qs[wid * 128 + lane] + n0[64 + lane] * qs[wid * 128 + 64 + lane]; d = wave_sum(d); if (lane == 0) nq[wid] = d; }
    { const int vrow = tid >> 2, dq = tid & 3;
      const float* c0 = FP_state_C + ((size_t)u * 128 + vrow) * 128 + 32 * dq; float* co = FP_out + OFF_CS + ((size_t)u * 128 + vrow) * 128 + 32 * dq;
      f32x4 cv[8];
#pragma unroll
      for (int i = 0; i < 8; ++i) cv[i] = *(const f32x4*)(c0 + 4 * i);
      float ps[4]; float coef[4];
      ps[0] = 0.f; ps[1] = 0.f; ps[2] = 0.f; ps[3] = 0.f;
      coef[0] = wend0 * vs[vrow]; coef[1] = wend1 * vs[128 + vrow]; coef[2] = wend2 * vs[256 + vrow]; coef[3] = wend3 * vs[384 + vrow];
#pragma unroll
      for (int i = 0; i < 8; ++i) { f32x4 cn = cv[i] * decay;
#pragma unroll
          for (int t = 0; t < 4; ++t) { const f32x4 qv = *(const LAS f32x4*)(qs + t * 128 + 32 * dq + 4 * i), kv = *(const LAS f32x4*)(ks + t * 128 + 32 * dq + 4 * i);
              ps[t] += (cv[i].x * qv.x + cv[i].y * qv.y) + (cv[i].z * qv.z + cv[i].w * qv.w); cn += kv * coef[t]; }
          *(f32x4*)(co + 4 * i) = cn; }
#pragma unroll
      for (int t = 0; t < 4; ++t) { ps[t] += __shfl_xor(ps[t], 1); ps[t] += __shfl_xor(ps[t], 2); if (dq == 0) numI[t * 128 + vrow] = ps[t]; } }
    WG_BAR();
    { const int t = tid >> 7, v = tid & 127;
      const float it = gl[12 + t], mtt = gl[16 + t];
      float num = it * numI[tid], den = it * nq[t];
#pragma unroll
      for (int s = 0; s < 4; ++s) { const float sv = Sm[t * 4 + s]; num += sv * vs[s * 128 + v]; den += sv; }
      const float hval = num / fmaxf(fabsf(den), __expf(-mtt));
      const float ssw = wave_sum(hval * hval); if (lane == 0) red[wid] = ssw;
      WG_BAR();
      const float rms = rsqrtf((red[2 * t] + red[2 * t + 1]) * (1.f / 128.f) + EPS);
      const float mo = bf2f(FP_Z[(size_t)(mrow + t) * ZP + ZO + h * 128 + v]);
      FP_HM[(size_t)(mrow + t) * 512 + h * 128 + v] = f2bf(hval * rms * FP_g_mlstm[h * 128 + v] * sigmoidf_(mo));
      if (tid < 128) { const float n0v = FP_state_n[(size_t)u * 128 + tid]; float nn = decay * n0v;
          nn += wend0 * ks[tid] + wend1 * ks[128 + tid] + wend2 * ks[256 + tid] + wend3 * ks[384 + tid];
          FP_out[OFF_NS + (size_t)u * 128 + tid] = nn; }
      if (tid == 0) FP_out[OFF_MS + u] = m_end; }
    WG_BAR();
}
__device__ __forceinline__ void mlstm_scan_item(const Frame& F, int item) {
    const int bh = item >> 5, j = item & 31, e = 512 * j + F.tid; const bool nthr = (j == 0 && F.tid < 128);
    float C = 0.f, m = 0.f, nacc = 0.f;
    const float* Ub = FP_U + (size_t)bh * 128 * 16384 + e; bf16_t* Cp = FP_CPREV + (size_t)bh * 128 * 16384 + e;
    for (int c0 = 0; c0 < 128; c0 += 32) {
        float uu[32], un[32];
#pragma unroll
        for (int i = 0; i < 32; ++i) { uu[i] = Ub[(size_t)(c0 + i) * 16384]; un[i] = nthr ? FP_NU[(size_t)(bh * 128 + c0 + i) * 128 + F.tid] : 0.f; }
#pragma unroll
        for (int i = 0; i < 32; ++i) { const int c = c0 + i; const float fs = FP_ST[2 * (bh * 128 + c)], ml = FP_ST[2 * (bh * 128 + c) + 1];
            Cp[(size_t)c * 16384] = f2bf(C);
            if (nthr) FP_NPREV[(size_t)(bh * 128 + c) * 128 + F.tid] = nacc;
            if (j == 0 && F.tid == 0) FP_MPREV[bh * 128 + c] = m;
            const float mn = fs + fmaxf(m, ml), dec = __expf(fs + m - mn), sc = __expf(fs + ml - mn);
            C = dec * C + sc * uu[i]; nacc = dec * nacc + sc * un[i]; m = mn; }
    }
    FP_out[OFF_CP + (size_t)bh * 16384 + e] = C;
    if (nthr) FP_out[OFF_NP + bh * 128 + F.tid] = nacc;
    if (j == 0 && F.tid == 0) FP_out[OFF_MP + bh] = m;
}
__device__ __forceinline__ void glds16(const void* gsrc, unsigned lds_dst);
__device__ __forceinline__ void mlstm_C_group(const Frame& F, int grp) {
    int tid_ = F.tid; asm volatile("" : "+v"(tid_));
    const int lane = tid_ & 63, wid = F.wave, r32 = lane & 31, hi = lane >> 5, ci = wid >> 1, tt = wid & 1;
    const int u = 4 * grp + ci, bh = u >> 7, c = u & 127, b = bh >> 2, h = bh & 3, m0 = b * TP + c * 64;
    LAS unsigned char* Vt = F.lds + ci * 16384;
    LAS float* Fa = (LAS float*)(F.lds + 65536 + wid * 1024); LAS float* aa = Fa + 64; LAS float* Aa = aa + 64;
    {
        const unsigned lds0 = (unsigned)(uintptr_t)Vt;
#pragma unroll
        for (int k = 0; k < 8; ++k) { const int bb = 8 * tt + k, c4 = bb >> 2, kg = bb & 3;
            glds16(FP_Z + (size_t)(m0 + kg * 16 + (lane >> 2)) * ZP + ZV + h * 128 + c4 * 32 + (lane & 3) * 8, (unsigned)__builtin_amdgcn_readfirstlane(lds0 + bb * 1024)); }
    }
    {
        const float lf = FP_LF[(size_t)(m0 + lane) * 4 + h], ig = FP_IG[(size_t)(m0 + lane) * 4 + h];
        const float Fc = wave_scan_sum(lf, lane), a = ig - Fc, Ac = wave_scan_max(a, lane);
        Fa[lane] = Fc; aa[lane] = a; Aa[lane] = Ac;
    }
    const int t = 32 * tt + r32;
    const float mprev = FP_MPREV[u];
    bf16x8 qf[8];
    { const bf16_t* qp = FP_Z + (size_t)(m0 + t) * ZP + ZQ + h * 128 + 8 * hi;
#pragma unroll
      for (int st = 0; st < 8; ++st) qf[st] = *(const bf16x8*)(qp + 16 * st); }
    const float Ft = Fa[t], At = Aa[t], mxt = fmaxf(mprev, At), mt = Ft + mxt, inter = __expf(mprev - mxt);
    float dq = 0.f;
    { const float* np = FP_NPREV + (size_t)u * 128 + 8 * hi;
#pragma unroll
      for (int st = 0; st < 8; ++st) { const f32x4 n0 = *(const f32x4*)(np + 16 * st), n1 = *(const f32x4*)(np + 16 * st + 4); f32x4 q0, q1; unpack8(__builtin_bit_cast(u32x4, qf[st]), q0, q1);
          dq += (q0.x * n0.x + q0.y * n0.y) + (q0.z * n0.z + q0.w * n0.w) + (q1.x * n1.x + q1.y * n1.y) + (q1.z * n1.z + q1.w * n1.w); } }
    dq += __shfl_xor(dq, 32);
    f32x16 acc[4];
#pragma unroll
    for (int vt = 0; vt < 4; ++vt) { for (int i = 0; i < 16; ++i) acc[vt][i] = 0.f;
        const bf16_t* cp = FP_CPREV + (size_t)u * 16384 + (size_t)(32 * vt + r32) * 128 + 8 * hi;
#pragma unroll
        for (int st = 0; st < 8; ++st) acc[vt] = MFMA32(*(const bf16x8*)(cp + 16 * st), qf[st], acc[vt]);
#pragma unroll
        for (int i = 0; i < 16; ++i) acc[vt][i] *= inter; }
    asm volatile("s_waitcnt vmcnt(0) lgkmcnt(0)\n\ts_barrier" ::: "memory");
    float den = 0.f;
    const int vh = (lane >> 4) & 1, q4 = (lane & 15) >> 2, p = lane & 3;
    const int vlane = (4 * hi + q4) * 64 + (16 * vh + 4 * p) * 2;
    for (int sub = 0; sub <= tt; ++sub) {
        f32x16 sacc; for (int i = 0; i < 16; ++i) sacc[i] = 0.f;
        { const bf16_t* kp = FP_Z + (size_t)(m0 + 32 * sub + r32) * ZP + ZK + h * 128 + 8 * hi;
#pragma unroll
          for (int st = 0; st < 8; ++st) sacc = MFMA32(*(const bf16x8*)(kp + 16 * st), qf[st], sacc); }
#pragma unroll
        for (int g = 0; g < 4; ++g) { const f32x4 av = *(const LAS f32x4*)(aa + 32 * sub + 8 * g + 4 * hi);
#pragma unroll
            for (int k = 0; k < 4; ++k) { const int sidx = 32 * sub + 8 * g + 4 * hi + k; const float wgt = (sidx <= t) ? __expf(av[k] - mxt) : 0.f; const float val = (sidx <= t) ? sacc[4 * g + k] * wgt : 0.f; sacc[4 * g + k] = val; den += val; } }
#pragma unroll
        for (int s2 = 0; s2 < 2; ++s2) {
            const bf16x8 pb = pack8((f32x4){sacc[8 * s2], sacc[8 * s2 + 1], sacc[8 * s2 + 2], sacc[8 * s2 + 3]}, (f32x4){sacc[8 * s2 + 4], sacc[8 * s2 + 5], sacc[8 * s2 + 6], sacc[8 * s2 + 7]});
            const LAS unsigned char* va = Vt + vlane + (2 * sub + s2) * 1024;
#pragma unroll
            for (int vt = 0; vt < 4; ++vt) acc[vt] = MFMA32(cat4(tr_rd(va + vt * 4096), tr_rd(va + vt * 4096 + 512)), pb, acc[vt]);
        }
    }
    den += __shfl_xor(den, 32);
    den += inter * dq;
    const float rden = 1.f / fmaxf(fabsf(den), __expf(-mt));
    float ss = 0.f;
#pragma unroll
    for (int vt = 0; vt < 4; ++vt) for (int i = 0; i < 16; ++i) { acc[vt][i] *= rden; ss += acc[vt][i] * acc[vt][i]; }
    ss += __shfl_xor(ss, 32);
    const float rms = rsqrtf(ss * (1.f / 128.f) + EPS);
#pragma unroll
    for (int vt = 0; vt < 4; ++vt)
#pragma unroll
        for (int g = 0; g < 4; ++g) { const int v = 32 * vt + 8 * g + 4 * hi;
            const f32x4 gv = *(const f32x4*)(FP_g_mlstm + h * 128 + v); const u32x2 mo = *(const u32x2*)(FP_Z + (size_t)(m0 + t) * ZP + ZO + h * 128 + v);
            u32x2 o; o.x = pk2(acc[vt][4 * g] * rms * gv.x * sigmoidf_(bflo(mo.x)), acc[vt][4 * g + 1] * rms * gv.y * sigmoidf_(bfhi(mo.x)));
            o.y = pk2(acc[vt][4 * g + 2] * rms * gv.z * sigmoidf_(bflo(mo.y)), acc[vt][4 * g + 3] * rms * gv.w * sigmoidf_(bfhi(mo.y)));
            *(u32x2*)(FP_HM + (size_t)(m0 + t) * 512 + h * 128 + v) = o; }
    asm volatile("s_waitcnt lgkmcnt(0)\n\ts_barrier" ::: "memory");
}
constexpr int AT_SLOT = 24576, AT_VOFF = 8192, AT_NSLOT = 4;
constexpr float AT_THR = 8.f;
__device__ __forceinline__ void glds16(const void* gsrc, unsigned lds_dst) { unsigned keep;
    asm volatile("s_mov_b32 %0, m0\n\ts_mov_b32 m0, %2\n\ts_nop 0\n\tglobal_load_lds_dwordx4 %1, off\n\ts_mov_b32 m0, %0" : "=&s"(keep) : "v"(gsrc), "s"(lds_dst) : "memory"); }
#define AT_WAIT_BAR(N) asm volatile("s_waitcnt vmcnt(" #N ") lgkmcnt(0)\n\ts_barrier" ::: "memory")
__device__ __forceinline__ void attn_half_unit(const Frame& F, int bh, int qb, int map, float* Odst) {
    int tid_ = F.tid; asm volatile("" : "+v"(tid_));
    const int b = bh >> 2, h = bh & 3, lane = tid_ & 63, wid = F.wave, r32 = lane & 31, hi = lane >> 5;
    const int rowbase = b * TP, q0 = qb * 256, qrow = q0 + 32 * wid + r32;
    const bf16_t* Zb = FP_Z + (size_t)rowbase * ZP;
    const unsigned lds0 = (unsigned)(uintptr_t)F.lds;
    const bf16_t* ksrc = Zb + (size_t)lane * ZP + ZDK + h * 128 + map * 64 + wid * 8;
    const bf16_t* vsrc0 = Zb + (size_t)(((2 * wid) & 3) * 16 + (lane >> 2)) * ZP + ZDV + h * 128 + ((2 * wid) >> 2) * 32 + (lane & 3) * 8;
    const bf16_t* vsrc1 = vsrc0 + (size_t)16 * ZP;
    const unsigned kdst = lds0 + wid * 1024, vdst = lds0 + AT_VOFF + 2 * wid * 1024;
#define AT_DMA(t, slot) do { const size_t adv_ = (size_t)(t) * 64 * ZP; const unsigned so_ = (unsigned)(slot) * AT_SLOT; \
        glds16(ksrc + adv_, (unsigned)__builtin_amdgcn_readfirstlane(kdst + so_)); glds16(vsrc0 + adv_, (unsigned)__builtin_amdgcn_readfirstlane(vdst + so_)); \
        glds16(vsrc1 + adv_, (unsigned)__builtin_amdgcn_readfirstlane(vdst + so_ + 1024u)); } while (0)
    bf16x8 qf[4];
    { const bf16_t* qp = Zb + (size_t)qrow * ZP + ZDQ + h * 128 + map * 64 + 8 * hi;
#pragma unroll
      for (int st = 0; st < 4; ++st) qf[st] = *(const bf16x8*)(qp + 16 * st); }
    const int NT = 4 * qb + 4;
    AT_DMA(0, 0); AT_DMA(1, 1); AT_DMA(2, 2);
    f32x16 o[4];
#pragma unroll
    for (int vt = 0; vt < 4; ++vt) for (int i = 0; i < 16; ++i) o[vt][i] = 0.f;
    f32x16 negm; for (int i = 0; i < 16; ++i) negm[i] = 0.f;
    float mhat = 0.f, lrun = 0.f;
    const int vh = (lane >> 4) & 1, q4 = (lane & 15) >> 2, p = lane & 3;
    const int vlane = AT_VOFF + (4 * hi + q4) * 64 + (16 * vh + 4 * p) * 2;
    const int klane = hi * 1024 + r32 * 16;
    const int wlast = q0 + 32 * wid + 31, wfirst = q0 + 32 * wid;
#define AT_SCHED() __builtin_amdgcn_sched_barrier(0)
#define AT_KRD(i0, kbase) do { kf[i0] = *(const LAS bf16x8*)((kbase) + ((i0) >> 1) * 2048 + ((i0) & 1) * 512); kf[(i0) + 1] = *(const LAS bf16x8*)((kbase) + (((i0) + 1) >> 1) * 2048 + (((i0) + 1) & 1) * 512); } while (0)
#define AT_VRD(dst, g, vbase) do { _Pragma("unroll") for (int vt = 0; vt < 4; ++vt) dst[vt] = cat4(tr_rd((vbase) + (g) * 1024 + vt * 4096), tr_rd((vbase) + (g) * 1024 + vt * 4096 + 512)); } while (0)
#define AT_PB(g) (((g) >> 1) == 0 ? pack8((f32x4){p0[8 * ((g) & 1)], p0[8 * ((g) & 1) + 1], p0[8 * ((g) & 1) + 2], p0[8 * ((g) & 1) + 3]}, (f32x4){p0[8 * ((g) & 1) + 4], p0[8 * ((g) & 1) + 5], p0[8 * ((g) & 1) + 6], p0[8 * ((g) & 1) + 7]}) \
                                  : pack8((f32x4){p1[8 * ((g) & 1)], p1[8 * ((g) & 1) + 1], p1[8 * ((g) & 1) + 2], p1[8 * ((g) & 1) + 3]}, (f32x4){p1[8 * ((g) & 1) + 4], p1[8 * ((g) & 1) + 5], p1[8 * ((g) & 1) + 6], p1[8 * ((g) & 1) + 7]}))
#define AT_PV(src, g) do { const bf16x8 pb_ = AT_PB(g); _Pragma("unroll") for (int vt = 0; vt < 4; ++vt) o[vt] = MFMA32(src[vt], pb_, o[vt]); } while (0)
    AT_WAIT_BAR(3);
    bf16x8 kf[8];
    { const LAS unsigned char* kb = F.lds + klane; AT_KRD(0, kb); AT_KRD(2, kb); AT_KRD(4, kb); AT_KRD(6, kb); }
    int slot = 0, slot1 = 1, slot3 = 3;
    for (int j = 0; j < NT; ++j) {
        if (j + 3 < NT) AT_DMA(j + 3, slot3);
        if (64 * j <= wlast) {
            const LAS unsigned char* vb = F.lds + slot * AT_SLOT + vlane;
            const LAS unsigned char* kn = F.lds + slot1 * AT_SLOT + klane;
            const bool knext = (j + 1 < NT);
            f32x16 p0 = negm, p1 = negm;
#pragma unroll
            for (int st = 0; st < 4; ++st) { p0 = MFMA32(kf[2 * st], qf[st], p0); p1 = MFMA32(kf[2 * st + 1], qf[st], p1); }
            AT_SCHED();
            bf16x8 vfA[4], vfB[4];
            AT_VRD(vfA, 0, vb);
            AT_SCHED();
            if (64 * j + 63 > wfirst) {
#pragma unroll
                for (int i = 0; i < 16; ++i) { const int key = 64 * j + crow(i, hi); if (key > qrow) p0[i] = -INFINITY; if (key + 32 > qrow) p1[i] = -INFINITY; }
            }
            float mx = fmaxf(p0[0], p1[0]);
#pragma unroll
            for (int i = 1; i < 16; ++i) mx = fmaxf(mx, fmaxf(p0[i], p1[i]));
            mx = fmaxf(mx, __shfl_xor(mx, 32));
            if (j == 0 || __any(mx > AT_THR)) {
                const float dl = (j == 0) ? mx : fmaxf(mx, 0.f), f = __builtin_amdgcn_exp2f(-dl);
                mhat += dl; lrun *= f;
#pragma unroll
                for (int i = 0; i < 16; ++i) { p0[i] -= dl; p1[i] -= dl; negm[i] = -mhat; }
#pragma unroll
                for (int vt = 0; vt < 4; ++vt) for (int i = 0; i < 16; ++i) o[vt][i] *= f;
            }
            float rsum = 0.f;
#pragma unroll
            for (int i = 0; i < 16; ++i) { p0[i] = __builtin_amdgcn_exp2f(p0[i]); p1[i] = __builtin_amdgcn_exp2f(p1[i]); rsum += p0[i] + p1[i]; }
            lrun += rsum;
            AT_SCHED();
            AT_VRD(vfB, 1, vb); if (knext) AT_KRD(0, kn); AT_SCHED(); AT_PV(vfA, 0); AT_SCHED();
            AT_VRD(vfA, 2, vb); if (knext) AT_KRD(2, kn); AT_SCHED(); AT_PV(vfB, 1); AT_SCHED();
            AT_VRD(vfB, 3, vb); if (knext) AT_KRD(4, kn); AT_SCHED(); AT_PV(vfA, 2); AT_SCHED();
            if (knext) AT_KRD(6, kn); AT_SCHED(); AT_PV(vfB, 3); AT_SCHED();
        }
        if (j + 3 < NT) AT_WAIT_BAR(3); else AT_WAIT_BAR(0);
        slot = slot1; slot1 = (slot1 == AT_NSLOT - 1) ? 0 : slot1 + 1; slot3 = (slot3 == AT_NSLOT - 1) ? 0 : slot3 + 1;
    }
#undef AT_SCHED
#undef AT_KRD
#undef AT_VRD
#undef AT_PB
#undef AT_PV
    lrun += __shfl_xor(lrun, 32);
    const float rl = 1.f / lrun;
    float* op = Odst + (size_t)(rowbase + qrow) * 512 + h * 128 + 4 * hi;
#pragma unroll
    for (int vt = 0; vt < 4; ++vt)
#pragma unroll
        for (int g = 0; g < 4; ++g) *(f32x4*)(op + 32 * vt + 8 * g) = (f32x4){o[vt][4 * g] * rl, o[vt][4 * g + 1] * rl, o[vt][4 * g + 2] * rl, o[vt][4 * g + 3] * rl};
    AT_WAIT_BAR(0);
#undef AT_DMA
}
__device__ __forceinline__ float lambda_full(const Frame& F, int lane) {
    const float a = wave_sum(FP_lq1[lane] * FP_lk1[lane]), b = wave_sum(FP_lq2[lane] * FP_lk2[lane]);
    return __expf(a) - __expf(b) + LAM_INIT;
}
__device__ __forceinline__ void attn_combine_rows(const Frame& F) {
    const int lane = F.lane, gw = F.vcu * NWAVES + F.wave, NGW = F.G * NWAVES;
    const float lam = lambda_full(F, lane);
    const f32x4 g0 = *(const f32x4*)(FP_g_diff + 8 * lane), g1 = *(const f32x4*)(FP_g_diff + 8 * lane + 4);
    for (int m = gw; m < MP; m += NGW) {
        const float* a = FP_O1 + (size_t)m * 512 + 8 * lane; const float* bb = FP_O2 + (size_t)m * 512 + 8 * lane;
        const f32x4 x0 = *(const f32x4*)a - *(const f32x4*)bb * lam, x1 = *(const f32x4*)(a + 4) - *(const f32x4*)(bb + 4) * lam;
        float ss = (x0.x * x0.x + x0.y * x0.y) + (x0.z * x0.z + x0.w * x0.w) + (x1.x * x1.x + x1.y * x1.y) + (x1.z * x1.z + x1.w * x1.w);
        ss += __shfl_xor(ss, 1); ss += __shfl_xor(ss, 2); ss += __shfl_xor(ss, 4); ss += __shfl_xor(ss, 8);
        const float rms = rsqrtf(ss * (1.f / 128.f) + EPS) * (1.f - LAM_INIT);
        *(bf16x8*)(FP_HD + (size_t)m * 512 + 8 * lane) = pack8(x0 * rms * g0, x1 * rms * g1);
    }
}
constexpr int SB_P = 2064;
__device__ __forceinline__ void decode_unit(const Frame& F, int u, float lam) {
    int tid_ = F.tid; asm volatile("" : "+v"(tid_));
    const int n = u >> 2, h = u & 3, tid = tid_, lane = tid_ & 63, wid = F.wave;
    const int mrow = MP + 4 * n;
    LAS float* Sbuf = (LAS float*)F.lds;
    LAS float* part = Sbuf + 8 * SB_P;
    LAS float* rlv = part + 8192;
    LAS float* red = rlv + 8;
    const int* pt = FP_page_table + n * NPAGES;
    const int c16 = lane & 15, g = lane >> 4;
    bf16x8 bq[4];
#pragma unroll
    for (int st = 0; st < 4; ++st) { const bool ok = (c16 < 4 && st < 2) || (c16 >= 4 && c16 < 8 && st >= 2);
        const bf16x8 v = *(const bf16x8*)(FP_Z + (size_t)(mrow + (c16 & 3)) * ZP + ZDQ + h * 128 + 32 * st + 8 * g);
        const bf16x8 zz = {0, 0, 0, 0, 0, 0, 0, 0}; bq[st] = ok ? v : zz; }
    const int hh = lane >> 5, l5 = lane & 31;
    const char* vpool = (const char*)FP_cache_v; const char* kpool = (const char*)FP_cache_k;
    const unsigned voff = (((unsigned)pt[2 * wid + hh] * PAGE) * 4u + (unsigned)h) * 512u + 16u * (unsigned)l5;
#define NTL(p) __builtin_nontemporal_load((const f32x4*)(p))
#define VLD(row) NTL(vpool + (voff + 2048u * (unsigned)(row)))
    f32x4 va[8], vb[8];
    {
        const unsigned ko0 = (((unsigned)pt[2 * wid] * PAGE + (unsigned)c16) * 4u + (unsigned)h) * 512u + 32u * (unsigned)g;
        const unsigned ko1 = (((unsigned)pt[2 * wid + 1] * PAGE + (unsigned)c16) * 4u + (unsigned)h) * 512u + 32u * (unsigned)g;
        f32x4 ka[16], kb[8];
#define KLOAD(dst, ti) do { const unsigned ko_ = (((ti) < 8) ? ko0 : ko1) + 32768u * (unsigned)((ti) & 7); \
            _Pragma("unroll") for (int st = 0; st < 4; ++st) { dst[2 * st] = NTL(kpool + (ko_ + 128u * st)); dst[2 * st + 1] = NTL(kpool + (ko_ + 128u * st + 16u)); } } while (0)
#define KTILE(src, ti) do { f32x4 acc_ = {0.f, 0.f, 0.f, 0.f}; \
            _Pragma("unroll") for (int st = 0; st < 4; ++st) acc_ = MFMA16(pack8(src[2 * st], src[2 * st + 1]), bq[st], acc_); \
            if (c16 < 8) *(LAS f32x4*)(Sbuf + c16 * SB_P + 256 * wid + 16 * (ti) + 4 * g) = acc_; } while (0)
        KLOAD(ka, 0); KLOAD((ka + 8), 1); KLOAD(kb, 2);
        for (int ip = 0; ip < 12; ip += 3) {
            KTILE(ka, ip); KTILE((ka + 8), ip + 1); KLOAD(ka, ip + 3); KLOAD((ka + 8), ip + 4);
            KTILE(kb, ip + 2); KLOAD(kb, ip + 5);
        }
        KTILE(ka, 12); KTILE((ka + 8), 13); KLOAD(ka, 15);
#pragma unroll
        for (int kk = 0; kk < 8; ++kk) va[kk] = VLD(kk);
        KTILE(kb, 14);
#pragma unroll
        for (int kk = 0; kk < 8; ++kk) vb[kk] = VLD(8 + kk);
        KTILE(ka, 15);
#undef KLOAD
#undef KTILE
        if (wid == 0) {
            f32x4 acc = {0.f, 0.f, 0.f, 0.f};
#pragma unroll
            for (int st = 0; st < 4; ++st) { const bf16x8 v = *(const bf16x8*)(FP_Z + (size_t)(mrow + (c16 & 3)) * ZP + ZDK + h * 128 + 32 * st + 8 * g);
                const bf16x8 zz = {0, 0, 0, 0, 0, 0, 0, 0}; const bf16x8 av = (c16 < 4) ? v : zz; acc = MFMA16(av, bq[st], acc); }
            if (g == 0 && c16 < 8) { const int t = c16 & 3; f32x4 m;
                m.x = acc.x; m.y = (1 <= t) ? acc.y : -INFINITY; m.z = (2 <= t) ? acc.z : -INFINITY; m.w = (3 <= t) ? acc.w : -INFINITY;
                *(LAS f32x4*)(Sbuf + c16 * SB_P + PAST) = m; }
        }
    }
    WG_BAR();
    {
        LAS float* col = Sbuf + wid * SB_P; float mx = -INFINITY;
        for (int k = lane; k < PAST + 4; k += 64) mx = fmaxf(mx, col[k]);
        mx = wave_max(mx); float sm = 0.f;
        for (int k = lane; k < PAST + 4; k += 64) { const float pv = __builtin_amdgcn_exp2f(col[k] - mx); col[k] = pv; sm += pv; }
        sm = wave_sum(sm); if (lane == 0) rlv[wid] = 1.f / sm;
    }
    WG_BAR();
    {
        const LAS float* pbase = Sbuf + 256 * wid + 128 * hh;
        f32x4 acc[8];
#pragma unroll
        for (int c = 0; c < 8; ++c) acc[c] = (f32x4){0.f, 0.f, 0.f, 0.f};
#define VSTEP(buf, t8) do { f32x4 vc_[8]; _Pragma("unroll") for (int kk = 0; kk < 8; ++kk) vc_[kk] = buf[kk]; \
            if ((t8) + 2 < 16) { _Pragma("unroll") for (int kk = 0; kk < 8; ++kk) buf[kk] = VLD(8 * ((t8) + 2) + kk); } \
            _Pragma("unroll") for (int c = 0; c < 8; ++c) { const f32x4 p0_ = *(const LAS f32x4*)(pbase + c * SB_P + 8 * (t8)), p1_ = *(const LAS f32x4*)(pbase + c * SB_P + 8 * (t8) + 4); \
                acc[c] += vc_[0] * p0_.x + vc_[1] * p0_.y + vc_[2] * p0_.z + vc_[3] * p0_.w + vc_[4] * p1_.x + vc_[5] * p1_.y + vc_[6] * p1_.z + vc_[7] * p1_.w; } } while (0)
        for (int t8 = 0; t8 < 16; t8 += 2) { VSTEP(va, t8); VSTEP(vb, t8 + 1); }
#undef VSTEP
        if (wid == 0) {
#pragma unroll
            for (int s = 0; s < 4; ++s) { const u32x2 vv = *(const u32x2*)(FP_Z + (size_t)(mrow + s) * ZP + ZDV + h * 128 + 4 * l5);
                const f32x4 vf = {bflo(vv.x), bfhi(vv.x), bflo(vv.y), bfhi(vv.y)};
#pragma unroll
                for (int c = 0; c < 8; ++c) { const float pp = (hh == 0) ? Sbuf[c * SB_P + PAST + s] : 0.f; acc[c] += vf * pp; } }
        }
#pragma unroll
        for (int c = 0; c < 8; ++c) { acc[c].x += __shfl_xor(acc[c].x, 32); acc[c].y += __shfl_xor(acc[c].y, 32); acc[c].z += __shfl_xor(acc[c].z, 32); acc[c].w += __shfl_xor(acc[c].w, 32);
            if (hh == 0) *(LAS f32x4*)(part + (wid * 8 + c) * 128 + 4 * l5) = acc[c]; }
    }
    WG_BAR();
    { const int t = tid >> 7, v = tid & 127; float o1 = 0.f, o2 = 0.f;
#pragma unroll
      for (int w = 0; w < 8; ++w) { o1 += part[(w * 8 + t) * 128 + v]; o2 += part[(w * 8 + 4 + t) * 128 + v]; }
      const float ov = o1 * rlv[t] - lam * o2 * rlv[4 + t];
      const float ssw = wave_sum(ov * ov); if (lane == 0) red[wid] = ssw;
      WG_BAR();
      const float rms = rsqrtf((red[2 * t] + red[2 * t + 1]) * (1.f / 128.f) + EPS) * (1.f - LAM_INIT);
      FP_HD[(size_t)(mrow + t) * 512 + h * 128 + v] = f2bf(ov * rms * FP_g_diff[h * 128 + v]); }
    WG_BAR();
}
__device__ __forceinline__ void rows_post_mix(const Frame& F) {
    const int lane = F.lane, gw = F.vcu * NWAVES + F.wave, NGW = F.G * NWAVES;
    const int r_lo = (int)(((long)gw * MT) / NGW), r_hi = (int)(((long)(gw + 1) * MT) / NGW);
    f32x4 gpm[4], gpf[4], g1[4], sh2[4], sc2[4], yn[4], xn[4];
#pragma unroll
    for (int j = 0; j < 4; ++j) { gpm[j] = *(const f32x4*)(FP_g_post_mix + 4 * lane + 256 * j); gpf[j] = *(const f32x4*)(FP_g_pre_ffn + 4 * lane + 256 * j); g1[j] = gpm[j]; sh2[j] = gpm[j]; sc2[j] = gpm[j]; yn[j] = gpm[j]; xn[j] = gpm[j]; }
    int ccur = -1;
    if (r_lo < r_hi) { const float* xr = xrow_of(F, r_lo); const bf16_t* yr = FP_Y + (size_t)r_lo * DM;
#pragma unroll
        for (int j = 0; j < 4; ++j) { { const u32x2 yy = *(const u32x2*)(yr + 4 * lane + 256 * j); yn[j] = (f32x4){bflo(yy.x), bfhi(yy.x), bflo(yy.y), bfhi(yy.y)}; } xn[j] = *(const f32x4*)(xr + 4 * lane + 256 * j); } }
    for (int m = r_lo; m < r_hi; ++m) {
        f32x4 y[4], x1[4]; float ss = 0.f;
#pragma unroll
        for (int j = 0; j < 4; ++j) { y[j] = yn[j]; x1[j] = xn[j]; }
        if (m + 1 < r_hi) { const float* xr = xrow_of(F, m + 1); const bf16_t* yr = FP_Y + (size_t)(m + 1) * DM;
#pragma unroll
            for (int j = 0; j < 4; ++j) { { const u32x2 yy = *(const u32x2*)(yr + 4 * lane + 256 * j); yn[j] = (f32x4){bflo(yy.x), bfhi(yy.x), bflo(yy.y), bfhi(yy.y)}; } xn[j] = *(const f32x4*)(xr + 4 * lane + 256 * j); } }
        const int cr = crow_of(m);
        if (cr != ccur) { ccur = cr; const float* ada = FP_ADA + (size_t)cr * 6144;
#pragma unroll
            for (int j = 0; j < 4; ++j) { const int c = 4 * lane + 256 * j; g1[j] = *(const f32x4*)(ada + 2048 + c) * gpm[j]; sh2[j] = *(const f32x4*)(ada + 3072 + c); sc2[j] = (*(const f32x4*)(ada + 4096 + c) + 1.f) * gpf[j]; } }
#pragma unroll
        for (int j = 0; j < 4; ++j) ss += (y[j].x * y[j].x + y[j].y * y[j].y) + (y[j].z * y[j].z + y[j].w * y[j].w);
        const float rs = rsqrtf(wave_sum(ss) * (1.f / DM) + EPS); float s1 = 0.f;
#pragma unroll
        for (int j = 0; j < 4; ++j) { const int c = 4 * lane + 256 * j;
            x1[j] = x1[j] + g1[j] * (y[j] * rs); *(f32x4*)(FP_out + OFF_Y + (size_t)m * DM + c) = x1[j];
            s1 += (x1[j].x * x1[j].x + x1[j].y * x1[j].y) + (x1[j].z * x1[j].z + x1[j].w * x1[j].w); }
        const float r1 = rsqrtf(wave_sum(s1) * (1.f / DM) + EPS);
#pragma unroll
        for (int j = 0; j < 4; ++j) { const int c = 4 * lane + 256 * j;
            const f32x4 hv = (x1[j] * r1) * sc2[j] + sh2[j]; u32x2 o; o.x = pk2(hv.x, hv.y); o.y = pk2(hv.z, hv.w); *(u32x2*)(FP_H1 + (size_t)m * DM + c) = o; }
    }
}
__device__ __forceinline__ void rows_final(const Frame& F) {
    const int lane = F.lane, gw = F.vcu * NWAVES + F.wave, NGW = F.G * NWAVES;
    const int r_lo = (int)(((long)gw * MT) / NGW), r_hi = (int)(((long)(gw + 1) * MT) / NGW);
    f32x4 gpf[4], g2[4], yn[4], xn[4];
#pragma unroll
    for (int j = 0; j < 4; ++j) { gpf[j] = *(const f32x4*)(FP_g_post_ffn + 4 * lane + 256 * j); g2[j] = gpf[j]; yn[j] = gpf[j]; xn[j] = gpf[j]; }
    int ccur = -1;
    if (r_lo < r_hi) { const float* xr = FP_out + OFF_Y + (size_t)r_lo * DM; const bf16_t* yr = FP_Y + (size_t)r_lo * DM;
#pragma unroll
        for (int j = 0; j < 4; ++j) { { const u32x2 yy = *(const u32x2*)(yr + 4 * lane + 256 * j); yn[j] = (f32x4){bflo(yy.x), bfhi(yy.x), bflo(yy.y), bfhi(yy.y)}; } xn[j] = *(const f32x4*)(xr + 4 * lane + 256 * j); } }
    for (int m = r_lo; m < r_hi; ++m) {
        f32x4 y[4], x1[4]; float ss = 0.f;
#pragma unroll
        for (int j = 0; j < 4; ++j) { y[j] = yn[j]; x1[j] = xn[j]; }
        if (m + 1 < r_hi) { const float* xr = FP_out + OFF_Y + (size_t)(m + 1) * DM; const bf16_t* yr = FP_Y + (size_t)(m + 1) * DM;
#pragma unroll
            for (int j = 0; j < 4; ++j) { { const u32x2 yy = *(const u32x2*)(yr + 4 * lane + 256 * j); yn[j] = (f32x4){bflo(yy.x), bfhi(yy.x), bflo(yy.y), bfhi(yy.y)}; } xn[j] = *(const f32x4*)(xr + 4 * lane + 256 * j); } }
        const int cr = crow_of(m);
        if (cr != ccur) { ccur = cr; const float* ada = FP_ADA + (size_t)cr * 6144;
#pragma unroll
            for (int j = 0; j < 4; ++j) g2[j] = *(const f32x4*)(ada + 5120 + 4 * lane + 256 * j) * gpf[j]; }
#pragma unroll
        for (int j = 0; j < 4; ++j) ss += (y[j].x * y[j].x + y[j].y * y[j].y) + (y[j].z * y[j].z + y[j].w * y[j].w);
        const float rs = rsqrtf(wave_sum(ss) * (1.f / DM) + EPS);
#pragma unroll
        for (int j = 0; j < 4; ++j) *(f32x4*)(FP_out + OFF_Y + (size_t)m * DM + 4 * lane + 256 * j) = x1[j] + g2[j] * (y[j] * rs);
    }
}
__device__ __forceinline__ float gelu_tanh(float x) { const float u = 1.5957691216057308f * (x + 0.044715f * x * x * x); return x * __builtin_amdgcn_rcpf(1.f + __builtin_amdgcn_exp2f(-u * LOG2E)); }
__device__ __forceinline__ void geglu_hist(const Frame& F, int m, int f0, f32x4& p10, f32x4& p11, f32x4& p20, f32x4& p21) {
    const f32x4 z4 = {0.f, 0.f, 0.f, 0.f};
    if (m < MP) { const int t = m & (TP - 1);
        if (t >= 1) unpack8(*(const u32x4*)(FP_UA + (size_t)(m - 1) * DFF + f0), p10, p11); else { p10 = z4; p11 = z4; }
        if (t >= 2) unpack8(*(const u32x4*)(FP_UA + (size_t)(m - 2) * DFF + f0), p20, p21); else { p20 = z4; p21 = z4; }
    } else { const int t = (m - MP) & 3, n = (m - MP) >> 2; const float* st = FP_state_conv + (size_t)n * 2 * DFF + f0;
        if (t >= 1) unpack8(*(const u32x4*)(FP_UA + (size_t)(m - 1) * DFF + f0), p10, p11); else { p10 = *(const f32x4*)(st + DFF); p11 = *(const f32x4*)(st + DFF + 4); }
        if (t >= 2) unpack8(*(const u32x4*)(FP_UA + (size_t)(m - 2) * DFF + f0), p20, p21);
        else if (t == 1) { p20 = *(const f32x4*)(st + DFF); p21 = *(const f32x4*)(st + DFF + 4); } else { p20 = *(const f32x4*)st; p21 = *(const f32x4*)(st + 4); } }
}
__device__ __forceinline__ void geglu_phase(const Frame& F) {
    constexpr int RB = 66, NBLK = MT / RB;
    if (F.tid >= 352) return;
    const int f0 = 8 * F.tid;
    const f32x4 w00 = *(const f32x4*)(FP_conv_w + f0), w01 = *(const f32x4*)(FP_conv_w + f0 + 4), w10 = *(const f32x4*)(FP_conv_w + DFF + f0), w11 = *(const f32x4*)(FP_conv_w + DFF + f0 + 4),
                w20 = *(const f32x4*)(FP_conv_w + 2 * DFF + f0), w21 = *(const f32x4*)(FP_conv_w + 2 * DFF + f0 + 4), cb0 = *(const f32x4*)(FP_conv_b + f0), cb1 = *(const f32x4*)(FP_conv_b + f0 + 4);
    for (int blk = F.vcu; blk < NBLK; blk += F.G) {
        const int m0 = blk * RB;
        f32x4 p10, p11, p20, p21;
        geglu_hist(F, m0, f0, p10, p11, p20, p21);
        u32x4 qa[4], qb[4];
#pragma unroll
        for (int i = 0; i < 4; ++i) { qa[i] = *(const u32x4*)(FP_UA + (size_t)(m0 + i) * DFF + f0); qb[i] = *(const u32x4*)(FP_UB + (size_t)(m0 + i) * DFF + f0); }
        for (int r0 = 0; r0 < RB; r0 += 4) {
#pragma unroll
            for (int i = 0; i < 4; ++i) {
                const int r = r0 + i;
                if (r < RB) {
                    const int m = m0 + r;
                    f32x4 a0, a1, b0, b1; unpack8(qa[i], a0, a1); unpack8(qb[i], b0, b1);
                    if (r + 4 < RB) { qa[i] = *(const u32x4*)(FP_UA + (size_t)(m + 4) * DFF + f0); qb[i] = *(const u32x4*)(FP_UB + (size_t)(m + 4) * DFF + f0); }
                    const bool seq_start = (m < MP) ? ((m & (TP - 1)) == 0) : (((m - MP) & 3) == 0);
                    if (seq_start && r != 0) geglu_hist(F, m, f0, p10, p11, p20, p21);
                    f32x4 c0 = cb0 + w00 * p20 + w10 * p10 + w20 * a0, c1 = cb1 + w01 * p21 + w11 * p11 + w21 * a1;
                    c0.x = gelu_tanh(c0.x) * b0.x; c0.y = gelu_tanh(c0.y) * b0.y; c0.z = gelu_tanh(c0.z) * b0.z; c0.w = gelu_tanh(c0.w) * b0.w;
                    c1.x = gelu_tanh(c1.x) * b1.x; c1.y = gelu_tanh(c1.y) * b1.y; c1.z = gelu_tanh(c1.z) * b1.z; c1.w = gelu_tanh(c1.w) * b1.w;
                    *(bf16x8*)(FP_GB + (size_t)m * DFF + f0) = pack8(c0, c1);
                    p20 = p10; p21 = p11; p10 = a0; p11 = a1;
                }
            }
        }
    }
}

__device__ __forceinline__ void attention_phase(const Frame& F, volatile LAS unsigned* MISC) {
    unsigned* ctl = (unsigned*)(F.a->ws + WS_CTL) + CW_SCHED;
    const int xq = (F.vcu * 8) / F.G;
    const float lam = lambda_full(F, F.lane);
    for (;;) {
        if (F.tid == 0) {
            int kind = -1; unsigned idx = 0u;
            unsigned* QD = ctl + 64 * 8; unsigned* NS = ctl + 64 * (9 + xq);
            if (xb_ld(QD) < 512u) { const unsigned sn = xb_add(NS, 1u);
                if (sn < (unsigned)DEC_LIM8) { const unsigned d = xb_add(QD, 1u); if (d < 512u) { kind = 1; idx = d; } }
                if (kind < 0) (void)__hip_atomic_fetch_sub(NS, 1u, __ATOMIC_RELAXED, __HIP_MEMORY_SCOPE_AGENT); }
            for (int k = 0; k < 8 && kind < 0; ++k) { const int x = (xq + k) & 7; unsigned* QP = ctl + 64 * x;
                if (xb_ld(QP) < 64u) { const unsigned p = xb_add(QP, 1u); if (p < 64u) { kind = 0; idx = (unsigned)x * 64u + p; } } }
            if (kind < 0) { const unsigned d = xb_add(QD, 1u); if (d < 512u) { kind = 2; idx = d; } }
            MISC[0] = (unsigned)kind; MISC[1] = idx;
        }
        WG_BAR();
        const int kind = (int)MISC[0]; const int idx = (int)MISC[1];
        WG_BAR();
        if (kind < 0) break;
        if (kind == 0) { const int bh = idx >> 6, j = idx & 63, qb = 31 - (j >> 1), map = j & 1; attn_half_unit(F, bh, qb, map, map ? FP_O2 : FP_O1); }
        else { decode_unit(F, idx, lam);
               if (kind == 1 && F.tid == 0) (void)__hip_atomic_fetch_sub(ctl + 64 * (9 + xq), 1u, __ATOMIC_RELAXED, __HIP_MEMORY_SCOPE_AGENT); }
    }
}

constexpr int NPHASE = 15;
#ifndef DUPMASK
#define DUPMASK 0
#endif
__global__ void __launch_bounds__(NTHR, 2) fwd_kernel(Args args) {
    extern __shared__ __attribute__((aligned(16))) unsigned char lds_raw[];
    Frame F;
    F.lds = (LAS unsigned char*)lds_raw;
    F.tid = threadIdx.x; F.lane = F.tid & 63; F.wave = __builtin_amdgcn_readfirstlane(F.tid >> 6);
    F.G = gridDim.x; { const int bx = blockIdx.x; F.vcu = (F.G % 8 == 0) ? (bx % 8) * (F.G / 8) + bx / 8 : bx; }
    F.a = &args; unsigned char* ws = args.ws;
    volatile LAS unsigned* MISC = (volatile LAS unsigned*)(F.lds + MISC_OFF);
    for (int u = F.tid; u < (LDS_BYTES - RING_BYTES) / 4; u += NTHR) ((LAS unsigned*)(F.lds + RING_BYTES))[u] = 0u;
    __syncthreads();
    const int lo = args.ph_lo, hi = args.ph_hi;
    const bool multi = (hi - lo) > 1;
    XcdBarrier bar; bar.bar = (unsigned*)(ws + WS_CTL) + CW_BAR; bar.x = 0; bar.st = nullptr;
    if (multi) bar = xcd_barrier_post((unsigned*)(ws + WS_CTL) + CW_BAR, MISC + 8);
#define IN(k) (lo <= (k) && (k) < hi)
#define SEAM(k) do { if (IN(k) && IN((k) + 1)) xcd_barrier(bar); } while (0)

#define DUP(k, ...) do { { __VA_ARGS__ } if ((DUPMASK >> (k)) & 1) { __VA_ARGS__ } } while (0)
    if (IN(0)) { DUP(0,  p0_ada(F); p0_transposes(F); ); } SEAM(0);
    if (IN(1)) { DUP(1,  p1_norm_gates(F); WG_BAR(); ); } SEAM(1);
    if (IN(2)) { DUP(2,  pg8::Gemm g{FP_H1, FP_WinT, MT, ZP, DM}; pg8::StaticOrder S; S.init(MT, ZP, F.G, (int)blockIdx.x); EpiZ E{FP_Z, FP_out}; pg8::gemm_phase(F.lds, g, S, E); ); } SEAM(2);
    if (IN(3)) { DUP(3,  for (int i = 0; i < 4; ++i) { const int u = F.vcu * 4 + i; if (u < 1024) mlstm_A_unit(F, u); }
                 if (F.G != 256) for (int u = 4 * F.G + F.vcu; u < 1024; u += F.G) mlstm_A_unit(F, u);
                 for (int u = F.vcu; u < 512; u += F.G) smlstm_unit(F, u); ); } SEAM(3);
    if (IN(4)) { DUP(4,  for (int it = F.vcu; it < 256; it += F.G) mlstm_scan_item(F, it); ); } SEAM(4);
    if (IN(5)) { attention_phase(F, MISC); } SEAM(5);
    if (IN(6)) { DUP(6,  for (int grp = F.vcu; grp < 256; grp += F.G) mlstm_C_group(F, grp);
                 attn_combine_rows(F); ); } SEAM(6);
    if (IN(7)) { DUP(7,  pg8::Gemm g{FP_HM, FP_WpmT, MP, DM, 512}; pg8::StaticOrder S; S.init(MP, DM, F.G, (int)blockIdx.x); EpiPM E{FP_Z, FP_MG}; pg8::gemm_phase(F.lds, g, S, E);
                 skinny_gemm(F, FP_HM + (size_t)MP * 512, FP_WpmT, 512, E); ); } SEAM(7);
    if (IN(8)) { pg8::Gemm g{FP_HD, FP_WpdT, MP, DM, 512}; pg8::StaticOrder S; S.init(MP, DM, F.G, (int)blockIdx.x); EpiPD E{FP_Z, FP_MG}; pg8::gemm_phase(F.lds, g, S, E);
                 skinny_gemm(F, FP_HD + (size_t)MP * 512, FP_WpdT, 512, E); } SEAM(8);
    if (IN(9)) { DUP(9,  pg8::Gemm g{FP_MG, FP_WoutT, MP, DM, DM}; pg8::StaticOrder S; S.init(MP, DM, F.G, (int)blockIdx.x); EpiF32 E{FP_Y}; pg8::gemm_phase(F.lds, g, S, E);
                 skinny_gemm(F, FP_MG + (size_t)MP * DM, FP_WoutT, DM, E); ); } SEAM(9);
    if (IN(10)) { DUP(10,  rows_post_mix(F); ); } SEAM(10);
    if (IN(11)) { DUP(11,  pg8::Gemm g{FP_H1, FP_WupT, MT, 2 * DFF, DM}; pg8::StaticOrder S; S.init(MT, 2 * DFF, F.G, (int)blockIdx.x); EpiUp E{FP_UA, FP_UB, FP_out}; pg8::gemm_phase(F.lds, g, S, E); ); } SEAM(11);
    if (IN(12)) { DUP(12,  geglu_phase(F); ); } SEAM(12);
    if (IN(13)) { DUP(13,  pg8::Gemm g{FP_GB, FP_WdownT, MP, DM, DFF}; pg8::StaticOrder S; S.init(MP, DM, F.G, (int)blockIdx.x); EpiF32 E{FP_Y}; pg8::gemm_phase(F.lds, g, S, E);
                  skinny_gemm(F, FP_GB + (size_t)MP * DFF, FP_WdownT, DFF, E); ); } SEAM(13);
    if (IN(14)) { rows_final(F); }
#undef DUP
#undef IN
#undef SEAM
}

#ifndef MK_ONE_LAUNCH
#define MK_ONE_LAUNCH 1
#endif
extern "C" void kernel_launch(void* const* d_in, const int* in_sizes, int n_in, void* d_out, int out_size, void* d_ws, size_t ws_size, hipStream_t stream) {
    static int grid = 0;
    if (grid == 0) {
        if (n_in != 32 || out_size != (int)OUT_TOTAL || ws_size < WS_END) { fprintf(stderr, "kernel_launch: unexpected sizes n_in %d out %d ws %zu\n", n_in, out_size, ws_size); grid = -1; return; }
        int dev = 0, cus = 0, per_cu = 0;
        if (hipGetDevice(&dev) != hipSuccess || hipDeviceGetAttribute(&cus, hipDeviceAttributeMultiprocessorCount, dev) != hipSuccess) { grid = -1; return; }
        if (hipFuncSetAttribute((const void*)fwd_kernel, hipFuncAttributeMaxDynamicSharedMemorySize, LDS_BYTES) != hipSuccess) { fprintf(stderr, "kernel_launch: hipFuncSetAttribute failed\n"); grid = -1; return; }
        if (hipOccupancyMaxActiveBlocksPerMultiprocessor(&per_cu, (const void*)fwd_kernel, NTHR, LDS_BYTES) != hipSuccess || per_cu < 1) fprintf(stderr, "kernel_launch: occupancy query reports %d\n", per_cu);
        (void)hipGetLastError();
        grid = cus;
    }
    if (grid < 0) return;
    if (hipMemsetAsync((char*)d_ws + WS_CTL, 0, CTL_ZERO_BYTES, stream) != hipSuccess) return;
    Args a{};
    for (int i = 0; i < 32; ++i) a.in[i] = d_in[i];
    a.out = (float*)d_out; a.ws = (unsigned char*)d_ws;
#if MK_ONE_LAUNCH
    a.ph_lo = 0; a.ph_hi = NPHASE;
    hipLaunchKernelGGL(fwd_kernel, dim3(grid), dim3(NTHR), LDS_BYTES, stream, a);
#else
    for (int p = 0; p < NPHASE; ++p) { a.ph_lo = p; a.ph_hi = p + 1; hipLaunchKernelGGL(fwd_kernel, dim3(grid), dim3(NTHR), LDS_BYTES, stream, a); }
#endif
}
```

```cpp
#include <hip/hip_runtime.h>
#include <cstdio>
#include <cstdint>

#define LAS __attribute__((address_space(3)))
#define GAS __attribute__((address_space(1)))
typedef unsigned short bf16_t;
typedef short bf16x8 __attribute__((ext_vector_type(8)));
typedef short s16x4 __attribute__((ext_vector_type(4)));
typedef short v4i16_t __attribute__((ext_vector_type(4)));
typedef float f32x2 __attribute__((ext_vector_type(2)));
typedef float f32x4 __attribute__((ext_vector_type(4)));
typedef float f32x16 __attribute__((ext_vector_type(16)));
typedef unsigned u32x2 __attribute__((ext_vector_type(2)));
typedef unsigned u32x4 __attribute__((ext_vector_type(4)));
typedef __bf16 bf16x2_t __attribute__((ext_vector_type(2)));
typedef GAS unsigned gu32;

constexpr int DM = 1024, TP = 8192, MP = 16384, MS = 512, MT = MP + MS;
constexpr int NSEQ = 128, TS = 4, NPAGES = 16, PAGE = 128, PAST = 2048;
constexpr int DIN = 5640, ZP = 5632, ZN = 5888, DFF = 2816;
constexpr int ZQ = 0, ZK = 512, ZV = 1024, ZO = 1536, ZDQ = 2048, ZDK = 2560, ZDV = 3072, ZGM = 3584, ZGD = 4608;
constexpr float EPS = 1e-6f, LAM_INIT = 0.2f, LOG2E = 1.4426950408889634f;
constexpr float QSCALE = 0.125f * LOG2E;
constexpr float KSCALE = 0.08838834764831845f;
constexpr size_t OFF_Y = 0, OFF_KP = 17301504, OFF_VP = 25690112, OFF_CP = 34078720, OFF_NP = 34209792, OFF_MP = 34210816, OFF_CVP = 34210824,
                 OFF_KS = 34222088, OFF_VS = 34484232, OFF_CS = 34746376, OFF_NS = 43134984, OFF_MS = 43200520, OFF_CVS = 43201032, OUT_TOTAL = 43921928;
constexpr size_t MiB = 1u << 20;
constexpr size_t WS_CTL = 0, CTL_ZERO_BYTES = 65536;
constexpr size_t WS_WIN = 639 * MiB  , WS_WUP = 12 * MiB, WS_WDOWN = 23 * MiB, WS_WOUT = 29 * MiB, WS_WPM = 31 * MiB, WS_WPD = 32 * MiB;
constexpr size_t WS_ADA = 33 * MiB, WS_IG = 37 * MiB, WS_LF = 37 * MiB + 512 * 1024, WS_ST = 38 * MiB, WS_NU = 38 * MiB + 65536, WS_NPREV = 39 * MiB, WS_MPREV = 39 * MiB + 768 * 1024;
constexpr size_t WS_H1 = 40 * MiB, WS_Z = 73 * MiB, WS_U = 255 * MiB, WS_CPREV = 319 * MiB, WS_HM = 351 * MiB, WS_HD = 368 * MiB, WS_O1 = 385 * MiB, WS_O2 = 417 * MiB;
constexpr size_t WS_MG = 449 * MiB, WS_Y = 482 * MiB, WS_UA = 548 * MiB, WS_UB = 639 * MiB, WS_G = 730 * MiB, WS_DPART = 821 * MiB, WS_END = 838 * MiB;
constexpr int CW_BAR = 4096, CW_SCHED = 8192;
#ifndef DEC_LIM8
#define DEC_LIM8 10
#endif
constexpr int RING_BYTES = 131072, MISC_OFF = RING_BYTES + 320, LDS_BYTES = 147456;
constexpr int NWAVES = 8, NTHR = 512;

__device__ __forceinline__ unsigned pk2(float lo, float hi) { f32x2 v = {lo, hi}; bf16x2_t b = __builtin_convertvector(v, bf16x2_t); return __builtin_bit_cast(unsigned, b); }
__device__ __forceinline__ bf16_t f2bf(float x) { return (bf16_t)(pk2(x, 0.f) & 0xffffu); }
__device__ __forceinline__ float bflo(unsigned u) { return __uint_as_float(u << 16); }
__device__ __forceinline__ float bfhi(unsigned u) { return __uint_as_float(u & 0xffff0000u); }
__device__ __forceinline__ float bf2f(bf16_t u) { return __uint_as_float(((unsigned)u) << 16); }
__device__ __forceinline__ bf16x8 pack8(f32x4 a, f32x4 b) { u32x4 w; w.x = pk2(a.x, a.y); w.y = pk2(a.z, a.w); w.z = pk2(b.x, b.y); w.w = pk2(b.z, b.w); return __builtin_bit_cast(bf16x8, w); }
__device__ __forceinline__ void unpack8(u32x4 w, f32x4& a, f32x4& b) { a.x = bflo(w.x); a.y = bfhi(w.x); a.z = bflo(w.y); a.w = bfhi(w.y); b.x = bflo(w.z); b.y = bfhi(w.z); b.z = bflo(w.w); b.w = bfhi(w.w); }
__device__ __forceinline__ float wave_sum(float v) {
#pragma unroll
    for (int o = 1; o < 64; o <<= 1) v += __shfl_xor(v, o);
    return v;
}
__device__ __forceinline__ float wave_max(float v) {
#pragma unroll
    for (int o = 1; o < 64; o <<= 1) v = fmaxf(v, __shfl_xor(v, o));
    return v;
}
__device__ __forceinline__ float wave_scan_sum(float v, int lane) {
#pragma unroll
    for (int o = 1; o < 64; o <<= 1) { const float t = __shfl_up(v, o); if (lane >= o) v += t; }
    return v;
}
__device__ __forceinline__ float wave_scan_max(float v, int lane) {
#pragma unroll
    for (int o = 1; o < 64; o <<= 1) { const float t = __shfl_up(v, o); if (lane >= o) v = fmaxf(v, t); }
    return v;
}
__device__ __forceinline__ float sigmoidf_(float x) { return __builtin_amdgcn_rcpf(1.f + __builtin_amdgcn_exp2f(-x * LOG2E)); }
__device__ __forceinline__ float log_sigmoid(float x) { return fminf(x, 0.f) - log1pf(__expf(-fabsf(x))); }
__device__ __forceinline__ int crow(int reg, int h) { return (reg & 3) + 8 * (reg >> 2) + 4 * h; }
#define MFMA32(a, b, c) __builtin_amdgcn_mfma_f32_32x32x16_bf16((a), (b), (c), 0, 0, 0)
#define MFMA16(a, b, c) __builtin_amdgcn_mfma_f32_16x16x32_bf16((a), (b), (c), 0, 0, 0)
__device__ __forceinline__ s16x4 tr_rd(const LAS unsigned char* p) { return __builtin_bit_cast(s16x4, __builtin_amdgcn_ds_read_tr16_b64_v4i16((LAS v4i16_t*)p)); }
__device__ __forceinline__ bf16x8 cat4(s16x4 lo, s16x4 hi) { return (bf16x8){lo[0], lo[1], lo[2], lo[3], hi[0], hi[1], hi[2], hi[3]}; }
#define WG_BAR() __syncthreads()
__device__ __forceinline__ int lane_id() { int l; asm volatile("v_mbcnt_lo_u32_b32 %0, -1, 0\n\tv_mbcnt_hi_u32_b32 %0, -1, %0" : "=v"(l)); return l; }
#define FTID(F) ((F).wave * 64 + lane_id())

namespace pg8 {
constexpr int BM = 256, BK = 64, HALF = 128, HTB = HALF * BK * 2, STAGE_BYTES = 8 * HTB, NXCD = 8, WGM = 8;
__host__ __device__ __forceinline__ int lds_byte(int r, int c) { const int st = (r >> 4) * 2 + (c >> 5), rr = r & 15, cc = c & 31, ob = rr * 64 + cc * 2; return st * 1024 + (ob ^ (((ob >> 9) & 1) << 5)); }
__host__ __device__ __forceinline__ void stage_rc(int b, int& R, int& C) { const int st = b / 1024, sb = b % 1024, swz = sb ^ (((sb >> 9) & 1) << 5); R = (st >> 1) * 16 + swz / 64; C = (st & 1) * 32 + (swz % 64) / 2; }
__host__ __device__ __forceinline__ int perm32(int rho) { const int n = rho >> 4, i = rho & 15; return 8 * (i >> 2) + 4 * n + (i & 3); }
struct Unit { int pm, pn, half; };
struct Gemm { const bf16_t* A; const bf16_t* Bt; int M, N, K, ld; };
struct StaticOrder {
    int nM, nN, nwg, G, c;
    __host__ __device__ __forceinline__ void init(int M, int N, int G_, int c_) { nM = M / BM; nN = N / BM; nwg = nM * nN; G = G_; c = c_; }
    __host__ __device__ __forceinline__ bool next(int i, Unit& u) const {
        const long L = (long)i * G + c; if (L >= nwg) return false;
        int wgid = (int)L; { const int q = nwg / NXCD, r = nwg % NXCD, xcd = wgid % NXCD, off = wgid / NXCD; wgid = (xcd < r ? xcd * (q + 1) : r * (q + 1) + (xcd - r) * q) + off; }
        const int nig = WGM * nN, gid = wgid / nig, fm = gid * WGM, gsz = (nM - fm) < WGM ? (nM - fm) : WGM;
        u.pm = fm + ((wgid % nig) % gsz); u.pn = (wgid % nig) / gsz; u.half = 0; return true;
    }
};
template <class Epi, bool SPLIT2 = false>
__device__ __forceinline__ void gemm_phase(LAS unsigned char* lds, const Gemm g, const StaticOrder& S, const Epi& E, int wave) {
    const int wid = wave, lane = lane_id(), tid = wid * 64 + lane, wr = wid >> 2, wc = wid & 3, fr = lane & 15, fq = lane >> 4;
    const int K = g.K, nt = K / BK, LD = g.ld;
    unsigned voffA[2], voffB[2];
#pragma unroll
    for (int i = 0; i < 2; ++i) { int R, C; stage_rc(tid * 16 + i * 8192, R, C); const int Rb = (R & ~31) + perm32(R & 31);
        voffA[i] = (unsigned)(R * LD + C) * 2u; voffB[i] = (unsigned)(Rb * LD + C) * 2u; }
    const size_t kstep = (size_t)(BK * 2);
    const size_t hstep = (size_t)HALF * LD * 2;
    const size_t tstep = 2 * hstep;
    const unsigned ldsw = (unsigned)wid * 1024u;
    const int aoff = lds_byte(wr * 64 + fr, fq * 8), boff = lds_byte(wc * 32 + fr, fq * 8);
#define PG8_SA(b, h) (((b) * 2 + (h)) * HTB)
#define PG8_SB(b, h) ((4 + (b) * 2 + (h)) * HTB)
#define PG8_STAGE(bufoff, gbase, voff) do { _Pragma("unroll") for (int _i = 0; _i < 2; ++_i) \
        __builtin_amdgcn_global_load_lds((const unsigned*)((const char*)(gbase) + (voff)[_i]), (LAS unsigned*)(lds + (bufoff) + ldsw + _i * 8192), 16, 0, 0); } while (0)
#define PG8_LDA(dst, b, h) do { _Pragma("unroll") for (int m = 0; m < 4; ++m) _Pragma("unroll") for (int k = 0; k < 2; ++k) dst[m][k] = *(const LAS bf16x8*)(lds + PG8_SA(b, h) + aoff + m * 2048 + k * 1024); } while (0)
#define PG8_LDB(dst, b, h) do { _Pragma("unroll") for (int n = 0; n < 2; ++n) _Pragma("unroll") for (int k = 0; k < 2; ++k) dst[n][k] = *(const LAS bf16x8*)(lds + PG8_SB(b, h) + boff + n * 2048 + k * 1024); } while (0)
#define PG8_MMA(ai, bj, At, Bt) do { __builtin_amdgcn_s_setprio(1); _Pragma("unroll") for (int m = 0; m < 4; ++m) _Pragma("unroll") for (int n = 0; n < 2; ++n) _Pragma("unroll") for (int k = 0; k < 2; ++k) \
        acc[ai][bj][m][n] = __builtin_amdgcn_mfma_f32_16x16x32_bf16(Bt[n][k], At[m][k], acc[ai][bj][m][n], 0, 0, 0); __builtin_amdgcn_s_setprio(0); } while (0)
#define PG8_WAIT_V(n) asm volatile("s_waitcnt vmcnt(" #n ")" ::: "memory")
#define PG8_WAIT_L(n) asm volatile("s_waitcnt lgkmcnt(" #n ")" ::: "memory")
#define PG8_BAR __builtin_amdgcn_s_barrier()
#define PG8_SCHED __builtin_amdgcn_sched_barrier(0)
#define PG8_NEXT(i, u) (SPLIT2 ? (S.next((i) >> 1, u) ? ((u).half = (i) & 1, true) : false) : S.next((i), u))
#define PG8_UA(u) ((const char*)g.A + (size_t)(u).pm * tstep + (size_t)(u).half * K * 2)
#define PG8_UB(u) ((const char*)g.Bt + (size_t)(u).pn * tstep + (size_t)(u).half * K * 2)
    Unit cur, nxt; int ui = 0;
    if (!PG8_NEXT(0, cur)) return;
    f32x4 acc[2][2][4][2];
#pragma unroll
    for (int a = 0; a < 2; ++a)
#pragma unroll
        for (int b = 0; b < 2; ++b)
#pragma unroll
            for (int m = 0; m < 4; ++m)
#pragma unroll
                for (int n = 0; n < 2; ++n) acc[a][b][m][n] = (f32x4){0.f, 0.f, 0.f, 0.f};
    bf16x8 At[4][2], B0[2][2], B1[2][2];
    const char* cA = PG8_UA(cur); const char* cB = PG8_UB(cur);
    PG8_STAGE(PG8_SB(0, 0), cB, voffB); PG8_STAGE(PG8_SB(0, 1), cB + hstep, voffB); PG8_STAGE(PG8_SA(0, 0), cA, voffA); PG8_STAGE(PG8_SA(0, 1), cA + hstep, voffA);
    if (wr == 1) PG8_BAR;
    PG8_WAIT_V(2); PG8_BAR;
    PG8_STAGE(PG8_SB(1, 0), cB + kstep, voffB); PG8_STAGE(PG8_SA(1, 0), cA + kstep, voffA); PG8_STAGE(PG8_SB(1, 1), cB + hstep + kstep, voffB);
    PG8_WAIT_V(6); PG8_BAR;
    for (;;) {
        const bool has_next = PG8_NEXT(ui + 1, nxt);
        const char* nA = has_next ? PG8_UA(nxt) : cA; const char* nB = has_next ? PG8_UB(nxt) : cB;
        for (int t = 0; t < nt; t += 2) {
            const bool last = (t == nt - 2);
            const char* a1 = cA + (size_t)(t + 1) * kstep;
            const char* a2 = last ? nA : cA + (size_t)(t + 2) * kstep; const char* b2 = last ? nB : cB + (size_t)(t + 2) * kstep;
            const char* a3 = a2 + kstep; const char* b3 = b2 + kstep;
            PG8_LDB(B0, 0, 0); PG8_LDB(B1, 0, 1); PG8_SCHED; PG8_LDA(At, 0, 0); PG8_STAGE(PG8_SA(1, 1), a1 + hstep, voffA);
            PG8_WAIT_V(8); PG8_WAIT_L(0); PG8_BAR; PG8_MMA(0, 0, At, B0); PG8_MMA(0, 1, At, B1); PG8_BAR; PG8_SCHED;
            PG8_LDA(At, 0, 1); PG8_STAGE(PG8_SB(0, 0), b2, voffB); PG8_STAGE(PG8_SB(0, 1), b2 + hstep, voffB); PG8_STAGE(PG8_SA(0, 0), a2, voffA);
            PG8_WAIT_V(8); PG8_WAIT_L(0); PG8_BAR; PG8_MMA(1, 0, At, B0); PG8_MMA(1, 1, At, B1); PG8_BAR; PG8_SCHED;
            PG8_LDB(B0, 1, 0); PG8_LDB(B1, 1, 1); PG8_SCHED; PG8_LDA(At, 1, 0); PG8_STAGE(PG8_SA(0, 1), a2 + hstep, voffA);
            PG8_WAIT_V(8); PG8_WAIT_L(0); PG8_BAR; PG8_MMA(0, 0, At, B0); PG8_MMA(0, 1, At, B1); PG8_BAR; PG8_SCHED;
            PG8_LDA(At, 1, 1); PG8_STAGE(PG8_SB(1, 0), b3, voffB); PG8_STAGE(PG8_SB(1, 1), b3 + hstep, voffB); PG8_STAGE(PG8_SA(1, 0), a3, voffA);
            PG8_WAIT_V(8); PG8_WAIT_L(0); PG8_BAR; PG8_MMA(1, 0, At, B0); PG8_MMA(1, 1, At, B1); PG8_BAR; PG8_SCHED;
        }
        if (wr == 0) PG8_BAR;
        const bool first_half = SPLIT2 && cur.half == 0;
        {
            const int row0 = cur.pm * BM + wr * 64 + fr, col0 = cur.pn * BM + wc * 32 + 8 * fq;
            if constexpr (SPLIT2) { if (first_half) {
#pragma unroll
                for (int ai = 0; ai < 2; ++ai)
#pragma unroll
                    for (int m = 0; m < 4; ++m) {
#pragma unroll
                        for (int bj = 0; bj < 2; ++bj) E.mid8(row0 + ai * HALF + m * 16, col0 + bj * HALF, acc[ai][bj][m][0], acc[ai][bj][m][1]);
                        asm volatile("" : "+v"(acc[ai][0][m][0]), "+v"(acc[ai][0][m][1]), "+v"(acc[ai][1][m][0]), "+v"(acc[ai][1][m][1]) :: "memory"); } } }
            if constexpr (Epi::TILE) E.tile(acc, cur.pm, cur.pn, wr, wc, fr, fq, (LAS float*)(lds + RING_BYTES + 2048));
            else if (!first_half) {
#pragma unroll
            for (int ai = 0; ai < 2; ++ai)
#pragma unroll
                for (int m = 0; m < 4; ++m)
#pragma unroll
                    for (int bj = 0; bj < 2; ++bj) E.st8(row0 + ai * HALF + m * 16, col0 + bj * HALF, acc[ai][bj][m][0], acc[ai][bj][m][1]);
            }
        }
        if (!has_next) break;
        if (!first_half) {
#pragma unroll
        for (int a = 0; a < 2; ++a)
#pragma unroll
            for (int b = 0; b < 2; ++b)
#pragma unroll
                for (int m = 0; m < 4; ++m)
#pragma unroll
                    for (int n = 0; n < 2; ++n) acc[a][b][m][n] = (f32x4){0.f, 0.f, 0.f, 0.f};
        }
        cur = nxt; cA = nA; cB = nB; ++ui;
        if (wr == 1) PG8_BAR;
    }
    PG8_WAIT_V(0);
    PG8_BAR;
#undef PG8_NEXT
#undef PG8_UA
#undef PG8_UB
#undef PG8_SA
#undef PG8_SB
#undef PG8_STAGE
#undef PG8_LDA
#undef PG8_LDB
#undef PG8_MMA
#undef PG8_WAIT_V
#undef PG8_WAIT_L
#undef PG8_BAR
#undef PG8_SCHED
}
}

#define XB_TMO      128
#define XB_XCNT(j)  (256  + 64 * (j))
#define XB_XSUB(j)  (1280 + 64 * (j))
#define XB_XGEN(j)  (2304 + 64 * (j))
#define XB_TOP      3328
#define XB_TOPGEN   3392
#define XCD_BAR_WORDS 3456
#define XB_SPIN_CAP (1u << 18)
__device__ __forceinline__ unsigned xb_ld(unsigned* p)              { return __hip_atomic_load(p, __ATOMIC_RELAXED, __HIP_MEMORY_SCOPE_AGENT); }
__device__ __forceinline__ unsigned xb_add(unsigned* p, unsigned v) { return __hip_atomic_fetch_add(p, v, __ATOMIC_RELAXED, __HIP_MEMORY_SCOPE_AGENT); }
__device__ __forceinline__ unsigned xb_xcc_id() { return (unsigned)__builtin_amdgcn_s_getreg((3 << 11) | 20) & 0xFu; }
#define XB_SPIN(cond, bar) do { unsigned _sp = 0; while (cond) { __builtin_amdgcn_s_sleep(1); \
    if ((++_sp & 255u) == 0u) { if (xb_ld(&(bar)[XB_TMO])) break; if (_sp > XB_SPIN_CAP) { atomicAdd(&(bar)[XB_TMO], 1u); break; } } } } while (0)
struct XcdBarrier { unsigned* bar; unsigned x; volatile LAS unsigned* st; int wave; };
__device__ __forceinline__ XcdBarrier xcd_barrier_post(unsigned* bar, volatile LAS unsigned* st, int wave) {
    XcdBarrier b; b.bar = bar; b.x = xb_xcc_id(); b.st = st; b.wave = wave;
    if (wave == 0 && lane_id() == 0) (void)xb_add(&bar[XB_XCNT(b.x)], 1u);
    return b;
}
__device__ __forceinline__ void xcd_barrier_complete(unsigned* bar, unsigned x, unsigned& nloc, unsigned& nx) {
    const unsigned G = gridDim.x * gridDim.y * gridDim.z;
    unsigned sum, cnt, mine, sp = 0u;
    for (;;) {
        sum = 0u; cnt = 0u; mine = 0u;
#pragma unroll
        for (unsigned j = 0; j < 16; ++j) { const unsigned c = xb_ld(&bar[XB_XCNT(j)]); sum += c; cnt += (c > 0u) ? 1u : 0u; mine = (j == x) ? c : mine; }
        if (sum == G) break;
        __builtin_amdgcn_s_sleep(1);
        if ((++sp & 255u) == 0u) { if (xb_ld(&bar[XB_TMO])) break; if (sp > XB_SPIN_CAP) { atomicAdd(&bar[XB_TMO], 1u); break; } }
    }
    nloc = mine > 0u ? mine : 1u; nx = cnt > 0u ? cnt : 1u;
}
__device__ __forceinline__ void xcd_barrier(const XcdBarrier& b) {
    asm volatile("s_waitcnt vmcnt(0)" ::: "memory");
    __syncthreads();
    if (b.wave == 0 && lane_id() == 0) {
        unsigned* bar = b.bar;
        __builtin_amdgcn_s_waitcnt(0);
        unsigned nloc = b.st[0], nx = b.st[1];
        if (nloc == 0u) { xcd_barrier_complete(bar, b.x, nloc, nx); b.st[0] = nloc; b.st[1] = nx; }
        const unsigned old = xb_add(&bar[XB_XSUB(b.x)], 1u);
        const unsigned gen = old / nloc;
        if (old + 1u == (gen + 1u) * nloc) {
            __builtin_amdgcn_fence(__ATOMIC_RELEASE, "agent");
            asm volatile("s_waitcnt vmcnt(0)" ::: "memory");
            const unsigned og = xb_add(&bar[XB_TOP], 1u);
            const unsigned tg = og / nx;
            if (og + 1u == (tg + 1u) * nx) xb_add(&bar[XB_TOPGEN], 1u);
            else XB_SPIN(xb_ld(&bar[XB_TOPGEN]) == tg, bar);
            __builtin_amdgcn_fence(__ATOMIC_ACQUIRE, "agent");
            xb_add(&bar[XB_XGEN(b.x)], 1u);
            asm volatile("s_waitcnt vmcnt(0)" ::: "memory");
        } else {
            XB_SPIN(xb_ld(&bar[XB_XGEN(b.x)]) == gen, bar);
            __builtin_amdgcn_fence(__ATOMIC_ACQUIRE, "agent");
            asm volatile("s_waitcnt vmcnt(0)" ::: "memory");
        }
    }
    __syncthreads();
}

struct Args { const void* in[32]; float* out; unsigned char* ws; int ph_lo, ph_hi; };
struct Frame { LAS unsigned char* lds; int wave, vcu, G; const Args* a; };
#define FP_x_prompt ((const float*)F.a->in[0])
#define FP_x_sample ((const float*)F.a->in[1])
#define FP_c_prompt ((const float*)F.a->in[2])
#define FP_c_sample ((const float*)F.a->in[3])
#define FP_cache_k ((const float*)F.a->in[4])
#define FP_cache_v ((const float*)F.a->in[5])
#define FP_page_table ((const int*)F.a->in[6])
#define FP_state_C ((const float*)F.a->in[7])
#define FP_state_n ((const float*)F.a->in[8])
#define FP_state_m ((const float*)F.a->in[9])
#define FP_state_conv ((const float*)F.a->in[10])
#define FP_w_ada ((const float*)F.a->in[11])
#define FP_b_ada ((const float*)F.a->in[12])
#define FP_g_pre_mix ((const float*)F.a->in[13])
#define FP_g_post_mix ((const float*)F.a->in[14])
#define FP_w_in ((const float*)F.a->in[15])
#define FP_b_if ((const float*)F.a->in[16])
#define FP_g_mlstm ((const float*)F.a->in[17])
#define FP_lq1 ((const float*)F.a->in[18])
#define FP_lk1 ((const float*)F.a->in[19])
#define FP_lq2 ((const float*)F.a->in[20])
#define FP_lk2 ((const float*)F.a->in[21])
#define FP_g_diff ((const float*)F.a->in[22])
#define FP_w_proj_m ((const float*)F.a->in[23])
#define FP_w_proj_d ((const float*)F.a->in[24])
#define FP_w_out ((const float*)F.a->in[25])
#define FP_g_pre_ffn ((const float*)F.a->in[26])
#define FP_g_post_ffn ((const float*)F.a->in[27])
#define FP_w_up ((const float*)F.a->in[28])
#define FP_conv_w ((const float*)F.a->in[29])
#define FP_conv_b ((const float*)F.a->in[30])
#define FP_w_down ((const float*)F.a->in[31])
#define FP_WinT ((bf16_t*)(F.a->ws + WS_WIN))
#define FP_WupT ((bf16_t*)(F.a->ws + WS_WUP))
#define FP_WdownT ((bf16_t*)(F.a->ws + WS_WDOWN))
#define FP_WoutT ((bf16_t*)(F.a->ws + WS_WOUT))
#define FP_WpT ((bf16_t*)(F.a->ws + WS_WPM))
#define FP_H1 ((bf16_t*)(F.a->ws + WS_H1))
#define FP_Z ((bf16_t*)(F.a->ws + WS_Z))
#define FP_CPREV ((bf16_t*)(F.a->ws + WS_CPREV))
#define FP_HMD ((bf16_t*)(F.a->ws + WS_HM))
#define FP_MG ((bf16_t*)(F.a->ws + WS_MG))
#define FP_AH ((float*)(F.a->ws + WS_UA))
#define FP_AF ((float*)(F.a->ws + WS_UA + 2 * MiB))
#define FP_BF ((float*)(F.a->ws + WS_UA + 4 * MiB))
#define FP_GB ((bf16_t*)(F.a->ws + WS_G))
#define FP_ADA ((float*)(F.a->ws + WS_ADA))
#define FP_IG ((float*)(F.a->ws + WS_IG))
#define FP_LF ((float*)(F.a->ws + WS_LF))
#define FP_ST ((float*)(F.a->ws + WS_ST))
#define FP_NU ((float*)(F.a->ws + WS_NU))
#define FP_NPREV ((float*)(F.a->ws + WS_NPREV))
#define FP_MPREV ((float*)(F.a->ws + WS_MPREV))
#define FP_U ((float*)(F.a->ws + WS_U))
#define FP_O1 ((bf16_t*)(F.a->ws + WS_O1))
#define FP_O2 ((bf16_t*)(F.a->ws + WS_O2))
#define FP_Y ((bf16_t*)(F.a->ws + WS_Y))
#define FP_DPART ((float*)(F.a->ws + WS_DPART))
#define FP_X1 ((bf16_t*)(F.a->ws + WS_UB + 16 * MiB))
#define FP_out (F.a->out)


__device__ __forceinline__ void transpose_item(const float* W, int pitch, int scol0, int K, bf16_t* WT, int drow0, LAS float* scr, int kb, int nb, int lane, int koff = 0) {
    const int k0 = 64 * kb, n0 = 32 * nb;
    float tv[32];
#pragma unroll
    for (int i = 0; i < 32; ++i) { const int kk = 2 * i + (lane >> 5); tv[i] = W[(size_t)(k0 + kk) * pitch + scol0 + n0 + (lane & 31)]; }
#pragma unroll
    for (int i = 0; i < 32; ++i) { const int kk = 2 * i + (lane >> 5); scr[kk * 33 + (lane & 31)] = tv[i]; }
    asm volatile("s_waitcnt lgkmcnt(0)" ::: "memory");
    const int c = lane & 7;
#pragma unroll
    for (int j = 0; j < 4; ++j) { const int n = (lane >> 3) + 8 * j; const LAS float* s = scr + (8 * c) * 33 + n;
        u32x4 o; o.x = pk2(s[0 * 33], s[1 * 33]); o.y = pk2(s[2 * 33], s[3 * 33]); o.z = pk2(s[4 * 33], s[5 * 33]); o.w = pk2(s[6 * 33], s[7 * 33]);
        *(u32x4*)(WT + (size_t)(drow0 + n0 + n) * K + koff + k0 + 8 * c) = o; }
    asm volatile("s_waitcnt lgkmcnt(0)" ::: "memory");
}
struct TBlock { const float* W; bf16_t* WT; int pitch, col_a, col_b, k0, wt_pitch, koff, drow0; };
__device__ __forceinline__ TBlock tblock_of(const Frame& F, int it) {
    constexpr int B0 = 16 * 22, B1 = 8 * 4, B2 = 8 * 4, B3 = 16 * 4, B4 = 16 * 22;
    int r = it; TBlock t;
    if (r < B0) { const int kb = r / 22, nb = r % 22; t = {FP_w_in, FP_WinT, DIN, nb < 8 ? 256 * nb : 2056 + 256 * (nb - 8), -1, 64 * kb, 1024, 0, 256 * nb}; return t; } r -= B0;
    if (r < B1) { t = {FP_w_proj_m, FP_WpT, 1024, 256 * (r & 3), -1, 64 * (r >> 2), 1024, 0, 256 * (r & 3)}; return t; } r -= B1;
    if (r < B2) { t = {FP_w_proj_d, FP_WpT, 1024, 256 * (r & 3), -1, 64 * (r >> 2), 1024, 512, 256 * (r & 3)}; return t; } r -= B2;
    if (r < B3) { t = {FP_w_out, FP_WoutT, 1024, 256 * (r & 3), -1, 64 * (r >> 2), 1024, 0, 256 * (r & 3)}; return t; } r -= B3;
    if (r < B4) { const int kb = r / 22, pn = r % 22; t = {FP_w_up, FP_WupT, 2 * DFF, 128 * pn, DFF + 128 * pn, 64 * kb, 1024, 0, 256 * pn}; return t; } r -= B4;
    t = {FP_w_down, FP_WdownT, 1024, 256 * (r & 3), -1, 64 * (r >> 2), DFF, 0, 256 * (r & 3)}; return t;
}
__device__ __forceinline__ void p0_transposes(const Frame& F) {
    constexpr int NBLK = 16 * 22 + 8 * 4 + 8 * 4 + 16 * 4 + 16 * 22 + 44 * 4;
    const int lane = lane_id(), wid = F.wave, tid = wid * 64 + lane;
    LAS float* tile = (LAS float*)F.lds;
    f32x4 v[8];
    int it = F.vcu;
    if (it < NBLK) { const TBlock t = tblock_of(F, it); const int scol = (t.col_b >= 0 && lane >= 32) ? t.col_b + 4 * (lane - 32) : t.col_a + 4 * lane;
#pragma unroll
        for (int i = 0; i < 8; ++i) v[i] = *(const f32x4*)(t.W + (size_t)(t.k0 + 8 * wid + i) * t.pitch + scol); }
    for (; it < NBLK; it += F.G) {
        const TBlock t = tblock_of(F, it);
#pragma unroll
        for (int i = 0; i < 8; ++i) *(LAS f32x4*)(tile + (8 * wid + i) * 260 + 4 * lane) = v[i];
        if (it + F.G < NBLK) { const TBlock tn = tblock_of(F, it + F.G); const int scol = (tn.col_b >= 0 && lane >= 32) ? tn.col_b + 4 * (lane - 32) : tn.col_a + 4 * lane;
#pragma unroll
            for (int i = 0; i < 8; ++i) v[i] = *(const f32x4*)(tn.W + (size_t)(tn.k0 + 8 * wid + i) * tn.pitch + scol); }
        WG_BAR();
#pragma unroll
        for (int i = 0; i < 4; ++i) { const int idx = tid + 512 * i, n = idx >> 3, c = idx & 7; const LAS float* sp = tile + (8 * c) * 260 + n;
            u32x4 o; o.x = pk2(sp[0], sp[260]); o.y = pk2(sp[2 * 260], sp[3 * 260]); o.z = pk2(sp[4 * 260], sp[5 * 260]); o.w = pk2(sp[6 * 260], sp[7 * 260]);
            *(u32x4*)(t.WT + (size_t)(t.drow0 + n) * t.wt_pitch + t.koff + t.k0 + 8 * c) = o; }
        WG_BAR();
    }
    {
        LAS float* scr = (LAS float*)(F.lds + F.wave * 8448);
        const int gw = F.vcu * NWAVES + F.wave; if (gw < 16) transpose_item(FP_w_in, DIN, 2048 - ZP, 1024, FP_WinT, 0, scr, gw, ZP / 32, lane_id());
    }
}
__device__ __forceinline__ void p0_ada(const Frame& F) {
    const int lane = lane_id(), r = lane & 31, h = lane >> 5, w = F.wave, tid = w * 64 + lane;
    LAS float* part = (LAS float*)F.lds;
    for (int task = F.vcu; task < 192; task += F.G) {
        const int n0 = 32 * task;
        bf16x8 bw[8];
#pragma unroll
        for (int ks = 0; ks < 8; ++ks) { const float* p = FP_w_ada + (size_t)(128 * w + 16 * ks + 8 * h) * 6144 + n0 + r;
            f32x4 a, b; a.x = p[0]; a.y = p[6144]; a.z = p[2 * 6144]; a.w = p[3 * 6144]; b.x = p[4 * 6144]; b.y = p[5 * 6144]; b.z = p[6 * 6144]; b.w = p[7 * 6144]; bw[ks] = pack8(a, b); }
        f32x16 acc[5];
        LAS unsigned char* ct = F.lds + w * 8704;
        int lo_ = lane; asm volatile("" : "+v"(lo_));
        const int lrow = lo_ >> 5, lcol = (lo_ & 31) * 4;
#pragma unroll
        for (int rt = 0; rt < 5; ++rt) {
            f32x4 cv[16];
#pragma unroll
            for (int i = 0; i < 16; ++i) { const int R0 = 32 * rt + 2 * i;
                if (R0 == 0) cv[i] = *(const f32x4*)(FP_c_prompt + (size_t)lrow * 1024 + 128 * w + lcol);
                else if (R0 < 130) cv[i] = *(const f32x4*)(FP_c_sample + (size_t)(R0 - 2 + lrow) * 1024 + 128 * w + lcol);
                else cv[i] = (f32x4){0.f, 0.f, 0.f, 0.f}; }
#pragma unroll
            for (int i = 0; i < 16; ++i) { u32x2 o; o.x = pk2(cv[i].x, cv[i].y); o.y = pk2(cv[i].z, cv[i].w); *(LAS u32x2*)(ct + (2 * i + lrow) * 272 + lcol * 2) = o; }
            for (int i = 0; i < 16; ++i) acc[rt][i] = 0.f;
#pragma unroll
            for (int ks = 0; ks < 8; ++ks) acc[rt] = MFMA32(*(const LAS bf16x8*)(ct + r * 272 + (16 * ks + 8 * h) * 2), bw[ks], acc[rt]);
            asm volatile("s_waitcnt lgkmcnt(0)" ::: "memory");
        }
        WG_BAR();
#pragma unroll
        for (int batch = 0; batch < 2; ++batch) {
            const int rt0 = 3 * batch, nrt = batch ? 2 : 3;
#pragma unroll
            for (int j = 0; j < 3; ++j) if (j < nrt) {
#pragma unroll
                for (int i = 0; i < 16; ++i) part[((w * 3 + j) * 32 + crow(i, h)) * 32 + r] = acc[rt0 + j][i]; }
            WG_BAR();
            for (int idx = tid; idx < nrt * 1024; idx += NTHR) { const int j = idx >> 10, row = (idx >> 5) & 31, col = idx & 31; float sum = 0.f;
#pragma unroll
                for (int ww = 0; ww < 8; ++ww) sum += part[((ww * 3 + j) * 32 + row) * 32 + col];
                const int Rr = 32 * (rt0 + j) + row; if (Rr < 130) FP_ADA[(size_t)Rr * 6144 + n0 + col] = sum + FP_b_ada[n0 + col]; }
            WG_BAR();
        }
    }
}
__device__ __forceinline__ int crow_of(int m) { return m < MP ? (m >> 13) : 2 + ((m - MP) >> 2); }
__device__ __forceinline__ const float* xrow_of(const Frame& F, int m) { return m < MP ? FP_x_prompt + (size_t)m * DM : FP_x_sample + (size_t)(m - MP) * DM; }
__device__ __forceinline__ void p1_norm_gates(const Frame& F) {
    const int lane = lane_id(), gw = F.vcu * NWAVES + F.wave, NGW = F.G * NWAVES;
    const int r_lo = (int)(((long)gw * MT) / NGW), r_hi = (int)(((long)(gw + 1) * MT) / NGW);
    f32x4 gs[4], sh[4], vn[4], vn2[4];
#pragma unroll
    for (int j = 0; j < 4; ++j) { gs[j] = (f32x4){0.f, 0.f, 0.f, 0.f}; sh[j] = gs[j]; vn[j] = gs[j]; vn2[j] = gs[j]; }
    int ccur = -1;
    if (r_lo < r_hi) { const float* xr = xrow_of(F, r_lo);
#pragma unroll
        for (int j = 0; j < 4; ++j) vn[j] = *(const f32x4*)(xr + 4 * lane + 256 * j); }
    if (r_lo + 1 < r_hi) { const float* xr = xrow_of(F, r_lo + 1);
#pragma unroll
        for (int j = 0; j < 4; ++j) vn2[j] = *(const f32x4*)(xr + 4 * lane + 256 * j); }
    for (int m = r_lo; m < r_hi; ++m) {
        f32x4 v[4]; float ss = 0.f;
#pragma unroll
        for (int j = 0; j < 4; ++j) { v[j] = vn[j]; vn[j] = vn2[j]; }
        if (m + 2 < r_hi) { const float* xr = xrow_of(F, m + 2);
#pragma unroll
            for (int j = 0; j < 4; ++j) vn2[j] = *(const f32x4*)(xr + 4 * lane + 256 * j); }
        const int cr = crow_of(m);
        if (cr != ccur) { ccur = cr; const float* ada = FP_ADA + (size_t)cr * 6144;
#pragma unroll
            for (int j = 0; j < 4; ++j) { sh[j] = *(const f32x4*)(ada + 4 * lane + 256 * j); gs[j] = *(const f32x4*)(FP_g_pre_mix + 4 * lane + 256 * j) * (*(const f32x4*)(ada + 1024 + 4 * lane + 256 * j) + 1.f); } }
#pragma unroll
        for (int j = 0; j < 4; ++j) ss += (v[j].x * v[j].x + v[j].y * v[j].y) + (v[j].z * v[j].z + v[j].w * v[j].w);
        const float rs = rsqrtf(wave_sum(ss) * (1.f / DM) + EPS);
#pragma unroll
        for (int j = 0; j < 4; ++j) { const f32x4 hv = (v[j] * rs) * gs[j] + sh[j];
            u32x2 o; o.x = pk2(hv.x, hv.y); o.y = pk2(hv.z, hv.w); *(u32x2*)(FP_H1 + (size_t)m * DM + 4 * lane + 256 * j) = o; }
    }
}
struct EpiZ {
    static constexpr int MID_T = -1; static constexpr bool TILE = false;
    bf16_t* Z; float* out; float* IG; float* LF; const float* b_if;
    __device__ __forceinline__ void st8(int row, int col, f32x4 v0, f32x4 v1) const {
        if (col >= ZP) { if (col == ZP) { const f32x4 bi = *(const f32x4*)b_if, bf = *(const f32x4*)(b_if + 4);
                *(f32x4*)(IG + (size_t)row * 4) = v0 + bi; v1 = v1 + bf; *(f32x4*)(LF + (size_t)row * 4) = (f32x4){log_sigmoid(v1.x), log_sigmoid(v1.y), log_sigmoid(v1.z), log_sigmoid(v1.w)}; } return; }
        const int pn = col >> 8; const float sc = (pn == 2 || pn == 3) ? KSCALE : ((pn == 8 || pn == 9) ? QSCALE : 1.f);
        if (pn >= 10 && pn < 14) { const int kv = pn >= 12; const int c = col - (kv ? ZDV : ZDK);
            float* o = row < MP ? out + (kv ? OFF_VP : OFF_KP) + (size_t)row * 512 + c : out + (kv ? OFF_VS : OFF_KS) + (size_t)(row - MP) * 512 + c;
            *(f32x4*)o = v0; *(f32x4*)(o + 4) = v1; }
        if (pn >= 14) { v0.x = sigmoidf_(v0.x); v0.y = sigmoidf_(v0.y); v0.z = sigmoidf_(v0.z); v0.w = sigmoidf_(v0.w); v1.x = sigmoidf_(v1.x); v1.y = sigmoidf_(v1.y); v1.z = sigmoidf_(v1.z); v1.w = sigmoidf_(v1.w); }
        *(bf16x8*)(Z + (size_t)row * ZP + col) = pack8(v0 * sc, v1 * sc);
    }
};
struct EpiPMD {
    static constexpr int MID_T = 6; static constexpr bool TILE = false;
    const bf16_t* Z; bf16_t* MG;
    __device__ __forceinline__ void mid8(int row, int col, f32x4& v0, f32x4& v1) const {
        const u32x4 gm = *(const u32x4*)(Z + (size_t)row * ZP + ZGM + col), gd = *(const u32x4*)(Z + (size_t)row * ZP + ZGD + col);
        f32x4 m0, m1, d0, d1; unpack8(gm, m0, m1); unpack8(gd, d0, d1);
        d0.x = fmaxf(d0.x, 1e-20f); d0.y = fmaxf(d0.y, 1e-20f); d0.z = fmaxf(d0.z, 1e-20f); d0.w = fmaxf(d0.w, 1e-20f); d1.x = fmaxf(d1.x, 1e-20f); d1.y = fmaxf(d1.y, 1e-20f); d1.z = fmaxf(d1.z, 1e-20f); d1.w = fmaxf(d1.w, 1e-20f);
        v0.x *= m0.x * __builtin_amdgcn_rcpf(d0.x); v0.y *= m0.y * __builtin_amdgcn_rcpf(d0.y); v0.z *= m0.z * __builtin_amdgcn_rcpf(d0.z); v0.w *= m0.w * __builtin_amdgcn_rcpf(d0.w);
        v1.x *= m1.x * __builtin_amdgcn_rcpf(d1.x); v1.y *= m1.y * __builtin_amdgcn_rcpf(d1.y); v1.z *= m1.z * __builtin_amdgcn_rcpf(d1.z); v1.w *= m1.w * __builtin_amdgcn_rcpf(d1.w); }
    __device__ __forceinline__ void st8(int row, int col, f32x4 v0, f32x4 v1) const {
        f32x4 d0, d1; unpack8(*(const u32x4*)(Z + (size_t)row * ZP + ZGD + col), d0, d1);
        d0.x = fmaxf(d0.x, 1e-20f); d0.y = fmaxf(d0.y, 1e-20f); d0.z = fmaxf(d0.z, 1e-20f); d0.w = fmaxf(d0.w, 1e-20f); d1.x = fmaxf(d1.x, 1e-20f); d1.y = fmaxf(d1.y, 1e-20f); d1.z = fmaxf(d1.z, 1e-20f); d1.w = fmaxf(d1.w, 1e-20f);
        *(bf16x8*)(MG + (size_t)row * DM + col) = pack8(v0 * d0, v1 * d1); }
    __device__ __forceinline__ void st4md(int row, int col, f32x4 am, f32x4 ad) const {
        const u32x2 gm = *(const u32x2*)(Z + (size_t)row * ZP + ZGM + col), gd = *(const u32x2*)(Z + (size_t)row * ZP + ZGD + col);
        u32x2 o; o.x = pk2(bflo(gm.x) * am.x + bflo(gd.x) * ad.x, bfhi(gm.x) * am.y + bfhi(gd.x) * ad.y); o.y = pk2(bflo(gm.y) * am.z + bflo(gd.y) * ad.z, bfhi(gm.y) * am.w + bfhi(gd.y) * ad.w);
        *(u32x2*)(MG + (size_t)row * DM + col) = o; }
};
struct EpiF32 {
    static constexpr int MID_T = -1; static constexpr bool TILE = false;
    bf16_t* Y;
    __device__ __forceinline__ void st4(int row, int col, f32x4 v) const { u32x2 o; o.x = pk2(v.x, v.y); o.y = pk2(v.z, v.w); *(u32x2*)(Y + (size_t)row * DM + col) = o; }
    __device__ __forceinline__ void st8(int row, int col, f32x4 v0, f32x4 v1) const { *(bf16x8*)(Y + (size_t)row * DM + col) = pack8(v0, v1); }
};
__device__ __forceinline__ float gelu_tanh(float x) { const float u = 1.5957691216057308f * (x + 0.044715f * x * x * x); return x * __builtin_amdgcn_rcpf(1.f + __builtin_amdgcn_exp2f(-u * LOG2E)); }
#define DPP_F(oldv, srcv, ctrl) __builtin_bit_cast(float, __builtin_amdgcn_update_dpp(__builtin_bit_cast(int, (float)(oldv)), __builtin_bit_cast(int, (float)(srcv)), (ctrl), 0xf, 0xf, false))
struct EpiUpG {
    static constexpr int MID_T = -1; static constexpr bool TILE = true;
    bf16_t* G; float* out; const float* conv_w; const float* conv_b; const float* state_conv; float* AH; float* AF; float* BF;
    __device__ __forceinline__ void st8(int, int, f32x4, f32x4) const {}
    __device__ __forceinline__ void tile(f32x4 (&acc)[2][2][4][2], int pm, int pn, int wr, int wc, int fr, int fq, LAS float* halo) const {
        const int f0 = 128 * pn + 32 * wc + 8 * fq;
        const bool sample = pm >= MP / 256;
#pragma unroll
        for (int ai = 0; ai < 2; ++ai) if (fr >= 14) { LAS float* hp = halo + ((2 * ai + wr) * 2 + (fr - 14)) * 128 + 32 * wc + 8 * fq; *(LAS f32x4*)hp = acc[ai][0][3][0]; *(LAS f32x4*)(hp + 4) = acc[ai][0][3][1]; }
        asm volatile("s_waitcnt lgkmcnt(0)\n\ts_barrier" ::: "memory");
#pragma unroll
        for (int n = 0; n < 2; ++n) {
            const int fc = f0 + 4 * n;
            const f32x4 w0 = *(const f32x4*)(conv_w + fc), w1 = *(const f32x4*)(conv_w + DFF + fc), w2 = *(const f32x4*)(conv_w + 2 * DFF + fc), cb = *(const f32x4*)(conv_b + fc);
#pragma unroll
            for (int ai = 0; ai < 2; ++ai) {
                const int g = 2 * ai + wr;
                f32x4 h0 = {0.f, 0.f, 0.f, 0.f}, h1 = h0;
                if (g > 0) { const LAS float* hp = halo + ((g - 1) * 2) * 128 + 32 * wc + 8 * fq + 4 * n; h0 = *(const LAS f32x4*)hp; h1 = *(const LAS f32x4*)(hp + 128); }
#pragma unroll
                for (int m = 0; m < 4; ++m) {
                    const int rowt = 128 * ai + 64 * wr + 16 * m + fr, row = 256 * pm + rowt, tq = fr & 3;
                    f32x4 s0 = {0.f, 0.f, 0.f, 0.f}, s1 = s0;
                    if (sample) { const float* st = state_conv + (size_t)((row - MP) >> 2) * 2 * DFF + fc; s0 = *(const f32x4*)st; s1 = *(const f32x4*)(st + DFF); }
                    f32x4 gv;
#pragma unroll
                    for (int e = 0; e < 4; ++e) {
                        const float a0 = acc[ai][0][m][n][e], bv = acc[ai][1][m][n][e];
                        float p1, p2;
                        if (sample) {
                            const float d1 = DPP_F(0.f, a0, 0x111), d2 = DPP_F(0.f, a0, 0x112);
                            p1 = (tq >= 1) ? d1 : s1[e]; p2 = (tq >= 2) ? d2 : ((tq == 1) ? s1[e] : s0[e]);
                        } else {
                            float t1, t2;
                            if (m > 0) { const float pr = acc[ai][0][m > 0 ? m - 1 : 0][n][e]; t1 = DPP_F(0.f, pr, 0x10F); t2 = DPP_F(0.f, pr, 0x10E); }
                            else { t1 = h1[e]; t2 = (fr == 0) ? h0[e] : h1[e]; }
                            p1 = DPP_F(t1, a0, 0x111); p2 = DPP_F(t2, a0, 0x112);
                        }
                        const float cv = cb[e] + w0[e] * p2 + w1[e] * p1 + w2[e] * a0;
                        gv[e] = gelu_tanh(cv) * bv;
                    }
                    { u32x2 o; o.x = pk2(gv.x, gv.y); o.y = pk2(gv.z, gv.w); *(u32x2*)(G + (size_t)row * DFF + fc) = o; }
                    if (!sample) {
                        if (rowt >= 254) { *(f32x4*)(AH + ((size_t)pm * 2 + (rowt - 254)) * DFF + fc) = acc[ai][0][m][n];
                            if ((pm & 31) == 31) *(f32x4*)(out + OFF_CVP + ((size_t)(pm >> 5) * 2 + (rowt - 254)) * DFF + fc) = acc[ai][0][m][n]; }
                        if (rowt < 2) { *(f32x4*)(AF + ((size_t)pm * 2 + rowt) * DFF + fc) = acc[ai][0][m][n]; *(f32x4*)(BF + ((size_t)pm * 2 + rowt) * DFF + fc) = acc[ai][1][m][n]; }
                    } else if (tq >= 2) *(f32x4*)(out + OFF_CVS + ((size_t)((row - MP) >> 2) * 2 + (tq - 2)) * DFF + fc) = acc[ai][0][m][n];
                    asm volatile("" ::: "memory");
                }
            }
        }
    }
};
__device__ __forceinline__ void geglu_fixup(const Frame& F, int pm) {
    if (pm >= MP / 256 || (pm & 31) == 0) return;
    const float* ah = FP_AH + (size_t)(pm - 1) * 2 * DFF; const float* af = FP_AF + (size_t)pm * 2 * DFF; const float* bfp = FP_BF + (size_t)pm * 2 * DFF;
    for (int i = FTID(F); i < 2 * DFF; i += NTHR) { const int r = i / DFF, f = i - r * DFF;
        const float a0 = af[r * DFF + f], bv = bfp[r * DFF + f], p1 = (r == 0) ? ah[DFF + f] : af[f], p2 = (r == 0) ? ah[f] : ah[DFF + f];
        const float cv = FP_conv_b[f] + FP_conv_w[f] * p2 + FP_conv_w[DFF + f] * p1 + FP_conv_w[2 * DFF + f] * a0;
        FP_GB[(size_t)(256 * pm + r) * DFF + f] = f2bf(gelu_tanh(cv) * bv); }
    asm volatile("s_waitcnt vmcnt(0)" ::: "memory");
    WG_BAR();
}
template <bool MD, class Epi>
__device__ __forceinline__ void skinny_gemm(const Frame& F, const bf16_t* A, const bf16_t* Bt, int K, const Epi& E) {
    const int lane = lane_id(), r = lane & 31, h = lane >> 5, ke = F.wave, K8 = K >> 3, tid = F.wave * 64 + lane;
    LAS float* part = (LAS float*)F.lds;
    for (int task = F.vcu; task < 256; task += F.G) {
        const int rt = task >> 4, cg = task & 15;
        const bf16_t* ap = A + (size_t)(32 * rt + r) * K + ke * K8 + 8 * h;
        const bf16_t* bp0 = Bt + (size_t)(64 * cg + r) * K + ke * K8 + 8 * h; const bf16_t* bp1 = bp0 + (size_t)32 * K;
        f32x16 acc0, acc1; for (int i = 0; i < 16; ++i) { acc0[i] = 0.f; acc1[i] = 0.f; }
#pragma unroll 4
        for (int s = 0; s < K8 / 16; ++s) { const bf16x8 a = *(const bf16x8*)(ap + 16 * s), b0 = *(const bf16x8*)(bp0 + 16 * s), b1 = *(const bf16x8*)(bp1 + 16 * s); acc0 = MFMA32(b0, a, acc0); acc1 = MFMA32(b1, a, acc1); }
#pragma unroll
        for (int g4 = 0; g4 < 4; ++g4) { *(LAS f32x4*)(part + (ke * 32 + r) * 68 + 8 * g4 + 4 * h) = (f32x4){acc0[4 * g4], acc0[4 * g4 + 1], acc0[4 * g4 + 2], acc0[4 * g4 + 3]};
            *(LAS f32x4*)(part + (ke * 32 + r) * 68 + 32 + 8 * g4 + 4 * h) = (f32x4){acc1[4 * g4], acc1[4 * g4 + 1], acc1[4 * g4 + 2], acc1[4 * g4 + 3]}; }
        WG_BAR();
        { const int row = tid >> 4, c4 = (tid & 15) * 4;
          const f32x4 lo = *(const LAS f32x4*)(part + row * 68 + c4) + *(const LAS f32x4*)(part + (32 + row) * 68 + c4) + *(const LAS f32x4*)(part + (64 + row) * 68 + c4) + *(const LAS f32x4*)(part + (96 + row) * 68 + c4);
          const f32x4 hi4 = *(const LAS f32x4*)(part + (128 + row) * 68 + c4) + *(const LAS f32x4*)(part + (160 + row) * 68 + c4) + *(const LAS f32x4*)(part + (192 + row) * 68 + c4) + *(const LAS f32x4*)(part + (224 + row) * 68 + c4);
          if constexpr (MD) E.st4md(MP + 32 * rt + row, 64 * cg + c4, lo, hi4);
          else E.st4(MP + 32 * rt + row, 64 * cg + c4, lo + hi4); }
        WG_BAR();
    }
}

constexpr int VROW = 320;
constexpr int CH = 128, NCH = TP / CH;
__device__ __forceinline__ void chunk_scan(const Frame& F, int m0, int h, int lane, float& F1, float& F2, float& a1, float& a2, float& A1, float& A2) {
    const float lf1 = FP_LF[(size_t)(m0 + lane) * 4 + h], lf2 = FP_LF[(size_t)(m0 + 64 + lane) * 4 + h], ig1 = FP_IG[(size_t)(m0 + lane) * 4 + h], ig2 = FP_IG[(size_t)(m0 + 64 + lane) * 4 + h];
    F1 = wave_scan_sum(lf1, lane); F2 = __shfl(F1, 63) + wave_scan_sum(lf2, lane);
    a1 = ig1 - F1; a2 = ig2 - F2;
    A1 = wave_scan_max(a1, lane); A2 = fmaxf(__shfl(A1, 63), wave_scan_max(a2, lane));
}
__device__ __forceinline__ void mlstm_A_unit(const Frame& F, int u) {
    const int bh = u / NCH, c = u % NCH, b = bh >> 2, h = bh & 3, m0 = b * TP + c * CH;
    const int lane = lane_id(), wid = F.wave, tid = wid * 64 + lane;
    LAS unsigned char* Vt = F.lds; LAS unsigned char* Kt = F.lds + CH * VROW; LAS float* wl = (LAS float*)(F.lds + 2 * CH * VROW);
    if (wid == 0) {
        float F1, F2, a1, a2, A1, A2; chunk_scan(F, m0, h, lane, F1, F2, a1, a2, A1, A2);
        const float Mloc = __shfl(A2, 63), Fsum = __shfl(F2, 63);
        wl[lane] = __expf(a1 - Mloc); wl[64 + lane] = __expf(a2 - Mloc);
        if (lane == 0) { FP_ST[2 * u] = Fsum; FP_ST[2 * u + 1] = Mloc; }
    }
    WG_BAR();
#pragma unroll
    for (int i = 0; i < 4; ++i) { const int idx = tid + 512 * i, row = idx >> 4, ch = idx & 15;
        const bf16_t* src = FP_Z + (size_t)(m0 + row) * ZP + h * 128 + ch * 8;
        const u32x4 vv = *(const u32x4*)(src + ZV); const u32x4 kk = *(const u32x4*)(src + ZK);
        f32x4 k0, k1; unpack8(kk, k0, k1); const float w = wl[row];
        *(LAS u32x4*)(Vt + row * VROW + ch * 16) = vv;
        *(LAS bf16x8*)(Kt + row * VROW + ch * 16) = pack8(k0 * w, k1 * w); }
    WG_BAR();
    if (tid < 128) { float sm = 0.f;
#pragma unroll 8
        for (int row = 0; row < CH; ++row) sm += bf2f(*(const LAS bf16_t*)(Kt + row * VROW + tid * 2));
        FP_NU[(size_t)u * 128 + tid] = sm; }
    {
        const int r32 = lane & 31, hi = lane >> 5, vh = (lane >> 4) & 1, q4 = (lane & 15) >> 2, p = lane & 3;
        const int vt = wid >> 1, dt0 = 2 * (wid & 1);
        const int lbase = (8 * hi + q4) * VROW + (16 * vh + 4 * p) * 2;
        f32x16 acc0, acc1; for (int i = 0; i < 16; ++i) { acc0[i] = 0.f; acc1[i] = 0.f; }
#pragma unroll
        for (int st = 0; st < CH / 16; ++st) {
            const LAS unsigned char* va = Vt + lbase + st * 16 * VROW + vt * 64;
            const bf16x8 af = cat4(tr_rd(va), tr_rd(va + 4 * VROW));
            const LAS unsigned char* ka = Kt + lbase + st * 16 * VROW + dt0 * 64;
            const bf16x8 b0 = cat4(tr_rd(ka), tr_rd(ka + 4 * VROW)), b1 = cat4(tr_rd(ka + 64), tr_rd(ka + 64 + 4 * VROW));
            acc0 = MFMA32(af, b0, acc0); acc1 = MFMA32(af, b1, acc1);
        }
        float* Uo = FP_U + (size_t)u * 16384;
#pragma unroll
        for (int i = 0; i < 16; ++i) { const int v = 32 * vt + crow(i, hi); Uo[v * 128 + 32 * dt0 + r32] = acc0[i]; Uo[v * 128 + 32 * dt0 + 32 + r32] = acc1[i]; }
    }
    WG_BAR();
}
__device__ __forceinline__ void smlstm_unit(const Frame& F, int u) {
    const int n = u >> 2, h = u & 3, tid = FTID(F), lane = lane_id(), wid = F.wave;
    const int mrow = MP + 4 * n;
    LAS float* qs = (LAS float*)F.lds; LAS float* ks = qs + 512; LAS float* vs = ks + 512; LAS float* numI = vs + 512; LAS float* Sm = numI + 512; LAS float* nq = Sm + 16; LAS float* red = nq + 4;
    { const int t = tid >> 7, d = tid & 127; const bf16_t* z = FP_Z + (size_t)(mrow + t) * ZP + h * 128 + d;
      qs[tid] = bf2f(z[ZQ]); ks[tid] = bf2f(z[ZK]); vs[tid] = bf2f(z[ZV]); }
    LAS float* gl = red + 8;
    const float m0 = FP_state_m[n * 4 + h];
    if (tid < 4) { float cum = 0.f, am = -INFINITY, at = 0.f;
      for (int t = 0; t <= tid; ++t) { cum += FP_LF[(size_t)(mrow + t) * 4 + h]; at = FP_IG[(size_t)(mrow + t) * 4 + h] - cum; am = fmaxf(am, at); }
      const float mxv = fmaxf(m0, am);
      gl[tid] = cum; gl[4 + tid] = at; gl[8 + tid] = mxv; gl[12 + tid] = __expf(m0 - mxv); gl[16 + tid] = cum + mxv; }
    WG_BAR();
    const float m_end = gl[19], Fend = gl[3], decay = __expf(Fend + m0 - m_end);
    const float wend0 = __expf(Fend + gl[4] - m_end), wend1 = __expf(Fend + gl[5] - m_end), wend2 = __expf(Fend + gl[6] - m_end), wend3 = __expf(Fend + gl[7] - m_end);
#pragma unroll
    for (int k = 0; k < 2; ++k) { const int pid = 2 * wid + k, t = pid >> 2, s = pid & 3;
        float d = qs[t * 128 + lane] * ks[s * 128 + lane] + qs[t * 128 + 64 + lane] * ks[s * 128 + 64 + lane]; d = wave_sum(d);
        if (lane == 0) Sm[pid] = (s <= t) ? d * __expf(gl[4 + s] - gl[8 + t]) : 0.f; }
    if (wid < 4) { const float* n0 = FP_state_n + (size_t)u * 128; float d = n0[lane] * qs[wid * 128 + lane] + n0[64 + lane] * qs[wid * 128 + 64 + lane]; d = wave_sum(d); if (lane == 0) nq[wid] = d; }
    { const int vrow = tid >> 2, dq = tid & 3;
      const float* c0 = FP_state_C + ((size_t)u * 128 + vrow) * 128 + 32 * dq; float* co = FP_out + OFF_CS + ((size_t)u * 128 + vrow) * 128 + 32 * dq;
      f32x4 cv[8];
#pragma unroll
      for (int i = 0; i < 8; ++i) cv[i] = *(const f32x4*)(c0 + 4 * i);
      float ps[4]; float coef[4];
      ps[0] = 0.f; ps[1] = 0.f; ps[2] = 0.f; ps[3] = 0.f;
      coef[0] = wend0 * vs[vrow]; coef[1] = wend1 * vs[128 + vrow]; coef[2] = wend2 * vs[256 + vrow]; coef[3] = wend3 * vs[384 + vrow];
#pragma unroll
      for (int i = 0; i < 8; ++i) { f32x4 cn = cv[i] * decay;
#pragma unroll
          for (int t = 0; t < 4; ++t) { const f32x4 qv = *(const LAS f32x4*)(qs + t * 128 + 32 * dq + 4 * i), kv = *(const LAS f32x4*)(ks + t * 128 + 32 * dq + 4 * i);
              ps[t] += (cv[i].x * qv.x + cv[i].y * qv.y) + (cv[i].z * qv.z + cv[i].w * qv.w); cn += kv * coef[t]; }
          *(f32x4*)(co + 4 * i) = cn; }
#pragma unroll
      for (int t = 0; t < 4; ++t) { ps[t] += __shfl_xor(ps[t], 1); ps[t] += __shfl_xor(ps[t], 2); if (dq == 0) numI[t * 128 + vrow] = ps[t]; } }
    WG_BAR();
    { const int t = tid >> 7, v = tid & 127;
      const float it = gl[12 + t], mtt = gl[16 + t];
      float num = it * numI[tid], den = it * nq[t];
#pragma unroll
      for (int s = 0; s < 4; ++s) { const float sv = Sm[t * 4 + s]; num += sv * vs[s * 128 + v]; den += sv; }
      const float hval = num / fmaxf(fabsf(den), __expf(-mtt));
      const float ssw = wave_sum(hval * hval); if (lane == 0) red[wid] = ssw;
      WG_BAR();
      const float rms = rsqrtf((red[2 * t] + red[2 * t + 1]) * (1.f / 128.f) + EPS);
      const float mo = bf2f(FP_Z[(size_t)(mrow + t) * ZP + ZO + h * 128 + v]);
      FP_HMD[(size_t)(mrow + t) * 1024 + h * 128 + v] = f2bf(hval * rms * FP_g_mlstm[h * 128 + v] * sigmoidf_(mo));
      if (tid < 128) { const float n0v = FP_state_n[(size_t)u * 128 + tid]; float nn = decay * n0v;
          nn += wend0 * ks[tid] + wend1 * ks[128 + tid] + wend2 * ks[256 + tid] + wend3 * ks[384 + tid];
          FP_out[OFF_NS + (size_t)u * 128 + tid] = nn; }
      if (tid == 0) FP_out[OFF_MS + u] = m_end; }
    WG_BAR();
}
__device__ __forceinline__ void mlstm_scan_item(const Frame& F, int item) {
    const int tid = FTID(F), bh = item >> 5, j = item & 31, e = 512 * j + tid; const bool nthr = (j == 0 && tid < 128);
    float C = 0.f, m = 0.f, nacc = 0.f;
    const float* Ub = FP_U + (size_t)bh * NCH * 16384 + e; bf16_t* Cp = FP_CPREV + (size_t)bh * NCH * 16384 + e;
    for (int c0 = 0; c0 < NCH; c0 += 32) {
        float uu[32], un[32];
#pragma unroll
        for (int i = 0; i < 32; ++i) { uu[i] = Ub[(size_t)(c0 + i) * 16384]; un[i] = nthr ? FP_NU[(size_t)(bh * NCH + c0 + i) * 128 + tid] : 0.f; }
#pragma unroll
        for (int i = 0; i < 32; ++i) { const int c = c0 + i; const float fs = FP_ST[2 * (bh * NCH + c)], ml = FP_ST[2 * (bh * NCH + c) + 1];
            Cp[(size_t)c * 16384] = f2bf(C);
            if (nthr) FP_NPREV[(size_t)(bh * NCH + c) * 128 + tid] = nacc;
            if (j == 0 && tid == 0) FP_MPREV[bh * NCH + c] = m;
            const float mn = fs + fmaxf(m, ml), dec = __expf(fs + m - mn), sc = __expf(fs + ml - mn);
            C = dec * C + sc * uu[i]; nacc = dec * nacc + sc * un[i]; m = mn; }
    }
    FP_out[OFF_CP + (size_t)bh * 16384 + e] = C;
    if (nthr) FP_out[OFF_NP + bh * 128 + tid] = nacc;
    if (j == 0 && tid == 0) FP_out[OFF_MP + bh] = m;
}
__device__ __forceinline__ void glds16(const void* gsrc, unsigned lds_dst);
__device__ __forceinline__ void mlstm_C_group(const Frame& F, int grp) {
    const int tid_ = FTID(F);
    const int lane = tid_ & 63, wid = F.wave, r32 = lane & 31, hi = lane >> 5, ci = wid >> 2, tt = wid & 3;
    const int u = 2 * grp + ci, bh = u / NCH, c = u % NCH, b = bh >> 2, h = bh & 3, m0 = b * TP + c * CH;
    LAS unsigned char* Vt = F.lds + ci * 32768;
    LAS float* Fa = (LAS float*)(F.lds + 65536 + wid * 2048); LAS float* aa = Fa + 128; LAS float* Aa = aa + 128;
    {
        const unsigned lds0 = (unsigned)(uintptr_t)Vt;
#pragma unroll
        for (int k = 0; k < 8; ++k) { const int bb = 8 * tt + k, c4 = bb >> 3, kg = bb & 7;
            glds16(FP_Z + (size_t)(m0 + kg * 16 + (lane >> 2)) * ZP + ZV + h * 128 + c4 * 32 + (lane & 3) * 8, (unsigned)__builtin_amdgcn_readfirstlane(lds0 + bb * 1024)); }
    }
    {
        float F1, F2, a1, a2, A1, A2; chunk_scan(F, m0, h, lane, F1, F2, a1, a2, A1, A2);
        Fa[lane] = F1; Fa[64 + lane] = F2; aa[lane] = a1; aa[64 + lane] = a2; Aa[lane] = A1; Aa[64 + lane] = A2;
    }
    const int t = 32 * tt + r32;
    const float mprev = FP_MPREV[u];
    bf16x8 qf[8];
    { const bf16_t* qp = FP_Z + (size_t)(m0 + t) * ZP + ZQ + h * 128 + 8 * hi;
#pragma unroll
      for (int st = 0; st < 8; ++st) qf[st] = *(const bf16x8*)(qp + 16 * st); }
    const float Ft = Fa[t], At = Aa[t], mxt = fmaxf(mprev, At), mt = Ft + mxt, inter = __expf(mprev - mxt);
    float dq = 0.f;
    { const float* np = FP_NPREV + (size_t)u * 128 + 8 * hi;
#pragma unroll
      for (int st = 0; st < 8; ++st) { const f32x4 n0 = *(const f32x4*)(np + 16 * st), n1 = *(const f32x4*)(np + 16 * st + 4); f32x4 q0, q1; unpack8(__builtin_bit_cast(u32x4, qf[st]), q0, q1);
          dq += (q0.x * n0.x + q0.y * n0.y) + (q0.z * n0.z + q0.w * n0.w) + (q1.x * n1.x + q1.y * n1.y) + (q1.z * n1.z + q1.w * n1.w); } }
    dq += __shfl_xor(dq, 32);
    f32x16 acc[4];
#pragma unroll
    for (int vt = 0; vt < 4; ++vt) { for (int i = 0; i < 16; ++i) acc[vt][i] = 0.f;
        const bf16_t* cp = FP_CPREV + (size_t)u * 16384 + (size_t)(32 * vt + r32) * 128 + 8 * hi;
#pragma unroll
        for (int st = 0; st < 8; ++st) acc[vt] = MFMA32(*(const bf16x8*)(cp + 16 * st), qf[st], acc[vt]);
#pragma unroll
        for (int i = 0; i < 16; ++i) acc[vt][i] *= inter; }
    asm volatile("s_waitcnt vmcnt(0) lgkmcnt(0)\n\ts_barrier" ::: "memory");
    float den = 0.f;
    const int vh = (lane >> 4) & 1, q4 = (lane & 15) >> 2, p = lane & 3;
    const int vlane = (4 * hi + q4) * 64 + (16 * vh + 4 * p) * 2;
    for (int sub = 0; sub <= tt; ++sub) {
        f32x16 sacc; for (int i = 0; i < 16; ++i) sacc[i] = 0.f;
        { const bf16_t* kp = FP_Z + (size_t)(m0 + 32 * sub + r32) * ZP + ZK + h * 128 + 8 * hi;
#pragma unroll
          for (int st = 0; st < 8; ++st) sacc = MFMA32(*(const bf16x8*)(kp + 16 * st), qf[st], sacc); }
#pragma unroll
        for (int g = 0; g < 4; ++g) { const f32x4 av = *(const LAS f32x4*)(aa + 32 * sub + 8 * g + 4 * hi);
#pragma unroll
            for (int k = 0; k < 4; ++k) { const int sidx = 32 * sub + 8 * g + 4 * hi + k; const float wgt = (sidx <= t) ? __expf(av[k] - mxt) : 0.f; const float val = (sidx <= t) ? sacc[4 * g + k] * wgt : 0.f; sacc[4 * g + k] = val; den += val; } }
#pragma unroll
        for (int s2 = 0; s2 < 2; ++s2) {
            const bf16x8 pb = pack8((f32x4){sacc[8 * s2], sacc[8 * s2 + 1], sacc[8 * s2 + 2], sacc[8 * s2 + 3]}, (f32x4){sacc[8 * s2 + 4], sacc[8 * s2 + 5], sacc[8 * s2 + 6], sacc[8 * s2 + 7]});
            const LAS unsigned char* va = Vt + vlane + (2 * sub + s2) * 1024;
#pragma unroll
            for (int vt = 0; vt < 4; ++vt) acc[vt] = MFMA32(cat4(tr_rd(va + vt * 8192), tr_rd(va + vt * 8192 + 512)), pb, acc[vt]);
        }
    }
    den += __shfl_xor(den, 32);
    den += inter * dq;
    const float rden = 1.f / fmaxf(fabsf(den), __expf(-mt));
    float ss = 0.f;
#pragma unroll
    for (int vt = 0; vt < 4; ++vt) for (int i = 0; i < 16; ++i) { acc[vt][i] *= rden; ss += acc[vt][i] * acc[vt][i]; }
    ss += __shfl_xor(ss, 32);
    const float rms = rsqrtf(ss * (1.f / 128.f) + EPS);
#pragma unroll
    for (int vt = 0; vt < 4; ++vt)
#pragma unroll
        for (int g = 0; g < 4; ++g) { const int v = 32 * vt + 8 * g + 4 * hi;
            const f32x4 gv = *(const f32x4*)(FP_g_mlstm + h * 128 + v); const u32x2 mo = *(const u32x2*)(FP_Z + (size_t)(m0 + t) * ZP + ZO + h * 128 + v);
            u32x2 o; o.x = pk2(acc[vt][4 * g] * rms * gv.x * sigmoidf_(bflo(mo.x)), acc[vt][4 * g + 1] * rms * gv.y * sigmoidf_(bfhi(mo.x)));
            o.y = pk2(acc[vt][4 * g + 2] * rms * gv.z * sigmoidf_(bflo(mo.y)), acc[vt][4 * g + 3] * rms * gv.w * sigmoidf_(bfhi(mo.y)));
            *(u32x2*)(FP_HMD + (size_t)(m0 + t) * 1024 + h * 128 + v) = o; }
    asm volatile("s_waitcnt lgkmcnt(0)\n\ts_barrier" ::: "memory");
}
constexpr int AT_SLOT = 24576, AT_VOFF = 8192, AT_NSLOT = 4;
constexpr float AT_THR = 8.f;
__device__ __forceinline__ void glds16(const void* gsrc, unsigned lds_dst) { unsigned keep;
    asm volatile("s_mov_b32 %0, m0\n\ts_mov_b32 m0, %2\n\ts_nop 0\n\tglobal_load_lds_dwordx4 %1, off\n\ts_mov_b32 m0, %0" : "=&s"(keep) : "v"(gsrc), "s"(lds_dst) : "memory"); }
__device__ __forceinline__ float max3f(float a, float b, float c) { float r; asm("v_max3_f32 %0, %1, %2, %3" : "=v"(r) : "v"(a), "v"(b), "v"(c)); return r; }
#define AT_WAIT_BAR(N) asm volatile("s_waitcnt vmcnt(" #N ") lgkmcnt(0)\n\ts_barrier" ::: "memory")
__device__ __forceinline__ void attn_half_unit(const Frame& F, int bh, int qb, int map, bf16_t* Odst) {
    const int tid_ = FTID(F);
    const int b = bh >> 2, h = bh & 3, lane = tid_ & 63, wid = F.wave, r32 = lane & 31, hi = lane >> 5;
    const int rowbase = b * TP, q0 = qb * 256, qrow = q0 + 32 * wid + r32;
    const bf16_t* Zb = FP_Z + (size_t)rowbase * ZP;
    const unsigned lds0 = (unsigned)(uintptr_t)F.lds;
    const bf16_t* ksrc = Zb + (size_t)lane * ZP + ZDK + h * 128 + map * 64 + wid * 8;
    const bf16_t* vsrc0 = Zb + (size_t)(((2 * wid) & 3) * 16 + (lane >> 2)) * ZP + ZDV + h * 128 + ((2 * wid) >> 2) * 32 + (lane & 3) * 8;
    const bf16_t* vsrc1 = vsrc0 + (size_t)16 * ZP;
    const unsigned kdst = lds0 + wid * 1024, vdst = lds0 + AT_VOFF + 2 * wid * 1024;
#define AT_DMA(t, slot) do { const size_t adv_ = (size_t)(t) * 64 * ZP; const unsigned so_ = (unsigned)(slot) * AT_SLOT; \
        glds16(ksrc + adv_, (unsigned)__builtin_amdgcn_readfirstlane(kdst + so_)); glds16(vsrc0 + adv_, (unsigned)__builtin_amdgcn_readfirstlane(vdst + so_)); \
        glds16(vsrc1 + adv_, (unsigned)__builtin_amdgcn_readfirstlane(vdst + so_ + 1024u)); } while (0)
    bf16x8 qf[4];
    { const bf16_t* qp = Zb + (size_t)qrow * ZP + ZDQ + h * 128 + map * 64 + 8 * hi;
#pragma unroll
      for (int st = 0; st < 4; ++st) qf[st] = *(const bf16x8*)(qp + 16 * st); }
    const int NT = 4 * qb + 4;
    AT_DMA(0, 0); AT_DMA(1, 1); AT_DMA(2, 2);
    f32x16 o[4];
#pragma unroll
    for (int vt = 0; vt < 4; ++vt) for (int i = 0; i < 16; ++i) o[vt][i] = 0.f;
    f32x16 negm; for (int i = 0; i < 16; ++i) negm[i] = 0.f;
    float mhat = 0.f, lrun = 0.f;
    const int vh = (lane >> 4) & 1, q4 = (lane & 15) >> 2, p = lane & 3;
    const int vlane = AT_VOFF + (4 * hi + q4) * 64 + (16 * vh + 4 * p) * 2;
    const int klane = hi * 1024 + r32 * 16;
    const int wlast = q0 + 32 * wid + 31, wfirst = q0 + 32 * wid;
#define AT_SCHED() __builtin_amdgcn_sched_barrier(0)
#define AT_KRD(i0, kbase) do { kf[i0] = *(const LAS bf16x8*)((kbase) + ((i0) >> 1) * 2048 + ((i0) & 1) * 512); kf[(i0) + 1] = *(const LAS bf16x8*)((kbase) + (((i0) + 1) >> 1) * 2048 + (((i0) + 1) & 1) * 512); } while (0)
#define AT_VRD(dst, g, vbase) do { _Pragma("unroll") for (int vt = 0; vt < 4; ++vt) dst[vt] = cat4(tr_rd((vbase) + (g) * 1024 + vt * 4096), tr_rd((vbase) + (g) * 1024 + vt * 4096 + 512)); } while (0)
#define AT_PB(g) (((g) >> 1) == 0 ? pack8((f32x4){p0[8 * ((g) & 1)], p0[8 * ((g) & 1) + 1], p0[8 * ((g) & 1) + 2], p0[8 * ((g) & 1) + 3]}, (f32x4){p0[8 * ((g) & 1) + 4], p0[8 * ((g) & 1) + 5], p0[8 * ((g) & 1) + 6], p0[8 * ((g) & 1) + 7]}) \
                                  : pack8((f32x4){p1[8 * ((g) & 1)], p1[8 * ((g) & 1) + 1], p1[8 * ((g) & 1) + 2], p1[8 * ((g) & 1) + 3]}, (f32x4){p1[8 * ((g) & 1) + 4], p1[8 * ((g) & 1) + 5], p1[8 * ((g) & 1) + 6], p1[8 * ((g) & 1) + 7]}))
#define AT_PV(src, g) do { const bf16x8 pb_ = AT_PB(g); _Pragma("unroll") for (int vt = 0; vt < 4; ++vt) o[vt] = MFMA32(src[vt], pb_, o[vt]); } while (0)
    AT_WAIT_BAR(3);
    bf16x8 kf[8];
    { const LAS unsigned char* kb = F.lds + klane; AT_KRD(0, kb); AT_KRD(2, kb); AT_KRD(4, kb); AT_KRD(6, kb); }
    int slot = 0, slot1 = 1, slot3 = 3;
    for (int j = 0; j < NT; ++j) {
        if (j + 3 < NT) AT_DMA(j + 3, slot3);
        if (64 * j <= wlast) {
            const LAS unsigned char* vb = F.lds + slot * AT_SLOT + vlane;
            const LAS unsigned char* kn = F.lds + slot1 * AT_SLOT + klane;
            const bool knext = (j + 1 < NT);
            f32x16 p0 = MFMA32(kf[0], qf[0], negm), p1 = MFMA32(kf[1], qf[0], negm);
#pragma unroll
            for (int st = 1; st < 4; ++st) { p0 = MFMA32(kf[2 * st], qf[st], p0); p1 = MFMA32(kf[2 * st + 1], qf[st], p1); }
            AT_SCHED();
            bf16x8 vfA[4], vfB[4];
            AT_VRD(vfA, 0, vb);
            AT_SCHED();
            if (64 * j + 63 > wfirst) {
#pragma unroll
                for (int i = 0; i < 16; ++i) { const int key = 64 * j + crow(i, hi); if (key > qrow) p0[i] = -INFINITY; if (key + 32 > qrow) p1[i] = -INFINITY; }
            }
            asm volatile("s_nop 15\n\ts_nop 7" : "+v"(p0), "+v"(p1));
            float mx = max3f(p0[0], p1[0], p0[1]), mx2 = max3f(p1[1], p0[2], p1[2]);
#pragma unroll
            for (int i = 3; i < 15; i += 2) { mx = max3f(mx, p0[i], p1[i]); mx2 = max3f(mx2, p0[i + 1], p1[i + 1]); }
            mx = max3f(mx, p0[15], p1[15]); mx = fmaxf(mx, mx2);
            mx = fmaxf(mx, __shfl_xor(mx, 32));
            if (j == 0 || __any(mx > AT_THR)) {
                const float dl = (j == 0) ? mx : fmaxf(mx, 0.f), f = __builtin_amdgcn_exp2f(-dl);
                mhat += dl; lrun *= f;
#pragma unroll
                for (int i = 0; i < 16; ++i) { p0[i] -= dl; p1[i] -= dl; negm[i] = -mhat; }
#pragma unroll
                for (int vt = 0; vt < 4; ++vt) for (int i = 0; i < 16; ++i) o[vt][i] *= f;
            }
            float rsum = 0.f;
#pragma unroll
            for (int i = 0; i < 16; ++i) { p0[i] = __builtin_amdgcn_exp2f(p0[i]); p1[i] = __builtin_amdgcn_exp2f(p1[i]); rsum += p0[i] + p1[i]; }
            lrun += rsum;
            AT_SCHED();
            AT_VRD(vfB, 1, vb); if (knext) AT_KRD(0, kn); AT_SCHED(); AT_PV(vfA, 0); AT_SCHED();
            AT_VRD(vfA, 2, vb); if (knext) AT_KRD(2, kn); AT_SCHED(); AT_PV(vfB, 1); AT_SCHED();
            AT_VRD(vfB, 3, vb); if (knext) AT_KRD(4, kn); AT_SCHED(); AT_PV(vfA, 2); AT_SCHED();
            if (knext) AT_KRD(6, kn); AT_SCHED(); AT_PV(vfB, 3); AT_SCHED();
        }
        if (j + 3 < NT) AT_WAIT_BAR(3); else AT_WAIT_BAR(0);
        slot = slot1; slot1 = (slot1 == AT_NSLOT - 1) ? 0 : slot1 + 1; slot3 = (slot3 == AT_NSLOT - 1) ? 0 : slot3 + 1;
    }
#undef AT_SCHED
#undef AT_KRD
#undef AT_VRD
#undef AT_PB
#undef AT_PV
    lrun += __shfl_xor(lrun, 32);
    const float rl = 1.f / lrun;
    bf16_t* op = Odst + (size_t)(rowbase + qrow) * 512 + h * 128 + 4 * hi;
#pragma unroll
    for (int vt = 0; vt < 4; ++vt)
#pragma unroll
        for (int g = 0; g < 4; ++g) { u32x2 w; w.x = pk2(o[vt][4 * g] * rl, o[vt][4 * g + 1] * rl); w.y = pk2(o[vt][4 * g + 2] * rl, o[vt][4 * g + 3] * rl); *(u32x2*)(op + 32 * vt + 8 * g) = w; }
    AT_WAIT_BAR(0);
#undef AT_DMA
}
__device__ __forceinline__ float lambda_full(const Frame& F, int lane) {
    const float a = wave_sum(FP_lq1[lane] * FP_lk1[lane]), b = wave_sum(FP_lq2[lane] * FP_lk2[lane]);
    return __expf(a) - __expf(b) + LAM_INIT;
}
__device__ __forceinline__ void attn_combine_rows(const Frame& F) {
    const int lane = lane_id(), gw = F.vcu * NWAVES + F.wave, NGW = F.G * NWAVES;
    const float lam = lambda_full(F, lane);
    const f32x4 g0 = *(const f32x4*)(FP_g_diff + 8 * lane), g1 = *(const f32x4*)(FP_g_diff + 8 * lane + 4);
    for (int m = gw; m < MP; m += NGW) {
        f32x4 a0, a1, b0, b1; unpack8(*(const u32x4*)(FP_O1 + (size_t)m * 512 + 8 * lane), a0, a1); unpack8(*(const u32x4*)(FP_O2 + (size_t)m * 512 + 8 * lane), b0, b1);
        const f32x4 x0 = a0 - b0 * lam, x1 = a1 - b1 * lam;
        float ss = (x0.x * x0.x + x0.y * x0.y) + (x0.z * x0.z + x0.w * x0.w) + (x1.x * x1.x + x1.y * x1.y) + (x1.z * x1.z + x1.w * x1.w);
        ss += __shfl_xor(ss, 1); ss += __shfl_xor(ss, 2); ss += __shfl_xor(ss, 4); ss += __shfl_xor(ss, 8);
        const float rms = rsqrtf(ss * (1.f / 128.f) + EPS) * (1.f - LAM_INIT);
        *(bf16x8*)(FP_HMD + (size_t)m * 1024 + 512 + 8 * lane) = pack8(x0 * rms * g0, x1 * rms * g1);
    }
}
constexpr int SB_P = 264;
constexpr int DPART = 1040;
__device__ __forceinline__ void decode_unit(const Frame& F, int u) {
    const int tid_ = FTID(F);
    const int n = u >> 2, blk = u & 3, lane = tid_ & 63, wid = F.wave, h = wid & 3, qt = wid >> 2;
    const int mrow = MP + 4 * n;
    LAS float* Sb = (LAS float*)(F.lds + wid * 8704);
    LAS float* fac = Sb + 8 * SB_P;
    const int* pt = FP_page_table + n * NPAGES + 4 * blk + 2 * qt;
    const int c16 = lane & 15, g = lane >> 4, hh = lane >> 5, l5 = lane & 31, scol = lane >> 3, sseg = lane & 7;
    bf16x8 bq[4];
#pragma unroll
    for (int st = 0; st < 4; ++st) { const bool ok = (c16 < 4 && st < 2) || (c16 >= 4 && c16 < 8 && st >= 2);
        const bf16x8 v = *(const bf16x8*)(FP_Z + (size_t)(mrow + (c16 & 3)) * ZP + ZDQ + h * 128 + 32 * st + 8 * g);
        const bf16x8 zz = {0, 0, 0, 0, 0, 0, 0, 0}; bq[st] = ok ? v : zz; }
    const char* vpool = (const char*)FP_cache_v; const char* kpool = (const char*)FP_cache_k;
    const unsigned voff = (((unsigned)pt[hh] * PAGE) * 4u + (unsigned)h) * 512u + 16u * (unsigned)l5;
#define NTL(p) (*(const f32x4*)(p))
#define VLD(row) NTL(vpool + (voff + 2048u * (unsigned)(row)))
    f32x4 va[8], vb[8];
    {
        const unsigned ko0 = (((unsigned)pt[0] * PAGE + (unsigned)c16) * 4u + (unsigned)h) * 512u + 32u * (unsigned)g;
        const unsigned ko1 = (((unsigned)pt[1] * PAGE + (unsigned)c16) * 4u + (unsigned)h) * 512u + 32u * (unsigned)g;
        f32x4 ka[16], kb[16];
#define KLOAD(dst, ti) do { const unsigned ko_ = (((ti) < 8) ? ko0 : ko1) + 32768u * (unsigned)((ti) & 7); \
            _Pragma("unroll") for (int st = 0; st < 4; ++st) { dst[2 * st] = NTL(kpool + (ko_ + 128u * st)); dst[2 * st + 1] = NTL(kpool + (ko_ + 128u * st + 16u)); } } while (0)
#define KTILE(src, ti) do { f32x4 acc_ = {0.f, 0.f, 0.f, 0.f}; \
            _Pragma("unroll") for (int st = 0; st < 4; ++st) acc_ = MFMA16(pack8(src[2 * st], src[2 * st + 1]), bq[st], acc_); \
            if (c16 < 8) *(LAS f32x4*)(Sb + c16 * SB_P + 16 * (ti) + 4 * g) = acc_; } while (0)
        KLOAD(ka, 0); KLOAD((ka + 8), 1); KLOAD(kb, 2); KLOAD((kb + 8), 3);
        for (int ip = 0; ip < 12; ip += 4) {
            KTILE(ka, ip); KTILE((ka + 8), ip + 1); KLOAD(ka, ip + 4); KLOAD((ka + 8), ip + 5);
            KTILE(kb, ip + 2); KTILE((kb + 8), ip + 3); KLOAD(kb, ip + 6); KLOAD((kb + 8), ip + 7);
        }
        KTILE(ka, 12); KTILE((ka + 8), 13);
#pragma unroll
        for (int kk = 0; kk < 8; ++kk) va[kk] = VLD(kk);
        KTILE(kb, 14); KTILE((kb + 8), 15);
#pragma unroll
        for (int kk = 0; kk < 8; ++kk) vb[kk] = VLD(8 + kk);
#undef KLOAD
#undef KTILE
    }
    {
        LAS float* sp = Sb + scol * SB_P + 32 * sseg;
        f32x4 sv[8]; float mx = -INFINITY;
#pragma unroll
        for (int i = 0; i < 8; ++i) { sv[i] = *(const LAS f32x4*)(sp + 4 * i); mx = fmaxf(fmaxf(mx, fmaxf(sv[i].x, sv[i].y)), fmaxf(sv[i].z, sv[i].w)); }
        mx = fmaxf(mx, __shfl_xor(mx, 1)); mx = fmaxf(mx, __shfl_xor(mx, 2)); mx = fmaxf(mx, __shfl_xor(mx, 4));
        float ls = 0.f;
#pragma unroll
        for (int i = 0; i < 8; ++i) { f32x4 pv; pv.x = __builtin_amdgcn_exp2f(sv[i].x - mx); pv.y = __builtin_amdgcn_exp2f(sv[i].y - mx); pv.z = __builtin_amdgcn_exp2f(sv[i].z - mx); pv.w = __builtin_amdgcn_exp2f(sv[i].w - mx);
            ls += (pv.x + pv.y) + (pv.z + pv.w); *(LAS f32x4*)(sp + 4 * i) = pv; }
        ls += __shfl_xor(ls, 1); ls += __shfl_xor(ls, 2); ls += __shfl_xor(ls, 4);
        if (sseg == 0) { fac[scol] = mx; fac[8 + scol] = ls; }
    }
    {
        const LAS float* pbase = Sb + 128 * hh;
        f32x4 acc[8];
#pragma unroll
        for (int c = 0; c < 8; ++c) acc[c] = (f32x4){0.f, 0.f, 0.f, 0.f};
#define VSTEP(buf, t8) do { f32x4 vc_[8]; _Pragma("unroll") for (int kk = 0; kk < 8; ++kk) vc_[kk] = buf[kk]; \
            if ((t8) + 2 < 16) { _Pragma("unroll") for (int kk = 0; kk < 8; ++kk) buf[kk] = VLD(8 * ((t8) + 2) + kk); } \
            _Pragma("unroll") for (int c = 0; c < 8; ++c) { const f32x4 p0_ = *(const LAS f32x4*)(pbase + c * SB_P + 8 * (t8)), p1_ = *(const LAS f32x4*)(pbase + c * SB_P + 8 * (t8) + 4); \
                acc[c] += vc_[0] * p0_.x + vc_[1] * p0_.y + vc_[2] * p0_.z + vc_[3] * p0_.w + vc_[4] * p1_.x + vc_[5] * p1_.y + vc_[6] * p1_.z + vc_[7] * p1_.w; } } while (0)
        for (int t8 = 0; t8 < 16; t8 += 2) { VSTEP(va, t8); VSTEP(vb, t8 + 1); }
#undef VSTEP
        float* po = FP_DPART + ((size_t)(n * 4 + h) * 8 + (2 * blk + qt)) * DPART;
#pragma unroll
        for (int c = 0; c < 8; ++c) { acc[c].x += __shfl_xor(acc[c].x, 32); acc[c].y += __shfl_xor(acc[c].y, 32); acc[c].z += __shfl_xor(acc[c].z, 32); acc[c].w += __shfl_xor(acc[c].w, 32);
            if (hh == 0) *(f32x4*)(po + c * 128 + 4 * l5) = acc[c]; }
        if (lane < 16) po[1024 + lane] = fac[lane];
    }
#undef VLD
#undef NTL
}
__device__ __forceinline__ void decode_merge(const Frame& F, int u, float lam) {
    const int n = u >> 2, h = u & 3, lane = lane_id(), wid = F.wave, tid = wid * 64 + lane;
    const int mrow = MP + 4 * n;
    LAS float* Sn = (LAS float*)F.lds;
    LAS float* wgt = Sn + 32;
    LAS float* en = wgt + 64;
    LAS float* rlv = en + 32;
    LAS float* red = rlv + 8;
    const float* pp = FP_DPART + (size_t)u * 8 * DPART;
    if (wid == 0) {
        const int c16 = lane & 15, g = lane >> 4;
        f32x4 acc = {0.f, 0.f, 0.f, 0.f};
#pragma unroll
        for (int st = 0; st < 4; ++st) { const bool ok = (c16 < 4 && st < 2) || (c16 >= 4 && c16 < 8 && st >= 2);
            const bf16x8 zz = {0, 0, 0, 0, 0, 0, 0, 0};
            const bf16x8 qv = *(const bf16x8*)(FP_Z + (size_t)(mrow + (c16 & 3)) * ZP + ZDQ + h * 128 + 32 * st + 8 * g);
            const bf16x8 kv = *(const bf16x8*)(FP_Z + (size_t)(mrow + (c16 & 3)) * ZP + ZDK + h * 128 + 32 * st + 8 * g);
            const bf16x8 bqv = ok ? qv : zz, akv = (c16 < 4) ? kv : zz; acc = MFMA16(akv, bqv, acc); }
        if (g == 0 && c16 < 8) { const int t = c16 & 3; f32x4 m;
            m.x = acc.x; m.y = (1 <= t) ? acc.y : -INFINITY; m.z = (2 <= t) ? acc.z : -INFINITY; m.w = (3 <= t) ? acc.w : -INFINITY;
            *(LAS f32x4*)(Sn + 4 * c16) = m; }
    }
    WG_BAR();
    if (tid < 8) { const int c = tid; const f32x4 sn = *(const LAS f32x4*)(Sn + 4 * c);
        float mi[8]; float M = fmaxf(fmaxf(sn.x, sn.y), fmaxf(sn.z, sn.w));
#pragma unroll
        for (int i = 0; i < 8; ++i) { mi[i] = pp[i * DPART + 1024 + c]; M = fmaxf(M, mi[i]); }
        const f32x4 e = {__builtin_amdgcn_exp2f(sn.x - M), __builtin_amdgcn_exp2f(sn.y - M), __builtin_amdgcn_exp2f(sn.z - M), __builtin_amdgcn_exp2f(sn.w - M)};
        float L = (e.x + e.y) + (e.z + e.w);
#pragma unroll
        for (int i = 0; i < 8; ++i) { const float w = __builtin_amdgcn_exp2f(mi[i] - M); wgt[8 * i + c] = w; L += w * pp[i * DPART + 1032 + c]; }
        *(LAS f32x4*)(en + 4 * c) = e; rlv[c] = 1.f / L; }
    WG_BAR();
    { const int t = tid >> 7, v = tid & 127; float o1 = 0.f, o2 = 0.f;
#pragma unroll
      for (int i = 0; i < 8; ++i) { o1 += wgt[8 * i + t] * pp[i * DPART + t * 128 + v]; o2 += wgt[8 * i + 4 + t] * pp[i * DPART + (4 + t) * 128 + v]; }
#pragma unroll
      for (int sx = 0; sx < 4; ++sx) { const float vn = bf2f(FP_Z[(size_t)(mrow + sx) * ZP + ZDV + h * 128 + v]); o1 += en[4 * t + sx] * vn; o2 += en[4 * (4 + t) + sx] * vn; }
      const float ov = o1 * rlv[t] - lam * o2 * rlv[4 + t];
      const float ssw = wave_sum(ov * ov); if (lane == 0) red[wid] = ssw;
      WG_BAR();
      const float rms = rsqrtf((red[2 * t] + red[2 * t + 1]) * (1.f / 128.f) + EPS) * (1.f - LAM_INIT);
      FP_HMD[(size_t)(mrow + t) * 1024 + 512 + h * 128 + v] = f2bf(ov * rms * FP_g_diff[h * 128 + v]); }
    WG_BAR();
}
__device__ __forceinline__ void rows_post_mix(const Frame& F) {
    const int lane = lane_id(), gw = F.vcu * NWAVES + F.wave, NGW = F.G * NWAVES;
    const int r_lo = (int)(((long)gw * MT) / NGW), r_hi = (int)(((long)(gw + 1) * MT) / NGW);
    f32x4 gpm[4], gpf[4], g1[4], sh2[4], sc2[4], yn[4], xn[4];
#pragma unroll
    for (int j = 0; j < 4; ++j) { gpm[j] = *(const f32x4*)(FP_g_post_mix + 4 * lane + 256 * j); gpf[j] = *(const f32x4*)(FP_g_pre_ffn + 4 * lane + 256 * j); g1[j] = gpm[j]; sh2[j] = gpm[j]; sc2[j] = gpm[j]; yn[j] = gpm[j]; xn[j] = gpm[j]; }
    int ccur = -1;
    if (r_lo < r_hi) { const float* xr = xrow_of(F, r_lo); const bf16_t* yr = FP_Y + (size_t)r_lo * DM;
#pragma unroll
        for (int j = 0; j < 4; ++j) { { const u32x2 yy = *(const u32x2*)(yr + 4 * lane + 256 * j); yn[j] = (f32x4){bflo(yy.x), bfhi(yy.x), bflo(yy.y), bfhi(yy.y)}; } xn[j] = *(const f32x4*)(xr + 4 * lane + 256 * j); } }
    for (int m = r_lo; m < r_hi; ++m) {
        f32x4 y[4], x1[4]; float ss = 0.f;
#pragma unroll
        for (int j = 0; j < 4; ++j) { y[j] = yn[j]; x1[j] = xn[j]; }
        if (m + 1 < r_hi) { const float* xr = xrow_of(F, m + 1); const bf16_t* yr = FP_Y + (size_t)(m + 1) * DM;
#pragma unroll
            for (int j = 0; j < 4; ++j) { { const u32x2 yy = *(const u32x2*)(yr + 4 * lane + 256 * j); yn[j] = (f32x4){bflo(yy.x), bfhi(yy.x), bflo(yy.y), bfhi(yy.y)}; } xn[j] = *(const f32x4*)(xr + 4 * lane + 256 * j); } }
        const int cr = crow_of(m);
        if (cr != ccur) { ccur = cr; const float* ada = FP_ADA + (size_t)cr * 6144;
#pragma unroll
            for (int j = 0; j < 4; ++j) { const int c = 4 * lane + 256 * j; g1[j] = *(const f32x4*)(ada + 2048 + c) * gpm[j]; sh2[j] = *(const f32x4*)(ada + 3072 + c); sc2[j] = (*(const f32x4*)(ada + 4096 + c) + 1.f) * gpf[j]; } }
#pragma unroll
        for (int j = 0; j < 4; ++j) ss += (y[j].x * y[j].x + y[j].y * y[j].y) + (y[j].z * y[j].z + y[j].w * y[j].w);
        const float rs = rsqrtf(wave_sum(ss) * (1.f / DM) + EPS); float s1 = 0.f;
#pragma unroll
        for (int j = 0; j < 4; ++j) { const int c = 4 * lane + 256 * j;
            x1[j] = x1[j] + g1[j] * (y[j] * rs); { u32x2 xo; xo.x = pk2(x1[j].x, x1[j].y); xo.y = pk2(x1[j].z, x1[j].w); *(u32x2*)(FP_X1 + (size_t)m * DM + c) = xo; }
            s1 += (x1[j].x * x1[j].x + x1[j].y * x1[j].y) + (x1[j].z * x1[j].z + x1[j].w * x1[j].w); }
        const float r1 = rsqrtf(wave_sum(s1) * (1.f / DM) + EPS);
#pragma unroll
        for (int j = 0; j < 4; ++j) { const int c = 4 * lane + 256 * j;
            const f32x4 hv = (x1[j] * r1) * sc2[j] + sh2[j]; u32x2 o; o.x = pk2(hv.x, hv.y); o.y = pk2(hv.z, hv.w); *(u32x2*)(FP_H1 + (size_t)m * DM + c) = o; }
    }
}
__device__ __forceinline__ void rows_final(const Frame& F) {
    const int lane = lane_id(), gw = F.vcu * NWAVES + F.wave, NGW = F.G * NWAVES;
    const int r_lo = (int)(((long)gw * MT) / NGW), r_hi = (int)(((long)(gw + 1) * MT) / NGW);
    f32x4 gpf[4], g2[4], yn[4], xn[4];
#pragma unroll
    for (int j = 0; j < 4; ++j) { gpf[j] = *(const f32x4*)(FP_g_post_ffn + 4 * lane + 256 * j); g2[j] = gpf[j]; yn[j] = gpf[j]; xn[j] = gpf[j]; }
    int ccur = -1;
    if (r_lo < r_hi) { const bf16_t* xr = FP_X1 + (size_t)r_lo * DM; const bf16_t* yr = FP_Y + (size_t)r_lo * DM;
#pragma unroll
        for (int j = 0; j < 4; ++j) { { const u32x2 yy = *(const u32x2*)(yr + 4 * lane + 256 * j); yn[j] = (f32x4){bflo(yy.x), bfhi(yy.x), bflo(yy.y), bfhi(yy.y)}; } { const u32x2 xx = *(const u32x2*)(xr + 4 * lane + 256 * j); xn[j] = (f32x4){bflo(xx.x), bfhi(xx.x), bflo(xx.y), bfhi(xx.y)}; } } }
    for (int m = r_lo; m < r_hi; ++m) {
        f32x4 y[4], x1[4]; float ss = 0.f;
#pragma unroll
        for (int j = 0; j < 4; ++j) { y[j] = yn[j]; x1[j] = xn[j]; }
        if (m + 1 < r_hi) { const bf16_t* xr = FP_X1 + (size_t)(m + 1) * DM; const bf16_t* yr = FP_Y + (size_t)(m + 1) * DM;
#pragma unroll
            for (int j = 0; j < 4; ++j) { { const u32x2 yy = *(const u32x2*)(yr + 4 * lane + 256 * j); yn[j] = (f32x4){bflo(yy.x), bfhi(yy.x), bflo(yy.y), bfhi(yy.y)}; } { const u32x2 xx = *(const u32x2*)(xr + 4 * lane + 256 * j); xn[j] = (f32x4){bflo(xx.x), bfhi(xx.x), bflo(xx.y), bfhi(xx.y)}; } } }
        const int cr = crow_of(m);
        if (cr != ccur) { ccur = cr; const float* ada = FP_ADA + (size_t)cr * 6144;
#pragma unroll
            for (int j = 0; j < 4; ++j) g2[j] = *(const f32x4*)(ada + 5120 + 4 * lane + 256 * j) * gpf[j]; }
#pragma unroll
        for (int j = 0; j < 4; ++j) ss += (y[j].x * y[j].x + y[j].y * y[j].y) + (y[j].z * y[j].z + y[j].w * y[j].w);
        const float rs = rsqrtf(wave_sum(ss) * (1.f / DM) + EPS);
#pragma unroll
        for (int j = 0; j < 4; ++j) *(f32x4*)(FP_out + OFF_Y + (size_t)m * DM + 4 * lane + 256 * j) = x1[j] + g2[j] * (y[j] * rs);
    }
}
__device__ __forceinline__ void attention_phase(const Frame& F, volatile LAS unsigned* MISC) {
    unsigned* ctl = (unsigned*)(F.a->ws + WS_CTL) + CW_SCHED;
    const int xq = (F.vcu * 8) / F.G;
    for (;;) {
        if (FTID(F) == 0) {
            int kind = -1; unsigned idx = 0u;
            unsigned* QD = ctl + 64 * 8; unsigned* NS = ctl + 64 * (9 + xq);
            if (xb_ld(QD) < 512u) { const unsigned sn = xb_add(NS, 1u);
                if (sn < (unsigned)DEC_LIM8) { const unsigned d = xb_add(QD, 1u); if (d < 512u) { kind = 1; idx = d; } }
                if (kind < 0) (void)__hip_atomic_fetch_sub(NS, 1u, __ATOMIC_RELAXED, __HIP_MEMORY_SCOPE_AGENT); }
            for (int k = 0; k < 8 && kind < 0; ++k) { const int x = (xq + k) & 7; unsigned* QP = ctl + 64 * x;
                if (xb_ld(QP) < 64u) { const unsigned p = xb_add(QP, 1u); if (p < 64u) { kind = 0; idx = (unsigned)x * 64u + p; } } }
            if (kind < 0) { const unsigned d = xb_add(QD, 1u); if (d < 512u) { kind = 2; idx = d; } }
            MISC[0] = (unsigned)kind; MISC[1] = idx;
        }
        WG_BAR();
        const int kind = (int)MISC[0]; const int idx = (int)MISC[1];
        WG_BAR();
        if (kind < 0) break;
        if (kind == 0) { const int bh = idx >> 6, j = idx & 63, qb = 31 - (j >> 1), map = j & 1; attn_half_unit(F, bh, qb, map, map ? FP_O2 : FP_O1); }
        else { decode_unit(F, idx); asm volatile("s_waitcnt vmcnt(0) lgkmcnt(0)\n\ts_barrier" ::: "memory");
               if (kind == 1 && FTID(F) == 0) (void)__hip_atomic_fetch_sub(ctl + 64 * (9 + xq), 1u, __ATOMIC_RELAXED, __HIP_MEMORY_SCOPE_AGENT); }
    }
}

constexpr int NPHASE = 15;
#ifndef DUPMASK
#define DUPMASK 0
#endif
#ifndef PROBE_MASK
#define PROBE_MASK 0
#endif
__global__ void __launch_bounds__(NTHR, 2) fwd_kernel(Args args) {
    extern __shared__ __attribute__((aligned(16))) unsigned char lds_raw[];
    Frame F;
    F.lds = (LAS unsigned char*)lds_raw;
    F.wave = __builtin_amdgcn_readfirstlane((int)threadIdx.x >> 6);
    F.G = gridDim.x; { const int bx = blockIdx.x; F.vcu = (F.G % 8 == 0) ? (bx % 8) * (F.G / 8) + bx / 8 : bx; }
    F.a = &args; unsigned char* ws = args.ws;
    volatile LAS unsigned* MISC = (volatile LAS unsigned*)(F.lds + MISC_OFF);
    for (int u = FTID(F); u < (LDS_BYTES - RING_BYTES) / 4; u += NTHR) ((LAS unsigned*)(F.lds + RING_BYTES))[u] = 0u;
    __syncthreads();
    const int lo = args.ph_lo, hi = args.ph_hi;
    const bool multi = (hi - lo) > 1;
    XcdBarrier bar; bar.bar = (unsigned*)(ws + WS_CTL) + CW_BAR; bar.x = 0; bar.st = nullptr; bar.wave = F.wave;
    if (multi) bar = xcd_barrier_post((unsigned*)(ws + WS_CTL) + CW_BAR, MISC + 8, F.wave);
#define IN(k) (lo <= (k) && (k) < hi)
    unsigned long long pr_t0 = 0ull, pr_acc = 0ull;
#define PST(k) do { if ((PROBE_MASK >> (k)) & 1) pr_t0 = __builtin_amdgcn_s_memrealtime(); } while (0)
#define PEN(k) do { if ((PROBE_MASK >> (k)) & 1) pr_acc += __builtin_amdgcn_s_memrealtime() - pr_t0; } while (0)
#define SEAM(k) do { if (IN(k) && IN((k) + 1)) xcd_barrier(bar); } while (0)

#define DUP(k, ...) do { { __VA_ARGS__ } if ((DUPMASK >> (k)) & 1) { __VA_ARGS__ } } while (0)
    PST(0);
    if (IN(0)) { PST(15); p0_ada(F); PEN(15); p0_transposes(F); } SEAM(0); PEN(0);
    PST(1);
    if (IN(1)) { DUP(1,  p1_norm_gates(F); WG_BAR(); ); } SEAM(1); PEN(1);
    PST(2);
    if (IN(2)) { DUP(2,  pg8::Gemm g{FP_H1, FP_WinT, MT, ZN, DM, DM}; pg8::StaticOrder S; S.init(MT, ZN, F.G, (int)blockIdx.x); EpiZ E{FP_Z, FP_out, FP_IG, FP_LF, FP_b_if}; pg8::gemm_phase(F.lds, g, S, E, F.wave); ); } SEAM(2); PEN(2);
    PST(3);
    if (IN(3)) { DUP(3,  for (int u = F.vcu; u < 8 * NCH; u += F.G) mlstm_A_unit(F, u);
                 for (int u = F.vcu; u < 512; u += F.G) smlstm_unit(F, u); ); } SEAM(3); PEN(3);
    PST(4);
    PEN(4);
    PST(5);
    if (IN(5)) { for (int it = F.vcu; it < 256; it += F.G) mlstm_scan_item(F, it);
                 attention_phase(F, MISC); } SEAM(5); PEN(5);
    PST(6);
    if (IN(6)) { DUP(6,  for (int grp = F.vcu; grp < 256; grp += F.G) mlstm_C_group(F, grp);
                 attn_combine_rows(F);
                 { const float lam = lambda_full(F, lane_id()); for (int u = F.vcu; u < 512; u += F.G) decode_merge(F, u, lam); } ); } SEAM(6); PEN(6);
    PST(7);
    if (IN(7)) { DUP(7,  pg8::Gemm g{FP_HMD, FP_WpT, MP, DM, 512, DM}; pg8::StaticOrder S; S.init(MP, DM, F.G, (int)blockIdx.x); EpiPMD E{FP_Z, FP_MG}; pg8::gemm_phase<EpiPMD, true>(F.lds, g, S, E, F.wave);
                 skinny_gemm<true>(F, FP_HMD + (size_t)MP * DM, FP_WpT, DM, E); ); } SEAM(7); PEN(7);
    PST(8);
    PEN(8);
    PST(9);
    if (IN(9)) { DUP(9,  pg8::Gemm g{FP_MG, FP_WoutT, MP, DM, DM, DM}; pg8::StaticOrder S; S.init(MP, DM, F.G, (int)blockIdx.x); EpiF32 E{FP_Y}; pg8::gemm_phase(F.lds, g, S, E, F.wave);
                 skinny_gemm<false>(F, FP_MG + (size_t)MP * DM, FP_WoutT, DM, E); ); } SEAM(9); PEN(9);
    PST(10);
    if (IN(10)) { DUP(10,  rows_post_mix(F); ); } SEAM(10); PEN(10);
    PST(11);
    if (IN(11)) { DUP(11,  pg8::Gemm g{FP_H1, FP_WupT, MT, 2 * DFF, DM, DM}; pg8::StaticOrder S; S.init(MT, 2 * DFF, F.G, (int)blockIdx.x);
                  EpiUpG E{FP_GB, FP_out, FP_conv_w, FP_conv_b, FP_state_conv, FP_AH, FP_AF, FP_BF}; pg8::gemm_phase(F.lds, g, S, E, F.wave); ); } SEAM(11); PEN(11);
    PST(12);
    PEN(12);
    PST(13);
    if (IN(13)) { DUP(13,  pg8::Gemm g{FP_GB, FP_WdownT, MP, DM, DFF, DFF}; pg8::StaticOrder S; S.init(MP, DM, F.G, (int)blockIdx.x); EpiF32 E{FP_Y};
                  { pg8::Unit u0; for (int i = 0; S.next(i, u0); ++i) geglu_fixup(F, u0.pm); }
                  pg8::gemm_phase(F.lds, g, S, E, F.wave);
                  skinny_gemm<false>(F, FP_GB + (size_t)MP * DFF, FP_WdownT, DFF, E); ); } SEAM(13); PEN(13);
    PST(14);
    if (IN(14)) { rows_final(F); } PEN(14);
#undef DUP
    if (PROBE_MASK != 0 && blockIdx.x == 0 && FTID(F) == 0) { const unsigned long long t0 = __builtin_amdgcn_s_memrealtime(); while (__builtin_amdgcn_s_memrealtime() - t0 < pr_acc) __builtin_amdgcn_s_sleep(8); }
#undef IN
#undef SEAM
}

#ifndef MK_ONE_LAUNCH
#define MK_ONE_LAUNCH 1
#endif
extern "C" void kernel_launch(void* const* d_in, const int* in_sizes, int n_in, void* d_out, int out_size, void* d_ws, size_t ws_size, hipStream_t stream) {
    static int grid = 0;
    if (grid == 0) {
        if (n_in != 32 || out_size != (int)OUT_TOTAL || ws_size < WS_END) { fprintf(stderr, "kernel_launch: unexpected sizes n_in %d out %d ws %zu\n", n_in, out_size, ws_size); grid = -1; return; }
        int dev = 0, cus = 0, per_cu = 0;
        if (hipGetDevice(&dev) != hipSuccess || hipDeviceGetAttribute(&cus, hipDeviceAttributeMultiprocessorCount, dev) != hipSuccess) { grid = -1; return; }
        if (hipFuncSetAttribute((const void*)fwd_kernel, hipFuncAttributeMaxDynamicSharedMemorySize, LDS_BYTES) != hipSuccess) { fprintf(stderr, "kernel_launch: hipFuncSetAttribute failed\n"); grid = -1; return; }
        if (hipOccupancyMaxActiveBlocksPerMultiprocessor(&per_cu, (const void*)fwd_kernel, NTHR, LDS_BYTES) != hipSuccess || per_cu < 1) fprintf(stderr, "kernel_launch: occupancy query reports %d\n", per_cu);
        (void)hipGetLastError();
        grid = cus;
    }
    if (grid < 0) return;
    if (hipMemsetAsync((char*)d_ws + WS_CTL, 0, CTL_ZERO_BYTES, stream) != hipSuccess) return;
    Args a{};
    for (int i = 0; i < 32; ++i) a.in[i] = d_in[i];
    a.out = (float*)d_out; a.ws = (unsigned char*)d_ws;
#if MK_ONE_LAUNCH
    a.ph_lo = 0; a.ph_hi = NPHASE;
    hipLaunchKernelGGL(fwd_kernel, dim3(grid), dim3(NTHR), LDS_BYTES, stream, a);
#else
    for (int p = 0; p < NPHASE; ++p) { a.ph_lo = p; a.ph_hi = p + 1; hipLaunchKernelGGL(fwd_kernel, dim3(grid), dim3(NTHR), LDS_BYTES, stream, a); }
#endif
}
```

```cpp
#include <hip/hip_runtime.h>
#include <cstdio>
#include <cstdint>

#define LAS __attribute__((address_space(3)))
#define GAS __attribute__((address_space(1)))
typedef unsigned short bf16_t;
typedef short bf16x8 __attribute__((ext_vector_type(8)));
typedef short s16x4 __attribute__((ext_vector_type(4)));
typedef short v4i16_t __attribute__((ext_vector_type(4)));
typedef float f32x2 __attribute__((ext_vector_type(2)));
typedef float f32x4 __attribute__((ext_vector_type(4)));
typedef float f32x16 __attribute__((ext_vector_type(16)));
typedef unsigned u32x2 __attribute__((ext_vector_type(2)));
typedef unsigned u32x4 __attribute__((ext_vector_type(4)));
typedef __bf16 bf16x2_t __attribute__((ext_vector_type(2)));
typedef GAS unsigned gu32;

constexpr int DM = 1024, TP = 8192, MP = 16384, MS = 512, MT = MP + MS;
constexpr int NSEQ = 128, TS = 4, NPAGES = 16, PAGE = 128, PAST = 2048;
constexpr int DIN = 5640, ZP = 5632, ZN = 5888, DFF = 2816;
constexpr int ZQ = 0, ZK = 512, ZV = 1024, ZO = 1536, ZDQ = 2048, ZDK = 2560, ZDV = 3072, ZGM = 3584, ZGD = 4608;
__host__ __device__ constexpr size_t zbase(int col) { return (size_t)(col >> 8) * MT * 256 + (size_t)(col & 255); }
constexpr int ZR = 256;
constexpr float EPS = 1e-6f, LAM_INIT = 0.2f, LOG2E = 1.4426950408889634f;
constexpr float QSCALE = 0.125f * LOG2E;
constexpr float KSCALE = 0.08838834764831845f;
constexpr size_t OFF_Y = 0, OFF_KP = 17301504, OFF_VP = 25690112, OFF_CP = 34078720, OFF_NP = 34209792, OFF_MP = 34210816, OFF_CVP = 34210824,
                 OFF_KS = 34222088, OFF_VS = 34484232, OFF_CS = 34746376, OFF_NS = 43134984, OFF_MS = 43200520, OFF_CVS = 43201032, OUT_TOTAL = 43921928;
constexpr size_t MiB = 1u << 20;
constexpr size_t WS_CTL = 0, CTL_ZERO_BYTES = 65536;
constexpr size_t WS_WIN = 639 * MiB  , WS_WUP = 12 * MiB, WS_WDOWN = 23 * MiB, WS_WOUT = 29 * MiB, WS_WPM = 31 * MiB, WS_WPD = 32 * MiB;
constexpr size_t WS_ADA = 33 * MiB, WS_IG = 37 * MiB, WS_LF = 37 * MiB + 512 * 1024, WS_ST = 38 * MiB, WS_NU = 38 * MiB + 65536, WS_NPREV = 39 * MiB, WS_MPREV = 39 * MiB + 768 * 1024;
constexpr size_t WS_H1 = 40 * MiB, WS_Z = 73 * MiB, WS_U = 255 * MiB, WS_CPREV = 319 * MiB, WS_HM = 351 * MiB, WS_HD = 368 * MiB, WS_O1 = 385 * MiB, WS_O2 = 417 * MiB;
constexpr size_t WS_MG = 449 * MiB, WS_Y = 482 * MiB, WS_UA = 548 * MiB, WS_UB = 639 * MiB, WS_G = 730 * MiB, WS_DPART = 821 * MiB, WS_END = 838 * MiB;
constexpr int CW_BAR = 4096, CW_SCHED = 8192;
#ifndef DEC_LIM8
#define DEC_LIM8 10
#endif
constexpr int RING_BYTES = 131072, MISC_OFF = RING_BYTES + 320, LDS_BYTES = 147456;
constexpr int NWAVES = 8, NTHR = 512;

__device__ __forceinline__ unsigned pk2(float lo, float hi) { f32x2 v = {lo, hi}; bf16x2_t b = __builtin_convertvector(v, bf16x2_t); return __builtin_bit_cast(unsigned, b); }
__device__ __forceinline__ bf16_t f2bf(float x) { return (bf16_t)(pk2(x, 0.f) & 0xffffu); }
__device__ __forceinline__ float bflo(unsigned u) { return __uint_as_float(u << 16); }
__device__ __forceinline__ float bfhi(unsigned u) { return __uint_as_float(u & 0xffff0000u); }
__device__ __forceinline__ float bf2f(bf16_t u) { return __uint_as_float(((unsigned)u) << 16); }
__device__ __forceinline__ bf16x8 pack8(f32x4 a, f32x4 b) { u32x4 w; w.x = pk2(a.x, a.y); w.y = pk2(a.z, a.w); w.z = pk2(b.x, b.y); w.w = pk2(b.z, b.w); return __builtin_bit_cast(bf16x8, w); }
__device__ __forceinline__ void unpack8(u32x4 w, f32x4& a, f32x4& b) { a.x = bflo(w.x); a.y = bfhi(w.x); a.z = bflo(w.y); a.w = bfhi(w.y); b.x = bflo(w.z); b.y = bfhi(w.z); b.z = bflo(w.w); b.w = bfhi(w.w); }
__device__ __forceinline__ float wave_sum(float v) {
#pragma unroll
    for (int o = 1; o < 64; o <<= 1) v += __shfl_xor(v, o);
    return v;
}
__device__ __forceinline__ float wave_max(float v) {
#pragma unroll
    for (int o = 1; o < 64; o <<= 1) v = fmaxf(v, __shfl_xor(v, o));
    return v;
}
__device__ __forceinline__ float wave_scan_sum(float v, int lane) {
#pragma unroll
    for (int o = 1; o < 64; o <<= 1) { const float t = __shfl_up(v, o); if (lane >= o) v += t; }
    return v;
}
__device__ __forceinline__ float wave_scan_max(float v, int lane) {
#pragma unroll
    for (int o = 1; o < 64; o <<= 1) { const float t = __shfl_up(v, o); if (lane >= o) v = fmaxf(v, t); }
    return v;
}
__device__ __forceinline__ float sigmoidf_(float x) { return __builtin_amdgcn_rcpf(1.f + __builtin_amdgcn_exp2f(-x * LOG2E)); }
__device__ __forceinline__ float log_sigmoid(float x) { return fminf(x, 0.f) - log1pf(__expf(-fabsf(x))); }
__device__ __forceinline__ int crow(int reg, int h) { return (reg & 3) + 8 * (reg >> 2) + 4 * h; }
#define MFMA32(a, b, c) __builtin_amdgcn_mfma_f32_32x32x16_bf16((a), (b), (c), 0, 0, 0)
#define MFMA16(a, b, c) __builtin_amdgcn_mfma_f32_16x16x32_bf16((a), (b), (c), 0, 0, 0)
__device__ __forceinline__ s16x4 tr_rd(const LAS unsigned char* p) { return __builtin_bit_cast(s16x4, __builtin_amdgcn_ds_read_tr16_b64_v4i16((LAS v4i16_t*)p)); }
__device__ __forceinline__ bf16x8 cat4(s16x4 lo, s16x4 hi) { return (bf16x8){lo[0], lo[1], lo[2], lo[3], hi[0], hi[1], hi[2], hi[3]}; }
#define WG_BAR() __syncthreads()
__device__ __forceinline__ int lane_id() { int l; asm volatile("v_mbcnt_lo_u32_b32 %0, -1, 0\n\tv_mbcnt_hi_u32_b32 %0, -1, %0" : "=v"(l)); return l; }
#define FTID(F) ((F).wave * 64 + lane_id())

namespace pg8 {
constexpr int BM = 256, BK = 64, HALF = 128, HTB = HALF * BK * 2, STAGE_BYTES = 8 * HTB, NXCD = 8, WGM = 8;
__host__ __device__ __forceinline__ int lds_byte(int r, int c) { const int st = (r >> 4) * 2 + (c >> 5), rr = r & 15, cc = c & 31, ob = rr * 64 + cc * 2; return st * 1024 + (ob ^ (((ob >> 9) & 1) << 5)); }
__host__ __device__ __forceinline__ void stage_rc(int b, int& R, int& C) { const int st = b / 1024, sb = b % 1024, swz = sb ^ (((sb >> 9) & 1) << 5); R = (st >> 1) * 16 + swz / 64; C = (st & 1) * 32 + (swz % 64) / 2; }
__host__ __device__ __forceinline__ int perm32(int rho) { const int n = rho >> 4, i = rho & 15; return 8 * (i >> 2) + 4 * n + (i & 3); }
struct Unit { int pm, pn, half; };
struct Gemm { const bf16_t* A; const bf16_t* Bt; int M, N, K, ld; };
struct StaticOrder {
    int nM, nN, nwg, G, c;
    __host__ __device__ __forceinline__ void init(int M, int N, int G_, int c_) { nM = M / BM; nN = N / BM; nwg = nM * nN; G = G_; c = c_; }
    __host__ __device__ __forceinline__ bool next(int i, Unit& u) const {
        const long L = (long)i * G + c; if (L >= nwg) return false;
        int wgid = (int)L; { const int q = nwg / NXCD, r = nwg % NXCD, xcd = wgid % NXCD, off = wgid / NXCD; wgid = (xcd < r ? xcd * (q + 1) : r * (q + 1) + (xcd - r) * q) + off; }
        const int nig = WGM * nN, gid = wgid / nig, fm = gid * WGM, gsz = (nM - fm) < WGM ? (nM - fm) : WGM;
        u.pm = fm + ((wgid % nig) % gsz); u.pn = (wgid % nig) / gsz; u.half = 0; return true;
    }
};
template <class Epi, bool SPLIT2 = false>
__device__ __forceinline__ void gemm_phase(LAS unsigned char* lds, const Gemm g, const StaticOrder& S, const Epi& E, int wave) {
    const int wid = wave, lane = lane_id(), tid = wid * 64 + lane, wr = wid >> 2, wc = wid & 3, fr = lane & 15, fq = lane >> 4;
    const int K = g.K, nt = K / BK, LD = g.ld;
    unsigned voffA[2], voffB[2];
#pragma unroll
    for (int i = 0; i < 2; ++i) { int R, C; stage_rc(tid * 16 + i * 8192, R, C); const int Rb = (R & ~31) + perm32(R & 31);
        voffA[i] = (unsigned)(R * LD + C) * 2u; voffB[i] = (unsigned)(Rb * LD + C) * 2u; }
    const size_t kstep = (size_t)(BK * 2);
    const size_t hstep = (size_t)HALF * LD * 2;
    const size_t tstep = 2 * hstep;
    const unsigned ldsw = (unsigned)wid * 1024u;
    const int aoff = lds_byte(wr * 64 + fr, fq * 8), boff = lds_byte(wc * 32 + fr, fq * 8);
#define PG8_SA(b, h) (((b) * 2 + (h)) * HTB)
#define PG8_SB(b, h) ((4 + (b) * 2 + (h)) * HTB)
#define PG8_STAGE(bufoff, gbase, voff) do { _Pragma("unroll") for (int _i = 0; _i < 2; ++_i) \
        __builtin_amdgcn_global_load_lds((const unsigned*)((const char*)(gbase) + (voff)[_i]), (LAS unsigned*)(lds + (bufoff) + ldsw + _i * 8192), 16, 0, 0); } while (0)
#define PG8_LDA(dst, b, h) do { _Pragma("unroll") for (int m = 0; m < 4; ++m) _Pragma("unroll") for (int k = 0; k < 2; ++k) dst[m][k] = *(const LAS bf16x8*)(lds + PG8_SA(b, h) + aoff + m * 2048 + k * 1024); } while (0)
#define PG8_LDB(dst, b, h) do { _Pragma("unroll") for (int n = 0; n < 2; ++n) _Pragma("unroll") for (int k = 0; k < 2; ++k) dst[n][k] = *(const LAS bf16x8*)(lds + PG8_SB(b, h) + boff + n * 2048 + k * 1024); } while (0)
#define PG8_MMA(ai, bj, At, Bt) do { __builtin_amdgcn_s_setprio(1); _Pragma("unroll") for (int m = 0; m < 4; ++m) _Pragma("unroll") for (int n = 0; n < 2; ++n) _Pragma("unroll") for (int k = 0; k < 2; ++k) \
        acc[ai][bj][m][n] = __builtin_amdgcn_mfma_f32_16x16x32_bf16(Bt[n][k], At[m][k], acc[ai][bj][m][n], 0, 0, 0); __builtin_amdgcn_s_setprio(0); } while (0)
#define PG8_WAIT_V(n) asm volatile("s_waitcnt vmcnt(" #n ")" ::: "memory")
#define PG8_WAIT_L(n) asm volatile("s_waitcnt lgkmcnt(" #n ")" ::: "memory")
#define PG8_BAR __builtin_amdgcn_s_barrier()
#define PG8_SCHED __builtin_amdgcn_sched_barrier(0)
#define PG8_NEXT(i, u) (SPLIT2 ? (S.next((i) >> 1, u) ? ((u).half = (i) & 1, true) : false) : S.next((i), u))
#define PG8_UA(u) ((const char*)g.A + (size_t)(u).pm * tstep + (size_t)(u).half * K * 2)
#define PG8_UB(u) ((const char*)g.Bt + (size_t)(u).pn * tstep + (size_t)(u).half * K * 2)
    Unit cur, nxt; int ui = 0;
    if (!PG8_NEXT(0, cur)) return;
    f32x4 acc[2][2][4][2];
#pragma unroll
    for (int a = 0; a < 2; ++a)
#pragma unroll
        for (int b = 0; b < 2; ++b)
#pragma unroll
            for (int m = 0; m < 4; ++m)
#pragma unroll
                for (int n = 0; n < 2; ++n) acc[a][b][m][n] = (f32x4){0.f, 0.f, 0.f, 0.f};
    bf16x8 At[4][2], B0[2][2], B1[2][2];
    const char* cA = PG8_UA(cur); const char* cB = PG8_UB(cur);
    PG8_STAGE(PG8_SB(0, 0), cB, voffB); PG8_STAGE(PG8_SB(0, 1), cB + hstep, voffB); PG8_STAGE(PG8_SA(0, 0), cA, voffA); PG8_STAGE(PG8_SA(0, 1), cA + hstep, voffA);
    if (wr == 1) PG8_BAR;
    PG8_WAIT_V(2); PG8_BAR;
    PG8_STAGE(PG8_SB(1, 0), cB + kstep, voffB); PG8_STAGE(PG8_SA(1, 0), cA + kstep, voffA); PG8_STAGE(PG8_SB(1, 1), cB + hstep + kstep, voffB);
    PG8_WAIT_V(6); PG8_BAR;
    for (;;) {
        const bool has_next = PG8_NEXT(ui + 1, nxt);
        const char* nA = has_next ? PG8_UA(nxt) : cA; const char* nB = has_next ? PG8_UB(nxt) : cB;
        for (int t = 0; t < nt; t += 2) {
            const bool last = (t == nt - 2);
            const char* a1 = cA + (size_t)(t + 1) * kstep;
            const char* a2 = last ? nA : cA + (size_t)(t + 2) * kstep; const char* b2 = last ? nB : cB + (size_t)(t + 2) * kstep;
            const char* a3 = a2 + kstep; const char* b3 = b2 + kstep;
            PG8_LDB(B0, 0, 0); PG8_LDB(B1, 0, 1); PG8_SCHED; PG8_LDA(At, 0, 0); PG8_STAGE(PG8_SA(1, 1), a1 + hstep, voffA);
            PG8_WAIT_V(8); PG8_WAIT_L(0); PG8_BAR; PG8_MMA(0, 0, At, B0); PG8_MMA(0, 1, At, B1); PG8_BAR; PG8_SCHED;
            PG8_LDA(At, 0, 1); PG8_STAGE(PG8_SB(0, 0), b2, voffB); PG8_STAGE(PG8_SB(0, 1), b2 + hstep, voffB); PG8_STAGE(PG8_SA(0, 0), a2, voffA);
            PG8_WAIT_V(8); PG8_WAIT_L(0); PG8_BAR; PG8_MMA(1, 0, At, B0); PG8_MMA(1, 1, At, B1); PG8_BAR; PG8_SCHED;
            PG8_LDB(B0, 1, 0); PG8_LDB(B1, 1, 1); PG8_SCHED; PG8_LDA(At, 1, 0); PG8_STAGE(PG8_SA(0, 1), a2 + hstep, voffA);
            PG8_WAIT_V(8); PG8_WAIT_L(0); PG8_BAR; PG8_MMA(0, 0, At, B0); PG8_MMA(0, 1, At, B1); PG8_BAR; PG8_SCHED;
            PG8_LDA(At, 1, 1); PG8_STAGE(PG8_SB(1, 0), b3, voffB); PG8_STAGE(PG8_SB(1, 1), b3 + hstep, voffB); PG8_STAGE(PG8_SA(1, 0), a3, voffA);
            PG8_WAIT_V(8); PG8_WAIT_L(0); PG8_BAR; PG8_MMA(1, 0, At, B0); PG8_MMA(1, 1, At, B1); PG8_BAR; PG8_SCHED;
        }
        if (wr == 0) PG8_BAR;
        const bool first_half = SPLIT2 && cur.half == 0;
        {
            const int row0 = cur.pm * BM + wr * 64 + fr, col0 = cur.pn * BM + wc * 32 + 8 * fq;
            if constexpr (SPLIT2) { if (first_half) {
#pragma unroll
                for (int ai = 0; ai < 2; ++ai)
#pragma unroll
                    for (int m = 0; m < 4; ++m) {
#pragma unroll
                        for (int bj = 0; bj < 2; ++bj) E.mid8(row0 + ai * HALF + m * 16, col0 + bj * HALF, acc[ai][bj][m][0], acc[ai][bj][m][1]);
                        asm volatile("" : "+v"(acc[ai][0][m][0]), "+v"(acc[ai][0][m][1]), "+v"(acc[ai][1][m][0]), "+v"(acc[ai][1][m][1]) :: "memory"); } } }
            if constexpr (Epi::TILE) E.tile(acc, cur.pm, cur.pn, wr, wc, fr, fq, (LAS float*)(lds + RING_BYTES + 2048));
            else if (!first_half) {
#pragma unroll
            for (int ai = 0; ai < 2; ++ai)
#pragma unroll
                for (int m = 0; m < 4; ++m)
#pragma unroll
                    for (int bj = 0; bj < 2; ++bj) E.st8(row0 + ai * HALF + m * 16, col0 + bj * HALF, acc[ai][bj][m][0], acc[ai][bj][m][1]);
            }
        }
        if (!has_next) break;
        if (!first_half) {
#pragma unroll
        for (int a = 0; a < 2; ++a)
#pragma unroll
            for (int b = 0; b < 2; ++b)
#pragma unroll
                for (int m = 0; m < 4; ++m)
#pragma unroll
                    for (int n = 0; n < 2; ++n) acc[a][b][m][n] = (f32x4){0.f, 0.f, 0.f, 0.f};
        }
        cur = nxt; cA = nA; cB = nB; ++ui;
        if (wr == 1) PG8_BAR;
    }
    PG8_WAIT_V(0);
    PG8_BAR;
#undef PG8_NEXT
#undef PG8_UA
#undef PG8_UB
#undef PG8_SA
#undef PG8_SB
#undef PG8_STAGE
#undef PG8_LDA
#undef PG8_LDB
#undef PG8_MMA
#undef PG8_WAIT_V
#undef PG8_WAIT_L
#undef PG8_BAR
#undef PG8_SCHED
}
}

#define XB_TMO      128
#define XB_XCNT(j)  (256  + 64 * (j))
#define XB_XSUB(j)  (1280 + 64 * (j))
#define XB_XGEN(j)  (2304 + 64 * (j))
#define XB_TOP      3328
#define XB_TOPGEN   3392
#define XCD_BAR_WORDS 3456
#define XB_SPIN_CAP (1u << 18)
__device__ __forceinline__ unsigned xb_ld(unsigned* p)              { return __hip_atomic_load(p, __ATOMIC_RELAXED, __HIP_MEMORY_SCOPE_AGENT); }
__device__ __forceinline__ unsigned xb_add(unsigned* p, unsigned v) { return __hip_atomic_fetch_add(p, v, __ATOMIC_RELAXED, __HIP_MEMORY_SCOPE_AGENT); }
__device__ __forceinline__ unsigned xb_xcc_id() { return (unsigned)__builtin_amdgcn_s_getreg((3 << 11) | 20) & 0xFu; }
#define XB_SPIN(cond, bar) do { unsigned _sp = 0; while (cond) { __builtin_amdgcn_s_sleep(1); \
    if ((++_sp & 255u) == 0u) { if (xb_ld(&(bar)[XB_TMO])) break; if (_sp > XB_SPIN_CAP) { atomicAdd(&(bar)[XB_TMO], 1u); break; } } } } while (0)
struct XcdBarrier { unsigned* bar; unsigned x; volatile LAS unsigned* st; int wave; };
__device__ __forceinline__ XcdBarrier xcd_barrier_post(unsigned* bar, volatile LAS unsigned* st, int wave) {
    XcdBarrier b; b.bar = bar; b.x = xb_xcc_id(); b.st = st; b.wave = wave;
    if (wave == 0 && lane_id() == 0) (void)xb_add(&bar[XB_XCNT(b.x)], 1u);
    return b;
}
__device__ __forceinline__ void xcd_barrier_complete(unsigned* bar, unsigned x, unsigned& nloc, unsigned& nx) {
    const unsigned G = gridDim.x * gridDim.y * gridDim.z;
    unsigned sum, cnt, mine, sp = 0u;
    for (;;) {
        sum = 0u; cnt = 0u; mine = 0u;
#pragma unroll
        for (unsigned j = 0; j < 16; ++j) { const unsigned c = xb_ld(&bar[XB_XCNT(j)]); sum += c; cnt += (c > 0u) ? 1u : 0u; mine = (j == x) ? c : mine; }
        if (sum == G) break;
        __builtin_amdgcn_s_sleep(1);
        if ((++sp & 255u) == 0u) { if (xb_ld(&bar[XB_TMO])) break; if (sp > XB_SPIN_CAP) { atomicAdd(&bar[XB_TMO], 1u); break; } }
    }
    nloc = mine > 0u ? mine : 1u; nx = cnt > 0u ? cnt : 1u;
}
__device__ __forceinline__ void xcd_barrier(const XcdBarrier& b) {
    asm volatile("s_waitcnt vmcnt(0)" ::: "memory");
    __syncthreads();
    if (b.wave == 0 && lane_id() == 0) {
        unsigned* bar = b.bar;
        __builtin_amdgcn_s_waitcnt(0);
        unsigned nloc = b.st[0], nx = b.st[1];
        if (nloc == 0u) { xcd_barrier_complete(bar, b.x, nloc, nx); b.st[0] = nloc; b.st[1] = nx; }
        const unsigned old = xb_add(&bar[XB_XSUB(b.x)], 1u);
        const unsigned gen = old / nloc;
        if (old + 1u == (gen + 1u) * nloc) {
            __builtin_amdgcn_fence(__ATOMIC_RELEASE, "agent");
            asm volatile("s_waitcnt vmcnt(0)" ::: "memory");
            const unsigned og = xb_add(&bar[XB_TOP], 1u);
            const unsigned tg = og / nx;
            if (og + 1u == (tg + 1u) * nx) xb_add(&bar[XB_TOPGEN], 1u);
            else XB_SPIN(xb_ld(&bar[XB_TOPGEN]) == tg, bar);
            __builtin_amdgcn_fence(__ATOMIC_ACQUIRE, "agent");
            xb_add(&bar[XB_XGEN(b.x)], 1u);
            asm volatile("s_waitcnt vmcnt(0)" ::: "memory");
        } else {
            XB_SPIN(xb_ld(&bar[XB_XGEN(b.x)]) == gen, bar);
            __builtin_amdgcn_fence(__ATOMIC_ACQUIRE, "agent");
            asm volatile("s_waitcnt vmcnt(0)" ::: "memory");
        }
    }
    __syncthreads();
}

struct Args { const void* in[32]; float* out; unsigned char* ws; int ph_lo, ph_hi; };
struct Frame { LAS unsigned char* lds; int wave, vcu, G; const Args* a; };
#define FP_x_prompt ((const float*)F.a->in[0])
#define FP_x_sample ((const float*)F.a->in[1])
#define FP_c_prompt ((const float*)F.a->in[2])
#define FP_c_sample ((const float*)F.a->in[3])
#define FP_cache_k ((const float*)F.a->in[4])
#define FP_cache_v ((const float*)F.a->in[5])
#define FP_page_table ((const int*)F.a->in[6])
#define FP_state_C ((const float*)F.a->in[7])
#define FP_state_n ((const float*)F.a->in[8])
#define FP_state_m ((const float*)F.a->in[9])
#define FP_state_conv ((const float*)F.a->in[10])
#define FP_w_ada ((const float*)F.a->in[11])
#define FP_b_ada ((const float*)F.a->in[12])
#define FP_g_pre_mix ((const float*)F.a->in[13])
#define FP_g_post_mix ((const float*)F.a->in[14])
#define FP_w_in ((const float*)F.a->in[15])
#define FP_b_if ((const float*)F.a->in[16])
#define FP_g_mlstm ((const float*)F.a->in[17])
#define FP_lq1 ((const float*)F.a->in[18])
#define FP_lk1 ((const float*)F.a->in[19])
#define FP_lq2 ((const float*)F.a->in[20])
#define FP_lk2 ((const float*)F.a->in[21])
#define FP_g_diff ((const float*)F.a->in[22])
#define FP_w_proj_m ((const float*)F.a->in[23])
#define FP_w_proj_d ((const float*)F.a->in[24])
#define FP_w_out ((const float*)F.a->in[25])
#define FP_g_pre_ffn ((const float*)F.a->in[26])
#define FP_g_post_ffn ((const float*)F.a->in[27])
#define FP_w_up ((const float*)F.a->in[28])
#define FP_conv_w ((const float*)F.a->in[29])
#define FP_conv_b ((const float*)F.a->in[30])
#define FP_w_down ((const float*)F.a->in[31])
#define FP_WinT ((bf16_t*)(F.a->ws + WS_WIN))
#define FP_WupT ((bf16_t*)(F.a->ws + WS_WUP))
#define FP_WdownT ((bf16_t*)(F.a->ws + WS_WDOWN))
#define FP_WoutT ((bf16_t*)(F.a->ws + WS_WOUT))
#define FP_WpT ((bf16_t*)(F.a->ws + WS_WPM))
#define FP_H1 ((bf16_t*)(F.a->ws + WS_H1))
#define FP_Z ((bf16_t*)(F.a->ws + WS_Z))
#define FP_CPREV ((bf16_t*)(F.a->ws + WS_CPREV))
#define FP_HMD ((bf16_t*)(F.a->ws + WS_HM))
#define FP_MG ((bf16_t*)(F.a->ws + WS_MG))
#define FP_AH ((float*)(F.a->ws + WS_UA))
#define FP_AF ((float*)(F.a->ws + WS_UA + 2 * MiB))
#define FP_BF ((float*)(F.a->ws + WS_UA + 4 * MiB))
#define FP_GB ((bf16_t*)(F.a->ws + WS_G))
#define FP_ADA ((float*)(F.a->ws + WS_ADA))
#define FP_IG ((float*)(F.a->ws + WS_IG))
#define FP_LF ((float*)(F.a->ws + WS_LF))
#define FP_ST ((float*)(F.a->ws + WS_ST))
#define FP_NU ((float*)(F.a->ws + WS_NU))
#define FP_NPREV ((float*)(F.a->ws + WS_NPREV))
#define FP_MPREV ((float*)(F.a->ws + WS_MPREV))
#define FP_U ((float*)(F.a->ws + WS_U))
#define FP_O1 ((bf16_t*)(F.a->ws + WS_O1))
#define FP_O2 ((bf16_t*)(F.a->ws + WS_O2))
#define FP_Y ((bf16_t*)(F.a->ws + WS_Y))
#define FP_DPART ((float*)(F.a->ws + WS_DPART))
#define FP_X1 ((bf16_t*)(F.a->ws + WS_UB + 16 * MiB))
#define FP_out (F.a->out)


__device__ __forceinline__ void transpose_item(const float* W, int pitch, int scol0, int K, bf16_t* WT, int drow0, LAS float* scr, int kb, int nb, int lane, int koff = 0) {
    const int k0 = 64 * kb, n0 = 32 * nb;
    float tv[32];
#pragma unroll
    for (int i = 0; i < 32; ++i) { const int kk = 2 * i + (lane >> 5); tv[i] = W[(size_t)(k0 + kk) * pitch + scol0 + n0 + (lane & 31)]; }
#pragma unroll
    for (int i = 0; i < 32; ++i) { const int kk = 2 * i + (lane >> 5); scr[kk * 33 + (lane & 31)] = tv[i]; }
    asm volatile("s_waitcnt lgkmcnt(0)" ::: "memory");
    const int c = lane & 7;
#pragma unroll
    for (int j = 0; j < 4; ++j) { const int n = (lane >> 3) + 8 * j; const LAS float* s = scr + (8 * c) * 33 + n;
        u32x4 o; o.x = pk2(s[0 * 33], s[1 * 33]); o.y = pk2(s[2 * 33], s[3 * 33]); o.z = pk2(s[4 * 33], s[5 * 33]); o.w = pk2(s[6 * 33], s[7 * 33]);
        *(u32x4*)(WT + (size_t)(drow0 + n0 + n) * K + koff + k0 + 8 * c) = o; }
    asm volatile("s_waitcnt lgkmcnt(0)" ::: "memory");
}
struct TBlock { const float* W; bf16_t* WT; int pitch, col_a, col_b, k0, wt_pitch, koff, drow0; };
__device__ __forceinline__ TBlock tblock_of(const Frame& F, int it) {
    constexpr int B0 = 16 * 22, B1 = 8 * 4, B2 = 8 * 4, B3 = 16 * 4, B4 = 16 * 22;
    int r = it; TBlock t;
    if (r < B0) { const int kb = r / 22, nb = r % 22; t = {FP_w_in, FP_WinT, DIN, nb < 8 ? 256 * nb : 2056 + 256 * (nb - 8), -1, 64 * kb, 1024, 0, 256 * nb}; return t; } r -= B0;
    if (r < B1) { t = {FP_w_proj_m, FP_WpT, 1024, 256 * (r & 3), -1, 64 * (r >> 2), 1024, 0, 256 * (r & 3)}; return t; } r -= B1;
    if (r < B2) { t = {FP_w_proj_d, FP_WpT, 1024, 256 * (r & 3), -1, 64 * (r >> 2), 1024, 512, 256 * (r & 3)}; return t; } r -= B2;
    if (r < B3) { t = {FP_w_out, FP_WoutT, 1024, 256 * (r & 3), -1, 64 * (r >> 2), 1024, 0, 256 * (r & 3)}; return t; } r -= B3;
    if (r < B4) { const int kb = r / 22, pn = r % 22; t = {FP_w_up, FP_WupT, 2 * DFF, 128 * pn, DFF + 128 * pn, 64 * kb, 1024, 0, 256 * pn}; return t; } r -= B4;
    t = {FP_w_down, FP_WdownT, 1024, 256 * (r & 3), -1, 64 * (r >> 2), DFF, 0, 256 * (r & 3)}; return t;
}
__device__ __forceinline__ void p0_transposes(const Frame& F) {
    constexpr int NBLK = 16 * 22 + 8 * 4 + 8 * 4 + 16 * 4 + 16 * 22 + 44 * 4;
    const int lane = lane_id(), wid = F.wave, tid = wid * 64 + lane;
    LAS float* tile = (LAS float*)F.lds;
    f32x4 v[8];
    int it = F.vcu;
    if (it < NBLK) { const TBlock t = tblock_of(F, it); const int scol = (t.col_b >= 0 && lane >= 32) ? t.col_b + 4 * (lane - 32) : t.col_a + 4 * lane;
#pragma unroll
        for (int i = 0; i < 8; ++i) v[i] = *(const f32x4*)(t.W + (size_t)(t.k0 + 8 * wid + i) * t.pitch + scol); }
    for (; it < NBLK; it += F.G) {
        const TBlock t = tblock_of(F, it);
#pragma unroll
        for (int i = 0; i < 8; ++i) *(LAS f32x4*)(tile + (8 * wid + i) * 260 + 4 * lane) = v[i];
        if (it + F.G < NBLK) { const TBlock tn = tblock_of(F, it + F.G); const int scol = (tn.col_b >= 0 && lane >= 32) ? tn.col_b + 4 * (lane - 32) : tn.col_a + 4 * lane;
#pragma unroll
            for (int i = 0; i < 8; ++i) v[i] = *(const f32x4*)(tn.W + (size_t)(tn.k0 + 8 * wid + i) * tn.pitch + scol); }
        WG_BAR();
#pragma unroll
        for (int i = 0; i < 4; ++i) { const int idx = tid + 512 * i, n = idx >> 3, c = idx & 7; const LAS float* sp = tile + (8 * c) * 260 + n;
            u32x4 o; o.x = pk2(sp[0], sp[260]); o.y = pk2(sp[2 * 260], sp[3 * 260]); o.z = pk2(sp[4 * 260], sp[5 * 260]); o.w = pk2(sp[6 * 260], sp[7 * 260]);
            *(u32x4*)(t.WT + (size_t)(t.drow0 + n) * t.wt_pitch + t.koff + t.k0 + 8 * c) = o; }
        WG_BAR();
    }
    {
        LAS float* scr = (LAS float*)(F.lds + F.wave * 8448);
        const int gw = F.vcu * NWAVES + F.wave; if (gw < 16) transpose_item(FP_w_in, DIN, 2048 - ZP, 1024, FP_WinT, 0, scr, gw, ZP / 32, lane_id());
    }
}
__device__ __forceinline__ void p0_ada(const Frame& F) {
    const int lane = lane_id(), r = lane & 31, h = lane >> 5, w = F.wave, tid = w * 64 + lane;
    LAS float* part = (LAS float*)F.lds;
    for (int task = F.vcu; task < 192; task += F.G) {
        const int n0 = 32 * task;
        bf16x8 bw[8];
#pragma unroll
        for (int ks = 0; ks < 8; ++ks) { const float* p = FP_w_ada + (size_t)(128 * w + 16 * ks + 8 * h) * 6144 + n0 + r;
            f32x4 a, b; a.x = p[0]; a.y = p[6144]; a.z = p[2 * 6144]; a.w = p[3 * 6144]; b.x = p[4 * 6144]; b.y = p[5 * 6144]; b.z = p[6 * 6144]; b.w = p[7 * 6144]; bw[ks] = pack8(a, b); }
        f32x16 acc[5];
        LAS unsigned char* ct = F.lds + w * 8704;
        int lo_ = lane; asm volatile("" : "+v"(lo_));
        const int lrow = lo_ >> 5, lcol = (lo_ & 31) * 4;
#pragma unroll
        for (int rt = 0; rt < 5; ++rt) {
            f32x4 cv[16];
#pragma unroll
            for (int i = 0; i < 16; ++i) { const int R0 = 32 * rt + 2 * i;
                if (R0 == 0) cv[i] = *(const f32x4*)(FP_c_prompt + (size_t)lrow * 1024 + 128 * w + lcol);
                else if (R0 < 130) cv[i] = *(const f32x4*)(FP_c_sample + (size_t)(R0 - 2 + lrow) * 1024 + 128 * w + lcol);
                else cv[i] = (f32x4){0.f, 0.f, 0.f, 0.f}; }
#pragma unroll
            for (int i = 0; i < 16; ++i) { u32x2 o; o.x = pk2(cv[i].x, cv[i].y); o.y = pk2(cv[i].z, cv[i].w); *(LAS u32x2*)(ct + (2 * i + lrow) * 272 + lcol * 2) = o; }
            for (int i = 0; i < 16; ++i) acc[rt][i] = 0.f;
#pragma unroll
            for (int ks = 0; ks < 8; ++ks) acc[rt] = MFMA32(*(const LAS bf16x8*)(ct + r * 272 + (16 * ks + 8 * h) * 2), bw[ks], acc[rt]);
            asm volatile("s_waitcnt lgkmcnt(0)" ::: "memory");
        }
        WG_BAR();
#pragma unroll
        for (int batch = 0; batch < 2; ++batch) {
            const int rt0 = 3 * batch, nrt = batch ? 2 : 3;
#pragma unroll
            for (int j = 0; j < 3; ++j) if (j < nrt) {
#pragma unroll
                for (int i = 0; i < 16; ++i) part[((w * 3 + j) * 32 + crow(i, h)) * 32 + r] = acc[rt0 + j][i]; }
            WG_BAR();
            for (int idx = tid; idx < nrt * 1024; idx += NTHR) { const int j = idx >> 10, row = (idx >> 5) & 31, col = idx & 31; float sum = 0.f;
#pragma unroll
                for (int ww = 0; ww < 8; ++ww) sum += part[((ww * 3 + j) * 32 + row) * 32 + col];
                const int Rr = 32 * (rt0 + j) + row; if (Rr < 130) FP_ADA[(size_t)Rr * 6144 + n0 + col] = sum + FP_b_ada[n0 + col]; }
            WG_BAR();
        }
    }
}
__device__ __forceinline__ int crow_of(int m) { return m < MP ? (m >> 13) : 2 + ((m - MP) >> 2); }
__device__ __forceinline__ const float* xrow_of(const Frame& F, int m) { return m < MP ? FP_x_prompt + (size_t)m * DM : FP_x_sample + (size_t)(m - MP) * DM; }
__device__ __forceinline__ void p1_norm_gates(const Frame& F) {
    const int lane = lane_id(), gw = F.vcu * NWAVES + F.wave, NGW = F.G * NWAVES;
    const int r_lo = (int)(((long)gw * MT) / NGW), r_hi = (int)(((long)(gw + 1) * MT) / NGW);
    f32x4 gs[4], sh[4], vn[4], vn2[4];
#pragma unroll
    for (int j = 0; j < 4; ++j) { gs[j] = (f32x4){0.f, 0.f, 0.f, 0.f}; sh[j] = gs[j]; vn[j] = gs[j]; vn2[j] = gs[j]; }
    int ccur = -1;
    if (r_lo < r_hi) { const float* xr = xrow_of(F, r_lo);
#pragma unroll
        for (int j = 0; j < 4; ++j) vn[j] = *(const f32x4*)(xr + 4 * lane + 256 * j); }
    if (r_lo + 1 < r_hi) { const float* xr = xrow_of(F, r_lo + 1);
#pragma unroll
        for (int j = 0; j < 4; ++j) vn2[j] = *(const f32x4*)(xr + 4 * lane + 256 * j); }
    for (int m = r_lo; m < r_hi; ++m) {
        f32x4 v[4]; float ss = 0.f;
#pragma unroll
        for (int j = 0; j < 4; ++j) { v[j] = vn[j]; vn[j] = vn2[j]; }
        if (m + 2 < r_hi) { const float* xr = xrow_of(F, m + 2);
#pragma unroll
            for (int j = 0; j < 4; ++j) vn2[j] = *(const f32x4*)(xr + 4 * lane + 256 * j); }
        const int cr = crow_of(m);
        if (cr != ccur) { ccur = cr; const float* ada = FP_ADA + (size_t)cr * 6144;
#pragma unroll
            for (int j = 0; j < 4; ++j) { sh[j] = *(const f32x4*)(ada + 4 * lane + 256 * j); gs[j] = *(const f32x4*)(FP_g_pre_mix + 4 * lane + 256 * j) * (*(const f32x4*)(ada + 1024 + 4 * lane + 256 * j) + 1.f); } }
#pragma unroll
        for (int j = 0; j < 4; ++j) ss += (v[j].x * v[j].x + v[j].y * v[j].y) + (v[j].z * v[j].z + v[j].w * v[j].w);
        const float rs = rsqrtf(wave_sum(ss) * (1.f / DM) + EPS);
#pragma unroll
        for (int j = 0; j < 4; ++j) { const f32x4 hv = (v[j] * rs) * gs[j] + sh[j];
            u32x2 o; o.x = pk2(hv.x, hv.y); o.y = pk2(hv.z, hv.w); *(u32x2*)(FP_H1 + (size_t)m * DM + 4 * lane + 256 * j) = o; }
    }
}
struct EpiZ {
    static constexpr int MID_T = -1; static constexpr bool TILE = false;
    bf16_t* Z; float* out; float* IG; float* LF; const float* b_if;
    __device__ __forceinline__ void st8(int row, int col, f32x4 v0, f32x4 v1) const {
        if (col >= ZP) { if (col == ZP) { const f32x4 bi = *(const f32x4*)b_if, bf = *(const f32x4*)(b_if + 4);
                *(f32x4*)(IG + (size_t)row * 4) = v0 + bi; v1 = v1 + bf; *(f32x4*)(LF + (size_t)row * 4) = (f32x4){log_sigmoid(v1.x), log_sigmoid(v1.y), log_sigmoid(v1.z), log_sigmoid(v1.w)}; } return; }
        const int pn = col >> 8; const float sc = (pn == 2 || pn == 3) ? KSCALE : ((pn == 8 || pn == 9) ? QSCALE : 1.f);
        if (pn >= 10 && pn < 14) { const int kv = pn >= 12; const int c = col - (kv ? ZDV : ZDK);
            float* o = row < MP ? out + (kv ? OFF_VP : OFF_KP) + (size_t)row * 512 + c : out + (kv ? OFF_VS : OFF_KS) + (size_t)(row - MP) * 512 + c;
            *(f32x4*)o = v0; *(f32x4*)(o + 4) = v1; }
        if (pn >= 14) { v0.x = sigmoidf_(v0.x); v0.y = sigmoidf_(v0.y); v0.z = sigmoidf_(v0.z); v0.w = sigmoidf_(v0.w); v1.x = sigmoidf_(v1.x); v1.y = sigmoidf_(v1.y); v1.z = sigmoidf_(v1.z); v1.w = sigmoidf_(v1.w); }
        *(bf16x8*)(Z + zbase(col) + (size_t)row * ZR) = pack8(v0 * sc, v1 * sc);
    }
};
struct EpiPMD {
    static constexpr int MID_T = 6; static constexpr bool TILE = false;
    const bf16_t* Z; bf16_t* MG;
    __device__ __forceinline__ void mid8(int row, int col, f32x4& v0, f32x4& v1) const {
        const u32x4 gm = *(const u32x4*)(Z + zbase(ZGM + col) + (size_t)row * ZR), gd = *(const u32x4*)(Z + zbase(ZGD + col) + (size_t)row * ZR);
        f32x4 m0, m1, d0, d1; unpack8(gm, m0, m1); unpack8(gd, d0, d1);
        d0.x = fmaxf(d0.x, 1e-20f); d0.y = fmaxf(d0.y, 1e-20f); d0.z = fmaxf(d0.z, 1e-20f); d0.w = fmaxf(d0.w, 1e-20f); d1.x = fmaxf(d1.x, 1e-20f); d1.y = fmaxf(d1.y, 1e-20f); d1.z = fmaxf(d1.z, 1e-20f); d1.w = fmaxf(d1.w, 1e-20f);
        v0.x *= m0.x * __builtin_amdgcn_rcpf(d0.x); v0.y *= m0.y * __builtin_amdgcn_rcpf(d0.y); v0.z *= m0.z * __builtin_amdgcn_rcpf(d0.z); v0.w *= m0.w * __builtin_amdgcn_rcpf(d0.w);
        v1.x *= m1.x * __builtin_amdgcn_rcpf(d1.x); v1.y *= m1.y * __builtin_amdgcn_rcpf(d1.y); v1.z *= m1.z * __builtin_amdgcn_rcpf(d1.z); v1.w *= m1.w * __builtin_amdgcn_rcpf(d1.w); }
    __device__ __forceinline__ void st8(int row, int col, f32x4 v0, f32x4 v1) const {
        f32x4 d0, d1; unpack8(*(const u32x4*)(Z + zbase(ZGD + col) + (size_t)row * ZR), d0, d1);
        d0.x = fmaxf(d0.x, 1e-20f); d0.y = fmaxf(d0.y, 1e-20f); d0.z = fmaxf(d0.z, 1e-20f); d0.w = fmaxf(d0.w, 1e-20f); d1.x = fmaxf(d1.x, 1e-20f); d1.y = fmaxf(d1.y, 1e-20f); d1.z = fmaxf(d1.z, 1e-20f); d1.w = fmaxf(d1.w, 1e-20f);
        *(bf16x8*)(MG + (size_t)row * DM + col) = pack8(v0 * d0, v1 * d1); }
    __device__ __forceinline__ void st4md(int row, int col, f32x4 am, f32x4 ad) const {
        const u32x2 gm = *(const u32x2*)(Z + zbase(ZGM + col) + (size_t)row * ZR), gd = *(const u32x2*)(Z + zbase(ZGD + col) + (size_t)row * ZR);
        u32x2 o; o.x = pk2(bflo(gm.x) * am.x + bflo(gd.x) * ad.x, bfhi(gm.x) * am.y + bfhi(gd.x) * ad.y); o.y = pk2(bflo(gm.y) * am.z + bflo(gd.y) * ad.z, bfhi(gm.y) * am.w + bfhi(gd.y) * ad.w);
        *(u32x2*)(MG + (size_t)row * DM + col) = o; }
};
struct EpiF32 {
    static constexpr int MID_T = -1; static constexpr bool TILE = false;
    bf16_t* Y;
    __device__ __forceinline__ void st4(int row, int col, f32x4 v) const { u32x2 o; o.x = pk2(v.x, v.y); o.y = pk2(v.z, v.w); *(u32x2*)(Y + (size_t)row * DM + col) = o; }
    __device__ __forceinline__ void st8(int row, int col, f32x4 v0, f32x4 v1) const { *(bf16x8*)(Y + (size_t)row * DM + col) = pack8(v0, v1); }
};
__device__ __forceinline__ float gelu_tanh(float x) { const float u = 1.5957691216057308f * (x + 0.044715f * x * x * x); return x * __builtin_amdgcn_rcpf(1.f + __builtin_amdgcn_exp2f(-u * LOG2E)); }
#define DPP_F(oldv, srcv, ctrl) __builtin_bit_cast(float, __builtin_amdgcn_update_dpp(__builtin_bit_cast(int, (float)(oldv)), __builtin_bit_cast(int, (float)(srcv)), (ctrl), 0xf, 0xf, false))
struct EpiUpG {
    static constexpr int MID_T = -1; static constexpr bool TILE = true;
    bf16_t* G; float* out; const float* conv_w; const float* conv_b; const float* state_conv; float* AH; float* AF; float* BF;
    __device__ __forceinline__ void st8(int, int, f32x4, f32x4) const {}
    __device__ __forceinline__ void tile(f32x4 (&acc)[2][2][4][2], int pm, int pn, int wr, int wc, int fr, int fq, LAS float* halo) const {
        const int f0 = 128 * pn + 32 * wc + 8 * fq;
        const bool sample = pm >= MP / 256;
#pragma unroll
        for (int ai = 0; ai < 2; ++ai) if (fr >= 14) { LAS float* hp = halo + ((2 * ai + wr) * 2 + (fr - 14)) * 128 + 32 * wc + 8 * fq; *(LAS f32x4*)hp = acc[ai][0][3][0]; *(LAS f32x4*)(hp + 4) = acc[ai][0][3][1]; }
        asm volatile("s_waitcnt lgkmcnt(0)\n\ts_barrier" ::: "memory");
#pragma unroll
        for (int n = 0; n < 2; ++n) {
            const int fc = f0 + 4 * n;
            const f32x4 w0 = *(const f32x4*)(conv_w + fc), w1 = *(const f32x4*)(conv_w + DFF + fc), w2 = *(const f32x4*)(conv_w + 2 * DFF + fc), cb = *(const f32x4*)(conv_b + fc);
#pragma unroll
            for (int ai = 0; ai < 2; ++ai) {
                const int g = 2 * ai + wr;
                f32x4 h0 = {0.f, 0.f, 0.f, 0.f}, h1 = h0;
                if (g > 0) { const LAS float* hp = halo + ((g - 1) * 2) * 128 + 32 * wc + 8 * fq + 4 * n; h0 = *(const LAS f32x4*)hp; h1 = *(const LAS f32x4*)(hp + 128); }
#pragma unroll
                for (int m = 0; m < 4; ++m) {
                    const int rowt = 128 * ai + 64 * wr + 16 * m + fr, row = 256 * pm + rowt, tq = fr & 3;
                    f32x4 s0 = {0.f, 0.f, 0.f, 0.f}, s1 = s0;
                    if (sample) { const float* st = state_conv + (size_t)((row - MP) >> 2) * 2 * DFF + fc; s0 = *(const f32x4*)st; s1 = *(const f32x4*)(st + DFF); }
                    f32x4 gv;
#pragma unroll
                    for (int e = 0; e < 4; ++e) {
                        const float a0 = acc[ai][0][m][n][e], bv = acc[ai][1][m][n][e];
                        float p1, p2;
                        if (sample) {
                            const float d1 = DPP_F(0.f, a0, 0x111), d2 = DPP_F(0.f, a0, 0x112);
                            p1 = (tq >= 1) ? d1 : s1[e]; p2 = (tq >= 2) ? d2 : ((tq == 1) ? s1[e] : s0[e]);
                        } else {
                            float t1, t2;
                            if (m > 0) { const float pr = acc[ai][0][m > 0 ? m - 1 : 0][n][e]; t1 = DPP_F(0.f, pr, 0x10F); t2 = DPP_F(0.f, pr, 0x10E); }
                            else { t1 = h1[e]; t2 = (fr == 0) ? h0[e] : h1[e]; }
                            p1 = DPP_F(t1, a0, 0x111); p2 = DPP_F(t2, a0, 0x112);
                        }
                        const float cv = cb[e] + w0[e] * p2 + w1[e] * p1 + w2[e] * a0;
                        gv[e] = gelu_tanh(cv) * bv;
                    }
                    { u32x2 o; o.x = pk2(gv.x, gv.y); o.y = pk2(gv.z, gv.w); *(u32x2*)(G + (size_t)row * DFF + fc) = o; }
                    if (!sample) {
                        if (rowt >= 254) { *(f32x4*)(AH + ((size_t)pm * 2 + (rowt - 254)) * DFF + fc) = acc[ai][0][m][n];
                            if ((pm & 31) == 31) *(f32x4*)(out + OFF_CVP + ((size_t)(pm >> 5) * 2 + (rowt - 254)) * DFF + fc) = acc[ai][0][m][n]; }
                        if (rowt < 2) { *(f32x4*)(AF + ((size_t)pm * 2 + rowt) * DFF + fc) = acc[ai][0][m][n]; *(f32x4*)(BF + ((size_t)pm * 2 + rowt) * DFF + fc) = acc[ai][1][m][n]; }
                    } else if (tq >= 2) *(f32x4*)(out + OFF_CVS + ((size_t)((row - MP) >> 2) * 2 + (tq - 2)) * DFF + fc) = acc[ai][0][m][n];
                    asm volatile("" ::: "memory");
                }
            }
        }
    }
};
__device__ __forceinline__ void geglu_fixup(const Frame& F, int pm) {
    if (pm >= MP / 256 || (pm & 31) == 0) return;
    const float* ah = FP_AH + (size_t)(pm - 1) * 2 * DFF; const float* af = FP_AF + (size_t)pm * 2 * DFF; const float* bfp = FP_BF + (size_t)pm * 2 * DFF;
    for (int i = FTID(F); i < 2 * DFF; i += NTHR) { const int r = i / DFF, f = i - r * DFF;
        const float a0 = af[r * DFF + f], bv = bfp[r * DFF + f], p1 = (r == 0) ? ah[DFF + f] : af[f], p2 = (r == 0) ? ah[f] : ah[DFF + f];
        const float cv = FP_conv_b[f] + FP_conv_w[f] * p2 + FP_conv_w[DFF + f] * p1 + FP_conv_w[2 * DFF + f] * a0;
        FP_GB[(size_t)(256 * pm + r) * DFF + f] = f2bf(gelu_tanh(cv) * bv); }
    asm volatile("s_waitcnt vmcnt(0)" ::: "memory");
    WG_BAR();
}
template <bool MD, class Epi>
__device__ __forceinline__ void skinny_gemm(const Frame& F, const bf16_t* A, const bf16_t* Bt, int K, const Epi& E) {
    const int lane = lane_id(), r = lane & 31, h = lane >> 5, ke = F.wave, K8 = K >> 3, tid = F.wave * 64 + lane;
    LAS float* part = (LAS float*)F.lds;
    for (int task = F.vcu; task < 256; task += F.G) {
        const int rt = task >> 4, cg = task & 15;
        const bf16_t* ap = A + (size_t)(32 * rt + r) * K + ke * K8 + 8 * h;
        const bf16_t* bp0 = Bt + (size_t)(64 * cg + r) * K + ke * K8 + 8 * h; const bf16_t* bp1 = bp0 + (size_t)32 * K;
        f32x16 acc0, acc1; for (int i = 0; i < 16; ++i) { acc0[i] = 0.f; acc1[i] = 0.f; }
#pragma unroll 4
        for (int s = 0; s < K8 / 16; ++s) { const bf16x8 a = *(const bf16x8*)(ap + 16 * s), b0 = *(const bf16x8*)(bp0 + 16 * s), b1 = *(const bf16x8*)(bp1 + 16 * s); acc0 = MFMA32(b0, a, acc0); acc1 = MFMA32(b1, a, acc1); }
#pragma unroll
        for (int g4 = 0; g4 < 4; ++g4) { *(LAS f32x4*)(part + (ke * 32 + r) * 68 + 8 * g4 + 4 * h) = (f32x4){acc0[4 * g4], acc0[4 * g4 + 1], acc0[4 * g4 + 2], acc0[4 * g4 + 3]};
            *(LAS f32x4*)(part + (ke * 32 + r) * 68 + 32 + 8 * g4 + 4 * h) = (f32x4){acc1[4 * g4], acc1[4 * g4 + 1], acc1[4 * g4 + 2], acc1[4 * g4 + 3]}; }
        WG_BAR();
        { const int row = tid >> 4, c4 = (tid & 15) * 4;
          const f32x4 lo = *(const LAS f32x4*)(part + row * 68 + c4) + *(const LAS f32x4*)(part + (32 + row) * 68 + c4) + *(const LAS f32x4*)(part + (64 + row) * 68 + c4) + *(const LAS f32x4*)(part + (96 + row) * 68 + c4);
          const f32x4 hi4 = *(const LAS f32x4*)(part + (128 + row) * 68 + c4) + *(const LAS f32x4*)(part + (160 + row) * 68 + c4) + *(const LAS f32x4*)(part + (192 + row) * 68 + c4) + *(const LAS f32x4*)(part + (224 + row) * 68 + c4);
          if constexpr (MD) E.st4md(MP + 32 * rt + row, 64 * cg + c4, lo, hi4);
          else E.st4(MP + 32 * rt + row, 64 * cg + c4, lo + hi4); }
        WG_BAR();
    }
}

constexpr int VROW = 320;
constexpr int CH = 128, NCH = TP / CH;
__device__ __forceinline__ void chunk_scan(const Frame& F, int m0, int h, int lane, float& F1, float& F2, float& a1, float& a2, float& A1, float& A2) {
    const float lf1 = FP_LF[(size_t)(m0 + lane) * 4 + h], lf2 = FP_LF[(size_t)(m0 + 64 + lane) * 4 + h], ig1 = FP_IG[(size_t)(m0 + lane) * 4 + h], ig2 = FP_IG[(size_t)(m0 + 64 + lane) * 4 + h];
    F1 = wave_scan_sum(lf1, lane); F2 = __shfl(F1, 63) + wave_scan_sum(lf2, lane);
    a1 = ig1 - F1; a2 = ig2 - F2;
    A1 = wave_scan_max(a1, lane); A2 = fmaxf(__shfl(A1, 63), wave_scan_max(a2, lane));
}
__device__ __forceinline__ void mlstm_A_unit(const Frame& F, int u) {
    const int bh = u / NCH, c = u % NCH, b = bh >> 2, h = bh & 3, m0 = b * TP + c * CH;
    const int lane = lane_id(), wid = F.wave, tid = wid * 64 + lane;
    LAS unsigned char* Vt = F.lds; LAS unsigned char* Kt = F.lds + CH * VROW; LAS float* wl = (LAS float*)(F.lds + 2 * CH * VROW);
    if (wid == 0) {
        float F1, F2, a1, a2, A1, A2; chunk_scan(F, m0, h, lane, F1, F2, a1, a2, A1, A2);
        const float Mloc = __shfl(A2, 63), Fsum = __shfl(F2, 63);
        wl[lane] = __expf(a1 - Mloc); wl[64 + lane] = __expf(a2 - Mloc);
        if (lane == 0) { FP_ST[2 * u] = Fsum; FP_ST[2 * u + 1] = Mloc; }
    }
    WG_BAR();
#pragma unroll
    for (int i = 0; i < 4; ++i) { const int idx = tid + 512 * i, row = idx >> 4, ch = idx & 15;
        const bf16_t* src = FP_Z + (size_t)(m0 + row) * ZR;
        const u32x4 vv = *(const u32x4*)(src + zbase(ZV + h * 128 + ch * 8)); const u32x4 kk = *(const u32x4*)(src + zbase(ZK + h * 128 + ch * 8));
        f32x4 k0, k1; unpack8(kk, k0, k1); const float w = wl[row];
        *(LAS u32x4*)(Vt + row * VROW + ch * 16) = vv;
        *(LAS bf16x8*)(Kt + row * VROW + ch * 16) = pack8(k0 * w, k1 * w); }
    WG_BAR();
    if (tid < 128) { float sm = 0.f;
#pragma unroll 8
        for (int row = 0; row < CH; ++row) sm += bf2f(*(const LAS bf16_t*)(Kt + row * VROW + tid * 2));
        FP_NU[(size_t)u * 128 + tid] = sm; }
    {
        const int r32 = lane & 31, hi = lane >> 5, vh = (lane >> 4) & 1, q4 = (lane & 15) >> 2, p = lane & 3;
        const int vt = wid >> 1, dt0 = 2 * (wid & 1);
        const int lbase = (8 * hi + q4) * VROW + (16 * vh + 4 * p) * 2;
        f32x16 acc0, acc1; for (int i = 0; i < 16; ++i) { acc0[i] = 0.f; acc1[i] = 0.f; }
#pragma unroll
        for (int st = 0; st < CH / 16; ++st) {
            const LAS unsigned char* va = Vt + lbase + st * 16 * VROW + vt * 64;
            const bf16x8 af = cat4(tr_rd(va), tr_rd(va + 4 * VROW));
            const LAS unsigned char* ka = Kt + lbase + st * 16 * VROW + dt0 * 64;
            const bf16x8 b0 = cat4(tr_rd(ka), tr_rd(ka + 4 * VROW)), b1 = cat4(tr_rd(ka + 64), tr_rd(ka + 64 + 4 * VROW));
            acc0 = MFMA32(af, b0, acc0); acc1 = MFMA32(af, b1, acc1);
        }
        float* Uo = FP_U + (size_t)u * 16384;
#pragma unroll
        for (int i = 0; i < 16; ++i) { const int v = 32 * vt + crow(i, hi); Uo[v * 128 + 32 * dt0 + r32] = acc0[i]; Uo[v * 128 + 32 * dt0 + 32 + r32] = acc1[i]; }
    }
    WG_BAR();
}
__device__ __forceinline__ void smlstm_unit(const Frame& F, int u) {
    const int n = u >> 2, h = u & 3, tid = FTID(F), lane = lane_id(), wid = F.wave;
    const int mrow = MP + 4 * n;
    LAS float* qs = (LAS float*)F.lds; LAS float* ks = qs + 512; LAS float* vs = ks + 512; LAS float* numI = vs + 512; LAS float* Sm = numI + 512; LAS float* nq = Sm + 16; LAS float* red = nq + 4;
    { const int t = tid >> 7, d = tid & 127; const bf16_t* z = FP_Z + (size_t)(mrow + t) * ZR;
      qs[tid] = bf2f(z[zbase(ZQ + h * 128 + d)]); ks[tid] = bf2f(z[zbase(ZK + h * 128 + d)]); vs[tid] = bf2f(z[zbase(ZV + h * 128 + d)]); }
    LAS float* gl = red + 8;
    const float m0 = FP_state_m[n * 4 + h];
    if (tid < 4) { float cum = 0.f, am = -INFINITY, at = 0.f;
      for (int t = 0; t <= tid; ++t) { cum += FP_LF[(size_t)(mrow + t) * 4 + h]; at = FP_IG[(size_t)(mrow + t) * 4 + h] - cum; am = fmaxf(am, at); }
      const float mxv = fmaxf(m0, am);
      gl[tid] = cum; gl[4 + tid] = at; gl[8 + tid] = mxv; gl[12 + tid] = __expf(m0 - mxv); gl[16 + tid] = cum + mxv; }
    WG_BAR();
    const float m_end = gl[19], Fend = gl[3], decay = __expf(Fend + m0 - m_end);
    const float wend0 = __expf(Fend + gl[4] - m_end), wend1 = __expf(Fend + gl[5] - m_end), wend2 = __expf(Fend + gl[6] - m_end), wend3 = __expf(Fend + gl[7] - m_end);
#pragma unroll
    for (int k = 0; k < 2; ++k) { const int pid = 2 * wid + k, t = pid >> 2, s = pid & 3;
        float d = qs[t * 128 + lane] * ks[s * 128 + lane] + qs[t * 128 + 64 + lane] * ks[s * 128 + 64 + lane]; d = wave_sum(d);
        if (lane == 0) Sm[pid] = (s <= t) ? d * __expf(gl[4 + s] - gl[8 + t]) : 0.f; }
    if (wid < 4) { const float* n0 = FP_state_n + (size_t)u * 128; float d = n0[lane] * qs[wid * 128 + lane] + n0[64 + lane] * qs[wid * 128 + 64 + lane]; d = wave_sum(d); if (lane == 0) nq[wid] = d; }
    { const int vrow = tid >> 2, dq = tid & 3;
      const float* c0 = FP_state_C + ((size_t)u * 128 + vrow) * 128 + 32 * dq; float* co = FP_out + OFF_CS + ((size_t)u * 128 + vrow) * 128 + 32 * dq;
      f32x4 cv[8];
#pragma unroll
      for (int i = 0; i < 8; ++i) cv[i] = *(const f32x4*)(c0 + 4 * i);
      float ps[4]; float coef[4];
      ps[0] = 0.f; ps[1] = 0.f; ps[2] = 0.f; ps[3] = 0.f;
      coef[0] = wend0 * vs[vrow]; coef[1] = wend1 * vs[128 + vrow]; coef[2] = wend2 * vs[256 + vrow]; coef[3] = wend3 * vs[384 + vrow];
#pragma unroll
      for (int i = 0; i < 8; ++i) { f32x4 cn = cv[i] * decay;
#pragma unroll
          for (int t = 0; t < 4; ++t) { const f32x4 qv = *(const LAS f32x4*)(qs + t * 128 + 32 * dq + 4 * i), kv = *(const LAS f32x4*)(ks + t * 128 + 32 * dq + 4 * i);
              ps[t] += (cv[i].x * qv.x + cv[i].y * qv.y) + (cv[i].z * qv.z + cv[i].w * qv.w); cn += kv * coef[t]; }
          *(f32x4*)(co + 4 * i) = cn; }
#pragma unroll
      for (int t = 0; t < 4; ++t) { ps[t] += __shfl_xor(ps[t], 1); ps[t] += __shfl_xor(ps[t], 2); if (dq == 0) numI[t * 128 + vrow] = ps[t]; } }
    WG_BAR();
    { const int t = tid >> 7, v = tid & 127;
      const float it = gl[12 + t], mtt = gl[16 + t];
      float num = it * numI[tid], den = it * nq[t];
#pragma unroll
      for (int s = 0; s < 4; ++s) { const float sv = Sm[t * 4 + s]; num += sv * vs[s * 128 + v]; den += sv; }
      const float hval = num / fmaxf(fabsf(den), __expf(-mtt));
      const float ssw = wave_sum(hval * hval); if (lane == 0) red[wid] = ssw;
      WG_BAR();
      const float rms = rsqrtf((red[2 * t] + red[2 * t + 1]) * (1.f / 128.f) + EPS);
      const float mo = bf2f(FP_Z[zbase(ZO + h * 128 + v) + (size_t)(mrow + t) * ZR]);
      FP_HMD[(size_t)(mrow + t) * 1024 + h * 128 + v] = f2bf(hval * rms * FP_g_mlstm[h * 128 + v] * sigmoidf_(mo));
      if (tid < 128) { const float n0v = FP_state_n[(size_t)u * 128 + tid]; float nn = decay * n0v;
          nn += wend0 * ks[tid] + wend1 * ks[128 + tid] + wend2 * ks[256 + tid] + wend3 * ks[384 + tid];
          FP_out[OFF_NS + (size_t)u * 128 + tid] = nn; }
      if (tid == 0) FP_out[OFF_MS + u] = m_end; }
    WG_BAR();
}
__device__ __forceinline__ void mlstm_scan_item(const Frame& F, int item) {
    const int tid = FTID(F), bh = item >> 5, j = item & 31, e = 512 * j + tid; const bool nthr = (j == 0 && tid < 128);
    float C = 0.f, m = 0.f, nacc = 0.f;
    const float* Ub = FP_U + (size_t)bh * NCH * 16384 + e; bf16_t* Cp = FP_CPREV + (size_t)bh * NCH * 16384 + e;
    for (int c0 = 0; c0 < NCH; c0 += 32) {
        float uu[32], un[32];
#pragma unroll
        for (int i = 0; i < 32; ++i) { uu[i] = Ub[(size_t)(c0 + i) * 16384]; un[i] = nthr ? FP_NU[(size_t)(bh * NCH + c0 + i) * 128 + tid] : 0.f; }
#pragma unroll
        for (int i = 0; i < 32; ++i) { const int c = c0 + i; const float fs = FP_ST[2 * (bh * NCH + c)], ml = FP_ST[2 * (bh * NCH + c) + 1];
            Cp[(size_t)c * 16384] = f2bf(C);
            if (nthr) FP_NPREV[(size_t)(bh * NCH + c) * 128 + tid] = nacc;
            if (j == 0 && tid == 0) FP_MPREV[bh * NCH + c] = m;
            const float mn = fs + fmaxf(m, ml), dec = __expf(fs + m - mn), sc = __expf(fs + ml - mn);
            C = dec * C + sc * uu[i]; nacc = dec * nacc + sc * un[i]; m = mn; }
    }
    FP_out[OFF_CP + (size_t)bh * 16384 + e] = C;
    if (nthr) FP_out[OFF_NP + bh * 128 + tid] = nacc;
    if (j == 0 && tid == 0) FP_out[OFF_MP + bh] = m;
}
__device__ __forceinline__ void glds16(const void* gsrc, unsigned lds_dst);
__device__ __forceinline__ void mlstm_C_group(const Frame& F, int grp) {
    const int tid_ = FTID(F);
    const int lane = tid_ & 63, wid = F.wave, r32 = lane & 31, hi = lane >> 5, ci = wid >> 2, tt = wid & 3;
    const int u = 2 * grp + ci, bh = u / NCH, c = u % NCH, b = bh >> 2, h = bh & 3, m0 = b * TP + c * CH;
    LAS unsigned char* Vt = F.lds + ci * 32768;
    LAS float* Fa = (LAS float*)(F.lds + 65536 + wid * 2048); LAS float* aa = Fa + 128; LAS float* Aa = aa + 128;
    {
        const unsigned lds0 = (unsigned)(uintptr_t)Vt;
#pragma unroll
        for (int k = 0; k < 8; ++k) { const int bb = 8 * tt + k, c4 = bb >> 3, kg = bb & 7;
            glds16(FP_Z + zbase(ZV + h * 128 + c4 * 32 + (lane & 3) * 8) + (size_t)(m0 + kg * 16 + (lane >> 2)) * ZR, (unsigned)__builtin_amdgcn_readfirstlane(lds0 + bb * 1024)); }
    }
    {
        float F1, F2, a1, a2, A1, A2; chunk_scan(F, m0, h, lane, F1, F2, a1, a2, A1, A2);
        Fa[lane] = F1; Fa[64 + lane] = F2; aa[lane] = a1; aa[64 + lane] = a2; Aa[lane] = A1; Aa[64 + lane] = A2;
    }
    const int t = 32 * tt + r32;
    const float mprev = FP_MPREV[u];
    bf16x8 qf[8];
    { const bf16_t* qp = FP_Z + zbase(ZQ + h * 128 + 8 * hi) + (size_t)(m0 + t) * ZR;
#pragma unroll
      for (int st = 0; st < 8; ++st) qf[st] = *(const bf16x8*)(qp + 16 * st); }
    const float Ft = Fa[t], At = Aa[t], mxt = fmaxf(mprev, At), mt = Ft + mxt, inter = __expf(mprev - mxt);
    float dq = 0.f;
    { const float* np = FP_NPREV + (size_t)u * 128 + 8 * hi;
#pragma unroll
      for (int st = 0; st < 8; ++st) { const f32x4 n0 = *(const f32x4*)(np + 16 * st), n1 = *(const f32x4*)(np + 16 * st + 4); f32x4 q0, q1; unpack8(__builtin_bit_cast(u32x4, qf[st]), q0, q1);
          dq += (q0.x * n0.x + q0.y * n0.y) + (q0.z * n0.z + q0.w * n0.w) + (q1.x * n1.x + q1.y * n1.y) + (q1.z * n1.z + q1.w * n1.w); } }
    dq += __shfl_xor(dq, 32);
    f32x16 acc[4];
#pragma unroll
    for (int vt = 0; vt < 4; ++vt) { for (int i = 0; i < 16; ++i) acc[vt][i] = 0.f;
        const bf16_t* cp = FP_CPREV + (size_t)u * 16384 + (size_t)(32 * vt + r32) * 128 + 8 * hi;
#pragma unroll
        for (int st = 0; st < 8; ++st) acc[vt] = MFMA32(*(const bf16x8*)(cp + 16 * st), qf[st], acc[vt]);
#pragma unroll
        for (int i = 0; i < 16; ++i) acc[vt][i] *= inter; }
    asm volatile("s_waitcnt vmcnt(0) lgkmcnt(0)\n\ts_barrier" ::: "memory");
    float den = 0.f;
    const int vh = (lane >> 4) & 1, q4 = (lane & 15) >> 2, p = lane & 3;
    const int vlane = (4 * hi + q4) * 64 + (16 * vh + 4 * p) * 2;
    for (int sub = 0; sub <= tt; ++sub) {
        f32x16 sacc; for (int i = 0; i < 16; ++i) sacc[i] = 0.f;
        { const bf16_t* kp = FP_Z + zbase(ZK + h * 128 + 8 * hi) + (size_t)(m0 + 32 * sub + r32) * ZR;
#pragma unroll
          for (int st = 0; st < 8; ++st) sacc = MFMA32(*(const bf16x8*)(kp + 16 * st), qf[st], sacc); }
#pragma unroll
        for (int g = 0; g < 4; ++g) { const f32x4 av = *(const LAS f32x4*)(aa + 32 * sub + 8 * g + 4 * hi);
#pragma unroll
            for (int k = 0; k < 4; ++k) { const int sidx = 32 * sub + 8 * g + 4 * hi + k; const float wgt = (sidx <= t) ? __expf(av[k] - mxt) : 0.f; const float val = (sidx <= t) ? sacc[4 * g + k] * wgt : 0.f; sacc[4 * g + k] = val; den += val; } }
#pragma unroll
        for (int s2 = 0; s2 < 2; ++s2) {
            const bf16x8 pb = pack8((f32x4){sacc[8 * s2], sacc[8 * s2 + 1], sacc[8 * s2 + 2], sacc[8 * s2 + 3]}, (f32x4){sacc[8 * s2 + 4], sacc[8 * s2 + 5], sacc[8 * s2 + 6], sacc[8 * s2 + 7]});
            const LAS unsigned char* va = Vt + vlane + (2 * sub + s2) * 1024;
#pragma unroll
            for (int vt = 0; vt < 4; ++vt) acc[vt] = MFMA32(cat4(tr_rd(va + vt * 8192), tr_rd(va + vt * 8192 + 512)), pb, acc[vt]);
        }
    }
    den += __shfl_xor(den, 32);
    den += inter * dq;
    const float rden = 1.f / fmaxf(fabsf(den), __expf(-mt));
    float ss = 0.f;
#pragma unroll
    for (int vt = 0; vt < 4; ++vt) for (int i = 0; i < 16; ++i) { acc[vt][i] *= rden; ss += acc[vt][i] * acc[vt][i]; }
    ss += __shfl_xor(ss, 32);
    const float rms = rsqrtf(ss * (1.f / 128.f) + EPS);
#pragma unroll
    for (int vt = 0; vt < 4; ++vt)
#pragma unroll
        for (int g = 0; g < 4; ++g) { const int v = 32 * vt + 8 * g + 4 * hi;
            const f32x4 gv = *(const f32x4*)(FP_g_mlstm + h * 128 + v); const u32x2 mo = *(const u32x2*)(FP_Z + zbase(ZO + h * 128 + v) + (size_t)(m0 + t) * ZR);
            u32x2 o; o.x = pk2(acc[vt][4 * g] * rms * gv.x * sigmoidf_(bflo(mo.x)), acc[vt][4 * g + 1] * rms * gv.y * sigmoidf_(bfhi(mo.x)));
            o.y = pk2(acc[vt][4 * g + 2] * rms * gv.z * sigmoidf_(bflo(mo.y)), acc[vt][4 * g + 3] * rms * gv.w * sigmoidf_(bfhi(mo.y)));
            *(u32x2*)(FP_HMD + (size_t)(m0 + t) * 1024 + h * 128 + v) = o; }
    asm volatile("s_waitcnt lgkmcnt(0)\n\ts_barrier" ::: "memory");
}
constexpr int AT_SLOT = 24576, AT_VOFF = 8192, AT_NSLOT = 4;
constexpr float AT_THR = 8.f;
__device__ __forceinline__ void glds16(const void* gsrc, unsigned lds_dst) { unsigned keep;
    asm volatile("s_mov_b32 %0, m0\n\ts_mov_b32 m0, %2\n\ts_nop 0\n\tglobal_load_lds_dwordx4 %1, off\n\ts_mov_b32 m0, %0" : "=&s"(keep) : "v"(gsrc), "s"(lds_dst) : "memory"); }
__device__ __forceinline__ float max3f(float a, float b, float c) { float r; asm("v_max3_f32 %0, %1, %2, %3" : "=v"(r) : "v"(a), "v"(b), "v"(c)); return r; }
#define AT_WAIT_BAR(N) asm volatile("s_waitcnt vmcnt(" #N ") lgkmcnt(0)\n\ts_barrier" ::: "memory")
__device__ __forceinline__ void attn_half_unit(const Frame& F, int bh, int qb, int map, bf16_t* Odst) {
    const int tid_ = FTID(F);
    const int b = bh >> 2, h = bh & 3, lane = tid_ & 63, wid = F.wave, r32 = lane & 31, hi = lane >> 5;
    const int rowbase = b * TP, q0 = qb * 256, qrow = q0 + 32 * wid + r32;
    const bf16_t* Zb = FP_Z + (size_t)rowbase * ZR;
    const unsigned lds0 = (unsigned)(uintptr_t)F.lds;
    const bf16_t* ksrc = Zb + zbase(ZDK + h * 128 + map * 64 + wid * 8) + (size_t)lane * ZR;
    const bf16_t* vsrc0 = Zb + zbase(ZDV + h * 128 + ((2 * wid) >> 2) * 32 + (lane & 3) * 8) + (size_t)(((2 * wid) & 3) * 16 + (lane >> 2)) * ZR;
    const bf16_t* vsrc1 = vsrc0 + (size_t)16 * ZR;
    const unsigned kdst = lds0 + wid * 1024, vdst = lds0 + AT_VOFF + 2 * wid * 1024;
#define AT_DMA(t, slot) do { const size_t adv_ = (size_t)(t) * 64 * ZR; const unsigned so_ = (unsigned)(slot) * AT_SLOT; \
        glds16(ksrc + adv_, (unsigned)__builtin_amdgcn_readfirstlane(kdst + so_)); glds16(vsrc0 + adv_, (unsigned)__builtin_amdgcn_readfirstlane(vdst + so_)); \
        glds16(vsrc1 + adv_, (unsigned)__builtin_amdgcn_readfirstlane(vdst + so_ + 1024u)); } while (0)
    bf16x8 qf[4];
    { const bf16_t* qp = Zb + zbase(ZDQ + h * 128 + map * 64 + 8 * hi) + (size_t)qrow * ZR;
#pragma unroll
      for (int st = 0; st < 4; ++st) qf[st] = *(const bf16x8*)(qp + 16 * st); }
    const int NT = 4 * qb + 4;
    AT_DMA(0, 0); AT_DMA(1, 1); AT_DMA(2, 2);
    f32x16 o[4];
#pragma unroll
    for (int vt = 0; vt < 4; ++vt) for (int i = 0; i < 16; ++i) o[vt][i] = 0.f;
    f32x16 negm; for (int i = 0; i < 16; ++i) negm[i] = 0.f;
    float mhat = 0.f, lrun = 0.f;
    const int vh = (lane >> 4) & 1, q4 = (lane & 15) >> 2, p = lane & 3;
    const int vlane = AT_VOFF + (4 * hi + q4) * 64 + (16 * vh + 4 * p) * 2;
    const int klane = hi * 1024 + r32 * 16;
    const int wlast = q0 + 32 * wid + 31, wfirst = q0 + 32 * wid;
#define AT_SCHED() __builtin_amdgcn_sched_barrier(0)
#define AT_KRD(i0, kbase) do { kf[i0] = *(const LAS bf16x8*)((kbase) + ((i0) >> 1) * 2048 + ((i0) & 1) * 512); kf[(i0) + 1] = *(const LAS bf16x8*)((kbase) + (((i0) + 1) >> 1) * 2048 + (((i0) + 1) & 1) * 512); } while (0)
#define AT_VRD(dst, g, vbase) do { _Pragma("unroll") for (int vt = 0; vt < 4; ++vt) dst[vt] = cat4(tr_rd((vbase) + (g) * 1024 + vt * 4096), tr_rd((vbase) + (g) * 1024 + vt * 4096 + 512)); } while (0)
#define AT_PB(g) (((g) >> 1) == 0 ? pack8((f32x4){p0[8 * ((g) & 1)], p0[8 * ((g) & 1) + 1], p0[8 * ((g) & 1) + 2], p0[8 * ((g) & 1) + 3]}, (f32x4){p0[8 * ((g) & 1) + 4], p0[8 * ((g) & 1) + 5], p0[8 * ((g) & 1) + 6], p0[8 * ((g) & 1) + 7]}) \
                                  : pack8((f32x4){p1[8 * ((g) & 1)], p1[8 * ((g) & 1) + 1], p1[8 * ((g) & 1) + 2], p1[8 * ((g) & 1) + 3]}, (f32x4){p1[8 * ((g) & 1) + 4], p1[8 * ((g) & 1) + 5], p1[8 * ((g) & 1) + 6], p1[8 * ((g) & 1) + 7]}))
#define AT_PV(src, g) do { const bf16x8 pb_ = AT_PB(g); _Pragma("unroll") for (int vt = 0; vt < 4; ++vt) o[vt] = MFMA32(src[vt], pb_, o[vt]); } while (0)
    AT_WAIT_BAR(3);
    bf16x8 kf[8];
    { const LAS unsigned char* kb = F.lds + klane; AT_KRD(0, kb); AT_KRD(2, kb); AT_KRD(4, kb); AT_KRD(6, kb); }
    int slot = 0, slot1 = 1, slot3 = 3;
    for (int j = 0; j < NT; ++j) {
        if (j + 3 < NT) AT_DMA(j + 3, slot3);
        if (64 * j <= wlast) {
            const LAS unsigned char* vb = F.lds + slot * AT_SLOT + vlane;
            const LAS unsigned char* kn = F.lds + slot1 * AT_SLOT + klane;
            const bool knext = (j + 1 < NT);
            f32x16 p0 = MFMA32(kf[0], qf[0], negm), p1 = MFMA32(kf[1], qf[0], negm);
#pragma unroll
            for (int st = 1; st < 4; ++st) { p0 = MFMA32(kf[2 * st], qf[st], p0); p1 = MFMA32(kf[2 * st + 1], qf[st], p1); }
            AT_SCHED();
            bf16x8 vfA[4], vfB[4];
            AT_VRD(vfA, 0, vb);
            AT_SCHED();
            if (64 * j + 63 > wfirst) {
#pragma unroll
                for (int i = 0; i < 16; ++i) { const int key = 64 * j + crow(i, hi); if (key > qrow) p0[i] = -INFINITY; if (key + 32 > qrow) p1[i] = -INFINITY; }
            }
            asm volatile("s_nop 15\n\ts_nop 7" : "+v"(p0), "+v"(p1));
            float mx = max3f(p0[0], p1[0], p0[1]), mx2 = max3f(p1[1], p0[2], p1[2]);
#pragma unroll
            for (int i = 3; i < 15; i += 2) { mx = max3f(mx, p0[i], p1[i]); mx2 = max3f(mx2, p0[i + 1], p1[i + 1]); }
            mx = max3f(mx, p0[15], p1[15]); mx = fmaxf(mx, mx2);
            mx = fmaxf(mx, __shfl_xor(mx, 32));
            if (j == 0 || __any(mx > AT_THR)) {
                const float dl = (j == 0) ? mx : fmaxf(mx, 0.f), f = __builtin_amdgcn_exp2f(-dl);
                mhat += dl; lrun *= f;
#pragma unroll
                for (int i = 0; i < 16; ++i) { p0[i] -= dl; p1[i] -= dl; negm[i] = -mhat; }
#pragma unroll
                for (int vt = 0; vt < 4; ++vt) for (int i = 0; i < 16; ++i) o[vt][i] *= f;
            }
            float rsum = 0.f;
#pragma unroll
            for (int i = 0; i < 16; ++i) { p0[i] = __builtin_amdgcn_exp2f(p0[i]); p1[i] = __builtin_amdgcn_exp2f(p1[i]); rsum += p0[i] + p1[i]; }
            lrun += rsum;
            AT_SCHED();
            AT_VRD(vfB, 1, vb); if (knext) AT_KRD(0, kn); AT_SCHED(); AT_PV(vfA, 0); AT_SCHED();
            AT_VRD(vfA, 2, vb); if (knext) AT_KRD(2, kn); AT_SCHED(); AT_PV(vfB, 1); AT_SCHED();
            AT_VRD(vfB, 3, vb); if (knext) AT_KRD(4, kn); AT_SCHED(); AT_PV(vfA, 2); AT_SCHED();
            if (knext) AT_KRD(6, kn); AT_SCHED(); AT_PV(vfB, 3); AT_SCHED();
        }
        if (j + 3 < NT) AT_WAIT_BAR(3); else AT_WAIT_BAR(0);
        slot = slot1; slot1 = (slot1 == AT_NSLOT - 1) ? 0 : slot1 + 1; slot3 = (slot3 == AT_NSLOT - 1) ? 0 : slot3 + 1;
    }
#undef AT_SCHED
#undef AT_KRD
#undef AT_VRD
#undef AT_PB
#undef AT_PV
    lrun += __shfl_xor(lrun, 32);
    const float rl = 1.f / lrun;
    bf16_t* op = Odst + (size_t)(rowbase + qrow) * 512 + h * 128 + 4 * hi;
#pragma unroll
    for (int vt = 0; vt < 4; ++vt)
#pragma unroll
        for (int g = 0; g < 4; ++g) { u32x2 w; w.x = pk2(o[vt][4 * g] * rl, o[vt][4 * g + 1] * rl); w.y = pk2(o[vt][4 * g + 2] * rl, o[vt][4 * g + 3] * rl); *(u32x2*)(op + 32 * vt + 8 * g) = w; }
    AT_WAIT_BAR(0);
#undef AT_DMA
}
__device__ __forceinline__ float lambda_full(const Frame& F, int lane) {
    const float a = wave_sum(FP_lq1[lane] * FP_lk1[lane]), b = wave_sum(FP_lq2[lane] * FP_lk2[lane]);
    return __expf(a) - __expf(b) + LAM_INIT;
}
__device__ __forceinline__ void attn_combine_rows(const Frame& F) {
    const int lane = lane_id(), gw = F.vcu * NWAVES + F.wave, NGW = F.G * NWAVES;
    const float lam = lambda_full(F, lane);
    const f32x4 g0 = *(const f32x4*)(FP_g_diff + 8 * lane), g1 = *(const f32x4*)(FP_g_diff + 8 * lane + 4);
    for (int m = gw; m < MP; m += NGW) {
        f32x4 a0, a1, b0, b1; unpack8(*(const u32x4*)(FP_O1 + (size_t)m * 512 + 8 * lane), a0, a1); unpack8(*(const u32x4*)(FP_O2 + (size_t)m * 512 + 8 * lane), b0, b1);
        const f32x4 x0 = a0 - b0 * lam, x1 = a1 - b1 * lam;
        float ss = (x0.x * x0.x + x0.y * x0.y) + (x0.z * x0.z + x0.w * x0.w) + (x1.x * x1.x + x1.y * x1.y) + (x1.z * x1.z + x1.w * x1.w);
        ss += __shfl_xor(ss, 1); ss += __shfl_xor(ss, 2); ss += __shfl_xor(ss, 4); ss += __shfl_xor(ss, 8);
        const float rms = rsqrtf(ss * (1.f / 128.f) + EPS) * (1.f - LAM_INIT);
        *(bf16x8*)(FP_HMD + (size_t)m * 1024 + 512 + 8 * lane) = pack8(x0 * rms * g0, x1 * rms * g1);
    }
}
constexpr int SB_P = 264;
constexpr int DPART = 1040;
__device__ __forceinline__ void decode_unit(const Frame& F, int u) {
    const int tid_ = FTID(F);
    const int n = u >> 2, blk = u & 3, lane = tid_ & 63, wid = F.wave, h = wid & 3, qt = wid >> 2;
    const int mrow = MP + 4 * n;
    LAS float* Sb = (LAS float*)(F.lds + wid * 8704);
    LAS float* fac = Sb + 8 * SB_P;
    const int* pt = FP_page_table + n * NPAGES + 4 * blk + 2 * qt;
    const int c16 = lane & 15, g = lane >> 4, hh = lane >> 5, l5 = lane & 31, scol = lane >> 3, sseg = lane & 7;
    bf16x8 bq[4];
#pragma unroll
    for (int st = 0; st < 4; ++st) { const bool ok = (c16 < 4 && st < 2) || (c16 >= 4 && c16 < 8 && st >= 2);
        const bf16x8 v = *(const bf16x8*)(FP_Z + zbase(ZDQ + h * 128 + 32 * st + 8 * g) + (size_t)(mrow + (c16 & 3)) * ZR);
        const bf16x8 zz = {0, 0, 0, 0, 0, 0, 0, 0}; bq[st] = ok ? v : zz; }
    const char* vpool = (const char*)FP_cache_v; const char* kpool = (const char*)FP_cache_k;
    const unsigned voff = (((unsigned)pt[hh] * PAGE) * 4u + (unsigned)h) * 512u + 16u * (unsigned)l5;
#define NTL(p) (*(const f32x4*)(p))
#define VLD(row) NTL(vpool + (voff + 2048u * (unsigned)(row)))
    f32x4 va[8], vb[8];
    {
        const unsigned ko0 = (((unsigned)pt[0] * PAGE + (unsigned)c16) * 4u + (unsigned)h) * 512u + 32u * (unsigned)g;
        const unsigned ko1 = (((unsigned)pt[1] * PAGE + (unsigned)c16) * 4u + (unsigned)h) * 512u + 32u * (unsigned)g;
        f32x4 ka[16], kb[16];
#define KLOAD(dst, ti) do { const unsigned ko_ = (((ti) < 8) ? ko0 : ko1) + 32768u * (unsigned)((ti) & 7); \
            _Pragma("unroll") for (int st = 0; st < 4; ++st) { dst[2 * st] = NTL(kpool + (ko_ + 128u * st)); dst[2 * st + 1] = NTL(kpool + (ko_ + 128u * st + 16u)); } } while (0)
#define KTILE(src, ti) do { f32x4 acc_ = {0.f, 0.f, 0.f, 0.f}; \
            _Pragma("unroll") for (int st = 0; st < 4; ++st) acc_ = MFMA16(pack8(src[2 * st], src[2 * st + 1]), bq[st], acc_); \
            if (c16 < 8) *(LAS f32x4*)(Sb + c16 * SB_P + 16 * (ti) + 4 * g) = acc_; } while (0)
        KLOAD(ka, 0); KLOAD((ka + 8), 1); KLOAD(kb, 2); KLOAD((kb + 8), 3);
        for (int ip = 0; ip < 12; ip += 4) {
            KTILE(ka, ip); KTILE((ka + 8), ip + 1); KLOAD(ka, ip + 4); KLOAD((ka + 8), ip + 5);
            KTILE(kb, ip + 2); KTILE((kb + 8), ip + 3); KLOAD(kb, ip + 6); KLOAD((kb + 8), ip + 7);
        }
        KTILE(ka, 12); KTILE((ka + 8), 13);
#pragma unroll
        for (int kk = 0; kk < 8; ++kk) va[kk] = VLD(kk);
        KTILE(kb, 14); KTILE((kb + 8), 15);
#pragma unroll
        for (int kk = 0; kk < 8; ++kk) vb[kk] = VLD(8 + kk);
#undef KLOAD
#undef KTILE
    }
    {
        LAS float* sp = Sb + scol * SB_P + 32 * sseg;
        f32x4 sv[8]; float mx = -INFINITY;
#pragma unroll
        for (int i = 0; i < 8; ++i) { sv[i] = *(const LAS f32x4*)(sp + 4 * i); mx = fmaxf(fmaxf(mx, fmaxf(sv[i].x, sv[i].y)), fmaxf(sv[i].z, sv[i].w)); }
        mx = fmaxf(mx, __shfl_xor(mx, 1)); mx = fmaxf(mx, __shfl_xor(mx, 2)); mx = fmaxf(mx, __shfl_xor(mx, 4));
        float ls = 0.f;
#pragma unroll
        for (int i = 0; i < 8; ++i) { f32x4 pv; pv.x = __builtin_amdgcn_exp2f(sv[i].x - mx); pv.y = __builtin_amdgcn_exp2f(sv[i].y - mx); pv.z = __builtin_amdgcn_exp2f(sv[i].z - mx); pv.w = __builtin_amdgcn_exp2f(sv[i].w - mx);
            ls += (pv.x + pv.y) + (pv.z + pv.w); *(LAS f32x4*)(sp + 4 * i) = pv; }
        ls += __shfl_xor(ls, 1); ls += __shfl_xor(ls, 2); ls += __shfl_xor(ls, 4);
        if (sseg == 0) { fac[scol] = mx; fac[8 + scol] = ls; }
    }
    {
        const LAS float* pbase = Sb + 128 * hh;
        f32x4 acc[8];
#pragma unroll
        for (int c = 0; c < 8; ++c) acc[c] = (f32x4){0.f, 0.f, 0.f, 0.f};
#define VSTEP(buf, t8) do { f32x4 vc_[8]; _Pragma("unroll") for (int kk = 0; kk < 8; ++kk) vc_[kk] = buf[kk]; \
            if ((t8) + 2 < 16) { _Pragma("unroll") for (int kk = 0; kk < 8; ++kk) buf[kk] = VLD(8 * ((t8) + 2) + kk); } \
            _Pragma("unroll") for (int c = 0; c < 8; ++c) { const f32x4 p0_ = *(const LAS f32x4*)(pbase + c * SB_P + 8 * (t8)), p1_ = *(const LAS f32x4*)(pbase + c * SB_P + 8 * (t8) + 4); \
                acc[c] += vc_[0] * p0_.x + vc_[1] * p0_.y + vc_[2] * p0_.z + vc_[3] * p0_.w + vc_[4] * p1_.x + vc_[5] * p1_.y + vc_[6] * p1_.z + vc_[7] * p1_.w; } } while (0)
        for (int t8 = 0; t8 < 16; t8 += 2) { VSTEP(va, t8); VSTEP(vb, t8 + 1); }
#undef VSTEP
        float* po = FP_DPART + ((size_t)(n * 4 + h) * 8 + (2 * blk + qt)) * DPART;
#pragma unroll
        for (int c = 0; c < 8; ++c) { acc[c].x += __shfl_xor(acc[c].x, 32); acc[c].y += __shfl_xor(acc[c].y, 32); acc[c].z += __shfl_xor(acc[c].z, 32); acc[c].w += __shfl_xor(acc[c].w, 32);
            if (hh == 0) *(f32x4*)(po + c * 128 + 4 * l5) = acc[c]; }
        if (lane < 16) po[1024 + lane] = fac[lane];
    }
#undef VLD
#undef NTL
}
__device__ __forceinline__ void decode_merge(const Frame& F, int u, float lam) {
    const int n = u >> 2, h = u & 3, lane = lane_id(), wid = F.wave, tid = wid * 64 + lane;
    const int mrow = MP + 4 * n;
    LAS float* Sn = (LAS float*)F.lds;
    LAS float* wgt = Sn + 32;
    LAS float* en = wgt + 64;
    LAS float* rlv = en + 32;
    LAS float* red = rlv + 8;
    const float* pp = FP_DPART + (size_t)u * 8 * DPART;
    if (wid == 0) {
        const int c16 = lane & 15, g = lane >> 4;
        f32x4 acc = {0.f, 0.f, 0.f, 0.f};
#pragma unroll
        for (int st = 0; st < 4; ++st) { const bool ok = (c16 < 4 && st < 2) || (c16 >= 4 && c16 < 8 && st >= 2);
            const bf16x8 zz = {0, 0, 0, 0, 0, 0, 0, 0};
            const bf16x8 qv = *(const bf16x8*)(FP_Z + zbase(ZDQ + h * 128 + 32 * st + 8 * g) + (size_t)(mrow + (c16 & 3)) * ZR);
            const bf16x8 kv = *(const bf16x8*)(FP_Z + zbase(ZDK + h * 128 + 32 * st + 8 * g) + (size_t)(mrow + (c16 & 3)) * ZR);
            const bf16x8 bqv = ok ? qv : zz, akv = (c16 < 4) ? kv : zz; acc = MFMA16(akv, bqv, acc); }
        if (g == 0 && c16 < 8) { const int t = c16 & 3; f32x4 m;
            m.x = acc.x; m.y = (1 <= t) ? acc.y : -INFINITY; m.z = (2 <= t) ? acc.z : -INFINITY; m.w = (3 <= t) ? acc.w : -INFINITY;
            *(LAS f32x4*)(Sn + 4 * c16) = m; }
    }
    WG_BAR();
    if (tid < 8) { const int c = tid; const f32x4 sn = *(const LAS f32x4*)(Sn + 4 * c);
        float mi[8]; float M = fmaxf(fmaxf(sn.x, sn.y), fmaxf(sn.z, sn.w));
#pragma unroll
        for (int i = 0; i < 8; ++i) { mi[i] = pp[i * DPART + 1024 + c]; M = fmaxf(M, mi[i]); }
        const f32x4 e = {__builtin_amdgcn_exp2f(sn.x - M), __builtin_amdgcn_exp2f(sn.y - M), __builtin_amdgcn_exp2f(sn.z - M), __builtin_amdgcn_exp2f(sn.w - M)};
        float L = (e.x + e.y) + (e.z + e.w);
#pragma unroll
        for (int i = 0; i < 8; ++i) { const float w = __builtin_amdgcn_exp2f(mi[i] - M); wgt[8 * i + c] = w; L += w * pp[i * DPART + 1032 + c]; }
        *(LAS f32x4*)(en + 4 * c) = e; rlv[c] = 1.f / L; }
    WG_BAR();
    { const int t = tid >> 7, v = tid & 127; float o1 = 0.f, o2 = 0.f;
#pragma unroll
      for (int i = 0; i < 8; ++i) { o1 += wgt[8 * i + t] * pp[i * DPART + t * 128 + v]; o2 += wgt[8 * i + 4 + t] * pp[i * DPART + (4 + t) * 128 + v]; }
#pragma unroll
      for (int sx = 0; sx < 4; ++sx) { const float vn = bf2f(FP_Z[zbase(ZDV + h * 128 + v) + (size_t)(mrow + sx) * ZR]); o1 += en[4 * t + sx] * vn; o2 += en[4 * (4 + t) + sx] * vn; }
      const float ov = o1 * rlv[t] - lam * o2 * rlv[4 + t];
      const float ssw = wave_sum(ov * ov); if (lane == 0) red[wid] = ssw;
      WG_BAR();
      const float rms = rsqrtf((red[2 * t] + red[2 * t + 1]) * (1.f / 128.f) + EPS) * (1.f - LAM_INIT);
      FP_HMD[(size_t)(mrow + t) * 1024 + 512 + h * 128 + v] = f2bf(ov * rms * FP_g_diff[h * 128 + v]); }
    WG_BAR();
}
__device__ __forceinline__ void rows_post_mix(const Frame& F) {
    const int lane = lane_id(), gw = F.vcu * NWAVES + F.wave, NGW = F.G * NWAVES;
    const int r_lo = (int)(((long)gw * MT) / NGW), r_hi = (int)(((long)(gw + 1) * MT) / NGW);
    f32x4 gpm[4], gpf[4], g1[4], sh2[4], sc2[4], yn[4], xn[4];
#pragma unroll
    for (int j = 0; j < 4; ++j) { gpm[j] = *(const f32x4*)(FP_g_post_mix + 4 * lane + 256 * j); gpf[j] = *(const f32x4*)(FP_g_pre_ffn + 4 * lane + 256 * j); g1[j] = gpm[j]; sh2[j] = gpm[j]; sc2[j] = gpm[j]; yn[j] = gpm[j]; xn[j] = gpm[j]; }
    int ccur = -1;
    if (r_lo < r_hi) { const float* xr = xrow_of(F, r_lo); const bf16_t* yr = FP_Y + (size_t)r_lo * DM;
#pragma unroll
        for (int j = 0; j < 4; ++j) { { const u32x2 yy = *(const u32x2*)(yr + 4 * lane + 256 * j); yn[j] = (f32x4){bflo(yy.x), bfhi(yy.x), bflo(yy.y), bfhi(yy.y)}; } xn[j] = *(const f32x4*)(xr + 4 * lane + 256 * j); } }
    for (int m = r_lo; m < r_hi; ++m) {
        f32x4 y[4], x1[4]; float ss = 0.f;
#pragma unroll
        for (int j = 0; j < 4; ++j) { y[j] = yn[j]; x1[j] = xn[j]; }
        if (m + 1 < r_hi) { const float* xr = xrow_of(F, m + 1); const bf16_t* yr = FP_Y + (size_t)(m + 1) * DM;
#pragma unroll
            for (int j = 0; j < 4; ++j) { { const u32x2 yy = *(const u32x2*)(yr + 4 * lane + 256 * j); yn[j] = (f32x4){bflo(yy.x), bfhi(yy.x), bflo(yy.y), bfhi(yy.y)}; } xn[j] = *(const f32x4*)(xr + 4 * lane + 256 * j); } }
        const int cr = crow_of(m);
        if (cr != ccur) { ccur = cr; const float* ada = FP_ADA + (size_t)cr * 6144;
#pragma unroll
            for (int j = 0; j < 4; ++j) { const int c = 4 * lane + 256 * j; g1[j] = *(const f32x4*)(ada + 2048 + c) * gpm[j]; sh2[j] = *(const f32x4*)(ada + 3072 + c); sc2[j] = (*(const f32x4*)(ada + 4096 + c) + 1.f) * gpf[j]; } }
#pragma unroll
        for (int j = 0; j < 4; ++j) ss += (y[j].x * y[j].x + y[j].y * y[j].y) + (y[j].z * y[j].z + y[j].w * y[j].w);
        const float rs = rsqrtf(wave_sum(ss) * (1.f / DM) + EPS); float s1 = 0.f;
#pragma unroll
        for (int j = 0; j < 4; ++j) { const int c = 4 * lane + 256 * j;
            x1[j] = x1[j] + g1[j] * (y[j] * rs); { u32x2 xo; xo.x = pk2(x1[j].x, x1[j].y); xo.y = pk2(x1[j].z, x1[j].w); *(u32x2*)(FP_X1 + (size_t)m * DM + c) = xo; }
            s1 += (x1[j].x * x1[j].x + x1[j].y * x1[j].y) + (x1[j].z * x1[j].z + x1[j].w * x1[j].w); }
        const float r1 = rsqrtf(wave_sum(s1) * (1.f / DM) + EPS);
#pragma unroll
        for (int j = 0; j < 4; ++j) { const int c = 4 * lane + 256 * j;
            const f32x4 hv = (x1[j] * r1) * sc2[j] + sh2[j]; u32x2 o; o.x = pk2(hv.x, hv.y); o.y = pk2(hv.z, hv.w); *(u32x2*)(FP_H1 + (size_t)m * DM + c) = o; }
    }
}
__device__ __forceinline__ void rows_final(const Frame& F) {
    const int lane = lane_id(), gw = F.vcu * NWAVES + F.wave, NGW = F.G * NWAVES;
    const int r_lo = (int)(((long)gw * MT) / NGW), r_hi = (int)(((long)(gw + 1) * MT) / NGW);
    f32x4 gpf[4], g2[4], yn[4], xn[4];
#pragma unroll
    for (int j = 0; j < 4; ++j) { gpf[j] = *(const f32x4*)(FP_g_post_ffn + 4 * lane + 256 * j); g2[j] = gpf[j]; yn[j] = gpf[j]; xn[j] = gpf[j]; }
    int ccur = -1;
    if (r_lo < r_hi) { const bf16_t* xr = FP_X1 + (size_t)r_lo * DM; const bf16_t* yr = FP_Y + (size_t)r_lo * DM;
#pragma unroll
        for (int j = 0; j < 4; ++j) { { const u32x2 yy = *(const u32x2*)(yr + 4 * lane + 256 * j); yn[j] = (f32x4){bflo(yy.x), bfhi(yy.x), bflo(yy.y), bfhi(yy.y)}; } { const u32x2 xx = *(const u32x2*)(xr + 4 * lane + 256 * j); xn[j] = (f32x4){bflo(xx.x), bfhi(xx.x), bflo(xx.y), bfhi(xx.y)}; } } }
    for (int m = r_lo; m < r_hi; ++m) {
        f32x4 y[4], x1[4]; float ss = 0.f;
#pragma unroll
        for (int j = 0; j < 4; ++j) { y[j] = yn[j]; x1[j] = xn[j]; }
        if (m + 1 < r_hi) { const bf16_t* xr = FP_X1 + (size_t)(m + 1) * DM; const bf16_t* yr = FP_Y + (size_t)(m + 1) * DM;
#pragma unroll
            for (int j = 0; j < 4; ++j) { { const u32x2 yy = *(const u32x2*)(yr + 4 * lane + 256 * j); yn[j] = (f32x4){bflo(yy.x), bfhi(yy.x), bflo(yy.y), bfhi(yy.y)}; } { const u32x2 xx = *(const u32x2*)(xr + 4 * lane + 256 * j); xn[j] = (f32x4){bflo(xx.x), bfhi(xx.x), bflo(xx.y), bfhi(xx.y)}; } } }
        const int cr = crow_of(m);
        if (cr != ccur) { ccur = cr; const float* ada = FP_ADA + (size_t)cr * 6144;
#pragma unroll
            for (int j = 0; j < 4; ++j) g2[j] = *(const f32x4*)(ada + 5120 + 4 * lane + 256 * j) * gpf[j]; }
#pragma unroll
        for (int j = 0; j < 4; ++j) ss += (y[j].x * y[j].x + y[j].y * y[j].y) + (y[j].z * y[j].z + y[j].w * y[j].w);
        const float rs = rsqrtf(wave_sum(ss) * (1.f / DM) + EPS);
#pragma unroll
        for (int j = 0; j < 4; ++j) *(f32x4*)(FP_out + OFF_Y + (size_t)m * DM + 4 * lane + 256 * j) = x1[j] + g2[j] * (y[j] * rs);
    }
}
__device__ __forceinline__ void attention_phase(const Frame& F, volatile LAS unsigned* MISC) {
    unsigned* ctl = (unsigned*)(F.a->ws + WS_CTL) + CW_SCHED;
    const int xq = (F.vcu * 8) / F.G;
    for (;;) {
        if (FTID(F) == 0) {
            int kind = -1; unsigned idx = 0u;
            unsigned* QD = ctl + 64 * 8; unsigned* NS = ctl + 64 * (9 + xq);
            if (xb_ld(QD) < 512u) { const unsigned sn = xb_add(NS, 1u);
                if (sn < (unsigned)DEC_LIM8) { const unsigned d = xb_add(QD, 1u); if (d < 512u) { kind = 1; idx = d; } }
                if (kind < 0) (void)__hip_atomic_fetch_sub(NS, 1u, __ATOMIC_RELAXED, __HIP_MEMORY_SCOPE_AGENT); }
            for (int k = 0; k < 8 && kind < 0; ++k) { const int x = (xq + k) & 7; unsigned* QP = ctl + 64 * x;
                if (xb_ld(QP) < 64u) { const unsigned p = xb_add(QP, 1u); if (p < 64u) { kind = 0; idx = (unsigned)x * 64u + p; } } }
            if (kind < 0) { const unsigned d = xb_add(QD, 1u); if (d < 512u) { kind = 2; idx = d; } }
            MISC[0] = (unsigned)kind; MISC[1] = idx;
        }
        WG_BAR();
        const int kind = (int)MISC[0]; const int idx = (int)MISC[1];
        WG_BAR();
        if (kind < 0) break;
        if (kind == 0) { const int bh = idx >> 6, j = idx & 63, qb = 31 - (j >> 1), map = j & 1; attn_half_unit(F, bh, qb, map, map ? FP_O2 : FP_O1); }
        else { decode_unit(F, idx); asm volatile("s_waitcnt vmcnt(0) lgkmcnt(0)\n\ts_barrier" ::: "memory");
               if (kind == 1 && FTID(F) == 0) (void)__hip_atomic_fetch_sub(ctl + 64 * (9 + xq), 1u, __ATOMIC_RELAXED, __HIP_MEMORY_SCOPE_AGENT); }
    }
}

constexpr int NPHASE = 15;
#ifndef DUPMASK
#define DUPMASK 0
#endif
#ifndef PROBE_MASK
#define PROBE_MASK 0
#endif
__global__ void __launch_bounds__(NTHR, 2) fwd_kernel(Args args) {
    extern __shared__ __attribute__((aligned(16))) unsigned char lds_raw[];
    Frame F;
    F.lds = (LAS unsigned char*)lds_raw;
    F.wave = __builtin_amdgcn_readfirstlane((int)threadIdx.x >> 6);
    F.G = gridDim.x; { const int bx = blockIdx.x; F.vcu = (F.G % 8 == 0) ? (bx % 8) * (F.G / 8) + bx / 8 : bx; }
    F.a = &args; unsigned char* ws = args.ws;
    volatile LAS unsigned* MISC = (volatile LAS unsigned*)(F.lds + MISC_OFF);
    for (int u = FTID(F); u < (LDS_BYTES - RING_BYTES) / 4; u += NTHR) ((LAS unsigned*)(F.lds + RING_BYTES))[u] = 0u;
    __syncthreads();
    const int lo = args.ph_lo, hi = args.ph_hi;
    const bool multi = (hi - lo) > 1;
    XcdBarrier bar; bar.bar = (unsigned*)(ws + WS_CTL) + CW_BAR; bar.x = 0; bar.st = nullptr; bar.wave = F.wave;
    if (multi) bar = xcd_barrier_post((unsigned*)(ws + WS_CTL) + CW_BAR, MISC + 8, F.wave);
#define IN(k) (lo <= (k) && (k) < hi)
    unsigned long long pr_t0 = 0ull, pr_acc = 0ull;
#define PST(k) do { if ((PROBE_MASK >> (k)) & 1) pr_t0 = __builtin_amdgcn_s_memrealtime(); } while (0)
#define PEN(k) do { if ((PROBE_MASK >> (k)) & 1) pr_acc += __builtin_amdgcn_s_memrealtime() - pr_t0; } while (0)
#define SEAM(k) do { if (IN(k) && IN((k) + 1)) xcd_barrier(bar); } while (0)

#define DUP(k, ...) do { { __VA_ARGS__ } if ((DUPMASK >> (k)) & 1) { __VA_ARGS__ } } while (0)
    PST(0);
    if (IN(0)) { PST(15); p0_ada(F); PEN(15); p0_transposes(F); } SEAM(0); PEN(0);
    PST(1);
    if (IN(1)) { DUP(1,  p1_norm_gates(F); WG_BAR(); ); } SEAM(1); PEN(1);
    PST(2);
    if (IN(2)) { DUP(2,  pg8::Gemm g{FP_H1, FP_WinT, MT, ZN, DM, DM}; pg8::StaticOrder S; S.init(MT, ZN, F.G, (int)blockIdx.x); EpiZ E{FP_Z, FP_out, FP_IG, FP_LF, FP_b_if}; pg8::gemm_phase(F.lds, g, S, E, F.wave); ); } SEAM(2); PEN(2);
    PST(3);
    if (IN(3)) { DUP(3,  for (int u = F.vcu; u < 8 * NCH; u += F.G) mlstm_A_unit(F, u);
                 for (int u = F.vcu; u < 512; u += F.G) smlstm_unit(F, u); ); } SEAM(3); PEN(3);
    PST(4);
    PEN(4);
    PST(5);
    if (IN(5)) { for (int it = F.vcu; it < 256; it += F.G) mlstm_scan_item(F, it);
                 attention_phase(F, MISC); } SEAM(5); PEN(5);
    PST(6);
    if (IN(6)) { DUP(6,  for (int grp = F.vcu; grp < 256; grp += F.G) mlstm_C_group(F, grp);
                 attn_combine_rows(F);
                 { const float lam = lambda_full(F, lane_id()); for (int u = F.vcu; u < 512; u += F.G) decode_merge(F, u, lam); } ); } SEAM(6); PEN(6);
    PST(7);
    if (IN(7)) { DUP(7,  pg8::Gemm g{FP_HMD, FP_WpT, MP, DM, 512, DM}; pg8::StaticOrder S; S.init(MP, DM, F.G, (int)blockIdx.x); EpiPMD E{FP_Z, FP_MG}; pg8::gemm_phase<EpiPMD, true>(F.lds, g, S, E, F.wave);
                 skinny_gemm<true>(F, FP_HMD + (size_t)MP * DM, FP_WpT, DM, E); ); } SEAM(7); PEN(7);
    PST(8);
    PEN(8);
    PST(9);
    if (IN(9)) { DUP(9,  pg8::Gemm g{FP_MG, FP_WoutT, MP, DM, DM, DM}; pg8::StaticOrder S; S.init(MP, DM, F.G, (int)blockIdx.x); EpiF32 E{FP_Y}; pg8::gemm_phase(F.lds, g, S, E, F.wave);
                 skinny_gemm<false>(F, FP_MG + (size_t)MP * DM, FP_WoutT, DM, E); ); } SEAM(9); PEN(9);
    PST(10);
    if (IN(10)) { DUP(10,  rows_post_mix(F); ); } SEAM(10); PEN(10);
    PST(11);
    if (IN(11)) { DUP(11,  pg8::Gemm g{FP_H1, FP_WupT, MT, 2 * DFF, DM, DM}; pg8::StaticOrder S; S.init(MT, 2 * DFF, F.G, (int)blockIdx.x);
                  EpiUpG E{FP_GB, FP_out, FP_conv_w, FP_conv_b, FP_state_conv, FP_AH, FP_AF, FP_BF}; pg8::gemm_phase(F.lds, g, S, E, F.wave); ); } SEAM(11); PEN(11);
    PST(12);
    PEN(12);
    PST(13);
    if (IN(13)) { DUP(13,  pg8::Gemm g{FP_GB, FP_WdownT, MP, DM, DFF, DFF}; pg8::StaticOrder S; S.init(MP, DM, F.G, (int)blockIdx.x); EpiF32 E{FP_Y};
                  { pg8::Unit u0; for (int i = 0; S.next(i, u0); ++i) geglu_fixup(F, u0.pm); }
                  pg8::gemm_phase(F.lds, g, S, E, F.wave);
                  skinny_gemm<false>(F, FP_GB + (size_t)MP * DFF, FP_WdownT, DFF, E); ); } SEAM(13); PEN(13);
    PST(14);
    if (IN(14)) { rows_final(F); } PEN(14);
#undef DUP
    if (PROBE_MASK != 0 && blockIdx.x == 0 && FTID(F) == 0) { const unsigned long long t0 = __builtin_amdgcn_s_memrealtime(); while (__builtin_amdgcn_s_memrealtime() - t0 < pr_acc) __builtin_amdgcn_s_sleep(8); }
#undef IN
#undef SEAM
}

#ifndef MK_ONE_LAUNCH
#define MK_ONE_LAUNCH 1
#endif
extern "C" void kernel_launch(void* const* d_in, const int* in_sizes, int n_in, void* d_out, int out_size, void* d_ws, size_t ws_size, hipStream_t stream) {
    static int grid = 0;
    if (grid == 0) {
        if (n_in != 32 || out_size != (int)OUT_TOTAL || ws_size < WS_END) { fprintf(stderr, "kernel_launch: unexpected sizes n_in %d out %d ws %zu\n", n_in, out_size, ws_size); grid = -1; return; }
        int dev = 0, cus = 0, per_cu = 0;
        if (hipGetDevice(&dev) != hipSuccess || hipDeviceGetAttribute(&cus, hipDeviceAttributeMultiprocessorCount, dev) != hipSuccess) { grid = -1; return; }
        if (hipFuncSetAttribute((const void*)fwd_kernel, hipFuncAttributeMaxDynamicSharedMemorySize, LDS_BYTES) != hipSuccess) { fprintf(stderr, "kernel_launch: hipFuncSetAttribute failed\n"); grid = -1; return; }
        if (hipOccupancyMaxActiveBlocksPerMultiprocessor(&per_cu, (const void*)fwd_kernel, NTHR, LDS_BYTES) != hipSuccess || per_cu < 1) fprintf(stderr, "kernel_launch: occupancy query reports %d\n", per_cu);
        (void)hipGetLastError();
        grid = cus;
    }
    if (grid < 0) return;
    if (hipMemsetAsync((char*)d_ws + WS_CTL, 0, CTL_ZERO_BYTES, stream) != hipSuccess) return;
    Args a{};
    for (int i = 0; i < 32; ++i) a.in[i] = d_in[i];
    a.out = (float*)d_out; a.ws = (unsigned char*)d_ws;
#if MK_ONE_LAUNCH
    a.ph_lo = 0; a.ph_hi = NPHASE;
    hipLaunchKernelGGL(fwd_kernel, dim3(grid), dim3(NTHR), LDS_BYTES, stream, a);
#else
    for (int p = 0; p < NPHASE; ++p) { a.ph_lo = p; a.ph_hi = p + 1; hipLaunchKernelGGL(fwd_kernel, dim3(grid), dim3(NTHR), LDS_BYTES, stream, a); }
#endif
}
```

```cpp
#include <hip/hip_runtime.h>
#include <cstdio>
#include <cstdint>

#define LAS __attribute__((address_space(3)))
#define GAS __attribute__((address_space(1)))
typedef unsigned short bf16_t;
typedef short bf16x8 __attribute__((ext_vector_type(8)));
typedef short s16x4 __attribute__((ext_vector_type(4)));
typedef short v4i16_t __attribute__((ext_vector_type(4)));
typedef float f32x2 __attribute__((ext_vector_type(2)));
typedef float f32x4 __attribute__((ext_vector_type(4)));
typedef float f32x16 __attribute__((ext_vector_type(16)));
typedef unsigned u32x2 __attribute__((ext_vector_type(2)));
typedef unsigned u32x4 __attribute__((ext_vector_type(4)));
typedef __bf16 bf16x2_t __attribute__((ext_vector_type(2)));
typedef GAS unsigned gu32;

constexpr int DM = 1024, TP = 8192, MP = 16384, MS = 512, MT = MP + MS;
constexpr int NSEQ = 128, TS = 4, NPAGES = 16, PAGE = 128, PAST = 2048;
constexpr int DIN = 5640, ZP = 5632, ZN = 5888, DFF = 2816;
constexpr int ZQ = 0, ZK = 512, ZV = 1024, ZO = 1536, ZDQ = 2048, ZDK = 2560, ZDV = 3072, ZGM = 3584, ZGD = 4608;
__host__ __device__ constexpr size_t zbase(int col) { return (size_t)(col >> 8) * MT * 256 + (size_t)(col & 255); }
constexpr int ZR = 256;
constexpr float EPS = 1e-6f, LAM_INIT = 0.2f, LOG2E = 1.4426950408889634f;
constexpr float QSCALE = 0.125f * LOG2E;
constexpr float KSCALE = 0.08838834764831845f;
constexpr size_t OFF_Y = 0, OFF_KP = 17301504, OFF_VP = 25690112, OFF_CP = 34078720, OFF_NP = 34209792, OFF_MP = 34210816, OFF_CVP = 34210824,
                 OFF_KS = 34222088, OFF_VS = 34484232, OFF_CS = 34746376, OFF_NS = 43134984, OFF_MS = 43200520, OFF_CVS = 43201032, OUT_TOTAL = 43921928;
constexpr size_t MiB = 1u << 20;
constexpr size_t WS_CTL = 0, CTL_ZERO_BYTES = 65536;
constexpr size_t WS_WIN = 639 * MiB  , WS_WUP = 12 * MiB, WS_WDOWN = 23 * MiB, WS_WOUT = 29 * MiB, WS_WPM = 31 * MiB, WS_WPD = 32 * MiB;
constexpr size_t WS_ADA = 33 * MiB, WS_IG = 37 * MiB, WS_LF = 37 * MiB + 512 * 1024, WS_ST = 38 * MiB, WS_NU = 38 * MiB + 65536, WS_NPREV = 39 * MiB, WS_MPREV = 39 * MiB + 768 * 1024;
constexpr size_t WS_H1 = 40 * MiB, WS_Z = 73 * MiB, WS_U = 255 * MiB, WS_CPREV = 319 * MiB, WS_HM = 351 * MiB, WS_HD = 368 * MiB, WS_O1 = 385 * MiB, WS_O2 = 417 * MiB;
constexpr size_t WS_MG = 449 * MiB, WS_Y = 482 * MiB, WS_UA = 548 * MiB, WS_UB = 639 * MiB, WS_G = 730 * MiB, WS_DPART = 821 * MiB, WS_END = 838 * MiB;
constexpr int CW_BAR = 4096, CW_SCHED = 8192;
#ifndef DEC_LIM8
#define DEC_LIM8 10
#endif
constexpr int RING_BYTES = 131072, MISC_OFF = RING_BYTES + 320, LDS_BYTES = 147456;
constexpr int NWAVES = 8, NTHR = 512;

__device__ __forceinline__ unsigned pk2(float lo, float hi) { f32x2 v = {lo, hi}; bf16x2_t b = __builtin_convertvector(v, bf16x2_t); return __builtin_bit_cast(unsigned, b); }
__device__ __forceinline__ bf16_t f2bf(float x) { return (bf16_t)(pk2(x, 0.f) & 0xffffu); }
__device__ __forceinline__ float bflo(unsigned u) { return __uint_as_float(u << 16); }
__device__ __forceinline__ float bfhi(unsigned u) { return __uint_as_float(u & 0xffff0000u); }
__device__ __forceinline__ float bf2f(bf16_t u) { return __uint_as_float(((unsigned)u) << 16); }
__device__ __forceinline__ bf16x8 pack8(f32x4 a, f32x4 b) { u32x4 w; w.x = pk2(a.x, a.y); w.y = pk2(a.z, a.w); w.z = pk2(b.x, b.y); w.w = pk2(b.z, b.w); return __builtin_bit_cast(bf16x8, w); }
__device__ __forceinline__ void unpack8(u32x4 w, f32x4& a, f32x4& b) { a.x = bflo(w.x); a.y = bfhi(w.x); a.z = bflo(w.y); a.w = bfhi(w.y); b.x = bflo(w.z); b.y = bfhi(w.z); b.z = bflo(w.w); b.w = bfhi(w.w); }
__device__ __forceinline__ float wave_sum(float v) {
#pragma unroll
    for (int o = 1; o < 64; o <<= 1) v += __shfl_xor(v, o);
    return v;
}
__device__ __forceinline__ float wave_max(float v) {
#pragma unroll
    for (int o = 1; o < 64; o <<= 1) v = fmaxf(v, __shfl_xor(v, o));
    return v;
}
__device__ __forceinline__ float wave_scan_sum(float v, int lane) {
#pragma unroll
    for (int o = 1; o < 64; o <<= 1) { const float t = __shfl_up(v, o); if (lane >= o) v += t; }
    return v;
}
__device__ __forceinline__ float wave_scan_max(float v, int lane) {
#pragma unroll
    for (int o = 1; o < 64; o <<= 1) { const float t = __shfl_up(v, o); if (lane >= o) v = fmaxf(v, t); }
    return v;
}
__device__ __forceinline__ float sigmoidf_(float x) { return __builtin_amdgcn_rcpf(1.f + __builtin_amdgcn_exp2f(-x * LOG2E)); }
__device__ __forceinline__ float log_sigmoid(float x) { return fminf(x, 0.f) - log1pf(__expf(-fabsf(x))); }
__device__ __forceinline__ int crow(int reg, int h) { return (reg & 3) + 8 * (reg >> 2) + 4 * h; }
#define MFMA32(a, b, c) __builtin_amdgcn_mfma_f32_32x32x16_bf16((a), (b), (c), 0, 0, 0)
#define MFMA16(a, b, c) __builtin_amdgcn_mfma_f32_16x16x32_bf16((a), (b), (c), 0, 0, 0)
__device__ __forceinline__ s16x4 tr_rd(const LAS unsigned char* p) { return __builtin_bit_cast(s16x4, __builtin_amdgcn_ds_read_tr16_b64_v4i16((LAS v4i16_t*)p)); }
__device__ __forceinline__ bf16x8 cat4(s16x4 lo, s16x4 hi) { return (bf16x8){lo[0], lo[1], lo[2], lo[3], hi[0], hi[1], hi[2], hi[3]}; }
#define WG_BAR() __syncthreads()
__device__ __forceinline__ int lane_id() { int l; asm volatile("v_mbcnt_lo_u32_b32 %0, -1, 0\n\tv_mbcnt_hi_u32_b32 %0, -1, %0" : "=v"(l)); return l; }
#define FTID(F) ((F).wave * 64 + lane_id())

namespace pg8 {
constexpr int BM = 256, BK = 64, HALF = 128, HTB = HALF * BK * 2, STAGE_BYTES = 8 * HTB, NXCD = 8, WGM = 8;
__host__ __device__ __forceinline__ int lds_byte(int r, int c) { const int st = (r >> 4) * 2 + (c >> 5), rr = r & 15, cc = c & 31, ob = rr * 64 + cc * 2; return st * 1024 + (ob ^ (((ob >> 9) & 1) << 5)); }
__host__ __device__ __forceinline__ void stage_rc(int b, int& R, int& C) { const int st = b / 1024, sb = b % 1024, swz = sb ^ (((sb >> 9) & 1) << 5); R = (st >> 1) * 16 + swz / 64; C = (st & 1) * 32 + (swz % 64) / 2; }
__host__ __device__ __forceinline__ int perm32(int rho) { const int n = rho >> 4, i = rho & 15; return 8 * (i >> 2) + 4 * n + (i & 3); }
struct Unit { int pm, pn, half; };
struct Gemm { const bf16_t* A; const bf16_t* Bt; int M, N, K, ld; };
struct StaticOrder {
    int nM, nN, nwg, G, c;
    __host__ __device__ __forceinline__ void init(int M, int N, int G_, int c_) { nM = M / BM; nN = N / BM; nwg = nM * nN; G = G_; c = c_; }
    __host__ __device__ __forceinline__ bool next(int i, Unit& u) const {
        const long L = (long)i * G + c; if (L >= nwg) return false;
        int wgid = (int)L; { const int q = nwg / NXCD, r = nwg % NXCD, xcd = wgid % NXCD, off = wgid / NXCD; wgid = (xcd < r ? xcd * (q + 1) : r * (q + 1) + (xcd - r) * q) + off; }
        const int nig = WGM * nN, gid = wgid / nig, fm = gid * WGM, gsz = (nM - fm) < WGM ? (nM - fm) : WGM;
        u.pm = fm + ((wgid % nig) % gsz); u.pn = (wgid % nig) / gsz; u.half = 0; return true;
    }
};
template <class Epi, bool SPLIT2 = false>
__device__ __forceinline__ void gemm_phase(LAS unsigned char* lds, const Gemm g, const StaticOrder& S, const Epi& E, int wave) {
    const int wid = wave, lane = lane_id(), tid = wid * 64 + lane, wr = wid >> 2, wc = wid & 3, fr = lane & 15, fq = lane >> 4;
    const int K = g.K, nt = K / BK, LD = g.ld;
    unsigned voffA[2], voffB[2];
#pragma unroll
    for (int i = 0; i < 2; ++i) { int R, C; stage_rc(tid * 16 + i * 8192, R, C); const int Rb = (R & ~31) + perm32(R & 31);
        voffA[i] = (unsigned)(R * LD + C) * 2u; voffB[i] = (unsigned)(Rb * LD + C) * 2u; }
    const size_t kstep = (size_t)(BK * 2);
    const size_t hstep = (size_t)HALF * LD * 2;
    const size_t tstep = 2 * hstep;
    const unsigned ldsw = (unsigned)wid * 1024u;
    const int aoff = lds_byte(wr * 64 + fr, fq * 8), boff = lds_byte(wc * 32 + fr, fq * 8);
#define PG8_SA(b, h) (((b) * 2 + (h)) * HTB)
#define PG8_SB(b, h) ((4 + (b) * 2 + (h)) * HTB)
#define PG8_STAGE(bufoff, gbase, voff) do { _Pragma("unroll") for (int _i = 0; _i < 2; ++_i) \
        __builtin_amdgcn_global_load_lds((const unsigned*)((const char*)(gbase) + (voff)[_i]), (LAS unsigned*)(lds + (bufoff) + ldsw + _i * 8192), 16, 0, 0); } while (0)
#define PG8_LDA(dst, b, h) do { _Pragma("unroll") for (int m = 0; m < 4; ++m) _Pragma("unroll") for (int k = 0; k < 2; ++k) dst[m][k] = *(const LAS bf16x8*)(lds + PG8_SA(b, h) + aoff + m * 2048 + k * 1024); } while (0)
#define PG8_LDB(dst, b, h) do { _Pragma("unroll") for (int n = 0; n < 2; ++n) _Pragma("unroll") for (int k = 0; k < 2; ++k) dst[n][k] = *(const LAS bf16x8*)(lds + PG8_SB(b, h) + boff + n * 2048 + k * 1024); } while (0)
#define PG8_MMA(ai, bj, At, Bt) do { __builtin_amdgcn_s_setprio(1); _Pragma("unroll") for (int m = 0; m < 4; ++m) _Pragma("unroll") for (int n = 0; n < 2; ++n) _Pragma("unroll") for (int k = 0; k < 2; ++k) \
        acc[ai][bj][m][n] = __builtin_amdgcn_mfma_f32_16x16x32_bf16(Bt[n][k], At[m][k], acc[ai][bj][m][n], 0, 0, 0); __builtin_amdgcn_s_setprio(0); } while (0)
#define PG8_WAIT_V(n) asm volatile("s_waitcnt vmcnt(" #n ")" ::: "memory")
#define PG8_WAIT_L(n) asm volatile("s_waitcnt lgkmcnt(" #n ")" ::: "memory")
#define PG8_BAR __builtin_amdgcn_s_barrier()
#define PG8_SCHED __builtin_amdgcn_sched_barrier(0)
#define PG8_NEXT(i, u) (SPLIT2 ? (S.next((i) >> 1, u) ? ((u).half = (i) & 1, true) : false) : S.next((i), u))
#define PG8_UA(u) ((const char*)g.A + (size_t)(u).pm * tstep + (size_t)(u).half * K * 2)
#define PG8_UB(u) ((const char*)g.Bt + (size_t)(u).pn * tstep + (size_t)(u).half * K * 2)
    Unit cur, nxt; int ui = 0;
    if (!PG8_NEXT(0, cur)) return;
    f32x4 acc[2][2][4][2];
#pragma unroll
    for (int a = 0; a < 2; ++a)
#pragma unroll
        for (int b = 0; b < 2; ++b)
#pragma unroll
            for (int m = 0; m < 4; ++m)
#pragma unroll
                for (int n = 0; n < 2; ++n) acc[a][b][m][n] = (f32x4){0.f, 0.f, 0.f, 0.f};
    bf16x8 At[4][2], B0[2][2], B1[2][2];
    const char* cA = PG8_UA(cur); const char* cB = PG8_UB(cur);
    PG8_STAGE(PG8_SB(0, 0), cB, voffB); PG8_STAGE(PG8_SB(0, 1), cB + hstep, voffB); PG8_STAGE(PG8_SA(0, 0), cA, voffA); PG8_STAGE(PG8_SA(0, 1), cA + hstep, voffA);
    if (wr == 1) PG8_BAR;
    PG8_WAIT_V(2); PG8_BAR;
    PG8_STAGE(PG8_SB(1, 0), cB + kstep, voffB); PG8_STAGE(PG8_SA(1, 0), cA + kstep, voffA); PG8_STAGE(PG8_SB(1, 1), cB + hstep + kstep, voffB);
    PG8_WAIT_V(6); PG8_BAR;
    for (;;) {
        const bool has_next = PG8_NEXT(ui + 1, nxt);
        const char* nA = has_next ? PG8_UA(nxt) : cA; const char* nB = has_next ? PG8_UB(nxt) : cB;
        for (int t = 0; t < nt; t += 2) {
            const bool last = (t == nt - 2);
            const char* a1 = cA + (size_t)(t + 1) * kstep;
            const char* a2 = last ? nA : cA + (size_t)(t + 2) * kstep; const char* b2 = last ? nB : cB + (size_t)(t + 2) * kstep;
            const char* a3 = a2 + kstep; const char* b3 = b2 + kstep;
            PG8_LDB(B0, 0, 0); PG8_LDB(B1, 0, 1); PG8_SCHED; PG8_LDA(At, 0, 0); PG8_STAGE(PG8_SA(1, 1), a1 + hstep, voffA);
            PG8_WAIT_V(8); PG8_WAIT_L(0); PG8_BAR; PG8_MMA(0, 0, At, B0); PG8_MMA(0, 1, At, B1); PG8_BAR; PG8_SCHED;
            PG8_LDA(At, 0, 1); PG8_STAGE(PG8_SB(0, 0), b2, voffB); PG8_STAGE(PG8_SB(0, 1), b2 + hstep, voffB); PG8_STAGE(PG8_SA(0, 0), a2, voffA);
            PG8_WAIT_V(8); PG8_WAIT_L(0); PG8_BAR; PG8_MMA(1, 0, At, B0); PG8_MMA(1, 1, At, B1); PG8_BAR; PG8_SCHED;
            PG8_LDB(B0, 1, 0); PG8_LDB(B1, 1, 1); PG8_SCHED; PG8_LDA(At, 1, 0); PG8_STAGE(PG8_SA(0, 1), a2 + hstep, voffA);
            PG8_WAIT_V(8); PG8_WAIT_L(0); PG8_BAR; PG8_MMA(0, 0, At, B0); PG8_MMA(0, 1, At, B1); PG8_BAR; PG8_SCHED;
            PG8_LDA(At, 1, 1); PG8_STAGE(PG8_SB(1, 0), b3, voffB); PG8_STAGE(PG8_SB(1, 1), b3 + hstep, voffB); PG8_STAGE(PG8_SA(1, 0), a3, voffA);
            PG8_WAIT_V(8); PG8_WAIT_L(0); PG8_BAR; PG8_MMA(1, 0, At, B0); PG8_MMA(1, 1, At, B1); PG8_BAR; PG8_SCHED;
        }
        if (wr == 0) PG8_BAR;
        const bool first_half = SPLIT2 && cur.half == 0;
        {
            const int row0 = cur.pm * BM + wr * 64 + fr, col0 = cur.pn * BM + wc * 32 + 8 * fq;
            if constexpr (SPLIT2) { if (first_half) {
#pragma unroll
                for (int ai = 0; ai < 2; ++ai)
#pragma unroll
                    for (int m = 0; m < 4; ++m) {
#pragma unroll
                        for (int bj = 0; bj < 2; ++bj) E.mid8(row0 + ai * HALF + m * 16, col0 + bj * HALF, acc[ai][bj][m][0], acc[ai][bj][m][1]);
                        asm volatile("" : "+v"(acc[ai][0][m][0]), "+v"(acc[ai][0][m][1]), "+v"(acc[ai][1][m][0]), "+v"(acc[ai][1][m][1]) :: "memory"); } } }
            if constexpr (Epi::TILE) E.tile(acc, cur.pm, cur.pn, wr, wc, fr, fq, (LAS float*)(lds + RING_BYTES + 2048));
            else if (!first_half) {
#pragma unroll
            for (int ai = 0; ai < 2; ++ai)
#pragma unroll
                for (int m = 0; m < 4; ++m)
#pragma unroll
                    for (int bj = 0; bj < 2; ++bj) E.st8(row0 + ai * HALF + m * 16, col0 + bj * HALF, acc[ai][bj][m][0], acc[ai][bj][m][1]);
            }
        }
        if (!has_next) break;
        if (!first_half) {
#pragma unroll
        for (int a = 0; a < 2; ++a)
#pragma unroll
            for (int b = 0; b < 2; ++b)
#pragma unroll
                for (int m = 0; m < 4; ++m)
#pragma unroll
                    for (int n = 0; n < 2; ++n) acc[a][b][m][n] = (f32x4){0.f, 0.f, 0.f, 0.f};
        }
        cur = nxt; cA = nA; cB = nB; ++ui;
        if (wr == 1) PG8_BAR;
    }
    PG8_WAIT_V(0);
    PG8_BAR;
#undef PG8_NEXT
#undef PG8_UA
#undef PG8_UB
#undef PG8_SA
#undef PG8_SB
#undef PG8_STAGE
#undef PG8_LDA
#undef PG8_LDB
#undef PG8_MMA
#undef PG8_WAIT_V
#undef PG8_WAIT_L
#undef PG8_BAR
#undef PG8_SCHED
}
}

#define XB_TMO      128
#define XB_XCNT(j)  (256  + 64 * (j))
#define XB_XSUB(j)  (1280 + 64 * (j))
#define XB_XGEN(j)  (2304 + 64 * (j))
#define XB_TOP      3328
#define XB_TOPGEN   3392
#define XCD_BAR_WORDS 3456
#define XB_SPIN_CAP (1u << 18)
__device__ __forceinline__ unsigned xb_ld(unsigned* p)              { return __hip_atomic_load(p, __ATOMIC_RELAXED, __HIP_MEMORY_SCOPE_AGENT); }
__device__ __forceinline__ unsigned xb_add(unsigned* p, unsigned v) { return __hip_atomic_fetch_add(p, v, __ATOMIC_RELAXED, __HIP_MEMORY_SCOPE_AGENT); }
__device__ __forceinline__ unsigned xb_xcc_id() { return (unsigned)__builtin_amdgcn_s_getreg((3 << 11) | 20) & 0xFu; }
#define XB_SPIN(cond, bar) do { unsigned _sp = 0; while (cond) { __builtin_amdgcn_s_sleep(1); \
    if ((++_sp & 255u) == 0u) { if (xb_ld(&(bar)[XB_TMO])) break; if (_sp > XB_SPIN_CAP) { atomicAdd(&(bar)[XB_TMO], 1u); break; } } } } while (0)
struct XcdBarrier { unsigned* bar; unsigned x; volatile LAS unsigned* st; int wave; };
__device__ __forceinline__ XcdBarrier xcd_barrier_post(unsigned* bar, volatile LAS unsigned* st, int wave) {
    XcdBarrier b; b.bar = bar; b.x = xb_xcc_id(); b.st = st; b.wave = wave;
    if (wave == 0 && lane_id() == 0) (void)xb_add(&bar[XB_XCNT(b.x)], 1u);
    return b;
}
__device__ __forceinline__ void xcd_barrier_complete(unsigned* bar, unsigned x, unsigned& nloc, unsigned& nx) {
    const unsigned G = gridDim.x * gridDim.y * gridDim.z;
    unsigned sum, cnt, mine, sp = 0u;
    for (;;) {
        sum = 0u; cnt = 0u; mine = 0u;
#pragma unroll
        for (unsigned j = 0; j < 16; ++j) { const unsigned c = xb_ld(&bar[XB_XCNT(j)]); sum += c; cnt += (c > 0u) ? 1u : 0u; mine = (j == x) ? c : mine; }
        if (sum == G) break;
        __builtin_amdgcn_s_sleep(1);
        if ((++sp & 255u) == 0u) { if (xb_ld(&bar[XB_TMO])) break; if (sp > XB_SPIN_CAP) { atomicAdd(&bar[XB_TMO], 1u); break; } }
    }
    nloc = mine > 0u ? mine : 1u; nx = cnt > 0u ? cnt : 1u;
}
__device__ __forceinline__ void xcd_barrier(const XcdBarrier& b) {
    asm volatile("s_waitcnt vmcnt(0)" ::: "memory");
    __syncthreads();
    if (b.wave == 0 && lane_id() == 0) {
        unsigned* bar = b.bar;
        __builtin_amdgcn_s_waitcnt(0);
        unsigned nloc = b.st[0], nx = b.st[1];
        if (nloc == 0u) { xcd_barrier_complete(bar, b.x, nloc, nx); b.st[0] = nloc; b.st[1] = nx; }
        const unsigned old = xb_add(&bar[XB_XSUB(b.x)], 1u);
        const unsigned gen = old / nloc;
        if (old + 1u == (gen + 1u) * nloc) {
            __builtin_amdgcn_fence(__ATOMIC_RELEASE, "agent");
            asm volatile("s_waitcnt vmcnt(0)" ::: "memory");
            const unsigned og = xb_add(&bar[XB_TOP], 1u);
            const unsigned tg = og / nx;
            if (og + 1u == (tg + 1u) * nx) xb_add(&bar[XB_TOPGEN], 1u);
            else XB_SPIN(xb_ld(&bar[XB_TOPGEN]) == tg, bar);
            __builtin_amdgcn_fence(__ATOMIC_ACQUIRE, "agent");
            xb_add(&bar[XB_XGEN(b.x)], 1u);
            asm volatile("s_waitcnt vmcnt(0)" ::: "memory");
        } else {
            XB_SPIN(xb_ld(&bar[XB_XGEN(b.x)]) == gen, bar);
            __builtin_amdgcn_fence(__ATOMIC_ACQUIRE, "agent");
            asm volatile("s_waitcnt vmcnt(0)" ::: "memory");
        }
    }
    __syncthreads();
}

struct Args { const void* in[32]; float* out; unsigned char* ws; int ph_lo, ph_hi; };
struct Frame { LAS unsigned char* lds; int wave, vcu, G; const Args* a; };
#define FP_x_prompt ((const float*)F.a->in[0])
#define FP_x_sample ((const float*)F.a->in[1])
#define FP_c_prompt ((const float*)F.a->in[2])
#define FP_c_sample ((const float*)F.a->in[3])
#define FP_cache_k ((const float*)F.a->in[4])
#define FP_cache_v ((const float*)F.a->in[5])
#define FP_page_table ((const int*)F.a->in[6])
#define FP_state_C ((const float*)F.a->in[7])
#define FP_state_n ((const float*)F.a->in[8])
#define FP_state_m ((const float*)F.a->in[9])
#define FP_state_conv ((const float*)F.a->in[10])
#define FP_w_ada ((const float*)F.a->in[11])
#define FP_b_ada ((const float*)F.a->in[12])
#define FP_g_pre_mix ((const float*)F.a->in[13])
#define FP_g_post_mix ((const float*)F.a->in[14])
#define FP_w_in ((const float*)F.a->in[15])
#define FP_b_if ((const float*)F.a->in[16])
#define FP_g_mlstm ((const float*)F.a->in[17])
#define FP_lq1 ((const float*)F.a->in[18])
#define FP_lk1 ((const float*)F.a->in[19])
#define FP_lq2 ((const float*)F.a->in[20])
#define FP_lk2 ((const float*)F.a->in[21])
#define FP_g_diff ((const float*)F.a->in[22])
#define FP_w_proj_m ((const float*)F.a->in[23])
#define FP_w_proj_d ((const float*)F.a->in[24])
#define FP_w_out ((const float*)F.a->in[25])
#define FP_g_pre_ffn ((const float*)F.a->in[26])
#define FP_g_post_ffn ((const float*)F.a->in[27])
#define FP_w_up ((const float*)F.a->in[28])
#define FP_conv_w ((const float*)F.a->in[29])
#define FP_conv_b ((const float*)F.a->in[30])
#define FP_w_down ((const float*)F.a->in[31])
#define FP_WinT ((bf16_t*)(F.a->ws + WS_WIN))
#define FP_WupT ((bf16_t*)(F.a->ws + WS_WUP))
#define FP_WdownT ((bf16_t*)(F.a->ws + WS_WDOWN))
#define FP_WoutT ((bf16_t*)(F.a->ws + WS_WOUT))
#define FP_WpT ((bf16_t*)(F.a->ws + WS_WPM))
#define FP_H1 ((bf16_t*)(F.a->ws + WS_H1))
#define FP_Z ((bf16_t*)(F.a->ws + WS_Z))
#define FP_CPREV ((bf16_t*)(F.a->ws + WS_CPREV))
#define FP_HMD ((bf16_t*)(F.a->ws + WS_HM))
#define FP_MG ((bf16_t*)(F.a->ws + WS_MG))
#define FP_AH ((float*)(F.a->ws + WS_UA))
#define FP_AF ((float*)(F.a->ws + WS_UA + 2 * MiB))
#define FP_BF ((float*)(F.a->ws + WS_UA + 4 * MiB))
#define FP_GB ((bf16_t*)(F.a->ws + WS_G))
#define FP_ADA ((float*)(F.a->ws + WS_ADA))
#define FP_IG ((float*)(F.a->ws + WS_IG))
#define FP_LF ((float*)(F.a->ws + WS_LF))
#define FP_ST ((float*)(F.a->ws + WS_ST))
#define FP_NU ((float*)(F.a->ws + WS_NU))
#define FP_NPREV ((float*)(F.a->ws + WS_NPREV))
#define FP_MPREV ((float*)(F.a->ws + WS_MPREV))
#define FP_U ((float*)(F.a->ws + WS_U))
#define FP_O1 ((bf16_t*)(F.a->ws + WS_O1))
#define FP_O2 ((bf16_t*)(F.a->ws + WS_O2))
#define FP_Y ((bf16_t*)(F.a->ws + WS_Y))
#define FP_DPART ((float*)(F.a->ws + WS_DPART))
#define FP_X1 ((bf16_t*)(F.a->ws + WS_UB + 16 * MiB))
#define FP_out (F.a->out)


__device__ __forceinline__ void transpose_item(const float* W, int pitch, int scol0, int K, bf16_t* WT, int drow0, LAS float* scr, int kb, int nb, int lane, int koff = 0) {
    const int k0 = 64 * kb, n0 = 32 * nb;
    float tv[32];
#pragma unroll
    for (int i = 0; i < 32; ++i) { const int kk = 2 * i + (lane >> 5); tv[i] = W[(size_t)(k0 + kk) * pitch + scol0 + n0 + (lane & 31)]; }
#pragma unroll
    for (int i = 0; i < 32; ++i) { const int kk = 2 * i + (lane >> 5); scr[kk * 33 + (lane & 31)] = tv[i]; }
    asm volatile("s_waitcnt lgkmcnt(0)" ::: "memory");
    const int c = lane & 7;
#pragma unroll
    for (int j = 0; j < 4; ++j) { const int n = (lane >> 3) + 8 * j; const LAS float* s = scr + (8 * c) * 33 + n;
        u32x4 o; o.x = pk2(s[0 * 33], s[1 * 33]); o.y = pk2(s[2 * 33], s[3 * 33]); o.z = pk2(s[4 * 33], s[5 * 33]); o.w = pk2(s[6 * 33], s[7 * 33]);
        *(u32x4*)(WT + (size_t)(drow0 + n0 + n) * K + koff + k0 + 8 * c) = o; }
    asm volatile("s_waitcnt lgkmcnt(0)" ::: "memory");
}
struct TBlock { const float* W; bf16_t* WT; int pitch, col_a, col_b, k0, wt_pitch, koff, drow0; };
__device__ __forceinline__ TBlock tblock_of(const Frame& F, int it) {
    constexpr int B0 = 16 * 22, B1 = 8 * 4, B2 = 8 * 4, B3 = 16 * 4, B4 = 16 * 22;
    int r = it; TBlock t;
    if (r < B0) { const int kb = r / 22, nb = r % 22; t = {FP_w_in, FP_WinT, DIN, nb < 8 ? 256 * nb : 2056 + 256 * (nb - 8), -1, 64 * kb, 1024, 0, 256 * nb}; return t; } r -= B0;
    if (r < B1) { t = {FP_w_proj_m, FP_WpT, 1024, 256 * (r & 3), -1, 64 * (r >> 2), 1024, 0, 256 * (r & 3)}; return t; } r -= B1;
    if (r < B2) { t = {FP_w_proj_d, FP_WpT, 1024, 256 * (r & 3), -1, 64 * (r >> 2), 1024, 512, 256 * (r & 3)}; return t; } r -= B2;
    if (r < B3) { t = {FP_w_out, FP_WoutT, 1024, 256 * (r & 3), -1, 64 * (r >> 2), 1024, 0, 256 * (r & 3)}; return t; } r -= B3;
    if (r < B4) { const int kb = r / 22, pn = r % 22; t = {FP_w_up, FP_WupT, 2 * DFF, 128 * pn, DFF + 128 * pn, 64 * kb, 1024, 0, 256 * pn}; return t; } r -= B4;
    t = {FP_w_down, FP_WdownT, 1024, 256 * (r & 3), -1, 64 * (r >> 2), DFF, 0, 256 * (r & 3)}; return t;
}
__device__ __forceinline__ void p0_transposes(const Frame& F) {
    constexpr int NBLK = 16 * 22 + 8 * 4 + 8 * 4 + 16 * 4 + 16 * 22 + 44 * 4;
    const int lane = lane_id(), wid = F.wave, tid = wid * 64 + lane;
    LAS float* tile = (LAS float*)F.lds;
    f32x4 v[8];
    int it = F.vcu;
    if (it < NBLK) { const TBlock t = tblock_of(F, it); const int scol = (t.col_b >= 0 && lane >= 32) ? t.col_b + 4 * (lane - 32) : t.col_a + 4 * lane;
#pragma unroll
        for (int i = 0; i < 8; ++i) v[i] = *(const f32x4*)(t.W + (size_t)(t.k0 + 8 * wid + i) * t.pitch + scol); }
    for (; it < NBLK; it += F.G) {
        const TBlock t = tblock_of(F, it);
#pragma unroll
        for (int i = 0; i < 8; ++i) *(LAS f32x4*)(tile + (8 * wid + i) * 260 + 4 * lane) = v[i];
        if (it + F.G < NBLK) { const TBlock tn = tblock_of(F, it + F.G); const int scol = (tn.col_b >= 0 && lane >= 32) ? tn.col_b + 4 * (lane - 32) : tn.col_a + 4 * lane;
#pragma unroll
            for (int i = 0; i < 8; ++i) v[i] = *(const f32x4*)(tn.W + (size_t)(tn.k0 + 8 * wid + i) * tn.pitch + scol); }
        WG_BAR();
#pragma unroll
        for (int i = 0; i < 4; ++i) { const int idx = tid + 512 * i, n = idx >> 3, c = idx & 7; const LAS float* sp = tile + (8 * c) * 260 + n;
            u32x4 o; o.x = pk2(sp[0], sp[260]); o.y = pk2(sp[2 * 260], sp[3 * 260]); o.z = pk2(sp[4 * 260], sp[5 * 260]); o.w = pk2(sp[6 * 260], sp[7 * 260]);
            *(u32x4*)(t.WT + (size_t)(t.drow0 + n) * t.wt_pitch + t.koff + t.k0 + 8 * c) = o; }
        WG_BAR();
    }
    {
        LAS float* scr = (LAS float*)(F.lds + F.wave * 8448);
        const int gw = F.vcu * NWAVES + F.wave; if (gw < 16) transpose_item(FP_w_in, DIN, 2048 - ZP, 1024, FP_WinT, 0, scr, gw, ZP / 32, lane_id());
    }
}
__device__ __forceinline__ void p0_ada(const Frame& F) {
    const int lane = lane_id(), r = lane & 31, h = lane >> 5, w = F.wave, tid = w * 64 + lane;
    LAS float* part = (LAS float*)F.lds;
    for (int task = F.vcu; task < 192; task += F.G) {
        const int n0 = 32 * task;
        bf16x8 bw[8];
#pragma unroll
        for (int ks = 0; ks < 8; ++ks) { const float* p = FP_w_ada + (size_t)(128 * w + 16 * ks + 8 * h) * 6144 + n0 + r;
            f32x4 a, b; a.x = p[0]; a.y = p[6144]; a.z = p[2 * 6144]; a.w = p[3 * 6144]; b.x = p[4 * 6144]; b.y = p[5 * 6144]; b.z = p[6 * 6144]; b.w = p[7 * 6144]; bw[ks] = pack8(a, b); }
        f32x16 acc[5];
        LAS unsigned char* ct = F.lds + w * 8704;
        int lo_ = lane; asm volatile("" : "+v"(lo_));
        const int lrow = lo_ >> 5, lcol = (lo_ & 31) * 4;
#pragma unroll
        for (int rt = 0; rt < 5; ++rt) {
            f32x4 cv[16];
#pragma unroll
            for (int i = 0; i < 16; ++i) { const int R0 = 32 * rt + 2 * i;
                if (R0 == 0) cv[i] = *(const f32x4*)(FP_c_prompt + (size_t)lrow * 1024 + 128 * w + lcol);
                else if (R0 < 130) cv[i] = *(const f32x4*)(FP_c_sample + (size_t)(R0 - 2 + lrow) * 1024 + 128 * w + lcol);
                else cv[i] = (f32x4){0.f, 0.f, 0.f, 0.f}; }
#pragma unroll
            for (int i = 0; i < 16; ++i) { u32x2 o; o.x = pk2(cv[i].x, cv[i].y); o.y = pk2(cv[i].z, cv[i].w); *(LAS u32x2*)(ct + (2 * i + lrow) * 272 + lcol * 2) = o; }
            for (int i = 0; i < 16; ++i) acc[rt][i] = 0.f;
#pragma unroll
            for (int ks = 0; ks < 8; ++ks) acc[rt] = MFMA32(*(const LAS bf16x8*)(ct + r * 272 + (16 * ks + 8 * h) * 2), bw[ks], acc[rt]);
            asm volatile("s_waitcnt lgkmcnt(0)" ::: "memory");
        }
        WG_BAR();
#pragma unroll
        for (int batch = 0; batch < 2; ++batch) {
            const int rt0 = 3 * batch, nrt = batch ? 2 : 3;
#pragma unroll
            for (int j = 0; j < 3; ++j) if (j < nrt) {
#pragma unroll
                for (int i = 0; i < 16; ++i) part[((w * 3 + j) * 32 + crow(i, h)) * 32 + r] = acc[rt0 + j][i]; }
            WG_BAR();
            for (int idx = tid; idx < nrt * 1024; idx += NTHR) { const int j = idx >> 10, row = (idx >> 5) & 31, col = idx & 31; float sum = 0.f;
#pragma unroll
                for (int ww = 0; ww < 8; ++ww) sum += part[((ww * 3 + j) * 32 + row) * 32 + col];
                const int Rr = 32 * (rt0 + j) + row; if (Rr < 130) FP_ADA[(size_t)Rr * 6144 + n0 + col] = sum + FP_b_ada[n0 + col]; }
            WG_BAR();
        }
    }
}
__device__ __forceinline__ int crow_of(int m) { return m < MP ? (m >> 13) : 2 + ((m - MP) >> 2); }
__device__ __forceinline__ const float* xrow_of(const Frame& F, int m) { return m < MP ? FP_x_prompt + (size_t)m * DM : FP_x_sample + (size_t)(m - MP) * DM; }
__device__ __forceinline__ void p1_norm_gates(const Frame& F) {
    const int lane = lane_id(), gw = F.vcu * NWAVES + F.wave, NGW = F.G * NWAVES;
    const int r_lo = (int)(((long)gw * MT) / NGW), r_hi = (int)(((long)(gw + 1) * MT) / NGW);
    f32x4 gs[4], sh[4], vn[4], vn2[4];
#pragma unroll
    for (int j = 0; j < 4; ++j) { gs[j] = (f32x4){0.f, 0.f, 0.f, 0.f}; sh[j] = gs[j]; vn[j] = gs[j]; vn2[j] = gs[j]; }
    int ccur = -1;
    if (r_lo < r_hi) { const float* xr = xrow_of(F, r_lo);
#pragma unroll
        for (int j = 0; j < 4; ++j) vn[j] = *(const f32x4*)(xr + 4 * lane + 256 * j); }
    if (r_lo + 1 < r_hi) { const float* xr = xrow_of(F, r_lo + 1);
#pragma unroll
        for (int j = 0; j < 4; ++j) vn2[j] = *(const f32x4*)(xr + 4 * lane + 256 * j); }
    for (int m = r_lo; m < r_hi; ++m) {
        f32x4 v[4]; float ss = 0.f;
#pragma unroll
        for (int j = 0; j < 4; ++j) { v[j] = vn[j]; vn[j] = vn2[j]; }
        if (m + 2 < r_hi) { const float* xr = xrow_of(F, m + 2);
#pragma unroll
            for (int j = 0; j < 4; ++j) vn2[j] = *(const f32x4*)(xr + 4 * lane + 256 * j); }
        const int cr = crow_of(m);
        if (cr != ccur) { ccur = cr; const float* ada = FP_ADA + (size_t)cr * 6144;
#pragma unroll
            for (int j = 0; j < 4; ++j) { sh[j] = *(const f32x4*)(ada + 4 * lane + 256 * j); gs[j] = *(const f32x4*)(FP_g_pre_mix + 4 * lane + 256 * j) * (*(const f32x4*)(ada + 1024 + 4 * lane + 256 * j) + 1.f); } }
#pragma unroll
        for (int j = 0; j < 4; ++j) ss += (v[j].x * v[j].x + v[j].y * v[j].y) + (v[j].z * v[j].z + v[j].w * v[j].w);
        const float rs = rsqrtf(wave_sum(ss) * (1.f / DM) + EPS);
#pragma unroll
        for (int j = 0; j < 4; ++j) { const f32x4 hv = (v[j] * rs) * gs[j] + sh[j];
            u32x2 o; o.x = pk2(hv.x, hv.y); o.y = pk2(hv.z, hv.w); *(u32x2*)(FP_H1 + (size_t)m * DM + 4 * lane + 256 * j) = o; }
    }
}
struct EpiZ {
    static constexpr int MID_T = -1; static constexpr bool TILE = false;
    bf16_t* Z; float* out; float* IG; float* LF; const float* b_if;
    __device__ __forceinline__ void st8(int row, int col, f32x4 v0, f32x4 v1) const {
        if (col >= ZP) { if (col == ZP) { const f32x4 bi = *(const f32x4*)b_if, bf = *(const f32x4*)(b_if + 4);
                *(f32x4*)(IG + (size_t)row * 4) = v0 + bi; v1 = v1 + bf; *(f32x4*)(LF + (size_t)row * 4) = (f32x4){log_sigmoid(v1.x), log_sigmoid(v1.y), log_sigmoid(v1.z), log_sigmoid(v1.w)}; } return; }
        const int pn = col >> 8; const float sc = (pn == 2 || pn == 3) ? KSCALE : ((pn == 8 || pn == 9) ? QSCALE : 1.f);
        if (pn >= 10 && pn < 14) { const int kv = pn >= 12; const int c = col - (kv ? ZDV : ZDK);
            float* o = row < MP ? out + (kv ? OFF_VP : OFF_KP) + (size_t)row * 512 + c : out + (kv ? OFF_VS : OFF_KS) + (size_t)(row - MP) * 512 + c;
            *(f32x4*)o = v0; *(f32x4*)(o + 4) = v1; }
        if (pn >= 14) { v0.x = sigmoidf_(v0.x); v0.y = sigmoidf_(v0.y); v0.z = sigmoidf_(v0.z); v0.w = sigmoidf_(v0.w); v1.x = sigmoidf_(v1.x); v1.y = sigmoidf_(v1.y); v1.z = sigmoidf_(v1.z); v1.w = sigmoidf_(v1.w); }
        *(bf16x8*)(Z + zbase(col) + (size_t)row * ZR) = pack8(v0 * sc, v1 * sc);
    }
};
struct EpiPMD {
    static constexpr int MID_T = 6; static constexpr bool TILE = false;
    const bf16_t* Z; bf16_t* MG;
    __device__ __forceinline__ void mid8(int row, int col, f32x4& v0, f32x4& v1) const {
        const u32x4 gm = *(const u32x4*)(Z + zbase(ZGM + col) + (size_t)row * ZR), gd = *(const u32x4*)(Z + zbase(ZGD + col) + (size_t)row * ZR);
        f32x4 m0, m1, d0, d1; unpack8(gm, m0, m1); unpack8(gd, d0, d1);
        d0.x = fmaxf(d0.x, 1e-20f); d0.y = fmaxf(d0.y, 1e-20f); d0.z = fmaxf(d0.z, 1e-20f); d0.w = fmaxf(d0.w, 1e-20f); d1.x = fmaxf(d1.x, 1e-20f); d1.y = fmaxf(d1.y, 1e-20f); d1.z = fmaxf(d1.z, 1e-20f); d1.w = fmaxf(d1.w, 1e-20f);
        v0.x *= m0.x * __builtin_amdgcn_rcpf(d0.x); v0.y *= m0.y * __builtin_amdgcn_rcpf(d0.y); v0.z *= m0.z * __builtin_amdgcn_rcpf(d0.z); v0.w *= m0.w * __builtin_amdgcn_rcpf(d0.w);
        v1.x *= m1.x * __builtin_amdgcn_rcpf(d1.x); v1.y *= m1.y * __builtin_amdgcn_rcpf(d1.y); v1.z *= m1.z * __builtin_amdgcn_rcpf(d1.z); v1.w *= m1.w * __builtin_amdgcn_rcpf(d1.w); }
    __device__ __forceinline__ void st8(int row, int col, f32x4 v0, f32x4 v1) const {
        f32x4 d0, d1; unpack8(*(const u32x4*)(Z + zbase(ZGD + col) + (size_t)row * ZR), d0, d1);
        d0.x = fmaxf(d0.x, 1e-20f); d0.y = fmaxf(d0.y, 1e-20f); d0.z = fmaxf(d0.z, 1e-20f); d0.w = fmaxf(d0.w, 1e-20f); d1.x = fmaxf(d1.x, 1e-20f); d1.y = fmaxf(d1.y, 1e-20f); d1.z = fmaxf(d1.z, 1e-20f); d1.w = fmaxf(d1.w, 1e-20f);
        *(bf16x8*)(MG + (size_t)row * DM + col) = pack8(v0 * d0, v1 * d1); }
    __device__ __forceinline__ void st4md(int row, int col, f32x4 am, f32x4 ad) const {
        const u32x2 gm = *(const u32x2*)(Z + zbase(ZGM + col) + (size_t)row * ZR), gd = *(const u32x2*)(Z + zbase(ZGD + col) + (size_t)row * ZR);
        u32x2 o; o.x = pk2(bflo(gm.x) * am.x + bflo(gd.x) * ad.x, bfhi(gm.x) * am.y + bfhi(gd.x) * ad.y); o.y = pk2(bflo(gm.y) * am.z + bflo(gd.y) * ad.z, bfhi(gm.y) * am.w + bfhi(gd.y) * ad.w);
        *(u32x2*)(MG + (size_t)row * DM + col) = o; }
};
struct EpiF32 {
    static constexpr int MID_T = -1; static constexpr bool TILE = false;
    bf16_t* Y;
    __device__ __forceinline__ void st4(int row, int col, f32x4 v) const { u32x2 o; o.x = pk2(v.x, v.y); o.y = pk2(v.z, v.w); *(u32x2*)(Y + (size_t)row * DM + col) = o; }
    __device__ __forceinline__ void st8(int row, int col, f32x4 v0, f32x4 v1) const { *(bf16x8*)(Y + (size_t)row * DM + col) = pack8(v0, v1); }
};
__device__ __forceinline__ float gelu_tanh(float x) { const float u = 1.5957691216057308f * (x + 0.044715f * x * x * x); return x * __builtin_amdgcn_rcpf(1.f + __builtin_amdgcn_exp2f(-u * LOG2E)); }
#define DPP_F(oldv, srcv, ctrl) __builtin_bit_cast(float, __builtin_amdgcn_update_dpp(__builtin_bit_cast(int, (float)(oldv)), __builtin_bit_cast(int, (float)(srcv)), (ctrl), 0xf, 0xf, false))
struct EpiUpG {
    static constexpr int MID_T = -1; static constexpr bool TILE = true;
    bf16_t* G; float* out; const float* conv_w; const float* conv_b; const float* state_conv; float* AH; float* AF; float* BF;
    __device__ __forceinline__ void st8(int, int, f32x4, f32x4) const {}
    __device__ __forceinline__ void tile(f32x4 (&acc)[2][2][4][2], int pm, int pn, int wr, int wc, int fr, int fq, LAS float* halo) const {
        if (pm >= MP / 256) body<true>(acc, pm, pn, wr, wc, fr, fq, halo); else body<false>(acc, pm, pn, wr, wc, fr, fq, halo);
    }
    template <bool SAMPLE>
    __device__ __forceinline__ void body(f32x4 (&acc)[2][2][4][2], int pm, int pn, int wr, int wc, int fr, int fq, LAS float* halo) const {
        const int f0 = 128 * pn + 32 * wc + 8 * fq;
        if constexpr (!SAMPLE) {
#pragma unroll
            for (int ai = 0; ai < 2; ++ai) if (fr >= 14) { LAS float* hp = halo + ((2 * ai + wr) * 2 + (fr - 14)) * 128 + 32 * wc + 8 * fq; *(LAS f32x4*)hp = acc[ai][0][3][0]; *(LAS f32x4*)(hp + 4) = acc[ai][0][3][1]; }
        }
        asm volatile("s_waitcnt lgkmcnt(0)\n\ts_barrier" ::: "memory");
#pragma unroll
        for (int n = 0; n < 2; ++n) {
            const int fc = f0 + 4 * n;
            const f32x4 w0 = *(const f32x4*)(conv_w + fc), w1 = *(const f32x4*)(conv_w + DFF + fc), w2 = *(const f32x4*)(conv_w + 2 * DFF + fc), cb = *(const f32x4*)(conv_b + fc);
#pragma unroll
            for (int ai = 0; ai < 2; ++ai) {
                const int g = 2 * ai + wr;
                f32x4 h0 = {0.f, 0.f, 0.f, 0.f}, h1 = h0;
                if constexpr (!SAMPLE) { if (g > 0) { const LAS float* hp = halo + ((g - 1) * 2) * 128 + 32 * wc + 8 * fq + 4 * n; h0 = *(const LAS f32x4*)hp; h1 = *(const LAS f32x4*)(hp + 128); } }
#pragma unroll
                for (int m = 0; m < 4; ++m) {
                    const int rowt = 128 * ai + 64 * wr + 16 * m + fr, row = 256 * pm + rowt, tq = fr & 3;
                    f32x4 s0 = {0.f, 0.f, 0.f, 0.f}, s1 = s0;
                    if constexpr (SAMPLE) { const float* st = state_conv + (size_t)((row - MP) >> 2) * 2 * DFF + fc; s0 = *(const f32x4*)st; s1 = *(const f32x4*)(st + DFF); }
                    f32x4 gv;
#pragma unroll
                    for (int e = 0; e < 4; ++e) {
                        const float a0 = acc[ai][0][m][n][e], bv = acc[ai][1][m][n][e];
                        float p1, p2;
                        if constexpr (SAMPLE) {
                            const float d1 = DPP_F(0.f, a0, 0x111), d2 = DPP_F(0.f, a0, 0x112);
                            p1 = (tq >= 1) ? d1 : s1[e]; p2 = (tq >= 2) ? d2 : ((tq == 1) ? s1[e] : s0[e]);
                        } else {
                            float t1, t2;
                            if (m > 0) { const float pr = acc[ai][0][m > 0 ? m - 1 : 0][n][e]; t1 = DPP_F(0.f, pr, 0x10F); t2 = DPP_F(0.f, pr, 0x10E); }
                            else { t1 = h1[e]; t2 = (fr == 0) ? h0[e] : h1[e]; }
                            p1 = DPP_F(t1, a0, 0x111); p2 = DPP_F(t2, a0, 0x112);
                        }
                        const float cv = cb[e] + w0[e] * p2 + w1[e] * p1 + w2[e] * a0;
                        gv[e] = gelu_tanh(cv) * bv;
                    }
                    { u32x2 o; o.x = pk2(gv.x, gv.y); o.y = pk2(gv.z, gv.w); *(u32x2*)(G + (size_t)row * DFF + fc) = o; }
                    if constexpr (!SAMPLE) {
                        if (ai == 1 && m == 3) { if (rowt >= 254) { *(f32x4*)(AH + ((size_t)pm * 2 + (rowt - 254)) * DFF + fc) = acc[ai][0][m][n];
                            if ((pm & 31) == 31) *(f32x4*)(out + OFF_CVP + ((size_t)(pm >> 5) * 2 + (rowt - 254)) * DFF + fc) = acc[ai][0][m][n]; } }
                        if (ai == 0 && m == 0) { if (rowt < 2) { *(f32x4*)(AF + ((size_t)pm * 2 + rowt) * DFF + fc) = acc[ai][0][m][n]; *(f32x4*)(BF + ((size_t)pm * 2 + rowt) * DFF + fc) = acc[ai][1][m][n]; } }
                    } else { if (tq >= 2) *(f32x4*)(out + OFF_CVS + ((size_t)((row - MP) >> 2) * 2 + (tq - 2)) * DFF + fc) = acc[ai][0][m][n]; }
                    asm volatile("" ::: "memory");
                }
            }
        }
    }
};
__device__ __forceinline__ void geglu_fixup(const Frame& F, int pm) {
    if (pm >= MP / 256 || (pm & 31) == 0) return;
    const float* ah = FP_AH + (size_t)(pm - 1) * 2 * DFF; const float* af = FP_AF + (size_t)pm * 2 * DFF; const float* bfp = FP_BF + (size_t)pm * 2 * DFF;
    for (int i = FTID(F); i < 2 * DFF; i += NTHR) { const int r = i / DFF, f = i - r * DFF;
        const float a0 = af[r * DFF + f], bv = bfp[r * DFF + f], p1 = (r == 0) ? ah[DFF + f] : af[f], p2 = (r == 0) ? ah[f] : ah[DFF + f];
        const float cv = FP_conv_b[f] + FP_conv_w[f] * p2 + FP_conv_w[DFF + f] * p1 + FP_conv_w[2 * DFF + f] * a0;
        FP_GB[(size_t)(256 * pm + r) * DFF + f] = f2bf(gelu_tanh(cv) * bv); }
    asm volatile("s_waitcnt vmcnt(0)" ::: "memory");
    WG_BAR();
}
template <bool MD, class Epi>
__device__ __forceinline__ void skinny_gemm(const Frame& F, const bf16_t* A, const bf16_t* Bt, int K, const Epi& E) {
    const int lane = lane_id(), r = lane & 31, h = lane >> 5, ke = F.wave, K8 = K >> 3, tid = F.wave * 64 + lane;
    LAS float* part = (LAS float*)F.lds;
    for (int task = F.vcu; task < 256; task += F.G) {
        const int rt = task >> 4, cg = task & 15;
        const bf16_t* ap = A + (size_t)(32 * rt + r) * K + ke * K8 + 8 * h;
        const bf16_t* bp0 = Bt + (size_t)(64 * cg + r) * K + ke * K8 + 8 * h; const bf16_t* bp1 = bp0 + (size_t)32 * K;
        f32x16 acc0, acc1; for (int i = 0; i < 16; ++i) { acc0[i] = 0.f; acc1[i] = 0.f; }
#pragma unroll 4
        for (int s = 0; s < K8 / 16; ++s) { const bf16x8 a = *(const bf16x8*)(ap + 16 * s), b0 = *(const bf16x8*)(bp0 + 16 * s), b1 = *(const bf16x8*)(bp1 + 16 * s); acc0 = MFMA32(b0, a, acc0); acc1 = MFMA32(b1, a, acc1); }
#pragma unroll
        for (int g4 = 0; g4 < 4; ++g4) { *(LAS f32x4*)(part + (ke * 32 + r) * 68 + 8 * g4 + 4 * h) = (f32x4){acc0[4 * g4], acc0[4 * g4 + 1], acc0[4 * g4 + 2], acc0[4 * g4 + 3]};
            *(LAS f32x4*)(part + (ke * 32 + r) * 68 + 32 + 8 * g4 + 4 * h) = (f32x4){acc1[4 * g4], acc1[4 * g4 + 1], acc1[4 * g4 + 2], acc1[4 * g4 + 3]}; }
        WG_BAR();
        { const int row = tid >> 4, c4 = (tid & 15) * 4;
          const f32x4 lo = *(const LAS f32x4*)(part + row * 68 + c4) + *(const LAS f32x4*)(part + (32 + row) * 68 + c4) + *(const LAS f32x4*)(part + (64 + row) * 68 + c4) + *(const LAS f32x4*)(part + (96 + row) * 68 + c4);
          const f32x4 hi4 = *(const LAS f32x4*)(part + (128 + row) * 68 + c4) + *(const LAS f32x4*)(part + (160 + row) * 68 + c4) + *(const LAS f32x4*)(part + (192 + row) * 68 + c4) + *(const LAS f32x4*)(part + (224 + row) * 68 + c4);
          if constexpr (MD) E.st4md(MP + 32 * rt + row, 64 * cg + c4, lo, hi4);
          else E.st4(MP + 32 * rt + row, 64 * cg + c4, lo + hi4); }
        WG_BAR();
    }
}

constexpr int VROW = 320;
constexpr int CH = 128, NCH = TP / CH;
__device__ __forceinline__ void chunk_scan(const Frame& F, int m0, int h, int lane, float& F1, float& F2, float& a1, float& a2, float& A1, float& A2) {
    const float lf1 = FP_LF[(size_t)(m0 + lane) * 4 + h], lf2 = FP_LF[(size_t)(m0 + 64 + lane) * 4 + h], ig1 = FP_IG[(size_t)(m0 + lane) * 4 + h], ig2 = FP_IG[(size_t)(m0 + 64 + lane) * 4 + h];
    F1 = wave_scan_sum(lf1, lane); F2 = __shfl(F1, 63) + wave_scan_sum(lf2, lane);
    a1 = ig1 - F1; a2 = ig2 - F2;
    A1 = wave_scan_max(a1, lane); A2 = fmaxf(__shfl(A1, 63), wave_scan_max(a2, lane));
}
__device__ __forceinline__ void mlstm_A_unit(const Frame& F, int u) {
    const int bh = u / NCH, c = u % NCH, b = bh >> 2, h = bh & 3, m0 = b * TP + c * CH;
    const int lane = lane_id(), wid = F.wave, tid = wid * 64 + lane;
    LAS unsigned char* Vt = F.lds; LAS unsigned char* Kt = F.lds + CH * VROW; LAS float* wl = (LAS float*)(F.lds + 2 * CH * VROW);
    if (wid == 0) {
        float F1, F2, a1, a2, A1, A2; chunk_scan(F, m0, h, lane, F1, F2, a1, a2, A1, A2);
        const float Mloc = __shfl(A2, 63), Fsum = __shfl(F2, 63);
        wl[lane] = __expf(a1 - Mloc); wl[64 + lane] = __expf(a2 - Mloc);
        if (lane == 0) { FP_ST[2 * u] = Fsum; FP_ST[2 * u + 1] = Mloc; }
    }
    WG_BAR();
#pragma unroll
    for (int i = 0; i < 4; ++i) { const int idx = tid + 512 * i, row = idx >> 4, ch = idx & 15;
        const bf16_t* src = FP_Z + (size_t)(m0 + row) * ZR;
        const u32x4 vv = *(const u32x4*)(src + zbase(ZV + h * 128 + ch * 8)); const u32x4 kk = *(const u32x4*)(src + zbase(ZK + h * 128 + ch * 8));
        f32x4 k0, k1; unpack8(kk, k0, k1); const float w = wl[row];
        *(LAS u32x4*)(Vt + row * VROW + ch * 16) = vv;
        *(LAS bf16x8*)(Kt + row * VROW + ch * 16) = pack8(k0 * w, k1 * w); }
    WG_BAR();
    if (tid < 128) { float sm = 0.f;
#pragma unroll 8
        for (int row = 0; row < CH; ++row) sm += bf2f(*(const LAS bf16_t*)(Kt + row * VROW + tid * 2));
        FP_NU[(size_t)u * 128 + tid] = sm; }
    {
        const int r32 = lane & 31, hi = lane >> 5, vh = (lane >> 4) & 1, q4 = (lane & 15) >> 2, p = lane & 3;
        const int vt = wid >> 1, dt0 = 2 * (wid & 1);
        const int lbase = (8 * hi + q4) * VROW + (16 * vh + 4 * p) * 2;
        f32x16 acc0, acc1; for (int i = 0; i < 16; ++i) { acc0[i] = 0.f; acc1[i] = 0.f; }
#pragma unroll
        for (int st = 0; st < CH / 16; ++st) {
            const LAS unsigned char* va = Vt + lbase + st * 16 * VROW + vt * 64;
            const bf16x8 af = cat4(tr_rd(va), tr_rd(va + 4 * VROW));
            const LAS unsigned char* ka = Kt + lbase + st * 16 * VROW + dt0 * 64;
            const bf16x8 b0 = cat4(tr_rd(ka), tr_rd(ka + 4 * VROW)), b1 = cat4(tr_rd(ka + 64), tr_rd(ka + 64 + 4 * VROW));
            acc0 = MFMA32(af, b0, acc0); acc1 = MFMA32(af, b1, acc1);
        }
        float* Uo = FP_U + (size_t)u * 16384;
#pragma unroll
        for (int i = 0; i < 16; ++i) { const int v = 32 * vt + crow(i, hi); Uo[v * 128 + 32 * dt0 + r32] = acc0[i]; Uo[v * 128 + 32 * dt0 + 32 + r32] = acc1[i]; }
    }
    WG_BAR();
}
__device__ __forceinline__ void smlstm_unit(const Frame& F, int u) {
    const int n = u >> 2, h = u & 3, tid = FTID(F), lane = lane_id(), wid = F.wave;
    const int mrow = MP + 4 * n;
    LAS float* qs = (LAS float*)F.lds; LAS float* ks = qs + 512; LAS float* vs = ks + 512; LAS float* numI = vs + 512; LAS float* Sm = numI + 512; LAS float* nq = Sm + 16; LAS float* red = nq + 4;
    { const int t = tid >> 7, d = tid & 127; const bf16_t* z = FP_Z + (size_t)(mrow + t) * ZR;
      qs[tid] = bf2f(z[zbase(ZQ + h * 128 + d)]); ks[tid] = bf2f(z[zbase(ZK + h * 128 + d)]); vs[tid] = bf2f(z[zbase(ZV + h * 128 + d)]); }
    LAS float* gl = red + 8;
    const float m0 = FP_state_m[n * 4 + h];
    if (tid < 4) { float cum = 0.f, am = -INFINITY, at = 0.f;
      for (int t = 0; t <= tid; ++t) { cum += FP_LF[(size_t)(mrow + t) * 4 + h]; at = FP_IG[(size_t)(mrow + t) * 4 + h] - cum; am = fmaxf(am, at); }
      const float mxv = fmaxf(m0, am);
      gl[tid] = cum; gl[4 + tid] = at; gl[8 + tid] = mxv; gl[12 + tid] = __expf(m0 - mxv); gl[16 + tid] = cum + mxv; }
    WG_BAR();
    const float m_end = gl[19], Fend = gl[3], decay = __expf(Fend + m0 - m_end);
    const float wend0 = __expf(Fend + gl[4] - m_end), wend1 = __expf(Fend + gl[5] - m_end), wend2 = __expf(Fend + gl[6] - m_end), wend3 = __expf(Fend + gl[7] - m_end);
#pragma unroll
    for (int k = 0; k < 2; ++k) { const int pid = 2 * wid + k, t = pid >> 2, s = pid & 3;
        float d = qs[t * 128 + lane] * ks[s * 128 + lane] + qs[t * 128 + 64 + lane] * ks[s * 128 + 64 + lane]; d = wave_sum(d);
        if (lane == 0) Sm[pid] = (s <= t) ? d * __expf(gl[4 + s] - gl[8 + t]) : 0.f; }
    if (wid < 4) { const float* n0 = FP_state_n + (size_t)u * 128; float d = n0[lane] * qs[wid * 128 + lane] + n0[64 + lane] * qs[wid * 128 + 64 + lane]; d = wave_sum(d); if (lane == 0) nq[wid] = d; }
    { const int vrow = tid >> 2, dq = tid & 3;
      const float* c0 = FP_state_C + ((size_t)u * 128 + vrow) * 128 + 32 * dq; float* co = FP_out + OFF_CS + ((size_t)u * 128 + vrow) * 128 + 32 * dq;
      f32x4 cv[8];
#pragma unroll
      for (int i = 0; i < 8; ++i) cv[i] = *(const f32x4*)(c0 + 4 * i);
      float ps[4]; float coef[4];
      ps[0] = 0.f; ps[1] = 0.f; ps[2] = 0.f; ps[3] = 0.f;
      coef[0] = wend0 * vs[vrow]; coef[1] = wend1 * vs[128 + vrow]; coef[2] = wend2 * vs[256 + vrow]; coef[3] = wend3 * vs[384 + vrow];
#pragma unroll
      for (int i = 0; i < 8; ++i) { f32x4 cn = cv[i] * decay;
#pragma unroll
          for (int t = 0; t < 4; ++t) { const f32x4 qv = *(const LAS f32x4*)(qs + t * 128 + 32 * dq + 4 * i), kv = *(const LAS f32x4*)(ks + t * 128 + 32 * dq + 4 * i);
              ps[t] += (cv[i].x * qv.x + cv[i].y * qv.y) + (cv[i].z * qv.z + cv[i].w * qv.w); cn += kv * coef[t]; }
          *(f32x4*)(co + 4 * i) = cn; }
#pragma unroll
      for (int t = 0; t < 4; ++t) { ps[t] += __shfl_xor(ps[t], 1); ps[t] += __shfl_xor(ps[t], 2); if (dq == 0) numI[t * 128 + vrow] = ps[t]; } }
    WG_BAR();
    { const int t = tid >> 7, v = tid & 127;
      const float it = gl[12 + t], mtt = gl[16 + t];
      float num = it * numI[tid], den = it * nq[t];
#pragma unroll
      for (int s = 0; s < 4; ++s) { const float sv = Sm[t * 4 + s]; num += sv * vs[s * 128 + v]; den += sv; }
      const float hval = num / fmaxf(fabsf(den), __expf(-mtt));
      const float ssw = wave_sum(hval * hval); if (lane == 0) red[wid] = ssw;
      WG_BAR();
      const float rms = rsqrtf((red[2 * t] + red[2 * t + 1]) * (1.f / 128.f) + EPS);
      const float mo = bf2f(FP_Z[zbase(ZO + h * 128 + v) + (size_t)(mrow + t) * ZR]);
      FP_HMD[(size_t)(mrow + t) * 1024 + h * 128 + v] = f2bf(hval * rms * FP_g_mlstm[h * 128 + v] * sigmoidf_(mo));
      if (tid < 128) { const float n0v = FP_state_n[(size_t)u * 128 + tid]; float nn = decay * n0v;
          nn += wend0 * ks[tid] + wend1 * ks[128 + tid] + wend2 * ks[256 + tid] + wend3 * ks[384 + tid];
          FP_out[OFF_NS + (size_t)u * 128 + tid] = nn; }
      if (tid == 0) FP_out[OFF_MS + u] = m_end; }
    WG_BAR();
}
__device__ __forceinline__ void mlstm_scan_item(const Frame& F, int item) {
    const int tid = FTID(F), bh = item >> 5, j = item & 31, e = 512 * j + tid; const bool nthr = (j == 0 && tid < 128);
    float C = 0.f, m = 0.f, nacc = 0.f;
    const float* Ub = FP_U + (size_t)bh * NCH * 16384 + e; bf16_t* Cp = FP_CPREV + (size_t)bh * NCH * 16384 + e;
    for (int c0 = 0; c0 < NCH; c0 += 32) {
        float uu[32], un[32];
#pragma unroll
        for (int i = 0; i < 32; ++i) { uu[i] = Ub[(size_t)(c0 + i) * 16384]; un[i] = nthr ? FP_NU[(size_t)(bh * NCH + c0 + i) * 128 + tid] : 0.f; }
#pragma unroll
        for (int i = 0; i < 32; ++i) { const int c = c0 + i; const float fs = FP_ST[2 * (bh * NCH + c)], ml = FP_ST[2 * (bh * NCH + c) + 1];
            Cp[(size_t)c * 16384] = f2bf(C);
            if (nthr) FP_NPREV[(size_t)(bh * NCH + c) * 128 + tid] = nacc;
            if (j == 0 && tid == 0) FP_MPREV[bh * NCH + c] = m;
            const float mn = fs + fmaxf(m, ml), dec = __expf(fs + m - mn), sc = __expf(fs + ml - mn);
            C = dec * C + sc * uu[i]; nacc = dec * nacc + sc * un[i]; m = mn; }
    }
    FP_out[OFF_CP + (size_t)bh * 16384 + e] = C;
    if (nthr) FP_out[OFF_NP + bh * 128 + tid] = nacc;
    if (j == 0 && tid == 0) FP_out[OFF_MP + bh] = m;
}
__device__ __forceinline__ void glds16(const void* gsrc, unsigned lds_dst);
__device__ __forceinline__ void mlstm_C_group(const Frame& F, int grp) {
    const int tid_ = FTID(F);
    const int lane = tid_ & 63, wid = F.wave, r32 = lane & 31, hi = lane >> 5, ci = wid >> 2, tt = wid & 3;
    const int u = 2 * grp + ci, bh = u / NCH, c = u % NCH, b = bh >> 2, h = bh & 3, m0 = b * TP + c * CH;
    LAS unsigned char* Vt = F.lds + ci * 32768;
    LAS float* Fa = (LAS float*)(F.lds + 65536 + wid * 2048); LAS float* aa = Fa + 128; LAS float* Aa = aa + 128;
    {
        const unsigned lds0 = (unsigned)(uintptr_t)Vt;
#pragma unroll
        for (int k = 0; k < 8; ++k) { const int bb = 8 * tt + k, c4 = bb >> 3, kg = bb & 7;
            glds16(FP_Z + zbase(ZV + h * 128 + c4 * 32 + (lane & 3) * 8) + (size_t)(m0 + kg * 16 + (lane >> 2)) * ZR, (unsigned)__builtin_amdgcn_readfirstlane(lds0 + bb * 1024)); }
    }
    {
        float F1, F2, a1, a2, A1, A2; chunk_scan(F, m0, h, lane, F1, F2, a1, a2, A1, A2);
        Fa[lane] = F1; Fa[64 + lane] = F2; aa[lane] = a1; aa[64 + lane] = a2; Aa[lane] = A1; Aa[64 + lane] = A2;
    }
    const int t = 32 * tt + r32;
    const float mprev = FP_MPREV[u];
    bf16x8 qf[8];
    { const bf16_t* qp = FP_Z + zbase(ZQ + h * 128 + 8 * hi) + (size_t)(m0 + t) * ZR;
#pragma unroll
      for (int st = 0; st < 8; ++st) qf[st] = *(const bf16x8*)(qp + 16 * st); }
    const float Ft = Fa[t], At = Aa[t], mxt = fmaxf(mprev, At), mt = Ft + mxt, inter = __expf(mprev - mxt);
    float dq = 0.f;
    { const float* np = FP_NPREV + (size_t)u * 128 + 8 * hi;
#pragma unroll
      for (int st = 0; st < 8; ++st) { const f32x4 n0 = *(const f32x4*)(np + 16 * st), n1 = *(const f32x4*)(np + 16 * st + 4); f32x4 q0, q1; unpack8(__builtin_bit_cast(u32x4, qf[st]), q0, q1);
          dq += (q0.x * n0.x + q0.y * n0.y) + (q0.z * n0.z + q0.w * n0.w) + (q1.x * n1.x + q1.y * n1.y) + (q1.z * n1.z + q1.w * n1.w); } }
    dq += __shfl_xor(dq, 32);
    f32x16 acc[4];
#pragma unroll
    for (int vt = 0; vt < 4; ++vt) { for (int i = 0; i < 16; ++i) acc[vt][i] = 0.f;
        const bf16_t* cp = FP_CPREV + (size_t)u * 16384 + (size_t)(32 * vt + r32) * 128 + 8 * hi;
#pragma unroll
        for (int st = 0; st < 8; ++st) acc[vt] = MFMA32(*(const bf16x8*)(cp + 16 * st), qf[st], acc[vt]);
#pragma unroll
        for (int i = 0; i < 16; ++i) acc[vt][i] *= inter; }
    asm volatile("s_waitcnt vmcnt(0) lgkmcnt(0)\n\ts_barrier" ::: "memory");
    float den = 0.f;
    const int vh = (lane >> 4) & 1, q4 = (lane & 15) >> 2, p = lane & 3;
    const int vlane = (4 * hi + q4) * 64 + (16 * vh + 4 * p) * 2;
    for (int sub = 0; sub <= tt; ++sub) {
        f32x16 sacc; for (int i = 0; i < 16; ++i) sacc[i] = 0.f;
        { const bf16_t* kp = FP_Z + zbase(ZK + h * 128 + 8 * hi) + (size_t)(m0 + 32 * sub + r32) * ZR;
#pragma unroll
          for (int st = 0; st < 8; ++st) sacc = MFMA32(*(const bf16x8*)(kp + 16 * st), qf[st], sacc); }
#pragma unroll
        for (int g = 0; g < 4; ++g) { const f32x4 av = *(const LAS f32x4*)(aa + 32 * sub + 8 * g + 4 * hi);
#pragma unroll
            for (int k = 0; k < 4; ++k) { const int sidx = 32 * sub + 8 * g + 4 * hi + k; const float wgt = (sidx <= t) ? __expf(av[k] - mxt) : 0.f; const float val = (sidx <= t) ? sacc[4 * g + k] * wgt : 0.f; sacc[4 * g + k] = val; den += val; } }
#pragma unroll
        for (int s2 = 0; s2 < 2; ++s2) {
            const bf16x8 pb = pack8((f32x4){sacc[8 * s2], sacc[8 * s2 + 1], sacc[8 * s2 + 2], sacc[8 * s2 + 3]}, (f32x4){sacc[8 * s2 + 4], sacc[8 * s2 + 5], sacc[8 * s2 + 6], sacc[8 * s2 + 7]});
            const LAS unsigned char* va = Vt + vlane + (2 * sub + s2) * 1024;
#pragma unroll
            for (int vt = 0; vt < 4; ++vt) acc[vt] = MFMA32(cat4(tr_rd(va + vt * 8192), tr_rd(va + vt * 8192 + 512)), pb, acc[vt]);
        }
    }
    den += __shfl_xor(den, 32);
    den += inter * dq;
    const float rden = 1.f / fmaxf(fabsf(den), __expf(-mt));
    float ss = 0.f;
#pragma unroll
    for (int vt = 0; vt < 4; ++vt) for (int i = 0; i < 16; ++i) { acc[vt][i] *= rden; ss += acc[vt][i] * acc[vt][i]; }
    ss += __shfl_xor(ss, 32);
    const float rms = rsqrtf(ss * (1.f / 128.f) + EPS);
#pragma unroll
    for (int vt = 0; vt < 4; ++vt)
#pragma unroll
        for (int g = 0; g < 4; ++g) { const int v = 32 * vt + 8 * g + 4 * hi;
            const f32x4 gv = *(const f32x4*)(FP_g_mlstm + h * 128 + v); const u32x2 mo = *(const u32x2*)(FP_Z + zbase(ZO + h * 128 + v) + (size_t)(m0 + t) * ZR);
            u32x2 o; o.x = pk2(acc[vt][4 * g] * rms * gv.x * sigmoidf_(bflo(mo.x)), acc[vt][4 * g + 1] * rms * gv.y * sigmoidf_(bfhi(mo.x)));
            o.y = pk2(acc[vt][4 * g + 2] * rms * gv.z * sigmoidf_(bflo(mo.y)), acc[vt][4 * g + 3] * rms * gv.w * sigmoidf_(bfhi(mo.y)));
            *(u32x2*)(FP_HMD + (size_t)(m0 + t) * 1024 + h * 128 + v) = o; }
    asm volatile("s_waitcnt lgkmcnt(0)\n\ts_barrier" ::: "memory");
}
constexpr int AT_SLOT = 24576, AT_VOFF = 8192, AT_NSLOT = 4;
constexpr float AT_THR = 8.f;
__device__ __forceinline__ void glds16(const void* gsrc, unsigned lds_dst) { unsigned keep;
    asm volatile("s_mov_b32 %0, m0\n\ts_mov_b32 m0, %2\n\ts_nop 0\n\tglobal_load_lds_dwordx4 %1, off\n\ts_mov_b32 m0, %0" : "=&s"(keep) : "v"(gsrc), "s"(lds_dst) : "memory"); }
__device__ __forceinline__ float max3f(float a, float b, float c) { float r; asm("v_max3_f32 %0, %1, %2, %3" : "=v"(r) : "v"(a), "v"(b), "v"(c)); return r; }
#define AT_WAIT_BAR(N) asm volatile("s_waitcnt vmcnt(" #N ") lgkmcnt(0)\n\ts_barrier" ::: "memory")
__device__ __forceinline__ void attn_half_unit(const Frame& F, int bh, int qb, int map, bf16_t* Odst) {
    const int tid_ = FTID(F);
    const int b = bh >> 2, h = bh & 3, lane = tid_ & 63, wid = F.wave, r32 = lane & 31, hi = lane >> 5;
    const int rowbase = b * TP, q0 = qb * 256, qrow = q0 + 32 * wid + r32;
    const bf16_t* Zb = FP_Z + (size_t)rowbase * ZR;
    const unsigned lds0 = (unsigned)(uintptr_t)F.lds;
    const bf16_t* ksrc = Zb + zbase(ZDK + h * 128 + map * 64 + wid * 8) + (size_t)lane * ZR;
    const bf16_t* vsrc0 = Zb + zbase(ZDV + h * 128 + ((2 * wid) >> 2) * 32 + (lane & 3) * 8) + (size_t)(((2 * wid) & 3) * 16 + (lane >> 2)) * ZR;
    const bf16_t* vsrc1 = vsrc0 + (size_t)16 * ZR;
    const unsigned kdst = lds0 + wid * 1024, vdst = lds0 + AT_VOFF + 2 * wid * 1024;
#define AT_DMA(t, slot) do { const size_t adv_ = (size_t)(t) * 64 * ZR; const unsigned so_ = (unsigned)(slot) * AT_SLOT; \
        glds16(ksrc + adv_, (unsigned)__builtin_amdgcn_readfirstlane(kdst + so_)); glds16(vsrc0 + adv_, (unsigned)__builtin_amdgcn_readfirstlane(vdst + so_)); \
        glds16(vsrc1 + adv_, (unsigned)__builtin_amdgcn_readfirstlane(vdst + so_ + 1024u)); } while (0)
    bf16x8 qf[4];
    { const bf16_t* qp = Zb + zbase(ZDQ + h * 128 + map * 64 + 8 * hi) + (size_t)qrow * ZR;
#pragma unroll
      for (int st = 0; st < 4; ++st) qf[st] = *(const bf16x8*)(qp + 16 * st); }
    const int NT = 4 * qb + 4;
    AT_DMA(0, 0); AT_DMA(1, 1); AT_DMA(2, 2);
    f32x16 o[4];
#pragma unroll
    for (int vt = 0; vt < 4; ++vt) for (int i = 0; i < 16; ++i) o[vt][i] = 0.f;
    f32x16 negm; for (int i = 0; i < 16; ++i) negm[i] = 0.f;
    float mhat = 0.f, lrun = 0.f;
    const int vh = (lane >> 4) & 1, q4 = (lane & 15) >> 2, p = lane & 3;
    const int vlane = AT_VOFF + (4 * hi + q4) * 64 + (16 * vh + 4 * p) * 2;
    const int klane = hi * 1024 + r32 * 16;
    const int wlast = q0 + 32 * wid + 31, wfirst = q0 + 32 * wid;
#define AT_SCHED() __builtin_amdgcn_sched_barrier(0)
#define AT_KRD(i0, kbase) do { kf[i0] = *(const LAS bf16x8*)((kbase) + ((i0) >> 1) * 2048 + ((i0) & 1) * 512); kf[(i0) + 1] = *(const LAS bf16x8*)((kbase) + (((i0) + 1) >> 1) * 2048 + (((i0) + 1) & 1) * 512); } while (0)
#define AT_VRD(dst, g, vbase) do { _Pragma("unroll") for (int vt = 0; vt < 4; ++vt) dst[vt] = cat4(tr_rd((vbase) + (g) * 1024 + vt * 4096), tr_rd((vbase) + (g) * 1024 + vt * 4096 + 512)); } while (0)
#define AT_PB(g) (((g) >> 1) == 0 ? pack8((f32x4){p0[8 * ((g) & 1)], p0[8 * ((g) & 1) + 1], p0[8 * ((g) & 1) + 2], p0[8 * ((g) & 1) + 3]}, (f32x4){p0[8 * ((g) & 1) + 4], p0[8 * ((g) & 1) + 5], p0[8 * ((g) & 1) + 6], p0[8 * ((g) & 1) + 7]}) \
                                  : pack8((f32x4){p1[8 * ((g) & 1)], p1[8 * ((g) & 1) + 1], p1[8 * ((g) & 1) + 2], p1[8 * ((g) & 1) + 3]}, (f32x4){p1[8 * ((g) & 1) + 4], p1[8 * ((g) & 1) + 5], p1[8 * ((g) & 1) + 6], p1[8 * ((g) & 1) + 7]}))
#define AT_PV(src, g) do { const bf16x8 pb_ = AT_PB(g); _Pragma("unroll") for (int vt = 0; vt < 4; ++vt) o[vt] = MFMA32(src[vt], pb_, o[vt]); } while (0)
    AT_WAIT_BAR(3);
    bf16x8 kf[8];
    { const LAS unsigned char* kb = F.lds + klane; AT_KRD(0, kb); AT_KRD(2, kb); AT_KRD(4, kb); AT_KRD(6, kb); }
    int slot = 0, slot1 = 1, slot3 = 3;
    for (int j = 0; j < NT; ++j) {
        if (j + 3 < NT) AT_DMA(j + 3, slot3);
        if (64 * j <= wlast) {
            const LAS unsigned char* vb = F.lds + slot * AT_SLOT + vlane;
            const LAS unsigned char* kn = F.lds + slot1 * AT_SLOT + klane;
            const bool knext = (j + 1 < NT);
            f32x16 p0 = MFMA32(kf[0], qf[0], negm), p1 = MFMA32(kf[1], qf[0], negm);
#pragma unroll
            for (int st = 1; st < 4; ++st) { p0 = MFMA32(kf[2 * st], qf[st], p0); p1 = MFMA32(kf[2 * st + 1], qf[st], p1); }
            AT_SCHED();
            bf16x8 vfA[4], vfB[4];
            AT_VRD(vfA, 0, vb);
            AT_SCHED();
            if (64 * j + 63 > wfirst) {
#pragma unroll
                for (int i = 0; i < 16; ++i) { const int key = 64 * j + crow(i, hi); if (key > qrow) p0[i] = -INFINITY; if (key + 32 > qrow) p1[i] = -INFINITY; }
            }
            asm volatile("s_nop 15\n\ts_nop 7" : "+v"(p0), "+v"(p1));
            float mx = max3f(p0[0], p1[0], p0[1]), mx2 = max3f(p1[1], p0[2], p1[2]);
#pragma unroll
            for (int i = 3; i < 15; i += 2) { mx = max3f(mx, p0[i], p1[i]); mx2 = max3f(mx2, p0[i + 1], p1[i + 1]); }
            mx = max3f(mx, p0[15], p1[15]); mx = fmaxf(mx, mx2);
            mx = fmaxf(mx, __shfl_xor(mx, 32));
            if (j == 0 || __any(mx > AT_THR)) {
                const float dl = (j == 0) ? mx : fmaxf(mx, 0.f), f = __builtin_amdgcn_exp2f(-dl);
                mhat += dl; lrun *= f;
#pragma unroll
                for (int i = 0; i < 16; ++i) { p0[i] -= dl; p1[i] -= dl; negm[i] = -mhat; }
#pragma unroll
                for (int vt = 0; vt < 4; ++vt) for (int i = 0; i < 16; ++i) o[vt][i] *= f;
            }
            float rsum = 0.f;
#pragma unroll
            for (int i = 0; i < 16; ++i) { p0[i] = __builtin_amdgcn_exp2f(p0[i]); p1[i] = __builtin_amdgcn_exp2f(p1[i]); rsum += p0[i] + p1[i]; }
            lrun += rsum;
            AT_SCHED();
            AT_VRD(vfB, 1, vb); if (knext) AT_KRD(0, kn); AT_SCHED(); AT_PV(vfA, 0); AT_SCHED();
            AT_VRD(vfA, 2, vb); if (knext) AT_KRD(2, kn); AT_SCHED(); AT_PV(vfB, 1); AT_SCHED();
            AT_VRD(vfB, 3, vb); if (knext) AT_KRD(4, kn); AT_SCHED(); AT_PV(vfA, 2); AT_SCHED();
            if (knext) AT_KRD(6, kn); AT_SCHED(); AT_PV(vfB, 3); AT_SCHED();
        }
        if (j + 3 < NT) AT_WAIT_BAR(3); else AT_WAIT_BAR(0);
        slot = slot1; slot1 = (slot1 == AT_NSLOT - 1) ? 0 : slot1 + 1; slot3 = (slot3 == AT_NSLOT - 1) ? 0 : slot3 + 1;
    }
#undef AT_SCHED
#undef AT_KRD
#undef AT_VRD
#undef AT_PB
#undef AT_PV
    lrun += __shfl_xor(lrun, 32);
    const float rl = 1.f / lrun;
    bf16_t* op = Odst + (size_t)(rowbase + qrow) * 512 + h * 128 + 4 * hi;
#pragma unroll
    for (int vt = 0; vt < 4; ++vt)
#pragma unroll
        for (int g = 0; g < 4; ++g) { u32x2 w; w.x = pk2(o[vt][4 * g] * rl, o[vt][4 * g + 1] * rl); w.y = pk2(o[vt][4 * g + 2] * rl, o[vt][4 * g + 3] * rl); *(u32x2*)(op + 32 * vt + 8 * g) = w; }
    AT_WAIT_BAR(0);
#undef AT_DMA
}
__device__ __forceinline__ float lambda_full(const Frame& F, int lane) {
    const float a = wave_sum(FP_lq1[lane] * FP_lk1[lane]), b = wave_sum(FP_lq2[lane] * FP_lk2[lane]);
    return __expf(a) - __expf(b) + LAM_INIT;
}
__device__ __forceinline__ void attn_combine_rows(const Frame& F) {
    const int lane = lane_id(), gw = F.vcu * NWAVES + F.wave, NGW = F.G * NWAVES;
    const float lam = lambda_full(F, lane);
    const f32x4 g0 = *(const f32x4*)(FP_g_diff + 8 * lane), g1 = *(const f32x4*)(FP_g_diff + 8 * lane + 4);
    for (int m = gw; m < MP; m += NGW) {
        f32x4 a0, a1, b0, b1; unpack8(*(const u32x4*)(FP_O1 + (size_t)m * 512 + 8 * lane), a0, a1); unpack8(*(const u32x4*)(FP_O2 + (size_t)m * 512 + 8 * lane), b0, b1);
        const f32x4 x0 = a0 - b0 * lam, x1 = a1 - b1 * lam;
        float ss = (x0.x * x0.x + x0.y * x0.y) + (x0.z * x0.z + x0.w * x0.w) + (x1.x * x1.x + x1.y * x1.y) + (x1.z * x1.z + x1.w * x1.w);
        ss += __shfl_xor(ss, 1); ss += __shfl_xor(ss, 2); ss += __shfl_xor(ss, 4); ss += __shfl_xor(ss, 8);
        const float rms = rsqrtf(ss * (1.f / 128.f) + EPS) * (1.f - LAM_INIT);
        *(bf16x8*)(FP_HMD + (size_t)m * 1024 + 512 + 8 * lane) = pack8(x0 * rms * g0, x1 * rms * g1);
    }
}
constexpr int SB_P = 264;
constexpr int DPART = 1040;
__device__ __forceinline__ void decode_unit(const Frame& F, int u) {
    const int tid_ = FTID(F);
    const int n = u >> 2, blk = u & 3, lane = tid_ & 63, wid = F.wave, h = wid & 3, qt = wid >> 2;
    const int mrow = MP + 4 * n;
    LAS float* Sb = (LAS float*)(F.lds + wid * 8704);
    LAS float* fac = Sb + 8 * SB_P;
    const int* pt = FP_page_table + n * NPAGES + 4 * blk + 2 * qt;
    const int c16 = lane & 15, g = lane >> 4, hh = lane >> 5, l5 = lane & 31, scol = lane >> 3, sseg = lane & 7;
    bf16x8 bq[4];
#pragma unroll
    for (int st = 0; st < 4; ++st) { const bool ok = (c16 < 4 && st < 2) || (c16 >= 4 && c16 < 8 && st >= 2);
        const bf16x8 v = *(const bf16x8*)(FP_Z + zbase(ZDQ + h * 128 + 32 * st + 8 * g) + (size_t)(mrow + (c16 & 3)) * ZR);
        const bf16x8 zz = {0, 0, 0, 0, 0, 0, 0, 0}; bq[st] = ok ? v : zz; }
    const char* vpool = (const char*)FP_cache_v; const char* kpool = (const char*)FP_cache_k;
    const unsigned voff = (((unsigned)pt[hh] * PAGE) * 4u + (unsigned)h) * 512u + 16u * (unsigned)l5;
#define NTL(p) (*(const f32x4*)(p))
#define VLD(row) NTL(vpool + (voff + 2048u * (unsigned)(row)))
    f32x4 va[8], vb[8];
    {
        const unsigned ko0 = (((unsigned)pt[0] * PAGE + (unsigned)c16) * 4u + (unsigned)h) * 512u + 32u * (unsigned)g;
        const unsigned ko1 = (((unsigned)pt[1] * PAGE + (unsigned)c16) * 4u + (unsigned)h) * 512u + 32u * (unsigned)g;
        f32x4 ka[16], kb[16];
#define KLOAD(dst, ti) do { const unsigned ko_ = (((ti) < 8) ? ko0 : ko1) + 32768u * (unsigned)((ti) & 7); \
            _Pragma("unroll") for (int st = 0; st < 4; ++st) { dst[2 * st] = NTL(kpool + (ko_ + 128u * st)); dst[2 * st + 1] = NTL(kpool + (ko_ + 128u * st + 16u)); } } while (0)
#define KTILE(src, ti) do { f32x4 acc_ = {0.f, 0.f, 0.f, 0.f}; \
            _Pragma("unroll") for (int st = 0; st < 4; ++st) acc_ = MFMA16(pack8(src[2 * st], src[2 * st + 1]), bq[st], acc_); \
            if (c16 < 8) *(LAS f32x4*)(Sb + c16 * SB_P + 16 * (ti) + 4 * g) = acc_; } while (0)
        KLOAD(ka, 0); KLOAD((ka + 8), 1); KLOAD(kb, 2); KLOAD((kb + 8), 3);
        for (int ip = 0; ip < 12; ip += 4) {
            KTILE(ka, ip); KTILE((ka + 8), ip + 1); KLOAD(ka, ip + 4); KLOAD((ka + 8), ip + 5);
            KTILE(kb, ip + 2); KTILE((kb + 8), ip + 3); KLOAD(kb, ip + 6); KLOAD((kb + 8), ip + 7);
        }
        KTILE(ka, 12); KTILE((ka + 8), 13);
#pragma unroll
        for (int kk = 0; kk < 8; ++kk) va[kk] = VLD(kk);
        KTILE(kb, 14); KTILE((kb + 8), 15);
#pragma unroll
        for (int kk = 0; kk < 8; ++kk) vb[kk] = VLD(8 + kk);
#undef KLOAD
#undef KTILE
    }
    {
        LAS float* sp = Sb + scol * SB_P + 32 * sseg;
        f32x4 sv[8]; float mx = -INFINITY;
#pragma unroll
        for (int i = 0; i < 8; ++i) { sv[i] = *(const LAS f32x4*)(sp + 4 * i); mx = fmaxf(fmaxf(mx, fmaxf(sv[i].x, sv[i].y)), fmaxf(sv[i].z, sv[i].w)); }
        mx = fmaxf(mx, __shfl_xor(mx, 1)); mx = fmaxf(mx, __shfl_xor(mx, 2)); mx = fmaxf(mx, __shfl_xor(mx, 4));
        float ls = 0.f;
#pragma unroll
        for (int i = 0; i < 8; ++i) { f32x4 pv; pv.x = __builtin_amdgcn_exp2f(sv[i].x - mx); pv.y = __builtin_amdgcn_exp2f(sv[i].y - mx); pv.z = __builtin_amdgcn_exp2f(sv[i].z - mx); pv.w = __builtin_amdgcn_exp2f(sv[i].w - mx);
            ls += (pv.x + pv.y) + (pv.z + pv.w); *(LAS f32x4*)(sp + 4 * i) = pv; }
        ls += __shfl_xor(ls, 1); ls += __shfl_xor(ls, 2); ls += __shfl_xor(ls, 4);
        if (sseg == 0) { fac[scol] = mx; fac[8 + scol] = ls; }
    }
    {
        const LAS float* pbase = Sb + 128 * hh;
        f32x4 acc[8];
#pragma unroll
        for (int c = 0; c < 8; ++c) acc[c] = (f32x4){0.f, 0.f, 0.f, 0.f};
#define VSTEP(buf, t8) do { f32x4 vc_[8]; _Pragma("unroll") for (int kk = 0; kk < 8; ++kk) vc_[kk] = buf[kk]; \
            if ((t8) + 2 < 16) { _Pragma("unroll") for (int kk = 0; kk < 8; ++kk) buf[kk] = VLD(8 * ((t8) + 2) + kk); } \
            _Pragma("unroll") for (int c = 0; c < 8; ++c) { const f32x4 p0_ = *(const LAS f32x4*)(pbase + c * SB_P + 8 * (t8)), p1_ = *(const LAS f32x4*)(pbase + c * SB_P + 8 * (t8) + 4); \
                acc[c] += vc_[0] * p0_.x + vc_[1] * p0_.y + vc_[2] * p0_.z + vc_[3] * p0_.w + vc_[4] * p1_.x + vc_[5] * p1_.y + vc_[6] * p1_.z + vc_[7] * p1_.w; } } while (0)
        for (int t8 = 0; t8 < 16; t8 += 2) { VSTEP(va, t8); VSTEP(vb, t8 + 1); }
#undef VSTEP
        float* po = FP_DPART + ((size_t)(n * 4 + h) * 8 + (2 * blk + qt)) * DPART;
#pragma unroll
        for (int c = 0; c < 8; ++c) { acc[c].x += __shfl_xor(acc[c].x, 32); acc[c].y += __shfl_xor(acc[c].y, 32); acc[c].z += __shfl_xor(acc[c].z, 32); acc[c].w += __shfl_xor(acc[c].w, 32);
            if (hh == 0) *(f32x4*)(po + c * 128 + 4 * l5) = acc[c]; }
        if (lane < 16) po[1024 + lane] = fac[lane];
    }
#undef VLD
#undef NTL
}
__device__ __forceinline__ void decode_merge(const Frame& F, int u, float lam) {
    const int n = u >> 2, h = u & 3, lane = lane_id(), wid = F.wave, tid = wid * 64 + lane;
    const int mrow = MP + 4 * n;
    LAS float* Sn = (LAS float*)F.lds;
    LAS float* wgt = Sn + 32;
    LAS float* en = wgt + 64;
    LAS float* rlv = en + 32;
    LAS float* red = rlv + 8;
    const float* pp = FP_DPART + (size_t)u * 8 * DPART;
    if (wid == 0) {
        const int c16 = lane & 15, g = lane >> 4;
        f32x4 acc = {0.f, 0.f, 0.f, 0.f};
#pragma unroll
        for (int st = 0; st < 4; ++st) { const bool ok = (c16 < 4 && st < 2) || (c16 >= 4 && c16 < 8 && st >= 2);
            const bf16x8 zz = {0, 0, 0, 0, 0, 0, 0, 0};
            const bf16x8 qv = *(const bf16x8*)(FP_Z + zbase(ZDQ + h * 128 + 32 * st + 8 * g) + (size_t)(mrow + (c16 & 3)) * ZR);
            const bf16x8 kv = *(const bf16x8*)(FP_Z + zbase(ZDK + h * 128 + 32 * st + 8 * g) + (size_t)(mrow + (c16 & 3)) * ZR);
            const bf16x8 bqv = ok ? qv : zz, akv = (c16 < 4) ? kv : zz; acc = MFMA16(akv, bqv, acc); }
        if (g == 0 && c16 < 8) { const int t = c16 & 3; f32x4 m;
            m.x = acc.x; m.y = (1 <= t) ? acc.y : -INFINITY; m.z = (2 <= t) ? acc.z : -INFINITY; m.w = (3 <= t) ? acc.w : -INFINITY;
            *(LAS f32x4*)(Sn + 4 * c16) = m; }
    }
    WG_BAR();
    if (tid < 8) { const int c = tid; const f32x4 sn = *(const LAS f32x4*)(Sn + 4 * c);
        float mi[8]; float M = fmaxf(fmaxf(sn.x, sn.y), fmaxf(sn.z, sn.w));
#pragma unroll
        for (int i = 0; i < 8; ++i) { mi[i] = pp[i * DPART + 1024 + c]; M = fmaxf(M, mi[i]); }
        const f32x4 e = {__builtin_amdgcn_exp2f(sn.x - M), __builtin_amdgcn_exp2f(sn.y - M), __builtin_amdgcn_exp2f(sn.z - M), __builtin_amdgcn_exp2f(sn.w - M)};
        float L = (e.x + e.y) + (e.z + e.w);
#pragma unroll
        for (int i = 0; i < 8; ++i) { const float w = __builtin_amdgcn_exp2f(mi[i] - M); wgt[8 * i + c] = w; L += w * pp[i * DPART + 1032 + c]; }
        *(LAS f32x4*)(en + 4 * c) = e; rlv[c] = 1.f / L; }
    WG_BAR();
    { const int t = tid >> 7, v = tid & 127; float o1 = 0.f, o2 = 0.f;
#pragma unroll
      for (int i = 0; i < 8; ++i) { o1 += wgt[8 * i + t] * pp[i * DPART + t * 128 + v]; o2 += wgt[8 * i + 4 + t] * pp[i * DPART + (4 + t) * 128 + v]; }
#pragma unroll
      for (int sx = 0; sx < 4; ++sx) { const float vn = bf2f(FP_Z[zbase(ZDV + h * 128 + v) + (size_t)(mrow + sx) * ZR]); o1 += en[4 * t + sx] * vn; o2 += en[4 * (4 + t) + sx] * vn; }
      const float ov = o1 * rlv[t] - lam * o2 * rlv[4 + t];
      const float ssw = wave_sum(ov * ov); if (lane == 0) red[wid] = ssw;
      WG_BAR();
      const float rms = rsqrtf((red[2 * t] + red[2 * t + 1]) * (1.f / 128.f) + EPS) * (1.f - LAM_INIT);
      FP_HMD[(size_t)(mrow + t) * 1024 + 512 + h * 128 + v] = f2bf(ov * rms * FP_g_diff[h * 128 + v]); }
    WG_BAR();
}
__device__ __forceinline__ void rows_post_mix(const Frame& F) {
    const int lane = lane_id(), gw = F.vcu * NWAVES + F.wave, NGW = F.G * NWAVES;
    const int r_lo = (int)(((long)gw * MT) / NGW), r_hi = (int)(((long)(gw + 1) * MT) / NGW);
    f32x4 gpm[4], gpf[4], g1[4], sh2[4], sc2[4], yn[4], xn[4];
#pragma unroll
    for (int j = 0; j < 4; ++j) { gpm[j] = *(const f32x4*)(FP_g_post_mix + 4 * lane + 256 * j); gpf[j] = *(const f32x4*)(FP_g_pre_ffn + 4 * lane + 256 * j); g1[j] = gpm[j]; sh2[j] = gpm[j]; sc2[j] = gpm[j]; yn[j] = gpm[j]; xn[j] = gpm[j]; }
    int ccur = -1;
    if (r_lo < r_hi) { const float* xr = xrow_of(F, r_lo); const bf16_t* yr = FP_Y + (size_t)r_lo * DM;
#pragma unroll
        for (int j = 0; j < 4; ++j) { { const u32x2 yy = *(const u32x2*)(yr + 4 * lane + 256 * j); yn[j] = (f32x4){bflo(yy.x), bfhi(yy.x), bflo(yy.y), bfhi(yy.y)}; } xn[j] = *(const f32x4*)(xr + 4 * lane + 256 * j); } }
    for (int m = r_lo; m < r_hi; ++m) {
        f32x4 y[4], x1[4]; float ss = 0.f;
#pragma unroll
        for (int j = 0; j < 4; ++j) { y[j] = yn[j]; x1[j] = xn[j]; }
        if (m + 1 < r_hi) { const float* xr = xrow_of(F, m + 1); const bf16_t* yr = FP_Y + (size_t)(m + 1) * DM;
#pragma unroll
            for (int j = 0; j < 4; ++j) { { const u32x2 yy = *(const u32x2*)(yr + 4 * lane + 256 * j); yn[j] = (f32x4){bflo(yy.x), bfhi(yy.x), bflo(yy.y), bfhi(yy.y)}; } xn[j] = *(const f32x4*)(xr + 4 * lane + 256 * j); } }
        const int cr = crow_of(m);
        if (cr != ccur) { ccur = cr; const float* ada = FP_ADA + (size_t)cr * 6144;
#pragma unroll
            for (int j = 0; j < 4; ++j) { const int c = 4 * lane + 256 * j; g1[j] = *(const f32x4*)(ada + 2048 + c) * gpm[j]; sh2[j] = *(const f32x4*)(ada + 3072 + c); sc2[j] = (*(const f32x4*)(ada + 4096 + c) + 1.f) * gpf[j]; } }
#pragma unroll
        for (int j = 0; j < 4; ++j) ss += (y[j].x * y[j].x + y[j].y * y[j].y) + (y[j].z * y[j].z + y[j].w * y[j].w);
        const float rs = rsqrtf(wave_sum(ss) * (1.f / DM) + EPS); float s1 = 0.f;
#pragma unroll
        for (int j = 0; j < 4; ++j) { const int c = 4 * lane + 256 * j;
            x1[j] = x1[j] + g1[j] * (y[j] * rs); { u32x2 xo; xo.x = pk2(x1[j].x, x1[j].y); xo.y = pk2(x1[j].z, x1[j].w); *(u32x2*)(FP_X1 + (size_t)m * DM + c) = xo; }
            s1 += (x1[j].x * x1[j].x + x1[j].y * x1[j].y) + (x1[j].z * x1[j].z + x1[j].w * x1[j].w); }
        const float r1 = rsqrtf(wave_sum(s1) * (1.f / DM) + EPS);
#pragma unroll
        for (int j = 0; j < 4; ++j) { const int c = 4 * lane + 256 * j;
            const f32x4 hv = (x1[j] * r1) * sc2[j] + sh2[j]; u32x2 o; o.x = pk2(hv.x, hv.y); o.y = pk2(hv.z, hv.w); *(u32x2*)(FP_H1 + (size_t)m * DM + c) = o; }
    }
}
__device__ __forceinline__ void rows_final(const Frame& F) {
    const int lane = lane_id(), gw = F.vcu * NWAVES + F.wave, NGW = F.G * NWAVES;
    const int r_lo = (int)(((long)gw * MT) / NGW), r_hi = (int)(((long)(gw + 1) * MT) / NGW);
    f32x4 gpf[4], g2[4], yn[4], xn[4];
#pragma unroll
    for (int j = 0; j < 4; ++j) { gpf[j] = *(const f32x4*)(FP_g_post_ffn + 4 * lane + 256 * j); g2[j] = gpf[j]; yn[j] = gpf[j]; xn[j] = gpf[j]; }
    int ccur = -1;
    if (r_lo < r_hi) { const bf16_t* xr = FP_X1 + (size_t)r_lo * DM; const bf16_t* yr = FP_Y + (size_t)r_lo * DM;
#pragma unroll
        for (int j = 0; j < 4; ++j) { { const u32x2 yy = *(const u32x2*)(yr + 4 * lane + 256 * j); yn[j] = (f32x4){bflo(yy.x), bfhi(yy.x), bflo(yy.y), bfhi(yy.y)}; } { const u32x2 xx = *(const u32x2*)(xr + 4 * lane + 256 * j); xn[j] = (f32x4){bflo(xx.x), bfhi(xx.x), bflo(xx.y), bfhi(xx.y)}; } } }
    for (int m = r_lo; m < r_hi; ++m) {
        f32x4 y[4], x1[4]; float ss = 0.f;
#pragma unroll
        for (int j = 0; j < 4; ++j) { y[j] = yn[j]; x1[j] = xn[j]; }
        if (m + 1 < r_hi) { const bf16_t* xr = FP_X1 + (size_t)(m + 1) * DM; const bf16_t* yr = FP_Y + (size_t)(m + 1) * DM;
#pragma unroll
            for (int j = 0; j < 4; ++j) { { const u32x2 yy = *(const u32x2*)(yr + 4 * lane + 256 * j); yn[j] = (f32x4){bflo(yy.x), bfhi(yy.x), bflo(yy.y), bfhi(yy.y)}; } { const u32x2 xx = *(const u32x2*)(xr + 4 * lane + 256 * j); xn[j] = (f32x4){bflo(xx.x), bfhi(xx.x), bflo(xx.y), bfhi(xx.y)}; } } }
        const int cr = crow_of(m);
        if (cr != ccur) { ccur = cr; const float* ada = FP_ADA + (size_t)cr * 6144;
#pragma unroll
            for (int j = 0; j < 4; ++j) g2[j] = *(const f32x4*)(ada + 5120 + 4 * lane + 256 * j) * gpf[j]; }
#pragma unroll
        for (int j = 0; j < 4; ++j) ss += (y[j].x * y[j].x + y[j].y * y[j].y) + (y[j].z * y[j].z + y[j].w * y[j].w);
        const float rs = rsqrtf(wave_sum(ss) * (1.f / DM) + EPS);
#pragma unroll
        for (int j = 0; j < 4; ++j) *(f32x4*)(FP_out + OFF_Y + (size_t)m * DM + 4 * lane + 256 * j) = x1[j] + g2[j] * (y[j] * rs);
    }
}
__device__ __forceinline__ void attention_phase(const Frame& F, volatile LAS unsigned* MISC) {
    unsigned* ctl = (unsigned*)(F.a->ws + WS_CTL) + CW_SCHED;
    const int xq = (F.vcu * 8) / F.G;
    for (;;) {
        if (FTID(F) == 0) {
            int kind = -1; unsigned idx = 0u;
            unsigned* QD = ctl + 64 * 8; unsigned* NS = ctl + 64 * (9 + xq);
            if (xb_ld(QD) < 512u) { const unsigned sn = xb_add(NS, 1u);
                if (sn < (unsigned)DEC_LIM8) { const unsigned d = xb_add(QD, 1u); if (d < 512u) { kind = 1; idx = d; } }
                if (kind < 0) (void)__hip_atomic_fetch_sub(NS, 1u, __ATOMIC_RELAXED, __HIP_MEMORY_SCOPE_AGENT); }
            for (int k = 0; k < 8 && kind < 0; ++k) { const int x = (xq + k) & 7; unsigned* QP = ctl + 64 * x;
                if (xb_ld(QP) < 64u) { const unsigned p = xb_add(QP, 1u); if (p < 64u) { kind = 0; idx = (unsigned)x * 64u + p; } } }
            if (kind < 0) { const unsigned d = xb_add(QD, 1u); if (d < 512u) { kind = 2; idx = d; } }
            MISC[0] = (unsigned)kind; MISC[1] = idx;
        }
        WG_BAR();
        const int kind = (int)MISC[0]; const int idx = (int)MISC[1];
        WG_BAR();
        if (kind < 0) break;
        if (kind == 0) { const int bh = idx >> 6, j = idx & 63, qb = 31 - (j >> 1), map = j & 1; attn_half_unit(F, bh, qb, map, map ? FP_O2 : FP_O1); }
        else { decode_unit(F, idx); asm volatile("s_waitcnt vmcnt(0) lgkmcnt(0)\n\ts_barrier" ::: "memory");
               if (kind == 1 && FTID(F) == 0) (void)__hip_atomic_fetch_sub(ctl + 64 * (9 + xq), 1u, __ATOMIC_RELAXED, __HIP_MEMORY_SCOPE_AGENT); }
    }
}

constexpr int NPHASE = 15;
#ifndef DUPMASK
#define DUPMASK 0
#endif
#ifndef PROBE_MASK
#define PROBE_MASK 0
#endif
__global__ void __launch_bounds__(NTHR, 2) fwd_kernel(Args args) {
    extern __shared__ __attribute__((aligned(16))) unsigned char lds_raw[];
    Frame F;
    F.lds = (LAS unsigned char*)lds_raw;
    F.wave = __builtin_amdgcn_readfirstlane((int)threadIdx.x >> 6);
    F.G = gridDim.x; { const int bx = blockIdx.x; F.vcu = (F.G % 8 == 0) ? (bx % 8) * (F.G / 8) + bx / 8 : bx; }
    F.a = &args; unsigned char* ws = args.ws;
    volatile LAS unsigned* MISC = (volatile LAS unsigned*)(F.lds + MISC_OFF);
    for (int u = FTID(F); u < (LDS_BYTES - RING_BYTES) / 4; u += NTHR) ((LAS unsigned*)(F.lds + RING_BYTES))[u] = 0u;
    __syncthreads();
    const int lo = args.ph_lo, hi = args.ph_hi;
    const bool multi = (hi - lo) > 1;
    XcdBarrier bar; bar.bar = (unsigned*)(ws + WS_CTL) + CW_BAR; bar.x = 0; bar.st = nullptr; bar.wave = F.wave;
    if (multi) bar = xcd_barrier_post((unsigned*)(ws + WS_CTL) + CW_BAR, MISC + 8, F.wave);
#define IN(k) (lo <= (k) && (k) < hi)
    unsigned long long pr_t0 = 0ull, pr_acc = 0ull;
#define PST(k) do { if ((PROBE_MASK >> (k)) & 1) pr_t0 = __builtin_amdgcn_s_memrealtime(); } while (0)
#define PEN(k) do { if ((PROBE_MASK >> (k)) & 1) pr_acc += __builtin_amdgcn_s_memrealtime() - pr_t0; } while (0)
#define SEAM(k) do { if (IN(k) && IN((k) + 1)) xcd_barrier(bar); } while (0)

#define DUP(k, ...) do { { __VA_ARGS__ } if ((DUPMASK >> (k)) & 1) { __VA_ARGS__ } } while (0)
    PST(0);
    if (IN(0)) { PST(15); p0_ada(F); PEN(15); p0_transposes(F); } SEAM(0); PEN(0);
    PST(1);
    if (IN(1)) { DUP(1,  p1_norm_gates(F); WG_BAR(); ); } SEAM(1); PEN(1);
    PST(2);
    if (IN(2)) { DUP(2,  pg8::Gemm g{FP_H1, FP_WinT, MT, ZN, DM, DM}; pg8::StaticOrder S; S.init(MT, ZN, F.G, (int)blockIdx.x); EpiZ E{FP_Z, FP_out, FP_IG, FP_LF, FP_b_if}; pg8::gemm_phase(F.lds, g, S, E, F.wave); ); } SEAM(2); PEN(2);
    PST(3);
    if (IN(3)) { DUP(3,  for (int u = F.vcu; u < 8 * NCH; u += F.G) mlstm_A_unit(F, u);
                 for (int u = F.vcu; u < 512; u += F.G) smlstm_unit(F, u); ); } SEAM(3); PEN(3);
    PST(4);
    PEN(4);
    PST(5);
    if (IN(5)) { for (int it = F.vcu; it < 256; it += F.G) mlstm_scan_item(F, it);
                 attention_phase(F, MISC); } SEAM(5); PEN(5);
    PST(6);
    if (IN(6)) { DUP(6,  for (int grp = F.vcu; grp < 256; grp += F.G) mlstm_C_group(F, grp);
                 attn_combine_rows(F);
                 { const float lam = lambda_full(F, lane_id()); for (int u = F.vcu; u < 512; u += F.G) decode_merge(F, u, lam); } ); } SEAM(6); PEN(6);
    PST(7);
    if (IN(7)) { DUP(7,  pg8::Gemm g{FP_HMD, FP_WpT, MP, DM, 512, DM}; pg8::StaticOrder S; S.init(MP, DM, F.G, (int)blockIdx.x); EpiPMD E{FP_Z, FP_MG}; pg8::gemm_phase<EpiPMD, true>(F.lds, g, S, E, F.wave);
                 skinny_gemm<true>(F, FP_HMD + (size_t)MP * DM, FP_WpT, DM, E); ); } SEAM(7); PEN(7);
    PST(8);
    PEN(8);
    PST(9);
    if (IN(9)) { DUP(9,  pg8::Gemm g{FP_MG, FP_WoutT, MP, DM, DM, DM}; pg8::StaticOrder S; S.init(MP, DM, F.G, (int)blockIdx.x); EpiF32 E{FP_Y}; pg8::gemm_phase(F.lds, g, S, E, F.wave);
                 skinny_gemm<false>(F, FP_MG + (size_t)MP * DM, FP_WoutT, DM, E); ); } SEAM(9); PEN(9);
    PST(10);
    if (IN(10)) { DUP(10,  rows_post_mix(F); ); } SEAM(10); PEN(10);
    PST(11);
    if (IN(11)) { DUP(11,  pg8::Gemm g{FP_H1, FP_WupT, MT, 2 * DFF, DM, DM}; pg8::StaticOrder S; S.init(MT, 2 * DFF, F.G, (int)blockIdx.x);
                  EpiUpG E{FP_GB, FP_out, FP_conv_w, FP_conv_b, FP_state_conv, FP_AH, FP_AF, FP_BF}; pg8::gemm_phase(F.lds, g, S, E, F.wave); ); } SEAM(11); PEN(11);
    PST(12);
    PEN(12);
    PST(13);
    if (IN(13)) { DUP(13,  pg8::Gemm g{FP_GB, FP_WdownT, MP, DM, DFF, DFF}; pg8::StaticOrder S; S.init(MP, DM, F.G, (int)blockIdx.x); EpiF32 E{FP_Y};
                  { pg8::Unit u0; for (int i = 0; S.next(i, u0); ++i) geglu_fixup(F, u0.pm); }
                  pg8::gemm_phase(F.lds, g, S, E, F.wave);
                  skinny_gemm<false>(F, FP_GB + (size_t)MP * DFF, FP_WdownT, DFF, E); ); } SEAM(13); PEN(13);
    PST(14);
    if (IN(14)) { rows_final(F); } PEN(14);
#undef DUP
    if (PROBE_MASK != 0 && blockIdx.x == 0 && FTID(F) == 0) { const unsigned long long t0 = __builtin_amdgcn_s_memrealtime(); while (__builtin_amdgcn_s_memrealtime() - t0 < pr_acc) __builtin_amdgcn_s_sleep(8); }
#undef IN
#undef SEAM
}

#ifndef MK_ONE_LAUNCH
#define MK_ONE_LAUNCH 1
#endif
extern "C" void kernel_launch(void* const* d_in, const int* in_sizes, int n_in, void* d_out, int out_size, void* d_ws, size_t ws_size, hipStream_t stream) {
    static int grid = 0;
    if (grid == 0) {
        if (n_in != 32 || out_size != (int)OUT_TOTAL || ws_size < WS_END) { fprintf(stderr, "kernel_launch: unexpected sizes n_in %d out %d ws %zu\n", n_in, out_size, ws_size); grid = -1; return; }
        int dev = 0, cus = 0, per_cu = 0;
        if (hipGetDevice(&dev) != hipSuccess || hipDeviceGetAttribute(&cus, hipDeviceAttributeMultiprocessorCount, dev) != hipSuccess) { grid = -1; return; }
        if (hipFuncSetAttribute((const void*)fwd_kernel, hipFuncAttributeMaxDynamicSharedMemorySize, LDS_BYTES) != hipSuccess) { fprintf(stderr, "kernel_launch: hipFuncSetAttribute failed\n"); grid = -1; return; }
        if (hipOccupancyMaxActiveBlocksPerMultiprocessor(&per_cu, (const void*)fwd_kernel, NTHR, LDS_BYTES) != hipSuccess || per_cu < 1) fprintf(stderr, "kernel_launch: occupancy query reports %d\n", per_cu);
        (void)hipGetLastError();
        grid = cus;
    }
    if (grid < 0) return;
    if (hipMemsetAsync((char*)d_ws + WS_CTL, 0, CTL_ZERO_BYTES, stream) != hipSuccess) return;
    Args a{};
    for (int i = 0; i < 32; ++i) a.in[i] = d_in[i];
    a.out = (float*)d_out; a.ws = (unsigned char*)d_ws;
#if MK_ONE_LAUNCH
    a.ph_lo = 0; a.ph_hi = NPHASE;
    hipLaunchKernelGGL(fwd_kernel, dim3(grid), dim3(NTHR), LDS_BYTES, stream, a);
#else
    for (int p = 0; p < NPHASE; ++p) { a.ph_lo = p; a.ph_hi = p + 1; hipLaunchKernelGGL(fwd_kernel, dim3(grid), dim3(NTHR), LDS_BYTES, stream, a); }
#endif
}
```

```cpp
#include <hip/hip_runtime.h>
#include <cstdio>
#include <cstdint>

#define LAS __attribute__((address_space(3)))
#define GAS __attribute__((address_space(1)))
typedef unsigned short bf16_t;
typedef short bf16x8 __attribute__((ext_vector_type(8)));
typedef short s16x4 __attribute__((ext_vector_type(4)));
typedef short v4i16_t __attribute__((ext_vector_type(4)));
typedef float f32x2 __attribute__((ext_vector_type(2)));
typedef float f32x4 __attribute__((ext_vector_type(4)));
typedef float f32x16 __attribute__((ext_vector_type(16)));
typedef unsigned u32x2 __attribute__((ext_vector_type(2)));
typedef unsigned u32x4 __attribute__((ext_vector_type(4)));
typedef __bf16 bf16x2_t __attribute__((ext_vector_type(2)));
typedef GAS unsigned gu32;

constexpr int DM = 1024, TP = 8192, MP = 16384, MS = 512, MT = MP + MS;
constexpr int NSEQ = 128, TS = 4, NPAGES = 16, PAGE = 128, PAST = 2048;
constexpr int DIN = 5640, ZP = 5632, ZN = 5888, DFF = 2816;
constexpr int ZQ = 0, ZK = 512, ZV = 1024, ZO = 1536, ZDQ = 2048, ZDK = 2560, ZDV = 3072, ZGM = 3584, ZGD = 4608;
__host__ __device__ constexpr size_t zbase(int col) { return (size_t)(col >> 8) * MT * 256 + (size_t)(col & 255); }
constexpr int ZR = 256;
constexpr float EPS = 1e-6f, LAM_INIT = 0.2f, LOG2E = 1.4426950408889634f;
constexpr float QSCALE = 0.125f * LOG2E;
constexpr float KSCALE = 0.08838834764831845f;
constexpr size_t OFF_Y = 0, OFF_KP = 17301504, OFF_VP = 25690112, OFF_CP = 34078720, OFF_NP = 34209792, OFF_MP = 34210816, OFF_CVP = 34210824,
                 OFF_KS = 34222088, OFF_VS = 34484232, OFF_CS = 34746376, OFF_NS = 43134984, OFF_MS = 43200520, OFF_CVS = 43201032, OUT_TOTAL = 43921928;
constexpr size_t MiB = 1u << 20;
constexpr size_t WS_CTL = 0, CTL_ZERO_BYTES = 65536;
constexpr size_t WS_WIN = 639 * MiB  , WS_WUP = 12 * MiB, WS_WDOWN = 23 * MiB, WS_WOUT = 29 * MiB, WS_WPM = 31 * MiB, WS_WPD = 32 * MiB;
constexpr size_t WS_ADA = 33 * MiB, WS_IG = 37 * MiB, WS_LF = 37 * MiB + 512 * 1024, WS_ST = 38 * MiB, WS_NU = 38 * MiB + 65536, WS_NPREV = 39 * MiB, WS_MPREV = 39 * MiB + 768 * 1024;
constexpr size_t WS_H1 = 40 * MiB, WS_Z = 73 * MiB, WS_U = 255 * MiB, WS_CPREV = 319 * MiB, WS_HM = 351 * MiB, WS_HD = 368 * MiB, WS_O1 = 385 * MiB, WS_O2 = 417 * MiB;
constexpr size_t WS_MG = 449 * MiB, WS_Y = 482 * MiB, WS_UA = 548 * MiB, WS_UB = 639 * MiB, WS_G = 730 * MiB, WS_DPART = 821 * MiB, WS_END = 838 * MiB;
constexpr int CW_BAR = 4096, CW_SCHED = 8192;
#ifndef DEC_LIM8
#define DEC_LIM8 10
#endif
constexpr int RING_BYTES = 131072, MISC_OFF = RING_BYTES + 320, LDS_BYTES = 147456;
constexpr int NWAVES = 8, NTHR = 512;

__device__ __forceinline__ unsigned pk2(float lo, float hi) { f32x2 v = {lo, hi}; bf16x2_t b = __builtin_convertvector(v, bf16x2_t); return __builtin_bit_cast(unsigned, b); }
__device__ __forceinline__ bf16_t f2bf(float x) { return (bf16_t)(pk2(x, 0.f) & 0xffffu); }
__device__ __forceinline__ float bflo(unsigned u) { return __uint_as_float(u << 16); }
__device__ __forceinline__ float bfhi(unsigned u) { return __uint_as_float(u & 0xffff0000u); }
__device__ __forceinline__ float bf2f(bf16_t u) { return __uint_as_float(((unsigned)u) << 16); }
__device__ __forceinline__ bf16x8 pack8(f32x4 a, f32x4 b) { u32x4 w; w.x = pk2(a.x, a.y); w.y = pk2(a.z, a.w); w.z = pk2(b.x, b.y); w.w = pk2(b.z, b.w); return __builtin_bit_cast(bf16x8, w); }
__device__ __forceinline__ void unpack8(u32x4 w, f32x4& a, f32x4& b) { a.x = bflo(w.x); a.y = bfhi(w.x); a.z = bflo(w.y); a.w = bfhi(w.y); b.x = bflo(w.z); b.y = bfhi(w.z); b.z = bflo(w.w); b.w = bfhi(w.w); }
__device__ __forceinline__ float wave_sum(float v) {
#pragma unroll
    for (int o = 1; o < 64; o <<= 1) v += __shfl_xor(v, o);
    return v;
}
__device__ __forceinline__ float wave_max(float v) {
#pragma unroll
    for (int o = 1; o < 64; o <<= 1) v = fmaxf(v, __shfl_xor(v, o));
    return v;
}
__device__ __forceinline__ float wave_scan_sum(float v, int lane) {
#pragma unroll
    for (int o = 1; o < 64; o <<= 1) { const float t = __shfl_up(v, o); if (lane >= o) v += t; }
    return v;
}
__device__ __forceinline__ float wave_scan_max(float v, int lane) {
#pragma unroll
    for (int o = 1; o < 64; o <<= 1) { const float t = __shfl_up(v, o); if (lane >= o) v = fmaxf(v, t); }
    return v;
}
__device__ __forceinline__ float sigmoidf_(float x) { return __builtin_amdgcn_rcpf(1.f + __builtin_amdgcn_exp2f(-x * LOG2E)); }
__device__ __forceinline__ float log_sigmoid(float x) { return fminf(x, 0.f) - __logf(1.f + __expf(-fabsf(x))); }
__device__ __forceinline__ int crow(int reg, int h) { return (reg & 3) + 8 * (reg >> 2) + 4 * h; }
#define MFMA32(a, b, c) __builtin_amdgcn_mfma_f32_32x32x16_bf16((a), (b), (c), 0, 0, 0)
#define MFMA16(a, b, c) __builtin_amdgcn_mfma_f32_16x16x32_bf16((a), (b), (c), 0, 0, 0)
__device__ __forceinline__ s16x4 tr_rd(const LAS unsigned char* p) { return __builtin_bit_cast(s16x4, __builtin_amdgcn_ds_read_tr16_b64_v4i16((LAS v4i16_t*)p)); }
__device__ __forceinline__ bf16x8 cat4(s16x4 lo, s16x4 hi) { return (bf16x8){lo[0], lo[1], lo[2], lo[3], hi[0], hi[1], hi[2], hi[3]}; }
#define WG_BAR() __syncthreads()
__device__ __forceinline__ int lane_id() { int l; asm volatile("v_mbcnt_lo_u32_b32 %0, -1, 0\n\tv_mbcnt_hi_u32_b32 %0, -1, %0" : "=v"(l)); return l; }
#define FTID(F) ((F).wave * 64 + lane_id())

namespace pg8 {
constexpr int BM = 256, BK = 64, HALF = 128, HTB = HALF * BK * 2, STAGE_BYTES = 8 * HTB, NXCD = 8, WGM = 8;
__host__ __device__ __forceinline__ int lds_byte(int r, int c) { const int st = (r >> 4) * 2 + (c >> 5), rr = r & 15, cc = c & 31, ob = rr * 64 + cc * 2; return st * 1024 + (ob ^ (((ob >> 9) & 1) << 5)); }
__host__ __device__ __forceinline__ void stage_rc(int b, int& R, int& C) { const int st = b / 1024, sb = b % 1024, swz = sb ^ (((sb >> 9) & 1) << 5); R = (st >> 1) * 16 + swz / 64; C = (st & 1) * 32 + (swz % 64) / 2; }
__host__ __device__ __forceinline__ int perm32(int rho) { const int n = rho >> 4, i = rho & 15; return 8 * (i >> 2) + 4 * n + (i & 3); }
struct Unit { int pm, pn, half; };
struct Gemm { const bf16_t* A; const bf16_t* Bt; int M, N, K, ld; };
struct StaticOrder {
    int nM, nN, nwg, G, c;
    __host__ __device__ __forceinline__ void init(int M, int N, int G_, int c_) { nM = M / BM; nN = N / BM; nwg = nM * nN; G = G_; c = c_; }
    __host__ __device__ __forceinline__ bool next(int i, Unit& u) const {
        const long L = (long)i * G + c; if (L >= nwg) return false;
        int wgid = (int)L; { const int q = nwg / NXCD, r = nwg % NXCD, xcd = wgid % NXCD, off = wgid / NXCD; wgid = (xcd < r ? xcd * (q + 1) : r * (q + 1) + (xcd - r) * q) + off; }
        const int nig = WGM * nN, gid = wgid / nig, fm = gid * WGM, gsz = (nM - fm) < WGM ? (nM - fm) : WGM;
        u.pm = fm + ((wgid % nig) % gsz); u.pn = (wgid % nig) / gsz; u.half = 0; return true;
    }
};
template <class Epi, bool SPLIT2 = false>
__device__ __forceinline__ void gemm_phase(LAS unsigned char* lds, const Gemm g, const StaticOrder& S, const Epi& E, int wave) {
    const int wid = wave, lane = lane_id(), tid = wid * 64 + lane, wr = wid >> 2, wc = wid & 3, fr = lane & 15, fq = lane >> 4;
    const int K = g.K, nt = K / BK, LD = g.ld;
    unsigned voffA[2], voffB[2];
#pragma unroll
    for (int i = 0; i < 2; ++i) { int R, C; stage_rc(tid * 16 + i * 8192, R, C); const int Rb = (R & ~31) + perm32(R & 31);
        voffA[i] = (unsigned)(R * LD + C) * 2u; voffB[i] = (unsigned)(Rb * LD + C) * 2u; }
    const size_t kstep = (size_t)(BK * 2);
    const size_t hstep = (size_t)HALF * LD * 2;
    const size_t tstep = 2 * hstep;
    const unsigned ldsw = (unsigned)wid * 1024u;
    const int aoff = lds_byte(wr * 64 + fr, fq * 8), boff = lds_byte(wc * 32 + fr, fq * 8);
#define PG8_SA(b, h) (((b) * 2 + (h)) * HTB)
#define PG8_SB(b, h) ((4 + (b) * 2 + (h)) * HTB)
#define PG8_STAGE(bufoff, gbase, voff) do { _Pragma("unroll") for (int _i = 0; _i < 2; ++_i) \
        __builtin_amdgcn_global_load_lds((const unsigned*)((const char*)(gbase) + (voff)[_i]), (LAS unsigned*)(lds + (bufoff) + ldsw + _i * 8192), 16, 0, 0); } while (0)
#define PG8_LDA(dst, b, h) do { _Pragma("unroll") for (int m = 0; m < 4; ++m) _Pragma("unroll") for (int k = 0; k < 2; ++k) dst[m][k] = *(const LAS bf16x8*)(lds + PG8_SA(b, h) + aoff + m * 2048 + k * 1024); } while (0)
#define PG8_LDB(dst, b, h) do { _Pragma("unroll") for (int n = 0; n < 2; ++n) _Pragma("unroll") for (int k = 0; k < 2; ++k) dst[n][k] = *(const LAS bf16x8*)(lds + PG8_SB(b, h) + boff + n * 2048 + k * 1024); } while (0)
#define PG8_MMA(ai, bj, At, Bt) do { __builtin_amdgcn_s_setprio(1); _Pragma("unroll") for (int m = 0; m < 4; ++m) _Pragma("unroll") for (int n = 0; n < 2; ++n) _Pragma("unroll") for (int k = 0; k < 2; ++k) \
        acc[ai][bj][m][n] = __builtin_amdgcn_mfma_f32_16x16x32_bf16(Bt[n][k], At[m][k], acc[ai][bj][m][n], 0, 0, 0); __builtin_amdgcn_s_setprio(0); } while (0)
#define PG8_WAIT_V(n) asm volatile("s_waitcnt vmcnt(" #n ")" ::: "memory")
#define PG8_WAIT_L(n) asm volatile("s_waitcnt lgkmcnt(" #n ")" ::: "memory")
#define PG8_BAR __builtin_amdgcn_s_barrier()
#define PG8_SCHED __builtin_amdgcn_sched_barrier(0)
#define PG8_NEXT(i, u) (SPLIT2 ? (S.next((i) >> 1, u) ? ((u).half = (i) & 1, true) : false) : S.next((i), u))
#define PG8_UA(u) ((const char*)g.A + (size_t)(u).pm * tstep + (size_t)(u).half * K * 2)
#define PG8_UB(u) ((const char*)g.Bt + (size_t)(u).pn * tstep + (size_t)(u).half * K * 2)
    Unit cur, nxt; int ui = 0;
    if (!PG8_NEXT(0, cur)) return;
    f32x4 acc[2][2][4][2];
#pragma unroll
    for (int a = 0; a < 2; ++a)
#pragma unroll
        for (int b = 0; b < 2; ++b)
#pragma unroll
            for (int m = 0; m < 4; ++m)
#pragma unroll
                for (int n = 0; n < 2; ++n) acc[a][b][m][n] = (f32x4){0.f, 0.f, 0.f, 0.f};
    bf16x8 At[4][2], B0[2][2], B1[2][2];
    const char* cA = PG8_UA(cur); const char* cB = PG8_UB(cur);
    PG8_STAGE(PG8_SB(0, 0), cB, voffB); PG8_STAGE(PG8_SB(0, 1), cB + hstep, voffB); PG8_STAGE(PG8_SA(0, 0), cA, voffA); PG8_STAGE(PG8_SA(0, 1), cA + hstep, voffA);
    if (wr == 1) PG8_BAR;
    PG8_WAIT_V(2); PG8_BAR;
    PG8_STAGE(PG8_SB(1, 0), cB + kstep, voffB); PG8_STAGE(PG8_SA(1, 0), cA + kstep, voffA); PG8_STAGE(PG8_SB(1, 1), cB + hstep + kstep, voffB);
    PG8_WAIT_V(6); PG8_BAR;
    for (;;) {
        const bool has_next = PG8_NEXT(ui + 1, nxt);
        const char* nA = has_next ? PG8_UA(nxt) : cA; const char* nB = has_next ? PG8_UB(nxt) : cB;
        for (int t = 0; t < nt; t += 2) {
            const bool last = (t == nt - 2);
            const char* a1 = cA + (size_t)(t + 1) * kstep;
            const char* a2 = last ? nA : cA + (size_t)(t + 2) * kstep; const char* b2 = last ? nB : cB + (size_t)(t + 2) * kstep;
            const char* a3 = a2 + kstep; const char* b3 = b2 + kstep;
            PG8_LDB(B0, 0, 0); PG8_LDB(B1, 0, 1); PG8_SCHED; PG8_LDA(At, 0, 0); PG8_STAGE(PG8_SA(1, 1), a1 + hstep, voffA);
            PG8_WAIT_V(8); PG8_WAIT_L(0); PG8_BAR; PG8_MMA(0, 0, At, B0); PG8_MMA(0, 1, At, B1); PG8_BAR; PG8_SCHED;
            PG8_LDA(At, 0, 1); PG8_STAGE(PG8_SB(0, 0), b2, voffB); PG8_STAGE(PG8_SB(0, 1), b2 + hstep, voffB); PG8_STAGE(PG8_SA(0, 0), a2, voffA);
            PG8_WAIT_V(8); PG8_WAIT_L(0); PG8_BAR; PG8_MMA(1, 0, At, B0); PG8_MMA(1, 1, At, B1); PG8_BAR; PG8_SCHED;
            PG8_LDB(B0, 1, 0); PG8_LDB(B1, 1, 1); PG8_SCHED; PG8_LDA(At, 1, 0); PG8_STAGE(PG8_SA(0, 1), a2 + hstep, voffA);
            PG8_WAIT_V(8); PG8_WAIT_L(0); PG8_BAR; PG8_MMA(0, 0, At, B0); PG8_MMA(0, 1, At, B1); PG8_BAR; PG8_SCHED;
            PG8_LDA(At, 1, 1); PG8_STAGE(PG8_SB(1, 0), b3, voffB); PG8_STAGE(PG8_SB(1, 1), b3 + hstep, voffB); PG8_STAGE(PG8_SA(1, 0), a3, voffA);
            PG8_WAIT_V(8); PG8_WAIT_L(0); PG8_BAR; PG8_MMA(1, 0, At, B0); PG8_MMA(1, 1, At, B1); PG8_BAR; PG8_SCHED;
        }
        if (wr == 0) PG8_BAR;
        const bool first_half = SPLIT2 && cur.half == 0;
        {
            const int row0 = cur.pm * BM + wr * 64 + fr, col0 = cur.pn * BM + wc * 32 + 8 * fq;
            if constexpr (SPLIT2) { if (first_half) {
#pragma unroll
                for (int ai = 0; ai < 2; ++ai)
#pragma unroll
                    for (int m = 0; m < 4; ++m) {
#pragma unroll
                        for (int bj = 0; bj < 2; ++bj) E.mid8(row0 + ai * HALF + m * 16, col0 + bj * HALF, acc[ai][bj][m][0], acc[ai][bj][m][1]);
                        asm volatile("" : "+v"(acc[ai][0][m][0]), "+v"(acc[ai][0][m][1]), "+v"(acc[ai][1][m][0]), "+v"(acc[ai][1][m][1]) :: "memory"); } } }
            if constexpr (Epi::TILE) E.tile(acc, cur.pm, cur.pn, wr, wc, fr, fq, (LAS float*)(lds + RING_BYTES + 2048));
            else if (!first_half) {
#pragma unroll
            for (int ai = 0; ai < 2; ++ai)
#pragma unroll
                for (int m = 0; m < 4; ++m)
#pragma unroll
                    for (int bj = 0; bj < 2; ++bj) E.st8(row0 + ai * HALF + m * 16, col0 + bj * HALF, acc[ai][bj][m][0], acc[ai][bj][m][1]);
            }
        }
        if (!has_next) break;
        if (!first_half) {
#pragma unroll
        for (int a = 0; a < 2; ++a)
#pragma unroll
            for (int b = 0; b < 2; ++b)
#pragma unroll
                for (int m = 0; m < 4; ++m)
#pragma unroll
                    for (int n = 0; n < 2; ++n) acc[a][b][m][n] = (f32x4){0.f, 0.f, 0.f, 0.f};
        }
        cur = nxt; cA = nA; cB = nB; ++ui;
        if (wr == 1) PG8_BAR;
    }
    PG8_WAIT_V(0);
    PG8_BAR;
#undef PG8_NEXT
#undef PG8_UA
#undef PG8_UB
#undef PG8_SA
#undef PG8_SB
#undef PG8_STAGE
#undef PG8_LDA
#undef PG8_LDB
#undef PG8_MMA
#undef PG8_WAIT_V
#undef PG8_WAIT_L
#undef PG8_BAR
#undef PG8_SCHED
}
}

#define XB_TMO      128
#define XB_XCNT(j)  (256  + 64 * (j))
#define XB_XSUB(j)  (1280 + 64 * (j))
#define XB_XGEN(j)  (2304 + 64 * (j))
#define XB_TOP      3328
#define XB_TOPGEN   3392
#define XCD_BAR_WORDS 3456
#define XB_SPIN_CAP (1u << 18)
__device__ __forceinline__ unsigned xb_ld(unsigned* p)              { return __hip_atomic_load(p, __ATOMIC_RELAXED, __HIP_MEMORY_SCOPE_AGENT); }
__device__ __forceinline__ unsigned xb_add(unsigned* p, unsigned v) { return __hip_atomic_fetch_add(p, v, __ATOMIC_RELAXED, __HIP_MEMORY_SCOPE_AGENT); }
__device__ __forceinline__ unsigned xb_xcc_id() { return (unsigned)__builtin_amdgcn_s_getreg((3 << 11) | 20) & 0xFu; }
#define XB_SPIN(cond, bar) do { unsigned _sp = 0; while (cond) { __builtin_amdgcn_s_sleep(1); \
    if ((++_sp & 255u) == 0u) { if (xb_ld(&(bar)[XB_TMO])) break; if (_sp > XB_SPIN_CAP) { atomicAdd(&(bar)[XB_TMO], 1u); break; } } } } while (0)
struct XcdBarrier { unsigned* bar; unsigned x; volatile LAS unsigned* st; int wave; };
__device__ __forceinline__ XcdBarrier xcd_barrier_post(unsigned* bar, volatile LAS unsigned* st, int wave) {
    XcdBarrier b; b.bar = bar; b.x = xb_xcc_id(); b.st = st; b.wave = wave;
    if (wave == 0 && lane_id() == 0) (void)xb_add(&bar[XB_XCNT(b.x)], 1u);
    return b;
}
__device__ __forceinline__ void xcd_barrier_complete(unsigned* bar, unsigned x, unsigned& nloc, unsigned& nx) {
    const unsigned G = gridDim.x * gridDim.y * gridDim.z;
    unsigned sum, cnt, mine, sp = 0u;
    for (;;) {
        sum = 0u; cnt = 0u; mine = 0u;
#pragma unroll
        for (unsigned j = 0; j < 16; ++j) { const unsigned c = xb_ld(&bar[XB_XCNT(j)]); sum += c; cnt += (c > 0u) ? 1u : 0u; mine = (j == x) ? c : mine; }
        if (sum == G) break;
        __builtin_amdgcn_s_sleep(1);
        if ((++sp & 255u) == 0u) { if (xb_ld(&bar[XB_TMO])) break; if (sp > XB_SPIN_CAP) { atomicAdd(&bar[XB_TMO], 1u); break; } }
    }
    nloc = mine > 0u ? mine : 1u; nx = cnt > 0u ? cnt : 1u;
}
__device__ __forceinline__ void xcd_barrier(const XcdBarrier& b) {
    asm volatile("s_waitcnt vmcnt(0)" ::: "memory");
    __syncthreads();
    if (b.wave == 0 && lane_id() == 0) {
        unsigned* bar = b.bar;
        __builtin_amdgcn_s_waitcnt(0);
        unsigned nloc = b.st[0], nx = b.st[1];
        if (nloc == 0u) { xcd_barrier_complete(bar, b.x, nloc, nx); b.st[0] = nloc; b.st[1] = nx; }
        const unsigned old = xb_add(&bar[XB_XSUB(b.x)], 1u);
        const unsigned gen = old / nloc;
        if (old + 1u == (gen + 1u) * nloc) {
            __builtin_amdgcn_fence(__ATOMIC_RELEASE, "agent");
            asm volatile("s_waitcnt vmcnt(0)" ::: "memory");
            const unsigned og = xb_add(&bar[XB_TOP], 1u);
            const unsigned tg = og / nx;
            if (og + 1u == (tg + 1u) * nx) xb_add(&bar[XB_TOPGEN], 1u);
            else XB_SPIN(xb_ld(&bar[XB_TOPGEN]) == tg, bar);
            __builtin_amdgcn_fence(__ATOMIC_ACQUIRE, "agent");
            xb_add(&bar[XB_XGEN(b.x)], 1u);
            asm volatile("s_waitcnt vmcnt(0)" ::: "memory");
        } else {
            XB_SPIN(xb_ld(&bar[XB_XGEN(b.x)]) == gen, bar);
            __builtin_amdgcn_fence(__ATOMIC_ACQUIRE, "agent");
            asm volatile("s_waitcnt vmcnt(0)" ::: "memory");
        }
    }
    __syncthreads();
}

struct Args { const void* in[32]; float* out; unsigned char* ws; int ph_lo, ph_hi; };
struct Frame { LAS unsigned char* lds; int wave, vcu, G; const Args* a; };
#define FP_x_prompt ((const float*)F.a->in[0])
#define FP_x_sample ((const float*)F.a->in[1])
#define FP_c_prompt ((const float*)F.a->in[2])
#define FP_c_sample ((const float*)F.a->in[3])
#define FP_cache_k ((const float*)F.a->in[4])
#define FP_cache_v ((const float*)F.a->in[5])
#define FP_page_table ((const int*)F.a->in[6])
#define FP_state_C ((const float*)F.a->in[7])
#define FP_state_n ((const float*)F.a->in[8])
#define FP_state_m ((const float*)F.a->in[9])
#define FP_state_conv ((const float*)F.a->in[10])
#define FP_w_ada ((const float*)F.a->in[11])
#define FP_b_ada ((const float*)F.a->in[12])
#define FP_g_pre_mix ((const float*)F.a->in[13])
#define FP_g_post_mix ((const float*)F.a->in[14])
#define FP_w_in ((const float*)F.a->in[15])
#define FP_b_if ((const float*)F.a->in[16])
#define FP_g_mlstm ((const float*)F.a->in[17])
#define FP_lq1 ((const float*)F.a->in[18])
#define FP_lk1 ((const float*)F.a->in[19])
#define FP_lq2 ((const float*)F.a->in[20])
#define FP_lk2 ((const float*)F.a->in[21])
#define FP_g_diff ((const float*)F.a->in[22])
#define FP_w_proj_m ((const float*)F.a->in[23])
#define FP_w_proj_d ((const float*)F.a->in[24])
#define FP_w_out ((const float*)F.a->in[25])
#define FP_g_pre_ffn ((const float*)F.a->in[26])
#define FP_g_post_ffn ((const float*)F.a->in[27])
#define FP_w_up ((const float*)F.a->in[28])
#define FP_conv_w ((const float*)F.a->in[29])
#define FP_conv_b ((const float*)F.a->in[30])
#define FP_w_down ((const float*)F.a->in[31])
#define FP_WinT ((bf16_t*)(F.a->ws + WS_WIN))
#define FP_WupT ((bf16_t*)(F.a->ws + WS_WUP))
#define FP_WdownT ((bf16_t*)(F.a->ws + WS_WDOWN))
#define FP_WoutT ((bf16_t*)(F.a->ws + WS_WOUT))
#define FP_WpT ((bf16_t*)(F.a->ws + WS_WPM))
#define FP_H1 ((bf16_t*)(F.a->ws + WS_H1))
#define FP_Z ((bf16_t*)(F.a->ws + WS_Z))
#define FP_CPREV ((bf16_t*)(F.a->ws + WS_CPREV))
#define FP_HMD ((bf16_t*)(F.a->ws + WS_HM))
#define FP_MG ((bf16_t*)(F.a->ws + WS_MG))
#define FP_AH ((float*)(F.a->ws + WS_UA))
#define FP_AF ((float*)(F.a->ws + WS_UA + 2 * MiB))
#define FP_BF ((float*)(F.a->ws + WS_UA + 4 * MiB))
#define FP_GB ((bf16_t*)(F.a->ws + WS_G))
#define FP_ADA ((float*)(F.a->ws + WS_ADA))
#define FP_IG ((float*)(F.a->ws + WS_IG))
#define FP_LF ((float*)(F.a->ws + WS_LF))
#define FP_ST ((float*)(F.a->ws + WS_ST))
#define FP_NU ((float*)(F.a->ws + WS_NU))
#define FP_NPREV ((float*)(F.a->ws + WS_NPREV))
#define FP_MPREV ((float*)(F.a->ws + WS_MPREV))
#define FP_U ((float*)(F.a->ws + WS_U))
#define FP_O1 ((bf16_t*)(F.a->ws + WS_O1))
#define FP_O2 ((bf16_t*)(F.a->ws + WS_O2))
#define FP_Y ((bf16_t*)(F.a->ws + WS_Y))
#define FP_DPART ((float*)(F.a->ws + WS_DPART))
#define FP_X1 ((bf16_t*)(F.a->ws + WS_UB + 16 * MiB))
#define FP_out (F.a->out)


__device__ __forceinline__ void transpose_item(const float* W, int pitch, int scol0, int K, bf16_t* WT, int drow0, LAS float* scr, int kb, int nb, int lane, int koff = 0) {
    const int k0 = 64 * kb, n0 = 32 * nb;
    float tv[32];
#pragma unroll
    for (int i = 0; i < 32; ++i) { const int kk = 2 * i + (lane >> 5); tv[i] = W[(size_t)(k0 + kk) * pitch + scol0 + n0 + (lane & 31)]; }
#pragma unroll
    for (int i = 0; i < 32; ++i) { const int kk = 2 * i + (lane >> 5); scr[kk * 33 + (lane & 31)] = tv[i]; }
    asm volatile("s_waitcnt lgkmcnt(0)" ::: "memory");
    const int c = lane & 7;
#pragma unroll
    for (int j = 0; j < 4; ++j) { const int n = (lane >> 3) + 8 * j; const LAS float* s = scr + (8 * c) * 33 + n;
        u32x4 o; o.x = pk2(s[0 * 33], s[1 * 33]); o.y = pk2(s[2 * 33], s[3 * 33]); o.z = pk2(s[4 * 33], s[5 * 33]); o.w = pk2(s[6 * 33], s[7 * 33]);
        *(u32x4*)(WT + (size_t)(drow0 + n0 + n) * K + koff + k0 + 8 * c) = o; }
    asm volatile("s_waitcnt lgkmcnt(0)" ::: "memory");
}
struct TBlock { const float* W; bf16_t* WT; int pitch, col_a, col_b, k0, wt_pitch, koff, drow0; };
__device__ __forceinline__ TBlock tblock_of(const Frame& F, int it) {
    constexpr int B0 = 16 * 22, B1 = 8 * 4, B2 = 8 * 4, B3 = 16 * 4, B4 = 16 * 22;
    int r = it; TBlock t;
    if (r < B0) { const int kb = r / 22, nb = r % 22; t = {FP_w_in, FP_WinT, DIN, nb < 8 ? 256 * nb : 2056 + 256 * (nb - 8), -1, 64 * kb, 1024, 0, 256 * nb}; return t; } r -= B0;
    if (r < B1) { t = {FP_w_proj_m, FP_WpT, 1024, 256 * (r & 3), -1, 64 * (r >> 2), 1024, 0, 256 * (r & 3)}; return t; } r -= B1;
    if (r < B2) { t = {FP_w_proj_d, FP_WpT, 1024, 256 * (r & 3), -1, 64 * (r >> 2), 1024, 512, 256 * (r & 3)}; return t; } r -= B2;
    if (r < B3) { t = {FP_w_out, FP_WoutT, 1024, 256 * (r & 3), -1, 64 * (r >> 2), 1024, 0, 256 * (r & 3)}; return t; } r -= B3;
    if (r < B4) { const int kb = r / 22, pn = r % 22; t = {FP_w_up, FP_WupT, 2 * DFF, 128 * pn, DFF + 128 * pn, 64 * kb, 1024, 0, 256 * pn}; return t; } r -= B4;
    t = {FP_w_down, FP_WdownT, 1024, 256 * (r & 3), -1, 64 * (r >> 2), DFF, 0, 256 * (r & 3)}; return t;
}
__device__ __forceinline__ void p0_transposes(const Frame& F) {
    constexpr int NBLK = 16 * 22 + 8 * 4 + 8 * 4 + 16 * 4 + 16 * 22 + 44 * 4;
    const int lane = lane_id(), wid = F.wave, tid = wid * 64 + lane;
    LAS float* tile = (LAS float*)F.lds;
    f32x4 v[8];
    int it = F.vcu;
    if (it < NBLK) { const TBlock t = tblock_of(F, it); const int scol = (t.col_b >= 0 && lane >= 32) ? t.col_b + 4 * (lane - 32) : t.col_a + 4 * lane;
#pragma unroll
        for (int i = 0; i < 8; ++i) v[i] = *(const f32x4*)(t.W + (size_t)(t.k0 + 8 * wid + i) * t.pitch + scol); }
    for (; it < NBLK; it += F.G) {
        const TBlock t = tblock_of(F, it);
#pragma unroll
        for (int i = 0; i < 8; ++i) *(LAS f32x4*)(tile + (8 * wid + i) * 260 + 4 * lane) = v[i];
        if (it + F.G < NBLK) { const TBlock tn = tblock_of(F, it + F.G); const int scol = (tn.col_b >= 0 && lane >= 32) ? tn.col_b + 4 * (lane - 32) : tn.col_a + 4 * lane;
#pragma unroll
            for (int i = 0; i < 8; ++i) v[i] = *(const f32x4*)(tn.W + (size_t)(tn.k0 + 8 * wid + i) * tn.pitch + scol); }
        WG_BAR();
#pragma unroll
        for (int i = 0; i < 4; ++i) { const int idx = tid + 512 * i, n = idx >> 3, c = idx & 7; const LAS float* sp = tile + (8 * c) * 260 + n;
            u32x4 o; o.x = pk2(sp[0], sp[260]); o.y = pk2(sp[2 * 260], sp[3 * 260]); o.z = pk2(sp[4 * 260], sp[5 * 260]); o.w = pk2(sp[6 * 260], sp[7 * 260]);
            *(u32x4*)(t.WT + (size_t)(t.drow0 + n) * t.wt_pitch + t.koff + t.k0 + 8 * c) = o; }
        WG_BAR();
    }
    {
        LAS float* scr = (LAS float*)(F.lds + F.wave * 8448);
        const int gw = F.vcu * NWAVES + F.wave; if (gw < 16) transpose_item(FP_w_in, DIN, 2048 - ZP, 1024, FP_WinT, 0, scr, gw, ZP / 32, lane_id());
    }
}
__device__ __forceinline__ void p0_ada(const Frame& F) {
    const int lane = lane_id(), r = lane & 31, h = lane >> 5, w = F.wave, tid = w * 64 + lane;
    LAS float* part = (LAS float*)F.lds;
    for (int task = F.vcu; task < 192; task += F.G) {
        const int n0 = 32 * task;
        bf16x8 bw[8];
#pragma unroll
        for (int ks = 0; ks < 8; ++ks) { const float* p = FP_w_ada + (size_t)(128 * w + 16 * ks + 8 * h) * 6144 + n0 + r;
            f32x4 a, b; a.x = p[0]; a.y = p[6144]; a.z = p[2 * 6144]; a.w = p[3 * 6144]; b.x = p[4 * 6144]; b.y = p[5 * 6144]; b.z = p[6 * 6144]; b.w = p[7 * 6144]; bw[ks] = pack8(a, b); }
        f32x16 acc[5];
        LAS unsigned char* ct = F.lds + w * 8704;
        int lo_ = lane; asm volatile("" : "+v"(lo_));
        const int lrow = lo_ >> 5, lcol = (lo_ & 31) * 4;
#pragma unroll
        for (int rt = 0; rt < 5; ++rt) {
            f32x4 cv[16];
#pragma unroll
            for (int i = 0; i < 16; ++i) { const int R0 = 32 * rt + 2 * i;
                if (R0 == 0) cv[i] = *(const f32x4*)(FP_c_prompt + (size_t)lrow * 1024 + 128 * w + lcol);
                else if (R0 < 130) cv[i] = *(const f32x4*)(FP_c_sample + (size_t)(R0 - 2 + lrow) * 1024 + 128 * w + lcol);
                else cv[i] = (f32x4){0.f, 0.f, 0.f, 0.f}; }
#pragma unroll
            for (int i = 0; i < 16; ++i) { u32x2 o; o.x = pk2(cv[i].x, cv[i].y); o.y = pk2(cv[i].z, cv[i].w); *(LAS u32x2*)(ct + (2 * i + lrow) * 272 + lcol * 2) = o; }
            for (int i = 0; i < 16; ++i) acc[rt][i] = 0.f;
#pragma unroll
            for (int ks = 0; ks < 8; ++ks) acc[rt] = MFMA32(*(const LAS bf16x8*)(ct + r * 272 + (16 * ks + 8 * h) * 2), bw[ks], acc[rt]);
            asm volatile("s_waitcnt lgkmcnt(0)" ::: "memory");
        }
        WG_BAR();
#pragma unroll
        for (int batch = 0; batch < 2; ++batch) {
            const int rt0 = 3 * batch, nrt = batch ? 2 : 3;
#pragma unroll
            for (int j = 0; j < 3; ++j) if (j < nrt) {
#pragma unroll
                for (int i = 0; i < 16; ++i) part[((w * 3 + j) * 32 + crow(i, h)) * 32 + r] = acc[rt0 + j][i]; }
            WG_BAR();
            for (int idx = tid; idx < nrt * 1024; idx += NTHR) { const int j = idx >> 10, row = (idx >> 5) & 31, col = idx & 31; float sum = 0.f;
#pragma unroll
                for (int ww = 0; ww < 8; ++ww) sum += part[((ww * 3 + j) * 32 + row) * 32 + col];
                const int Rr = 32 * (rt0 + j) + row; if (Rr < 130) FP_ADA[(size_t)Rr * 6144 + n0 + col] = sum + FP_b_ada[n0 + col]; }
            WG_BAR();
        }
    }
}
__device__ __forceinline__ int crow_of(int m) { return m < MP ? (m >> 13) : 2 + ((m - MP) >> 2); }
__device__ __forceinline__ const float* xrow_of(const Frame& F, int m) { return m < MP ? FP_x_prompt + (size_t)m * DM : FP_x_sample + (size_t)(m - MP) * DM; }
__device__ __forceinline__ void p1_norm_gates(const Frame& F) {
    const int lane = lane_id(), gw = F.vcu * NWAVES + F.wave, NGW = F.G * NWAVES;
    const int r_lo = (int)(((long)gw * MT) / NGW), r_hi = (int)(((long)(gw + 1) * MT) / NGW);
    f32x4 gs[4], sh[4], vn[4], vn2[4];
#pragma unroll
    for (int j = 0; j < 4; ++j) { gs[j] = (f32x4){0.f, 0.f, 0.f, 0.f}; sh[j] = gs[j]; vn[j] = gs[j]; vn2[j] = gs[j]; }
    int ccur = -1;
    if (r_lo < r_hi) { const float* xr = xrow_of(F, r_lo);
#pragma unroll
        for (int j = 0; j < 4; ++j) vn[j] = *(const f32x4*)(xr + 4 * lane + 256 * j); }
    if (r_lo + 1 < r_hi) { const float* xr = xrow_of(F, r_lo + 1);
#pragma unroll
        for (int j = 0; j < 4; ++j) vn2[j] = *(const f32x4*)(xr + 4 * lane + 256 * j); }
    for (int m = r_lo; m < r_hi; ++m) {
        f32x4 v[4]; float ss = 0.f;
#pragma unroll
        for (int j = 0; j < 4; ++j) { v[j] = vn[j]; vn[j] = vn2[j]; }
        if (m + 2 < r_hi) { const float* xr = xrow_of(F, m + 2);
#pragma unroll
            for (int j = 0; j < 4; ++j) vn2[j] = *(const f32x4*)(xr + 4 * lane + 256 * j); }
        const int cr = crow_of(m);
        if (cr != ccur) { ccur = cr; const float* ada = FP_ADA + (size_t)cr * 6144;
#pragma unroll
            for (int j = 0; j < 4; ++j) { sh[j] = *(const f32x4*)(ada + 4 * lane + 256 * j); gs[j] = *(const f32x4*)(FP_g_pre_mix + 4 * lane + 256 * j) * (*(const f32x4*)(ada + 1024 + 4 * lane + 256 * j) + 1.f); } }
#pragma unroll
        for (int j = 0; j < 4; ++j) ss += (v[j].x * v[j].x + v[j].y * v[j].y) + (v[j].z * v[j].z + v[j].w * v[j].w);
        const float rs = rsqrtf(wave_sum(ss) * (1.f / DM) + EPS);
#pragma unroll
        for (int j = 0; j < 4; ++j) { const f32x4 hv = (v[j] * rs) * gs[j] + sh[j];
            u32x2 o; o.x = pk2(hv.x, hv.y); o.y = pk2(hv.z, hv.w); *(u32x2*)(FP_H1 + (size_t)m * DM + 4 * lane + 256 * j) = o; }
    }
}
struct EpiZ {
    static constexpr int MID_T = -1; static constexpr bool TILE = true;
    bf16_t* Z; float* out; float* IG; float* LF; const float* b_if;
    __device__ __forceinline__ void st8(int, int, f32x4, f32x4) const {}
    __device__ __forceinline__ void tile(f32x4 (&acc)[2][2][4][2], int pm, int pn, int wr, int wc, int fr, int fq, LAS float*) const {
        const int row0 = pm * 256 + wr * 64 + fr, col0 = pn * 256 + wc * 32 + 8 * fq;
        if (pn == ZP / 256) {
            if (wc == 0 && fq == 0) { const f32x4 bi = *(const f32x4*)b_if, bf = *(const f32x4*)(b_if + 4);
#pragma unroll
                for (int ai = 0; ai < 2; ++ai)
#pragma unroll
                    for (int m = 0; m < 4; ++m) { const int row = row0 + ai * 128 + m * 16; const f32x4 v1 = acc[ai][0][m][1] + bf;
                        *(f32x4*)(IG + (size_t)row * 4) = acc[ai][0][m][0] + bi;
                        *(f32x4*)(LF + (size_t)row * 4) = (f32x4){log_sigmoid(v1.x), log_sigmoid(v1.y), log_sigmoid(v1.z), log_sigmoid(v1.w)}; } }
        } else if (pn >= 14) {
#pragma unroll
            for (int ai = 0; ai < 2; ++ai)
#pragma unroll
                for (int m = 0; m < 4; ++m)
#pragma unroll
                    for (int bj = 0; bj < 2; ++bj) { f32x4 v0 = acc[ai][bj][m][0], v1 = acc[ai][bj][m][1];
                        v0.x = sigmoidf_(v0.x); v0.y = sigmoidf_(v0.y); v0.z = sigmoidf_(v0.z); v0.w = sigmoidf_(v0.w); v1.x = sigmoidf_(v1.x); v1.y = sigmoidf_(v1.y); v1.z = sigmoidf_(v1.z); v1.w = sigmoidf_(v1.w);
                        *(bf16x8*)(Z + zbase(col0 + bj * 128) + (size_t)(row0 + ai * 128 + m * 16) * ZR) = pack8(v0, v1); }
        } else if (pn >= 10) {
            const int kv = pn >= 12;
#pragma unroll
            for (int ai = 0; ai < 2; ++ai)
#pragma unroll
                for (int m = 0; m < 4; ++m)
#pragma unroll
                    for (int bj = 0; bj < 2; ++bj) { const int row = row0 + ai * 128 + m * 16, col = col0 + bj * 128, c = col - (kv ? ZDV : ZDK);
                        float* o = row < MP ? out + (kv ? OFF_VP : OFF_KP) + (size_t)row * 512 + c : out + (kv ? OFF_VS : OFF_KS) + (size_t)(row - MP) * 512 + c;
                        *(f32x4*)o = acc[ai][bj][m][0]; *(f32x4*)(o + 4) = acc[ai][bj][m][1];
                        *(bf16x8*)(Z + zbase(col) + (size_t)row * ZR) = pack8(acc[ai][bj][m][0], acc[ai][bj][m][1]); }
        } else {
            const float sc = (pn == 2 || pn == 3) ? KSCALE : ((pn == 8 || pn == 9) ? QSCALE : 1.f);
#pragma unroll
            for (int ai = 0; ai < 2; ++ai)
#pragma unroll
                for (int m = 0; m < 4; ++m)
#pragma unroll
                    for (int bj = 0; bj < 2; ++bj) *(bf16x8*)(Z + zbase(col0 + bj * 128) + (size_t)(row0 + ai * 128 + m * 16) * ZR) = pack8(acc[ai][bj][m][0] * sc, acc[ai][bj][m][1] * sc);
        }
    }
};
struct EpiPMD {
    static constexpr int MID_T = 6; static constexpr bool TILE = false;
    const bf16_t* Z; bf16_t* MG;
    __device__ __forceinline__ void mid8(int row, int col, f32x4& v0, f32x4& v1) const {
        const u32x4 gm = *(const u32x4*)(Z + zbase(ZGM + col) + (size_t)row * ZR), gd = *(const u32x4*)(Z + zbase(ZGD + col) + (size_t)row * ZR);
        f32x4 m0, m1, d0, d1; unpack8(gm, m0, m1); unpack8(gd, d0, d1);
        d0.x = fmaxf(d0.x, 1e-20f); d0.y = fmaxf(d0.y, 1e-20f); d0.z = fmaxf(d0.z, 1e-20f); d0.w = fmaxf(d0.w, 1e-20f); d1.x = fmaxf(d1.x, 1e-20f); d1.y = fmaxf(d1.y, 1e-20f); d1.z = fmaxf(d1.z, 1e-20f); d1.w = fmaxf(d1.w, 1e-20f);
        v0.x *= m0.x * __builtin_amdgcn_rcpf(d0.x); v0.y *= m0.y * __builtin_amdgcn_rcpf(d0.y); v0.z *= m0.z * __builtin_amdgcn_rcpf(d0.z); v0.w *= m0.w * __builtin_amdgcn_rcpf(d0.w);
        v1.x *= m1.x * __builtin_amdgcn_rcpf(d1.x); v1.y *= m1.y * __builtin_amdgcn_rcpf(d1.y); v1.z *= m1.z * __builtin_amdgcn_rcpf(d1.z); v1.w *= m1.w * __builtin_amdgcn_rcpf(d1.w); }
    __device__ __forceinline__ void st8(int row, int col, f32x4 v0, f32x4 v1) const {
        f32x4 d0, d1; unpack8(*(const u32x4*)(Z + zbase(ZGD + col) + (size_t)row * ZR), d0, d1);
        d0.x = fmaxf(d0.x, 1e-20f); d0.y = fmaxf(d0.y, 1e-20f); d0.z = fmaxf(d0.z, 1e-20f); d0.w = fmaxf(d0.w, 1e-20f); d1.x = fmaxf(d1.x, 1e-20f); d1.y = fmaxf(d1.y, 1e-20f); d1.z = fmaxf(d1.z, 1e-20f); d1.w = fmaxf(d1.w, 1e-20f);
        *(bf16x8*)(MG + (size_t)row * DM + col) = pack8(v0 * d0, v1 * d1); }
    __device__ __forceinline__ void st4md(int row, int col, f32x4 am, f32x4 ad) const {
        const u32x2 gm = *(const u32x2*)(Z + zbase(ZGM + col) + (size_t)row * ZR), gd = *(const u32x2*)(Z + zbase(ZGD + col) + (size_t)row * ZR);
        u32x2 o; o.x = pk2(bflo(gm.x) * am.x + bflo(gd.x) * ad.x, bfhi(gm.x) * am.y + bfhi(gd.x) * ad.y); o.y = pk2(bflo(gm.y) * am.z + bflo(gd.y) * ad.z, bfhi(gm.y) * am.w + bfhi(gd.y) * ad.w);
        *(u32x2*)(MG + (size_t)row * DM + col) = o; }
};
struct EpiF32 {
    static constexpr int MID_T = -1; static constexpr bool TILE = false;
    bf16_t* Y;
    __device__ __forceinline__ void st4(int row, int col, f32x4 v) const { u32x2 o; o.x = pk2(v.x, v.y); o.y = pk2(v.z, v.w); *(u32x2*)(Y + (size_t)row * DM + col) = o; }
    __device__ __forceinline__ void st8(int row, int col, f32x4 v0, f32x4 v1) const { *(bf16x8*)(Y + (size_t)row * DM + col) = pack8(v0, v1); }
};
__device__ __forceinline__ float gelu_tanh(float x) { const float u = 1.5957691216057308f * (x + 0.044715f * x * x * x); return x * __builtin_amdgcn_rcpf(1.f + __builtin_amdgcn_exp2f(-u * LOG2E)); }
#define DPP_F(oldv, srcv, ctrl) __builtin_bit_cast(float, __builtin_amdgcn_update_dpp(__builtin_bit_cast(int, (float)(oldv)), __builtin_bit_cast(int, (float)(srcv)), (ctrl), 0xf, 0xf, false))
struct EpiUpG {
    static constexpr int MID_T = -1; static constexpr bool TILE = true;
    bf16_t* G; float* out; const float* conv_w; const float* conv_b; const float* state_conv; float* AH; float* AF; float* BF;
    __device__ __forceinline__ void st8(int, int, f32x4, f32x4) const {}
    __device__ __forceinline__ void tile(f32x4 (&acc)[2][2][4][2], int pm, int pn, int wr, int wc, int fr, int fq, LAS float* halo) const {
        if (pm >= MP / 256) body<true>(acc, pm, pn, wr, wc, fr, fq, halo); else body<false>(acc, pm, pn, wr, wc, fr, fq, halo);
    }
    template <bool SAMPLE>
    __device__ __forceinline__ void body(f32x4 (&acc)[2][2][4][2], int pm, int pn, int wr, int wc, int fr, int fq, LAS float* halo) const {
        const int f0 = 128 * pn + 32 * wc + 8 * fq;
        if constexpr (!SAMPLE) {
#pragma unroll
            for (int ai = 0; ai < 2; ++ai) if (fr >= 14) { LAS float* hp = halo + ((2 * ai + wr) * 2 + (fr - 14)) * 128 + 32 * wc + 8 * fq; *(LAS f32x4*)hp = acc[ai][0][3][0]; *(LAS f32x4*)(hp + 4) = acc[ai][0][3][1]; }
        }
        asm volatile("s_waitcnt lgkmcnt(0)\n\ts_barrier" ::: "memory");
#pragma unroll
        for (int n = 0; n < 2; ++n) {
            const int fc = f0 + 4 * n;
            const f32x4 w0 = *(const f32x4*)(conv_w + fc), w1 = *(const f32x4*)(conv_w + DFF + fc), w2 = *(const f32x4*)(conv_w + 2 * DFF + fc), cb = *(const f32x4*)(conv_b + fc);
#pragma unroll
            for (int ai = 0; ai < 2; ++ai) {
                const int g = 2 * ai + wr;
                f32x4 h0 = {0.f, 0.f, 0.f, 0.f}, h1 = h0;
                if constexpr (!SAMPLE) { if (g > 0) { const LAS float* hp = halo + ((g - 1) * 2) * 128 + 32 * wc + 8 * fq + 4 * n; h0 = *(const LAS f32x4*)hp; h1 = *(const LAS f32x4*)(hp + 128); } }
#pragma unroll
                for (int m = 0; m < 4; ++m) {
                    const int rowt = 128 * ai + 64 * wr + 16 * m + fr, row = 256 * pm + rowt, tq = fr & 3;
                    f32x4 s0 = {0.f, 0.f, 0.f, 0.f}, s1 = s0;
                    if constexpr (SAMPLE) { const float* st = state_conv + (size_t)((row - MP) >> 2) * 2 * DFF + fc; s0 = *(const f32x4*)st; s1 = *(const f32x4*)(st + DFF); }
                    f32x4 gv;
#pragma unroll
                    for (int e = 0; e < 4; ++e) {
                        const float a0 = acc[ai][0][m][n][e], bv = acc[ai][1][m][n][e];
                        float p1, p2;
                        if constexpr (SAMPLE) {
                            const float d1 = DPP_F(0.f, a0, 0x111), d2 = DPP_F(0.f, a0, 0x112);
                            p1 = (tq >= 1) ? d1 : s1[e]; p2 = (tq >= 2) ? d2 : ((tq == 1) ? s1[e] : s0[e]);
                        } else {
                            float t1, t2;
                            if (m > 0) { const float pr = acc[ai][0][m > 0 ? m - 1 : 0][n][e]; t1 = DPP_F(0.f, pr, 0x10F); t2 = DPP_F(0.f, pr, 0x10E); }
                            else { t1 = h1[e]; t2 = (fr == 0) ? h0[e] : h1[e]; }
                            p1 = DPP_F(t1, a0, 0x111); p2 = DPP_F(t2, a0, 0x112);
                        }
                        const float cv = cb[e] + w0[e] * p2 + w1[e] * p1 + w2[e] * a0;
                        gv[e] = gelu_tanh(cv) * bv;
                    }
                    { u32x2 o; o.x = pk2(gv.x, gv.y); o.y = pk2(gv.z, gv.w); *(u32x2*)(G + (size_t)row * DFF + fc) = o; }
                    if constexpr (!SAMPLE) {
                        if (ai == 1 && m == 3) { if (rowt >= 254) { *(f32x4*)(AH + ((size_t)pm * 2 + (rowt - 254)) * DFF + fc) = acc[ai][0][m][n];
                            if ((pm & 31) == 31) *(f32x4*)(out + OFF_CVP + ((size_t)(pm >> 5) * 2 + (rowt - 254)) * DFF + fc) = acc[ai][0][m][n]; } }
                        if (ai == 0 && m == 0) { if (rowt < 2) { *(f32x4*)(AF + ((size_t)pm * 2 + rowt) * DFF + fc) = acc[ai][0][m][n]; *(f32x4*)(BF + ((size_t)pm * 2 + rowt) * DFF + fc) = acc[ai][1][m][n]; } }
                    } else { if (tq >= 2) *(f32x4*)(out + OFF_CVS + ((size_t)((row - MP) >> 2) * 2 + (tq - 2)) * DFF + fc) = acc[ai][0][m][n]; }
                    asm volatile("" ::: "memory");
                }
            }
        }
    }
};
__device__ __forceinline__ void geglu_fixup(const Frame& F, int pm) {
    if (pm >= MP / 256 || (pm & 31) == 0) return;
    const float* ah = FP_AH + (size_t)(pm - 1) * 2 * DFF; const float* af = FP_AF + (size_t)pm * 2 * DFF; const float* bfp = FP_BF + (size_t)pm * 2 * DFF;
    for (int i = FTID(F); i < 2 * DFF; i += NTHR) { const int r = i / DFF, f = i - r * DFF;
        const float a0 = af[r * DFF + f], bv = bfp[r * DFF + f], p1 = (r == 0) ? ah[DFF + f] : af[f], p2 = (r == 0) ? ah[f] : ah[DFF + f];
        const float cv = FP_conv_b[f] + FP_conv_w[f] * p2 + FP_conv_w[DFF + f] * p1 + FP_conv_w[2 * DFF + f] * a0;
        FP_GB[(size_t)(256 * pm + r) * DFF + f] = f2bf(gelu_tanh(cv) * bv); }
    asm volatile("s_waitcnt vmcnt(0)" ::: "memory");
    WG_BAR();
}
template <bool MD, class Epi>
__device__ __forceinline__ void skinny_gemm(const Frame& F, const bf16_t* A, const bf16_t* Bt, int K, const Epi& E) {
    const int lane = lane_id(), r = lane & 31, h = lane >> 5, ke = F.wave, K8 = K >> 3, tid = F.wave * 64 + lane;
    LAS float* part = (LAS float*)F.lds;
    for (int task = F.vcu; task < 256; task += F.G) {
        const int rt = task >> 4, cg = task & 15;
        const bf16_t* ap = A + (size_t)(32 * rt + r) * K + ke * K8 + 8 * h;
        const bf16_t* bp0 = Bt + (size_t)(64 * cg + r) * K + ke * K8 + 8 * h; const bf16_t* bp1 = bp0 + (size_t)32 * K;
        f32x16 acc0, acc1; for (int i = 0; i < 16; ++i) { acc0[i] = 0.f; acc1[i] = 0.f; }
#pragma unroll 4
        for (int s = 0; s < K8 / 16; ++s) { const bf16x8 a = *(const bf16x8*)(ap + 16 * s), b0 = *(const bf16x8*)(bp0 + 16 * s), b1 = *(const bf16x8*)(bp1 + 16 * s); acc0 = MFMA32(b0, a, acc0); acc1 = MFMA32(b1, a, acc1); }
#pragma unroll
        for (int g4 = 0; g4 < 4; ++g4) { *(LAS f32x4*)(part + (ke * 32 + r) * 68 + 8 * g4 + 4 * h) = (f32x4){acc0[4 * g4], acc0[4 * g4 + 1], acc0[4 * g4 + 2], acc0[4 * g4 + 3]};
            *(LAS f32x4*)(part + (ke * 32 + r) * 68 + 32 + 8 * g4 + 4 * h) = (f32x4){acc1[4 * g4], acc1[4 * g4 + 1], acc1[4 * g4 + 2], acc1[4 * g4 + 3]}; }
        WG_BAR();
        { const int row = tid >> 4, c4 = (tid & 15) * 4;
          const f32x4 lo = *(const LAS f32x4*)(part + row * 68 + c4) + *(const LAS f32x4*)(part + (32 + row) * 68 + c4) + *(const LAS f32x4*)(part + (64 + row) * 68 + c4) + *(const LAS f32x4*)(part + (96 + row) * 68 + c4);
          const f32x4 hi4 = *(const LAS f32x4*)(part + (128 + row) * 68 + c4) + *(const LAS f32x4*)(part + (160 + row) * 68 + c4) + *(const LAS f32x4*)(part + (192 + row) * 68 + c4) + *(const LAS f32x4*)(part + (224 + row) * 68 + c4);
          if constexpr (MD) E.st4md(MP + 32 * rt + row, 64 * cg + c4, lo, hi4);
          else E.st4(MP + 32 * rt + row, 64 * cg + c4, lo + hi4); }
        WG_BAR();
    }
}

constexpr int VROW = 320;
constexpr int CH = 128, NCH = TP / CH;
__device__ __forceinline__ void chunk_scan(const Frame& F, int m0, int h, int lane, float& F1, float& F2, float& a1, float& a2, float& A1, float& A2) {
    const float lf1 = FP_LF[(size_t)(m0 + lane) * 4 + h], lf2 = FP_LF[(size_t)(m0 + 64 + lane) * 4 + h], ig1 = FP_IG[(size_t)(m0 + lane) * 4 + h], ig2 = FP_IG[(size_t)(m0 + 64 + lane) * 4 + h];
    F1 = wave_scan_sum(lf1, lane); F2 = __shfl(F1, 63) + wave_scan_sum(lf2, lane);
    a1 = ig1 - F1; a2 = ig2 - F2;
    A1 = wave_scan_max(a1, lane); A2 = fmaxf(__shfl(A1, 63), wave_scan_max(a2, lane));
}
__device__ __forceinline__ void mlstm_A_unit(const Frame& F, int u) {
    const int bh = u / NCH, c = u % NCH, b = bh >> 2, h = bh & 3, m0 = b * TP + c * CH;
    const int lane = lane_id(), wid = F.wave, tid = wid * 64 + lane;
    LAS unsigned char* Vt = F.lds; LAS unsigned char* Kt = F.lds + CH * VROW; LAS float* wl = (LAS float*)(F.lds + 2 * CH * VROW);
    if (wid == 0) {
        float F1, F2, a1, a2, A1, A2; chunk_scan(F, m0, h, lane, F1, F2, a1, a2, A1, A2);
        const float Mloc = __shfl(A2, 63), Fsum = __shfl(F2, 63);
        wl[lane] = __expf(a1 - Mloc); wl[64 + lane] = __expf(a2 - Mloc);
        if (lane == 0) { FP_ST[2 * u] = Fsum; FP_ST[2 * u + 1] = Mloc; }
    }
    WG_BAR();
#pragma unroll
    for (int i = 0; i < 4; ++i) { const int idx = tid + 512 * i, row = idx >> 4, ch = idx & 15;
        const bf16_t* src = FP_Z + (size_t)(m0 + row) * ZR;
        const u32x4 vv = *(const u32x4*)(src + zbase(ZV + h * 128 + ch * 8)); const u32x4 kk = *(const u32x4*)(src + zbase(ZK + h * 128 + ch * 8));
        f32x4 k0, k1; unpack8(kk, k0, k1); const float w = wl[row];
        *(LAS u32x4*)(Vt + row * VROW + ch * 16) = vv;
        *(LAS bf16x8*)(Kt + row * VROW + ch * 16) = pack8(k0 * w, k1 * w); }
    WG_BAR();
    if (tid < 128) { float sm = 0.f;
#pragma unroll 8
        for (int row = 0; row < CH; ++row) sm += bf2f(*(const LAS bf16_t*)(Kt + row * VROW + tid * 2));
        FP_NU[(size_t)u * 128 + tid] = sm; }
    {
        const int r32 = lane & 31, hi = lane >> 5, vh = (lane >> 4) & 1, q4 = (lane & 15) >> 2, p = lane & 3;
        const int vt = wid >> 1, dt0 = 2 * (wid & 1);
        const int lbase = (8 * hi + q4) * VROW + (16 * vh + 4 * p) * 2;
        f32x16 acc0, acc1; for (int i = 0; i < 16; ++i) { acc0[i] = 0.f; acc1[i] = 0.f; }
#pragma unroll
        for (int st = 0; st < CH / 16; ++st) {
            const LAS unsigned char* va = Vt + lbase + st * 16 * VROW + vt * 64;
            const bf16x8 af = cat4(tr_rd(va), tr_rd(va + 4 * VROW));
            const LAS unsigned char* ka = Kt + lbase + st * 16 * VROW + dt0 * 64;
            const bf16x8 b0 = cat4(tr_rd(ka), tr_rd(ka + 4 * VROW)), b1 = cat4(tr_rd(ka + 64), tr_rd(ka + 64 + 4 * VROW));
            acc0 = MFMA32(af, b0, acc0); acc1 = MFMA32(af, b1, acc1);
        }
        float* Uo = FP_U + (size_t)u * 16384;
#pragma unroll
        for (int i = 0; i < 16; ++i) { const int v = 32 * vt + crow(i, hi); Uo[v * 128 + 32 * dt0 + r32] = acc0[i]; Uo[v * 128 + 32 * dt0 + 32 + r32] = acc1[i]; }
    }
    WG_BAR();
}
__device__ __forceinline__ void smlstm_unit(const Frame& F, int u) {
    const int n = u >> 2, h = u & 3, tid = FTID(F), lane = lane_id(), wid = F.wave;
    const int mrow = MP + 4 * n;
    LAS float* qs = (LAS float*)F.lds; LAS float* ks = qs + 512; LAS float* vs = ks + 512; LAS float* numI = vs + 512; LAS float* Sm = numI + 512; LAS float* nq = Sm + 16; LAS float* red = nq + 4;
    { const int t = tid >> 7, d = tid & 127; const bf16_t* z = FP_Z + (size_t)(mrow + t) * ZR;
      qs[tid] = bf2f(z[zbase(ZQ + h * 128 + d)]); ks[tid] = bf2f(z[zbase(ZK + h * 128 + d)]); vs[tid] = bf2f(z[zbase(ZV + h * 128 + d)]); }
    LAS float* gl = red + 8;
    const float m0 = FP_state_m[n * 4 + h];
    if (tid < 4) { float cum = 0.f, am = -INFINITY, at = 0.f;
      for (int t = 0; t <= tid; ++t) { cum += FP_LF[(size_t)(mrow + t) * 4 + h]; at = FP_IG[(size_t)(mrow + t) * 4 + h] - cum; am = fmaxf(am, at); }
      const float mxv = fmaxf(m0, am);
      gl[tid] = cum; gl[4 + tid] = at; gl[8 + tid] = mxv; gl[12 + tid] = __expf(m0 - mxv); gl[16 + tid] = cum + mxv; }
    WG_BAR();
    const float m_end = gl[19], Fend = gl[3], decay = __expf(Fend + m0 - m_end);
    const float wend0 = __expf(Fend + gl[4] - m_end), wend1 = __expf(Fend + gl[5] - m_end), wend2 = __expf(Fend + gl[6] - m_end), wend3 = __expf(Fend + gl[7] - m_end);
#pragma unroll
    for (int k = 0; k < 2; ++k) { const int pid = 2 * wid + k, t = pid >> 2, s = pid & 3;
        float d = qs[t * 128 + lane] * ks[s * 128 + lane] + qs[t * 128 + 64 + lane] * ks[s * 128 + 64 + lane]; d = wave_sum(d);
        if (lane == 0) Sm[pid] = (s <= t) ? d * __expf(gl[4 + s] - gl[8 + t]) : 0.f; }
    if (wid < 4) { const float* n0 = FP_state_n + (size_t)u * 128; float d = n0[lane] * qs[wid * 128 + lane] + n0[64 + lane] * qs[wid * 128 + 64 + lane]; d = wave_sum(d); if (lane == 0) nq[wid] = d; }
    { const int vrow = tid >> 2, dq = tid & 3;
      const float* c0 = FP_state_C + ((size_t)u * 128 + vrow) * 128 + 32 * dq; float* co = FP_out + OFF_CS + ((size_t)u * 128 + vrow) * 128 + 32 * dq;
      f32x4 cv[8];
#pragma unroll
      for (int i = 0; i < 8; ++i) cv[i] = *(const f32x4*)(c0 + 4 * i);
      float ps[4]; float coef[4];
      ps[0] = 0.f; ps[1] = 0.f; ps[2] = 0.f; ps[3] = 0.f;
      coef[0] = wend0 * vs[vrow]; coef[1] = wend1 * vs[128 + vrow]; coef[2] = wend2 * vs[256 + vrow]; coef[3] = wend3 * vs[384 + vrow];
#pragma unroll
      for (int i = 0; i < 8; ++i) { f32x4 cn = cv[i] * decay;
#pragma unroll
          for (int t = 0; t < 4; ++t) { const f32x4 qv = *(const LAS f32x4*)(qs + t * 128 + 32 * dq + 4 * i), kv = *(const LAS f32x4*)(ks + t * 128 + 32 * dq + 4 * i);
              ps[t] += (cv[i].x * qv.x + cv[i].y * qv.y) + (cv[i].z * qv.z + cv[i].w * qv.w); cn += kv * coef[t]; }
          *(f32x4*)(co + 4 * i) = cn; }
#pragma unroll
      for (int t = 0; t < 4; ++t) { ps[t] += __shfl_xor(ps[t], 1); ps[t] += __shfl_xor(ps[t], 2); if (dq == 0) numI[t * 128 + vrow] = ps[t]; } }
    WG_BAR();
    { const int t = tid >> 7, v = tid & 127;
      const float it = gl[12 + t], mtt = gl[16 + t];
      float num = it * numI[tid], den = it * nq[t];
#pragma unroll
      for (int s = 0; s < 4; ++s) { const float sv = Sm[t * 4 + s]; num += sv * vs[s * 128 + v]; den += sv; }
      const float hval = num / fmaxf(fabsf(den), __expf(-mtt));
      const float ssw = wave_sum(hval * hval); if (lane == 0) red[wid] = ssw;
      WG_BAR();
      const float rms = rsqrtf((red[2 * t] + red[2 * t + 1]) * (1.f / 128.f) + EPS);
      const float mo = bf2f(FP_Z[zbase(ZO + h * 128 + v) + (size_t)(mrow + t) * ZR]);
      FP_HMD[(size_t)(mrow + t) * 1024 + h * 128 + v] = f2bf(hval * rms * FP_g_mlstm[h * 128 + v] * sigmoidf_(mo));
      if (tid < 128) { const float n0v = FP_state_n[(size_t)u * 128 + tid]; float nn = decay * n0v;
          nn += wend0 * ks[tid] + wend1 * ks[128 + tid] + wend2 * ks[256 + tid] + wend3 * ks[384 + tid];
          FP_out[OFF_NS + (size_t)u * 128 + tid] = nn; }
      if (tid == 0) FP_out[OFF_MS + u] = m_end; }
    WG_BAR();
}
__device__ __forceinline__ void mlstm_scan_item(const Frame& F, int item) {
    const int tid = FTID(F), bh = item >> 5, j = item & 31, e = 512 * j + tid; const bool nthr = (j == 0 && tid < 128);
    float C = 0.f, m = 0.f, nacc = 0.f;
    const float* Ub = FP_U + (size_t)bh * NCH * 16384 + e; bf16_t* Cp = FP_CPREV + (size_t)bh * NCH * 16384 + e;
    for (int c0 = 0; c0 < NCH; c0 += 32) {
        float uu[32], un[32];
#pragma unroll
        for (int i = 0; i < 32; ++i) { uu[i] = Ub[(size_t)(c0 + i) * 16384]; un[i] = nthr ? FP_NU[(size_t)(bh * NCH + c0 + i) * 128 + tid] : 0.f; }
#pragma unroll
        for (int i = 0; i < 32; ++i) { const int c = c0 + i; const float fs = FP_ST[2 * (bh * NCH + c)], ml = FP_ST[2 * (bh * NCH + c) + 1];
            Cp[(size_t)c * 16384] = f2bf(C);
            if (nthr) FP_NPREV[(size_t)(bh * NCH + c) * 128 + tid] = nacc;
            if (j == 0 && tid == 0) FP_MPREV[bh * NCH + c] = m;
            const float mn = fs + fmaxf(m, ml), dec = __expf(fs + m - mn), sc = __expf(fs + ml - mn);
            C = dec * C + sc * uu[i]; nacc = dec * nacc + sc * un[i]; m = mn; }
    }
    FP_out[OFF_CP + (size_t)bh * 16384 + e] = C;
    if (nthr) FP_out[OFF_NP + bh * 128 + tid] = nacc;
    if (j == 0 && tid == 0) FP_out[OFF_MP + bh] = m;
}
__device__ __forceinline__ void glds16(const void* gsrc, unsigned lds_dst);
__device__ __forceinline__ void mlstm_C_group(const Frame& F, int grp) {
    const int tid_ = FTID(F);
    const int lane = tid_ & 63, wid = F.wave, r32 = lane & 31, hi = lane >> 5, ci = wid >> 2, tt = wid & 3;
    const int u = 2 * grp + ci, bh = u / NCH, c = u % NCH, b = bh >> 2, h = bh & 3, m0 = b * TP + c * CH;
    LAS unsigned char* Vt = F.lds + ci * 32768;
    LAS float* Fa = (LAS float*)(F.lds + 65536 + wid * 2048); LAS float* aa = Fa + 128; LAS float* Aa = aa + 128;
    {
        const unsigned lds0 = (unsigned)(uintptr_t)Vt;
#pragma unroll
        for (int k = 0; k < 8; ++k) { const int bb = 8 * tt + k, c4 = bb >> 3, kg = bb & 7;
            glds16(FP_Z + zbase(ZV + h * 128 + c4 * 32 + (lane & 3) * 8) + (size_t)(m0 + kg * 16 + (lane >> 2)) * ZR, (unsigned)__builtin_amdgcn_readfirstlane(lds0 + bb * 1024)); }
    }
    {
        float F1, F2, a1, a2, A1, A2; chunk_scan(F, m0, h, lane, F1, F2, a1, a2, A1, A2);
        Fa[lane] = F1; Fa[64 + lane] = F2; aa[lane] = a1; aa[64 + lane] = a2; Aa[lane] = A1; Aa[64 + lane] = A2;
    }
    const int t = 32 * tt + r32;
    const float mprev = FP_MPREV[u];
    bf16x8 qf[8];
    { const bf16_t* qp = FP_Z + zbase(ZQ + h * 128 + 8 * hi) + (size_t)(m0 + t) * ZR;
#pragma unroll
      for (int st = 0; st < 8; ++st) qf[st] = *(const bf16x8*)(qp + 16 * st); }
    const float Ft = Fa[t], At = Aa[t], mxt = fmaxf(mprev, At), mt = Ft + mxt, inter = __expf(mprev - mxt);
    float dq = 0.f;
    { const float* np = FP_NPREV + (size_t)u * 128 + 8 * hi;
#pragma unroll
      for (int st = 0; st < 8; ++st) { const f32x4 n0 = *(const f32x4*)(np + 16 * st), n1 = *(const f32x4*)(np + 16 * st + 4); f32x4 q0, q1; unpack8(__builtin_bit_cast(u32x4, qf[st]), q0, q1);
          dq += (q0.x * n0.x + q0.y * n0.y) + (q0.z * n0.z + q0.w * n0.w) + (q1.x * n1.x + q1.y * n1.y) + (q1.z * n1.z + q1.w * n1.w); } }
    dq += __shfl_xor(dq, 32);
    f32x16 acc[4];
#pragma unroll
    for (int vt = 0; vt < 4; ++vt) { for (int i = 0; i < 16; ++i) acc[vt][i] = 0.f;
        const bf16_t* cp = FP_CPREV + (size_t)u * 16384 + (size_t)(32 * vt + r32) * 128 + 8 * hi;
#pragma unroll
        for (int st = 0; st < 8; ++st) acc[vt] = MFMA32(*(const bf16x8*)(cp + 16 * st), qf[st], acc[vt]);
#pragma unroll
        for (int i = 0; i < 16; ++i) acc[vt][i] *= inter; }
    asm volatile("s_waitcnt vmcnt(0) lgkmcnt(0)\n\ts_barrier" ::: "memory");
    float den = 0.f;
    const int vh = (lane >> 4) & 1, q4 = (lane & 15) >> 2, p = lane & 3;
    const int vlane = (4 * hi + q4) * 64 + (16 * vh + 4 * p) * 2;
    for (int sub = 0; sub <= tt; ++sub) {
        f32x16 sacc; for (int i = 0; i < 16; ++i) sacc[i] = 0.f;
        { const bf16_t* kp = FP_Z + zbase(ZK + h * 128 + 8 * hi) + (size_t)(m0 + 32 * sub + r32) * ZR;
#pragma unroll
          for (int st = 0; st < 8; ++st) sacc = MFMA32(*(const bf16x8*)(kp + 16 * st), qf[st], sacc); }
#pragma unroll
        for (int g = 0; g < 4; ++g) { const f32x4 av = *(const LAS f32x4*)(aa + 32 * sub + 8 * g + 4 * hi);
#pragma unroll
            for (int k = 0; k < 4; ++k) { const int sidx = 32 * sub + 8 * g + 4 * hi + k; const float wgt = (sidx <= t) ? __expf(av[k] - mxt) : 0.f; const float val = (sidx <= t) ? sacc[4 * g + k] * wgt : 0.f; sacc[4 * g + k] = val; den += val; } }
#pragma unroll
        for (int s2 = 0; s2 < 2; ++s2) {
            const bf16x8 pb = pack8((f32x4){sacc[8 * s2], sacc[8 * s2 + 1], sacc[8 * s2 + 2], sacc[8 * s2 + 3]}, (f32x4){sacc[8 * s2 + 4], sacc[8 * s2 + 5], sacc[8 * s2 + 6], sacc[8 * s2 + 7]});
            const LAS unsigned char* va = Vt + vlane + (2 * sub + s2) * 1024;
#pragma unroll
            for (int vt = 0; vt < 4; ++vt) acc[vt] = MFMA32(cat4(tr_rd(va + vt * 8192), tr_rd(va + vt * 8192 + 512)), pb, acc[vt]);
        }
    }
    den += __shfl_xor(den, 32);
    den += inter * dq;
    const float rden = 1.f / fmaxf(fabsf(den), __expf(-mt));
    float ss = 0.f;
#pragma unroll
    for (int vt = 0; vt < 4; ++vt) for (int i = 0; i < 16; ++i) { acc[vt][i] *= rden; ss += acc[vt][i] * acc[vt][i]; }
    ss += __shfl_xor(ss, 32);
    const float rms = rsqrtf(ss * (1.f / 128.f) + EPS);
#pragma unroll
    for (int vt = 0; vt < 4; ++vt)
#pragma unroll
        for (int g = 0; g < 4; ++g) { const int v = 32 * vt + 8 * g + 4 * hi;
            const f32x4 gv = *(const f32x4*)(FP_g_mlstm + h * 128 + v); const u32x2 mo = *(const u32x2*)(FP_Z + zbase(ZO + h * 128 + v) + (size_t)(m0 + t) * ZR);
            u32x2 o; o.x = pk2(acc[vt][4 * g] * rms * gv.x * sigmoidf_(bflo(mo.x)), acc[vt][4 * g + 1] * rms * gv.y * sigmoidf_(bfhi(mo.x)));
            o.y = pk2(acc[vt][4 * g + 2] * rms * gv.z * sigmoidf_(bflo(mo.y)), acc[vt][4 * g + 3] * rms * gv.w * sigmoidf_(bfhi(mo.y)));
            *(u32x2*)(FP_HMD + (size_t)(m0 + t) * 1024 + h * 128 + v) = o; }
    asm volatile("s_waitcnt lgkmcnt(0)\n\ts_barrier" ::: "memory");
}
constexpr int AT_SLOT = 24576, AT_VOFF = 8192, AT_NSLOT = 4;
constexpr float AT_THR = 8.f;
__device__ __forceinline__ void glds16(const void* gsrc, unsigned lds_dst) { unsigned keep;
    asm volatile("s_mov_b32 %0, m0\n\ts_mov_b32 m0, %2\n\ts_nop 0\n\tglobal_load_lds_dwordx4 %1, off\n\ts_mov_b32 m0, %0" : "=&s"(keep) : "v"(gsrc), "s"(lds_dst) : "memory"); }
__device__ __forceinline__ float max3f(float a, float b, float c) { float r; asm("v_max3_f32 %0, %1, %2, %3" : "=v"(r) : "v"(a), "v"(b), "v"(c)); return r; }
#define AT_WAIT_BAR(N) asm volatile("s_waitcnt vmcnt(" #N ") lgkmcnt(0)\n\ts_barrier" ::: "memory")
__device__ __forceinline__ void attn_half_unit(const Frame& F, int bh, int qb, int map, bf16_t* Odst) {
    const int tid_ = FTID(F);
    const int b = bh >> 2, h = bh & 3, lane = tid_ & 63, wid = F.wave, r32 = lane & 31, hi = lane >> 5;
    const int rowbase = b * TP, q0 = qb * 256, qrow = q0 + 32 * wid + r32;
    const bf16_t* Zb = FP_Z + (size_t)rowbase * ZR;
    const unsigned lds0 = (unsigned)(uintptr_t)F.lds;
    const bf16_t* ksrc = Zb + zbase(ZDK + h * 128 + map * 64 + wid * 8) + (size_t)lane * ZR;
    const bf16_t* vsrc0 = Zb + zbase(ZDV + h * 128 + ((2 * wid) >> 2) * 32 + (lane & 3) * 8) + (size_t)(((2 * wid) & 3) * 16 + (lane >> 2)) * ZR;
    const bf16_t* vsrc1 = vsrc0 + (size_t)16 * ZR;
    const unsigned kdst = lds0 + wid * 1024, vdst = lds0 + AT_VOFF + 2 * wid * 1024;
#define AT_DMA(t, slot) do { const size_t adv_ = (size_t)(t) * 64 * ZR; const unsigned so_ = (unsigned)(slot) * AT_SLOT; \
        glds16(ksrc + adv_, (unsigned)__builtin_amdgcn_readfirstlane(kdst + so_)); glds16(vsrc0 + adv_, (unsigned)__builtin_amdgcn_readfirstlane(vdst + so_)); \
        glds16(vsrc1 + adv_, (unsigned)__builtin_amdgcn_readfirstlane(vdst + so_ + 1024u)); } while (0)
    bf16x8 qf[4];
    { const bf16_t* qp = Zb + zbase(ZDQ + h * 128 + map * 64 + 8 * hi) + (size_t)qrow * ZR;
#pragma unroll
      for (int st = 0; st < 4; ++st) qf[st] = *(const bf16x8*)(qp + 16 * st); }
    const int NT = 4 * qb + 4;
    AT_DMA(0, 0); AT_DMA(1, 1); AT_DMA(2, 2);
    f32x16 o[4];
#pragma unroll
    for (int vt = 0; vt < 4; ++vt) for (int i = 0; i < 16; ++i) o[vt][i] = 0.f;
    f32x16 negm; for (int i = 0; i < 16; ++i) negm[i] = 0.f;
    float mhat = 0.f, lrun = 0.f;
    const int vh = (lane >> 4) & 1, q4 = (lane & 15) >> 2, p = lane & 3;
    const int vlane = AT_VOFF + (4 * hi + q4) * 64 + (16 * vh + 4 * p) * 2;
    const int klane = hi * 1024 + r32 * 16;
    const int wlast = q0 + 32 * wid + 31, wfirst = q0 + 32 * wid;
#define AT_SCHED() __builtin_amdgcn_sched_barrier(0)
#define AT_KRD(i0, kbase) do { kf[i0] = *(const LAS bf16x8*)((kbase) + ((i0) >> 1) * 2048 + ((i0) & 1) * 512); kf[(i0) + 1] = *(const LAS bf16x8*)((kbase) + (((i0) + 1) >> 1) * 2048 + (((i0) + 1) & 1) * 512); } while (0)
#define AT_VRD(dst, g, vbase) do { _Pragma("unroll") for (int vt = 0; vt < 4; ++vt) dst[vt] = cat4(tr_rd((vbase) + (g) * 1024 + vt * 4096), tr_rd((vbase) + (g) * 1024 + vt * 4096 + 512)); } while (0)
#define AT_PB(g) (((g) >> 1) == 0 ? pack8((f32x4){p0[8 * ((g) & 1)], p0[8 * ((g) & 1) + 1], p0[8 * ((g) & 1) + 2], p0[8 * ((g) & 1) + 3]}, (f32x4){p0[8 * ((g) & 1) + 4], p0[8 * ((g) & 1) + 5], p0[8 * ((g) & 1) + 6], p0[8 * ((g) & 1) + 7]}) \
                                  : pack8((f32x4){p1[8 * ((g) & 1)], p1[8 * ((g) & 1) + 1], p1[8 * ((g) & 1) + 2], p1[8 * ((g) & 1) + 3]}, (f32x4){p1[8 * ((g) & 1) + 4], p1[8 * ((g) & 1) + 5], p1[8 * ((g) & 1) + 6], p1[8 * ((g) & 1) + 7]}))
#define AT_PV(src, g) do { const bf16x8 pb_ = AT_PB(g); _Pragma("unroll") for (int vt = 0; vt < 4; ++vt) o[vt] = MFMA32(src[vt], pb_, o[vt]); } while (0)
    AT_WAIT_BAR(3);
    bf16x8 kf[8];
    { const LAS unsigned char* kb = F.lds + klane; AT_KRD(0, kb); AT_KRD(2, kb); AT_KRD(4, kb); AT_KRD(6, kb); }
    int slot = 0, slot1 = 1, slot3 = 3;
    for (int j = 0; j < NT; ++j) {
        if (j + 3 < NT) AT_DMA(j + 3, slot3);
        if (64 * j <= wlast) {
            const LAS unsigned char* vb = F.lds + slot * AT_SLOT + vlane;
            const LAS unsigned char* kn = F.lds + slot1 * AT_SLOT + klane;
            const bool knext = (j + 1 < NT);
            f32x16 p0 = MFMA32(kf[0], qf[0], negm), p1 = MFMA32(kf[1], qf[0], negm);
#pragma unroll
            for (int st = 1; st < 4; ++st) { p0 = MFMA32(kf[2 * st], qf[st], p0); p1 = MFMA32(kf[2 * st + 1], qf[st], p1); }
            AT_SCHED();
            bf16x8 vfA[4], vfB[4];
            AT_VRD(vfA, 0, vb);
            AT_SCHED();
            if (64 * j + 63 > wfirst) {
#pragma unroll
                for (int i = 0; i < 16; ++i) { const int key = 64 * j + crow(i, hi); if (key > qrow) p0[i] = -INFINITY; if (key + 32 > qrow) p1[i] = -INFINITY; }
            }
            asm volatile("s_nop 15\n\ts_nop 7" : "+v"(p0), "+v"(p1));
            float mx = max3f(p0[0], p1[0], p0[1]), mx2 = max3f(p1[1], p0[2], p1[2]);
#pragma unroll
            for (int i = 3; i < 15; i += 2) { mx = max3f(mx, p0[i], p1[i]); mx2 = max3f(mx2, p0[i + 1], p1[i + 1]); }
            mx = max3f(mx, p0[15], p1[15]); mx = fmaxf(mx, mx2);
            mx = fmaxf(mx, __shfl_xor(mx, 32));
            if (j == 0 || __any(mx > AT_THR)) {
                const float dl = (j == 0) ? mx : fmaxf(mx, 0.f), f = __builtin_amdgcn_exp2f(-dl);
                mhat += dl; lrun *= f;
#pragma unroll
                for (int i = 0; i < 16; ++i) { p0[i] -= dl; p1[i] -= dl; negm[i] = -mhat; }
#pragma unroll
                for (int vt = 0; vt < 4; ++vt) for (int i = 0; i < 16; ++i) o[vt][i] *= f;
            }
            float rsum = 0.f;
#pragma unroll
            for (int i = 0; i < 16; ++i) { p0[i] = __builtin_amdgcn_exp2f(p0[i]); p1[i] = __builtin_amdgcn_exp2f(p1[i]); rsum += p0[i] + p1[i]; }
            lrun += rsum;
            AT_SCHED();
            AT_VRD(vfB, 1, vb); if (knext) AT_KRD(0, kn); AT_SCHED(); AT_PV(vfA, 0); AT_SCHED();
            AT_VRD(vfA, 2, vb); if (knext) AT_KRD(2, kn); AT_SCHED(); AT_PV(vfB, 1); AT_SCHED();
            AT_VRD(vfB, 3, vb); if (knext) AT_KRD(4, kn); AT_SCHED(); AT_PV(vfA, 2); AT_SCHED();
            if (knext) AT_KRD(6, kn); AT_SCHED(); AT_PV(vfB, 3); AT_SCHED();
        }
        if (j + 3 < NT) AT_WAIT_BAR(3); else AT_WAIT_BAR(0);
        slot = slot1; slot1 = (slot1 == AT_NSLOT - 1) ? 0 : slot1 + 1; slot3 = (slot3 == AT_NSLOT - 1) ? 0 : slot3 + 1;
    }
#undef AT_SCHED
#undef AT_KRD
#undef AT_VRD
#undef AT_PB
#undef AT_PV
    lrun += __shfl_xor(lrun, 32);
    const float rl = 1.f / lrun;
    bf16_t* op = Odst + (size_t)(rowbase + qrow) * 512 + h * 128 + 4 * hi;
#pragma unroll
    for (int vt = 0; vt < 4; ++vt)
#pragma unroll
        for (int g = 0; g < 4; ++g) { u32x2 w; w.x = pk2(o[vt][4 * g] * rl, o[vt][4 * g + 1] * rl); w.y = pk2(o[vt][4 * g + 2] * rl, o[vt][4 * g + 3] * rl); *(u32x2*)(op + 32 * vt + 8 * g) = w; }
    AT_WAIT_BAR(0);
#undef AT_DMA
}
__device__ __forceinline__ float lambda_full(const Frame& F, int lane) {
    const float a = wave_sum(FP_lq1[lane] * FP_lk1[lane]), b = wave_sum(FP_lq2[lane] * FP_lk2[lane]);
    return __expf(a) - __expf(b) + LAM_INIT;
}
__device__ __forceinline__ void attn_combine_rows(const Frame& F) {
    const int lane = lane_id(), gw = F.vcu * NWAVES + F.wave, NGW = F.G * NWAVES;
    const float lam = lambda_full(F, lane);
    const f32x4 g0 = *(const f32x4*)(FP_g_diff + 8 * lane), g1 = *(const f32x4*)(FP_g_diff + 8 * lane + 4);
    for (int m = gw; m < MP; m += NGW) {
        f32x4 a0, a1, b0, b1; unpack8(*(const u32x4*)(FP_O1 + (size_t)m * 512 + 8 * lane), a0, a1); unpack8(*(const u32x4*)(FP_O2 + (size_t)m * 512 + 8 * lane), b0, b1);
        const f32x4 x0 = a0 - b0 * lam, x1 = a1 - b1 * lam;
        float ss = (x0.x * x0.x + x0.y * x0.y) + (x0.z * x0.z + x0.w * x0.w) + (x1.x * x1.x + x1.y * x1.y) + (x1.z * x1.z + x1.w * x1.w);
        ss += __shfl_xor(ss, 1); ss += __shfl_xor(ss, 2); ss += __shfl_xor(ss, 4); ss += __shfl_xor(ss, 8);
        const float rms = rsqrtf(ss * (1.f / 128.f) + EPS) * (1.f - LAM_INIT);
        *(bf16x8*)(FP_HMD + (size_t)m * 1024 + 512 + 8 * lane) = pack8(x0 * rms * g0, x1 * rms * g1);
    }
}
constexpr int SB_P = 264;
constexpr int DPART = 1040;
__device__ __forceinline__ void decode_unit(const Frame& F, int u) {
    const int tid_ = FTID(F);
    const int n = u >> 2, blk = u & 3, lane = tid_ & 63, wid = F.wave, h = wid & 3, qt = wid >> 2;
    const int mrow = MP + 4 * n;
    LAS float* Sb = (LAS float*)(F.lds + wid * 8704);
    LAS float* fac = Sb + 8 * SB_P;
    const int* pt = FP_page_table + n * NPAGES + 4 * blk + 2 * qt;
    const int c16 = lane & 15, g = lane >> 4, hh = lane >> 5, l5 = lane & 31, scol = lane >> 3, sseg = lane & 7;
    bf16x8 bq[4];
#pragma unroll
    for (int st = 0; st < 4; ++st) { const bool ok = (c16 < 4 && st < 2) || (c16 >= 4 && c16 < 8 && st >= 2);
        const bf16x8 v = *(const bf16x8*)(FP_Z + zbase(ZDQ + h * 128 + 32 * st + 8 * g) + (size_t)(mrow + (c16 & 3)) * ZR);
        const bf16x8 zz = {0, 0, 0, 0, 0, 0, 0, 0}; bq[st] = ok ? v : zz; }
    const char* vpool = (const char*)FP_cache_v; const char* kpool = (const char*)FP_cache_k;
    const unsigned voff = (((unsigned)pt[hh] * PAGE) * 4u + (unsigned)h) * 512u + 16u * (unsigned)l5;
#define NTL(p) (*(const f32x4*)(p))
#define VLD(row) NTL(vpool + (voff + 2048u * (unsigned)(row)))
    f32x4 va[8], vb[8];
    {
        const unsigned ko0 = (((unsigned)pt[0] * PAGE + (unsigned)c16) * 4u + (unsigned)h) * 512u + 32u * (unsigned)g;
        const unsigned ko1 = (((unsigned)pt[1] * PAGE + (unsigned)c16) * 4u + (unsigned)h) * 512u + 32u * (unsigned)g;
        f32x4 ka[16], kb[16];
#define KLOAD(dst, ti) do { const unsigned ko_ = (((ti) < 8) ? ko0 : ko1) + 32768u * (unsigned)((ti) & 7); \
            _Pragma("unroll") for (int st = 0; st < 4; ++st) { dst[2 * st] = NTL(kpool + (ko_ + 128u * st)); dst[2 * st + 1] = NTL(kpool + (ko_ + 128u * st + 16u)); } } while (0)
#define KTILE(src, ti) do { f32x4 acc_ = {0.f, 0.f, 0.f, 0.f}; \
            _Pragma("unroll") for (int st = 0; st < 4; ++st) acc_ = MFMA16(pack8(src[2 * st], src[2 * st + 1]), bq[st], acc_); \
            if (c16 < 8) *(LAS f32x4*)(Sb + c16 * SB_P + 16 * (ti) + 4 * g) = acc_; } while (0)
        KLOAD(ka, 0); KLOAD((ka + 8), 1); KLOAD(kb, 2); KLOAD((kb + 8), 3);
        for (int ip = 0; ip < 12; ip += 4) {
            KTILE(ka, ip); KTILE((ka + 8), ip + 1); KLOAD(ka, ip + 4); KLOAD((ka + 8), ip + 5);
            KTILE(kb, ip + 2); KTILE((kb + 8), ip + 3); KLOAD(kb, ip + 6); KLOAD((kb + 8), ip + 7);
        }
        KTILE(ka, 12); KTILE((ka + 8), 13);
#pragma unroll
        for (int kk = 0; kk < 8; ++kk) va[kk] = VLD(kk);
        KTILE(kb, 14); KTILE((kb + 8), 15);
#pragma unroll
        for (int kk = 0; kk < 8; ++kk) vb[kk] = VLD(8 + kk);
#undef KLOAD
#undef KTILE
    }
    {
        LAS float* sp = Sb + scol * SB_P + 32 * sseg;
        f32x4 sv[8]; float mx = -INFINITY;
#pragma unroll
        for (int i = 0; i < 8; ++i) { sv[i] = *(const LAS f32x4*)(sp + 4 * i); mx = fmaxf(fmaxf(mx, fmaxf(sv[i].x, sv[i].y)), fmaxf(sv[i].z, sv[i].w)); }
        mx = fmaxf(mx, __shfl_xor(mx, 1)); mx = fmaxf(mx, __shfl_xor(mx, 2)); mx = fmaxf(mx, __shfl_xor(mx, 4));
        float ls = 0.f;
#pragma unroll
        for (int i = 0; i < 8; ++i) { f32x4 pv; pv.x = __builtin_amdgcn_exp2f(sv[i].x - mx); pv.y = __builtin_amdgcn_exp2f(sv[i].y - mx); pv.z = __builtin_amdgcn_exp2f(sv[i].z - mx); pv.w = __builtin_amdgcn_exp2f(sv[i].w - mx);
            ls += (pv.x + pv.y) + (pv.z + pv.w); *(LAS f32x4*)(sp + 4 * i) = pv; }
        ls += __shfl_xor(ls, 1); ls += __shfl_xor(ls, 2); ls += __shfl_xor(ls, 4);
        if (sseg == 0) { fac[scol] = mx; fac[8 + scol] = ls; }
    }
    {
        const LAS float* pbase = Sb + 128 * hh;
        f32x4 acc[8];
#pragma unroll
        for (int c = 0; c < 8; ++c) acc[c] = (f32x4){0.f, 0.f, 0.f, 0.f};
#define VSTEP(buf, t8) do { f32x4 vc_[8]; _Pragma("unroll") for (int kk = 0; kk < 8; ++kk) vc_[kk] = buf[kk]; \
            if ((t8) + 2 < 16) { _Pragma("unroll") for (int kk = 0; kk < 8; ++kk) buf[kk] = VLD(8 * ((t8) + 2) + kk); } \
            _Pragma("unroll") for (int c = 0; c < 8; ++c) { const f32x4 p0_ = *(const LAS f32x4*)(pbase + c * SB_P + 8 * (t8)), p1_ = *(const LAS f32x4*)(pbase + c * SB_P + 8 * (t8) + 4); \
                acc[c] += vc_[0] * p0_.x + vc_[1] * p0_.y + vc_[2] * p0_.z + vc_[3] * p0_.w + vc_[4] * p1_.x + vc_[5] * p1_.y + vc_[6] * p1_.z + vc_[7] * p1_.w; } } while (0)
        for (int t8 = 0; t8 < 16; t8 += 2) { VSTEP(va, t8); VSTEP(vb, t8 + 1); }
#undef VSTEP
        float* po = FP_DPART + ((size_t)(n * 4 + h) * 8 + (2 * blk + qt)) * DPART;
#pragma unroll
        for (int c = 0; c < 8; ++c) { acc[c].x += __shfl_xor(acc[c].x, 32); acc[c].y += __shfl_xor(acc[c].y, 32); acc[c].z += __shfl_xor(acc[c].z, 32); acc[c].w += __shfl_xor(acc[c].w, 32);
            if (hh == 0) *(f32x4*)(po + c * 128 + 4 * l5) = acc[c]; }
        if (lane < 16) po[1024 + lane] = fac[lane];
    }
#undef VLD
#undef NTL
}
__device__ __forceinline__ void decode_merge(const Frame& F, int u, float lam) {
    const int n = u >> 2, h = u & 3, lane = lane_id(), wid = F.wave, tid = wid * 64 + lane;
    const int mrow = MP + 4 * n;
    LAS float* Sn = (LAS float*)F.lds;
    LAS float* wgt = Sn + 32;
    LAS float* en = wgt + 64;
    LAS float* rlv = en + 32;
    LAS float* red = rlv + 8;
    const float* pp = FP_DPART + (size_t)u * 8 * DPART;
    if (wid == 0) {
        const int c16 = lane & 15, g = lane >> 4;
        f32x4 acc = {0.f, 0.f, 0.f, 0.f};
#pragma unroll
        for (int st = 0; st < 4; ++st) { const bool ok = (c16 < 4 && st < 2) || (c16 >= 4 && c16 < 8 && st >= 2);
            const bf16x8 zz = {0, 0, 0, 0, 0, 0, 0, 0};
            const bf16x8 qv = *(const bf16x8*)(FP_Z + zbase(ZDQ + h * 128 + 32 * st + 8 * g) + (size_t)(mrow + (c16 & 3)) * ZR);
            const bf16x8 kv = *(const bf16x8*)(FP_Z + zbase(ZDK + h * 128 + 32 * st + 8 * g) + (size_t)(mrow + (c16 & 3)) * ZR);
            const bf16x8 bqv = ok ? qv : zz, akv = (c16 < 4) ? kv : zz; acc = MFMA16(akv, bqv, acc); }
        if (g == 0 && c16 < 8) { const int t = c16 & 3; f32x4 m;
            m.x = acc.x; m.y = (1 <= t) ? acc.y : -INFINITY; m.z = (2 <= t) ? acc.z : -INFINITY; m.w = (3 <= t) ? acc.w : -INFINITY;
            *(LAS f32x4*)(Sn + 4 * c16) = m; }
    }
    WG_BAR();
    if (tid < 8) { const int c = tid; const f32x4 sn = *(const LAS f32x4*)(Sn + 4 * c);
        float mi[8]; float M = fmaxf(fmaxf(sn.x, sn.y), fmaxf(sn.z, sn.w));
#pragma unroll
        for (int i = 0; i < 8; ++i) { mi[i] = pp[i * DPART + 1024 + c]; M = fmaxf(M, mi[i]); }
        const f32x4 e = {__builtin_amdgcn_exp2f(sn.x - M), __builtin_amdgcn_exp2f(sn.y - M), __builtin_amdgcn_exp2f(sn.z - M), __builtin_amdgcn_exp2f(sn.w - M)};
        float L = (e.x + e.y) + (e.z + e.w);
#pragma unroll
        for (int i = 0; i < 8; ++i) { const float w = __builtin_amdgcn_exp2f(mi[i] - M); wgt[8 * i + c] = w; L += w * pp[i * DPART + 1032 + c]; }
        *(LAS f32x4*)(en + 4 * c) = e; rlv[c] = 1.f / L; }
    WG_BAR();
    { const int t = tid >> 7, v = tid & 127; float o1 = 0.f, o2 = 0.f;
#pragma unroll
      for (int i = 0; i < 8; ++i) { o1 += wgt[8 * i + t] * pp[i * DPART + t * 128 + v]; o2 += wgt[8 * i + 4 + t] * pp[i * DPART + (4 + t) * 128 + v]; }
#pragma unroll
      for (int sx = 0; sx < 4; ++sx) { const float vn = bf2f(FP_Z[zbase(ZDV + h * 128 + v) + (size_t)(mrow + sx) * ZR]); o1 += en[4 * t + sx] * vn; o2 += en[4 * (4 + t) + sx] * vn; }
      const float ov = o1 * rlv[t] - lam * o2 * rlv[4 + t];
      const float ssw = wave_sum(ov * ov); if (lane == 0) red[wid] = ssw;
      WG_BAR();
      const float rms = rsqrtf((red[2 * t] + red[2 * t + 1]) * (1.f / 128.f) + EPS) * (1.f - LAM_INIT);
      FP_HMD[(size_t)(mrow + t) * 1024 + 512 + h * 128 + v] = f2bf(ov * rms * FP_g_diff[h * 128 + v]); }
    WG_BAR();
}
__device__ __forceinline__ void rows_post_mix(const Frame& F) {
    const int lane = lane_id(), gw = F.vcu * NWAVES + F.wave, NGW = F.G * NWAVES;
    const int r_lo = (int)(((long)gw * MT) / NGW), r_hi = (int)(((long)(gw + 1) * MT) / NGW);
    f32x4 gpm[4], gpf[4], g1[4], sh2[4], sc2[4], yn[4], xn[4];
#pragma unroll
    for (int j = 0; j < 4; ++j) { gpm[j] = *(const f32x4*)(FP_g_post_mix + 4 * lane + 256 * j); gpf[j] = *(const f32x4*)(FP_g_pre_ffn + 4 * lane + 256 * j); g1[j] = gpm[j]; sh2[j] = gpm[j]; sc2[j] = gpm[j]; yn[j] = gpm[j]; xn[j] = gpm[j]; }
    int ccur = -1;
    if (r_lo < r_hi) { const float* xr = xrow_of(F, r_lo); const bf16_t* yr = FP_Y + (size_t)r_lo * DM;
#pragma unroll
        for (int j = 0; j < 4; ++j) { { const u32x2 yy = *(const u32x2*)(yr + 4 * lane + 256 * j); yn[j] = (f32x4){bflo(yy.x), bfhi(yy.x), bflo(yy.y), bfhi(yy.y)}; } xn[j] = *(const f32x4*)(xr + 4 * lane + 256 * j); } }
    for (int m = r_lo; m < r_hi; ++m) {
        f32x4 y[4], x1[4]; float ss = 0.f;
#pragma unroll
        for (int j = 0; j < 4; ++j) { y[j] = yn[j]; x1[j] = xn[j]; }
        if (m + 1 < r_hi) { const float* xr = xrow_of(F, m + 1); const bf16_t* yr = FP_Y + (size_t)(m + 1) * DM;
#pragma unroll
            for (int j = 0; j < 4; ++j) { { const u32x2 yy = *(const u32x2*)(yr + 4 * lane + 256 * j); yn[j] = (f32x4){bflo(yy.x), bfhi(yy.x), bflo(yy.y), bfhi(yy.y)}; } xn[j] = *(const f32x4*)(xr + 4 * lane + 256 * j); } }
        const int cr = crow_of(m);
        if (cr != ccur) { ccur = cr; const float* ada = FP_ADA + (size_t)cr * 6144;
#pragma unroll
            for (int j = 0; j < 4; ++j) { const int c = 4 * lane + 256 * j; g1[j] = *(const f32x4*)(ada + 2048 + c) * gpm[j]; sh2[j] = *(const f32x4*)(ada + 3072 + c); sc2[j] = (*(const f32x4*)(ada + 4096 + c) + 1.f) * gpf[j]; } }
#pragma unroll
        for (int j = 0; j < 4; ++j) ss += (y[j].x * y[j].x + y[j].y * y[j].y) + (y[j].z * y[j].z + y[j].w * y[j].w);
        const float rs = rsqrtf(wave_sum(ss) * (1.f / DM) + EPS); float s1 = 0.f;
#pragma unroll
        for (int j = 0; j < 4; ++j) { const int c = 4 * lane + 256 * j;
            x1[j] = x1[j] + g1[j] * (y[j] * rs); { u32x2 xo; xo.x = pk2(x1[j].x, x1[j].y); xo.y = pk2(x1[j].z, x1[j].w); *(u32x2*)(FP_X1 + (size_t)m * DM + c) = xo; }
            s1 += (x1[j].x * x1[j].x + x1[j].y * x1[j].y) + (x1[j].z * x1[j].z + x1[j].w * x1[j].w); }
        const float r1 = rsqrtf(wave_sum(s1) * (1.f / DM) + EPS);
#pragma unroll
        for (int j = 0; j < 4; ++j) { const int c = 4 * lane + 256 * j;
            const f32x4 hv = (x1[j] * r1) * sc2[j] + sh2[j]; u32x2 o; o.x = pk2(hv.x, hv.y); o.y = pk2(hv.z, hv.w); *(u32x2*)(FP_H1 + (size_t)m * DM + c) = o; }
    }
}
__device__ __forceinline__ void rows_final(const Frame& F) {
    const int lane = lane_id(), gw = F.vcu * NWAVES + F.wave, NGW = F.G * NWAVES;
    const int r_lo = (int)(((long)gw * MT) / NGW), r_hi = (int)(((long)(gw + 1) * MT) / NGW);
    f32x4 gpf[4], g2[4], yn[4], xn[4];
#pragma unroll
    for (int j = 0; j < 4; ++j) { gpf[j] = *(const f32x4*)(FP_g_post_ffn + 4 * lane + 256 * j); g2[j] = gpf[j]; yn[j] = gpf[j]; xn[j] = gpf[j]; }
    int ccur = -1;
    if (r_lo < r_hi) { const bf16_t* xr = FP_X1 + (size_t)r_lo * DM; const bf16_t* yr = FP_Y + (size_t)r_lo * DM;
#pragma unroll
        for (int j = 0; j < 4; ++j) { { const u32x2 yy = *(const u32x2*)(yr + 4 * lane + 256 * j); yn[j] = (f32x4){bflo(yy.x), bfhi(yy.x), bflo(yy.y), bfhi(yy.y)}; } { const u32x2 xx = *(const u32x2*)(xr + 4 * lane + 256 * j); xn[j] = (f32x4){bflo(xx.x), bfhi(xx.x), bflo(xx.y), bfhi(xx.y)}; } } }
    for (int m = r_lo; m < r_hi; ++m) {
        f32x4 y[4], x1[4]; float ss = 0.f;
#pragma unroll
        for (int j = 0; j < 4; ++j) { y[j] = yn[j]; x1[j] = xn[j]; }
        if (m + 1 < r_hi) { const bf16_t* xr = FP_X1 + (size_t)(m + 1) * DM; const bf16_t* yr = FP_Y + (size_t)(m + 1) * DM;
#pragma unroll
            for (int j = 0; j < 4; ++j) { { const u32x2 yy = *(const u32x2*)(yr + 4 * lane + 256 * j); yn[j] = (f32x4){bflo(yy.x), bfhi(yy.x), bflo(yy.y), bfhi(yy.y)}; } { const u32x2 xx = *(const u32x2*)(xr + 4 * lane + 256 * j); xn[j] = (f32x4){bflo(xx.x), bfhi(xx.x), bflo(xx.y), bfhi(xx.y)}; } } }
        const int cr = crow_of(m);
        if (cr != ccur) { ccur = cr; const float* ada = FP_ADA + (size_t)cr * 6144;
#pragma unroll
            for (int j = 0; j < 4; ++j) g2[j] = *(const f32x4*)(ada + 5120 + 4 * lane + 256 * j) * gpf[j]; }
#pragma unroll
        for (int j = 0; j < 4; ++j) ss += (y[j].x * y[j].x + y[j].y * y[j].y) + (y[j].z * y[j].z + y[j].w * y[j].w);
        const float rs = rsqrtf(wave_sum(ss) * (1.f / DM) + EPS);
#pragma unroll
        for (int j = 0; j < 4; ++j) *(f32x4*)(FP_out + OFF_Y + (size_t)m * DM + 4 * lane + 256 * j) = x1[j] + g2[j] * (y[j] * rs);
    }
}
__device__ __forceinline__ void attention_phase(const Frame& F, volatile LAS unsigned* MISC) {
    unsigned* ctl = (unsigned*)(F.a->ws + WS_CTL) + CW_SCHED;
    const int xq = (F.vcu * 8) / F.G;
    for (;;) {
        if (FTID(F) == 0) {
            int kind = -1; unsigned idx = 0u;
            unsigned* QD = ctl + 64 * 8; unsigned* NS = ctl + 64 * (9 + xq);
            if (xb_ld(QD) < 512u) { const unsigned sn = xb_add(NS, 1u);
                if (sn < (unsigned)DEC_LIM8) { const unsigned d = xb_add(QD, 1u); if (d < 512u) { kind = 1; idx = d; } }
                if (kind < 0) (void)__hip_atomic_fetch_sub(NS, 1u, __ATOMIC_RELAXED, __HIP_MEMORY_SCOPE_AGENT); }
            for (int k = 0; k < 8 && kind < 0; ++k) { const int x = (xq + k) & 7; unsigned* QP = ctl + 64 * x;
                if (xb_ld(QP) < 64u) { const unsigned p = xb_add(QP, 1u); if (p < 64u) { kind = 0; idx = (unsigned)x * 64u + p; } } }
            if (kind < 0) { const unsigned d = xb_add(QD, 1u); if (d < 512u) { kind = 2; idx = d; } }
            MISC[0] = (unsigned)kind; MISC[1] = idx;
        }
        WG_BAR();
        const int kind = (int)MISC[0]; const int idx = (int)MISC[1];
        WG_BAR();
        if (kind < 0) break;
        if (kind == 0) { const int bh = idx >> 6, j = idx & 63, qb = 31 - (j >> 1), map = j & 1; attn_half_unit(F, bh, qb, map, map ? FP_O2 : FP_O1); }
        else { decode_unit(F, idx); asm volatile("s_waitcnt vmcnt(0) lgkmcnt(0)\n\ts_barrier" ::: "memory");
               if (kind == 1 && FTID(F) == 0) (void)__hip_atomic_fetch_sub(ctl + 64 * (9 + xq), 1u, __ATOMIC_RELAXED, __HIP_MEMORY_SCOPE_AGENT); }
    }
}

constexpr int NPHASE = 15;
#ifndef DUPMASK
#define DUPMASK 0
#endif
#ifndef PROBE_MASK
#define PROBE_MASK 0
#endif
__global__ void __launch_bounds__(NTHR, 2) fwd_kernel(Args args) {
    extern __shared__ __attribute__((aligned(16))) unsigned char lds_raw[];
    Frame F;
    F.lds = (LAS unsigned char*)lds_raw;
    F.wave = __builtin_amdgcn_readfirstlane((int)threadIdx.x >> 6);
    F.G = gridDim.x; { const int bx = blockIdx.x; F.vcu = (F.G % 8 == 0) ? (bx % 8) * (F.G / 8) + bx / 8 : bx; }
    F.a = &args; unsigned char* ws = args.ws;
    volatile LAS unsigned* MISC = (volatile LAS unsigned*)(F.lds + MISC_OFF);
    for (int u = FTID(F); u < (LDS_BYTES - RING_BYTES) / 4; u += NTHR) ((LAS unsigned*)(F.lds + RING_BYTES))[u] = 0u;
    __syncthreads();
    const int lo = args.ph_lo, hi = args.ph_hi;
    const bool multi = (hi - lo) > 1;
    XcdBarrier bar; bar.bar = (unsigned*)(ws + WS_CTL) + CW_BAR; bar.x = 0; bar.st = nullptr; bar.wave = F.wave;
    if (multi) bar = xcd_barrier_post((unsigned*)(ws + WS_CTL) + CW_BAR, MISC + 8, F.wave);
#define IN(k) (lo <= (k) && (k) < hi)
    unsigned long long pr_t0 = 0ull, pr_acc = 0ull;
#define PST(k) do { if ((PROBE_MASK >> (k)) & 1) pr_t0 = __builtin_amdgcn_s_memrealtime(); } while (0)
#define PEN(k) do { if ((PROBE_MASK >> (k)) & 1) pr_acc += __builtin_amdgcn_s_memrealtime() - pr_t0; } while (0)
#define SEAM(k) do { if (IN(k) && IN((k) + 1)) xcd_barrier(bar); } while (0)

#define DUP(k, ...) do { { __VA_ARGS__ } if ((DUPMASK >> (k)) & 1) { __VA_ARGS__ } } while (0)
    PST(0);
    if (IN(0)) { PST(15); p0_ada(F); PEN(15); p0_transposes(F); } SEAM(0); PEN(0);
    PST(1);
    if (IN(1)) { DUP(1,  p1_norm_gates(F); WG_BAR(); ); } SEAM(1); PEN(1);
    PST(2);
    if (IN(2)) { DUP(2,  pg8::Gemm g{FP_H1, FP_WinT, MT, ZN, DM, DM}; pg8::StaticOrder S; S.init(MT, ZN, F.G, (int)blockIdx.x); EpiZ E{FP_Z, FP_out, FP_IG, FP_LF, FP_b_if}; pg8::gemm_phase(F.lds, g, S, E, F.wave); ); } SEAM(2); PEN(2);
    PST(3);
    if (IN(3)) { DUP(3,  for (int u = F.vcu; u < 8 * NCH; u += F.G) mlstm_A_unit(F, u);
                 for (int u = F.vcu; u < 512; u += F.G) smlstm_unit(F, u); ); } SEAM(3); PEN(3);
    PST(4);
    PEN(4);
    PST(5);
    if (IN(5)) { for (int it = F.vcu; it < 256; it += F.G) mlstm_scan_item(F, it);
                 attention_phase(F, MISC); } SEAM(5); PEN(5);
    PST(6);
    if (IN(6)) { DUP(6,  for (int grp = F.vcu; grp < 256; grp += F.G) mlstm_C_group(F, grp);
                 attn_combine_rows(F);
                 { const float lam = lambda_full(F, lane_id()); for (int u = F.vcu; u < 512; u += F.G) decode_merge(F, u, lam); } ); } SEAM(6); PEN(6);
    PST(7);
    if (IN(7)) { DUP(7,  pg8::Gemm g{FP_HMD, FP_WpT, MP, DM, 512, DM}; pg8::StaticOrder S; S.init(MP, DM, F.G, (int)blockIdx.x); EpiPMD E{FP_Z, FP_MG}; pg8::gemm_phase<EpiPMD, true>(F.lds, g, S, E, F.wave);
                 skinny_gemm<true>(F, FP_HMD + (size_t)MP * DM, FP_WpT, DM, E); ); } SEAM(7); PEN(7);
    PST(8);
    PEN(8);
    PST(9);
    if (IN(9)) { DUP(9,  pg8::Gemm g{FP_MG, FP_WoutT, MP, DM, DM, DM}; pg8::StaticOrder S; S.init(MP, DM, F.G, (int)blockIdx.x); EpiF32 E{FP_Y}; pg8::gemm_phase(F.lds, g, S, E, F.wave);
                 skinny_gemm<false>(F, FP_MG + (size_t)MP * DM, FP_WoutT, DM, E); ); } SEAM(9); PEN(9);
    PST(10);
    if (IN(10)) { DUP(10,  rows_post_mix(F); ); } SEAM(10); PEN(10);
    PST(11);
    if (IN(11)) { DUP(11,  pg8::Gemm g{FP_H1, FP_WupT, MT, 2 * DFF, DM, DM}; pg8::StaticOrder S; S.init(MT, 2 * DFF, F.G, (int)blockIdx.x);
                  EpiUpG E{FP_GB, FP_out, FP_conv_w, FP_conv_b, FP_state_conv, FP_AH, FP_AF, FP_BF}; pg8::gemm_phase(F.lds, g, S, E, F.wave); ); } SEAM(11); PEN(11);
    PST(12);
    PEN(12);
    PST(13);
    if (IN(13)) { DUP(13,  pg8::Gemm g{FP_GB, FP_WdownT, MP, DM, DFF, DFF}; pg8::StaticOrder S; S.init(MP, DM, F.G, (int)blockIdx.x); EpiF32 E{FP_Y};
                  { pg8::Unit u0; for (int i = 0; S.next(i, u0); ++i) geglu_fixup(F, u0.pm); }
                  pg8::gemm_phase(F.lds, g, S, E, F.wave);
                  skinny_gemm<false>(F, FP_GB + (size_t)MP * DFF, FP_WdownT, DFF, E); ); } SEAM(13); PEN(13);
    PST(14);
    if (IN(14)) { rows_final(F); } PEN(14);
#undef DUP
    if (PROBE_MASK != 0 && blockIdx.x == 0 && FTID(F) == 0) { const unsigned long long t0 = __builtin_amdgcn_s_memrealtime(); while (__builtin_amdgcn_s_memrealtime() - t0 < pr_acc) __builtin_amdgcn_s_sleep(8); }
#undef IN
#undef SEAM
}

#ifndef MK_ONE_LAUNCH
#define MK_ONE_LAUNCH 1
#endif
extern "C" void kernel_launch(void* const* d_in, const int* in_sizes, int n_in, void* d_out, int out_size, void* d_ws, size_t ws_size, hipStream_t stream) {
    static int grid = 0;
    if (grid == 0) {
        if (n_in != 32 || out_size != (int)OUT_TOTAL || ws_size < WS_END) { fprintf(stderr, "kernel_launch: unexpected sizes n_in %d out %d ws %zu\n", n_in, out_size, ws_size); grid = -1; return; }
        int dev = 0, cus = 0, per_cu = 0;
        if (hipGetDevice(&dev) != hipSuccess || hipDeviceGetAttribute(&cus, hipDeviceAttributeMultiprocessorCount, dev) != hipSuccess) { grid = -1; return; }
        if (hipFuncSetAttribute((const void*)fwd_kernel, hipFuncAttributeMaxDynamicSharedMemorySize, LDS_BYTES) != hipSuccess) { fprintf(stderr, "kernel_launch: hipFuncSetAttribute failed\n"); grid = -1; return; }
        if (hipOccupancyMaxActiveBlocksPerMultiprocessor(&per_cu, (const void*)fwd_kernel, NTHR, LDS_BYTES) != hipSuccess || per_cu < 1) fprintf(stderr, "kernel_launch: occupancy query reports %d\n", per_cu);
        (void)hipGetLastError();
        grid = cus;
    }
    if (grid < 0) return;
    if (hipMemsetAsync((char*)d_ws + WS_CTL, 0, CTL_ZERO_BYTES, stream) != hipSuccess) return;
    Args a{};
    for (int i = 0; i < 32; ++i) a.in[i] = d_in[i];
    a.out = (float*)d_out; a.ws = (unsigned char*)d_ws;
#if MK_ONE_LAUNCH
    a.ph_lo = 0; a.ph_hi = NPHASE;
    hipLaunchKernelGGL(fwd_kernel, dim3(grid), dim3(NTHR), LDS_BYTES, stream, a);
#else
    for (int p = 0; p < NPHASE; ++p) { a.ph_lo = p; a.ph_hi = p + 1; hipLaunchKernelGGL(fwd_kernel, dim3(grid), dim3(NTHR), LDS_BYTES, stream, a); }
#endif
}
```

```cpp
#include <hip/hip_runtime.h>
#include <cstdio>
#include <cstdint>

#define LAS __attribute__((address_space(3)))
#define GAS __attribute__((address_space(1)))
typedef unsigned short bf16_t;
typedef short bf16x8 __attribute__((ext_vector_type(8)));
typedef short s16x4 __attribute__((ext_vector_type(4)));
typedef short v4i16_t __attribute__((ext_vector_type(4)));
typedef float f32x2 __attribute__((ext_vector_type(2)));
typedef float f32x4 __attribute__((ext_vector_type(4)));
typedef float f32x16 __attribute__((ext_vector_type(16)));
typedef unsigned u32x2 __attribute__((ext_vector_type(2)));
typedef unsigned u32x4 __attribute__((ext_vector_type(4)));
typedef __bf16 bf16x2_t __attribute__((ext_vector_type(2)));
typedef GAS unsigned gu32;

constexpr int DM = 1024, TP = 8192, MP = 16384, MS = 512, MT = MP + MS;
constexpr int NSEQ = 128, TS = 4, NPAGES = 16, PAGE = 128, PAST = 2048;
constexpr int DIN = 5640, ZP = 5632, ZN = 5888, DFF = 2816;
constexpr int ZQ = 0, ZK = 512, ZV = 1024, ZO = 1536, ZDQ = 2048, ZDK = 2560, ZDV = 3072, ZGM = 3584, ZGD = 4608;
__host__ __device__ constexpr size_t zbase(int col) { return (size_t)(col >> 8) * MT * 256 + (size_t)(col & 255); }
constexpr int ZR = 256;
constexpr float EPS = 1e-6f, LAM_INIT = 0.2f, LOG2E = 1.4426950408889634f;
constexpr float QSCALE = 0.125f * LOG2E;
constexpr float KSCALE = 0.08838834764831845f;
constexpr size_t OFF_Y = 0, OFF_KP = 17301504, OFF_VP = 25690112, OFF_CP = 34078720, OFF_NP = 34209792, OFF_MP = 34210816, OFF_CVP = 34210824,
                 OFF_KS = 34222088, OFF_VS = 34484232, OFF_CS = 34746376, OFF_NS = 43134984, OFF_MS = 43200520, OFF_CVS = 43201032, OUT_TOTAL = 43921928;
constexpr size_t MiB = 1u << 20;
constexpr size_t WS_CTL = 0, CTL_ZERO_BYTES = 65536;
constexpr size_t WS_WIN = 639 * MiB  , WS_WUP = 12 * MiB, WS_WDOWN = 23 * MiB, WS_WOUT = 29 * MiB, WS_WPM = 31 * MiB, WS_WPD = 32 * MiB;
constexpr size_t WS_ADA = 33 * MiB, WS_IG = 37 * MiB, WS_LF = 37 * MiB + 512 * 1024, WS_ST = 38 * MiB, WS_NU = 38 * MiB + 65536, WS_NPREV = 39 * MiB, WS_MPREV = 39 * MiB + 768 * 1024;
constexpr size_t WS_H1 = 40 * MiB, WS_Z = 73 * MiB, WS_U = 255 * MiB, WS_CPREV = 319 * MiB, WS_HM = 351 * MiB, WS_HD = 368 * MiB, WS_O1 = 385 * MiB, WS_O2 = 417 * MiB;
constexpr size_t WS_MG = 449 * MiB, WS_Y = 482 * MiB, WS_UA = 548 * MiB, WS_UB = 639 * MiB, WS_G = 730 * MiB, WS_DPART = 821 * MiB, WS_END = 838 * MiB;
constexpr int CW_BAR = 4096, CW_SCHED = 8192;
#ifndef DEC_LIM8
#define DEC_LIM8 10
#endif
constexpr int RING_BYTES = 131072, MISC_OFF = RING_BYTES + 320, LDS_BYTES = 147456;
constexpr int NWAVES = 8, NTHR = 512;

__device__ __forceinline__ unsigned pk2(float lo, float hi) { f32x2 v = {lo, hi}; bf16x2_t b = __builtin_convertvector(v, bf16x2_t); return __builtin_bit_cast(unsigned, b); }
__device__ __forceinline__ bf16_t f2bf(float x) { return (bf16_t)(pk2(x, 0.f) & 0xffffu); }
__device__ __forceinline__ float bflo(unsigned u) { return __uint_as_float(u << 16); }
__device__ __forceinline__ float bfhi(unsigned u) { return __uint_as_float(u & 0xffff0000u); }
__device__ __forceinline__ float bf2f(bf16_t u) { return __uint_as_float(((unsigned)u) << 16); }
__device__ __forceinline__ bf16x8 pack8(f32x4 a, f32x4 b) { u32x4 w; w.x = pk2(a.x, a.y); w.y = pk2(a.z, a.w); w.z = pk2(b.x, b.y); w.w = pk2(b.z, b.w); return __builtin_bit_cast(bf16x8, w); }
__device__ __forceinline__ void unpack8(u32x4 w, f32x4& a, f32x4& b) { a.x = bflo(w.x); a.y = bfhi(w.x); a.z = bflo(w.y); a.w = bfhi(w.y); b.x = bflo(w.z); b.y = bfhi(w.z); b.z = bflo(w.w); b.w = bfhi(w.w); }
__device__ __forceinline__ float wave_sum(float v) {
#pragma unroll
    for (int o = 1; o < 64; o <<= 1) v += __shfl_xor(v, o);
    return v;
}
__device__ __forceinline__ float wave_max(float v) {
#pragma unroll
    for (int o = 1; o < 64; o <<= 1) v = fmaxf(v, __shfl_xor(v, o));
    return v;
}
__device__ __forceinline__ float wave_scan_sum(float v, int lane) {
#pragma unroll
    for (int o = 1; o < 64; o <<= 1) { const float t = __shfl_up(v, o); if (lane >= o) v += t; }
    return v;
}
__device__ __forceinline__ float wave_scan_max(float v, int lane) {
#pragma unroll
    for (int o = 1; o < 64; o <<= 1) { const float t = __shfl_up(v, o); if (lane >= o) v = fmaxf(v, t); }
    return v;
}
__device__ __forceinline__ float sigmoidf_(float x) { return __builtin_amdgcn_rcpf(1.f + __builtin_amdgcn_exp2f(-x * LOG2E)); }
__device__ __forceinline__ float log_sigmoid(float x) { return fminf(x, 0.f) - __logf(1.f + __expf(-fabsf(x))); }
__device__ __forceinline__ int crow(int reg, int h) { return (reg & 3) + 8 * (reg >> 2) + 4 * h; }
#define MFMA32(a, b, c) __builtin_amdgcn_mfma_f32_32x32x16_bf16((a), (b), (c), 0, 0, 0)
#define MFMA16(a, b, c) __builtin_amdgcn_mfma_f32_16x16x32_bf16((a), (b), (c), 0, 0, 0)
__device__ __forceinline__ s16x4 tr_rd(const LAS unsigned char* p) { return __builtin_bit_cast(s16x4, __builtin_amdgcn_ds_read_tr16_b64_v4i16((LAS v4i16_t*)p)); }
__device__ __forceinline__ bf16x8 cat4(s16x4 lo, s16x4 hi) { return (bf16x8){lo[0], lo[1], lo[2], lo[3], hi[0], hi[1], hi[2], hi[3]}; }
#define WG_BAR() __syncthreads()
__device__ __forceinline__ int lane_id() { int l; asm volatile("v_mbcnt_lo_u32_b32 %0, -1, 0\n\tv_mbcnt_hi_u32_b32 %0, -1, %0" : "=v"(l)); return l; }
#define FTID(F) ((F).wave * 64 + lane_id())

namespace pg8 {
constexpr int BM = 256, BK = 64, HALF = 128, HTB = HALF * BK * 2, STAGE_BYTES = 8 * HTB, NXCD = 8, WGM = 8;
__host__ __device__ __forceinline__ int lds_byte(int r, int c) { const int st = (r >> 4) * 2 + (c >> 5), rr = r & 15, cc = c & 31, ob = rr * 64 + cc * 2; return st * 1024 + (ob ^ (((ob >> 9) & 1) << 5)); }
__host__ __device__ __forceinline__ void stage_rc(int b, int& R, int& C) { const int st = b / 1024, sb = b % 1024, swz = sb ^ (((sb >> 9) & 1) << 5); R = (st >> 1) * 16 + swz / 64; C = (st & 1) * 32 + (swz % 64) / 2; }
__host__ __device__ __forceinline__ int perm32(int rho) { const int n = rho >> 4, i = rho & 15; return 8 * (i >> 2) + 4 * n + (i & 3); }
struct Unit { int pm, pn, half; };
struct Gemm { const bf16_t* A; const bf16_t* Bt; int M, N, K, ld; };
struct StaticOrder {
    int nM, nN, nwg, G, c, rev;
    __host__ __device__ __forceinline__ void init(int M, int N, int G_, int c_, int rev_ = 0) { nM = M / BM; nN = N / BM; nwg = nM * nN; G = G_; c = c_; rev = rev_; }
    __host__ __device__ __forceinline__ bool next(int i, Unit& u) const {
        const int cnt = c < nwg ? (nwg - c + G - 1) / G : 0; if (i >= cnt) return false;
        const long L = (long)(rev ? cnt - 1 - i : i) * G + c;
        int wgid = (int)L; { const int q = nwg / NXCD, r = nwg % NXCD, xcd = wgid % NXCD, off = wgid / NXCD; wgid = (xcd < r ? xcd * (q + 1) : r * (q + 1) + (xcd - r) * q) + off; }
        const int nig = WGM * nN, gid = wgid / nig, fm = gid * WGM, gsz = (nM - fm) < WGM ? (nM - fm) : WGM;
        u.pm = fm + ((wgid % nig) % gsz); u.pn = (wgid % nig) / gsz; u.half = 0; return true;
    }
};
template <class Epi, bool SPLIT2 = false>
__device__ __forceinline__ void gemm_phase(LAS unsigned char* lds, const Gemm g, const StaticOrder& S, const Epi& E, int wave) {
    const int wid = wave, lane = lane_id(), tid = wid * 64 + lane, wr = wid >> 2, wc = wid & 3, fr = lane & 15, fq = lane >> 4;
    const int K = g.K, nt = K / BK, LD = g.ld;
    unsigned voffA[2], voffB[2];
#pragma unroll
    for (int i = 0; i < 2; ++i) { int R, C; stage_rc(tid * 16 + i * 8192, R, C); const int Rb = (R & ~31) + perm32(R & 31);
        voffA[i] = (unsigned)(R * LD + C) * 2u; voffB[i] = (unsigned)(Rb * LD + C) * 2u; }
    const size_t kstep = (size_t)(BK * 2);
    const size_t hstep = (size_t)HALF * LD * 2;
    const size_t tstep = 2 * hstep;
    const unsigned ldsw = (unsigned)wid * 1024u;
    const int aoff = lds_byte(wr * 64 + fr, fq * 8), boff = lds_byte(wc * 32 + fr, fq * 8);
#define PG8_SA(b, h) (((b) * 2 + (h)) * HTB)
#define PG8_SB(b, h) ((4 + (b) * 2 + (h)) * HTB)
#define PG8_STAGE(bufoff, gbase, voff) do { _Pragma("unroll") for (int _i = 0; _i < 2; ++_i) \
        __builtin_amdgcn_global_load_lds((const unsigned*)((const char*)(gbase) + (voff)[_i]), (LAS unsigned*)(lds + (bufoff) + ldsw + _i * 8192), 16, 0, 0); } while (0)
#define PG8_LDA(dst, b, h) do { _Pragma("unroll") for (int m = 0; m < 4; ++m) _Pragma("unroll") for (int k = 0; k < 2; ++k) dst[m][k] = *(const LAS bf16x8*)(lds + PG8_SA(b, h) + aoff + m * 2048 + k * 1024); } while (0)
#define PG8_LDB(dst, b, h) do { _Pragma("unroll") for (int n = 0; n < 2; ++n) _Pragma("unroll") for (int k = 0; k < 2; ++k) dst[n][k] = *(const LAS bf16x8*)(lds + PG8_SB(b, h) + boff + n * 2048 + k * 1024); } while (0)
#define PG8_MMA(ai, bj, At, Bt) do { __builtin_amdgcn_s_setprio(1); _Pragma("unroll") for (int m = 0; m < 4; ++m) _Pragma("unroll") for (int n = 0; n < 2; ++n) _Pragma("unroll") for (int k = 0; k < 2; ++k) \
        acc[ai][bj][m][n] = __builtin_amdgcn_mfma_f32_16x16x32_bf16(Bt[n][k], At[m][k], acc[ai][bj][m][n], 0, 0, 0); __builtin_amdgcn_s_setprio(0); } while (0)
#define PG8_WAIT_V(n) asm volatile("s_waitcnt vmcnt(" #n ")" ::: "memory")
#define PG8_WAIT_L(n) asm volatile("s_waitcnt lgkmcnt(" #n ")" ::: "memory")
#define PG8_BAR __builtin_amdgcn_s_barrier()
#define PG8_SCHED __builtin_amdgcn_sched_barrier(0)
#define PG8_NEXT(i, u) (SPLIT2 ? (S.next((i) >> 1, u) ? ((u).half = (i) & 1, true) : false) : S.next((i), u))
#define PG8_UA(u) ((const char*)g.A + (size_t)(u).pm * tstep + (size_t)(u).half * K * 2)
#define PG8_UB(u) ((const char*)g.Bt + (size_t)(u).pn * tstep + (size_t)(u).half * K * 2)
    Unit cur, nxt; int ui = 0;
    if (!PG8_NEXT(0, cur)) return;
    f32x4 acc[2][2][4][2];
#pragma unroll
    for (int a = 0; a < 2; ++a)
#pragma unroll
        for (int b = 0; b < 2; ++b)
#pragma unroll
            for (int m = 0; m < 4; ++m)
#pragma unroll
                for (int n = 0; n < 2; ++n) acc[a][b][m][n] = (f32x4){0.f, 0.f, 0.f, 0.f};
    bf16x8 At[4][2], B0[2][2], B1[2][2];
    const char* cA = PG8_UA(cur); const char* cB = PG8_UB(cur);
    PG8_STAGE(PG8_SB(0, 0), cB, voffB); PG8_STAGE(PG8_SB(0, 1), cB + hstep, voffB); PG8_STAGE(PG8_SA(0, 0), cA, voffA); PG8_STAGE(PG8_SA(0, 1), cA + hstep, voffA);
    if (wr == 1) PG8_BAR;
    PG8_WAIT_V(2); PG8_BAR;
    PG8_STAGE(PG8_SB(1, 0), cB + kstep, voffB); PG8_STAGE(PG8_SA(1, 0), cA + kstep, voffA); PG8_STAGE(PG8_SB(1, 1), cB + hstep + kstep, voffB);
    PG8_WAIT_V(6); PG8_BAR;
    for (;;) {
        const bool has_next = PG8_NEXT(ui + 1, nxt);
        const char* nA = has_next ? PG8_UA(nxt) : cA; const char* nB = has_next ? PG8_UB(nxt) : cB;
        for (int t = 0; t < nt; t += 2) {
            const bool last = (t == nt - 2);
            const char* a1 = cA + (size_t)(t + 1) * kstep;
            const char* a2 = last ? nA : cA + (size_t)(t + 2) * kstep; const char* b2 = last ? nB : cB + (size_t)(t + 2) * kstep;
            const char* a3 = a2 + kstep; const char* b3 = b2 + kstep;
            PG8_LDB(B0, 0, 0); PG8_LDB(B1, 0, 1); PG8_SCHED; PG8_LDA(At, 0, 0); PG8_STAGE(PG8_SA(1, 1), a1 + hstep, voffA);
            PG8_WAIT_V(8); PG8_WAIT_L(0); PG8_BAR; PG8_MMA(0, 0, At, B0); PG8_MMA(0, 1, At, B1); PG8_BAR; PG8_SCHED;
            PG8_LDA(At, 0, 1); PG8_STAGE(PG8_SB(0, 0), b2, voffB); PG8_STAGE(PG8_SB(0, 1), b2 + hstep, voffB); PG8_STAGE(PG8_SA(0, 0), a2, voffA);
            PG8_WAIT_V(8); PG8_WAIT_L(0); PG8_BAR; PG8_MMA(1, 0, At, B0); PG8_MMA(1, 1, At, B1); PG8_BAR; PG8_SCHED;
            PG8_LDB(B0, 1, 0); PG8_LDB(B1, 1, 1); PG8_SCHED; PG8_LDA(At, 1, 0); PG8_STAGE(PG8_SA(0, 1), a2 + hstep, voffA);
            PG8_WAIT_V(8); PG8_WAIT_L(0); PG8_BAR; PG8_MMA(0, 0, At, B0); PG8_MMA(0, 1, At, B1); PG8_BAR; PG8_SCHED;
            PG8_LDA(At, 1, 1); PG8_STAGE(PG8_SB(1, 0), b3, voffB); PG8_STAGE(PG8_SB(1, 1), b3 + hstep, voffB); PG8_STAGE(PG8_SA(1, 0), a3, voffA);
            PG8_WAIT_V(8); PG8_WAIT_L(0); PG8_BAR; PG8_MMA(1, 0, At, B0); PG8_MMA(1, 1, At, B1); PG8_BAR; PG8_SCHED;
        }
        if (wr == 0) PG8_BAR;
        const bool first_half = SPLIT2 && cur.half == 0;
        {
            const int row0 = cur.pm * BM + wr * 64 + fr, col0 = cur.pn * BM + wc * 32 + 8 * fq;
            if constexpr (SPLIT2) { if (first_half) {
#pragma unroll
                for (int ai = 0; ai < 2; ++ai)
#pragma unroll
                    for (int m = 0; m < 4; ++m) {
#pragma unroll
                        for (int bj = 0; bj < 2; ++bj) E.mid8(row0 + ai * HALF + m * 16, col0 + bj * HALF, acc[ai][bj][m][0], acc[ai][bj][m][1]);
                        asm volatile("" : "+v"(acc[ai][0][m][0]), "+v"(acc[ai][0][m][1]), "+v"(acc[ai][1][m][0]), "+v"(acc[ai][1][m][1]) :: "memory"); } } }
            if constexpr (Epi::TILE) E.tile(acc, cur.pm, cur.pn, wr, wc, fr, fq, (LAS float*)(lds + RING_BYTES + 2048));
            else if (!first_half) {
#pragma unroll
            for (int ai = 0; ai < 2; ++ai)
#pragma unroll
                for (int m = 0; m < 4; ++m)
#pragma unroll
                    for (int bj = 0; bj < 2; ++bj) E.st8(row0 + ai * HALF + m * 16, col0 + bj * HALF, acc[ai][bj][m][0], acc[ai][bj][m][1]);
            }
        }
        if (!has_next) break;
        if (!first_half) {
#pragma unroll
        for (int a = 0; a < 2; ++a)
#pragma unroll
            for (int b = 0; b < 2; ++b)
#pragma unroll
                for (int m = 0; m < 4; ++m)
#pragma unroll
                    for (int n = 0; n < 2; ++n) acc[a][b][m][n] = (f32x4){0.f, 0.f, 0.f, 0.f};
        }
        cur = nxt; cA = nA; cB = nB; ++ui;
        if (wr == 1) PG8_BAR;
    }
    PG8_WAIT_V(0);
    PG8_BAR;
#undef PG8_NEXT
#undef PG8_UA
#undef PG8_UB
#undef PG8_SA
#undef PG8_SB
#undef PG8_STAGE
#undef PG8_LDA
#undef PG8_LDB
#undef PG8_MMA
#undef PG8_WAIT_V
#undef PG8_WAIT_L
#undef PG8_BAR
#undef PG8_SCHED
}
}

#define XB_TMO      128
#define XB_XCNT(j)  (256  + 64 * (j))
#define XB_XSUB(j)  (1280 + 64 * (j))
#define XB_XGEN(j)  (2304 + 64 * (j))
#define XB_TOP      3328
#define XB_TOPGEN   3392
#define XCD_BAR_WORDS 3456
#define XB_SPIN_CAP (1u << 18)
__device__ __forceinline__ unsigned xb_ld(unsigned* p)              { return __hip_atomic_load(p, __ATOMIC_RELAXED, __HIP_MEMORY_SCOPE_AGENT); }
__device__ __forceinline__ unsigned xb_add(unsigned* p, unsigned v) { return __hip_atomic_fetch_add(p, v, __ATOMIC_RELAXED, __HIP_MEMORY_SCOPE_AGENT); }
__device__ __forceinline__ unsigned xb_xcc_id() { return (unsigned)__builtin_amdgcn_s_getreg((3 << 11) | 20) & 0xFu; }
#define XB_SPIN(cond, bar) do { unsigned _sp = 0; while (cond) { __builtin_amdgcn_s_sleep(1); \
    if ((++_sp & 255u) == 0u) { if (xb_ld(&(bar)[XB_TMO])) break; if (_sp > XB_SPIN_CAP) { atomicAdd(&(bar)[XB_TMO], 1u); break; } } } } while (0)
struct XcdBarrier { unsigned* bar; unsigned x; volatile LAS unsigned* st; int wave; };
__device__ __forceinline__ XcdBarrier xcd_barrier_post(unsigned* bar, volatile LAS unsigned* st, int wave) {
    XcdBarrier b; b.bar = bar; b.x = xb_xcc_id(); b.st = st; b.wave = wave;
    if (wave == 0 && lane_id() == 0) (void)xb_add(&bar[XB_XCNT(b.x)], 1u);
    return b;
}
__device__ __forceinline__ void xcd_barrier_complete(unsigned* bar, unsigned x, unsigned& nloc, unsigned& nx) {
    const unsigned G = gridDim.x * gridDim.y * gridDim.z;
    unsigned sum, cnt, mine, sp = 0u;
    for (;;) {
        sum = 0u; cnt = 0u; mine = 0u;
#pragma unroll
        for (unsigned j = 0; j < 16; ++j) { const unsigned c = xb_ld(&bar[XB_XCNT(j)]); sum += c; cnt += (c > 0u) ? 1u : 0u; mine = (j == x) ? c : mine; }
        if (sum == G) break;
        __builtin_amdgcn_s_sleep(1);
        if ((++sp & 255u) == 0u) { if (xb_ld(&bar[XB_TMO])) break; if (sp > XB_SPIN_CAP) { atomicAdd(&bar[XB_TMO], 1u); break; } }
    }
    nloc = mine > 0u ? mine : 1u; nx = cnt > 0u ? cnt : 1u;
}
__device__ __forceinline__ void xcd_barrier(const XcdBarrier& b) {
    asm volatile("s_waitcnt vmcnt(0)" ::: "memory");
    __syncthreads();
    if (b.wave == 0 && lane_id() == 0) {
        unsigned* bar = b.bar;
        __builtin_amdgcn_s_waitcnt(0);
        unsigned nloc = b.st[0], nx = b.st[1];
        if (nloc == 0u) { xcd_barrier_complete(bar, b.x, nloc, nx); b.st[0] = nloc; b.st[1] = nx; }
        const unsigned old = xb_add(&bar[XB_XSUB(b.x)], 1u);
        const unsigned gen = old / nloc;
        if (old + 1u == (gen + 1u) * nloc) {
            __builtin_amdgcn_fence(__ATOMIC_RELEASE, "agent");
            asm volatile("s_waitcnt vmcnt(0)" ::: "memory");
            const unsigned og = xb_add(&bar[XB_TOP], 1u);
            const unsigned tg = og / nx;
            if (og + 1u == (tg + 1u) * nx) xb_add(&bar[XB_TOPGEN], 1u);
            else XB_SPIN(xb_ld(&bar[XB_TOPGEN]) == tg, bar);
            __builtin_amdgcn_fence(__ATOMIC_ACQUIRE, "agent");
            xb_add(&bar[XB_XGEN(b.x)], 1u);
            asm volatile("s_waitcnt vmcnt(0)" ::: "memory");
        } else {
            XB_SPIN(xb_ld(&bar[XB_XGEN(b.x)]) == gen, bar);
            __builtin_amdgcn_fence(__ATOMIC_ACQUIRE, "agent");
            asm volatile("s_waitcnt vmcnt(0)" ::: "memory");
        }
    }
    __syncthreads();
}

struct Args { const void* in[32]; float* out; unsigned char* ws; int ph_lo, ph_hi; };
struct Frame { LAS unsigned char* lds; int wave, vcu, G; const Args* a; };
#define FP_x_prompt ((const float*)F.a->in[0])
#define FP_x_sample ((const float*)F.a->in[1])
#define FP_c_prompt ((const float*)F.a->in[2])
#define FP_c_sample ((const float*)F.a->in[3])
#define FP_cache_k ((const float*)F.a->in[4])
#define FP_cache_v ((const float*)F.a->in[5])
#define FP_page_table ((const int*)F.a->in[6])
#define FP_state_C ((const float*)F.a->in[7])
#define FP_state_n ((const float*)F.a->in[8])
#define FP_state_m ((const float*)F.a->in[9])
#define FP_state_conv ((const float*)F.a->in[10])
#define FP_w_ada ((const float*)F.a->in[11])
#define FP_b_ada ((const float*)F.a->in[12])
#define FP_g_pre_mix ((const float*)F.a->in[13])
#define FP_g_post_mix ((const float*)F.a->in[14])
#define FP_w_in ((const float*)F.a->in[15])
#define FP_b_if ((const float*)F.a->in[16])
#define FP_g_mlstm ((const float*)F.a->in[17])
#define FP_lq1 ((const float*)F.a->in[18])
#define FP_lk1 ((const float*)F.a->in[19])
#define FP_lq2 ((const float*)F.a->in[20])
#define FP_lk2 ((const float*)F.a->in[21])
#define FP_g_diff ((const float*)F.a->in[22])
#define FP_w_proj_m ((const float*)F.a->in[23])
#define FP_w_proj_d ((const float*)F.a->in[24])
#define FP_w_out ((const float*)F.a->in[25])
#define FP_g_pre_ffn ((const float*)F.a->in[26])
#define FP_g_post_ffn ((const float*)F.a->in[27])
#define FP_w_up ((const float*)F.a->in[28])
#define FP_conv_w ((const float*)F.a->in[29])
#define FP_conv_b ((const float*)F.a->in[30])
#define FP_w_down ((const float*)F.a->in[31])
#define FP_WinT ((bf16_t*)(F.a->ws + WS_WIN))
#define FP_WupT ((bf16_t*)(F.a->ws + WS_WUP))
#define FP_WdownT ((bf16_t*)(F.a->ws + WS_WDOWN))
#define FP_WoutT ((bf16_t*)(F.a->ws + WS_WOUT))
#define FP_WpT ((bf16_t*)(F.a->ws + WS_WPM))
#define FP_H1 ((bf16_t*)(F.a->ws + WS_H1))
#define FP_Z ((bf16_t*)(F.a->ws + WS_Z))
#define FP_CPREV ((bf16_t*)(F.a->ws + WS_CPREV))
#define FP_HMD ((bf16_t*)(F.a->ws + WS_HM))
#define FP_MG ((bf16_t*)(F.a->ws + WS_MG))
#define FP_AH ((float*)(F.a->ws + WS_UA))
#define FP_AF ((float*)(F.a->ws + WS_UA + 2 * MiB))
#define FP_BF ((float*)(F.a->ws + WS_UA + 4 * MiB))
#define FP_GB ((bf16_t*)(F.a->ws + WS_G))
#define FP_ADA ((float*)(F.a->ws + WS_ADA))
#define FP_IG ((float*)(F.a->ws + WS_IG))
#define FP_LF ((float*)(F.a->ws + WS_LF))
#define FP_ST ((float*)(F.a->ws + WS_ST))
#define FP_NU ((float*)(F.a->ws + WS_NU))
#define FP_NPREV ((float*)(F.a->ws + WS_NPREV))
#define FP_MPREV ((float*)(F.a->ws + WS_MPREV))
#define FP_U ((float*)(F.a->ws + WS_U))
#define FP_O1 ((bf16_t*)(F.a->ws + WS_O1))
#define FP_O2 ((bf16_t*)(F.a->ws + WS_O2))
#define FP_Y ((bf16_t*)(F.a->ws + WS_Y))
#define FP_DPART ((float*)(F.a->ws + WS_DPART))
#define FP_X1 ((bf16_t*)(F.a->ws + WS_UB + 16 * MiB))
#define FP_out (F.a->out)


__device__ __forceinline__ void transpose_item(const float* W, int pitch, int scol0, int K, bf16_t* WT, int drow0, LAS float* scr, int kb, int nb, int lane, int koff = 0) {
    const int k0 = 64 * kb, n0 = 32 * nb;
    float tv[32];
#pragma unroll
    for (int i = 0; i < 32; ++i) { const int kk = 2 * i + (lane >> 5); tv[i] = W[(size_t)(k0 + kk) * pitch + scol0 + n0 + (lane & 31)]; }
#pragma unroll
    for (int i = 0; i < 32; ++i) { const int kk = 2 * i + (lane >> 5); scr[kk * 33 + (lane & 31)] = tv[i]; }
    asm volatile("s_waitcnt lgkmcnt(0)" ::: "memory");
    const int c = lane & 7;
#pragma unroll
    for (int j = 0; j < 4; ++j) { const int n = (lane >> 3) + 8 * j; const LAS float* s = scr + (8 * c) * 33 + n;
        u32x4 o; o.x = pk2(s[0 * 33], s[1 * 33]); o.y = pk2(s[2 * 33], s[3 * 33]); o.z = pk2(s[4 * 33], s[5 * 33]); o.w = pk2(s[6 * 33], s[7 * 33]);
        *(u32x4*)(WT + (size_t)(drow0 + n0 + n) * K + koff + k0 + 8 * c) = o; }
    asm volatile("s_waitcnt lgkmcnt(0)" ::: "memory");
}
struct TBlock { const float* W; bf16_t* WT; int pitch, col_a, col_b, k0, wt_pitch, koff, drow0; };
__device__ __forceinline__ TBlock tblock_of(const Frame& F, int it) {
    constexpr int B0 = 16 * 22, B1 = 8 * 4, B2 = 8 * 4, B3 = 16 * 4, B4 = 16 * 22;
    int r = it; TBlock t;
    if (r < B0) { const int kb = r / 22, nb = r % 22; t = {FP_w_in, FP_WinT, DIN, nb < 8 ? 256 * nb : 2056 + 256 * (nb - 8), -1, 64 * kb, 1024, 0, 256 * nb}; return t; } r -= B0;
    if (r < B1) { t = {FP_w_proj_m, FP_WpT, 1024, 256 * (r & 3), -1, 64 * (r >> 2), 1024, 0, 256 * (r & 3)}; return t; } r -= B1;
    if (r < B2) { t = {FP_w_proj_d, FP_WpT, 1024, 256 * (r & 3), -1, 64 * (r >> 2), 1024, 512, 256 * (r & 3)}; return t; } r -= B2;
    if (r < B3) { t = {FP_w_out, FP_WoutT, 1024, 256 * (r & 3), -1, 64 * (r >> 2), 1024, 0, 256 * (r & 3)}; return t; } r -= B3;
    if (r < B4) { const int kb = r / 22, pn = r % 22; t = {FP_w_up, FP_WupT, 2 * DFF, 128 * pn, DFF + 128 * pn, 64 * kb, 1024, 0, 256 * pn}; return t; } r -= B4;
    t = {FP_w_down, FP_WdownT, 1024, 256 * (r & 3), -1, 64 * (r >> 2), DFF, 0, 256 * (r & 3)}; return t;
}
__device__ __forceinline__ void p0_transposes(const Frame& F) {
    constexpr int NBLK = 16 * 22 + 8 * 4 + 8 * 4 + 16 * 4 + 16 * 22 + 44 * 4;
    const int lane = lane_id(), wid = F.wave, tid = wid * 64 + lane;
    LAS float* tile = (LAS float*)F.lds;
    f32x4 v[8];
    int it = F.vcu;
    if (it < NBLK) { const TBlock t = tblock_of(F, it); const int scol = (t.col_b >= 0 && lane >= 32) ? t.col_b + 4 * (lane - 32) : t.col_a + 4 * lane;
#pragma unroll
        for (int i = 0; i < 8; ++i) v[i] = *(const f32x4*)(t.W + (size_t)(t.k0 + 8 * wid + i) * t.pitch + scol); }
    for (; it < NBLK; it += F.G) {
        const TBlock t = tblock_of(F, it);
#pragma unroll
        for (int i = 0; i < 8; ++i) *(LAS f32x4*)(tile + (8 * wid + i) * 260 + 4 * lane) = v[i];
        if (it + F.G < NBLK) { const TBlock tn = tblock_of(F, it + F.G); const int scol = (tn.col_b >= 0 && lane >= 32) ? tn.col_b + 4 * (lane - 32) : tn.col_a + 4 * lane;
#pragma unroll
            for (int i = 0; i < 8; ++i) v[i] = *(const f32x4*)(tn.W + (size_t)(tn.k0 + 8 * wid + i) * tn.pitch + scol); }
        WG_BAR();
#pragma unroll
        for (int i = 0; i < 4; ++i) { const int idx = tid + 512 * i, n = idx >> 3, c = idx & 7; const LAS float* sp = tile + (8 * c) * 260 + n;
            u32x4 o; o.x = pk2(sp[0], sp[260]); o.y = pk2(sp[2 * 260], sp[3 * 260]); o.z = pk2(sp[4 * 260], sp[5 * 260]); o.w = pk2(sp[6 * 260], sp[7 * 260]);
            *(u32x4*)(t.WT + (size_t)(t.drow0 + n) * t.wt_pitch + t.koff + t.k0 + 8 * c) = o; }
        WG_BAR();
    }
    {
        LAS float* scr = (LAS float*)(F.lds + F.wave * 8448);
        const int gw = F.vcu * NWAVES + F.wave; if (gw < 16) transpose_item(FP_w_in, DIN, 2048 - ZP, 1024, FP_WinT, 0, scr, gw, ZP / 32, lane_id());
    }
}
__device__ __forceinline__ void p0_ada(const Frame& F) {
    const int lane = lane_id(), r = lane & 31, h = lane >> 5, w = F.wave, tid = w * 64 + lane;
    LAS float* part = (LAS float*)F.lds;
    for (int task = F.vcu; task < 192; task += F.G) {
        const int n0 = 32 * task;
        bf16x8 bw[8];
#pragma unroll
        for (int ks = 0; ks < 8; ++ks) { const float* p = FP_w_ada + (size_t)(128 * w + 16 * ks + 8 * h) * 6144 + n0 + r;
            f32x4 a, b; a.x = p[0]; a.y = p[6144]; a.z = p[2 * 6144]; a.w = p[3 * 6144]; b.x = p[4 * 6144]; b.y = p[5 * 6144]; b.z = p[6 * 6144]; b.w = p[7 * 6144]; bw[ks] = pack8(a, b); }
        f32x16 acc[5];
        LAS unsigned char* ct = F.lds + w * 8704;
        int lo_ = lane; asm volatile("" : "+v"(lo_));
        const int lrow = lo_ >> 5, lcol = (lo_ & 31) * 4;
#pragma unroll
        for (int rt = 0; rt < 5; ++rt) {
            f32x4 cv[16];
#pragma unroll
            for (int i = 0; i < 16; ++i) { const int R0 = 32 * rt + 2 * i;
                if (R0 == 0) cv[i] = *(const f32x4*)(FP_c_prompt + (size_t)lrow * 1024 + 128 * w + lcol);
                else if (R0 < 130) cv[i] = *(const f32x4*)(FP_c_sample + (size_t)(R0 - 2 + lrow) * 1024 + 128 * w + lcol);
                else cv[i] = (f32x4){0.f, 0.f, 0.f, 0.f}; }
#pragma unroll
            for (int i = 0; i < 16; ++i) { u32x2 o; o.x = pk2(cv[i].x, cv[i].y); o.y = pk2(cv[i].z, cv[i].w); *(LAS u32x2*)(ct + (2 * i + lrow) * 272 + lcol * 2) = o; }
            for (int i = 0; i < 16; ++i) acc[rt][i] = 0.f;
#pragma unroll
            for (int ks = 0; ks < 8; ++ks) acc[rt] = MFMA32(*(const LAS bf16x8*)(ct + r * 272 + (16 * ks + 8 * h) * 2), bw[ks], acc[rt]);
            asm volatile("s_waitcnt lgkmcnt(0)" ::: "memory");
        }
        WG_BAR();
#pragma unroll
        for (int batch = 0; batch < 2; ++batch) {
            const int rt0 = 3 * batch, nrt = batch ? 2 : 3;
#pragma unroll
            for (int j = 0; j < 3; ++j) if (j < nrt) {
#pragma unroll
                for (int i = 0; i < 16; ++i) part[((w * 3 + j) * 32 + crow(i, h)) * 32 + r] = acc[rt0 + j][i]; }
            WG_BAR();
            for (int idx = tid; idx < nrt * 1024; idx += NTHR) { const int j = idx >> 10, row = (idx >> 5) & 31, col = idx & 31; float sum = 0.f;
#pragma unroll
                for (int ww = 0; ww < 8; ++ww) sum += part[((ww * 3 + j) * 32 + row) * 32 + col];
                const int Rr = 32 * (rt0 + j) + row; if (Rr < 130) FP_ADA[(size_t)Rr * 6144 + n0 + col] = sum + FP_b_ada[n0 + col]; }
            WG_BAR();
        }
    }
}
__device__ __forceinline__ int crow_of(int m) { return m < MP ? (m >> 13) : 2 + ((m - MP) >> 2); }
__device__ __forceinline__ const float* xrow_of(const Frame& F, int m) { return m < MP ? FP_x_prompt + (size_t)m * DM : FP_x_sample + (size_t)(m - MP) * DM; }
__device__ __forceinline__ void p1_norm_gates(const Frame& F) {
    const int lane = lane_id(), gw = F.vcu * NWAVES + F.wave, NGW = F.G * NWAVES;
    const int r_lo = (int)(((long)gw * MT) / NGW), r_hi = (int)(((long)(gw + 1) * MT) / NGW);
    f32x4 gs[4], sh[4], vn[4], vn2[4];
#pragma unroll
    for (int j = 0; j < 4; ++j) { gs[j] = (f32x4){0.f, 0.f, 0.f, 0.f}; sh[j] = gs[j]; vn[j] = gs[j]; vn2[j] = gs[j]; }
    int ccur = -1;
    if (r_lo < r_hi) { const float* xr = xrow_of(F, r_lo);
#pragma unroll
        for (int j = 0; j < 4; ++j) vn[j] = *(const f32x4*)(xr + 4 * lane + 256 * j); }
    if (r_lo + 1 < r_hi) { const float* xr = xrow_of(F, r_lo + 1);
#pragma unroll
        for (int j = 0; j < 4; ++j) vn2[j] = *(const f32x4*)(xr + 4 * lane + 256 * j); }
    for (int m = r_lo; m < r_hi; ++m) {
        f32x4 v[4]; float ss = 0.f;
#pragma unroll
        for (int j = 0; j < 4; ++j) { v[j] = vn[j]; vn[j] = vn2[j]; }
        if (m + 2 < r_hi) { const float* xr = xrow_of(F, m + 2);
#pragma unroll
            for (int j = 0; j < 4; ++j) vn2[j] = *(const f32x4*)(xr + 4 * lane + 256 * j); }
        const int cr = crow_of(m);
        if (cr != ccur) { ccur = cr; const float* ada = FP_ADA + (size_t)cr * 6144;
#pragma unroll
            for (int j = 0; j < 4; ++j) { sh[j] = *(const f32x4*)(ada + 4 * lane + 256 * j); gs[j] = *(const f32x4*)(FP_g_pre_mix + 4 * lane + 256 * j) * (*(const f32x4*)(ada + 1024 + 4 * lane + 256 * j) + 1.f); } }
#pragma unroll
        for (int j = 0; j < 4; ++j) ss += (v[j].x * v[j].x + v[j].y * v[j].y) + (v[j].z * v[j].z + v[j].w * v[j].w);
        const float rs = rsqrtf(wave_sum(ss) * (1.f / DM) + EPS);
#pragma unroll
        for (int j = 0; j < 4; ++j) { const f32x4 hv = (v[j] * rs) * gs[j] + sh[j];
            u32x2 o; o.x = pk2(hv.x, hv.y); o.y = pk2(hv.z, hv.w); *(u32x2*)(FP_H1 + (size_t)m * DM + 4 * lane + 256 * j) = o; }
    }
}
struct EpiZ {
    static constexpr int MID_T = -1; static constexpr bool TILE = true;
    bf16_t* Z; float* out; float* IG; float* LF; const float* b_if;
    __device__ __forceinline__ void st8(int, int, f32x4, f32x4) const {}
    __device__ __forceinline__ void tile(f32x4 (&acc)[2][2][4][2], int pm, int pn, int wr, int wc, int fr, int fq, LAS float*) const {
        const int row0 = pm * 256 + wr * 64 + fr, col0 = pn * 256 + wc * 32 + 8 * fq;
        if (pn == ZP / 256) {
            if (wc == 0 && fq == 0) { const f32x4 bi = *(const f32x4*)b_if, bf = *(const f32x4*)(b_if + 4);
#pragma unroll
                for (int ai = 0; ai < 2; ++ai)
#pragma unroll
                    for (int m = 0; m < 4; ++m) { const int row = row0 + ai * 128 + m * 16; const f32x4 v1 = acc[ai][0][m][1] + bf;
                        *(f32x4*)(IG + (size_t)row * 4) = acc[ai][0][m][0] + bi;
                        *(f32x4*)(LF + (size_t)row * 4) = (f32x4){log_sigmoid(v1.x), log_sigmoid(v1.y), log_sigmoid(v1.z), log_sigmoid(v1.w)}; } }
        } else if (pn >= 14) {
#pragma unroll
            for (int ai = 0; ai < 2; ++ai)
#pragma unroll
                for (int m = 0; m < 4; ++m)
#pragma unroll
                    for (int bj = 0; bj < 2; ++bj) { f32x4 v0 = acc[ai][bj][m][0], v1 = acc[ai][bj][m][1];
                        v0.x = sigmoidf_(v0.x); v0.y = sigmoidf_(v0.y); v0.z = sigmoidf_(v0.z); v0.w = sigmoidf_(v0.w); v1.x = sigmoidf_(v1.x); v1.y = sigmoidf_(v1.y); v1.z = sigmoidf_(v1.z); v1.w = sigmoidf_(v1.w);
                        *(bf16x8*)(Z + zbase(col0 + bj * 128) + (size_t)(row0 + ai * 128 + m * 16) * ZR) = pack8(v0, v1); }
        } else if (pn >= 10) {
            const int kv = pn >= 12;
#pragma unroll
            for (int ai = 0; ai < 2; ++ai)
#pragma unroll
                for (int m = 0; m < 4; ++m)
#pragma unroll
                    for (int bj = 0; bj < 2; ++bj) { const int row = row0 + ai * 128 + m * 16, col = col0 + bj * 128, c = col - (kv ? ZDV : ZDK);
                        float* o = row < MP ? out + (kv ? OFF_VP : OFF_KP) + (size_t)row * 512 + c : out + (kv ? OFF_VS : OFF_KS) + (size_t)(row - MP) * 512 + c;
                        *(f32x4*)o = acc[ai][bj][m][0]; *(f32x4*)(o + 4) = acc[ai][bj][m][1];
                        *(bf16x8*)(Z + zbase(col) + (size_t)row * ZR) = pack8(acc[ai][bj][m][0], acc[ai][bj][m][1]); }
        } else {
            const float sc = (pn == 2 || pn == 3) ? KSCALE : ((pn == 8 || pn == 9) ? QSCALE : 1.f);
#pragma unroll
            for (int ai = 0; ai < 2; ++ai)
#pragma unroll
                for (int m = 0; m < 4; ++m)
#pragma unroll
                    for (int bj = 0; bj < 2; ++bj) *(bf16x8*)(Z + zbase(col0 + bj * 128) + (size_t)(row0 + ai * 128 + m * 16) * ZR) = pack8(acc[ai][bj][m][0] * sc, acc[ai][bj][m][1] * sc);
        }
    }
};
struct EpiPMD {
    static constexpr int MID_T = 6; static constexpr bool TILE = false;
    const bf16_t* Z; bf16_t* MG;
    __device__ __forceinline__ void mid8(int row, int col, f32x4& v0, f32x4& v1) const {
        const u32x4 gm = *(const u32x4*)(Z + zbase(ZGM + col) + (size_t)row * ZR), gd = *(const u32x4*)(Z + zbase(ZGD + col) + (size_t)row * ZR);
        f32x4 m0, m1, d0, d1; unpack8(gm, m0, m1); unpack8(gd, d0, d1);
        d0.x = fmaxf(d0.x, 1e-20f); d0.y = fmaxf(d0.y, 1e-20f); d0.z = fmaxf(d0.z, 1e-20f); d0.w = fmaxf(d0.w, 1e-20f); d1.x = fmaxf(d1.x, 1e-20f); d1.y = fmaxf(d1.y, 1e-20f); d1.z = fmaxf(d1.z, 1e-20f); d1.w = fmaxf(d1.w, 1e-20f);
        v0.x *= m0.x * __builtin_amdgcn_rcpf(d0.x); v0.y *= m0.y * __builtin_amdgcn_rcpf(d0.y); v0.z *= m0.z * __builtin_amdgcn_rcpf(d0.z); v0.w *= m0.w * __builtin_amdgcn_rcpf(d0.w);
        v1.x *= m1.x * __builtin_amdgcn_rcpf(d1.x); v1.y *= m1.y * __builtin_amdgcn_rcpf(d1.y); v1.z *= m1.z * __builtin_amdgcn_rcpf(d1.z); v1.w *= m1.w * __builtin_amdgcn_rcpf(d1.w); }
    __device__ __forceinline__ void st8(int row, int col, f32x4 v0, f32x4 v1) const {
        f32x4 d0, d1; unpack8(*(const u32x4*)(Z + zbase(ZGD + col) + (size_t)row * ZR), d0, d1);
        d0.x = fmaxf(d0.x, 1e-20f); d0.y = fmaxf(d0.y, 1e-20f); d0.z = fmaxf(d0.z, 1e-20f); d0.w = fmaxf(d0.w, 1e-20f); d1.x = fmaxf(d1.x, 1e-20f); d1.y = fmaxf(d1.y, 1e-20f); d1.z = fmaxf(d1.z, 1e-20f); d1.w = fmaxf(d1.w, 1e-20f);
        *(bf16x8*)(MG + (size_t)row * DM + col) = pack8(v0 * d0, v1 * d1); }
    __device__ __forceinline__ void st4md(int row, int col, f32x4 am, f32x4 ad) const {
        const u32x2 gm = *(const u32x2*)(Z + zbase(ZGM + col) + (size_t)row * ZR), gd = *(const u32x2*)(Z + zbase(ZGD + col) + (size_t)row * ZR);
        u32x2 o; o.x = pk2(bflo(gm.x) * am.x + bflo(gd.x) * ad.x, bfhi(gm.x) * am.y + bfhi(gd.x) * ad.y); o.y = pk2(bflo(gm.y) * am.z + bflo(gd.y) * ad.z, bfhi(gm.y) * am.w + bfhi(gd.y) * ad.w);
        *(u32x2*)(MG + (size_t)row * DM + col) = o; }
};
struct EpiF32 {
    static constexpr int MID_T = -1; static constexpr bool TILE = false;
    bf16_t* Y;
    __device__ __forceinline__ void st4(int row, int col, f32x4 v) const { u32x2 o; o.x = pk2(v.x, v.y); o.y = pk2(v.z, v.w); *(u32x2*)(Y + (size_t)row * DM + col) = o; }
    __device__ __forceinline__ void st8(int row, int col, f32x4 v0, f32x4 v1) const { *(bf16x8*)(Y + (size_t)row * DM + col) = pack8(v0, v1); }
};
__device__ __forceinline__ float gelu_tanh(float x) { const float u = 1.5957691216057308f * (x + 0.044715f * x * x * x); return x * __builtin_amdgcn_rcpf(1.f + __builtin_amdgcn_exp2f(-u * LOG2E)); }
#define DPP_F(oldv, srcv, ctrl) __builtin_bit_cast(float, __builtin_amdgcn_update_dpp(__builtin_bit_cast(int, (float)(oldv)), __builtin_bit_cast(int, (float)(srcv)), (ctrl), 0xf, 0xf, false))
struct EpiUpG {
    static constexpr int MID_T = -1; static constexpr bool TILE = true;
    bf16_t* G; float* out; const float* conv_w; const float* conv_b; const float* state_conv; float* AH; float* AF; float* BF;
    __device__ __forceinline__ void st8(int, int, f32x4, f32x4) const {}
    __device__ __forceinline__ void tile(f32x4 (&acc)[2][2][4][2], int pm, int pn, int wr, int wc, int fr, int fq, LAS float* halo) const {
        if (pm >= MP / 256) body<true>(acc, pm, pn, wr, wc, fr, fq, halo); else body<false>(acc, pm, pn, wr, wc, fr, fq, halo);
    }
    template <bool SAMPLE>
    __device__ __forceinline__ void body(f32x4 (&acc)[2][2][4][2], int pm, int pn, int wr, int wc, int fr, int fq, LAS float* halo) const {
        const int f0 = 128 * pn + 32 * wc + 8 * fq;
        if constexpr (!SAMPLE) {
#pragma unroll
            for (int ai = 0; ai < 2; ++ai) if (fr >= 14) { LAS float* hp = halo + ((2 * ai + wr) * 2 + (fr - 14)) * 128 + 32 * wc + 8 * fq; *(LAS f32x4*)hp = acc[ai][0][3][0]; *(LAS f32x4*)(hp + 4) = acc[ai][0][3][1]; }
        }
        asm volatile("s_waitcnt lgkmcnt(0)\n\ts_barrier" ::: "memory");
#pragma unroll
        for (int n = 0; n < 2; ++n) {
            const int fc = f0 + 4 * n;
            const f32x4 w0 = *(const f32x4*)(conv_w + fc), w1 = *(const f32x4*)(conv_w + DFF + fc), w2 = *(const f32x4*)(conv_w + 2 * DFF + fc), cb = *(const f32x4*)(conv_b + fc);
#pragma unroll
            for (int ai = 0; ai < 2; ++ai) {
                const int g = 2 * ai + wr;
                f32x4 h0 = {0.f, 0.f, 0.f, 0.f}, h1 = h0;
                if constexpr (!SAMPLE) { if (g > 0) { const LAS float* hp = halo + ((g - 1) * 2) * 128 + 32 * wc + 8 * fq + 4 * n; h0 = *(const LAS f32x4*)hp; h1 = *(const LAS f32x4*)(hp + 128); } }
                f32x4 s0m[4], s1m[4];
#pragma unroll
                for (int m = 0; m < 4; ++m) { s0m[m] = (f32x4){0.f, 0.f, 0.f, 0.f}; s1m[m] = s0m[m];
                    if constexpr (SAMPLE) { const int row_ = 256 * pm + 128 * ai + 64 * wr + 16 * m + fr; const float* st = state_conv + (size_t)((row_ - MP) >> 2) * 2 * DFF + fc; s0m[m] = *(const f32x4*)st; s1m[m] = *(const f32x4*)(st + DFF); } }
#pragma unroll
                for (int m = 0; m < 4; ++m) {
                    const int rowt = 128 * ai + 64 * wr + 16 * m + fr, row = 256 * pm + rowt, tq = fr & 3;
                    const f32x4 s0 = s0m[m], s1 = s1m[m];
                    f32x4 gv;
#pragma unroll
                    for (int e = 0; e < 4; ++e) {
                        const float a0 = acc[ai][0][m][n][e], bv = acc[ai][1][m][n][e];
                        float p1, p2;
                        if constexpr (SAMPLE) {
                            const float d1 = DPP_F(0.f, a0, 0x111), d2 = DPP_F(0.f, a0, 0x112);
                            p1 = (tq >= 1) ? d1 : s1[e]; p2 = (tq >= 2) ? d2 : ((tq == 1) ? s1[e] : s0[e]);
                        } else {
                            float t1, t2;
                            if (m > 0) { const float pr = acc[ai][0][m > 0 ? m - 1 : 0][n][e]; t1 = DPP_F(0.f, pr, 0x10F); t2 = DPP_F(0.f, pr, 0x10E); }
                            else { t1 = h1[e]; t2 = (fr == 0) ? h0[e] : h1[e]; }
                            p1 = DPP_F(t1, a0, 0x111); p2 = DPP_F(t2, a0, 0x112);
                        }
                        const float cv = cb[e] + w0[e] * p2 + w1[e] * p1 + w2[e] * a0;
                        gv[e] = gelu_tanh(cv) * bv;
                    }
                    { u32x2 o; o.x = pk2(gv.x, gv.y); o.y = pk2(gv.z, gv.w); *(u32x2*)(G + (size_t)row * DFF + fc) = o; }
                    if constexpr (!SAMPLE) {
                        if (ai == 1 && m == 3) { if (rowt >= 254) { *(f32x4*)(AH + ((size_t)pm * 2 + (rowt - 254)) * DFF + fc) = acc[ai][0][m][n];
                            if ((pm & 31) == 31) *(f32x4*)(out + OFF_CVP + ((size_t)(pm >> 5) * 2 + (rowt - 254)) * DFF + fc) = acc[ai][0][m][n]; } }
                        if (ai == 0 && m == 0) { if (rowt < 2) { *(f32x4*)(AF + ((size_t)pm * 2 + rowt) * DFF + fc) = acc[ai][0][m][n]; *(f32x4*)(BF + ((size_t)pm * 2 + rowt) * DFF + fc) = acc[ai][1][m][n]; } }
                    } else { if (tq >= 2) *(f32x4*)(out + OFF_CVS + ((size_t)((row - MP) >> 2) * 2 + (tq - 2)) * DFF + fc) = acc[ai][0][m][n]; }
                    asm volatile("" ::: "memory");
                }
            }
        }
    }
};
__device__ __forceinline__ void geglu_fixup(const Frame& F, int pm) {
    if (pm >= MP / 256 || (pm & 31) == 0) return;
    const float* ah = FP_AH + (size_t)(pm - 1) * 2 * DFF; const float* af = FP_AF + (size_t)pm * 2 * DFF; const float* bfp = FP_BF + (size_t)pm * 2 * DFF;
    for (int i = FTID(F); i < 2 * DFF; i += NTHR) { const int r = i / DFF, f = i - r * DFF;
        const float a0 = af[r * DFF + f], bv = bfp[r * DFF + f], p1 = (r == 0) ? ah[DFF + f] : af[f], p2 = (r == 0) ? ah[f] : ah[DFF + f];
        const float cv = FP_conv_b[f] + FP_conv_w[f] * p2 + FP_conv_w[DFF + f] * p1 + FP_conv_w[2 * DFF + f] * a0;
        FP_GB[(size_t)(256 * pm + r) * DFF + f] = f2bf(gelu_tanh(cv) * bv); }
    asm volatile("s_waitcnt vmcnt(0)" ::: "memory");
    WG_BAR();
}
template <bool MD, class Epi>
__device__ __forceinline__ void skinny_gemm(const Frame& F, const bf16_t* A, const bf16_t* Bt, int K, const Epi& E) {
    const int lane = lane_id(), r = lane & 31, h = lane >> 5, ke = F.wave, K8 = K >> 3, tid = F.wave * 64 + lane;
    LAS float* part = (LAS float*)F.lds;
    for (int task = F.vcu; task < 256; task += F.G) {
        const int rt = task >> 4, cg = task & 15;
        const bf16_t* ap = A + (size_t)(32 * rt + r) * K + ke * K8 + 8 * h;
        const bf16_t* bp0 = Bt + (size_t)(64 * cg + r) * K + ke * K8 + 8 * h; const bf16_t* bp1 = bp0 + (size_t)32 * K;
        f32x16 acc0, acc1; for (int i = 0; i < 16; ++i) { acc0[i] = 0.f; acc1[i] = 0.f; }
#pragma unroll 4
        for (int s = 0; s < K8 / 16; ++s) { const bf16x8 a = *(const bf16x8*)(ap + 16 * s), b0 = *(const bf16x8*)(bp0 + 16 * s), b1 = *(const bf16x8*)(bp1 + 16 * s); acc0 = MFMA32(b0, a, acc0); acc1 = MFMA32(b1, a, acc1); }
#pragma unroll
        for (int g4 = 0; g4 < 4; ++g4) { *(LAS f32x4*)(part + (ke * 32 + r) * 68 + 8 * g4 + 4 * h) = (f32x4){acc0[4 * g4], acc0[4 * g4 + 1], acc0[4 * g4 + 2], acc0[4 * g4 + 3]};
            *(LAS f32x4*)(part + (ke * 32 + r) * 68 + 32 + 8 * g4 + 4 * h) = (f32x4){acc1[4 * g4], acc1[4 * g4 + 1], acc1[4 * g4 + 2], acc1[4 * g4 + 3]}; }
        WG_BAR();
        { const int row = tid >> 4, c4 = (tid & 15) * 4;
          const f32x4 lo = *(const LAS f32x4*)(part + row * 68 + c4) + *(const LAS f32x4*)(part + (32 + row) * 68 + c4) + *(const LAS f32x4*)(part + (64 + row) * 68 + c4) + *(const LAS f32x4*)(part + (96 + row) * 68 + c4);
          const f32x4 hi4 = *(const LAS f32x4*)(part + (128 + row) * 68 + c4) + *(const LAS f32x4*)(part + (160 + row) * 68 + c4) + *(const LAS f32x4*)(part + (192 + row) * 68 + c4) + *(const LAS f32x4*)(part + (224 + row) * 68 + c4);
          if constexpr (MD) E.st4md(MP + 32 * rt + row, 64 * cg + c4, lo, hi4);
          else E.st4(MP + 32 * rt + row, 64 * cg + c4, lo + hi4); }
        WG_BAR();
    }
}

constexpr int VROW = 320;
constexpr int CH = 128, NCH = TP / CH;
__device__ __forceinline__ void chunk_scan(const Frame& F, int m0, int h, int lane, float& F1, float& F2, float& a1, float& a2, float& A1, float& A2) {
    const float lf1 = FP_LF[(size_t)(m0 + lane) * 4 + h], lf2 = FP_LF[(size_t)(m0 + 64 + lane) * 4 + h], ig1 = FP_IG[(size_t)(m0 + lane) * 4 + h], ig2 = FP_IG[(size_t)(m0 + 64 + lane) * 4 + h];
    F1 = wave_scan_sum(lf1, lane); F2 = __shfl(F1, 63) + wave_scan_sum(lf2, lane);
    a1 = ig1 - F1; a2 = ig2 - F2;
    A1 = wave_scan_max(a1, lane); A2 = fmaxf(__shfl(A1, 63), wave_scan_max(a2, lane));
}
__device__ __forceinline__ void mlstm_A_unit(const Frame& F, int u) {
    const int bh = u / NCH, c = u % NCH, b = bh >> 2, h = bh & 3, m0 = b * TP + c * CH;
    const int lane = lane_id(), wid = F.wave, tid = wid * 64 + lane;
    LAS unsigned char* Vt = F.lds; LAS unsigned char* Kt = F.lds + CH * VROW; LAS float* wl = (LAS float*)(F.lds + 2 * CH * VROW);
    if (wid == 0) {
        float F1, F2, a1, a2, A1, A2; chunk_scan(F, m0, h, lane, F1, F2, a1, a2, A1, A2);
        const float Mloc = __shfl(A2, 63), Fsum = __shfl(F2, 63);
        wl[lane] = __expf(a1 - Mloc); wl[64 + lane] = __expf(a2 - Mloc);
        if (lane == 0) { FP_ST[2 * u] = Fsum; FP_ST[2 * u + 1] = Mloc; }
    }
    WG_BAR();
#pragma unroll
    for (int i = 0; i < 4; ++i) { const int idx = tid + 512 * i, row = idx >> 4, ch = idx & 15;
        const bf16_t* src = FP_Z + (size_t)(m0 + row) * ZR;
        const u32x4 vv = *(const u32x4*)(src + zbase(ZV + h * 128 + ch * 8)); const u32x4 kk = *(const u32x4*)(src + zbase(ZK + h * 128 + ch * 8));
        f32x4 k0, k1; unpack8(kk, k0, k1); const float w = wl[row];
        *(LAS u32x4*)(Vt + row * VROW + ch * 16) = vv;
        *(LAS bf16x8*)(Kt + row * VROW + ch * 16) = pack8(k0 * w, k1 * w); }
    WG_BAR();
    if (tid < 128) { float sm = 0.f;
#pragma unroll 8
        for (int row = 0; row < CH; ++row) sm += bf2f(*(const LAS bf16_t*)(Kt + row * VROW + tid * 2));
        FP_NU[(size_t)u * 128 + tid] = sm; }
    {
        const int r32 = lane & 31, hi = lane >> 5, vh = (lane >> 4) & 1, q4 = (lane & 15) >> 2, p = lane & 3;
        const int vt = wid >> 1, dt0 = 2 * (wid & 1);
        const int lbase = (8 * hi + q4) * VROW + (16 * vh + 4 * p) * 2;
        f32x16 acc0, acc1; for (int i = 0; i < 16; ++i) { acc0[i] = 0.f; acc1[i] = 0.f; }
#pragma unroll
        for (int st = 0; st < CH / 16; ++st) {
            const LAS unsigned char* va = Vt + lbase + st * 16 * VROW + vt * 64;
            const bf16x8 af = cat4(tr_rd(va), tr_rd(va + 4 * VROW));
            const LAS unsigned char* ka = Kt + lbase + st * 16 * VROW + dt0 * 64;
            const bf16x8 b0 = cat4(tr_rd(ka), tr_rd(ka + 4 * VROW)), b1 = cat4(tr_rd(ka + 64), tr_rd(ka + 64 + 4 * VROW));
            acc0 = MFMA32(af, b0, acc0); acc1 = MFMA32(af, b1, acc1);
        }
        float* Uo = FP_U + (size_t)u * 16384;
#pragma unroll
        for (int i = 0; i < 16; ++i) { const int v = 32 * vt + crow(i, hi); Uo[v * 128 + 32 * dt0 + r32] = acc0[i]; Uo[v * 128 + 32 * dt0 + 32 + r32] = acc1[i]; }
    }
    WG_BAR();
}
__device__ __forceinline__ void smlstm_unit(const Frame& F, int u) {
    const int n = u >> 2, h = u & 3, tid = FTID(F), lane = lane_id(), wid = F.wave;
    const int mrow = MP + 4 * n;
    LAS float* qs = (LAS float*)F.lds; LAS float* ks = qs + 512; LAS float* vs = ks + 512; LAS float* numI = vs + 512; LAS float* Sm = numI + 512; LAS float* nq = Sm + 16; LAS float* red = nq + 4;
    { const int t = tid >> 7, d = tid & 127; const bf16_t* z = FP_Z + (size_t)(mrow + t) * ZR;
      qs[tid] = bf2f(z[zbase(ZQ + h * 128 + d)]); ks[tid] = bf2f(z[zbase(ZK + h * 128 + d)]); vs[tid] = bf2f(z[zbase(ZV + h * 128 + d)]); }
    LAS float* gl = red + 8;
    const float m0 = FP_state_m[n * 4 + h];
    if (tid < 4) { float cum = 0.f, am = -INFINITY, at = 0.f;
      for (int t = 0; t <= tid; ++t) { cum += FP_LF[(size_t)(mrow + t) * 4 + h]; at = FP_IG[(size_t)(mrow + t) * 4 + h] - cum; am = fmaxf(am, at); }
      const float mxv = fmaxf(m0, am);
      gl[tid] = cum; gl[4 + tid] = at; gl[8 + tid] = mxv; gl[12 + tid] = __expf(m0 - mxv); gl[16 + tid] = cum + mxv; }
    WG_BAR();
    const float m_end = gl[19], Fend = gl[3], decay = __expf(Fend + m0 - m_end);
    const float wend0 = __expf(Fend + gl[4] - m_end), wend1 = __expf(Fend + gl[5] - m_end), wend2 = __expf(Fend + gl[6] - m_end), wend3 = __expf(Fend + gl[7] - m_end);
#pragma unroll
    for (int k = 0; k < 2; ++k) { const int pid = 2 * wid + k, t = pid >> 2, s = pid & 3;
        float d = qs[t * 128 + lane] * ks[s * 128 + lane] + qs[t * 128 + 64 + lane] * ks[s * 128 + 64 + lane]; d = wave_sum(d);
        if (lane == 0) Sm[pid] = (s <= t) ? d * __expf(gl[4 + s] - gl[8 + t]) : 0.f; }
    if (wid < 4) { const float* n0 = FP_state_n + (size_t)u * 128; float d = n0[lane] * qs[wid * 128 + lane] + n0[64 + lane] * qs[wid * 128 + 64 + lane]; d = wave_sum(d); if (lane == 0) nq[wid] = d; }
    { const int vrow = tid >> 2, dq = tid & 3;
      const float* c0 = FP_state_C + ((size_t)u * 128 + vrow) * 128 + 32 * dq; float* co = FP_out + OFF_CS + ((size_t)u * 128 + vrow) * 128 + 32 * dq;
      f32x4 cv[8];
#pragma unroll
      for (int i = 0; i < 8; ++i) cv[i] = *(const f32x4*)(c0 + 4 * i);
      float ps[4]; float coef[4];
      ps[0] = 0.f; ps[1] = 0.f; ps[2] = 0.f; ps[3] = 0.f;
      coef[0] = wend0 * vs[vrow]; coef[1] = wend1 * vs[128 + vrow]; coef[2] = wend2 * vs[256 + vrow]; coef[3] = wend3 * vs[384 + vrow];
#pragma unroll
      for (int i = 0; i < 8; ++i) { f32x4 cn = cv[i] * decay;
#pragma unroll
          for (int t = 0; t < 4; ++t) { const f32x4 qv = *(const LAS f32x4*)(qs + t * 128 + 32 * dq + 4 * i), kv = *(const LAS f32x4*)(ks + t * 128 + 32 * dq + 4 * i);
              ps[t] += (cv[i].x * qv.x + cv[i].y * qv.y) + (cv[i].z * qv.z + cv[i].w * qv.w); cn += kv * coef[t]; }
          *(f32x4*)(co + 4 * i) = cn; }
#pragma unroll
      for (int t = 0; t < 4; ++t) { ps[t] += __shfl_xor(ps[t], 1); ps[t] += __shfl_xor(ps[t], 2); if (dq == 0) numI[t * 128 + vrow] = ps[t]; } }
    WG_BAR();
    { const int t = tid >> 7, v = tid & 127;
      const float it = gl[12 + t], mtt = gl[16 + t];
      float num = it * numI[tid], den = it * nq[t];
#pragma unroll
      for (int s = 0; s < 4; ++s) { const float sv = Sm[t * 4 + s]; num += sv * vs[s * 128 + v]; den += sv; }
      const float hval = num / fmaxf(fabsf(den), __expf(-mtt));
      const float ssw = wave_sum(hval * hval); if (lane == 0) red[wid] = ssw;
      WG_BAR();
      const float rms = rsqrtf((red[2 * t] + red[2 * t + 1]) * (1.f / 128.f) + EPS);
      const float mo = bf2f(FP_Z[zbase(ZO + h * 128 + v) + (size_t)(mrow + t) * ZR]);
      FP_HMD[(size_t)(mrow + t) * 1024 + h * 128 + v] = f2bf(hval * rms * FP_g_mlstm[h * 128 + v] * sigmoidf_(mo));
      if (tid < 128) { const float n0v = FP_state_n[(size_t)u * 128 + tid]; float nn = decay * n0v;
          nn += wend0 * ks[tid] + wend1 * ks[128 + tid] + wend2 * ks[256 + tid] + wend3 * ks[384 + tid];
          FP_out[OFF_NS + (size_t)u * 128 + tid] = nn; }
      if (tid == 0) FP_out[OFF_MS + u] = m_end; }
    WG_BAR();
}
__device__ __forceinline__ void mlstm_scan_item(const Frame& F, int item) {
    const int tid = FTID(F), bh = item >> 5, j = item & 31, e = 512 * j + tid; const bool nthr = (j == 0 && tid < 128);
    float C = 0.f, m = 0.f, nacc = 0.f;
    const float* Ub = FP_U + (size_t)bh * NCH * 16384 + e; bf16_t* Cp = FP_CPREV + (size_t)bh * NCH * 16384 + e;
    for (int c0 = 0; c0 < NCH; c0 += 32) {
        float uu[32], un[32];
#pragma unroll
        for (int i = 0; i < 32; ++i) { uu[i] = Ub[(size_t)(c0 + i) * 16384]; un[i] = nthr ? FP_NU[(size_t)(bh * NCH + c0 + i) * 128 + tid] : 0.f; }
#pragma unroll
        for (int i = 0; i < 32; ++i) { const int c = c0 + i; const float fs = FP_ST[2 * (bh * NCH + c)], ml = FP_ST[2 * (bh * NCH + c) + 1];
            Cp[(size_t)c * 16384] = f2bf(C);
            if (nthr) FP_NPREV[(size_t)(bh * NCH + c) * 128 + tid] = nacc;
            if (j == 0 && tid == 0) FP_MPREV[bh * NCH + c] = m;
            const float mn = fs + fmaxf(m, ml), dec = __expf(fs + m - mn), sc = __expf(fs + ml - mn);
            C = dec * C + sc * uu[i]; nacc = dec * nacc + sc * un[i]; m = mn; }
    }
    FP_out[OFF_CP + (size_t)bh * 16384 + e] = C;
    if (nthr) FP_out[OFF_NP + bh * 128 + tid] = nacc;
    if (j == 0 && tid == 0) FP_out[OFF_MP + bh] = m;
}
__device__ __forceinline__ void glds16(const void* gsrc, unsigned lds_dst);
__device__ __forceinline__ void mlstm_C_group(const Frame& F, int grp) {
    const int tid_ = FTID(F);
    const int lane = tid_ & 63, wid = F.wave, r32 = lane & 31, hi = lane >> 5, ci = wid >> 2, tt = wid & 3;
    const int u = 2 * grp + ci, bh = u / NCH, c = u % NCH, b = bh >> 2, h = bh & 3, m0 = b * TP + c * CH;
    LAS unsigned char* Vt = F.lds + ci * 32768;
    LAS float* Fa = (LAS float*)(F.lds + 65536 + wid * 2048); LAS float* aa = Fa + 128; LAS float* Aa = aa + 128;
    {
        const unsigned lds0 = (unsigned)(uintptr_t)Vt;
#pragma unroll
        for (int k = 0; k < 8; ++k) { const int bb = 8 * tt + k, c4 = bb >> 3, kg = bb & 7;
            glds16(FP_Z + zbase(ZV + h * 128 + c4 * 32 + (lane & 3) * 8) + (size_t)(m0 + kg * 16 + (lane >> 2)) * ZR, (unsigned)__builtin_amdgcn_readfirstlane(lds0 + bb * 1024)); }
    }
    {
        float F1, F2, a1, a2, A1, A2; chunk_scan(F, m0, h, lane, F1, F2, a1, a2, A1, A2);
        Fa[lane] = F1; Fa[64 + lane] = F2; aa[lane] = a1; aa[64 + lane] = a2; Aa[lane] = A1; Aa[64 + lane] = A2;
    }
    const int t = 32 * tt + r32;
    const float mprev = FP_MPREV[u];
    bf16x8 qf[8];
    { const bf16_t* qp = FP_Z + zbase(ZQ + h * 128 + 8 * hi) + (size_t)(m0 + t) * ZR;
#pragma unroll
      for (int st = 0; st < 8; ++st) qf[st] = *(const bf16x8*)(qp + 16 * st); }
    const float Ft = Fa[t], At = Aa[t], mxt = fmaxf(mprev, At), mt = Ft + mxt, inter = __expf(mprev - mxt);
    float dq = 0.f;
    { const float* np = FP_NPREV + (size_t)u * 128 + 8 * hi;
#pragma unroll
      for (int st = 0; st < 8; ++st) { const f32x4 n0 = *(const f32x4*)(np + 16 * st), n1 = *(const f32x4*)(np + 16 * st + 4); f32x4 q0, q1; unpack8(__builtin_bit_cast(u32x4, qf[st]), q0, q1);
          dq += (q0.x * n0.x + q0.y * n0.y) + (q0.z * n0.z + q0.w * n0.w) + (q1.x * n1.x + q1.y * n1.y) + (q1.z * n1.z + q1.w * n1.w); } }
    dq += __shfl_xor(dq, 32);
    f32x16 acc[4];
#pragma unroll
    for (int vt = 0; vt < 4; ++vt) { for (int i = 0; i < 16; ++i) acc[vt][i] = 0.f;
        const bf16_t* cp = FP_CPREV + (size_t)u * 16384 + (size_t)(32 * vt + r32) * 128 + 8 * hi;
#pragma unroll
        for (int st = 0; st < 8; ++st) acc[vt] = MFMA32(*(const bf16x8*)(cp + 16 * st), qf[st], acc[vt]);
#pragma unroll
        for (int i = 0; i < 16; ++i) acc[vt][i] *= inter; }
    asm volatile("s_waitcnt vmcnt(0) lgkmcnt(0)\n\ts_barrier" ::: "memory");
    float den = 0.f;
    const int vh = (lane >> 4) & 1, q4 = (lane & 15) >> 2, p = lane & 3;
    const int vlane = (4 * hi + q4) * 64 + (16 * vh + 4 * p) * 2;
    for (int sub = 0; sub <= tt; ++sub) {
        f32x16 sacc; for (int i = 0; i < 16; ++i) sacc[i] = 0.f;
        { const bf16_t* kp = FP_Z + zbase(ZK + h * 128 + 8 * hi) + (size_t)(m0 + 32 * sub + r32) * ZR;
#pragma unroll
          for (int st = 0; st < 8; ++st) sacc = MFMA32(*(const bf16x8*)(kp + 16 * st), qf[st], sacc); }
#pragma unroll
        for (int g = 0; g < 4; ++g) { const f32x4 av = *(const LAS f32x4*)(aa + 32 * sub + 8 * g + 4 * hi);
#pragma unroll
            for (int k = 0; k < 4; ++k) { const int sidx = 32 * sub + 8 * g + 4 * hi + k; const float wgt = (sidx <= t) ? __expf(av[k] - mxt) : 0.f; const float val = (sidx <= t) ? sacc[4 * g + k] * wgt : 0.f; sacc[4 * g + k] = val; den += val; } }
#pragma unroll
        for (int s2 = 0; s2 < 2; ++s2) {
            const bf16x8 pb = pack8((f32x4){sacc[8 * s2], sacc[8 * s2 + 1], sacc[8 * s2 + 2], sacc[8 * s2 + 3]}, (f32x4){sacc[8 * s2 + 4], sacc[8 * s2 + 5], sacc[8 * s2 + 6], sacc[8 * s2 + 7]});
            const LAS unsigned char* va = Vt + vlane + (2 * sub + s2) * 1024;
#pragma unroll
            for (int vt = 0; vt < 4; ++vt) acc[vt] = MFMA32(cat4(tr_rd(va + vt * 8192), tr_rd(va + vt * 8192 + 512)), pb, acc[vt]);
        }
    }
    den += __shfl_xor(den, 32);
    den += inter * dq;
    const float rden = 1.f / fmaxf(fabsf(den), __expf(-mt));
    float ss = 0.f;
#pragma unroll
    for (int vt = 0; vt < 4; ++vt) for (int i = 0; i < 16; ++i) { acc[vt][i] *= rden; ss += acc[vt][i] * acc[vt][i]; }
    ss += __shfl_xor(ss, 32);
    const float rms = rsqrtf(ss * (1.f / 128.f) + EPS);
#pragma unroll
    for (int vt = 0; vt < 4; ++vt)
#pragma unroll
        for (int g = 0; g < 4; ++g) { const int v = 32 * vt + 8 * g + 4 * hi;
            const f32x4 gv = *(const f32x4*)(FP_g_mlstm + h * 128 + v); const u32x2 mo = *(const u32x2*)(FP_Z + zbase(ZO + h * 128 + v) + (size_t)(m0 + t) * ZR);
            u32x2 o; o.x = pk2(acc[vt][4 * g] * rms * gv.x * sigmoidf_(bflo(mo.x)), acc[vt][4 * g + 1] * rms * gv.y * sigmoidf_(bfhi(mo.x)));
            o.y = pk2(acc[vt][4 * g + 2] * rms * gv.z * sigmoidf_(bflo(mo.y)), acc[vt][4 * g + 3] * rms * gv.w * sigmoidf_(bfhi(mo.y)));
            *(u32x2*)(FP_HMD + (size_t)(m0 + t) * 1024 + h * 128 + v) = o; }
    asm volatile("s_waitcnt lgkmcnt(0)\n\ts_barrier" ::: "memory");
}
constexpr int AT_SLOT = 24576, AT_VOFF = 8192, AT_NSLOT = 4;
constexpr float AT_THR = 8.f;
__device__ __forceinline__ void glds16(const void* gsrc, unsigned lds_dst) { unsigned keep;
    asm volatile("s_mov_b32 %0, m0\n\ts_mov_b32 m0, %2\n\ts_nop 0\n\tglobal_load_lds_dwordx4 %1, off\n\ts_mov_b32 m0, %0" : "=&s"(keep) : "v"(gsrc), "s"(lds_dst) : "memory"); }
__device__ __forceinline__ float max3f(float a, float b, float c) { float r; asm("v_max3_f32 %0, %1, %2, %3" : "=v"(r) : "v"(a), "v"(b), "v"(c)); return r; }
#define AT_WAIT_BAR(N) asm volatile("s_waitcnt vmcnt(" #N ") lgkmcnt(0)\n\ts_barrier" ::: "memory")
__device__ __forceinline__ void attn_half_unit(const Frame& F, int bh, int qb, int map, bf16_t* Odst) {
    const int tid_ = FTID(F);
    const int b = bh >> 2, h = bh & 3, lane = tid_ & 63, wid = F.wave, r32 = lane & 31, hi = lane >> 5;
    const int rowbase = b * TP, q0 = qb * 256, qrow = q0 + 32 * wid + r32;
    const bf16_t* Zb = FP_Z + (size_t)rowbase * ZR;
    const unsigned lds0 = (unsigned)(uintptr_t)F.lds;
    const bf16_t* ksrc = Zb + zbase(ZDK + h * 128 + map * 64 + wid * 8) + (size_t)lane * ZR;
    const bf16_t* vsrc0 = Zb + zbase(ZDV + h * 128 + ((2 * wid) >> 2) * 32 + (lane & 3) * 8) + (size_t)(((2 * wid) & 3) * 16 + (lane >> 2)) * ZR;
    const bf16_t* vsrc1 = vsrc0 + (size_t)16 * ZR;
    const unsigned kdst = lds0 + wid * 1024, vdst = lds0 + AT_VOFF + 2 * wid * 1024;
#define AT_DMA(t, slot) do { const size_t adv_ = (size_t)(t) * 64 * ZR; const unsigned so_ = (unsigned)(slot) * AT_SLOT; \
        glds16(ksrc + adv_, (unsigned)__builtin_amdgcn_readfirstlane(kdst + so_)); glds16(vsrc0 + adv_, (unsigned)__builtin_amdgcn_readfirstlane(vdst + so_)); \
        glds16(vsrc1 + adv_, (unsigned)__builtin_amdgcn_readfirstlane(vdst + so_ + 1024u)); } while (0)
    bf16x8 qf[4];
    { const bf16_t* qp = Zb + zbase(ZDQ + h * 128 + map * 64 + 8 * hi) + (size_t)qrow * ZR;
#pragma unroll
      for (int st = 0; st < 4; ++st) qf[st] = *(const bf16x8*)(qp + 16 * st); }
    const int NT = 4 * qb + 4;
    AT_DMA(0, 0); AT_DMA(1, 1); AT_DMA(2, 2);
    f32x16 o[4];
#pragma unroll
    for (int vt = 0; vt < 4; ++vt) for (int i = 0; i < 16; ++i) o[vt][i] = 0.f;
    f32x16 negm; for (int i = 0; i < 16; ++i) negm[i] = 0.f;
    float mhat = 0.f, lrun = 0.f;
    const int vh = (lane >> 4) & 1, q4 = (lane & 15) >> 2, p = lane & 3;
    const int vlane = AT_VOFF + (4 * hi + q4) * 64 + (16 * vh + 4 * p) * 2;
    const int klane = hi * 1024 + r32 * 16;
    const int wlast = q0 + 32 * wid + 31, wfirst = q0 + 32 * wid;
#define AT_SCHED() __builtin_amdgcn_sched_barrier(0)
#define AT_KRD(i0, kbase) do { kf[i0] = *(const LAS bf16x8*)((kbase) + ((i0) >> 1) * 2048 + ((i0) & 1) * 512); kf[(i0) + 1] = *(const LAS bf16x8*)((kbase) + (((i0) + 1) >> 1) * 2048 + (((i0) + 1) & 1) * 512); } while (0)
#define AT_VRD(dst, g, vbase) do { _Pragma("unroll") for (int vt = 0; vt < 4; ++vt) dst[vt] = cat4(tr_rd((vbase) + (g) * 1024 + vt * 4096), tr_rd((vbase) + (g) * 1024 + vt * 4096 + 512)); } while (0)
#define AT_PB(g) (((g) >> 1) == 0 ? pack8((f32x4){p0[8 * ((g) & 1)], p0[8 * ((g) & 1) + 1], p0[8 * ((g) & 1) + 2], p0[8 * ((g) & 1) + 3]}, (f32x4){p0[8 * ((g) & 1) + 4], p0[8 * ((g) & 1) + 5], p0[8 * ((g) & 1) + 6], p0[8 * ((g) & 1) + 7]}) \
                                  : pack8((f32x4){p1[8 * ((g) & 1)], p1[8 * ((g) & 1) + 1], p1[8 * ((g) & 1) + 2], p1[8 * ((g) & 1) + 3]}, (f32x4){p1[8 * ((g) & 1) + 4], p1[8 * ((g) & 1) + 5], p1[8 * ((g) & 1) + 6], p1[8 * ((g) & 1) + 7]}))
#define AT_PV(src, g) do { const bf16x8 pb_ = AT_PB(g); _Pragma("unroll") for (int vt = 0; vt < 4; ++vt) o[vt] = MFMA32(src[vt], pb_, o[vt]); } while (0)
    AT_WAIT_BAR(3);
    bf16x8 kf[8];
    { const LAS unsigned char* kb = F.lds + klane; AT_KRD(0, kb); AT_KRD(2, kb); AT_KRD(4, kb); AT_KRD(6, kb); }
    int slot = 0, slot1 = 1, slot3 = 3;
    for (int j = 0; j < NT; ++j) {
        if (j + 3 < NT) AT_DMA(j + 3, slot3);
        if (64 * j <= wlast) {
            const LAS unsigned char* vb = F.lds + slot * AT_SLOT + vlane;
            const LAS unsigned char* kn = F.lds + slot1 * AT_SLOT + klane;
            const bool knext = (j + 1 < NT);
            f32x16 p0 = MFMA32(kf[0], qf[0], negm), p1 = MFMA32(kf[1], qf[0], negm);
#pragma unroll
            for (int st = 1; st < 4; ++st) { p0 = MFMA32(kf[2 * st], qf[st], p0); p1 = MFMA32(kf[2 * st + 1], qf[st], p1); }
            AT_SCHED();
            bf16x8 vfA[4], vfB[4];
            AT_VRD(vfA, 0, vb);
            AT_SCHED();
            if (64 * j + 63 > wfirst) {
#pragma unroll
                for (int i = 0; i < 16; ++i) { const int key = 64 * j + crow(i, hi); if (key > qrow) p0[i] = -INFINITY; if (key + 32 > qrow) p1[i] = -INFINITY; }
            }
            asm volatile("s_nop 15\n\ts_nop 7" : "+v"(p0), "+v"(p1));
            float mx = max3f(p0[0], p1[0], p0[1]), mx2 = max3f(p1[1], p0[2], p1[2]);
#pragma unroll
            for (int i = 3; i < 15; i += 2) { mx = max3f(mx, p0[i], p1[i]); mx2 = max3f(mx2, p0[i + 1], p1[i + 1]); }
            mx = max3f(mx, p0[15], p1[15]); mx = fmaxf(mx, mx2);
            mx = fmaxf(mx, __shfl_xor(mx, 32));
            if (j == 0 || __any(mx > AT_THR)) {
                const float dl = (j == 0) ? mx : fmaxf(mx, 0.f), f = __builtin_amdgcn_exp2f(-dl);
                mhat += dl; lrun *= f;
#pragma unroll
                for (int i = 0; i < 16; ++i) { p0[i] -= dl; p1[i] -= dl; negm[i] = -mhat; }
#pragma unroll
                for (int vt = 0; vt < 4; ++vt) for (int i = 0; i < 16; ++i) o[vt][i] *= f;
            }
            float rsum = 0.f;
#pragma unroll
            for (int i = 0; i < 16; ++i) { p0[i] = __builtin_amdgcn_exp2f(p0[i]); p1[i] = __builtin_amdgcn_exp2f(p1[i]); rsum += p0[i] + p1[i]; }
            lrun += rsum;
            AT_SCHED();
            AT_VRD(vfB, 1, vb); if (knext) AT_KRD(0, kn); AT_SCHED(); AT_PV(vfA, 0); AT_SCHED();
            AT_VRD(vfA, 2, vb); if (knext) AT_KRD(2, kn); AT_SCHED(); AT_PV(vfB, 1); AT_SCHED();
            AT_VRD(vfB, 3, vb); if (knext) AT_KRD(4, kn); AT_SCHED(); AT_PV(vfA, 2); AT_SCHED();
            if (knext) AT_KRD(6, kn); AT_SCHED(); AT_PV(vfB, 3); AT_SCHED();
        }
        if (j + 3 < NT) AT_WAIT_BAR(3); else AT_WAIT_BAR(0);
        slot = slot1; slot1 = (slot1 == AT_NSLOT - 1) ? 0 : slot1 + 1; slot3 = (slot3 == AT_NSLOT - 1) ? 0 : slot3 + 1;
    }
#undef AT_SCHED
#undef AT_KRD
#undef AT_VRD
#undef AT_PB
#undef AT_PV
    lrun += __shfl_xor(lrun, 32);
    const float rl = 1.f / lrun;
    bf16_t* op = Odst + (size_t)(rowbase + qrow) * 512 + h * 128 + 4 * hi;
#pragma unroll
    for (int vt = 0; vt < 4; ++vt)
#pragma unroll
        for (int g = 0; g < 4; ++g) { u32x2 w; w.x = pk2(o[vt][4 * g] * rl, o[vt][4 * g + 1] * rl); w.y = pk2(o[vt][4 * g + 2] * rl, o[vt][4 * g + 3] * rl); *(u32x2*)(op + 32 * vt + 8 * g) = w; }
    AT_WAIT_BAR(0);
#undef AT_DMA
}
__device__ __forceinline__ float lambda_full(const Frame& F, int lane) {
    const float a = wave_sum(FP_lq1[lane] * FP_lk1[lane]), b = wave_sum(FP_lq2[lane] * FP_lk2[lane]);
    return __expf(a) - __expf(b) + LAM_INIT;
}
__device__ __forceinline__ void attn_combine_rows(const Frame& F) {
    const int lane = lane_id(), gw = F.vcu * NWAVES + F.wave, NGW = F.G * NWAVES;
    const float lam = lambda_full(F, lane);
    const f32x4 g0 = *(const f32x4*)(FP_g_diff + 8 * lane), g1 = *(const f32x4*)(FP_g_diff + 8 * lane + 4);
    for (int m = gw; m < MP; m += NGW) {
        f32x4 a0, a1, b0, b1; unpack8(*(const u32x4*)(FP_O1 + (size_t)m * 512 + 8 * lane), a0, a1); unpack8(*(const u32x4*)(FP_O2 + (size_t)m * 512 + 8 * lane), b0, b1);
        const f32x4 x0 = a0 - b0 * lam, x1 = a1 - b1 * lam;
        float ss = (x0.x * x0.x + x0.y * x0.y) + (x0.z * x0.z + x0.w * x0.w) + (x1.x * x1.x + x1.y * x1.y) + (x1.z * x1.z + x1.w * x1.w);
        ss += __shfl_xor(ss, 1); ss += __shfl_xor(ss, 2); ss += __shfl_xor(ss, 4); ss += __shfl_xor(ss, 8);
        const float rms = rsqrtf(ss * (1.f / 128.f) + EPS) * (1.f - LAM_INIT);
        *(bf16x8*)(FP_HMD + (size_t)m * 1024 + 512 + 8 * lane) = pack8(x0 * rms * g0, x1 * rms * g1);
    }
}
constexpr int SB_P = 264;
constexpr int DPART = 1040;
__device__ __forceinline__ void decode_unit(const Frame& F, int u) {
    const int tid_ = FTID(F);
    const int n = u >> 2, blk = u & 3, lane = tid_ & 63, wid = F.wave, h = wid & 3, qt = wid >> 2;
    const int mrow = MP + 4 * n;
    LAS float* Sb = (LAS float*)(F.lds + wid * 8704);
    LAS float* fac = Sb + 8 * SB_P;
    const int* pt = FP_page_table + n * NPAGES + 4 * blk + 2 * qt;
    const int c16 = lane & 15, g = lane >> 4, hh = lane >> 5, l5 = lane & 31, scol = lane >> 3, sseg = lane & 7;
    bf16x8 bq[4];
#pragma unroll
    for (int st = 0; st < 4; ++st) { const bool ok = (c16 < 4 && st < 2) || (c16 >= 4 && c16 < 8 && st >= 2);
        const bf16x8 v = *(const bf16x8*)(FP_Z + zbase(ZDQ + h * 128 + 32 * st + 8 * g) + (size_t)(mrow + (c16 & 3)) * ZR);
        const bf16x8 zz = {0, 0, 0, 0, 0, 0, 0, 0}; bq[st] = ok ? v : zz; }
    const char* vpool = (const char*)FP_cache_v; const char* kpool = (const char*)FP_cache_k;
    const unsigned voff = (((unsigned)pt[hh] * PAGE) * 4u + (unsigned)h) * 512u + 16u * (unsigned)l5;
#define NTL(p) (*(const f32x4*)(p))
#define VLD(row) NTL(vpool + (voff + 2048u * (unsigned)(row)))
    f32x4 va[8], vb[8];
    {
        const unsigned ko0 = (((unsigned)pt[0] * PAGE + (unsigned)c16) * 4u + (unsigned)h) * 512u + 32u * (unsigned)g;
        const unsigned ko1 = (((unsigned)pt[1] * PAGE + (unsigned)c16) * 4u + (unsigned)h) * 512u + 32u * (unsigned)g;
        f32x4 ka[16], kb[16];
#define KLOAD(dst, ti) do { const unsigned ko_ = (((ti) < 8) ? ko0 : ko1) + 32768u * (unsigned)((ti) & 7); \
            _Pragma("unroll") for (int st = 0; st < 4; ++st) { dst[2 * st] = NTL(kpool + (ko_ + 128u * st)); dst[2 * st + 1] = NTL(kpool + (ko_ + 128u * st + 16u)); } } while (0)
#define KTILE(src, ti) do { f32x4 acc_ = {0.f, 0.f, 0.f, 0.f}; \
            _Pragma("unroll") for (int st = 0; st < 4; ++st) acc_ = MFMA16(pack8(src[2 * st], src[2 * st + 1]), bq[st], acc_); \
            if (c16 < 8) *(LAS f32x4*)(Sb + c16 * SB_P + 16 * (ti) + 4 * g) = acc_; } while (0)
        KLOAD(ka, 0); KLOAD((ka + 8), 1); KLOAD(kb, 2); KLOAD((kb + 8), 3);
        for (int ip = 0; ip < 12; ip += 4) {
            KTILE(ka, ip); KTILE((ka + 8), ip + 1); KLOAD(ka, ip + 4); KLOAD((ka + 8), ip + 5);
            KTILE(kb, ip + 2); KTILE((kb + 8), ip + 3); KLOAD(kb, ip + 6); KLOAD((kb + 8), ip + 7);
        }
        KTILE(ka, 12); KTILE((ka + 8), 13);
#pragma unroll
        for (int kk = 0; kk < 8; ++kk) va[kk] = VLD(kk);
        KTILE(kb, 14); KTILE((kb + 8), 15);
#pragma unroll
        for (int kk = 0; kk < 8; ++kk) vb[kk] = VLD(8 + kk);
#undef KLOAD
#undef KTILE
    }
    {
        LAS float* sp = Sb + scol * SB_P + 32 * sseg;
        f32x4 sv[8]; float mx = -INFINITY;
#pragma unroll
        for (int i = 0; i < 8; ++i) { sv[i] = *(const LAS f32x4*)(sp + 4 * i); mx = fmaxf(fmaxf(mx, fmaxf(sv[i].x, sv[i].y)), fmaxf(sv[i].z, sv[i].w)); }
        mx = fmaxf(mx, __shfl_xor(mx, 1)); mx = fmaxf(mx, __shfl_xor(mx, 2)); mx = fmaxf(mx, __shfl_xor(mx, 4));
        float ls = 0.f;
#pragma unroll
        for (int i = 0; i < 8; ++i) { f32x4 pv; pv.x = __builtin_amdgcn_exp2f(sv[i].x - mx); pv.y = __builtin_amdgcn_exp2f(sv[i].y - mx); pv.z = __builtin_amdgcn_exp2f(sv[i].z - mx); pv.w = __builtin_amdgcn_exp2f(sv[i].w - mx);
            ls += (pv.x + pv.y) + (pv.z + pv.w); *(LAS f32x4*)(sp + 4 * i) = pv; }
        ls += __shfl_xor(ls, 1); ls += __shfl_xor(ls, 2); ls += __shfl_xor(ls, 4);
        if (sseg == 0) { fac[scol] = mx; fac[8 + scol] = ls; }
    }
    {
        const LAS float* pbase = Sb + 128 * hh;
        f32x4 acc[8];
#pragma unroll
        for (int c = 0; c < 8; ++c) acc[c] = (f32x4){0.f, 0.f, 0.f, 0.f};
#define VSTEP(buf, t8) do { f32x4 vc_[8]; _Pragma("unroll") for (int kk = 0; kk < 8; ++kk) vc_[kk] = buf[kk]; \
            if ((t8) + 2 < 16) { _Pragma("unroll") for (int kk = 0; kk < 8; ++kk) buf[kk] = VLD(8 * ((t8) + 2) + kk); } \
            _Pragma("unroll") for (int c = 0; c < 8; ++c) { const f32x4 p0_ = *(const LAS f32x4*)(pbase + c * SB_P + 8 * (t8)), p1_ = *(const LAS f32x4*)(pbase + c * SB_P + 8 * (t8) + 4); \
                acc[c] += vc_[0] * p0_.x + vc_[1] * p0_.y + vc_[2] * p0_.z + vc_[3] * p0_.w + vc_[4] * p1_.x + vc_[5] * p1_.y + vc_[6] * p1_.z + vc_[7] * p1_.w; } } while (0)
        for (int t8 = 0; t8 < 16; t8 += 2) { VSTEP(va, t8); VSTEP(vb, t8 + 1); }
#undef VSTEP
        float* po = FP_DPART + ((size_t)(n * 4 + h) * 8 + (2 * blk + qt)) * DPART;
#pragma unroll
        for (int c = 0; c < 8; ++c) { acc[c].x += __shfl_xor(acc[c].x, 32); acc[c].y += __shfl_xor(acc[c].y, 32); acc[c].z += __shfl_xor(acc[c].z, 32); acc[c].w += __shfl_xor(acc[c].w, 32);
            if (hh == 0) *(f32x4*)(po + c * 128 + 4 * l5) = acc[c]; }
        if (lane < 16) po[1024 + lane] = fac[lane];
    }
#undef VLD
#undef NTL
}
__device__ __forceinline__ void decode_merge(const Frame& F, int u, float lam) {
    const int n = u >> 2, h = u & 3, lane = lane_id(), wid = F.wave, tid = wid * 64 + lane;
    const int mrow = MP + 4 * n;
    LAS float* Sn = (LAS float*)F.lds;
    LAS float* wgt = Sn + 32;
    LAS float* en = wgt + 64;
    LAS float* rlv = en + 32;
    LAS float* red = rlv + 8;
    const float* pp = FP_DPART + (size_t)u * 8 * DPART;
    if (wid == 0) {
        const int c16 = lane & 15, g = lane >> 4;
        f32x4 acc = {0.f, 0.f, 0.f, 0.f};
#pragma unroll
        for (int st = 0; st < 4; ++st) { const bool ok = (c16 < 4 && st < 2) || (c16 >= 4 && c16 < 8 && st >= 2);
            const bf16x8 zz = {0, 0, 0, 0, 0, 0, 0, 0};
            const bf16x8 qv = *(const bf16x8*)(FP_Z + zbase(ZDQ + h * 128 + 32 * st + 8 * g) + (size_t)(mrow + (c16 & 3)) * ZR);
            const bf16x8 kv = *(const bf16x8*)(FP_Z + zbase(ZDK + h * 128 + 32 * st + 8 * g) + (size_t)(mrow + (c16 & 3)) * ZR);
            const bf16x8 bqv = ok ? qv : zz, akv = (c16 < 4) ? kv : zz; acc = MFMA16(akv, bqv, acc); }
        if (g == 0 && c16 < 8) { const int t = c16 & 3; f32x4 m;
            m.x = acc.x; m.y = (1 <= t) ? acc.y : -INFINITY; m.z = (2 <= t) ? acc.z : -INFINITY; m.w = (3 <= t) ? acc.w : -INFINITY;
            *(LAS f32x4*)(Sn + 4 * c16) = m; }
    }
    WG_BAR();
    if (tid < 8) { const int c = tid; const f32x4 sn = *(const LAS f32x4*)(Sn + 4 * c);
        float mi[8]; float M = fmaxf(fmaxf(sn.x, sn.y), fmaxf(sn.z, sn.w));
#pragma unroll
        for (int i = 0; i < 8; ++i) { mi[i] = pp[i * DPART + 1024 + c]; M = fmaxf(M, mi[i]); }
        const f32x4 e = {__builtin_amdgcn_exp2f(sn.x - M), __builtin_amdgcn_exp2f(sn.y - M), __builtin_amdgcn_exp2f(sn.z - M), __builtin_amdgcn_exp2f(sn.w - M)};
        float L = (e.x + e.y) + (e.z + e.w);
#pragma unroll
        for (int i = 0; i < 8; ++i) { const float w = __builtin_amdgcn_exp2f(mi[i] - M); wgt[8 * i + c] = w; L += w * pp[i * DPART + 1032 + c]; }
        *(LAS f32x4*)(en + 4 * c) = e; rlv[c] = 1.f / L; }
    WG_BAR();
    { const int t = tid >> 7, v = tid & 127; float o1 = 0.f, o2 = 0.f;
#pragma unroll
      for (int i = 0; i < 8; ++i) { o1 += wgt[8 * i + t] * pp[i * DPART + t * 128 + v]; o2 += wgt[8 * i + 4 + t] * pp[i * DPART + (4 + t) * 128 + v]; }
#pragma unroll
      for (int sx = 0; sx < 4; ++sx) { const float vn = bf2f(FP_Z[zbase(ZDV + h * 128 + v) + (size_t)(mrow + sx) * ZR]); o1 += en[4 * t + sx] * vn; o2 += en[4 * (4 + t) + sx] * vn; }
      const float ov = o1 * rlv[t] - lam * o2 * rlv[4 + t];
      const float ssw = wave_sum(ov * ov); if (lane == 0) red[wid] = ssw;
      WG_BAR();
      const float rms = rsqrtf((red[2 * t] + red[2 * t + 1]) * (1.f / 128.f) + EPS) * (1.f - LAM_INIT);
      FP_HMD[(size_t)(mrow + t) * 1024 + 512 + h * 128 + v] = f2bf(ov * rms * FP_g_diff[h * 128 + v]); }
    WG_BAR();
}
__device__ __forceinline__ void rows_post_mix(const Frame& F) {
    const int lane = lane_id(), gw = F.vcu * NWAVES + F.wave, NGW = F.G * NWAVES;
    const int r_lo = (int)(((long)gw * MT) / NGW), r_hi = (int)(((long)(gw + 1) * MT) / NGW);
    f32x4 gpm[4], gpf[4], g1[4], sh2[4], sc2[4], yn[4], xn[4];
#pragma unroll
    for (int j = 0; j < 4; ++j) { gpm[j] = *(const f32x4*)(FP_g_post_mix + 4 * lane + 256 * j); gpf[j] = *(const f32x4*)(FP_g_pre_ffn + 4 * lane + 256 * j); g1[j] = gpm[j]; sh2[j] = gpm[j]; sc2[j] = gpm[j]; yn[j] = gpm[j]; xn[j] = gpm[j]; }
    int ccur = -1;
    if (r_lo < r_hi) { const float* xr = xrow_of(F, r_lo); const bf16_t* yr = FP_Y + (size_t)r_lo * DM;
#pragma unroll
        for (int j = 0; j < 4; ++j) { { const u32x2 yy = *(const u32x2*)(yr + 4 * lane + 256 * j); yn[j] = (f32x4){bflo(yy.x), bfhi(yy.x), bflo(yy.y), bfhi(yy.y)}; } xn[j] = *(const f32x4*)(xr + 4 * lane + 256 * j); } }
    for (int m = r_lo; m < r_hi; ++m) {
        f32x4 y[4], x1[4]; float ss = 0.f;
#pragma unroll
        for (int j = 0; j < 4; ++j) { y[j] = yn[j]; x1[j] = xn[j]; }
        if (m + 1 < r_hi) { const float* xr = xrow_of(F, m + 1); const bf16_t* yr = FP_Y + (size_t)(m + 1) * DM;
#pragma unroll
            for (int j = 0; j < 4; ++j) { { const u32x2 yy = *(const u32x2*)(yr + 4 * lane + 256 * j); yn[j] = (f32x4){bflo(yy.x), bfhi(yy.x), bflo(yy.y), bfhi(yy.y)}; } xn[j] = *(const f32x4*)(xr + 4 * lane + 256 * j); } }
        const int cr = crow_of(m);
        if (cr != ccur) { ccur = cr; const float* ada = FP_ADA + (size_t)cr * 6144;
#pragma unroll
            for (int j = 0; j < 4; ++j) { const int c = 4 * lane + 256 * j; g1[j] = *(const f32x4*)(ada + 2048 + c) * gpm[j]; sh2[j] = *(const f32x4*)(ada + 3072 + c); sc2[j] = (*(const f32x4*)(ada + 4096 + c) + 1.f) * gpf[j]; } }
#pragma unroll
        for (int j = 0; j < 4; ++j) ss += (y[j].x * y[j].x + y[j].y * y[j].y) + (y[j].z * y[j].z + y[j].w * y[j].w);
        const float rs = rsqrtf(wave_sum(ss) * (1.f / DM) + EPS); float s1 = 0.f;
#pragma unroll
        for (int j = 0; j < 4; ++j) { const int c = 4 * lane + 256 * j;
            x1[j] = x1[j] + g1[j] * (y[j] * rs); { u32x2 xo; xo.x = pk2(x1[j].x, x1[j].y); xo.y = pk2(x1[j].z, x1[j].w); *(u32x2*)(FP_X1 + (size_t)m * DM + c) = xo; }
            s1 += (x1[j].x * x1[j].x + x1[j].y * x1[j].y) + (x1[j].z * x1[j].z + x1[j].w * x1[j].w); }
        const float r1 = rsqrtf(wave_sum(s1) * (1.f / DM) + EPS);
#pragma unroll
        for (int j = 0; j < 4; ++j) { const int c = 4 * lane + 256 * j;
            const f32x4 hv = (x1[j] * r1) * sc2[j] + sh2[j]; u32x2 o; o.x = pk2(hv.x, hv.y); o.y = pk2(hv.z, hv.w); *(u32x2*)(FP_H1 + (size_t)m * DM + c) = o; }
    }
}
__device__ __forceinline__ void rows_final(const Frame& F) {
    const int lane = lane_id(), gw = F.vcu * NWAVES + F.wave, NGW = F.G * NWAVES;
    const int r_lo = (int)(((long)gw * MT) / NGW), r_hi = (int)(((long)(gw + 1) * MT) / NGW);
    f32x4 gpf[4], g2[4], yn[4], xn[4];
#pragma unroll
    for (int j = 0; j < 4; ++j) { gpf[j] = *(const f32x4*)(FP_g_post_ffn + 4 * lane + 256 * j); g2[j] = gpf[j]; yn[j] = gpf[j]; xn[j] = gpf[j]; }
    int ccur = -1;
    if (r_lo < r_hi) { const bf16_t* xr = FP_X1 + (size_t)r_lo * DM; const bf16_t* yr = FP_Y + (size_t)r_lo * DM;
#pragma unroll
        for (int j = 0; j < 4; ++j) { { const u32x2 yy = *(const u32x2*)(yr + 4 * lane + 256 * j); yn[j] = (f32x4){bflo(yy.x), bfhi(yy.x), bflo(yy.y), bfhi(yy.y)}; } { const u32x2 xx = *(const u32x2*)(xr + 4 * lane + 256 * j); xn[j] = (f32x4){bflo(xx.x), bfhi(xx.x), bflo(xx.y), bfhi(xx.y)}; } } }
    for (int m = r_lo; m < r_hi; ++m) {
        f32x4 y[4], x1[4]; float ss = 0.f;
#pragma unroll
        for (int j = 0; j < 4; ++j) { y[j] = yn[j]; x1[j] = xn[j]; }
        if (m + 1 < r_hi) { const bf16_t* xr = FP_X1 + (size_t)(m + 1) * DM; const bf16_t* yr = FP_Y + (size_t)(m + 1) * DM;
#pragma unroll
            for (int j = 0; j < 4; ++j) { { const u32x2 yy = *(const u32x2*)(yr + 4 * lane + 256 * j); yn[j] = (f32x4){bflo(yy.x), bfhi(yy.x), bflo(yy.y), bfhi(yy.y)}; } { const u32x2 xx = *(const u32x2*)(xr + 4 * lane + 256 * j); xn[j] = (f32x4){bflo(xx.x), bfhi(xx.x), bflo(xx.y), bfhi(xx.y)}; } } }
        const int cr = crow_of(m);
        if (cr != ccur) { ccur = cr; const float* ada = FP_ADA + (size_t)cr * 6144;
#pragma unroll
            for (int j = 0; j < 4; ++j) g2[j] = *(const f32x4*)(ada + 5120 + 4 * lane + 256 * j) * gpf[j]; }
#pragma unroll
        for (int j = 0; j < 4; ++j) ss += (y[j].x * y[j].x + y[j].y * y[j].y) + (y[j].z * y[j].z + y[j].w * y[j].w);
        const float rs = rsqrtf(wave_sum(ss) * (1.f / DM) + EPS);
#pragma unroll
        for (int j = 0; j < 4; ++j) *(f32x4*)(FP_out + OFF_Y + (size_t)m * DM + 4 * lane + 256 * j) = x1[j] + g2[j] * (y[j] * rs);
    }
}
__device__ __forceinline__ void attention_phase(const Frame& F, volatile LAS unsigned* MISC) {
    unsigned* ctl = (unsigned*)(F.a->ws + WS_CTL) + CW_SCHED;
    const int xq = (F.vcu * 8) / F.G;
    for (;;) {
        if (FTID(F) == 0) {
            int kind = -1; unsigned idx = 0u;
            unsigned* QD = ctl + 64 * 8; unsigned* NS = ctl + 64 * (9 + xq);
            if (xb_ld(QD) < 512u) { const unsigned sn = xb_add(NS, 1u);
                if (sn < (unsigned)DEC_LIM8) { const unsigned d = xb_add(QD, 1u); if (d < 512u) { kind = 1; idx = d; } }
                if (kind < 0) (void)__hip_atomic_fetch_sub(NS, 1u, __ATOMIC_RELAXED, __HIP_MEMORY_SCOPE_AGENT); }
            for (int k = 0; k < 8 && kind < 0; ++k) { const int x = (xq + k) & 7; unsigned* QP = ctl + 64 * x;
                if (xb_ld(QP) < 64u) { const unsigned p = xb_add(QP, 1u); if (p < 64u) { kind = 0; idx = (unsigned)x * 64u + p; } } }
            if (kind < 0) { const unsigned d = xb_add(QD, 1u); if (d < 512u) { kind = 2; idx = d; } }
            MISC[0] = (unsigned)kind; MISC[1] = idx;
        }
        WG_BAR();
        const int kind = (int)MISC[0]; const int idx = (int)MISC[1];
        WG_BAR();
        if (kind < 0) break;
        if (kind == 0) { const int bh = idx >> 6, j = idx & 63, qb = 31 - (j >> 1), map = j & 1; attn_half_unit(F, bh, qb, map, map ? FP_O2 : FP_O1); }
        else { decode_unit(F, idx); asm volatile("s_waitcnt vmcnt(0) lgkmcnt(0)\n\ts_barrier" ::: "memory");
               if (kind == 1 && FTID(F) == 0) (void)__hip_atomic_fetch_sub(ctl + 64 * (9 + xq), 1u, __ATOMIC_RELAXED, __HIP_MEMORY_SCOPE_AGENT); }
    }
}

constexpr int NPHASE = 15;
#ifndef DUPMASK
#define DUPMASK 0
#endif
#ifndef PROBE_SEAMS
#define PROBE_SEAMS 0
#endif
#ifndef PROBE_MASK
#define PROBE_MASK 0
#endif
__global__ void __launch_bounds__(NTHR, 2) fwd_kernel(Args args) {
    extern __shared__ __attribute__((aligned(16))) unsigned char lds_raw[];
    Frame F;
    F.lds = (LAS unsigned char*)lds_raw;
    F.wave = __builtin_amdgcn_readfirstlane((int)threadIdx.x >> 6);
    F.G = gridDim.x; { const int bx = blockIdx.x; F.vcu = (F.G % 8 == 0) ? (bx % 8) * (F.G / 8) + bx / 8 : bx; }
    F.a = &args; unsigned char* ws = args.ws;
    volatile LAS unsigned* MISC = (volatile LAS unsigned*)(F.lds + MISC_OFF);
    for (int u = FTID(F); u < (LDS_BYTES - RING_BYTES) / 4; u += NTHR) ((LAS unsigned*)(F.lds + RING_BYTES))[u] = 0u;
    __syncthreads();
    const int lo = args.ph_lo, hi = args.ph_hi;
    const bool multi = (hi - lo) > 1;
    XcdBarrier bar; bar.bar = (unsigned*)(ws + WS_CTL) + CW_BAR; bar.x = 0; bar.st = nullptr; bar.wave = F.wave;
    if (multi) bar = xcd_barrier_post((unsigned*)(ws + WS_CTL) + CW_BAR, MISC + 8, F.wave);
#define IN(k) (lo <= (k) && (k) < hi)
    unsigned long long pr_t0 = 0ull, pr_acc = 0ull;
#define PST(k) do { if ((PROBE_MASK >> (k)) & 1) pr_t0 = __builtin_amdgcn_s_memrealtime(); } while (0)
#define PEN(k) do { if ((PROBE_MASK >> (k)) & 1) pr_acc += __builtin_amdgcn_s_memrealtime() - pr_t0; } while (0)
#define SEAM(k) do { if (IN(k) && IN((k) + 1)) { if ((PROBE_SEAMS >> (k)) & 1) pr_t0 = __builtin_amdgcn_s_memrealtime(); xcd_barrier(bar); if ((PROBE_SEAMS >> (k)) & 1) pr_acc += __builtin_amdgcn_s_memrealtime() - pr_t0; } } while (0)

#define DUP(k, ...) do { { __VA_ARGS__ } if ((DUPMASK >> (k)) & 1) { __VA_ARGS__ } } while (0)
    PST(0);
    if (IN(0)) { PST(15); p0_ada(F); PEN(15); p0_transposes(F); } SEAM(0); PEN(0);
    PST(1);
    if (IN(1)) { DUP(1,  p1_norm_gates(F); WG_BAR(); ); } SEAM(1); PEN(1);
    PST(2);
    if (IN(2)) { DUP(2,  pg8::Gemm g{FP_H1, FP_WinT, MT, ZN, DM, DM}; pg8::StaticOrder S; S.init(MT, ZN, F.G, (int)blockIdx.x); EpiZ E{FP_Z, FP_out, FP_IG, FP_LF, FP_b_if}; pg8::gemm_phase(F.lds, g, S, E, F.wave); ); } SEAM(2); PEN(2);
    PST(3);
    if (IN(3)) { DUP(3,  for (int u = F.vcu; u < 8 * NCH; u += F.G) mlstm_A_unit(F, u);
                 for (int u = F.vcu; u < 512; u += F.G) smlstm_unit(F, u); ); } SEAM(3); PEN(3);
    PST(4);
    PEN(4);
    PST(5);
    if (IN(5)) { for (int it = F.vcu; it < 256; it += F.G) mlstm_scan_item(F, it);
                 attention_phase(F, MISC); } SEAM(5); PEN(5);
    PST(6);
    if (IN(6)) { DUP(6,  for (int grp = F.vcu; grp < 256; grp += F.G) mlstm_C_group(F, grp);
                 attn_combine_rows(F);
                 { const float lam = lambda_full(F, lane_id()); for (int u = F.vcu; u < 512; u += F.G) decode_merge(F, u, lam); } ); } SEAM(6); PEN(6);
    PST(7);
    if (IN(7)) { DUP(7,  pg8::Gemm g{FP_HMD, FP_WpT, MP, DM, 512, DM}; pg8::StaticOrder S; S.init(MP, DM, F.G, (int)blockIdx.x); EpiPMD E{FP_Z, FP_MG}; pg8::gemm_phase<EpiPMD, true>(F.lds, g, S, E, F.wave);
                 skinny_gemm<true>(F, FP_HMD + (size_t)MP * DM, FP_WpT, DM, E); ); } SEAM(7); PEN(7);
    PST(8);
    PEN(8);
    PST(9);
    if (IN(9)) { DUP(9,  pg8::Gemm g{FP_MG, FP_WoutT, MP, DM, DM, DM}; pg8::StaticOrder S; S.init(MP, DM, F.G, (int)blockIdx.x); EpiF32 E{FP_Y}; pg8::gemm_phase(F.lds, g, S, E, F.wave);
                 skinny_gemm<false>(F, FP_MG + (size_t)MP * DM, FP_WoutT, DM, E); ); } SEAM(9); PEN(9);
    PST(10);
    if (IN(10)) { DUP(10,  rows_post_mix(F); ); } SEAM(10); PEN(10);
    PST(11);
    if (IN(11)) { DUP(11,  pg8::Gemm g{FP_H1, FP_WupT, MT, 2 * DFF, DM, DM}; pg8::StaticOrder S; S.init(MT, 2 * DFF, F.G, (int)blockIdx.x, 1);
                  EpiUpG E{FP_GB, FP_out, FP_conv_w, FP_conv_b, FP_state_conv, FP_AH, FP_AF, FP_BF}; pg8::gemm_phase(F.lds, g, S, E, F.wave); ); } SEAM(11); PEN(11);
    PST(12);
    PEN(12);
    PST(13);
    if (IN(13)) { DUP(13,  pg8::Gemm g{FP_GB, FP_WdownT, MP, DM, DFF, DFF}; pg8::StaticOrder S; S.init(MP, DM, F.G, (int)blockIdx.x); EpiF32 E{FP_Y};
                  { pg8::Unit u0; for (int i = 0; S.next(i, u0); ++i) geglu_fixup(F, u0.pm); }
                  pg8::gemm_phase(F.lds, g, S, E, F.wave);
                  skinny_gemm<false>(F, FP_GB + (size_t)MP * DFF, FP_WdownT, DFF, E); ); } SEAM(13); PEN(13);
    PST(14);
    if (IN(14)) { rows_final(F); } PEN(14);
#undef DUP
    if ((PROBE_MASK != 0 || PROBE_SEAMS != 0) && blockIdx.x == 0 && FTID(F) == 0) { const unsigned long long t0 = __builtin_amdgcn_s_memrealtime(); while (__builtin_amdgcn_s_memrealtime() - t0 < pr_acc) __builtin_amdgcn_s_sleep(8); }
#undef IN
#undef SEAM
}

#ifndef MK_ONE_LAUNCH
#define MK_ONE_LAUNCH 1
#endif
extern "C" void kernel_launch(void* const* d_in, const int* in_sizes, int n_in, void* d_out, int out_size, void* d_ws, size_t ws_size, hipStream_t stream) {
    static int grid = 0;
    if (grid == 0) {
        if (n_in != 32 || out_size != (int)OUT_TOTAL || ws_size < WS_END) { fprintf(stderr, "kernel_launch: unexpected sizes n_in %d out %d ws %zu\n", n_in, out_size, ws_size); grid = -1; return; }
        int dev = 0, cus = 0, per_cu = 0;
        if (hipGetDevice(&dev) != hipSuccess || hipDeviceGetAttribute(&cus, hipDeviceAttributeMultiprocessorCount, dev) != hipSuccess) { grid = -1; return; }
        if (hipFuncSetAttribute((const void*)fwd_kernel, hipFuncAttributeMaxDynamicSharedMemorySize, LDS_BYTES) != hipSuccess) { fprintf(stderr, "kernel_launch: hipFuncSetAttribute failed\n"); grid = -1; return; }
        if (hipOccupancyMaxActiveBlocksPerMultiprocessor(&per_cu, (const void*)fwd_kernel, NTHR, LDS_BYTES) != hipSuccess || per_cu < 1) fprintf(stderr, "kernel_launch: occupancy query reports %d\n", per_cu);
        (void)hipGetLastError();
        grid = cus;
    }
    if (grid < 0) return;
    if (hipMemsetAsync((char*)d_ws + WS_CTL, 0, CTL_ZERO_BYTES, stream) != hipSuccess) return;
    Args a{};
    for (int i = 0; i < 32; ++i) a.in[i] = d_in[i];
    a.out = (float*)d_out; a.ws = (unsigned char*)d_ws;
#if MK_ONE_LAUNCH
    a.ph_lo = 0; a.ph_hi = NPHASE;
    hipLaunchKernelGGL(fwd_kernel, dim3(grid), dim3(NTHR), LDS_BYTES, stream, a);
#else
    for (int p = 0; p < NPHASE; ++p) { a.ph_lo = p; a.ph_hi = p + 1; hipLaunchKernelGGL(fwd_kernel, dim3(grid), dim3(NTHR), LDS_BYTES, stream, a); }
#endif
}
```
